# Optimizing an MI355X kernel written in HIP

```python
import math
import jax
import jax.numpy as jnp
from jax import lax
import numpy as np

D_MODEL = 1024
BATCH = 16
SEQ = 4096
DEPTH = 4

CTX_LEN = 256
GRID_W = 64
N_MIXERS = 4
N_OCC = tuple((DEPTH - m + N_MIXERS - 1) // N_MIXERS for m in range(N_MIXERS))

HEAD_DIM = 64
ROPE_BASE = 10000.0
NORM_EPS = 1e-6
NEG_INF = -1e30

WIN_HEADS = D_MODEL // HEAD_DIM
WIN_KV_HEADS = WIN_HEADS // 4
WINDOW = 128
WIN_BLOCK = 128
WIN_QKV = (WIN_HEADS + 2 * WIN_KV_HEADS) * HEAD_DIM

DIFF_HEADS = D_MODEL // (2 * HEAD_DIM)
DIFF_Q_BLOCK = 128

POOL_WINDOWS = (2, 4, 8, 16)
POOL_GROUPS = len(POOL_WINDOWS)
POOL_GROUP_DIM = D_MODEL // POOL_GROUPS

RWKV_HEAD = 64
RWKV_HEADS = D_MODEL // RWKV_HEAD
DECAY_LORA = 64
AAA_LORA = 64
GATE_LORA = 128
GN_EPS = 64e-5

N_GROUPS = 4
EXPERTS_PER_GROUP = 8
N_EXPERTS = N_GROUPS * EXPERTS_PER_GROUP
TOP_K_IN_GROUP = 2
EXPERT_FF = D_MODEL // 2
MOE_BLOCK = 256

kernel_name = "hybrid_dit_interleaved_moe"


def rmsnorm(x, g):
    xf = x.astype(jnp.float32)
    y = xf * lax.rsqrt(jnp.mean(xf * xf, axis=-1, keepdims=True) + NORM_EPS)
    return (y * g.astype(jnp.float32)).astype(x.dtype)


def axial_rope_tables(rows, dim):
    row = jnp.repeat(jnp.arange(rows), GRID_W).astype(jnp.float32)
    col = jnp.tile(jnp.arange(GRID_W), rows).astype(jnp.float32)
    nf = dim // 4
    inv = ROPE_BASE ** (-jnp.arange(nf, dtype=jnp.float32) / nf)
    ar, ac = row[:, None] * inv, col[:, None] * inv
    ang = jnp.concatenate([ar, ar, ac, ac], axis=-1)
    return jnp.cos(ang), jnp.sin(ang)


def apply_rope(x, cos, sin):
    shp = x.shape
    x4 = x.reshape(shp[:-1] + (2, 2, shp[-1] // 4))
    rot = jnp.concatenate([-x4[..., 1:, :], x4[..., :1, :]], axis=-2).reshape(shp)
    bshape = (shp[1],) + (1,) * (x.ndim - 3) + (shp[-1],)
    return x * cos.reshape(bshape).astype(x.dtype) + rot * sin.reshape(bshape).astype(x.dtype)


def window_attention(h, hc, cos, sin, w_qkv, sink, w_o, ctx_out):
    B, S, D = h.shape
    G = WIN_HEADS // WIN_KV_HEADS
    nq, nkv = WIN_HEADS * HEAD_DIM, WIN_KV_HEADS * HEAD_DIM

    def proj(t):
        qkv = t @ w_qkv
        lead = t.shape[:2]
        q = qkv[..., :nq].reshape(lead + (WIN_KV_HEADS, G, HEAD_DIM)) * HEAD_DIM ** -0.5
        k = qkv[..., nq:nq + nkv].reshape(lead + (WIN_KV_HEADS, HEAD_DIM))
        v = qkv[..., nq + nkv:].reshape(lead + (WIN_KV_HEADS, HEAD_DIM))
        return q, k, v

    q, k, v = proj(h)
    qc, kc, vc = proj(hc)
    q, k = apply_rope(q, cos, sin), apply_rope(k, cos, sin)
    sink_f = sink.astype(jnp.float32).reshape(1, WIN_KV_HEADS, G, 1, 1)

    def sink_softmax(parts):
        s = jnp.concatenate(parts + [jnp.broadcast_to(sink_f, parts[0].shape[:-1] + (1,))], axis=-1)
        return jax.nn.softmax(s, axis=-1)

    pad = ((0, 0), (WIN_BLOCK, WIN_BLOCK), (0, 0), (0, 0))
    kp, vp = jnp.pad(k, pad), jnp.pad(v, pad)
    nb = S // WIN_BLOCK
    span = 3 * WIN_BLOCK
    rel = jnp.arange(span)[None, :] - WIN_BLOCK - jnp.arange(WIN_BLOCK)[:, None]
    in_window = jnp.abs(rel) <= WINDOW
    qb = jnp.moveaxis(q.reshape((B, nb, WIN_BLOCK) + q.shape[2:]), 1, 0)

    def block(args):
        n, qblk = args
        start = n * WIN_BLOCK
        kblk = lax.dynamic_slice_in_dim(kp, start, span, axis=1)
        vblk = lax.dynamic_slice_in_dim(vp, start, span, axis=1)
        key_pos = start - WIN_BLOCK + jnp.arange(span)
        mask = in_window & ((key_pos >= 0) & (key_pos < S))[None, :]
        s_loc = jnp.einsum('bqhgd,bkhd->bhgqk', qblk, kblk, preferred_element_type=jnp.float32)
        s_loc = jnp.where(mask, s_loc, NEG_INF)
        s_ctx = jnp.einsum('bqhgd,bchd->bhgqc', qblk, kc, preferred_element_type=jnp.float32)
        p = sink_softmax([s_loc, s_ctx]).astype(v.dtype)
        return (jnp.einsum('bhgqk,bkhd->bqhgd', p[..., :span], vblk)
                + jnp.einsum('bhgqc,bchd->bqhgd', p[..., span:-1], vc))

    o = lax.map(block, (jnp.arange(nb), qb))
    y = jnp.moveaxis(o, 0, 1).reshape(B, S, D) @ w_o
    yc = None
    if ctx_out:
        s = jnp.einsum('bqhgd,bkhd->bhgqk', qc, kc, preferred_element_type=jnp.float32)
        pc = sink_softmax([s]).astype(v.dtype)
        yc = jnp.einsum('bhgqk,bkhd->bqhgd', pc[..., :-1], vc).reshape(hc.shape) @ w_o
    return y, yc


def diff_attention(h, hc, cos, sin, w_qkv, lam, subln_g, w_o, lambda_init, ctx_out):
    B, S, D = h.shape
    dv = 2 * HEAD_DIM

    def proj(t):
        qkv = t @ w_qkv
        lead = t.shape[:2]
        q = qkv[..., :D].reshape(lead + (DIFF_HEADS, 2, HEAD_DIM)) * HEAD_DIM ** -0.5
        k = qkv[..., D:2 * D].reshape(lead + (DIFF_HEADS, 2, HEAD_DIM))
        v = qkv[..., 2 * D:].reshape(lead + (DIFF_HEADS, dv))
        return q, k, v

    q, k, v = proj(h)
    qc, kc, vc = proj(hc)
    q, k = apply_rope(q, cos, sin), apply_rope(k, cos, sin)
    lf = lam.astype(jnp.float32)
    lam_full = jnp.exp(jnp.sum(lf[0] * lf[1])) - jnp.exp(jnp.sum(lf[2] * lf[3])) + lambda_init

    def attend(qblk, keys, vals):
        s = jnp.einsum('bqhmd,bkhmd->bhmqk', qblk, keys, preferred_element_type=jnp.float32)
        p = jax.nn.softmax(s, axis=-1)
        a = (p[:, :, 0] - lam_full * p[:, :, 1]).astype(vals.dtype)
        return jnp.einsum('bhqk,bkhd->bqhd', a, vals)

    def post(o):
        o = rmsnorm(o, subln_g) * (1.0 - lambda_init)
        return o.reshape(o.shape[:2] + (D,)) @ w_o

    k_all = jnp.concatenate([k, kc], axis=1)
    v_all = jnp.concatenate([v, vc], axis=1)
    nb = S // DIFF_Q_BLOCK
    qb = jnp.moveaxis(q.reshape((B, nb, DIFF_Q_BLOCK) + q.shape[2:]), 1, 0)
    o = lax.map(lambda qblk: attend(qblk, k_all, v_all), qb)
    y = post(jnp.moveaxis(o, 0, 1).reshape(B, S, DIFF_HEADS, dv))
    yc = post(attend(qc, kc, vc)) if ctx_out else None
    return y, yc


def multiscale_pool(t, w_group, b_group, layer_scale):
    B, L, D = t.shape
    tf = t.astype(jnp.float32)
    cs = jnp.concatenate([jnp.zeros((B, 1, D), jnp.float32), jnp.cumsum(tf, axis=1)], axis=1)
    pos = jnp.arange(L)
    means = []
    for gi, w in enumerate(POOL_WINDOWS):
        lo = jnp.clip(pos - w // 2, 0, L)
        hi = jnp.clip(pos + w - w // 2, 0, L)
        csg = cs[..., gi * POOL_GROUP_DIM:(gi + 1) * POOL_GROUP_DIM]
        means.append((csg[:, hi] - csg[:, lo]) / (hi - lo).astype(jnp.float32)[None, :, None])
    y = (jnp.concatenate(means, axis=-1) - tf).astype(t.dtype).reshape(B, L, POOL_GROUPS, POOL_GROUP_DIM)
    y = jnp.einsum('blgc,gcd->blgd', y, w_group).reshape(B, L, D) + b_group
    return y * layer_scale


def rwkv_features(t, p, with_out):
    mu, w_rkv, w0, w_a1, w_a2, a0, a_a1, a_a2, g1, g2, k_k, k_a = p
    B, L, D = t.shape
    prev = jnp.pad(t, ((0, 0), (1, 0), (0, 0)))[:, :-1]
    nxt = jnp.pad(t, ((0, 0), (0, 1), (0, 0)))[:, 1:]
    dp, dn = prev - t, nxt - t

    def mix(i):
        return t + dp * mu[0, i] + dn * mu[1, i]

    def heads(u):
        return u.astype(jnp.float32).reshape(B, L, RWKV_HEADS, RWKV_HEAD)

    k = (mix(2) @ w_rkv[1]).astype(jnp.float32)
    v = heads(mix(3) @ w_rkv[2])
    kk = heads(k * k_k.astype(jnp.float32))
    kk = kk / jnp.maximum(jnp.sqrt(jnp.sum(kk * kk, axis=-1, keepdims=True)), 1e-12)
    xw, xa = mix(1), mix(4)
    dirs = []
    for d in range(2):
        w = -jax.nn.softplus(-(w0[d] + jnp.tanh(xw @ w_a1[d]) @ w_a2[d]).astype(jnp.float32)) - 0.5
        a = jax.nn.sigmoid((a0[d] + (xa @ a_a1[d]) @ a_a2[d]).astype(jnp.float32))
        kd = k * (1.0 + (a - 1.0) * k_a.astype(jnp.float32))
        dirs.append((heads(jnp.exp(-jnp.exp(w))), heads(a), heads(kd)))
    r = heads(mix(0) @ w_rkv[0]) if with_out else None
    g = (jax.nn.sigmoid(mix(5) @ g1) @ g2).astype(jnp.float32) if with_out else None
    return r, v, kk, g, dirs


def rwkv_scan(state0, decay, k, v, kk, a, r, reverse):
    emit = r is not None
    seq = (decay, k, v, kk, a) + ((r,) if emit else ())
    xs = tuple(jnp.moveaxis(u, 1, 0) for u in seq)

    def step(S, inp):
        w_t, k_t, v_t, kk_t, a_t = inp[:5]
        sa = jnp.einsum('bhvk,bhk->bhv', S, kk_t)
        S = (S * w_t[:, :, None, :] - sa[..., None] * (kk_t * a_t)[:, :, None, :]
             + v_t[..., None] * k_t[:, :, None, :])
        return S, (jnp.einsum('bhvk,bhk->bhv', S, inp[5]) if emit else None)

    S_fin, out = lax.scan(step, state0, xs, reverse=reverse)
    return S_fin, (jnp.moveaxis(out, 0, 1) if emit else None)


def rwkv_output(o, r, v, kds, g, r_k, ln_w, ln_b, w_o, dtype):
    B, L = o.shape[:2]
    mean = jnp.mean(o, axis=-1, keepdims=True)
    var = jnp.mean(jnp.square(o - mean), axis=-1, keepdims=True)
    on = ((o - mean) * lax.rsqrt(var + GN_EPS)).reshape(B, L, D_MODEL) * ln_w.astype(jnp.float32) + ln_b.astype(jnp.float32)
    rk = r_k.astype(jnp.float32)
    bonus = (jnp.sum(r * kds[0] * rk, axis=-1, keepdims=True) * v
             + jnp.sum(r * kds[1] * rk, axis=-1, keepdims=True) * v).reshape(B, L, D_MODEL)
    return ((on + bonus) * g).astype(dtype) @ w_o


def rwkv_mix(h, hc, feat_p, out_p, ctx_out):
    r_k, ln_w, ln_b, w_o = out_p
    r, v, kk, g, dirs = rwkv_features(h, feat_p, True)
    rc, vc, kkc, gc, dirs_c = rwkv_features(hc, feat_p, ctx_out)
    B = h.shape[0]
    outs, outs_c = [], []
    for d, rev in enumerate((False, True)):
        S0 = jnp.zeros((B, RWKV_HEADS, RWKV_HEAD, RWKV_HEAD), jnp.float32)
        dec_c, a_c, k_c = dirs_c[d]
        S_c, o_c = rwkv_scan(S0, dec_c, k_c, vc, kkc, a_c, rc, rev)
        dec, a, kd = dirs[d]
        _, o_l = rwkv_scan(S_c, dec, kd, v, kk, a, r, rev)
        outs.append(o_l)
        outs_c.append(o_c)
    y = rwkv_output(outs[0] + outs[1], r, v, [dd[2] for dd in dirs], g, r_k, ln_w, ln_b, w_o, h.dtype)
    yc = None
    if ctx_out:
        yc = rwkv_output(outs_c[0] + outs_c[1], rc, vc, [dd[2] for dd in dirs_c], gc, r_k, ln_w, ln_b, w_o, hc.dtype)
    return y, yc


def expert_dispatch(t, eid, wts, w_up, w_down):
    T, D = t.shape
    A = T * TOP_K_IN_GROUP
    flat_e = eid.reshape(A)
    flat_tok = jnp.arange(A, dtype=jnp.int32) // TOP_K_IN_GROUP
    flat_w = wts.reshape(A)
    order = jnp.argsort(flat_e)
    se, stok, sw = flat_e[order], flat_tok[order], flat_w[order]
    counts = jnp.zeros((N_EXPERTS,), jnp.int32).at[flat_e].add(1)
    start = jnp.cumsum(counts) - counts
    nblk = (counts + MOE_BLOCK - 1) // MOE_BLOCK
    blk_end = jnp.cumsum(nblk)
    blk_start = blk_end - nblk
    dest = blk_start[se] * MOE_BLOCK + (jnp.arange(A, dtype=jnp.int32) - start[se])
    NB = -(-A // MOE_BLOCK) + N_EXPERTS
    src = jnp.full((NB * MOE_BLOCK,), T, jnp.int32).at[dest].set(stok)
    xb = jnp.concatenate([t, jnp.zeros((1, D), t.dtype)], axis=0)[src].reshape(NB, MOE_BLOCK, D)
    blk_expert = jnp.minimum(jnp.searchsorted(blk_end, jnp.arange(NB), side='right'), N_EXPERTS - 1)

    def run(args):
        xblk, e = args
        u = xblk @ w_up[e]
        return (jax.nn.silu(u[:, :EXPERT_FF]) * u[:, EXPERT_FF:]) @ w_down[e]

    yb = lax.map(run, (xb, blk_expert)).reshape(NB * MOE_BLOCK, D)
    return jnp.zeros((T, D), t.dtype).at[stok].add(yb[dest] * sw[:, None].astype(t.dtype))


def hier_moe(t, wg, bg, we, be, w_up, w_down):
    T, D = t.shape
    lg = (t @ wg).astype(jnp.float32) + bg.astype(jnp.float32)
    gsel = jnp.argmax(lg, axis=-1)
    p_grp = jnp.max(jax.nn.softmax(lg, axis=-1), axis=-1)
    le = ((t @ we).astype(jnp.float32) + be.astype(jnp.float32)).reshape(T, N_GROUPS, EXPERTS_PER_GROUP)
    le_sel = jnp.einsum('tge,tg->te', le, jax.nn.one_hot(gsel, N_GROUPS, dtype=jnp.float32))
    top_p, top_i = lax.top_k(jax.nn.softmax(le_sel, axis=-1), TOP_K_IN_GROUP)
    wts = p_grp[:, None] * top_p / jnp.sum(top_p, axis=-1, keepdims=True)
    eid = (gsel[:, None] * EXPERTS_PER_GROUP + top_i).astype(jnp.int32)
    return expert_dispatch(t, eid, wts, w_up, w_down)


def setup_inputs(seed: int = 0) -> dict:
    key = jax.random.key(seed)
    keys = iter(jax.random.split(key, 64))
    f32 = jnp.float32

    def nrm(shape, scale):
        return jax.random.normal(next(keys), shape, f32) * scale

    def near_one(shape):
        return 1.0 + nrm(shape, 0.02)

    NA, NBD, NC, ND = N_OCC
    D = D_MODEL
    return {
        "x": nrm((BATCH, SEQ, D), 1.0),
        "c": nrm((BATCH, D), 1.0),
        "ctx": nrm((BATCH, CTX_LEN, D), 1.0),
        "c_ctx": nrm((D,), 1.0),
        "mod_w": nrm((DEPTH, D, 6 * D), 0.5 * D ** -0.5),
        "mod_b": nrm((DEPTH, 6 * D), 0.02),
        "norm_g": near_one((DEPTH, 2, D)),
        "final_g": near_one((D,)),
        "win_w_qkv": nrm((NA, D, WIN_QKV), D ** -0.5),
        "win_sink": nrm((NA, WIN_HEADS), 0.5),
        "win_w_o": nrm((NA, D, D), D ** -0.5),
        "diff_w_qkv": nrm((NBD, D, 3 * D), D ** -0.5),
        "diff_lambda": nrm((NBD, 4, HEAD_DIM), 0.1),
        "diff_subln_g": near_one((NBD, 2 * HEAD_DIM)),
        "diff_w_o": nrm((NBD, D, D), D ** -0.5),
        "pool_w_group": nrm((NC, POOL_GROUPS, POOL_GROUP_DIM, POOL_GROUP_DIM), POOL_GROUP_DIM ** -0.5),
        "pool_b_group": nrm((NC, D), 0.02),
        "pool_scale": near_one((NC, D)),
        "rwkv_mu": jax.random.uniform(next(keys), (ND, 2, 6, D), f32, 0.0, 0.5),
        "rwkv_w_rkv": nrm((ND, 3, D, D), D ** -0.5),
        "rwkv_w0": jax.random.uniform(next(keys), (ND, 2, D), f32, -5.0, -0.5),
        "rwkv_w_a1": nrm((ND, 2, D, DECAY_LORA), D ** -0.5),
        "rwkv_w_a2": nrm((ND, 2, DECAY_LORA, D), 0.1 * DECAY_LORA ** -0.5),
        "rwkv_a0": nrm((ND, 2, D), 0.1),
        "rwkv_a_a1": nrm((ND, 2, D, AAA_LORA), D ** -0.5),
        "rwkv_a_a2": nrm((ND, 2, AAA_LORA, D), 0.1 * AAA_LORA ** -0.5),
        "rwkv_g1": nrm((ND, D, GATE_LORA), D ** -0.5),
        "rwkv_g2": nrm((ND, GATE_LORA, D), GATE_LORA ** -0.5),
        "rwkv_k_k": 0.85 + nrm((ND, D), 0.02),
        "rwkv_k_a": near_one((ND, D)),
        "rwkv_r_k": nrm((ND, RWKV_HEADS, RWKV_HEAD), 0.1),
        "rwkv_ln_w": near_one((ND, D)),
        "rwkv_ln_b": nrm((ND, D), 0.02),
        "rwkv_w_o": nrm((ND, D, D), D ** -0.5),
        "moe_wg": nrm((DEPTH, D, N_GROUPS), D ** -0.5),
        "moe_bg": nrm((DEPTH, N_GROUPS), 0.01),
        "moe_we": nrm((DEPTH, D, N_EXPERTS), D ** -0.5),
        "moe_be": nrm((DEPTH, N_EXPERTS), 0.01),
        "moe_w_up": nrm((DEPTH, N_EXPERTS, D, 2 * EXPERT_FF), D ** -0.5),
        "moe_w_down": nrm((DEPTH, N_EXPERTS, EXPERT_FF, D), EXPERT_FF ** -0.5),
    }


def reference(x, c, ctx, c_ctx, mod_w, mod_b, norm_g, final_g,
              win_w_qkv, win_sink, win_w_o,
              diff_w_qkv, diff_lambda, diff_subln_g, diff_w_o,
              pool_w_group, pool_b_group, pool_scale,
              rwkv_mu, rwkv_w_rkv, rwkv_w0, rwkv_w_a1, rwkv_w_a2, rwkv_a0, rwkv_a_a1, rwkv_a_a2,
              rwkv_g1, rwkv_g2, rwkv_k_k, rwkv_k_a, rwkv_r_k, rwkv_ln_w, rwkv_ln_b, rwkv_w_o,
              moe_wg, moe_bg, moe_we, moe_be, moe_w_up, moe_w_down):
    B, S, D = x.shape
    C = ctx.shape[1]
    ROWS = S // GRID_W
    cos, sin = axial_rope_tables(ROWS, HEAD_DIM)
    xc = ctx
    for i in range(DEPTH):
        m, occ = i % N_MIXERS, i // N_MIXERS
        last = i == DEPTH - 1
        mod = (jax.nn.silu(c) @ mod_w[i] + mod_b[i]).reshape(B, 6, 1, D)
        modc = (jax.nn.silu(c_ctx) @ mod_w[i] + mod_b[i]).reshape(6, D)
        h = rmsnorm(x, norm_g[i, 0]) * (1 + mod[:, 1]) + mod[:, 0]
        need_ctx = (not last) or m != 2
        hc = rmsnorm(xc, norm_g[i, 0]) * (1 + modc[1]) + modc[0] if need_ctx else None
        if m == 0:
            y, yc = window_attention(h, hc, cos, sin, win_w_qkv[occ], win_sink[occ], win_w_o[occ], not last)
        elif m == 1:
            lambda_init = 0.8 - 0.6 * math.exp(-0.3 * i)
            y, yc = diff_attention(h, hc, cos, sin, diff_w_qkv[occ], diff_lambda[occ], diff_subln_g[occ],
                                   diff_w_o[occ], lambda_init, not last)
        elif m == 2:
            y = multiscale_pool(h, pool_w_group[occ], pool_b_group[occ], pool_scale[occ])
            yc = None if last else multiscale_pool(hc, pool_w_group[occ], pool_b_group[occ], pool_scale[occ])
        else:
            feat_p = (rwkv_mu[occ], rwkv_w_rkv[occ], rwkv_w0[occ], rwkv_w_a1[occ], rwkv_w_a2[occ],
                      rwkv_a0[occ], rwkv_a_a1[occ], rwkv_a_a2[occ], rwkv_g1[occ], rwkv_g2[occ],
                      rwkv_k_k[occ], rwkv_k_a[occ])
            out_p = (rwkv_r_k[occ], rwkv_ln_w[occ], rwkv_ln_b[occ], rwkv_w_o[occ])
            y, yc = rwkv_mix(h, hc, feat_p, out_p, not last)
        x = x + mod[:, 2] * y
        h = rmsnorm(x, norm_g[i, 1]) * (1 + mod[:, 4]) + mod[:, 3]
        moe_p = (moe_wg[i], moe_bg[i], moe_we[i], moe_be[i], moe_w_up[i], moe_w_down[i])
        if last:
            x = x + mod[:, 5] * hier_moe(h.reshape(B * S, D), *moe_p).reshape(B, S, D)
        else:
            xc = xc + modc[2] * yc
            hc = rmsnorm(xc, norm_g[i, 1]) * (1 + modc[4]) + modc[3]
            out = hier_moe(jnp.concatenate([h.reshape(B * S, D), hc.reshape(B * C, D)], axis=0), *moe_p)
            x = x + mod[:, 5] * out[:B * S].reshape(B, S, D)
            xc = xc + modc[5] * out[B * S:].reshape(B, C, D)
    return rmsnorm(x, final_g)
```

```cpp
#include <hip/hip_runtime.h>
#include <stdint.h>
#include <stddef.h>

typedef unsigned short bf16_t;
typedef short bf16x8 __attribute__((ext_vector_type(8)));
typedef short s16x4 __attribute__((ext_vector_type(4)));
typedef float f32x4 __attribute__((ext_vector_type(4)));
typedef float f32x16 __attribute__((ext_vector_type(16)));
typedef unsigned u32x4 __attribute__((ext_vector_type(4)));
typedef unsigned u32x2 __attribute__((ext_vector_type(2)));
#define DI __device__ __forceinline__

constexpr int DM = 1024, NBATCH = 16, SEQ = 4096, CTX = 256;
constexpr int TL = NBATCH * SEQ, TC = NBATCH * CTX, TT = TL + TC;
constexpr int NTH = 512;
constexpr int MOE_PAD = 128;
constexpr int MOE_ROWS = 2 * TT + 32 * MOE_PAD;
constexpr int CAP = TT;

constexpr size_t al256(size_t x) { return (x + 255) & ~(size_t)255; }
constexpr size_t OFF_BAR = 0;
constexpr size_t OFF_CNT = 16384;
constexpr size_t OFF_MOD = 32768;
constexpr size_t OFF_ROPE = al256(OFF_MOD + (size_t)4 * 17 * 6144 * 4);
constexpr size_t OFF_XC = al256(OFF_ROPE + 2 * 64 * 16 * 4);
constexpr size_t OFF_H = al256(OFF_XC + (size_t)TC * DM * 4);
constexpr size_t OFF_TOK = al256(OFF_H + (size_t)TT * DM * 2);
constexpr size_t OFF_ROWL = al256(OFF_TOK + (size_t)TT * 32);
constexpr size_t OFF_WMIX = al256(OFF_ROWL + (size_t)32 * CAP * 4);
constexpr size_t W_WINQKV = 0;
constexpr size_t W_WINO = W_WINQKV + (size_t)1536 * 1024;
constexpr size_t W_DIFFQKV = W_WINO + (size_t)1024 * 1024;
constexpr size_t W_DIFFO = W_DIFFQKV + (size_t)3072 * 1024;
constexpr size_t W_POOL = W_DIFFO + (size_t)1024 * 1024;
constexpr size_t W_R = W_POOL + (size_t)4 * 256 * 256;
constexpr size_t W_K = W_R + (size_t)1024 * 1024;
constexpr size_t W_V = W_K + (size_t)1024 * 1024;
constexpr size_t W_WA1 = W_V + (size_t)1024 * 1024;
constexpr size_t W_AA1 = W_WA1 + (size_t)128 * 1024;
constexpr size_t W_G1 = W_AA1 + (size_t)128 * 1024;
constexpr size_t W_WA2 = W_G1 + (size_t)128 * 1024;
constexpr size_t W_AA2 = W_WA2 + (size_t)2 * 1024 * 64;
constexpr size_t W_G2 = W_AA2 + (size_t)2 * 1024 * 64;
constexpr size_t W_RO = W_G2 + (size_t)1024 * 128;
constexpr size_t W_MIX_END = W_RO + (size_t)1024 * 1024;
constexpr size_t OFF_WMOE = al256(OFF_WMIX + W_MIX_END * 2);
constexpr size_t WMOE_DOWN = (size_t)32 * 1024 * 1024;
constexpr size_t OFF_U = al256(OFF_WMOE + ((size_t)32 * 1024 * 1024 + (size_t)32 * 1024 * 512) * 2);
constexpr size_t SZ_TT = (size_t)TT * DM * 2, SZ_TL = (size_t)TL * DM * 2;
constexpr size_t U0_Q = 0, U0_K = U0_Q + SZ_TT, U0_VTL = U0_K + (size_t)TT * 256 * 2, U0_VTC = U0_VTL + (size_t)16 * 256 * 4096 * 2,
                 U0_O = U0_VTC + (size_t)16 * 256 * 256 * 2, U0_END = U0_O + SZ_TT;
constexpr size_t U1_Q = 0, U1_K = U1_Q + SZ_TT, U1_VTL = U1_K + SZ_TT, U1_VTC = U1_VTL + (size_t)16 * 1024 * 4096 * 2,
                 U1_O = U1_VTC + (size_t)16 * 1024 * 256 * 2, U1_END = U1_O + SZ_TT;
constexpr size_t U3_R = 0, U3_K = U3_R + SZ_TL, U3_V = U3_K + SZ_TT, U3_A0 = U3_V + SZ_TT, U3_A1 = U3_A0 + SZ_TT, U3_LD0 = U3_A1 + SZ_TT,
                 U3_LD1 = U3_LD0 + SZ_TT, U3_LW = U3_LD1 + SZ_TT, U3_LA = U3_LW + (size_t)TT * 128 * 2, U3_LG = U3_LA + (size_t)TT * 128 * 2,
                 U3_G = U3_LG + (size_t)TL * 128 * 2, U3_O0 = U3_G + SZ_TL, U3_O1 = U3_O0 + SZ_TL, U3_END = U3_O1 + SZ_TL;
constexpr size_t UM_ACT = 0, UM_YB = UM_ACT + (size_t)MOE_ROWS * 512 * 2, UM_END = UM_YB + (size_t)MOE_ROWS * 1024 * 2;
constexpr size_t cmax(size_t a, size_t b) { return a > b ? a : b; }
constexpr size_t U_SIZE = cmax(cmax(U0_END, U1_END), cmax(U3_END, UM_END));
constexpr size_t WS_NEED = OFF_U + U_SIZE;

struct CvtJob { const float* src; bf16_t* dst; int K, N, ld, item0; };
constexpr int NJOBS = 24;
struct Params {
  const float* in[40];
  float* out;
  char* ws;
  CvtJob jobs[NJOBS];
  int njobs, nitems;
};

DI unsigned pk2(float lo, float hi) {
  typedef __bf16 bf2 __attribute__((ext_vector_type(2)));
  typedef float f2 __attribute__((ext_vector_type(2)));
  f2 v = {lo, hi};
  return __builtin_bit_cast(unsigned, __builtin_convertvector(v, bf2));
}
DI bf16_t f2bf(float x) { return (bf16_t)(pk2(x, 0.f) & 0xffffu); }
DI float bf2f(bf16_t b) { return __uint_as_float(((unsigned)b) << 16); }
DI float bflo(unsigned u) { return __uint_as_float(u << 16); }
DI float bfhi(unsigned u) { return __uint_as_float(u & 0xffff0000u); }
DI float wave_sum(float v) {
#pragma unroll
  for (int o = 32; o >= 1; o >>= 1) v += __shfl_xor(v, o);
  return v;
}
DI float sigmoidf_(float x) { return 1.0f / (1.0f + __expf(-x)); }
DI int row_bi(int r) { return r < TL ? (r >> 12) : 16; }
DI float* xrow_ptr(const Params& p, int r) { return r < TL ? p.out + (size_t)r * DM : (float*)(p.ws + OFF_XC) + (size_t)(r - TL) * DM; }
DI const float* modp(const Params& p, int layer, int bi, int which) { return (const float*)(p.ws + OFF_MOD) + ((size_t)(layer * 17 + bi) * 6 + which) * DM; }
#define MFMA16(a, b, c) __builtin_amdgcn_mfma_f32_16x16x32_bf16((a), (b), (c), 0, 0, 0)
#define MFMA32(a, b, c) __builtin_amdgcn_mfma_f32_32x32x16_bf16((a), (b), (c), 0, 0, 0)

constexpr int SGLD = 72;
constexpr int SG_LDS = 2 * 128 * SGLD * 2;
template <class AL, class BL, class EP>
DI void sgemm_tile(char* smem, int K, AL la, BL lb, EP ep) {
  bf16_t* sA = (bf16_t*)smem;
  bf16_t* sB = sA + 128 * SGLD;
  const int tid = threadIdx.x, lane = tid & 63, wid = tid >> 6, wr = wid >> 2, wc = wid & 3, fr = lane & 15, fq = lane >> 4;
  f32x4 acc[4][2];
#pragma unroll
  for (int m = 0; m < 4; ++m)
#pragma unroll
    for (int n = 0; n < 2; ++n) acc[m][n] = (f32x4){0.f, 0.f, 0.f, 0.f};
  const int r_ = tid >> 3, k_ = (tid & 7) * 8;
  u32x4 ra0 = la(r_, k_), ra1 = la(r_ + 64, k_), rb0 = lb(r_, k_), rb1 = lb(r_ + 64, k_);
  const int nk = K >> 6;
  for (int kt = 0; kt < nk; ++kt) {
    __syncthreads();
    *(u32x4*)(sA + r_ * SGLD + k_) = ra0;
    *(u32x4*)(sA + (r_ + 64) * SGLD + k_) = ra1;
    *(u32x4*)(sB + r_ * SGLD + k_) = rb0;
    *(u32x4*)(sB + (r_ + 64) * SGLD + k_) = rb1;
    __syncthreads();
    if (kt + 1 < nk) {
      const int kk = (kt + 1) * 64 + k_;
      ra0 = la(r_, kk); ra1 = la(r_ + 64, kk); rb0 = lb(r_, kk); rb1 = lb(r_ + 64, kk);
    }
#pragma unroll
    for (int ks = 0; ks < 2; ++ks) {
      bf16x8 af[4], bq[2];
#pragma unroll
      for (int m = 0; m < 4; ++m) af[m] = *(const bf16x8*)(sA + (wr * 64 + m * 16 + fr) * SGLD + ks * 32 + fq * 8);
#pragma unroll
      for (int n = 0; n < 2; ++n) bq[n] = *(const bf16x8*)(sB + (wc * 32 + n * 16 + fr) * SGLD + ks * 32 + fq * 8);
#pragma unroll
      for (int m = 0; m < 4; ++m)
#pragma unroll
        for (int n = 0; n < 2; ++n) acc[m][n] = MFMA16(af[m], bq[n], acc[m][n]);
    }
  }
  ep(acc, wr * 64, wc * 32, fr, fq);
}
DI u32x4 ld16(const bf16_t* p) { return *(const u32x4*)p; }

DI void cvt_tile(char* smem, const float* src, int ld, bf16_t* dst, int K, int N, int item) {
  float* tile = (float*)smem;
  const int ntn = N >> 6, kt = item / ntn, nt = item % ntn, k0 = kt * 64, n0 = nt * 64, tid = threadIdx.x;
  __syncthreads();
#pragma unroll
  for (int i = 0; i < 8; ++i) { const int idx = tid + i * NTH, r = idx >> 6, c = idx & 63; tile[r * 65 + c] = src[(size_t)(k0 + r) * ld + n0 + c]; }
  __syncthreads();
  const int n = tid >> 3, k8 = (tid & 7) * 8;
  u32x4 o;
  o.x = pk2(tile[(k8 + 0) * 65 + n], tile[(k8 + 1) * 65 + n]);
  o.y = pk2(tile[(k8 + 2) * 65 + n], tile[(k8 + 3) * 65 + n]);
  o.z = pk2(tile[(k8 + 4) * 65 + n], tile[(k8 + 5) * 65 + n]);
  o.w = pk2(tile[(k8 + 6) * 65 + n], tile[(k8 + 7) * 65 + n]);
  *(u32x4*)(dst + (size_t)(n0 + n) * K + k0 + k8) = o;
}
DI void phase_cvt_mix(const Params& p, char* smem) {
  for (int it = blockIdx.x; it < p.nitems; it += gridDim.x) {
    int j = 0;
    while (j + 1 < p.njobs && p.jobs[j + 1].item0 <= it) ++j;
    const CvtJob& jb = p.jobs[j];
    cvt_tile(smem, jb.src, jb.ld, jb.dst, jb.K, jb.N, it - jb.item0);
  }
}
DI int up_src_col(int np) { const int tile = np >> 7, wc = (np >> 5) & 3, half = (np >> 4) & 1, i = np & 15; return half * 512 + tile * 64 + wc * 16 + i; }
DI void phase_cvt_moe(const Params& p, int layer, char* smem) {
  float* tile = (float*)smem;
  bf16_t* wm = (bf16_t*)(p.ws + OFF_WMOE);
  const int tid = threadIdx.x;
  const int NUP = 32 * 256, NDN = 32 * 128;
  for (int it = blockIdx.x; it < NUP + NDN; it += gridDim.x) {
    if (it < NUP) {
      const int e = it >> 8, t = it & 255, kt = t >> 4, nt = t & 15, k0 = kt * 64, n0 = nt * 64;
      const float* src = p.in[38] + ((size_t)(layer * 32 + e) * 1024) * 1024;
      bf16_t* dst = wm + (size_t)e * 1024 * 1024;
      __syncthreads();
#pragma unroll
      for (int i = 0; i < 8; ++i) { const int idx = tid + i * NTH, r = idx >> 6, c = idx & 63; tile[r * 65 + c] = src[(size_t)(k0 + r) * 1024 + up_src_col(n0 + c)]; }
      __syncthreads();
      const int n = tid >> 3, k8 = (tid & 7) * 8;
      u32x4 o;
      o.x = pk2(tile[(k8 + 0) * 65 + n], tile[(k8 + 1) * 65 + n]); o.y = pk2(tile[(k8 + 2) * 65 + n], tile[(k8 + 3) * 65 + n]);
      o.z = pk2(tile[(k8 + 4) * 65 + n], tile[(k8 + 5) * 65 + n]); o.w = pk2(tile[(k8 + 6) * 65 + n], tile[(k8 + 7) * 65 + n]);
      *(u32x4*)(dst + (size_t)(n0 + n) * 1024 + k0 + k8) = o;
    } else {
      const int i2 = it - NUP, e = i2 >> 7, t = i2 & 127;
      cvt_tile(smem, p.in[39] + ((size_t)(layer * 32 + e) * 512) * 1024, 1024, wm + WMOE_DOWN + (size_t)e * 1024 * 512, 512, 1024, t);
    }
  }
}

constexpr int MOD_LDS = 17 * 1024 * 4 + 8 * 17 * 64 * 4;
DI void phase_mod(const Params& p, char* smem) {
  float* sc = (float*)smem;
  float* red = sc + 17 * 1024;
  const int tid = threadIdx.x;
  for (int i = tid; i < 17 * 1024; i += NTH) {
    const int bi = i >> 10, k = i & 1023;
    const float v = bi < 16 ? p.in[1][bi * 1024 + k] : p.in[3][k];
    sc[i] = v / (1.0f + __expf(-v));
  }
  __syncthreads();
  const int col = tid & 63, ks = tid >> 6;
  for (int it = blockIdx.x; it < 4 * 96; it += gridDim.x) {
    const int l = it / 96, j = (it % 96) * 64 + col;
    const float* w = p.in[4] + (size_t)l * 1024 * 6144 + j;
    float acc[17];
#pragma unroll
    for (int b = 0; b < 17; ++b) acc[b] = 0.f;
    for (int k = ks * 128; k < ks * 128 + 128; ++k) {
      const float wv = w[(size_t)k * 6144];
#pragma unroll
      for (int b = 0; b < 17; ++b) acc[b] += sc[b * 1024 + k] * wv;
    }
    __syncthreads();
#pragma unroll
    for (int b = 0; b < 17; ++b) red[(ks * 17 + b) * 64 + col] = acc[b];
    __syncthreads();
    for (int o = tid; o < 17 * 64; o += NTH) {
      const int b = o >> 6, c = o & 63;
      float s = 0.f;
#pragma unroll
      for (int q = 0; q < 8; ++q) s += red[(q * 17 + b) * 64 + c];
      const int jj = (it % 96) * 64 + c;
      ((float*)(p.ws + OFF_MOD))[(size_t)(l * 17 + b) * 6144 + jj] = s + p.in[5][l * 6144 + jj];
    }
  }
  if (blockIdx.x == 0) {
    float* rc = (float*)(p.ws + OFF_ROPE);
    for (int i = tid; i < 1024; i += NTH) {
      const int pos = i >> 4, f = i & 15;
      const float inv = powf(10000.0f, -(float)f / 16.0f);
      const float ang = (float)pos * inv;
      rc[i] = cosf(ang); rc[1024 + i] = sinf(ang);
    }
  }
}

DI void moe_blkstart(const Params& p, int layer, int* bs  ) {
  if (threadIdx.x == 0) {
    const int* cnt = (const int*)(p.ws + OFF_CNT) + layer * 32;
    int s = 0;
    for (int e = 0; e < 32; ++e) { bs[e] = s; s += (cnt[e] + MOE_PAD - 1) / MOE_PAD; }
    bs[32] = s;
  }
  __syncthreads();
}
template <int MODE>
DI void phase_norm1(const Params& p, int layer, char* smem) {
  int* bs = (int*)smem;
  if (MODE != 0) moe_blkstart(p, MODE == 3 ? 3 : layer - 1, bs);
  const int lane = threadIdx.x & 63, wid = threadIdx.x >> 6;
  const int nrows = MODE == 3 ? TL : TT;
  const bf16_t* yb = (const bf16_t*)(p.ws + OFF_U + UM_YB);
  const int* tok = (const int*)(p.ws + OFF_TOK);
  bf16_t* hb = (bf16_t*)(p.ws + OFF_H);
  for (int r = blockIdx.x * 8 + wid; r < nrows; r += gridDim.x * 8) {
    const int bi = row_bi(r);
    float* xr = xrow_ptr(p, r);
    const float* src = xr;
    if (MODE == 0) src = r < TL ? p.in[0] + (size_t)r * DM : p.in[2] + (size_t)(r - TL) * DM;
    f32x4 v[4];
#pragma unroll
    for (int i = 0; i < 4; ++i) v[i] = *(const f32x4*)(src + (i * 64 + lane) * 4);
    if (MODE == 1 || MODE == 3) {
      const int pl = MODE == 3 ? 3 : layer - 1;
      const int4 t0 = *(const int4*)(tok + (size_t)r * 8);
      const int4 t1 = *(const int4*)(tok + (size_t)r * 8 + 4);
      const size_t d0 = (size_t)(bs[t0.x] * MOE_PAD + t0.y), d1 = (size_t)(bs[t0.z] * MOE_PAD + t0.w);
      const float w0 = __int_as_float(t1.x), w1 = __int_as_float(t1.y);
      const float* g2 = modp(p, pl, bi, 5);
#pragma unroll
      for (int i = 0; i < 4; ++i) {
        const int ch = (i * 64 + lane) * 4;
        const u32x2 a = *(const u32x2*)(yb + d0 * DM + ch), b = *(const u32x2*)(yb + d1 * DM + ch);
        const f32x4 g = *(const f32x4*)(g2 + ch);
        v[i][0] += g[0] * (w0 * bflo(a.x) + w1 * bflo(b.x));
        v[i][1] += g[1] * (w0 * bfhi(a.x) + w1 * bfhi(b.x));
        v[i][2] += g[2] * (w0 * bflo(a.y) + w1 * bflo(b.y));
        v[i][3] += g[3] * (w0 * bfhi(a.y) + w1 * bfhi(b.y));
      }
    }
    if (MODE == 0 || MODE == 1) {
#pragma unroll
      for (int i = 0; i < 4; ++i) *(f32x4*)(xr + (i * 64 + lane) * 4) = v[i];
    }
    float ss = 0.f;
#pragma unroll
    for (int i = 0; i < 4; ++i) ss += v[i][0] * v[i][0] + v[i][1] * v[i][1] + v[i][2] * v[i][2] + v[i][3] * v[i][3];
    ss = wave_sum(ss);
    const float rs = rsqrtf(ss * (1.0f / 1024.0f) + 1e-6f);
    if (MODE == 3) {
#pragma unroll
      for (int i = 0; i < 4; ++i) {
        const int ch = (i * 64 + lane) * 4;
        const f32x4 g = *(const f32x4*)(p.in[7] + ch);
        f32x4 o; o[0] = v[i][0] * rs * g[0]; o[1] = v[i][1] * rs * g[1]; o[2] = v[i][2] * rs * g[2]; o[3] = v[i][3] * rs * g[3];
        *(f32x4*)(xr + ch) = o;
      }
    } else {
      const float* gn = p.in[6] + (size_t)(layer * 2 + 0) * DM;
      const float* sh = modp(p, layer, bi, 0);
      const float* sc = modp(p, layer, bi, 1);
#pragma unroll
      for (int i = 0; i < 4; ++i) {
        const int ch = (i * 64 + lane) * 4;
        const f32x4 g = *(const f32x4*)(gn + ch), s1 = *(const f32x4*)(sc + ch), s0 = *(const f32x4*)(sh + ch);
        float o[4];
#pragma unroll
        for (int j = 0; j < 4; ++j) o[j] = v[i][j] * rs * g[j] * (1.0f + s1[j]) + s0[j];
        u32x2 w; w.x = pk2(o[0], o[1]); w.y = pk2(o[2], o[3]);
        *(u32x2*)(hb + (size_t)r * DM + ch) = w;
      }
    }
  }
}

DI void phase_norm2_router(const Params& p, int layer, char* smem) {
  const int lane = threadIdx.x & 63, wid = threadIdx.x >> 6;
  const int nrows = layer == 3 ? TL : TT;
  bf16_t* hb = (bf16_t*)(p.ws + OFF_H);
  int* tok = (int*)(p.ws + OFF_TOK);
  int* rowl = (int*)(p.ws + OFF_ROWL);
  int* cnt = (int*)(p.ws + OFF_CNT) + layer * 32;
  const float* wg = p.in[34] + (size_t)layer * 1024 * 4;
  const float* bg = p.in[35] + layer * 4;
  const float* we = p.in[36] + (size_t)layer * 1024 * 32;
  const float* be = p.in[37] + layer * 32;
  const float* gn = p.in[6] + (size_t)(layer * 2 + 1) * DM;
  for (int r = blockIdx.x * 8 + wid; r < nrows; r += gridDim.x * 8) {
    const int bi = row_bi(r);
    const float* xr = xrow_ptr(p, r);
    const float* sh = modp(p, layer, bi, 3);
    const float* sc = modp(p, layer, bi, 4);
    f32x4 v[4];
    float ss = 0.f;
#pragma unroll
    for (int i = 0; i < 4; ++i) { v[i] = *(const f32x4*)(xr + (i * 64 + lane) * 4); ss += v[i][0] * v[i][0] + v[i][1] * v[i][1] + v[i][2] * v[i][2] + v[i][3] * v[i][3]; }
    ss = wave_sum(ss);
    const float rs = rsqrtf(ss * (1.0f / 1024.0f) + 1e-6f);
    float lg[4] = {0.f, 0.f, 0.f, 0.f};
#pragma unroll
    for (int i = 0; i < 4; ++i) {
      const int ch = (i * 64 + lane) * 4;
      const f32x4 g = *(const f32x4*)(gn + ch), s1 = *(const f32x4*)(sc + ch), s0 = *(const f32x4*)(sh + ch);
#pragma unroll
      for (int j = 0; j < 4; ++j) {
        v[i][j] = v[i][j] * rs * g[j] * (1.0f + s1[j]) + s0[j];
        const f32x4 w4 = *(const f32x4*)(wg + (size_t)(ch + j) * 4);
        lg[0] += v[i][j] * w4[0]; lg[1] += v[i][j] * w4[1]; lg[2] += v[i][j] * w4[2]; lg[3] += v[i][j] * w4[3];
      }
      u32x2 w; w.x = pk2(v[i][0], v[i][1]); w.y = pk2(v[i][2], v[i][3]);
      *(u32x2*)(hb + (size_t)r * DM + ch) = w;
    }
#pragma unroll
    for (int q = 0; q < 4; ++q) lg[q] = wave_sum(lg[q]) + bg[q];
    int gsel = 0; float gm = lg[0];
#pragma unroll
    for (int q = 1; q < 4; ++q) if (lg[q] > gm) { gm = lg[q]; gsel = q; }
    float gden = 0.f;
#pragma unroll
    for (int q = 0; q < 4; ++q) gden += __expf(lg[q] - gm);
    const float pgrp = 1.0f / gden;
    float le[8];
#pragma unroll
    for (int q = 0; q < 8; ++q) le[q] = 0.f;
#pragma unroll
    for (int i = 0; i < 4; ++i) {
      const int ch = (i * 64 + lane) * 4;
#pragma unroll
      for (int j = 0; j < 4; ++j) {
        const f32x4 wa = *(const f32x4*)(we + (size_t)(ch + j) * 32 + gsel * 8), wb = *(const f32x4*)(we + (size_t)(ch + j) * 32 + gsel * 8 + 4);
        le[0] += v[i][j] * wa[0]; le[1] += v[i][j] * wa[1]; le[2] += v[i][j] * wa[2]; le[3] += v[i][j] * wa[3];
        le[4] += v[i][j] * wb[0]; le[5] += v[i][j] * wb[1]; le[6] += v[i][j] * wb[2]; le[7] += v[i][j] * wb[3];
      }
    }
#pragma unroll
    for (int q = 0; q < 8; ++q) le[q] = wave_sum(le[q]) + be[gsel * 8 + q];
    int i0 = 0; float m0 = le[0];
#pragma unroll
    for (int q = 1; q < 8; ++q) if (le[q] > m0) { m0 = le[q]; i0 = q; }
    int i1 = -1; float m1 = -3.0e38f;
#pragma unroll
    for (int q = 0; q < 8; ++q) if (q != i0 && le[q] > m1) { m1 = le[q]; i1 = q; }
    const float e1 = __expf(m1 - m0);
    const float w0 = pgrp / (1.0f + e1), w1 = pgrp * e1 / (1.0f + e1);
    if (lane == 0) {
      const int ea = gsel * 8 + i0, eb = gsel * 8 + i1;
      const int pa = atomicAdd(&cnt[ea], 1), pb = atomicAdd(&cnt[eb], 1);
      rowl[(size_t)ea * CAP + pa] = r; rowl[(size_t)eb * CAP + pb] = r;
      int4 t0; t0.x = ea; t0.y = pa; t0.z = eb; t0.w = pb;
      int4 t1; t1.x = __float_as_int(w0); t1.y = __float_as_int(w1); t1.z = 0; t1.w = 0;
      *(int4*)(tok + (size_t)r * 8) = t0; *(int4*)(tok + (size_t)r * 8 + 4) = t1;
    }
  }
}

DI void phase_moe_up(const Params& p, int layer, char* smem) {
  int* bs = (int*)(smem + SG_LDS);
  moe_blkstart(p, layer, bs);
  const int* cnt = (const int*)(p.ws + OFF_CNT) + layer * 32;
  const int* rowl = (const int*)(p.ws + OFF_ROWL);
  const bf16_t* hb = (const bf16_t*)(p.ws + OFF_H);
  const bf16_t* wm = (const bf16_t*)(p.ws + OFF_WMOE);
  bf16_t* act = (bf16_t*)(p.ws + OFF_U + UM_ACT);
  const int ntiles = bs[32] * 8;
  for (int t = blockIdx.x; t < ntiles; t += gridDim.x) {
    const int rt = t >> 3, ct = t & 7;
    int e = 0;
    while (e < 31 && bs[e + 1] <= rt) ++e;
    const int lt = rt - bs[e], ce = cnt[e];
    const int ra = lt * 128 + (threadIdx.x >> 3), rb = ra + 64;
    const int ta = ra < ce ? rowl[(size_t)e * CAP + ra] : -1, tb = rb < ce ? rowl[(size_t)e * CAP + rb] : -1;
    const bf16_t* Bt = wm + (size_t)e * 1024 * 1024 + (size_t)ct * 128 * 1024;
    auto la = [&](int trow, int k) -> u32x4 {
      const int tk = trow < 64 ? ta : tb;
      if (tk < 0) return (u32x4){0u, 0u, 0u, 0u};
      return ld16(hb + (size_t)tk * DM + k);
    };
    auto lb = [&](int tn, int k) -> u32x4 { return ld16(Bt + (size_t)tn * 1024 + k); };
    auto ep = [&](const f32x4 (&acc)[4][2], int r0, int c0, int fr, int fq) {
      const int colo = ct * 64 + (c0 >> 1) + fr;
#pragma unroll
      for (int m = 0; m < 4; ++m)
#pragma unroll
        for (int j = 0; j < 4; ++j) {
          const int row = rt * 128 + r0 + m * 16 + fq * 4 + j;
          const float g = acc[m][0][j], u = acc[m][1][j];
          act[(size_t)row * 512 + colo] = f2bf(g / (1.0f + __expf(-g)) * u);
        }
    };
    sgemm_tile(smem, 1024, la, lb, ep);
  }
}
DI void phase_moe_down(const Params& p, int layer, char* smem) {
  int* bs = (int*)(smem + SG_LDS);
  moe_blkstart(p, layer, bs);
  const bf16_t* wm = (const bf16_t*)(p.ws + OFF_WMOE) + WMOE_DOWN;
  const bf16_t* act = (const bf16_t*)(p.ws + OFF_U + UM_ACT);
  bf16_t* yb = (bf16_t*)(p.ws + OFF_U + UM_YB);
  const int ntiles = bs[32] * 8;
  for (int t = blockIdx.x; t < ntiles; t += gridDim.x) {
    const int rt = t >> 3, ct = t & 7;
    int e = 0;
    while (e < 31 && bs[e + 1] <= rt) ++e;
    const bf16_t* A = act + (size_t)rt * 128 * 512;
    const bf16_t* Bt = wm + (size_t)e * 1024 * 512 + (size_t)ct * 128 * 512;
    auto la = [&](int trow, int k) -> u32x4 { return ld16(A + (size_t)trow * 512 + k); };
    auto lb = [&](int tn, int k) -> u32x4 { return ld16(Bt + (size_t)tn * 512 + k); };
    auto ep = [&](const f32x4 (&acc)[4][2], int r0, int c0, int fr, int fq) {
#pragma unroll
      for (int m = 0; m < 4; ++m)
#pragma unroll
        for (int n = 0; n < 2; ++n)
#pragma unroll
          for (int j = 0; j < 4; ++j) {
            const int row = rt * 128 + r0 + m * 16 + fq * 4 + j, col = ct * 128 + c0 + n * 16 + fr;
            yb[(size_t)row * DM + col] = f2bf(acc[m][n][j]);
          }
    };
    sgemm_tile(smem, 512, la, lb, ep);
  }
}

template <int NKC  >
DI void phase_qkv(const Params& p, const bf16_t* Wt, bf16_t* Q, bf16_t* Kb, bf16_t* VTL, bf16_t* VTC, char* smem) {
  constexpr int N = 1024 + 2 * NKC, NCT = N / 128;
  const bf16_t* hb = (const bf16_t*)(p.ws + OFF_H);
  const float* rc = (const float*)(p.ws + OFF_ROPE);
  for (int t = blockIdx.x; t < (TT / 128) * NCT; t += gridDim.x) {
    const int rt = t / NCT, ct = t % NCT, row0 = rt * 128, col0 = ct * 128;
    auto la = [&](int trow, int k) -> u32x4 { return ld16(hb + (size_t)(row0 + trow) * DM + k); };
    auto lb = [&](int tn, int k) -> u32x4 { return ld16(Wt + (size_t)(col0 + tn) * 1024 + k); };
    auto ep = [&](const f32x4 (&acc)[4][2], int r0, int c0, int fr, int fq) {
      const int colb = col0 + c0;
      if (colb < 1024 + NKC) {
        const bool isq = colb < 1024;
        bf16_t* dst = isq ? Q : Kb;
        const int ldd = isq ? 1024 : NKC, cc = isq ? colb : colb - 1024;
        const float qs = isq ? 0.125f : 1.0f;
#pragma unroll
        for (int m = 0; m < 4; ++m)
#pragma unroll
          for (int j = 0; j < 4; ++j) {
            const int row = row0 + r0 + m * 16 + fq * 4 + j;
            float x0 = acc[m][0][j], x1 = acc[m][1][j];
            if (row < TL) {
              const int s = row & 4095, idx = (colb & 32) ? (s & 63) : (s >> 6);
              const float c = rc[idx * 16 + fr], sn = rc[1024 + idx * 16 + fr];
              const float o0 = x0 * c - x1 * sn, o1 = x1 * c + x0 * sn;
              x0 = o0; x1 = o1;
            }
            dst[(size_t)row * ldd + cc + fr] = f2bf(x0 * qs);
            dst[(size_t)row * ldd + cc + 16 + fr] = f2bf(x1 * qs);
          }
      } else {
#pragma unroll
        for (int m = 0; m < 4; ++m)
#pragma unroll
          for (int n = 0; n < 2; ++n) {
            const int row = row0 + r0 + m * 16 + fq * 4, cv = colb - (1024 + NKC) + n * 16 + fr;
            u32x2 w; w.x = pk2(acc[m][n][0], acc[m][n][1]); w.y = pk2(acc[m][n][2], acc[m][n][3]);
            if (row < TL) { const int b = row >> 12, s = row & 4095; *(u32x2*)(VTL + ((size_t)(b * NKC + cv) * 4096 + s)) = w; }
            else { const int rc2 = row - TL, b = rc2 >> 8, c = rc2 & 255; *(u32x2*)(VTC + ((size_t)(b * NKC + cv) * 256 + c)) = w; }
          }
      }
    };
    sgemm_tile(smem, 1024, la, lb, ep);
  }
}

DI void phase_oproj(const Params& p, int layer, const bf16_t* A, const bf16_t* Wt, int nrows, char* smem) {
  for (int t = blockIdx.x; t < (nrows / 128) * 8; t += gridDim.x) {
    const int rt = t >> 3, ct = t & 7, row0 = rt * 128, col0 = ct * 128;
    auto la = [&](int trow, int k) -> u32x4 { return ld16(A + (size_t)(row0 + trow) * DM + k); };
    auto lb = [&](int tn, int k) -> u32x4 { return ld16(Wt + (size_t)(col0 + tn) * 1024 + k); };
    auto ep = [&](const f32x4 (&acc)[4][2], int r0, int c0, int fr, int fq) {
#pragma unroll
      for (int m = 0; m < 4; ++m)
#pragma unroll
        for (int j = 0; j < 4; ++j) {
          const int row = row0 + r0 + m * 16 + fq * 4 + j;
          float* xr = xrow_ptr(p, row);
          const float* g1 = modp(p, layer, row_bi(row), 2);
#pragma unroll
          for (int n = 0; n < 2; ++n) { const int col = col0 + c0 + n * 16 + fr; xr[col] += g1[col] * acc[m][n][j]; }
        }
    };
    sgemm_tile(smem, 1024, la, lb, ep);
  }
}

constexpr int VLD = 72;
DI bf16x8 pack8(const f32x16& x, int s) {
  u32x4 q;
  q.x = pk2(x[8 * s + 0], x[8 * s + 1]); q.y = pk2(x[8 * s + 2], x[8 * s + 3]);
  q.z = pk2(x[8 * s + 4], x[8 * s + 5]); q.w = pk2(x[8 * s + 6], x[8 * s + 7]);
  return __builtin_bit_cast(bf16x8, q);
}
template <int DT, bool MASK>
DI void attn_tile(const bf16_t* sK, int kld, const bf16_t* sVt, const bf16x8 (&qf)[4], f32x16 (&Y)[DT], float& m, float& l, int r, int h, int qpos,
                  int kpos0) {
  f32x16 X[2];
#pragma unroll
  for (int sub = 0; sub < 2; ++sub) {
#pragma unroll
    for (int i = 0; i < 16; ++i) X[sub][i] = 0.f;
#pragma unroll
    for (int s = 0; s < 4; ++s) {
      const bf16x8 a = *(const bf16x8*)(sK + (sub * 32 + r) * kld + 16 * s + 8 * h);
      X[sub] = MFMA32(a, qf[s], X[sub]);
    }
  }
  if (MASK) {
#pragma unroll
    for (int sub = 0; sub < 2; ++sub)
#pragma unroll
      for (int i = 0; i < 16; ++i) {
        const int kp = kpos0 + sub * 32 + (i & 3) + 8 * (i >> 2) + 4 * h;
        const int d = qpos - kp;
        if (d > 128 || d < -128) X[sub][i] = -1e30f;
      }
  }
  float mx = m;
#pragma unroll
  for (int sub = 0; sub < 2; ++sub)
#pragma unroll
    for (int i = 0; i < 16; ++i) mx = fmaxf(mx, X[sub][i]);
  mx = fmaxf(mx, __shfl_xor(mx, 32));
  const float alpha = __expf(m - mx);
  m = mx;
  float ps = 0.f;
#pragma unroll
  for (int sub = 0; sub < 2; ++sub)
#pragma unroll
    for (int i = 0; i < 16; ++i) { const float pv = __expf(X[sub][i] - mx); X[sub][i] = pv; ps += pv; }
  l = l * alpha + ps;
#pragma unroll
  for (int dt = 0; dt < DT; ++dt)
#pragma unroll
    for (int i = 0; i < 16; ++i) Y[dt][i] *= alpha;
#pragma unroll
  for (int sub = 0; sub < 2; ++sub)
#pragma unroll
    for (int s = 0; s < 2; ++s) {
      const bf16x8 pf = pack8(X[sub], s);
#pragma unroll
      for (int dt = 0; dt < DT; ++dt) {
        const bf16_t* vp = sVt + (dt * 32 + r) * VLD + sub * 32 + 16 * s + 4 * h;
        const s16x4 lo = *(const s16x4*)vp, hi = *(const s16x4*)(vp + 8);
        const bf16x8 vf = __builtin_shufflevector(lo, hi, 0, 1, 2, 3, 4, 5, 6, 7);
        Y[dt] = MFMA32(vf, pf, Y[dt]);
      }
    }
}

constexpr int A0_KLD = 72;
constexpr int A0_LDS = 64 * A0_KLD * 2 + 64 * VLD * 2;
DI void phase_attn_win(const Params& p, char* smem) {
  bf16_t* sK = (bf16_t*)smem;
  bf16_t* sV = sK + 64 * A0_KLD;
  const bf16_t* Q = (const bf16_t*)(p.ws + OFF_U + U0_Q);
  const bf16_t* Kb = (const bf16_t*)(p.ws + OFF_U + U0_K);
  const bf16_t* VTL = (const bf16_t*)(p.ws + OFF_U + U0_VTL);
  const bf16_t* VTC = (const bf16_t*)(p.ws + OFF_U + U0_VTC);
  bf16_t* O = (bf16_t*)(p.ws + OFF_U + U0_O);
  const float* sink = p.in[9];
  const int tid = threadIdx.x, lane = tid & 63, wid = tid >> 6, r = lane & 31, h = lane >> 5;
  const int NLAT = 16 * 4 * 32 * 2, NCTX = 16 * 16;
  for (int it = blockIdx.x; it < NLAT + NCTX; it += gridDim.x) {
    const bool lat = it < NLAT;
    int b, kvh, qb = 0, head, qrow, qpos;
    if (lat) {
      b = it >> 8; kvh = (it >> 6) & 3; qb = (it >> 1) & 31; const int hp = it & 1;
      head = kvh * 4 + hp * 2 + (wid >> 2);
      qpos = qb * 128 + (wid & 3) * 32 + r; qrow = b * 4096 + qpos;
    } else {
      const int i2 = it - NLAT; b = i2 >> 4; head = i2 & 15; kvh = head >> 2;
      qpos = wid * 32 + r; qrow = TL + b * 256 + qpos;
    }
    bf16x8 qf[4];
#pragma unroll
    for (int s = 0; s < 4; ++s) qf[s] = *(const bf16x8*)(Q + (size_t)qrow * DM + head * 64 + 16 * s + 8 * h);
    f32x16 Y[2];
#pragma unroll
    for (int dt = 0; dt < 2; ++dt)
#pragma unroll
      for (int i = 0; i < 16; ++i) Y[dt][i] = 0.f;
    float m = sink[head], l = h == 0 ? 1.0f : 0.0f;
    const int kr = tid >> 3, k8 = (tid & 7) * 8;
    auto tile_ok = [&](int t) -> bool { if (t >= 6) return true; if (!lat) return false; const int kt = 2 * qb - 2 + t; return kt >= 0 && kt < 64; };
    auto ldk = [&](int t) -> u32x4 {
      const size_t row = t < 6 ? (size_t)b * 4096 + (2 * qb - 2 + t) * 64 + kr : (size_t)TL + b * 256 + (t - 6) * 64 + kr;
      return ld16(Kb + row * 256 + kvh * 64 + k8);
    };
    auto ldv = [&](int t) -> u32x4 {
      return t < 6 ? ld16(VTL + ((size_t)(b * 256 + kvh * 64 + kr) * 4096 + (2 * qb - 2 + t) * 64 + k8))
                   : ld16(VTC + ((size_t)(b * 256 + kvh * 64 + kr) * 256 + (t - 6) * 64 + k8));
    };
    int t = 0;
    while (t < 10 && !tile_ok(t)) ++t;
    u32x4 rk = ldk(t), rv = ldv(t);
    while (t < 10) {
      __syncthreads();
      *(u32x4*)(sK + kr * A0_KLD + k8) = rk;
      *(u32x4*)(sV + kr * VLD + k8) = rv;
      __syncthreads();
      int tn = t + 1;
      while (tn < 10 && !tile_ok(tn)) ++tn;
      if (tn < 10) { rk = ldk(tn); rv = ldv(tn); }
      if (t < 6) attn_tile<2, true>(sK, A0_KLD, sV, qf, Y, m, l, r, h, qpos, (2 * qb - 2 + t) * 64);
      else attn_tile<2, false>(sK, A0_KLD, sV, qf, Y, m, l, r, h, 0, 0);
      t = tn;
    }
    const float lt = l + __shfl_xor(l, 32);
    const float inv = 1.0f / lt;
#pragma unroll
    for (int dt = 0; dt < 2; ++dt)
#pragma unroll
      for (int g = 0; g < 4; ++g) {
        u32x2 w; w.x = pk2(Y[dt][4 * g] * inv, Y[dt][4 * g + 1] * inv); w.y = pk2(Y[dt][4 * g + 2] * inv, Y[dt][4 * g + 3] * inv);
        *(u32x2*)(O + (size_t)qrow * DM + head * 64 + dt * 32 + 8 * g + 4 * h) = w;
      }
  }
}

constexpr int A1_KLD = 136;
constexpr int A1_LDS = 64 * A1_KLD * 2 + 128 * VLD * 2 + 4 * 128 * 32 * 4;
DI void phase_attn_diff(const Params& p, char* smem) {
  bf16_t* sK = (bf16_t*)smem;
  bf16_t* sV = sK + 64 * A1_KLD;
  float* comb = (float*)(smem + 64 * A1_KLD * 2 + 128 * VLD * 2);
  const bf16_t* Q = (const bf16_t*)(p.ws + OFF_U + U1_Q);
  const bf16_t* Kb = (const bf16_t*)(p.ws + OFF_U + U1_K);
  const bf16_t* VTL = (const bf16_t*)(p.ws + OFF_U + U1_VTL);
  const bf16_t* VTC = (const bf16_t*)(p.ws + OFF_U + U1_VTC);
  bf16_t* O = (bf16_t*)(p.ws + OFF_U + U1_O);
  const int tid = threadIdx.x, lane = tid & 63, wid = tid >> 6, r = lane & 31, h = lane >> 5, grp = wid >> 2;
  const float lambda_init = 0.8f - 0.6f * 0.74081822068f;
  float lam_full;
  {
    const float* lf = p.in[12];
    float s1 = 0.f, s2 = 0.f;
    for (int i = 0; i < 64; ++i) { s1 += lf[i] * lf[64 + i]; s2 += lf[128 + i] * lf[192 + i]; }
    lam_full = expf(s1) - expf(s2) + lambda_init;
  }
  const float* subg = p.in[13];
  const int NLAT = 16 * 8 * 32, NCTX = 16 * 8 * 2;
  for (int it = blockIdx.x; it < NLAT + NCTX; it += gridDim.x) {
    const bool lat = it < NLAT;
    int b, head, qrow, nt, t0;
    if (lat) { b = it >> 8; head = (it >> 5) & 7; const int qb = it & 31; qrow = b * 4096 + qb * 128 + (wid & 3) * 32 + r; t0 = 0; nt = 68; }
    else { const int i2 = it - NLAT; b = i2 >> 4; head = (i2 >> 1) & 7; const int hf = i2 & 1; qrow = TL + b * 256 + hf * 128 + (wid & 3) * 32 + r; t0 = 64; nt = 68; }
    bf16x8 qf[4];
#pragma unroll
    for (int s = 0; s < 4; ++s) qf[s] = *(const bf16x8*)(Q + (size_t)qrow * DM + head * 128 + grp * 64 + 16 * s + 8 * h);
    f32x16 Y[4];
#pragma unroll
    for (int dt = 0; dt < 4; ++dt)
#pragma unroll
      for (int i = 0; i < 16; ++i) Y[dt][i] = 0.f;
    float m = -1e30f, l = 0.f;
    const int kr = tid >> 4, kc = (tid & 15) * 8;
    const int vr = tid >> 3, vc = (tid & 7) * 8;
    auto krow = [&](int t, int key) -> size_t { return t < 64 ? (size_t)b * 4096 + t * 64 + key : (size_t)TL + b * 256 + (t - 64) * 64 + key; };
    auto ldk = [&](int t, int i) -> u32x4 { return ld16(Kb + krow(t, kr + 32 * i) * DM + head * 128 + kc); };
    auto ldv = [&](int t, int i) -> u32x4 {
      const int dim = vr + 64 * i;
      return t < 64 ? ld16(VTL + ((size_t)(b * 1024 + head * 128 + dim) * 4096 + t * 64 + vc)) : ld16(VTC + ((size_t)(b * 1024 + head * 128 + dim) * 256 + (t - 64) * 64 + vc));
    };
    u32x4 rk0 = ldk(t0, 0), rk1 = ldk(t0, 1), rv0 = ldv(t0, 0), rv1 = ldv(t0, 1);
    for (int t = t0; t < nt; ++t) {
      __syncthreads();
      *(u32x4*)(sK + kr * A1_KLD + kc) = rk0; *(u32x4*)(sK + (kr + 32) * A1_KLD + kc) = rk1;
      *(u32x4*)(sV + vr * VLD + vc) = rv0; *(u32x4*)(sV + (vr + 64) * VLD + vc) = rv1;
      __syncthreads();
      if (t + 1 < nt) { rk0 = ldk(t + 1, 0); rk1 = ldk(t + 1, 1); rv0 = ldv(t + 1, 0); rv1 = ldv(t + 1, 1); }
      attn_tile<4, false>(sK + grp * 64, A1_KLD, sV, qf, Y, m, l, r, h, 0, 0);
    }
    const float lt = l + __shfl_xor(l, 32);
    const float inv = 1.0f / lt;
    if (grp == 1) {
#pragma unroll
      for (int dt = 0; dt < 4; ++dt)
#pragma unroll
        for (int i = 0; i < 16; ++i) comb[(((wid & 3) * 128) + dt * 32 + (i & 3) + 8 * (i >> 2) + 4 * h) * 32 + r] = Y[dt][i] * inv;
    }
    __syncthreads();
    if (grp == 0) {
      float ss = 0.f;
#pragma unroll
      for (int dt = 0; dt < 4; ++dt)
#pragma unroll
        for (int i = 0; i < 16; ++i) {
          const float o2 = comb[(((wid & 3) * 128) + dt * 32 + (i & 3) + 8 * (i >> 2) + 4 * h) * 32 + r];
          const float vv = Y[dt][i] * inv - lam_full * o2;
          Y[dt][i] = vv; ss += vv * vv;
        }
      ss += __shfl_xor(ss, 32);
      const float rs = rsqrtf(ss * (1.0f / 128.0f) + 1e-6f) * (1.0f - lambda_init);
#pragma unroll
      for (int dt = 0; dt < 4; ++dt)
#pragma unroll
        for (int g = 0; g < 4; ++g) {
          const int d0 = dt * 32 + 8 * g + 4 * h;
          const f32x4 sg = *(const f32x4*)(subg + d0);
          u32x2 w; w.x = pk2(Y[dt][4 * g] * rs * sg[0], Y[dt][4 * g + 1] * rs * sg[1]); w.y = pk2(Y[dt][4 * g + 2] * rs * sg[2], Y[dt][4 * g + 3] * rs * sg[3]);
          *(u32x2*)(O + (size_t)qrow * DM + head * 128 + d0) = w;
        }
    }
  }
}

DI void phase_pool(const Params& p, char* smem) {
  const bf16_t* hb = (const bf16_t*)(p.ws + OFF_H);
  const bf16_t* wp = (const bf16_t*)(p.ws + OFF_WMIX) + W_POOL;
  const float* pb = p.in[16];
  const float* psc = p.in[17];
  for (int t = blockIdx.x; t < (TT / 128) * 8; t += gridDim.x) {
    const int rt = t >> 3, g = (t >> 1) & 3, ct = t & 1, row0 = rt * 128, half = 1 << g;
    const bf16_t* Bt = wp + (size_t)g * 65536 + (size_t)ct * 128 * 256;
    auto la = [&](int trow, int k) -> u32x4 {
      const int row = row0 + trow;
      int s, L;
      if (row < TL) { s = row & 4095; L = 4096; } else { s = (row - TL) & 255; L = 256; }
      const int lo = s - half < 0 ? 0 : s - half, hi = s + half > L ? L : s + half;
      const bf16_t* base = hb + (size_t)(row - s) * DM + g * 256 + k;
      float a[8];
#pragma unroll
      for (int j = 0; j < 8; ++j) a[j] = 0.f;
      for (int q = lo; q < hi; ++q) {
        const u32x4 v = ld16(base + (size_t)q * DM);
        a[0] += bflo(v.x); a[1] += bfhi(v.x); a[2] += bflo(v.y); a[3] += bfhi(v.y); a[4] += bflo(v.z); a[5] += bfhi(v.z); a[6] += bflo(v.w); a[7] += bfhi(v.w);
      }
      const float inv = 1.0f / (float)(hi - lo);
      const u32x4 c = ld16(base + (size_t)s * DM);
      u32x4 o;
      o.x = pk2(a[0] * inv - bflo(c.x), a[1] * inv - bfhi(c.x)); o.y = pk2(a[2] * inv - bflo(c.y), a[3] * inv - bfhi(c.y));
      o.z = pk2(a[4] * inv - bflo(c.z), a[5] * inv - bfhi(c.z)); o.w = pk2(a[6] * inv - bflo(c.w), a[7] * inv - bfhi(c.w));
      return o;
    };
    auto lb = [&](int tn, int k) -> u32x4 { return ld16(Bt + (size_t)tn * 256 + k); };
    auto ep = [&](const f32x4 (&acc)[4][2], int r0, int c0, int fr, int fq) {
#pragma unroll
      for (int m = 0; m < 4; ++m)
#pragma unroll
        for (int j = 0; j < 4; ++j) {
          const int row = row0 + r0 + m * 16 + fq * 4 + j;
          float* xr = xrow_ptr(p, row);
          const float* g1 = modp(p, 2, row_bi(row), 2);
#pragma unroll
          for (int n = 0; n < 2; ++n) {
            const int col = g * 256 + ct * 128 + c0 + n * 16 + fr;
            xr[col] += g1[col] * ((acc[m][n][j] + pb[col]) * psc[col]);
          }
        }
    };
    sgemm_tile(smem, 256, la, lb, ep);
  }
}

DI u32x4 rwkv_mix_load(const bf16_t* hb, const float* mu, int mixi, int row, int k) {
  int s, L;
  if (row < TL) { s = row & 4095; L = 4096; } else { s = (row - TL) & 255; L = 256; }
  const bf16_t* hp = hb + (size_t)row * DM + k;
  const u32x4 c = ld16(hp);
  u32x4 pv = (u32x4){0u, 0u, 0u, 0u}, nx = (u32x4){0u, 0u, 0u, 0u};
  if (s > 0) pv = ld16(hp - DM);
  if (s < L - 1) nx = ld16(hp + DM);
  const float* m0 = mu + (size_t)(0 * 6 + mixi) * DM + k;
  const float* m1 = mu + (size_t)(1 * 6 + mixi) * DM + k;
  const f32x4 a0 = *(const f32x4*)m0, a1 = *(const f32x4*)(m0 + 4), b0 = *(const f32x4*)m1, b1 = *(const f32x4*)(m1 + 4);
  float cv[8] = {bflo(c.x), bfhi(c.x), bflo(c.y), bfhi(c.y), bflo(c.z), bfhi(c.z), bflo(c.w), bfhi(c.w)};
  float pvv[8] = {bflo(pv.x), bfhi(pv.x), bflo(pv.y), bfhi(pv.y), bflo(pv.z), bfhi(pv.z), bflo(pv.w), bfhi(pv.w)};
  float nv[8] = {bflo(nx.x), bfhi(nx.x), bflo(nx.y), bfhi(nx.y), bflo(nx.z), bfhi(nx.z), bflo(nx.w), bfhi(nx.w)};
  float mu0[8] = {a0[0], a0[1], a0[2], a0[3], a1[0], a1[1], a1[2], a1[3]};
  float mu1[8] = {b0[0], b0[1], b0[2], b0[3], b1[0], b1[1], b1[2], b1[3]};
  float o[8];
#pragma unroll
  for (int j = 0; j < 8; ++j) o[j] = cv[j] + (pvv[j] - cv[j]) * mu0[j] + (nv[j] - cv[j]) * mu1[j];
  u32x4 w; w.x = pk2(o[0], o[1]); w.y = pk2(o[2], o[3]); w.z = pk2(o[4], o[5]); w.w = pk2(o[6], o[7]);
  return w;
}
template <int ACT  , class AL>
DI void rwkv_gemm_tile(char* smem, AL la, const bf16_t* Bt, int K, int ldb, bf16_t* dst, int ldd, int row0, int col0, int ncols_valid) {
  auto lb = [&](int tn, int k) -> u32x4 { return (col0 + tn) < ncols_valid ? ld16(Bt + (size_t)(col0 + tn) * ldb + k) : (u32x4){0u, 0u, 0u, 0u}; };
  auto ep = [&](const f32x4 (&acc)[4][2], int r0, int c0, int fr, int fq) {
#pragma unroll
    for (int m = 0; m < 4; ++m)
#pragma unroll
      for (int n = 0; n < 2; ++n)
#pragma unroll
        for (int j = 0; j < 4; ++j) {
          const int row = row0 + r0 + m * 16 + fq * 4 + j, col = col0 + c0 + n * 16 + fr;
          float v = acc[m][n][j];
          if (ACT == 1) v = tanhf(v);
          if (ACT == 2) v = sigmoidf_(v);
          if (col < ncols_valid) dst[(size_t)row * ldd + col] = f2bf(v);
        }
  };
  sgemm_tile(smem, K, la, lb, ep);
}
DI void phase_rwkv_feat1(const Params& p, char* smem) {
  const bf16_t* hb = (const bf16_t*)(p.ws + OFF_H);
  const bf16_t* wm = (const bf16_t*)(p.ws + OFF_WMIX);
  const float* mu = p.in[18];
  char* U = p.ws + OFF_U;
  const int n0 = 512 * 8, n1 = n0 + 544 * 8, n2 = n1 + 544 * 8, n3 = n2 + 544, n4 = n3 + 544, n5 = n4 + 512;
  for (int t = blockIdx.x; t < n5; t += gridDim.x) {
    if (t < n0) {
      const int rt = t >> 3, ct = t & 7, row0 = rt * 128;
      auto la = [&](int trow, int k) -> u32x4 { return rwkv_mix_load(hb, mu, 0, row0 + trow, k); };
      rwkv_gemm_tile<0>(smem, la, wm + W_R, 1024, 1024, (bf16_t*)(U + U3_R), 1024, row0, ct * 128, 1024);
    } else if (t < n1) {
      const int u = t - n0, rt = u >> 3, ct = u & 7, row0 = rt * 128;
      auto la = [&](int trow, int k) -> u32x4 { return rwkv_mix_load(hb, mu, 2, row0 + trow, k); };
      rwkv_gemm_tile<0>(smem, la, wm + W_K, 1024, 1024, (bf16_t*)(U + U3_K), 1024, row0, ct * 128, 1024);
    } else if (t < n2) {
      const int u = t - n1, rt = u >> 3, ct = u & 7, row0 = rt * 128;
      auto la = [&](int trow, int k) -> u32x4 { return rwkv_mix_load(hb, mu, 3, row0 + trow, k); };
      rwkv_gemm_tile<0>(smem, la, wm + W_V, 1024, 1024, (bf16_t*)(U + U3_V), 1024, row0, ct * 128, 1024);
    } else if (t < n3) {
      const int row0 = (t - n2) * 128;
      auto la = [&](int trow, int k) -> u32x4 { return rwkv_mix_load(hb, mu, 1, row0 + trow, k); };
      rwkv_gemm_tile<1>(smem, la, wm + W_WA1, 1024, 1024, (bf16_t*)(U + U3_LW), 128, row0, 0, 128);
    } else if (t < n4) {
      const int row0 = (t - n3) * 128;
      auto la = [&](int trow, int k) -> u32x4 { return rwkv_mix_load(hb, mu, 4, row0 + trow, k); };
      rwkv_gemm_tile<0>(smem, la, wm + W_AA1, 1024, 1024, (bf16_t*)(U + U3_LA), 128, row0, 0, 128);
    } else {
      const int row0 = (t - n4) * 128;
      auto la = [&](int trow, int k) -> u32x4 { return rwkv_mix_load(hb, mu, 5, row0 + trow, k); };
      rwkv_gemm_tile<2>(smem, la, wm + W_G1, 1024, 1024, (bf16_t*)(U + U3_LG), 128, row0, 0, 128);
    }
  }
}
DI void phase_rwkv_feat2(const Params& p, char* smem) {
  const bf16_t* wm = (const bf16_t*)(p.ws + OFF_WMIX);
  char* U = p.ws + OFF_U;
  const int per = 544 * 8, n4 = 4 * per, n5 = n4 + 512 * 8;
  for (int t = blockIdx.x; t < n5; t += gridDim.x) {
    if (t < n4) {
      const int job = t / per, u = t % per, rt = u >> 3, ct = u & 7, row0 = rt * 128, col0 = ct * 128, d = job & 1;
      const bool isw = job < 2;
      const bf16_t* A = (const bf16_t*)(U + (isw ? U3_LW : U3_LA)) + d * 64;
      const bf16_t* Bt = wm + (isw ? W_WA2 : W_AA2) + (size_t)d * 1024 * 64;
      const float* bias = (isw ? p.in[20] : p.in[23]) + d * 1024;
      bf16_t* dst = (bf16_t*)(U + (isw ? (d ? U3_LD1 : U3_LD0) : (d ? U3_A1 : U3_A0)));
      auto la = [&](int trow, int k) -> u32x4 { return ld16(A + (size_t)(row0 + trow) * 128 + k); };
      auto lb = [&](int tn, int k) -> u32x4 { return ld16(Bt + (size_t)(col0 + tn) * 64 + k); };
      auto ep = [&](const f32x4 (&acc)[4][2], int r0, int c0, int fr, int fq) {
#pragma unroll
        for (int m = 0; m < 4; ++m)
#pragma unroll
          for (int n = 0; n < 2; ++n)
#pragma unroll
            for (int j = 0; j < 4; ++j) {
              const int row = row0 + r0 + m * 16 + fq * 4 + j, col = col0 + c0 + n * 16 + fr;
              const float sg = sigmoidf_(acc[m][n][j] + bias[col]);
              dst[(size_t)row * DM + col] = f2bf(isw ? -0.60653065971f * sg : sg);
            }
      };
      sgemm_tile(smem, 64, la, lb, ep);
    } else {
      const int u = t - n4, rt = u >> 3, ct = u & 7, row0 = rt * 128;
      const bf16_t* A = (const bf16_t*)(U + U3_LG);
      auto la = [&](int trow, int k) -> u32x4 { return ld16(A + (size_t)(row0 + trow) * 128 + k); };
      rwkv_gemm_tile<0>(smem, la, wm + W_G2, 128, 128, (bf16_t*)(U + U3_G), 1024, row0, ct * 128, 1024);
    }
  }
}

constexpr int SC_CH = 8;
constexpr int SC_LDS_W = 6 * SC_CH * 64 * 4;
DI void phase_rwkv_scan(const Params& p, char* smem) {
  const int lane = threadIdx.x & 63, wid = threadIdx.x >> 6;
  float* sw = (float*)(smem + (size_t)wid * SC_LDS_W);
  float* skk = sw + SC_CH * 64; float* skka = skk + SC_CH * 64; float* skd = skka + SC_CH * 64; float* sr = skd + SC_CH * 64; float* sv = sr + SC_CH * 64;
  char* U = p.ws + OFF_U;
  const bf16_t* Kx = (const bf16_t*)(U + U3_K);
  const bf16_t* Vx = (const bf16_t*)(U + U3_V);
  const bf16_t* Rx = (const bf16_t*)(U + U3_R);
  for (int item = wid * gridDim.x + blockIdx.x; item < 512; item += 8 * gridDim.x) {
    const int dir = item & 1, head = (item >> 1) & 15, b = item >> 5;
    const bf16_t* Ax = (const bf16_t*)(U + (dir ? U3_A1 : U3_A0));
    const bf16_t* Lx = (const bf16_t*)(U + (dir ? U3_LD1 : U3_LD0));
    bf16_t* Ox = (bf16_t*)(U + (dir ? U3_O1 : U3_O0));
    const int ch = head * 64 + lane;
    const float kkw = p.in[28][ch], kaw = p.in[29][ch];
    float S[64];
#pragma unroll
    for (int k = 0; k < 64; ++k) S[k] = 0.f;
    auto rowof = [&](int n) -> int {
      if (n < 256) { const int c = dir ? 255 - n : n; return TL + b * 256 + c; }
      const int s = dir ? 4095 - (n - 256) : n - 256; return b * 4096 + s;
    };
    for (int n0 = 0; n0 < 4352; n0 += SC_CH) {
      const bool emit = n0 >= 256;
#pragma unroll
      for (int q = 0; q < SC_CH; ++q) {
        const int row = rowof(n0 + q);
        const float kv = bf2f(Kx[(size_t)row * DM + ch]), av = bf2f(Ax[(size_t)row * DM + ch]), lv = bf2f(Lx[(size_t)row * DM + ch]);
        sv[q * 64 + lane] = bf2f(Vx[(size_t)row * DM + ch]);
        const float kkr = kv * kkw;
        const float nrm = sqrtf(wave_sum(kkr * kkr));
        const float kk = kkr / fmaxf(nrm, 1e-12f);
        sw[q * 64 + lane] = __expf(lv);
        skk[q * 64 + lane] = kk;
        skka[q * 64 + lane] = kk * av;
        skd[q * 64 + lane] = kv * (1.0f + (av - 1.0f) * kaw);
        sr[q * 64 + lane] = emit ? bf2f(Rx[(size_t)row * DM + ch]) : 0.f;
      }
      __builtin_amdgcn_s_waitcnt(0xc07f);
#pragma unroll 1
      for (int q = 0; q < SC_CH; ++q) {
        float sa = 0.f;
#pragma unroll
        for (int k4 = 0; k4 < 16; ++k4) {
          const f32x4 kk4 = *(const f32x4*)(skk + q * 64 + k4 * 4);
          sa += S[k4 * 4] * kk4[0] + S[k4 * 4 + 1] * kk4[1] + S[k4 * 4 + 2] * kk4[2] + S[k4 * 4 + 3] * kk4[3];
        }
        const float vv = sv[q * 64 + lane];
        float o = 0.f;
#pragma unroll
        for (int k4 = 0; k4 < 16; ++k4) {
          const f32x4 w4 = *(const f32x4*)(sw + q * 64 + k4 * 4), a4 = *(const f32x4*)(skka + q * 64 + k4 * 4), d4 = *(const f32x4*)(skd + q * 64 + k4 * 4),
                      r4 = *(const f32x4*)(sr + q * 64 + k4 * 4);
#pragma unroll
          for (int j = 0; j < 4; ++j) {
            const float ns = S[k4 * 4 + j] * w4[j] - sa * a4[j] + vv * d4[j];
            S[k4 * 4 + j] = ns;
            o += ns * r4[j];
          }
        }
        if (emit) Ox[(size_t)rowof(n0 + q) * DM + ch] = f2bf(o);
      }
    }
  }
}

DI void phase_rwkv_out(const Params& p, char* smem) {
  const int lane = threadIdx.x & 63, wid = threadIdx.x >> 6;
  char* U = p.ws + OFF_U;
  const bf16_t *Rx = (const bf16_t*)(U + U3_R), *Kx = (const bf16_t*)(U + U3_K), *Vx = (const bf16_t*)(U + U3_V), *A0 = (const bf16_t*)(U + U3_A0),
               *A1 = (const bf16_t*)(U + U3_A1), *Gx = (const bf16_t*)(U + U3_G), *O0 = (const bf16_t*)(U + U3_O0), *O1 = (const bf16_t*)(U + U3_O1);
  bf16_t* Z = (bf16_t*)(p.ws + OFF_H);
  const int ch0 = lane * 16;
  float ka[16], rk[16], lw[16], lb[16];
#pragma unroll
  for (int j = 0; j < 16; ++j) { ka[j] = p.in[29][ch0 + j]; rk[j] = p.in[30][ch0 + j]; lw[j] = p.in[31][ch0 + j]; lb[j] = p.in[32][ch0 + j]; }
  auto ld16f = [&](const bf16_t* base, size_t off, float (&o)[16]) {
    const u32x4 a = ld16(base + off), b = ld16(base + off + 8);
    o[0] = bflo(a.x); o[1] = bfhi(a.x); o[2] = bflo(a.y); o[3] = bfhi(a.y); o[4] = bflo(a.z); o[5] = bfhi(a.z); o[6] = bflo(a.w); o[7] = bfhi(a.w);
    o[8] = bflo(b.x); o[9] = bfhi(b.x); o[10] = bflo(b.y); o[11] = bfhi(b.y); o[12] = bflo(b.z); o[13] = bfhi(b.z); o[14] = bflo(b.w); o[15] = bfhi(b.w);
  };
  for (int r = blockIdx.x * 8 + wid; r < TL; r += gridDim.x * 8) {
    const size_t off = (size_t)r * DM + ch0;
    float o0[16], o1[16], rr[16], kk[16], vv[16], a0[16], a1[16], gg[16];
    ld16f(O0, off, o0); ld16f(O1, off, o1); ld16f(Rx, off, rr); ld16f(Kx, off, kk); ld16f(Vx, off, vv); ld16f(A0, off, a0); ld16f(A1, off, a1); ld16f(Gx, off, gg);
    float s = 0.f, bs = 0.f;
#pragma unroll
    for (int j = 0; j < 16; ++j) {
      o0[j] += o1[j]; s += o0[j];
      const float kd0 = kk[j] * (1.0f + (a0[j] - 1.0f) * ka[j]), kd1 = kk[j] * (1.0f + (a1[j] - 1.0f) * ka[j]);
      bs += rr[j] * (kd0 + kd1) * rk[j];
    }
    s += __shfl_xor(s, 1); s += __shfl_xor(s, 2);
    bs += __shfl_xor(bs, 1); bs += __shfl_xor(bs, 2);
    const float mean = s * (1.0f / 64.0f);
    float q = 0.f;
#pragma unroll
    for (int j = 0; j < 16; ++j) { const float d = o0[j] - mean; q += d * d; }
    q += __shfl_xor(q, 1); q += __shfl_xor(q, 2);
    const float rstd = rsqrtf(q * (1.0f / 64.0f) + 64e-5f);
    float z[16];
#pragma unroll
    for (int j = 0; j < 16; ++j) z[j] = ((o0[j] - mean) * rstd * lw[j] + lb[j] + bs * vv[j]) * gg[j];
    u32x4 w0, w1;
    w0.x = pk2(z[0], z[1]); w0.y = pk2(z[2], z[3]); w0.z = pk2(z[4], z[5]); w0.w = pk2(z[6], z[7]);
    w1.x = pk2(z[8], z[9]); w1.y = pk2(z[10], z[11]); w1.z = pk2(z[12], z[13]); w1.w = pk2(z[14], z[15]);
    *(u32x4*)(Z + off) = w0; *(u32x4*)(Z + off + 8) = w1;
  }
}

enum { PH_CVT, PH_MOD, PH_N1_0, PH_N1_C, PH_FINAL, PH_N2, PH_CVTMOE, PH_UP, PH_DOWN, PH_QKV0, PH_ATT0, PH_OP, PH_QKV1, PH_ATT1, PH_POOL, PH_F1, PH_F2, PH_SCAN, PH_ROUT };
template <int PH>
__global__ __launch_bounds__(NTH, 2) void k_phase(Params p, int layer) {
  extern __shared__ __attribute__((aligned(16))) char smem[];
  char* U = p.ws + OFF_U;
  const bf16_t* wm = (const bf16_t*)(p.ws + OFF_WMIX);
  if constexpr (PH == PH_CVT) phase_cvt_mix(p, smem);
  if constexpr (PH == PH_MOD) phase_mod(p, smem);
  if constexpr (PH == PH_N1_0) phase_norm1<0>(p, layer, smem);
  if constexpr (PH == PH_N1_C) phase_norm1<1>(p, layer, smem);
  if constexpr (PH == PH_FINAL) phase_norm1<3>(p, layer, smem);
  if constexpr (PH == PH_N2) phase_norm2_router(p, layer, smem);
  if constexpr (PH == PH_CVTMOE) phase_cvt_moe(p, layer, smem);
  if constexpr (PH == PH_UP) phase_moe_up(p, layer, smem);
  if constexpr (PH == PH_DOWN) phase_moe_down(p, layer, smem);
  if constexpr (PH == PH_QKV0) phase_qkv<256>(p, wm + W_WINQKV, (bf16_t*)(U + U0_Q), (bf16_t*)(U + U0_K), (bf16_t*)(U + U0_VTL), (bf16_t*)(U + U0_VTC), smem);
  if constexpr (PH == PH_ATT0) phase_attn_win(p, smem);
  if constexpr (PH == PH_OP) {
    if (layer == 0) phase_oproj(p, 0, (const bf16_t*)(U + U0_O), wm + W_WINO, TT, smem);
    else if (layer == 1) phase_oproj(p, 1, (const bf16_t*)(U + U1_O), wm + W_DIFFO, TT, smem);
    else phase_oproj(p, 3, (const bf16_t*)(p.ws + OFF_H), wm + W_RO, TL, smem);
  }
  if constexpr (PH == PH_QKV1) phase_qkv<1024>(p, wm + W_DIFFQKV, (bf16_t*)(U + U1_Q), (bf16_t*)(U + U1_K), (bf16_t*)(U + U1_VTL), (bf16_t*)(U + U1_VTC), smem);
  if constexpr (PH == PH_ATT1) phase_attn_diff(p, smem);
  if constexpr (PH == PH_POOL) phase_pool(p, smem);
  if constexpr (PH == PH_F1) phase_rwkv_feat1(p, smem);
  if constexpr (PH == PH_F2) phase_rwkv_feat2(p, smem);
  if constexpr (PH == PH_SCAN) phase_rwkv_scan(p, smem);
  if constexpr (PH == PH_ROUT) phase_rwkv_out(p, smem);
}

template <int PH>
static void launch(const Params& p, int layer, int grid, int lds, hipStream_t stream) {
  if (lds > 48 * 1024) hipFuncSetAttribute((const void*)k_phase<PH>, hipFuncAttributeMaxDynamicSharedMemorySize, lds);
  hipLaunchKernelGGL(k_phase<PH>, dim3(grid), dim3(NTH), lds, stream, p, layer);
}

extern "C" void kernel_launch(void* const* d_in, const int* in_sizes, int n_in, void* d_out, int out_size, void* d_ws, size_t ws_size, hipStream_t stream) {
  if (ws_size < WS_NEED || n_in < 40) return;
  Params p{};
  for (int i = 0; i < 40; ++i) p.in[i] = (const float*)d_in[i];
  p.out = (float*)d_out;
  p.ws = (char*)d_ws;
  bf16_t* wm = (bf16_t*)(p.ws + OFF_WMIX);
  int nj = 0, item = 0;
  auto add = [&](const float* src, size_t dstoff, int K, int N, int ld) {
    p.jobs[nj].src = src; p.jobs[nj].dst = wm + dstoff; p.jobs[nj].K = K; p.jobs[nj].N = N; p.jobs[nj].ld = ld; p.jobs[nj].item0 = item;
    item += (K / 64) * (N / 64); ++nj;
  };
  add(p.in[8], W_WINQKV, 1024, 1536, 1536);
  add(p.in[10], W_WINO, 1024, 1024, 1024);
  add(p.in[11], W_DIFFQKV, 1024, 3072, 3072);
  add(p.in[14], W_DIFFO, 1024, 1024, 1024);
  for (int g = 0; g < 4; ++g) add(p.in[15] + (size_t)g * 65536, W_POOL + (size_t)g * 65536, 256, 256, 256);
  add(p.in[19], W_R, 1024, 1024, 1024);
  add(p.in[19] + (size_t)1 * 1024 * 1024, W_K, 1024, 1024, 1024);
  add(p.in[19] + (size_t)2 * 1024 * 1024, W_V, 1024, 1024, 1024);
  for (int d = 0; d < 2; ++d) add(p.in[21] + (size_t)d * 1024 * 64, W_WA1 + (size_t)d * 64 * 1024, 1024, 64, 64);
  for (int d = 0; d < 2; ++d) add(p.in[24] + (size_t)d * 1024 * 64, W_AA1 + (size_t)d * 64 * 1024, 1024, 64, 64);
  add(p.in[26], W_G1, 1024, 128, 128);
  for (int d = 0; d < 2; ++d) add(p.in[22] + (size_t)d * 64 * 1024, W_WA2 + (size_t)d * 1024 * 64, 64, 1024, 1024);
  for (int d = 0; d < 2; ++d) add(p.in[25] + (size_t)d * 64 * 1024, W_AA2 + (size_t)d * 1024 * 64, 64, 1024, 1024);
  add(p.in[27], W_G2, 128, 1024, 1024);
  add(p.in[33], W_RO, 1024, 1024, 1024);
  p.njobs = nj; p.nitems = item;

  hipMemsetAsync(p.ws, 0, 32768, stream);
  const int G = 1024;
  launch<PH_CVT>(p, 0, G, 64 * 65 * 4, stream);
  launch<PH_MOD>(p, 0, 384, MOD_LDS, stream);
  for (int layer = 0; layer < 4; ++layer) {
    if (layer == 0) launch<PH_N1_0>(p, layer, G, 256, stream); else launch<PH_N1_C>(p, layer, G, 256, stream);
    if (layer == 0) {
      launch<PH_QKV0>(p, layer, G, SG_LDS, stream);
      launch<PH_ATT0>(p, layer, G, A0_LDS, stream);
      launch<PH_OP>(p, layer, G, SG_LDS, stream);
    } else if (layer == 1) {
      launch<PH_QKV1>(p, layer, G, SG_LDS, stream);
      launch<PH_ATT1>(p, layer, G, A1_LDS, stream);
      launch<PH_OP>(p, layer, G, SG_LDS, stream);
    } else if (layer == 2) {
      launch<PH_POOL>(p, layer, G, SG_LDS, stream);
    } else {
      launch<PH_F1>(p, layer, G, SG_LDS, stream);
      launch<PH_F2>(p, layer, G, SG_LDS, stream);
      launch<PH_SCAN>(p, layer, 256, 8 * SC_LDS_W, stream);
      launch<PH_ROUT>(p, layer, G, 256, stream);
      launch<PH_OP>(p, layer, G, SG_LDS, stream);
    }
    launch<PH_N2>(p, layer, G, 256, stream);
    launch<PH_CVTMOE>(p, layer, G, 64 * 65 * 4, stream);
    launch<PH_UP>(p, layer, G, SG_LDS + 256, stream);
    launch<PH_DOWN>(p, layer, G, SG_LDS + 256, stream);
  }
  launch<PH_FINAL>(p, 3, G, 256, stream);
}
```

```cpp
#include <hip/hip_runtime.h>
#include <stdint.h>
#include <stddef.h>

typedef unsigned short bf16_t;
typedef short bf16x8 __attribute__((ext_vector_type(8)));
typedef short s16x4 __attribute__((ext_vector_type(4)));
typedef float f32x4 __attribute__((ext_vector_type(4)));
typedef float f32x16 __attribute__((ext_vector_type(16)));
typedef unsigned u32x4 __attribute__((ext_vector_type(4)));
typedef unsigned u32x2 __attribute__((ext_vector_type(2)));
typedef float f32x2 __attribute__((ext_vector_type(2)));
#define DI __device__ __forceinline__

constexpr int DM = 1024, NBATCH = 16, SEQ = 4096, CTX = 256;
constexpr int TL = NBATCH * SEQ, TC = NBATCH * CTX, TT = TL + TC;
constexpr int NTH = 512;
constexpr int MOE_PAD = 256;
constexpr int MOE_ROWS = 2 * TT + 32 * MOE_PAD;
constexpr int CAP = TT;

constexpr size_t al256(size_t x) { return (x + 255) & ~(size_t)255; }
constexpr size_t OFF_BAR = 0;
constexpr size_t OFF_CNT = 16384;
constexpr size_t OFF_MOD = 32768;
constexpr size_t OFF_ROPE = al256(OFF_MOD + (size_t)4 * 17 * 6144 * 4);
constexpr size_t OFF_XB = al256(OFF_ROPE + 2 * 64 * 16 * 4);
constexpr size_t OFF_H = al256(OFF_XB + (size_t)TT * DM * 2);
constexpr size_t OFF_H8 = al256(OFF_H + (size_t)(TT + 8) * DM * 2);
constexpr size_t OFF_TOK = al256(OFF_H8 + (size_t)(TT + 8) * DM);
constexpr size_t OFF_ROWL = al256(OFF_TOK + (size_t)TT * 32);
constexpr size_t OFF_WMIX = al256(OFF_ROWL + (size_t)32 * CAP * 4);
constexpr size_t W_WINQKV = 0;
constexpr size_t W_WINO = W_WINQKV + (size_t)1536 * 1024;
constexpr size_t W_DIFFQKV = W_WINO + (size_t)1024 * 1024;
constexpr size_t W_DIFFO = W_DIFFQKV + (size_t)3072 * 1024;
constexpr size_t W_POOL = W_DIFFO + (size_t)1024 * 1024;
constexpr size_t W_R = W_POOL + (size_t)4 * 256 * 256;
constexpr size_t W_K = W_R + (size_t)1024 * 1024;
constexpr size_t W_V = W_K + (size_t)1024 * 1024;
constexpr size_t W_WA1 = W_V + (size_t)1024 * 1024;
constexpr size_t W_AA1 = W_WA1 + (size_t)128 * 1024;
constexpr size_t W_G1 = W_AA1 + (size_t)128 * 1024;
constexpr size_t W_WA2 = W_G1 + (size_t)128 * 1024;
constexpr size_t W_AA2 = W_WA2 + (size_t)2048 * 128;
constexpr size_t W_G2 = W_AA2 + (size_t)2048 * 128;
constexpr size_t W_RO = W_G2 + (size_t)1024 * 128;
constexpr size_t W_MIX_END = W_RO + (size_t)1024 * 1024;
constexpr size_t OFF_WR = al256(OFF_WMIX + W_MIX_END * 2);
constexpr size_t OFF_WMOE = al256(OFF_WR + (size_t)4 * 2 * 48 * 1024 * 2);
constexpr size_t WMOE_DOWN = (size_t)32 * 1024 * 1024;
constexpr size_t OFF_U = al256(OFF_WMOE + ((size_t)32 * 1024 * 1024 + (size_t)32 * 1024 * 512) * 2);
constexpr size_t SZ_TT = (size_t)TT * DM * 2, SZ_TL = (size_t)TL * DM * 2;
constexpr size_t U0_Q = 0, U0_K = U0_Q + SZ_TT, U0_V = U0_K + (size_t)TT * 256 * 2, U0_O = U0_V + (size_t)TT * 256 * 2, U0_END = U0_O + SZ_TT;
constexpr size_t U1_Q = 0, U1_K = U1_Q + SZ_TT, U1_V = U1_K + SZ_TT, U1_O = U1_V + SZ_TT, U1_END = U1_O + SZ_TT;
constexpr size_t U2_Y = 0, U2_END = SZ_TT;
constexpr size_t U3_R = 0, U3_K = U3_R + SZ_TL, U3_V = U3_K + SZ_TT, U3_A0 = U3_V + SZ_TT, U3_A1 = U3_A0 + SZ_TT, U3_LD0 = U3_A1 + SZ_TT,
                 U3_LD1 = U3_LD0 + SZ_TT, U3_LW = U3_LD1 + SZ_TT, U3_LA = U3_LW + (size_t)TT * 128 * 2, U3_LG = U3_LA + (size_t)TT * 128 * 2,
                 U3_G = U3_LG + (size_t)TL * 128 * 2, U3_O0 = U3_G + SZ_TL, U3_O1 = U3_O0 + SZ_TL, U3_END = U3_O1 + SZ_TL;
constexpr size_t U3_XR = U3_A0, U3_XK = U3_A1, U3_XV = U3_LD0;
constexpr size_t UM_ACT = 0, UM_YB = UM_ACT + (size_t)MOE_ROWS * 512 * 2, UM_END = UM_YB + (size_t)MOE_ROWS * 1024 * 2;
constexpr size_t cmax(size_t a, size_t b) { return a > b ? a : b; }
constexpr size_t U_SIZE = cmax(cmax(cmax(U0_END, U1_END), U2_END), cmax(U3_END, UM_END));
constexpr size_t WS_NEED = OFF_U + U_SIZE;

struct CvtJob { const float* src; bf16_t* dst; int K, N, ld, item0, dld, pad_; };
constexpr int NJOBS = 24;
struct Params {
  const float* in[40];
  float* out;
  char* ws;
  CvtJob jobs[NJOBS];
  int njobs, nitems;
};

typedef const __attribute__((address_space(4))) Params* KP;
DI KP kparams() { KP q = (KP)__builtin_amdgcn_kernarg_segment_ptr(); asm volatile("" : "+s"(q)); return q; }
DI char* ows(KP p) {
  const unsigned long long w = (unsigned long long)p->ws;
  unsigned lo = (unsigned)w, hi = (unsigned)(w >> 32);
  asm volatile("" : "+v"(lo), "+v"(hi));
  lo = __builtin_amdgcn_readfirstlane(lo); hi = __builtin_amdgcn_readfirstlane(hi);
  return (char*)(__attribute__((address_space(1))) char*)(((unsigned long long)hi << 32) | lo);
}
DI const float* gin(KP p, int i) { return (const float*)(__attribute__((address_space(1))) const float*)p->in[i]; }
DI float* gout(KP p) { return (float*)(__attribute__((address_space(1))) float*)p->out; }
DI int otid() { int t = threadIdx.x; asm volatile("" : "+v"(t)); return t; }
DI int obid() { int b = blockIdx.x; asm volatile("" : "+s"(b)); return b; }
DI unsigned pk2(float lo, float hi) {
  typedef __bf16 bf2 __attribute__((ext_vector_type(2)));
  typedef float f2 __attribute__((ext_vector_type(2)));
  f2 v = {lo, hi};
  return __builtin_bit_cast(unsigned, __builtin_convertvector(v, bf2));
}
DI float clamp8(float x) { return __builtin_amdgcn_fmed3f(x, -440.0f, 440.0f); }
DI void swap32(float x, float& a, float& b) {
  a = x; b = x;
  asm volatile("s_nop 1\n\tv_permlane32_swap_b32 %0, %1\n\ts_nop 1" : "+v"(a), "+v"(b));
}
DI unsigned pk4_fp8_nc(float a, float b, float c, float d) { int w; asm("" : "=v"(w)); w = __builtin_amdgcn_cvt_pk_fp8_f32(a, b, w, false); w = __builtin_amdgcn_cvt_pk_fp8_f32(c, d, w, true); return (unsigned)w; }
DI unsigned pk4_fp8(float a, float b, float c, float d) { int w = __builtin_amdgcn_cvt_pk_fp8_f32(clamp8(a), clamp8(b), 0, false); w = __builtin_amdgcn_cvt_pk_fp8_f32(clamp8(c), clamp8(d), w, true); return (unsigned)w; }
DI bf16_t f2bf(float x) { return (bf16_t)(pk2(x, 0.f) & 0xffffu); }
DI float bf2f(bf16_t b) { return __uint_as_float(((unsigned)b) << 16); }
DI float bflo(unsigned u) { return __uint_as_float(u << 16); }
DI float bfhi(unsigned u) { return __uint_as_float(u & 0xffff0000u); }
DI float wave_sum(float v) {
#pragma unroll
  for (int o = 32; o >= 1; o >>= 1) v += __shfl_xor(v, o);
  return v;
}
DI float sigmoidf_(float x) { return __builtin_amdgcn_rcpf(1.0f + __expf(-x)); }
DI int row_bi(int r) { return r < TL ? (r >> 12) : 16; }
DI bf16_t* xrow_ptr(KP p, char* ws, int r) { return (bf16_t*)(ws + OFF_XB) + (size_t)r * DM; }
DI f32x4 ldbf4(const bf16_t* q) { const u32x2 w = *(const u32x2*)q; return (f32x4){bflo(w.x), bfhi(w.x), bflo(w.y), bfhi(w.y)}; }
DI void stbf4(bf16_t* q, const f32x4& v) { u32x2 w; w.x = pk2(v[0], v[1]); w.y = pk2(v[2], v[3]); *(u32x2*)q = w; }
DI const float* modp(char* ws, int layer, int bi, int which) { return (const float*)(ws + OFF_MOD) + ((size_t)(layer * 17 + bi) * 6 + which) * DM; }
#define MFMA16(a, b, c) __builtin_amdgcn_mfma_f32_16x16x32_bf16((a), (b), (c), 0, 0, 0)
#define MFMA32(a, b, c) __builtin_amdgcn_mfma_f32_32x32x16_bf16((a), (b), (c), 0, 0, 0)

constexpr int SGLD = 72;
constexpr int SG_LDS = 2 * 128 * SGLD * 2;
template <class AL, class BL, class EP>
DI void sgemm_tile(char* smem, int K, AL la, BL lb, EP ep) {
  bf16_t* sA = (bf16_t*)smem;
  bf16_t* sB = sA + 128 * SGLD;
  const int tid = otid(), lane = tid & 63, wid = tid >> 6, wr = wid >> 2, wc = wid & 3, fr = lane & 15, fq = lane >> 4;
  f32x4 acc[4][2];
#pragma unroll
  for (int m = 0; m < 4; ++m)
#pragma unroll
    for (int n = 0; n < 2; ++n) acc[m][n] = (f32x4){0.f, 0.f, 0.f, 0.f};
  const int r_ = tid >> 3, k_ = (tid & 7) * 8;
  u32x4 ra0 = la(r_, k_), ra1 = la(r_ + 64, k_), rb0 = lb(r_, k_), rb1 = lb(r_ + 64, k_);
  const int nk = K >> 6;
  for (int kt = 0; kt < nk; ++kt) {
    __syncthreads();
    *(u32x4*)(sA + r_ * SGLD + k_) = ra0;
    *(u32x4*)(sA + (r_ + 64) * SGLD + k_) = ra1;
    *(u32x4*)(sB + r_ * SGLD + k_) = rb0;
    *(u32x4*)(sB + (r_ + 64) * SGLD + k_) = rb1;
    __syncthreads();
    if (kt + 1 < nk) {
      const int kk = (kt + 1) * 64 + k_;
      ra0 = la(r_, kk); ra1 = la(r_ + 64, kk); rb0 = lb(r_, kk); rb1 = lb(r_ + 64, kk);
    }
#pragma unroll
    for (int ks = 0; ks < 2; ++ks) {
      bf16x8 af[4], bq[2];
#pragma unroll
      for (int m = 0; m < 4; ++m) af[m] = *(const bf16x8*)(sA + (wr * 64 + m * 16 + fr) * SGLD + ks * 32 + fq * 8);
#pragma unroll
      for (int n = 0; n < 2; ++n) bq[n] = *(const bf16x8*)(sB + (wc * 32 + n * 16 + fr) * SGLD + ks * 32 + fq * 8);
#pragma unroll
      for (int m = 0; m < 4; ++m)
#pragma unroll
        for (int n = 0; n < 2; ++n) acc[m][n] = MFMA16(af[m], bq[n], acc[m][n]);
    }
  }
  ep(acc, wr * 64, wc * 32, fr, fq);
}
DI u32x4 ld16(const bf16_t* p) { return *(const u32x4*)p; }

#define LAS __attribute__((address_space(3)))
namespace fg {
typedef int v8i_t __attribute__((ext_vector_type(8)));
typedef int v4i_t __attribute__((ext_vector_type(4)));
constexpr int BM = 256, BK = 64, HALF = 128, HTB = HALF * BK * 2, STAGE_BYTES = 8 * HTB, NXCD = 8, WGM = 8;
DI int lds_byte(int r, int c) { const int st = (r >> 4) * 2 + (c >> 5), rr = r & 15, cc = c & 31, ob = rr * 64 + cc * 2; return st * 1024 + (ob ^ (((ob >> 9) & 1) << 5)); }
DI void stage_rc(int b, int& R, int& C) { const int st = b / 1024, sb = b % 1024, swz = sb ^ (((sb >> 9) & 1) << 5); R = (st >> 1) * 16 + swz / 64; C = (st & 1) * 32 + (swz % 64) / 2; }
struct Unit { const char* A; const char* B; int pm, pn, aux; };
DI bool static_order(int i, int G, int c, int nM, int nN, int& pm, int& pn) {
  const int nwg = nM * nN;
  const long L = (long)i * G + c; if (L >= nwg) return false;
  int wgid = (int)L; { const int q = nwg / NXCD, r = nwg % NXCD, xcd = wgid % NXCD, off = wgid / NXCD; wgid = (xcd < r ? xcd * (q + 1) : r * (q + 1) + (xcd - r) * q) + off; }
  const int nig = WGM * nN, gid = wgid / nig, fm = gid * WGM, gsz = (nM - fm) < WGM ? (nM - fm) : WGM;
  pm = fm + ((wgid % nig) % gsz); pn = (wgid % nig) / gsz; return true;
}
struct DenseSched {
  const char* A; const char* B; int nM, nN, G, c; size_t tA, tB;
  DI bool next(int i, Unit& u) const { int pm, pn; if (!static_order(i, G, c, nM, nN, pm, pn)) return false; u.pm = pm; u.pn = pn; u.aux = 0; u.A = A + (size_t)pm * tA; u.B = B + (size_t)pn * tB; return true; }
  DI const LAS int* rows(int) const { return nullptr; }
};

DI int perm32(int rho) { const int n = rho >> 4, i = rho & 15; return 8 * (i >> 2) + 4 * n + (i & 3); }
template <bool GATHER, bool PERM = false, class Epi, class Sched>
DI void gemm_phase(LAS unsigned char* lds, const int K, const int lda, const int ldb, const Sched& S, const Epi& E) {
  const int tid = otid(), wid = __builtin_amdgcn_readfirstlane(tid >> 6), lane = tid & 63, wr = wid >> 2, wc = wid & 3, fr = lane & 15, fq = lane >> 4;
  const int nt = K / BK;
  unsigned voffA[2], voffB[2]; int sR[2], sC[2];
#pragma unroll
  for (int i = 0; i < 2; ++i) { int R, C; stage_rc(tid * 16 + i * 8192, R, C); sR[i] = R; sC[i] = C; voffA[i] = (unsigned)(R * lda + C) * 2u; const int Rb = PERM ? ((R & ~31) + perm32(R & 31)) : R; voffB[i] = (unsigned)(Rb * ldb + C) * 2u; }
  const size_t kstep = (size_t)(BK * 2), hstepA = (size_t)HALF * lda * 2, hstepB = (size_t)HALF * ldb * 2;
  const unsigned ldsw = (unsigned)wid * 1024u;
  const int aoff = lds_byte(wr * 64 + fr, fq * 8), boff = lds_byte(wc * 32 + fr, fq * 8);
#define FG_SA(b, h) (((b) * 2 + (h)) * HTB)
#define FG_SB(b, h) ((4 + (b) * 2 + (h)) * HTB)
#define FG_GLDS(gp, bufoff, i_) __builtin_amdgcn_global_load_lds((const unsigned*)(gp), (LAS unsigned*)(lds + (bufoff) + ldsw + (i_) * 8192), 16, 0, 0)
#define FG_STAGE_B(bufoff, gbase) do { const char* _gb = (gbase); FG_GLDS(_gb + voffB[0], bufoff, 0); FG_GLDS(_gb + voffB[1], bufoff, 1); } while (0)
#define FG_STAGE_A(bufoff, NX, H, KB) do { \
    if constexpr (GATHER) { const char* _gb = ((NX) ? nA : cA) + (KB); FG_GLDS(_gb + ((NX) ? gn[H][0] : gc[H][0]), bufoff, 0); FG_GLDS(_gb + ((NX) ? gn[H][1] : gc[H][1]), bufoff, 1); } \
    else { const char* _gb = ((NX) ? nA : cA) + (size_t)(H) * hstepA + (KB); FG_GLDS(_gb + voffA[0], bufoff, 0); FG_GLDS(_gb + voffA[1], bufoff, 1); } } while (0)
#define FG_LDA(dst, b, h) do { _Pragma("unroll") for (int m = 0; m < 4; ++m) _Pragma("unroll") for (int k = 0; k < 2; ++k) dst[m][k] = *(const LAS bf16x8*)(lds + FG_SA(b, h) + aoff + m * 2048 + k * 1024); } while (0)
#define FG_LDB(dst, b, h) do { _Pragma("unroll") for (int n = 0; n < 2; ++n) _Pragma("unroll") for (int k = 0; k < 2; ++k) dst[n][k] = *(const LAS bf16x8*)(lds + FG_SB(b, h) + boff + n * 2048 + k * 1024); } while (0)
#define FG_MMA(ai, bj, At, Bt) do { __builtin_amdgcn_s_setprio(1); _Pragma("unroll") for (int m = 0; m < 4; ++m) _Pragma("unroll") for (int n = 0; n < 2; ++n) _Pragma("unroll") for (int k = 0; k < 2; ++k) \
    acc[ai][bj][m][n] = __builtin_amdgcn_mfma_f32_16x16x32_bf16(Bt[n][k], At[m][k], acc[ai][bj][m][n], 0, 0, 0); __builtin_amdgcn_s_setprio(0); } while (0)
#define FG_WAIT_V(n) asm volatile("s_waitcnt vmcnt(" #n ")" ::: "memory")
#define FG_WAIT_L(n) asm volatile("s_waitcnt lgkmcnt(" #n ")" ::: "memory")
#define FG_BAR __builtin_amdgcn_s_barrier()
#define FG_SCHED __builtin_amdgcn_sched_barrier(0)
  Unit cur, nxt; int ui = 0;
  if (!S.next(0, cur)) return;
  f32x4 acc[2][2][4][2];
#pragma unroll
  for (int a = 0; a < 2; ++a)
#pragma unroll
    for (int b = 0; b < 2; ++b)
#pragma unroll
      for (int m = 0; m < 4; ++m)
#pragma unroll
        for (int n = 0; n < 2; ++n) acc[a][b][m][n] = (f32x4){0.f, 0.f, 0.f, 0.f};
  bf16x8 At[4][2], B0[2][2], B1[2][2];
  const char* cA = cur.A; const char* cB = cur.B;
  const char* nA = cA; const char* nB = cB;
  unsigned gc[2][2] = {{0u, 0u}, {0u, 0u}}, gn[2][2] = {{0u, 0u}, {0u, 0u}};
  if constexpr (GATHER) {
    const LAS int* rw = S.rows(0);
#pragma unroll
    for (int h = 0; h < 2; ++h)
#pragma unroll
      for (int i = 0; i < 2; ++i) { gc[h][i] = (unsigned)(rw[h * HALF + sR[i]] * lda + sC[i]) * 2u; gn[h][i] = gc[h][i]; }
  }
  FG_STAGE_B(FG_SB(0, 0), cB); FG_STAGE_B(FG_SB(0, 1), cB + hstepB); FG_STAGE_A(FG_SA(0, 0), false, 0, 0); FG_STAGE_A(FG_SA(0, 1), false, 1, 0);
  if (wr == 1) FG_BAR;
  FG_WAIT_V(2); FG_BAR;
  FG_STAGE_B(FG_SB(1, 0), cB + kstep); FG_STAGE_A(FG_SA(1, 0), false, 0, kstep); FG_STAGE_B(FG_SB(1, 1), cB + hstepB + kstep);
  FG_WAIT_V(6); FG_BAR;
  for (;;) {
    const bool has_next = S.next(ui + 1, nxt);
    nA = has_next ? nxt.A : cA; nB = has_next ? nxt.B : cB;
    if constexpr (GATHER) {
      if (has_next) {
        const LAS int* rw = S.rows(ui + 1);
#pragma unroll
        for (int h = 0; h < 2; ++h)
#pragma unroll
          for (int i = 0; i < 2; ++i) gn[h][i] = (unsigned)(rw[h * HALF + sR[i]] * lda + sC[i]) * 2u;
      } else {
#pragma unroll
        for (int h = 0; h < 2; ++h)
#pragma unroll
          for (int i = 0; i < 2; ++i) gn[h][i] = gc[h][i];
      }
      FG_WAIT_L(0);
    }
    for (int t = 0; t < nt; t += 2) {
      const bool last = (t == nt - 2);
      const size_t k1 = (size_t)(t + 1) * kstep;
      const size_t k2 = last ? 0 : (size_t)(t + 2) * kstep, k3 = k2 + kstep;
      const char* b2 = last ? nB : cB + (size_t)(t + 2) * kstep; const char* b3 = b2 + kstep;
      FG_LDB(B0, 0, 0); FG_LDB(B1, 0, 1); FG_SCHED; FG_LDA(At, 0, 0); FG_STAGE_A(FG_SA(1, 1), false, 1, k1);
      FG_WAIT_V(8); FG_WAIT_L(0); FG_BAR; FG_MMA(0, 0, At, B0); FG_MMA(0, 1, At, B1); FG_BAR; FG_SCHED;
      FG_LDA(At, 0, 1); FG_STAGE_B(FG_SB(0, 0), b2); FG_STAGE_B(FG_SB(0, 1), b2 + hstepB); FG_STAGE_A(FG_SA(0, 0), last, 0, k2);
      FG_WAIT_V(8); FG_WAIT_L(0); FG_BAR; FG_MMA(1, 0, At, B0); FG_MMA(1, 1, At, B1); FG_BAR; FG_SCHED;
      FG_LDB(B0, 1, 0); FG_LDB(B1, 1, 1); FG_SCHED; FG_LDA(At, 1, 0); FG_STAGE_A(FG_SA(0, 1), last, 1, k2);
      FG_WAIT_V(8); FG_WAIT_L(0); FG_BAR; FG_MMA(0, 0, At, B0); FG_MMA(0, 1, At, B1); FG_BAR; FG_SCHED;
      FG_LDA(At, 1, 1); FG_STAGE_B(FG_SB(1, 0), b3); FG_STAGE_B(FG_SB(1, 1), b3 + hstepB); FG_STAGE_A(FG_SA(1, 0), last, 0, k3);
      FG_WAIT_V(8); FG_WAIT_L(0); FG_BAR; FG_MMA(1, 0, At, B0); FG_MMA(1, 1, At, B1); FG_BAR; FG_SCHED;
    }
    if (wr == 0) FG_BAR;
    E(acc, cur, wr, wc, fr, fq);
    if (!has_next) break;
#pragma unroll
    for (int a = 0; a < 2; ++a)
#pragma unroll
      for (int b = 0; b < 2; ++b)
#pragma unroll
        for (int m = 0; m < 4; ++m)
#pragma unroll
          for (int n = 0; n < 2; ++n) acc[a][b][m][n] = (f32x4){0.f, 0.f, 0.f, 0.f};
    cur = nxt; cA = nA; cB = nB; ++ui;
    if constexpr (GATHER) {
#pragma unroll
      for (int h = 0; h < 2; ++h)
#pragma unroll
        for (int i = 0; i < 2; ++i) gc[h][i] = gn[h][i];
    }
    if (wr == 1) FG_BAR;
  }
  FG_WAIT_V(0);
  FG_BAR;
#undef FG_SA
#undef FG_SB
#undef FG_GLDS
#undef FG_STAGE_A
#undef FG_STAGE_B
#undef FG_LDA
#undef FG_LDB
#undef FG_MMA
#undef FG_WAIT_V
#undef FG_WAIT_L
#undef FG_BAR
#undef FG_SCHED
}
DI int perm32f8(int s_) { return 16 * ((s_ >> 2) & 1) + (s_ & 3) + 4 * (s_ >> 3); }
template <bool GATHER, bool PERM = false, class Epi, class Sched>
DI void gemm_phase_f8(LAS unsigned char* lds, const int K, const int lda, const int ldb, const Sched& S, const Epi& E) {
  const int tid = otid(), wid = __builtin_amdgcn_readfirstlane(tid >> 6), lane = tid & 63, wr = wid >> 2, wc = wid & 3, fr = lane & 15, fq = lane >> 4;
  const int nt = K / BK;
  unsigned voffA[2], voffB[2]; int sR[2], sC[2];
#pragma unroll
  for (int i = 0; i < 2; ++i) { int R, C; stage_rc(tid * 16 + i * 8192, R, C); sR[i] = R; sC[i] = C; voffA[i] = (unsigned)(R * lda + C) * 2u; const int Rb = PERM ? ((R & ~31) + perm32f8(R & 31)) : R; voffB[i] = (unsigned)(Rb * ldb + C) * 2u; }
  const size_t kstep = (size_t)(BK * 2), hstepA = (size_t)HALF * lda * 2, hstepB = (size_t)HALF * ldb * 2;
  const unsigned ldsw = (unsigned)wid * 1024u;
  const int r32 = lane & 31, g32 = lane >> 5;
  const int aoff = lds_byte(wr * 64 + r32, 16 * g32), boff = lds_byte(wc * 32 + r32, 16 * g32);
#define FG_SA(b, h) (((b) * 2 + (h)) * HTB)
#define FG_SB(b, h) ((4 + (b) * 2 + (h)) * HTB)
#define FG_GLDS(gp, bufoff, i_) __builtin_amdgcn_global_load_lds((const unsigned*)(gp), (LAS unsigned*)(lds + (bufoff) + ldsw + (i_) * 8192), 16, 0, 0)
#define FG_STAGE_B(bufoff, gbase) do { const char* _gb = (gbase); FG_GLDS(_gb + voffB[0], bufoff, 0); FG_GLDS(_gb + voffB[1], bufoff, 1); } while (0)
#define FG_STAGE_A(bufoff, NX, H, KB) do { \
    if constexpr (GATHER) { const char* _gb = ((NX) ? nA : cA) + (KB); FG_GLDS(_gb + ((NX) ? gn[H][0] : gc[H][0]), bufoff, 0); FG_GLDS(_gb + ((NX) ? gn[H][1] : gc[H][1]), bufoff, 1); } \
    else { const char* _gb = ((NX) ? nA : cA) + (size_t)(H) * hstepA + (KB); FG_GLDS(_gb + voffA[0], bufoff, 0); FG_GLDS(_gb + voffA[1], bufoff, 1); } } while (0)
#define FG_LDA(dst, b, h) do { _Pragma("unroll") for (int m = 0; m < 2; ++m) _Pragma("unroll") for (int k = 0; k < 2; ++k) { const LAS v4i_t* q_ = (const LAS v4i_t*)(lds + FG_SA(b, h) + aoff + m * 4096 + k * 1024); dst[m][k] = __builtin_shufflevector(q_[0], q_[1], 0, 1, 2, 3, 4, 5, 6, 7); } } while (0)
#define FG_LDB(dst, b, h) do { _Pragma("unroll") for (int k = 0; k < 2; ++k) { const LAS v4i_t* q_ = (const LAS v4i_t*)(lds + FG_SB(b, h) + boff + k * 1024); dst[k] = __builtin_shufflevector(q_[0], q_[1], 0, 1, 2, 3, 4, 5, 6, 7); } } while (0)
#define FG_MMA(ai, bj, At, Bt) do { __builtin_amdgcn_s_setprio(1); _Pragma("unroll") for (int m = 0; m < 2; ++m) _Pragma("unroll") for (int k = 0; k < 2; ++k) \
    acc[ai][bj][m] = __builtin_amdgcn_mfma_scale_f32_32x32x64_f8f6f4(Bt[k], At[m][k], acc[ai][bj][m], 0, 0, 0, 0x7f7f7f7f, 0, 0x7f7f7f7f); __builtin_amdgcn_s_setprio(0); } while (0)
#define FG_WAIT_V(n) asm volatile("s_waitcnt vmcnt(" #n ")" ::: "memory")
#define FG_WAIT_L(n) asm volatile("s_waitcnt lgkmcnt(" #n ")" ::: "memory")
#define FG_BAR __builtin_amdgcn_s_barrier()
#define FG_SCHED __builtin_amdgcn_sched_barrier(0)
  Unit cur, nxt; int ui = 0;
  if (!S.next(0, cur)) return;
  f32x16 acc[2][2][2];
#pragma unroll
  for (int a = 0; a < 2; ++a)
#pragma unroll
    for (int b = 0; b < 2; ++b)
#pragma unroll
      for (int m = 0; m < 2; ++m)
#pragma unroll
        for (int n = 0; n < 16; ++n) acc[a][b][m][n] = 0.f;
  v8i_t At[2][2], B0[2], B1[2];
  const char* cA = cur.A; const char* cB = cur.B;
  const char* nA = cA; const char* nB = cB;
  unsigned gc[2][2] = {{0u, 0u}, {0u, 0u}}, gn[2][2] = {{0u, 0u}, {0u, 0u}};
  if constexpr (GATHER) {
    const LAS int* rw = S.rows(0);
#pragma unroll
    for (int h = 0; h < 2; ++h)
#pragma unroll
      for (int i = 0; i < 2; ++i) { gc[h][i] = (unsigned)(rw[h * HALF + sR[i]] * lda + sC[i]) * 2u; gn[h][i] = gc[h][i]; }
  }
  FG_STAGE_B(FG_SB(0, 0), cB); FG_STAGE_B(FG_SB(0, 1), cB + hstepB); FG_STAGE_A(FG_SA(0, 0), false, 0, 0); FG_STAGE_A(FG_SA(0, 1), false, 1, 0);
  if (wr == 1) FG_BAR;
  FG_WAIT_V(2); FG_BAR;
  FG_STAGE_B(FG_SB(1, 0), cB + kstep); FG_STAGE_A(FG_SA(1, 0), false, 0, kstep); FG_STAGE_B(FG_SB(1, 1), cB + hstepB + kstep);
  FG_WAIT_V(6); FG_BAR;
  for (;;) {
    const bool has_next = S.next(ui + 1, nxt);
    nA = has_next ? nxt.A : cA; nB = has_next ? nxt.B : cB;
    if constexpr (GATHER) {
      if (has_next) {
        const LAS int* rw = S.rows(ui + 1);
#pragma unroll
        for (int h = 0; h < 2; ++h)
#pragma unroll
          for (int i = 0; i < 2; ++i) gn[h][i] = (unsigned)(rw[h * HALF + sR[i]] * lda + sC[i]) * 2u;
      } else {
#pragma unroll
        for (int h = 0; h < 2; ++h)
#pragma unroll
          for (int i = 0; i < 2; ++i) gn[h][i] = gc[h][i];
      }
      FG_WAIT_L(0);
    }
#pragma nounroll
    for (int t = 0; t < nt; t += 2) {
      const bool last = (t == nt - 2);
      const size_t k1 = (size_t)(t + 1) * kstep;
      const size_t k2 = last ? 0 : (size_t)(t + 2) * kstep, k3 = k2 + kstep;
      const char* b2 = last ? nB : cB + (size_t)(t + 2) * kstep; const char* b3 = b2 + kstep;
      FG_LDB(B0, 0, 0); FG_LDB(B1, 0, 1); FG_SCHED; FG_LDA(At, 0, 0); FG_STAGE_A(FG_SA(1, 1), false, 1, k1);
      FG_WAIT_V(8); FG_WAIT_L(0); FG_BAR; FG_MMA(0, 0, At, B0); FG_MMA(0, 1, At, B1); FG_BAR; FG_SCHED;
      FG_LDA(At, 0, 1); FG_STAGE_B(FG_SB(0, 0), b2); FG_STAGE_B(FG_SB(0, 1), b2 + hstepB); FG_STAGE_A(FG_SA(0, 0), last, 0, k2);
      FG_WAIT_V(8); FG_WAIT_L(0); FG_BAR; FG_MMA(1, 0, At, B0); FG_MMA(1, 1, At, B1); FG_BAR; FG_SCHED;
      FG_LDB(B0, 1, 0); FG_LDB(B1, 1, 1); FG_SCHED; FG_LDA(At, 1, 0); FG_STAGE_A(FG_SA(0, 1), last, 1, k2);
      FG_WAIT_V(8); FG_WAIT_L(0); FG_BAR; FG_MMA(0, 0, At, B0); FG_MMA(0, 1, At, B1); FG_BAR; FG_SCHED;
      FG_LDA(At, 1, 1); FG_STAGE_B(FG_SB(1, 0), b3); FG_STAGE_B(FG_SB(1, 1), b3 + hstepB); FG_STAGE_A(FG_SA(1, 0), last, 0, k3);
      FG_WAIT_V(8); FG_WAIT_L(0); FG_BAR; FG_MMA(1, 0, At, B0); FG_MMA(1, 1, At, B1); FG_BAR; FG_SCHED;
    }
    if (wr == 0) FG_BAR;
    E(acc, cur, wr, wc, r32, g32);
    if (!has_next) break;
#pragma unroll
    for (int a = 0; a < 2; ++a)
#pragma unroll
      for (int b = 0; b < 2; ++b)
#pragma unroll
        for (int m = 0; m < 2; ++m)
#pragma unroll
          for (int n = 0; n < 16; ++n) acc[a][b][m][n] = 0.f;
    cur = nxt; cA = nA; cB = nB; ++ui;
    if constexpr (GATHER) {
#pragma unroll
      for (int h = 0; h < 2; ++h)
#pragma unroll
        for (int i = 0; i < 2; ++i) gc[h][i] = gn[h][i];
    }
    if (wr == 1) FG_BAR;
  }
  FG_WAIT_V(0);
  FG_BAR;
#undef FG_SA
#undef FG_SB
#undef FG_GLDS
#undef FG_STAGE_A
#undef FG_STAGE_B
#undef FG_LDA
#undef FG_LDB
#undef FG_MMA
#undef FG_WAIT_V
#undef FG_WAIT_L
#undef FG_BAR
#undef FG_SCHED
}
}

DI void cvt_tile(char* smem, const float* src, int ld, bf16_t* dst, int K, int N, int item, int dld, int f8) {
  float* tile = (float*)smem;
  const int ntn = N >> 6, kt = item / ntn, nt = item % ntn, k0 = kt * 64, n0 = nt * 64, tid = otid();
  __syncthreads();
#pragma unroll
  for (int i = 0; i < 8; ++i) { const int idx = tid + i * NTH, r = idx >> 6, c = idx & 63; tile[r * 65 + c] = src[(size_t)(k0 + r) * ld + n0 + c]; }
  __syncthreads();
  const int n = tid >> 3, k8 = (tid & 7) * 8;
  if (f8) {
    u32x2 o8;
    o8.x = pk4_fp8(tile[(k8 + 0) * 65 + n] * 32.f, tile[(k8 + 1) * 65 + n] * 32.f, tile[(k8 + 2) * 65 + n] * 32.f, tile[(k8 + 3) * 65 + n] * 32.f);
    o8.y = pk4_fp8(tile[(k8 + 4) * 65 + n] * 32.f, tile[(k8 + 5) * 65 + n] * 32.f, tile[(k8 + 6) * 65 + n] * 32.f, tile[(k8 + 7) * 65 + n] * 32.f);
    *(u32x2*)((unsigned char*)dst + (size_t)(n0 + n) * dld + k0 + k8) = o8;
    return;
  }
  u32x4 o;
  o.x = pk2(tile[(k8 + 0) * 65 + n], tile[(k8 + 1) * 65 + n]);
  o.y = pk2(tile[(k8 + 2) * 65 + n], tile[(k8 + 3) * 65 + n]);
  o.z = pk2(tile[(k8 + 4) * 65 + n], tile[(k8 + 5) * 65 + n]);
  o.w = pk2(tile[(k8 + 6) * 65 + n], tile[(k8 + 7) * 65 + n]);
  *(u32x4*)(dst + (size_t)(n0 + n) * dld + k0 + k8) = o;
}
DI void phase_cvt_mix(KP p, char* smem) {
  char* const ws = ows(p);
  {
    bf16_t* wz = (bf16_t*)(ws + OFF_WMIX) + W_WA2;
    for (int i = obid() * NTH + otid(); i < 2 * 2048 * 8; i += gridDim.x * NTH) {
      const int row = i >> 3, c8 = i & 7, d = (row & 2047) >> 10;
      *(u32x4*)(wz + (size_t)row * 128 + (1 - d) * 64 + c8 * 8) = (u32x4){0u, 0u, 0u, 0u};
    }
  }
  for (int it = obid(); it < p->nitems; it += gridDim.x) {
    int j = 0;
    while (j + 1 < p->njobs && p->jobs[j + 1].item0 <= it) ++j;
    cvt_tile(smem, (const float*)(__attribute__((address_space(1))) const float*)p->jobs[j].src, p->jobs[j].ld, (bf16_t*)(__attribute__((address_space(1))) bf16_t*)p->jobs[j].dst, p->jobs[j].K, p->jobs[j].N, it - p->jobs[j].item0, p->jobs[j].dld, p->jobs[j].pad_);
  }
}
constexpr float O8_SCALE = 4.0f;
constexpr float X8_SCALE = 4.0f;
constexpr float W8_SCALE = 32.0f, A8_SCALE = 4.0f, WD8_SCALE = 16.0f;
DI int up_src_col(int np) {
  const int slab = np >> 5, pos = np & 31, q = pos & 15, hh = (q >> 2) & 1, i = (q & 3) + 4 * (q >> 3);
  return (pos >> 4) * 512 + slab * 16 + 8 * hh + i;
}
DI void phase_cvt_moe(KP p, int layer, char* smem) {
  char* const ws = ows(p);
  float* tile = (float*)smem;
  bf16_t* wm = (bf16_t*)(ws + OFF_WMOE);
  const int tid = otid();
  const int NUP = 32 * 256, NDN = 32 * 128;
  for (int it = obid(); it < NUP + NDN; it += gridDim.x) {
    if (it < NUP) {
      const int e = it >> 8, t = it & 255, kt = t >> 4, nt = t & 15, k0 = kt * 64, n0 = nt * 64;
      const float* src = gin(p, 38) + ((size_t)(layer * 32 + e) * 1024) * 1024;
      __syncthreads();
#pragma unroll
      for (int i = 0; i < 8; ++i) { const int idx = tid + i * NTH, r = idx >> 6, c = idx & 63; tile[r * 65 + c] = src[(size_t)(k0 + r) * 1024 + up_src_col(n0 + c)]; }
      __syncthreads();
      const int n = tid >> 3, k8 = (tid & 7) * 8;
      u32x2 o;
      o.x = pk4_fp8(tile[(k8 + 0) * 65 + n] * W8_SCALE, tile[(k8 + 1) * 65 + n] * W8_SCALE, tile[(k8 + 2) * 65 + n] * W8_SCALE, tile[(k8 + 3) * 65 + n] * W8_SCALE);
      o.y = pk4_fp8(tile[(k8 + 4) * 65 + n] * W8_SCALE, tile[(k8 + 5) * 65 + n] * W8_SCALE, tile[(k8 + 6) * 65 + n] * W8_SCALE, tile[(k8 + 7) * 65 + n] * W8_SCALE);
      *(u32x2*)((unsigned char*)wm + (size_t)e * 1024 * 1024 + (size_t)(n0 + n) * 1024 + k0 + k8) = o;
    } else {
      const int i2 = it - NUP, e = i2 >> 7, t = i2 & 127;
      const int kt = t >> 4, nt = t & 15, k0 = kt * 64, n0 = nt * 64;
      const float* src = gin(p, 39) + ((size_t)(layer * 32 + e) * 512) * 1024;
      __syncthreads();
#pragma unroll
      for (int i = 0; i < 8; ++i) { const int idx = tid + i * NTH, r = idx >> 6, c = idx & 63; tile[r * 65 + c] = src[(size_t)(k0 + r) * 1024 + n0 + c]; }
      __syncthreads();
      const int n = tid >> 3, k8 = (tid & 7) * 8;
      u32x2 o;
      o.x = pk4_fp8(tile[(k8 + 0) * 65 + n] * WD8_SCALE, tile[(k8 + 1) * 65 + n] * WD8_SCALE, tile[(k8 + 2) * 65 + n] * WD8_SCALE, tile[(k8 + 3) * 65 + n] * WD8_SCALE);
      o.y = pk4_fp8(tile[(k8 + 4) * 65 + n] * WD8_SCALE, tile[(k8 + 5) * 65 + n] * WD8_SCALE, tile[(k8 + 6) * 65 + n] * WD8_SCALE, tile[(k8 + 7) * 65 + n] * WD8_SCALE);
      *(u32x2*)((unsigned char*)(wm + WMOE_DOWN) + (size_t)e * 1024 * 512 + (size_t)(n0 + n) * 512 + k0 + k8) = o;
    }
  }
}

constexpr int MOD_LDS = 17 * 1024 * 4 + 8 * 17 * 64 * 4;
DI void phase_mod(KP p, char* smem) {
  char* const ws = ows(p);
  float* sc = (float*)smem;
  float* red = sc + 17 * 1024;
  const int tid = otid();
  for (int i = tid; i < 17 * 1024; i += NTH) {
    const int bi = i >> 10, k = i & 1023;
    const float v = bi < 16 ? gin(p, 1)[bi * 1024 + k] : gin(p, 3)[k];
    sc[i] = v / (1.0f + __expf(-v));
  }
  __syncthreads();
  const int col = tid & 63, ks = tid >> 6;
  for (int it = obid(); it < 4 * 96; it += gridDim.x) {
    const int l = it / 96, j = (it % 96) * 64 + col;
    const float* w = gin(p, 4) + (size_t)l * 1024 * 6144 + j;
    float acc[17];
#pragma unroll
    for (int b = 0; b < 17; ++b) acc[b] = 0.f;
    for (int k = ks * 128; k < ks * 128 + 128; ++k) {
      const float wv = w[(size_t)k * 6144];
#pragma unroll
      for (int b = 0; b < 17; ++b) acc[b] += sc[b * 1024 + k] * wv;
    }
    __syncthreads();
#pragma unroll
    for (int b = 0; b < 17; ++b) red[(ks * 17 + b) * 64 + col] = acc[b];
    __syncthreads();
    for (int o = tid; o < 17 * 64; o += NTH) {
      const int b = o >> 6, c = o & 63;
      float s = 0.f;
#pragma unroll
      for (int q = 0; q < 8; ++q) s += red[(q * 17 + b) * 64 + c];
      const int jj = (it % 96) * 64 + c;
      ((float*)(ws + OFF_MOD))[(size_t)(l * 17 + b) * 6144 + jj] = s + gin(p, 5)[l * 6144 + jj];
    }
  }
  {
    bf16_t* wr = (bf16_t*)(ws + OFF_WR);
    for (int i = obid() * NTH + tid; i < 4 * 48 * 1024; i += gridDim.x * NTH) {
      const int l = i / (48 * 1024), n = (i / 1024) % 48, k = i & 1023;
      float w = 0.f;
      if (n < 4) w = gin(p, 34)[((size_t)l * 1024 + k) * 4 + n];
      else if (n < 36) w = gin(p, 36)[((size_t)l * 1024 + k) * 32 + (n - 4)];
      const bf16_t hi = f2bf(w);
      wr[((size_t)(l * 2 + 0) * 48 + n) * 1024 + k] = hi;
      wr[((size_t)(l * 2 + 1) * 48 + n) * 1024 + k] = f2bf(w - bf2f(hi));
    }
  }
  if (obid() == 0) {
    float* rc = (float*)(ws + OFF_ROPE);
    for (int i = tid; i < 1024; i += NTH) {
      const int pos = i >> 4, f = i & 15;
      const float inv = powf(10000.0f, -(float)f / 16.0f);
      const float ang = (float)pos * inv;
      rc[i] = cosf(ang); rc[1024 + i] = sinf(ang);
    }
  }
}

DI void moe_blkstart(char* ws, int layer, int* bs  ) {
  if (otid() == 0) {
    const int* cnt = (const int*)(ws + OFF_CNT) + layer * 32;
    int s = 0;
    for (int e = 0; e < 32; ++e) { bs[e] = s; s += (cnt[e] + MOE_PAD - 1) / MOE_PAD; }
    bs[32] = s;
  }
  __syncthreads();
}
template <int MODE, bool DRY = false, bool OUT8 = false>
DI void phase_norm1(KP p, int layer, char* smem) {
  char* const ws = ows(p);
  int* bs = (int*)smem;
  if (MODE != 0) moe_blkstart(ws, MODE == 3 ? 3 : layer - 1, bs);
  const int lane = otid() & 63, wid = otid() >> 6;
  const int nrows = MODE == 3 ? TL : TT;
  const bf16_t* yb = (const bf16_t*)(ws + OFF_U + UM_YB);
  const int* tok = (const int*)(ws + OFF_TOK);
  bf16_t* hb = (bf16_t*)(ws + OFF_H);
  const int stride = gridDim.x * 8;
  for (int rA = obid() * 8 + wid; rA < nrows; rA += 2 * stride) {
    const int rB = rA + stride;
    const bool hasB = rB < nrows;
    const int rr[2] = {rA, hasB ? rB : rA};
    f32x4 v[2][4];
    int4 t0[2], t1[2];
#pragma unroll
    for (int k = 0; k < 2; ++k) {
      const int r = rr[k];
      if (MODE == 0) {
        const float* src = r < TL ? gin(p, 0) + (size_t)r * DM : gin(p, 2) + (size_t)(r - TL) * DM;
#pragma unroll
        for (int i = 0; i < 4; ++i) v[k][i] = *(const f32x4*)(src + (i * 64 + lane) * 4);
      } else {
        const bf16_t* xr = xrow_ptr(p, ws, r);
#pragma unroll
        for (int i = 0; i < 4; ++i) v[k][i] = ldbf4(xr + (i * 64 + lane) * 4);
        t0[k] = *(const int4*)(tok + (size_t)r * 8);
        t1[k] = *(const int4*)(tok + (size_t)r * 8 + 4);
      }
    }
    if (MODE == 1 || MODE == 3) {
      const int pl = MODE == 3 ? 3 : layer - 1;
      u32x2 ya[2][4], yc[2][4];
#pragma unroll
      for (int k = 0; k < 2; ++k) {
        const size_t d0 = (size_t)(bs[t0[k].x] * MOE_PAD + t0[k].y), d1 = (size_t)(bs[t0[k].z] * MOE_PAD + t0[k].w);
#pragma unroll
        for (int i = 0; i < 4; ++i) { const int ch = (i * 64 + lane) * 4; ya[k][i] = *(const u32x2*)(yb + d0 * DM + ch); yc[k][i] = *(const u32x2*)(yb + d1 * DM + ch); }
      }
#pragma unroll
      for (int k = 0; k < 2; ++k) {
        const float w0 = __int_as_float(t1[k].x), w1 = __int_as_float(t1[k].y);
        const float* g2 = modp(ws, pl, row_bi(rr[k]), 5);
#pragma unroll
        for (int i = 0; i < 4; ++i) {
          const int ch = (i * 64 + lane) * 4;
          const u32x2 a = ya[k][i], b = yc[k][i];
          const f32x4 g = *(const f32x4*)(g2 + ch);
          v[k][i][0] += g[0] * (w0 * bflo(a.x) + w1 * bflo(b.x));
          v[k][i][1] += g[1] * (w0 * bfhi(a.x) + w1 * bfhi(b.x));
          v[k][i][2] += g[2] * (w0 * bflo(a.y) + w1 * bflo(b.y));
          v[k][i][3] += g[3] * (w0 * bfhi(a.y) + w1 * bfhi(b.y));
        }
      }
    }
#pragma unroll
    for (int k = 0; k < 2; ++k) {
      if (k == 1 && !hasB) break;
      const int r = rr[k], bi = row_bi(r);
      bf16_t* xr = xrow_ptr(p, ws, r);
      if ((MODE == 0 || MODE == 1) && !DRY) {
#pragma unroll
        for (int i = 0; i < 4; ++i) stbf4(xr + (i * 64 + lane) * 4, v[k][i]);
      }
      float ss = 0.f;
#pragma unroll
      for (int i = 0; i < 4; ++i) ss += v[k][i][0] * v[k][i][0] + v[k][i][1] * v[k][i][1] + v[k][i][2] * v[k][i][2] + v[k][i][3] * v[k][i][3];
      ss = wave_sum(ss);
      const float rs = rsqrtf(ss * (1.0f / 1024.0f) + 1e-6f);
      if (MODE == 3) {
#pragma unroll
        for (int i = 0; i < 4; ++i) {
          const int ch = (i * 64 + lane) * 4;
          const f32x4 g = *(const f32x4*)(gin(p, 7) + ch);
          f32x4 o; o[0] = v[k][i][0] * rs * g[0]; o[1] = v[k][i][1] * rs * g[1]; o[2] = v[k][i][2] * rs * g[2]; o[3] = v[k][i][3] * rs * g[3];
          if (!DRY) *(f32x4*)(gout(p) + (size_t)r * DM + ch) = o; else asm volatile("" :: "v"(o[0]), "v"(o[1]), "v"(o[2]), "v"(o[3]));
        }
      } else {
        const float* gn = gin(p, 6) + (size_t)(layer * 2 + 0) * DM;
        const float* sh = modp(ws, layer, bi, 0);
        const float* sc = modp(ws, layer, bi, 1);
#pragma unroll
        for (int i = 0; i < 4; ++i) {
          const int ch = (i * 64 + lane) * 4;
          const f32x4 g = *(const f32x4*)(gn + ch), s1 = *(const f32x4*)(sc + ch), s0 = *(const f32x4*)(sh + ch);
          float o[4];
#pragma unroll
          for (int j = 0; j < 4; ++j) o[j] = v[k][i][j] * rs * g[j] * (1.0f + s1[j]) + s0[j];
          if constexpr (OUT8) {
            const unsigned w8 = pk4_fp8(o[0] * X8_SCALE, o[1] * X8_SCALE, o[2] * X8_SCALE, o[3] * X8_SCALE);
            if (!DRY) *(unsigned*)((unsigned char*)(ws + OFF_H8) + (size_t)r * DM + ch) = w8; else asm volatile("" :: "v"(w8));
          } else {
            u32x2 w; w.x = pk2(o[0], o[1]); w.y = pk2(o[2], o[3]);
            if (!DRY) *(u32x2*)(hb + (size_t)r * DM + ch) = w; else asm volatile("" :: "v"(w.x), "v"(w.y));
          }
        }
      }
    }
  }
}

constexpr int R2_TLD = 1032;
constexpr int R2_LLD = 49;
constexpr int R2_LDS = 64 * R2_TLD * 2 + 64 * R2_LLD * 4;
template <bool DRY = false>
DI void phase_norm2_router(KP p, int layer, char* smem) {
  char* const ws = ows(p);
  const int tid = otid(), lane = tid & 63, wid = tid >> 6, fr = lane & 15, fq = lane >> 4;
  bf16_t* tile = (bf16_t*)smem;
  float* lgt = (float*)(smem + 64 * R2_TLD * 2);
  const int nrows = layer == 3 ? TL : TT;
  unsigned char* h8 = (unsigned char*)(ws + OFF_H8);
  int* tok = (int*)(ws + OFF_TOK);
  int* rowl = (int*)(ws + OFF_ROWL);
  int* cnt = (int*)(ws + OFF_CNT) + layer * 32;
  const float* bg = gin(p, 35) + layer * 4;
  const float* be = gin(p, 37) + layer * 32;
  const float* gn = gin(p, 6) + (size_t)(layer * 2 + 1) * DM;
  const bf16_t* wrh = (const bf16_t*)(ws + OFF_WR) + (size_t)layer * 2 * 48 * 1024;
  const bf16_t* wrl = wrh + 48 * 1024;
  bf16x8 bh[4][3], bl[4][3];
#pragma unroll
  for (int ks = 0; ks < 4; ++ks)
#pragma unroll
    for (int nt = 0; nt < 3; ++nt) {
      const size_t o = (size_t)(nt * 16 + fr) * 1024 + wid * 128 + ks * 32 + fq * 8;
      bh[ks][nt] = *(const bf16x8*)(wrh + o); bl[ks][nt] = *(const bf16x8*)(wrl + o);
    }
  for (int rbase = obid() * 64; rbase < nrows; rbase += gridDim.x * 64) {
    const int bi = row_bi(rbase);
    const float* sh = modp(ws, layer, bi, 3);
    const float* sc = modp(ws, layer, bi, 4);
    f32x4 gs[4], s0[4];
#pragma unroll
    for (int i = 0; i < 4; ++i) {
      const int ch = (i * 64 + lane) * 4;
      const f32x4 g = *(const f32x4*)(gn + ch), s1 = *(const f32x4*)(sc + ch);
      gs[i] = g * (1.0f + s1); s0[i] = *(const f32x4*)(sh + ch);
    }
#pragma unroll 2
    for (int q = 0; q < 8; ++q) {
      const int lr = wid * 8 + q, r = rbase + lr;
      const bf16_t* xr = xrow_ptr(p, ws, r);
      f32x4 v[4];
      float ss = 0.f;
#pragma unroll
      for (int i = 0; i < 4; ++i) { v[i] = ldbf4(xr + (i * 64 + lane) * 4); ss += v[i][0] * v[i][0] + v[i][1] * v[i][1] + v[i][2] * v[i][2] + v[i][3] * v[i][3]; }
      ss = wave_sum(ss);
      const float rs = rsqrtf(ss * (1.0f / 1024.0f) + 1e-6f);
#pragma unroll
      for (int i = 0; i < 4; ++i) {
        const int ch = (i * 64 + lane) * 4;
        const f32x4 o = v[i] * rs * gs[i] + s0[i];
        u32x2 w; w.x = pk2(o[0], o[1]); w.y = pk2(o[2], o[3]);
        *(unsigned*)(h8 + (size_t)r * DM + ch) = pk4_fp8(o[0], o[1], o[2], o[3]);
        *(u32x2*)(tile + lr * R2_TLD + ch) = w;
      }
    }
    __syncthreads();
    {
      f32x4 acc[4][3];
#pragma unroll
      for (int rt = 0; rt < 4; ++rt)
#pragma unroll
        for (int nt = 0; nt < 3; ++nt) acc[rt][nt] = (f32x4){0.f, 0.f, 0.f, 0.f};
#pragma unroll
      for (int ks = 0; ks < 4; ++ks)
#pragma unroll
        for (int rt = 0; rt < 4; ++rt) {
          const bf16x8 a = *(const bf16x8*)(tile + (rt * 16 + fr) * R2_TLD + wid * 128 + ks * 32 + fq * 8);
#pragma unroll
          for (int nt = 0; nt < 3; ++nt) { acc[rt][nt] = MFMA16(a, bh[ks][nt], acc[rt][nt]); acc[rt][nt] = MFMA16(a, bl[ks][nt], acc[rt][nt]); }
        }
      __syncthreads();
      float* part = (float*)smem + wid * 64 * R2_LLD;
#pragma unroll
      for (int rt = 0; rt < 4; ++rt)
#pragma unroll
        for (int nt = 0; nt < 3; ++nt)
#pragma unroll
          for (int j = 0; j < 4; ++j) part[(rt * 16 + fq * 4 + j) * R2_LLD + nt * 16 + fr] = acc[rt][nt][j];
    }
    __syncthreads();
    for (int i = tid; i < 64 * 36; i += NTH) {
      const int row = i / 36, col = i - row * 36;
      const float* pp = (const float*)smem + row * R2_LLD + col;
      float sacc = 0.f;
#pragma unroll
      for (int w = 0; w < 8; ++w) sacc += pp[w * 64 * R2_LLD];
      lgt[row * R2_LLD + col] = sacc;
    }
    __syncthreads();
    if (wid == 0) {
      const int r = rbase + lane;
      float* lr_ = lgt + lane * R2_LLD;
      float lg[4];
#pragma unroll
      for (int q = 0; q < 4; ++q) lg[q] = lr_[q] + bg[q];
      int gsel = 0; float gm = lg[0];
#pragma unroll
      for (int q = 1; q < 4; ++q) if (lg[q] > gm) { gm = lg[q]; gsel = q; }
      float gden = 0.f;
#pragma unroll
      for (int q = 0; q < 4; ++q) gden += __expf(lg[q] - gm);
      const float pgrp = 1.0f / gden;
      float le[8];
#pragma unroll
      for (int q = 0; q < 8; ++q) le[q] = lr_[4 + gsel * 8 + q] + be[gsel * 8 + q];
      int i0 = 0; float m0 = le[0];
#pragma unroll
      for (int q = 1; q < 8; ++q) if (le[q] > m0) { m0 = le[q]; i0 = q; }
      int i1 = -1; float m1 = -3.0e38f;
#pragma unroll
      for (int q = 0; q < 8; ++q) if (q != i0 && le[q] > m1) { m1 = le[q]; i1 = q; }
      const float e1 = __expf(m1 - m0);
      const float w0 = pgrp / (1.0f + e1), w1 = pgrp * e1 / (1.0f + e1);
      if (DRY) asm volatile("" :: "v"(w0), "v"(w1), "v"(i0), "v"(i1), "v"(gsel));
      if (!DRY) {
        const int ea = gsel * 8 + i0, eb = gsel * 8 + i1;
        const int pa = atomicAdd(&cnt[ea], 1), pb = atomicAdd(&cnt[eb], 1);
        rowl[(size_t)ea * CAP + pa] = r; rowl[(size_t)eb * CAP + pb] = r;
        int4 t0; t0.x = ea; t0.y = pa; t0.z = eb; t0.w = pb;
        int4 t1; t1.x = __float_as_int(w0); t1.y = __float_as_int(w1); t1.z = 0; t1.w = 0;
        *(int4*)(tok + (size_t)r * 8) = t0; *(int4*)(tok + (size_t)r * 8 + 4) = t1;
      }
    }
  }
}

DI void st_bf16x4(bf16_t* p, const f32x4& v) { u32x2 w; w.x = pk2(v[0], v[1]); w.y = pk2(v[2], v[3]); *(u32x2*)p = w; }
constexpr int FG_LDS = fg::STAGE_BYTES;
constexpr int MOE_UMAX = 12;

struct MoeSched {
  const char* A; const char* B; const LAS int* bs; const LAS int* rowtab; int G, c, ntile; size_t tA, eB, tB;
  DI bool next(int i, fg::Unit& u) const {
    const int rt = (G & 31) ? (i * G + c) >> 2 : i * (G >> 2) + (c & 7) * (G >> 5) + (c >> 5), ct = (G & 31) ? (i * G + c) & 3 : (c >> 3) & 3;
    if (rt >= ntile) return false;
    int e = 0;
#pragma unroll 1
    while (e < 31 && bs[e + 1] <= rt) ++e;
    u.pm = rt; u.pn = ct; u.aux = e; u.A = A + (size_t)rt * tA; u.B = B + (size_t)e * eB + (size_t)ct * tB; return true;
  }
  DI const LAS int* rows(int i) const { return rowtab + i * 256; }
};
DI void phase_moe_up(KP p, int layer, char* smem) {
  char* const ws = ows(p);
  LAS unsigned char* lds = (LAS unsigned char*)smem;
  LAS int* rowtab = (LAS int*)(lds + FG_LDS);
  int* bs = (int*)(smem + FG_LDS + MOE_UMAX * 1024);
  moe_blkstart(ws, layer, bs);
  const int* cnt = (const int*)(ws + OFF_CNT) + layer * 32;
  const int* rowl = (const int*)(ws + OFF_ROWL);
  unsigned char* act8 = (unsigned char*)(ws + OFF_U + UM_ACT);
  MoeSched S;
  S.A = ws + OFF_H8; S.B = ws + OFF_WMOE; S.bs = (const LAS int*)bs; S.rowtab = rowtab; S.G = gridDim.x; S.c = obid(); S.ntile = bs[32];
  S.tA = 0; S.eB = (size_t)1024 * 1024; S.tB = (size_t)256 * 1024;
  {
    const int tid = otid();
    fg::Unit u;
    for (int i = 0; i < MOE_UMAX && S.next(i, u); ++i) {
      if (tid < 256) {
        const int e = u.aux, pos = (u.pm - bs[e]) * 256 + tid;
        rowtab[i * 256 + tid] = pos < cnt[e] ? rowl[(size_t)e * CAP + pos] : TT;
      }
    }
    __syncthreads();
  }
  auto ep = [&](const f32x16 (&acc)[2][2][2], const fg::Unit& u, int wr, int wc, int r, int h) {
    constexpr float inv = 1.0f / W8_SCALE;
#pragma unroll
    for (int ai = 0; ai < 2; ++ai)
#pragma unroll
      for (int m = 0; m < 2; ++m) {
        const size_t row = (size_t)u.pm * 256 + ai * 128 + wr * 64 + m * 32 + r;
#pragma unroll
        for (int bj = 0; bj < 2; ++bj) {
          const int acol = ((u.pn * 256 + bj * 128 + wc * 32) >> 5) * 16 + 8 * h;
          float o[8];
#pragma unroll
          for (int i = 0; i < 8; ++i) { const float g = acc[ai][bj][m][i] * inv, uu = acc[ai][bj][m][i + 8] * inv; o[i] = g * __builtin_amdgcn_rcpf(1.0f + __expf(-g)) * uu; }
          u32x2 w8; w8.x = pk4_fp8(o[0] * A8_SCALE, o[1] * A8_SCALE, o[2] * A8_SCALE, o[3] * A8_SCALE); w8.y = pk4_fp8(o[4] * A8_SCALE, o[5] * A8_SCALE, o[6] * A8_SCALE, o[7] * A8_SCALE);
          *(u32x2*)(act8 + row * 512 + acol) = w8;
        }
      }
  };
  fg::gemm_phase_f8<true>(lds, 512, 512, 512, S, ep);
}
DI void phase_moe_down(KP p, int layer, char* smem) {
  char* const ws = ows(p);
  LAS unsigned char* lds = (LAS unsigned char*)smem;
  int* bs = (int*)(smem + FG_LDS + MOE_UMAX * 1024);
  moe_blkstart(ws, layer, bs);
  bf16_t* yb = (bf16_t*)(ws + OFF_U + UM_YB);
  MoeSched S;
  S.A = ws + OFF_U + UM_ACT; S.B = ws + OFF_WMOE + WMOE_DOWN * 2; S.bs = (const LAS int*)bs; S.rowtab = nullptr; S.G = gridDim.x; S.c = obid(); S.ntile = bs[32];
  S.tA = (size_t)256 * 512; S.eB = (size_t)1024 * 512; S.tB = (size_t)256 * 512;
  auto ep = [&](const f32x16 (&acc)[2][2][2], const fg::Unit& u, int wr, int wc, int r, int h) {
    constexpr float inv = 1.0f / (A8_SCALE * WD8_SCALE);
#pragma unroll
    for (int ai = 0; ai < 2; ++ai)
#pragma unroll
      for (int m = 0; m < 2; ++m) {
        const size_t row = (size_t)u.pm * 256 + ai * 128 + wr * 64 + m * 32 + r;
#pragma unroll
        for (int bj = 0; bj < 2; ++bj) {
          const f32x16& a = acc[ai][bj][m];
          u32x4 w0, w1;
          w0.x = pk2(a[0] * inv, a[1] * inv); w0.y = pk2(a[2] * inv, a[3] * inv); w0.z = pk2(a[4] * inv, a[5] * inv); w0.w = pk2(a[6] * inv, a[7] * inv);
          w1.x = pk2(a[8] * inv, a[9] * inv); w1.y = pk2(a[10] * inv, a[11] * inv); w1.z = pk2(a[12] * inv, a[13] * inv); w1.w = pk2(a[14] * inv, a[15] * inv);
          bf16_t* q = yb + row * DM + u.pn * 256 + bj * 128 + wc * 32 + 16 * h;
          *(u32x4*)q = w0; *(u32x4*)(q + 8) = w1;
        }
      }
  };
  fg::gemm_phase_f8<false, true>(lds, 256, 256, 256, S, ep);
}

template <int NKC>
DI void phase_qkv(KP p, const bf16_t* Wt, bf16_t* Q, bf16_t* Kb, bf16_t* Vb, char* smem) {
  char* const ws = ows(p);
  LAS unsigned char* lds = (LAS unsigned char*)smem;
  constexpr int N = 1024 + 2 * NKC;
  const float* rc = (const float*)(ws + OFF_ROPE);
  fg::DenseSched S;
  S.A = ws + OFF_H; S.B = (const char*)Wt; S.nM = TT / 256; S.nN = N / 256; S.G = gridDim.x; S.c = obid(); S.tA = (size_t)256 * 1024 * 2; S.tB = (size_t)256 * 1024 * 2;
  auto ep = [&](const f32x4 (&acc)[2][2][4][2], const fg::Unit& u, int wr, int wc, int fr, int fq) {
#pragma unroll
    for (int bj = 0; bj < 2; ++bj) {
      const int colb = u.pn * 256 + bj * 128 + wc * 32;
      if (colb < 1024 + NKC) {
        const bool isq = colb < 1024;
        bf16_t* dst = isq ? Q : Kb;
        const int ldd = isq ? 1024 : NKC, cc2 = (isq ? colb : colb - 1024) + 8 * fq;
        const float qs = isq ? 0.125f : 1.0f;
#pragma unroll
        for (int ai = 0; ai < 2; ++ai)
#pragma unroll
          for (int m = 0; m < 4; ++m) {
            const int row = u.pm * 256 + ai * 128 + wr * 64 + m * 16 + fr;
            f32x4 x0 = acc[ai][bj][m][0], x1 = acc[ai][bj][m][1];
            if (row < TL) {
              const int s = row & 4095, idx = (colb & 32) ? (s & 63) : (s >> 6);
              const f32x4 c = *(const f32x4*)(rc + idx * 16 + 4 * fq), sn = *(const f32x4*)(rc + 1024 + idx * 16 + 4 * fq);
              const f32x4 o0 = x0 * c - x1 * sn, o1 = x1 * c + x0 * sn;
              x0 = o0; x1 = o1;
            }
            const f32x4 y0 = x0 * qs, y1 = x1 * qs;
            if (NKC == 1024 && !isq) {
              u32x2 w8; w8.x = pk4_fp8(y0[0], y0[1], y0[2], y0[3]); w8.y = pk4_fp8(y1[0], y1[1], y1[2], y1[3]);
              *(u32x2*)((unsigned char*)Kb + (size_t)row * 1024 + cc2) = w8;
            } else {
              u32x4 w; w.x = pk2(y0[0], y0[1]); w.y = pk2(y0[2], y0[3]); w.z = pk2(y1[0], y1[1]); w.w = pk2(y1[2], y1[3]);
              *(u32x4*)(dst + (size_t)row * ldd + cc2) = w;
            }
          }
      } else {
        const int cv = colb - (1024 + NKC) + 4 * fq;
        if constexpr (NKC == 1024) {
          unsigned char* Vt = (unsigned char*)Vb;
          const int tq = fr & 3;
#pragma unroll
          for (int ai = 0; ai < 2; ++ai)
#pragma unroll
            for (int m = 0; m < 4; ++m) {
              const int row = u.pm * 256 + ai * 128 + wr * 64 + m * 16 + fr, rowq = row & ~3;
              size_t base; int kq;
              if (rowq < TL) { const int b = rowq >> 12, s0 = rowq & 4095; base = (size_t)b * 1024 * 4096 + (size_t)(s0 >> 6) * 64; kq = (s0 & 63) >> 2; }
              else { const int rc2 = rowq - TL, b = rc2 >> 8, c0 = rc2 & 255; base = (size_t)16 * 1024 * 4096 + (size_t)b * 1024 * 256 + (size_t)(c0 >> 6) * 64; kq = (c0 & 63) >> 2; }
              const size_t rstride = rowq < TL ? 4096 : 256;
              const int pos = 32 * (kq & 1) + 16 * (kq >> 3) + 4 * ((kq >> 1) & 3);
#pragma unroll
              for (int n = 0; n < 2; ++n) {
                const f32x4 a = acc[ai][bj][m][n];
                const int d = (int)pk4_fp8(a[0], a[1], a[2], a[3]);
                const int d0 = __builtin_amdgcn_update_dpp(0, d, 0x00, 0xF, 0xF, true), d1 = __builtin_amdgcn_update_dpp(0, d, 0x55, 0xF, 0xF, true);
                const int d2 = __builtin_amdgcn_update_dpp(0, d, 0xAA, 0xF, 0xF, true), d3 = __builtin_amdgcn_update_dpp(0, d, 0xFF, 0xF, 0xF, true);
                const int sh = 8 * tq;
                const unsigned w = ((unsigned)(d0 >> sh) & 0xffu) | (((unsigned)(d1 >> sh) & 0xffu) << 8) | (((unsigned)(d2 >> sh) & 0xffu) << 16) | (((unsigned)(d3 >> sh) & 0xffu) << 24);
                *(unsigned*)(Vt + base + (size_t)(cv + 16 * n + tq) * rstride + pos) = w;
              }
            }
        } else {
#pragma unroll
          for (int ai = 0; ai < 2; ++ai)
#pragma unroll
            for (int m = 0; m < 4; ++m) {
              const int row = u.pm * 256 + ai * 128 + wr * 64 + m * 16 + fr;
              st_bf16x4(Vb + (size_t)row * NKC + cv, acc[ai][bj][m][0]);
              st_bf16x4(Vb + (size_t)row * NKC + cv + 16, acc[ai][bj][m][1]);
            }
        }
      }
    }
  };
  fg::gemm_phase<false>(lds, 1024, 1024, 1024, S, ep);
}

DI void phase_qkv_diff8(KP p, char* smem) {
  char* const ws = ows(p);
  LAS unsigned char* lds = (LAS unsigned char*)smem;
  const float* rc = (const float*)(ws + OFF_ROPE);
  bf16_t* Q = (bf16_t*)(ws + OFF_U + U1_Q);
  unsigned char* K8 = (unsigned char*)(ws + OFF_U + U1_K);
  unsigned char* Vt = (unsigned char*)(ws + OFF_U + U1_V);
  fg::DenseSched S;
  S.A = ws + OFF_H8; S.B = ws + OFF_WMIX + W_DIFFQKV * 2; S.nM = TT / 256; S.nN = 12; S.G = gridDim.x; S.c = obid(); S.tA = (size_t)256 * 1024; S.tB = (size_t)256 * 1024;
  auto ep = [&](const f32x16 (&acc)[2][2][2], const fg::Unit& u, int wr, int wc, int r, int h) {
    constexpr float inv = 1.0f / (X8_SCALE * 32.0f);
#pragma unroll
    for (int bj = 0; bj < 2; ++bj) {
      const int colb = u.pn * 256 + bj * 128 + wc * 32;
      if (colb < 2048) {
        const bool isq = colb < 1024;
        const float qs = (isq ? 0.125f : 1.0f) * inv;
#pragma unroll
        for (int ai = 0; ai < 2; ++ai)
#pragma unroll
          for (int m = 0; m < 2; ++m) {
            const int row = u.pm * 256 + ai * 128 + wr * 64 + m * 32 + r;
            const f32x16& a = acc[ai][bj][m];
            float y[16];
            if (row < TL) {
              const int s = row & 4095, idx = (colb & 32) ? (s & 63) : (s >> 6);
              const f32x4 c0 = *(const f32x4*)(rc + idx * 16 + 4 * h), c1 = *(const f32x4*)(rc + idx * 16 + 8 + 4 * h);
              const f32x4 s0 = *(const f32x4*)(rc + 1024 + idx * 16 + 4 * h), s1 = *(const f32x4*)(rc + 1024 + idx * 16 + 8 + 4 * h);
#pragma unroll
              for (int i = 0; i < 8; ++i) {
                const float cc = i < 4 ? c0[i & 3] : c1[i & 3], sn = i < 4 ? s0[i & 3] : s1[i & 3];
                y[i] = (a[i] * cc - a[i + 8] * sn) * qs; y[i + 8] = (a[i + 8] * cc + a[i] * sn) * qs;
              }
            } else {
#pragma unroll
              for (int i = 0; i < 16; ++i) y[i] = a[i] * qs;
            }
            if (isq) {
              u32x4 w0, w1;
              w0.x = pk2(y[0], y[1]); w0.y = pk2(y[2], y[3]); w0.z = pk2(y[4], y[5]); w0.w = pk2(y[6], y[7]);
              w1.x = pk2(y[8], y[9]); w1.y = pk2(y[10], y[11]); w1.z = pk2(y[12], y[13]); w1.w = pk2(y[14], y[15]);
              bf16_t* q = Q + (size_t)row * 1024 + colb + 16 * h;
              *(u32x4*)q = w0; *(u32x4*)(q + 8) = w1;
            } else {
              u32x4 w8;
              w8.x = pk4_fp8(y[0], y[1], y[2], y[3]); w8.y = pk4_fp8(y[4], y[5], y[6], y[7]); w8.z = pk4_fp8(y[8], y[9], y[10], y[11]); w8.w = pk4_fp8(y[12], y[13], y[14], y[15]);
              *(u32x4*)(K8 + (size_t)row * 1024 + (colb - 1024) + 16 * h) = w8;
            }
          }
      } else {
        const int cv = colb - 2048 + 4 * h, tq = r & 3;
#pragma unroll
        for (int ai = 0; ai < 2; ++ai)
#pragma unroll
          for (int m = 0; m < 2; ++m) {
            const int row = u.pm * 256 + ai * 128 + wr * 64 + m * 32 + r, rowq = row & ~3;
            size_t base; int kq;
            if (rowq < TL) { const int b = rowq >> 12, s0 = rowq & 4095; base = (size_t)b * 1024 * 4096 + (size_t)(s0 >> 6) * 64; kq = (s0 & 63) >> 2; }
            else { const int rc2 = rowq - TL, b = rc2 >> 8, c0 = rc2 & 255; base = (size_t)16 * 1024 * 4096 + (size_t)b * 1024 * 256 + (size_t)(c0 >> 6) * 64; kq = (c0 & 63) >> 2; }
            const size_t rstride = rowq < TL ? 4096 : 256;
            const int pos = 32 * (kq & 1) + 16 * (kq >> 3) + 4 * ((kq >> 1) & 3);
            const f32x16& a = acc[ai][bj][m];
#pragma unroll
            for (int g = 0; g < 4; ++g) {
              const int d = (int)pk4_fp8(a[4 * g] * inv, a[4 * g + 1] * inv, a[4 * g + 2] * inv, a[4 * g + 3] * inv);
              const int d0 = __builtin_amdgcn_update_dpp(0, d, 0x00, 0xF, 0xF, true), d1 = __builtin_amdgcn_update_dpp(0, d, 0x55, 0xF, 0xF, true);
              const int d2 = __builtin_amdgcn_update_dpp(0, d, 0xAA, 0xF, 0xF, true), d3 = __builtin_amdgcn_update_dpp(0, d, 0xFF, 0xF, 0xF, true);
              const int sh = 8 * tq;
              const unsigned w = ((unsigned)(d0 >> sh) & 0xffu) | (((unsigned)(d1 >> sh) & 0xffu) << 8) | (((unsigned)(d2 >> sh) & 0xffu) << 16) | (((unsigned)(d3 >> sh) & 0xffu) << 24);
              *(unsigned*)(Vt + base + (size_t)(cv + 8 * g + tq) * rstride + pos) = w;
            }
          }
      }
    }
  };
  fg::gemm_phase_f8<false, false>(lds, 512, 512, 512, S, ep);
}

DI void phase_qkv_win8(KP p, char* smem) {
  char* const ws = ows(p);
  LAS unsigned char* lds = (LAS unsigned char*)smem;
  const float* rc = (const float*)(ws + OFF_ROPE);
  bf16_t* Q = (bf16_t*)(ws + OFF_U + U0_Q);
  bf16_t* Kb = (bf16_t*)(ws + OFF_U + U0_K);
  bf16_t* Vb = (bf16_t*)(ws + OFF_U + U0_V);
  fg::DenseSched S;
  S.A = ws + OFF_H8; S.B = ws + OFF_WMIX + W_WINQKV * 2; S.nM = TT / 256; S.nN = 6; S.G = gridDim.x; S.c = obid(); S.tA = (size_t)256 * 1024; S.tB = (size_t)256 * 1024;
  auto ep = [&](const f32x16 (&acc)[2][2][2], const fg::Unit& u, int wr, int wc, int r, int h) {
    constexpr float inv = 1.0f / (X8_SCALE * 32.0f);
#pragma unroll
    for (int bj = 0; bj < 2; ++bj) {
      const int colb = u.pn * 256 + bj * 128 + wc * 32;
      if (colb < 1280) {
        const bool isq = colb < 1024;
        const float qs = (isq ? 0.125f : 1.0f) * inv;
        bf16_t* dst = isq ? Q + colb + 16 * h : Kb + (colb - 1024) + 16 * h;
        const int ldd = isq ? 1024 : 256;
#pragma unroll
        for (int ai = 0; ai < 2; ++ai)
#pragma unroll
          for (int m = 0; m < 2; ++m) {
            const int row = u.pm * 256 + ai * 128 + wr * 64 + m * 32 + r;
            const f32x16& a = acc[ai][bj][m];
            float y[16];
            if (row < TL) {
              const int s = row & 4095, idx = (colb & 32) ? (s & 63) : (s >> 6);
              const f32x4 c0 = *(const f32x4*)(rc + idx * 16 + 4 * h), c1 = *(const f32x4*)(rc + idx * 16 + 8 + 4 * h);
              const f32x4 s0 = *(const f32x4*)(rc + 1024 + idx * 16 + 4 * h), s1 = *(const f32x4*)(rc + 1024 + idx * 16 + 8 + 4 * h);
#pragma unroll
              for (int i = 0; i < 8; ++i) {
                const float cc = i < 4 ? c0[i & 3] : c1[i & 3], sn = i < 4 ? s0[i & 3] : s1[i & 3];
                y[i] = (a[i] * cc - a[i + 8] * sn) * qs; y[i + 8] = (a[i + 8] * cc + a[i] * sn) * qs;
              }
            } else {
#pragma unroll
              for (int i = 0; i < 16; ++i) y[i] = a[i] * qs;
            }
            u32x4 w0, w1;
            w0.x = pk2(y[0], y[1]); w0.y = pk2(y[2], y[3]); w0.z = pk2(y[4], y[5]); w0.w = pk2(y[6], y[7]);
            w1.x = pk2(y[8], y[9]); w1.y = pk2(y[10], y[11]); w1.z = pk2(y[12], y[13]); w1.w = pk2(y[14], y[15]);
            bf16_t* q = dst + (size_t)row * ldd;
            *(u32x4*)q = w0; *(u32x4*)(q + 8) = w1;
          }
      } else {
        const int cv = colb - 1280 + 4 * h;
#pragma unroll
        for (int ai = 0; ai < 2; ++ai)
#pragma unroll
          for (int m = 0; m < 2; ++m) {
            const int row = u.pm * 256 + ai * 128 + wr * 64 + m * 32 + r;
            const f32x16& a = acc[ai][bj][m];
#pragma unroll
            for (int g = 0; g < 4; ++g) {
              f32x4 v4; v4[0] = a[4 * g] * inv; v4[1] = a[4 * g + 1] * inv; v4[2] = a[4 * g + 2] * inv; v4[3] = a[4 * g + 3] * inv;
              st_bf16x4(Vb + (size_t)row * 256 + cv + 8 * g, v4);
            }
          }
      }
    }
  };
  fg::gemm_phase_f8<false, false>(lds, 512, 512, 512, S, ep);
}

template <bool DRY = false>
DI void phase_oproj(KP p, int layer, const bf16_t* A, const bf16_t* Wt, int nrows, char* smem) {
  char* const ws = ows(p);
  LAS unsigned char* lds = (LAS unsigned char*)smem;
  fg::DenseSched S;
  S.A = (const char*)A; S.B = (const char*)Wt; S.nM = nrows / 256; S.nN = 4; S.G = gridDim.x; S.c = obid(); S.tA = (size_t)256 * 1024 * 2; S.tB = (size_t)256 * 1024 * 2;
  auto ep = [&](const f32x4 (&acc)[2][2][4][2], const fg::Unit& u, int wr, int wc, int fr, int fq) {
    const int row0 = u.pm * 256 + wr * 64 + fr, colb = u.pn * 256 + wc * 32 + 4 * fq;
    const float* g1 = modp(ws, layer, row_bi(row0), 2) + colb;
    f32x4 g[2][2];
#pragma unroll
    for (int bj = 0; bj < 2; ++bj)
#pragma unroll
      for (int n = 0; n < 2; ++n) g[bj][n] = *(const f32x4*)(g1 + bj * 128 + n * 16);
    f32x4 xa[2][2], xb[2][2];
    bf16_t* xr = xrow_ptr(p, ws, row0) + colb;
#pragma unroll
    for (int bj = 0; bj < 2; ++bj)
#pragma unroll
      for (int n = 0; n < 2; ++n) xa[bj][n] = ldbf4(xr + bj * 128 + n * 16);
#pragma unroll
    for (int rr = 0; rr < 8; ++rr) {
      const int ai = rr >> 2, m = rr & 3;
      bf16_t* xn = xr;
      if (rr + 1 < 8) {
        xn = xrow_ptr(p, ws, row0 + ((rr + 1) >> 2) * 128 + ((rr + 1) & 3) * 16) + colb;
#pragma unroll
        for (int bj = 0; bj < 2; ++bj)
#pragma unroll
          for (int n = 0; n < 2; ++n) xb[bj][n] = ldbf4(xn + bj * 128 + n * 16);
      }
#pragma unroll
      for (int bj = 0; bj < 2; ++bj)
#pragma unroll
        for (int n = 0; n < 2; ++n) {
          const f32x4 x = xa[bj][n] + g[bj][n] * acc[ai][bj][m][n];
          if (!DRY) stbf4(xr + bj * 128 + n * 16, x); else asm volatile("" :: "v"(x[0]), "v"(x[1]), "v"(x[2]), "v"(x[3]));
        }
#pragma unroll
      for (int bj = 0; bj < 2; ++bj)
#pragma unroll
        for (int n = 0; n < 2; ++n) xa[bj][n] = xb[bj][n];
      xr = xn;
    }
  };
  fg::gemm_phase<false>(lds, 1024, 1024, 1024, S, ep);
}

template <bool DRY = false>
DI void phase_oproj8(KP p, int layer, const char* A8, const char* W8, int nrows, char* smem) {
  char* const ws = ows(p);
  LAS unsigned char* lds = (LAS unsigned char*)smem;
  fg::DenseSched S;
  S.A = A8; S.B = W8; S.nM = nrows / 256; S.nN = 4; S.G = gridDim.x; S.c = obid(); S.tA = (size_t)256 * 1024; S.tB = (size_t)256 * 1024;
  auto ep = [&](const f32x16 (&acc)[2][2][2], const fg::Unit& u, int wr, int wc, int r, int h) {
    constexpr float inv = 1.0f / (O8_SCALE * 32.0f);
    const int row0 = u.pm * 256 + wr * 64 + r, colb = u.pn * 256 + wc * 32 + 16 * h;
    const float* g1 = modp(ws, layer, row_bi(row0), 2) + colb;
#pragma unroll
    for (int bj = 0; bj < 2; ++bj) {
      f32x4 g[4];
#pragma unroll
      for (int q = 0; q < 4; ++q) g[q] = *(const f32x4*)(g1 + bj * 128 + 4 * q) * inv;
#pragma unroll
      for (int ai = 0; ai < 2; ++ai)
#pragma unroll
        for (int m = 0; m < 2; ++m) {
          bf16_t* xr = xrow_ptr(p, ws, row0 + ai * 128 + m * 32) + colb + bj * 128;
          const u32x4 x0 = ld16(xr), x1 = ld16(xr + 8);
          const f32x16& a = acc[ai][bj][m];
          u32x4 w0, w1;
          w0.x = pk2(bflo(x0.x) + g[0][0] * a[0], bfhi(x0.x) + g[0][1] * a[1]); w0.y = pk2(bflo(x0.y) + g[0][2] * a[2], bfhi(x0.y) + g[0][3] * a[3]);
          w0.z = pk2(bflo(x0.z) + g[1][0] * a[4], bfhi(x0.z) + g[1][1] * a[5]); w0.w = pk2(bflo(x0.w) + g[1][2] * a[6], bfhi(x0.w) + g[1][3] * a[7]);
          w1.x = pk2(bflo(x1.x) + g[2][0] * a[8], bfhi(x1.x) + g[2][1] * a[9]); w1.y = pk2(bflo(x1.y) + g[2][2] * a[10], bfhi(x1.y) + g[2][3] * a[11]);
          w1.z = pk2(bflo(x1.z) + g[3][0] * a[12], bfhi(x1.z) + g[3][1] * a[13]); w1.w = pk2(bflo(x1.w) + g[3][2] * a[14], bfhi(x1.w) + g[3][3] * a[15]);
          if (!DRY) { *(u32x4*)xr = w0; *(u32x4*)(xr + 8) = w1; } else asm volatile("" :: "v"(w0), "v"(w1));
        }
    }
  };
  fg::gemm_phase_f8<false, true>(lds, 512, 512, 512, S, ep);
}

DI void phase_pool_pre(KP p, char* smem) {
  char* const ws = ows(p);
  const int lane = otid() & 63, wid = otid() >> 6;
  const bf16_t* hb = (const bf16_t*)(ws + OFF_H);
  bf16_t* Y = (bf16_t*)(ws + OFF_U + U2_Y);
  const int ch0 = lane * 16, half = 1 << (lane >> 4);
  for (int r = obid() * 8 + wid; r < TT; r += gridDim.x * 8) {
    int s, L;
    if (r < TL) { s = r & 4095; L = 4096; } else { s = (r - TL) & 255; L = 256; }
    const int lo = s - half < 0 ? 0 : s - half, hi = s + half > L ? L : s + half;
    const bf16_t* base = hb + (size_t)(r - s) * DM + ch0;
    float a[16];
#pragma unroll
    for (int j = 0; j < 16; ++j) a[j] = 0.f;
    for (int q = lo; q < hi; ++q) {
      const u32x4 v0 = ld16(base + (size_t)q * DM), v1 = ld16(base + (size_t)q * DM + 8);
      a[0] += bflo(v0.x); a[1] += bfhi(v0.x); a[2] += bflo(v0.y); a[3] += bfhi(v0.y); a[4] += bflo(v0.z); a[5] += bfhi(v0.z); a[6] += bflo(v0.w); a[7] += bfhi(v0.w);
      a[8] += bflo(v1.x); a[9] += bfhi(v1.x); a[10] += bflo(v1.y); a[11] += bfhi(v1.y); a[12] += bflo(v1.z); a[13] += bfhi(v1.z); a[14] += bflo(v1.w); a[15] += bfhi(v1.w);
    }
    const float inv = 1.0f / (float)(hi - lo);
    const u32x4 c0 = ld16(base + (size_t)s * DM), c1 = ld16(base + (size_t)s * DM + 8);
    u32x4 o0, o1;
    o0.x = pk2(a[0] * inv - bflo(c0.x), a[1] * inv - bfhi(c0.x)); o0.y = pk2(a[2] * inv - bflo(c0.y), a[3] * inv - bfhi(c0.y));
    o0.z = pk2(a[4] * inv - bflo(c0.z), a[5] * inv - bfhi(c0.z)); o0.w = pk2(a[6] * inv - bflo(c0.w), a[7] * inv - bfhi(c0.w));
    o1.x = pk2(a[8] * inv - bflo(c1.x), a[9] * inv - bfhi(c1.x)); o1.y = pk2(a[10] * inv - bflo(c1.y), a[11] * inv - bfhi(c1.y));
    o1.z = pk2(a[12] * inv - bflo(c1.z), a[13] * inv - bfhi(c1.z)); o1.w = pk2(a[14] * inv - bflo(c1.w), a[15] * inv - bfhi(c1.w));
    *(u32x4*)(Y + (size_t)r * DM + ch0) = o0; *(u32x4*)(Y + (size_t)r * DM + ch0 + 8) = o1;
  }
}
struct PoolSched {
  const char* A; const char* B; int G, c;
  DI bool next(int i, fg::Unit& u) const {
    const int L = i * G + c; if (L >= (TT / 256) * 4) return false;
    const int pm = L >> 2, g = L & 3;
    u.pm = pm; u.pn = g; u.aux = 0; u.A = A + ((size_t)pm * 256 * 1024 + g * 256) * 2; u.B = B + (size_t)g * 65536 * 2; return true;
  }
  DI const LAS int* rows(int) const { return nullptr; }
};
template <bool DRY = false>
DI void phase_pool(KP p, char* smem) {
  char* const ws = ows(p);
  LAS unsigned char* lds = (LAS unsigned char*)smem;
  const float* pb = gin(p, 16);
  const float* psc = gin(p, 17);
  PoolSched S; S.A = ws + OFF_U + U2_Y; S.B = ws + OFF_WMIX + W_POOL * 2; S.G = gridDim.x; S.c = obid();
  auto ep = [&](const f32x4 (&acc)[2][2][4][2], const fg::Unit& u, int wr, int wc, int fr, int fq) {
    const int row0 = u.pm * 256 + wr * 64 + fr, colb = u.pn * 256 + wc * 32 + 4 * fq;
    const float* g1 = modp(ws, 2, row_bi(row0), 2) + colb;
    f32x4 g[2][2], bb[2][2];
#pragma unroll
    for (int bj = 0; bj < 2; ++bj)
#pragma unroll
      for (int n = 0; n < 2; ++n) {
        const f32x4 s4 = *(const f32x4*)(psc + colb + bj * 128 + n * 16);
        g[bj][n] = *(const f32x4*)(g1 + bj * 128 + n * 16) * s4;
        bb[bj][n] = *(const f32x4*)(pb + colb + bj * 128 + n * 16) * g[bj][n];
      }
    f32x4 xa[2][2], xb[2][2];
    bf16_t* xr = xrow_ptr(p, ws, row0) + colb;
#pragma unroll
    for (int bj = 0; bj < 2; ++bj)
#pragma unroll
      for (int n = 0; n < 2; ++n) xa[bj][n] = ldbf4(xr + bj * 128 + n * 16);
#pragma unroll
    for (int rr = 0; rr < 8; ++rr) {
      const int ai = rr >> 2, m = rr & 3;
      bf16_t* xn = xr;
      if (rr + 1 < 8) {
        xn = xrow_ptr(p, ws, row0 + ((rr + 1) >> 2) * 128 + ((rr + 1) & 3) * 16) + colb;
#pragma unroll
        for (int bj = 0; bj < 2; ++bj)
#pragma unroll
          for (int n = 0; n < 2; ++n) xb[bj][n] = ldbf4(xn + bj * 128 + n * 16);
      }
#pragma unroll
      for (int bj = 0; bj < 2; ++bj)
#pragma unroll
        for (int n = 0; n < 2; ++n) {
          const f32x4 x = xa[bj][n] + (g[bj][n] * acc[ai][bj][m][n] + bb[bj][n]);
          if (!DRY) stbf4(xr + bj * 128 + n * 16, x); else asm volatile("" :: "v"(x[0]), "v"(x[1]), "v"(x[2]), "v"(x[3]));
        }
#pragma unroll
      for (int bj = 0; bj < 2; ++bj)
#pragma unroll
        for (int n = 0; n < 2; ++n) xa[bj][n] = xb[bj][n];
      xr = xn;
    }
  };
  fg::gemm_phase<false>(lds, 256, 1024, 256, S, ep);
}

typedef short v4i16_t __attribute__((ext_vector_type(4)));
DI s16x4 tr_read(const bf16_t* p) { return __builtin_bit_cast(s16x4, __builtin_amdgcn_ds_read_tr16_b64_v4i16((LAS v4i16_t*)p)); }
DI bf16x8 pack8(const f32x16& x, int s) {
  u32x4 q;
  q.x = pk2(x[8 * s + 0], x[8 * s + 1]); q.y = pk2(x[8 * s + 2], x[8 * s + 3]);
  q.z = pk2(x[8 * s + 4], x[8 * s + 5]); q.w = pk2(x[8 * s + 6], x[8 * s + 7]);
  return __builtin_bit_cast(bf16x8, q);
}
template <int DT, int VLD_, bool MASK>
DI void attn_tile(const bf16_t* sK, int kld, const bf16_t* vbase, const bf16x8 (&qf)[4], f32x16 (&Y)[DT], float& m, float& l, int r, int h, int qpos, int kpos0) {
  f32x16 X[2];
#pragma unroll
  for (int sub = 0; sub < 2; ++sub) {
#pragma unroll
    for (int i = 0; i < 16; ++i) X[sub][i] = 0.f;
#pragma unroll
    for (int s = 0; s < 4; ++s) {
      const bf16x8 a = *(const bf16x8*)(sK + (sub * 32 + r) * kld + 16 * s + 8 * h);
      X[sub] = MFMA32(a, qf[s], X[sub]);
    }
  }
  if (MASK) {
#pragma unroll
    for (int sub = 0; sub < 2; ++sub)
#pragma unroll
      for (int i = 0; i < 16; ++i) {
        const int kp = kpos0 + sub * 32 + (i & 3) + 8 * (i >> 2) + 4 * h;
        const int d = qpos - kp;
        if (d > 128 || d < -128) X[sub][i] = -1e30f;
      }
  }
  float mx = m;
#pragma unroll
  for (int sub = 0; sub < 2; ++sub)
#pragma unroll
    for (int i = 0; i < 16; ++i) mx = fmaxf(mx, X[sub][i]);
  mx = fmaxf(mx, __shfl_xor(mx, 32));
  const float alpha = __expf(m - mx);
  m = mx;
  float ps = 0.f;
#pragma unroll
  for (int sub = 0; sub < 2; ++sub)
#pragma unroll
    for (int i = 0; i < 16; ++i) { const float pv = __expf(X[sub][i] - mx); X[sub][i] = pv; ps += pv; }
  l = l * alpha + ps;
#pragma unroll
  for (int dt = 0; dt < DT; ++dt)
#pragma unroll
    for (int i = 0; i < 16; ++i) Y[dt][i] *= alpha;
#pragma unroll
  for (int sub = 0; sub < 2; ++sub)
#pragma unroll
    for (int s = 0; s < 2; ++s) {
      const bf16x8 pf = pack8(X[sub], s);
#pragma unroll
      for (int dt = 0; dt < DT; ++dt) {
        const bf16_t* vp = vbase + (sub * 32 + 16 * s) * VLD_ + dt * 32;
        const s16x4 lo = tr_read(vp), hi = tr_read(vp + 8 * VLD_);
        const bf16x8 vf = __builtin_shufflevector(lo, hi, 0, 1, 2, 3, 4, 5, 6, 7);
        Y[dt] = MFMA32(vf, pf, Y[dt]);
      }
    }
}

constexpr int A0_KLD = 72, A0_VLD = 96;
constexpr int A0_LDS = 64 * A0_KLD * 2 + 64 * A0_VLD * 2;
DI void phase_attn_win(KP p, char* smem) {
  char* const ws = ows(p);
  bf16_t* sK = (bf16_t*)smem;
  bf16_t* sV = sK + 64 * A0_KLD;
  const bf16_t* Q = (const bf16_t*)(ws + OFF_U + U0_Q);
  const bf16_t* Kb = (const bf16_t*)(ws + OFF_U + U0_K);
  const bf16_t* Vb = (const bf16_t*)(ws + OFF_U + U0_V);
  bf16_t* O = (bf16_t*)(ws + OFF_U + U0_O);
  const float* sink = gin(p, 9);
  const int tid = otid(), lane = tid & 63, wid = tid >> 6, r = lane & 31, h = lane >> 5;
  const bf16_t* vbase = sV + (4 * h + ((lane & 15) >> 2)) * A0_VLD + 16 * ((lane >> 4) & 1) + 4 * (lane & 3);
  const int NLAT = 16 * 4 * 32 * 2, NCTX = 16 * 16;
  for (int it = obid(); it < NLAT + NCTX; it += gridDim.x) {
    const bool lat = it < NLAT;
    int b, kvh, qb = 0, head, qrow, qpos;
    if (lat) {
      b = it >> 8; kvh = (it >> 6) & 3; qb = (it >> 1) & 31; const int hp = it & 1;
      head = kvh * 4 + hp * 2 + (wid >> 2);
      qpos = qb * 128 + (wid & 3) * 32 + r; qrow = b * 4096 + qpos;
    } else {
      const int i2 = it - NLAT; b = i2 >> 4; head = i2 & 15; kvh = head >> 2;
      qpos = wid * 32 + r; qrow = TL + b * 256 + qpos;
    }
    bf16x8 qf[4];
#pragma unroll
    for (int s = 0; s < 4; ++s) qf[s] = *(const bf16x8*)(Q + (size_t)qrow * DM + head * 64 + 16 * s + 8 * h);
    f32x16 Y[2];
#pragma unroll
    for (int dt = 0; dt < 2; ++dt)
#pragma unroll
      for (int i = 0; i < 16; ++i) Y[dt][i] = 0.f;
    float m = sink[head], l = h == 0 ? 1.0f : 0.0f;
    const int kr = tid >> 3, k8 = (tid & 7) * 8;
    auto tile_ok = [&](int t) -> bool { if (t >= 6) return true; if (!lat) return false; const int kt = 2 * qb - 2 + t; return kt >= 0 && kt < 64; };
    auto trow = [&](int t) -> size_t { return t < 6 ? (size_t)b * 4096 + (2 * qb - 2 + t) * 64 + kr : (size_t)TL + b * 256 + (t - 6) * 64 + kr; };
    int t = 0;
    while (t < 10 && !tile_ok(t)) ++t;
    u32x4 rk = ld16(Kb + trow(t) * 256 + kvh * 64 + k8), rv = ld16(Vb + trow(t) * 256 + kvh * 64 + k8);
    while (t < 10) {
      __syncthreads();
      *(u32x4*)(sK + kr * A0_KLD + k8) = rk;
      *(u32x4*)(sV + kr * A0_VLD + k8) = rv;
      __syncthreads();
      int tn = t + 1;
      while (tn < 10 && !tile_ok(tn)) ++tn;
      if (tn < 10) { rk = ld16(Kb + trow(tn) * 256 + kvh * 64 + k8); rv = ld16(Vb + trow(tn) * 256 + kvh * 64 + k8); }
      if (t < 6) attn_tile<2, A0_VLD, true>(sK, A0_KLD, vbase, qf, Y, m, l, r, h, qpos, (2 * qb - 2 + t) * 64);
      else attn_tile<2, A0_VLD, false>(sK, A0_KLD, vbase, qf, Y, m, l, r, h, 0, 0);
      t = tn;
    }
    const float lt = l + __shfl_xor(l, 32);
    const float inv = 1.0f / lt;
#pragma unroll
    for (int dt = 0; dt < 2; ++dt)
#pragma unroll
      for (int g = 0; g < 4; ++g) {
        u32x2 w; w.x = pk2(Y[dt][4 * g] * inv, Y[dt][4 * g + 1] * inv); w.y = pk2(Y[dt][4 * g + 2] * inv, Y[dt][4 * g + 3] * inv);
        *(u32x2*)(O + (size_t)qrow * DM + head * 64 + dt * 32 + 8 * g + 4 * h) = w;
      }
  }
}

constexpr int A1_KLD = 136, A1_VLD = 160;
constexpr int A1_K8LD = 144;
constexpr int A1_V8LD = 80;
constexpr int A1_KB = 64 * A1_K8LD, A1_VB = 128 * A1_V8LD;
constexpr int A1_LDS = 2 * A1_KB + 2 * A1_VB + 4 * 128 * 32 * 4;
DI void qk_tile(const bf16_t* sK, int kld, const bf16x8 (&qf)[4], f32x16 (&X)[2], int r, int h) {
  bf16x8 kf[2][4];
#pragma unroll
  for (int sub = 0; sub < 2; ++sub)
#pragma unroll
    for (int s = 0; s < 4; ++s) kf[sub][s] = *(const bf16x8*)(sK + (sub * 32 + r) * kld + 16 * s + 8 * h);
#pragma unroll
  for (int sub = 0; sub < 2; ++sub) {
#pragma unroll
    for (int i = 0; i < 16; ++i) X[sub][i] = 0.f;
#pragma unroll
    for (int s = 0; s < 4; ++s) X[sub] = MFMA32(kf[sub][s], qf[s], X[sub]);
  }
}
typedef int v8i_t __attribute__((ext_vector_type(8)));
typedef int v4i_t __attribute__((ext_vector_type(4)));
DI void qk8_tile(const unsigned char* sK8, int kld8, const v8i_t& q8, f32x16 (&X)[2], int r, int h) {
  v8i_t kf[2];
#pragma unroll
  for (int sub = 0; sub < 2; ++sub) { const v4i_t* q_ = (const v4i_t*)(sK8 + (sub * 32 + r) * kld8 + 32 * h); kf[sub] = __builtin_shufflevector(q_[0], q_[1], 0, 1, 2, 3, 4, 5, 6, 7); }
#pragma unroll
  for (int sub = 0; sub < 2; ++sub) {
    f32x16 z;
#pragma unroll
    for (int i = 0; i < 16; ++i) z[i] = 0.f;
    X[sub] = __builtin_amdgcn_mfma_scale_f32_32x32x64_f8f6f4(kf[sub], q8, z, 0, 0, 0, 0x7f7f7f7f, 0, 0x7f7f7f7f);
  }
}
template <int DT, int QSC = 1, int PSH = 0>
DI void softmax_lazy(f32x16 (&X)[2], f32x16 (&Y)[DT], float& m, float& l) {
  constexpr float THR = 4.0f * QSC, L2E = 1.44269504089f / QSC;
  float c0 = X[0][0], c1 = X[0][1], c2 = X[0][2], c3 = X[0][3];
#pragma unroll
  for (int i = 4; i < 16; i += 4) { c0 = fmaxf(c0, X[0][i]); c1 = fmaxf(c1, X[0][i + 1]); c2 = fmaxf(c2, X[0][i + 2]); c3 = fmaxf(c3, X[0][i + 3]); }
#pragma unroll
  for (int i = 0; i < 16; i += 4) { c0 = fmaxf(c0, X[1][i]); c1 = fmaxf(c1, X[1][i + 1]); c2 = fmaxf(c2, X[1][i + 2]); c3 = fmaxf(c3, X[1][i + 3]); }
  float mx = fmaxf(fmaxf(c0, c1), fmaxf(c2, c3));
  { float a, b; swap32(mx, a, b); mx = fmaxf(a, b); }
  if (__builtin_amdgcn_ballot_w64(mx > m + THR) != 0ull) {
    const float mn = fmaxf(m, mx);
    const float alpha = __builtin_amdgcn_exp2f((m - mn) * L2E);
    m = mn; l *= alpha;
#pragma unroll
    for (int dt = 0; dt < DT; ++dt)
#pragma unroll
      for (int i = 0; i < 16; ++i) Y[dt][i] *= alpha;
  }
  const float nm = fmaf(-m, L2E, (float)PSH);
  float ps0 = 0.f, ps1 = 0.f, ps2 = 0.f, ps3 = 0.f;
#pragma unroll
  for (int sub = 0; sub < 2; ++sub)
#pragma unroll
    for (int i = 0; i < 16; i += 4) {
      const float p0 = __builtin_amdgcn_exp2f(fmaf(X[sub][i], L2E, nm)), p1 = __builtin_amdgcn_exp2f(fmaf(X[sub][i + 1], L2E, nm));
      const float p2 = __builtin_amdgcn_exp2f(fmaf(X[sub][i + 2], L2E, nm)), p3 = __builtin_amdgcn_exp2f(fmaf(X[sub][i + 3], L2E, nm));
      X[sub][i] = p0; X[sub][i + 1] = p1; X[sub][i + 2] = p2; X[sub][i + 3] = p3;
      asm("v_add_f32 %0, %1, %0" : "+v"(ps0) : "v"(p0));
      asm("v_add_f32 %0, %1, %0" : "+v"(ps1) : "v"(p1));
      asm("v_add_f32 %0, %1, %0" : "+v"(ps2) : "v"(p2));
      asm("v_add_f32 %0, %1, %0" : "+v"(ps3) : "v"(p3));
    }
  asm("v_add_f32 %0, %1, %0" : "+v"(ps0) : "v"(ps1));
  asm("v_add_f32 %0, %1, %0" : "+v"(ps2) : "v"(ps3));
  l += ps0 + ps2;
}
template <int DT, int VLD_>
DI void pv_tile(const f32x16 (&X)[2], const bf16_t* vbase, f32x16 (&Y)[DT]) {
#pragma unroll
  for (int sub = 0; sub < 2; ++sub)
#pragma unroll
    for (int s = 0; s < 2; ++s) {
      const bf16x8 pf = pack8(X[sub], s);
#pragma unroll
      for (int dt = 0; dt < DT; ++dt) {
        const bf16_t* vp = vbase + (sub * 32 + 16 * s) * VLD_ + dt * 32;
        const s16x4 lo = tr_read(vp), hi = tr_read(vp + 8 * VLD_);
        const bf16x8 vf = __builtin_shufflevector(lo, hi, 0, 1, 2, 3, 4, 5, 6, 7);
        Y[dt] = MFMA32(vf, pf, Y[dt]);
      }
    }
}
DI void phase_attn_diff(KP p, char* smem) {
  char* const ws = ows(p);
  unsigned char* sK = (unsigned char*)smem;
  unsigned char* sV = (unsigned char*)(smem + 2 * A1_KB);
  float* comb = (float*)(smem + 2 * A1_KB + 2 * A1_VB);
  const bf16_t* Q = (const bf16_t*)(ws + OFF_U + U1_Q);
  const unsigned char* K8 = (const unsigned char*)(ws + OFF_U + U1_K);
  const unsigned char* Vt = (const unsigned char*)(ws + OFF_U + U1_V);
  bf16_t* O = (bf16_t*)(ws + OFF_U + U1_O);
  const int tid = otid(), lane = tid & 63, wid = tid >> 6, r = lane & 31, h = lane >> 5, grp = wid >> 2;
  const float lambda_init = 0.8f - 0.6f * 0.74081822068f;
  float lam_full;
  {
    const float* lf = gin(p, 12);
    float s1 = 0.f, s2 = 0.f;
    for (int i = 0; i < 64; ++i) { s1 += lf[i] * lf[64 + i]; s2 += lf[128 + i] * lf[192 + i]; }
    lam_full = expf(s1) - expf(s2) + lambda_init;
  }
  const float* subg = gin(p, 13);
  const int NLAT = 16 * 8 * 32, NCTX = 16 * 8 * 2;
  const int kr = tid >> 3, kc = (tid & 7) * 16;
  for (int it = obid(); it < NLAT + NCTX; it += gridDim.x) {
    const bool lat = it < NLAT;
    int b, head, qrow, t0;
    const int nt = 68;
    if (lat) { b = it >> 8; head = (it >> 5) & 7; const int qb = it & 31; qrow = b * 4096 + qb * 128 + (wid & 3) * 32 + r; t0 = 0; }
    else { const int i2 = it - NLAT; b = i2 >> 4; head = (i2 >> 1) & 7; const int hf = i2 & 1; qrow = TL + b * 256 + hf * 128 + (wid & 3) * 32 + r; t0 = 64; }
    v8i_t q8;
    {
      const bf16_t* qp = Q + (size_t)qrow * DM + head * 128 + grp * 64 + 32 * h;
#pragma unroll
      for (int c4 = 0; c4 < 4; ++c4) {
        const u32x4 w = ld16(qp + 8 * c4);
        q8[2 * c4] = (int)pk4_fp8(bflo(w.x) * 8.f, bfhi(w.x) * 8.f, bflo(w.y) * 8.f, bfhi(w.y) * 8.f);
        q8[2 * c4 + 1] = (int)pk4_fp8(bflo(w.z) * 8.f, bfhi(w.z) * 8.f, bflo(w.w) * 8.f, bfhi(w.w) * 8.f);
      }
    }
    f32x16 Y[4];
#pragma unroll
    for (int dt = 0; dt < 4; ++dt)
#pragma unroll
      for (int i = 0; i < 16; ++i) Y[dt][i] = 0.f;
    float m = -1e30f, l = 0.f;
    auto goff = [&](int t) -> size_t { return (t < 64 ? (size_t)b * 4096 + t * 64 + kr : (size_t)TL + b * 256 + (t - 64) * 64 + kr) * 1024 + head * 128 + kc; };
    auto stK = [&](int t, const u32x4& a) { *(u32x4*)(sK + (t & 1) * A1_KB + kr * A1_K8LD + kc) = a; };
    const int vd = tid >> 2, vcx = (tid & 3) * 16;
    auto voff = [&](int t) -> size_t { return t < 64 ? ((size_t)(b * 1024 + head * 128 + vd) * 4096 + (size_t)t * 64 + vcx) : ((size_t)16 * 1024 * 4096 + (size_t)(b * 1024 + head * 128 + vd) * 256 + (size_t)(t - 64) * 64 + vcx); };
    auto stV = [&](int t, const u32x4& a) { *(u32x4*)(sV + (t & 1) * A1_VB + vd * A1_V8LD + vcx) = a; };
    u32x4 rk0, rv0;
    __syncthreads();
    rk0 = *(const u32x4*)(K8 + goff(t0)); stK(t0, rk0);
    rk0 = *(const u32x4*)(K8 + goff(t0 + 1)); stK(t0 + 1, rk0);
    rk0 = *(const u32x4*)(K8 + goff(t0 + 2));
    rv0 = *(const u32x4*)(Vt + voff(t0));
    __syncthreads();
    f32x16 Xn[2];
    qk8_tile(sK + (t0 & 1) * A1_KB + grp * 64, A1_K8LD, q8, Xn, r, h);
    __syncthreads();
    v8i_t p8;
    auto pv8 = [&](int t) __attribute__((always_inline)) {
      const unsigned char* vb8 = sV + (t & 1) * A1_VB + r * A1_V8LD + 32 * h;
#pragma unroll
      for (int dt = 0; dt < 4; ++dt) {
        const v4i_t* q_ = (const v4i_t*)(vb8 + dt * 32 * A1_V8LD);
        const v8i_t vf = __builtin_shufflevector(q_[0], q_[1], 0, 1, 2, 3, 4, 5, 6, 7);
        Y[dt] = __builtin_amdgcn_mfma_scale_f32_32x32x64_f8f6f4(vf, p8, Y[dt], 0, 0, 0, 0x7f7f7f7f, 0, 0x7f7f7f7f);
      }
    };
    for (int t = t0; t < nt; ++t) {
      if (t + 2 < nt) stK(t + 2, rk0);
      stV(t, rv0);
      if (t + 3 < nt) rk0 = *(const u32x4*)(K8 + goff(t + 3));
      if (t + 1 < nt) rv0 = *(const u32x4*)(Vt + voff(t + 1));
      f32x16 X[2];
      X[0] = Xn[0]; X[1] = Xn[1];
      if (t + 1 < nt) qk8_tile(sK + ((t + 1) & 1) * A1_KB + grp * 64, A1_K8LD, q8, Xn, r, h);
      if (t > t0) pv8(t - 1);
      softmax_lazy<4, 8, 2>(X, Y, m, l);
#pragma unroll
      for (int sub = 0; sub < 2; ++sub)
#pragma unroll
        for (int g4 = 0; g4 < 4; ++g4) p8[4 * sub + g4] = (int)pk4_fp8_nc(X[sub][4 * g4], X[sub][4 * g4 + 1], X[sub][4 * g4 + 2], X[sub][4 * g4 + 3]);
      __syncthreads();
    }
    pv8(nt - 1);
    const float lt = l + __shfl_xor(l, 32);
    const float inv = 1.0f / lt;
    if (grp == 1) {
#pragma unroll
      for (int dt = 0; dt < 4; ++dt)
#pragma unroll
        for (int i = 0; i < 16; ++i) comb[(((wid & 3) * 128) + dt * 32 + (i & 3) + 8 * (i >> 2) + 4 * h) * 32 + r] = Y[dt][i] * inv;
    }
    __syncthreads();
    if (grp == 0) {
      float ss = 0.f;
#pragma unroll
      for (int dt = 0; dt < 4; ++dt)
#pragma unroll
        for (int i = 0; i < 16; ++i) {
          const float o2 = comb[(((wid & 3) * 128) + dt * 32 + (i & 3) + 8 * (i >> 2) + 4 * h) * 32 + r];
          const float vv = Y[dt][i] * inv - lam_full * o2;
          Y[dt][i] = vv; ss += vv * vv;
        }
      ss += __shfl_xor(ss, 32);
      const float rs = rsqrtf(ss * (1.0f / 128.0f) + 1e-6f) * (1.0f - lambda_init);
#pragma unroll
      for (int dt = 0; dt < 4; ++dt)
#pragma unroll
        for (int g = 0; g < 4; ++g) {
          const int d0 = dt * 32 + 8 * g + 4 * h;
          const f32x4 sg = *(const f32x4*)(subg + d0);
          const float r8 = rs * O8_SCALE;
          *(unsigned*)((unsigned char*)O + (size_t)qrow * DM + head * 128 + d0) = pk4_fp8(Y[dt][4 * g] * r8 * sg[0], Y[dt][4 * g + 1] * r8 * sg[1], Y[dt][4 * g + 2] * r8 * sg[2], Y[dt][4 * g + 3] * r8 * sg[3]);
        }
    }
  }
}

DI u32x4 rwkv_mix_load(const bf16_t* hb, const float* mu, int mixi, int row, int k) {
  int s, L;
  if (row < TL) { s = row & 4095; L = 4096; } else { s = (row - TL) & 255; L = 256; }
  const bf16_t* hp = hb + (size_t)row * DM + k;
  const u32x4 c = ld16(hp);
  u32x4 pv = (u32x4){0u, 0u, 0u, 0u}, nx = (u32x4){0u, 0u, 0u, 0u};
  if (s > 0) pv = ld16(hp - DM);
  if (s < L - 1) nx = ld16(hp + DM);
  const float* m0 = mu + (size_t)(0 * 6 + mixi) * DM + k;
  const float* m1 = mu + (size_t)(1 * 6 + mixi) * DM + k;
  const f32x4 a0 = *(const f32x4*)m0, a1 = *(const f32x4*)(m0 + 4), b0 = *(const f32x4*)m1, b1 = *(const f32x4*)(m1 + 4);
  float cv[8] = {bflo(c.x), bfhi(c.x), bflo(c.y), bfhi(c.y), bflo(c.z), bfhi(c.z), bflo(c.w), bfhi(c.w)};
  float pvv[8] = {bflo(pv.x), bfhi(pv.x), bflo(pv.y), bfhi(pv.y), bflo(pv.z), bfhi(pv.z), bflo(pv.w), bfhi(pv.w)};
  float nv[8] = {bflo(nx.x), bfhi(nx.x), bflo(nx.y), bfhi(nx.y), bflo(nx.z), bfhi(nx.z), bflo(nx.w), bfhi(nx.w)};
  float mu0[8] = {a0[0], a0[1], a0[2], a0[3], a1[0], a1[1], a1[2], a1[3]};
  float mu1[8] = {b0[0], b0[1], b0[2], b0[3], b1[0], b1[1], b1[2], b1[3]};
  float o[8];
#pragma unroll
  for (int j = 0; j < 8; ++j) o[j] = cv[j] + (pvv[j] - cv[j]) * mu0[j] + (nv[j] - cv[j]) * mu1[j];
  u32x4 w; w.x = pk2(o[0], o[1]); w.y = pk2(o[2], o[3]); w.z = pk2(o[4], o[5]); w.w = pk2(o[6], o[7]);
  return w;
}
template <int ACT  , class AL>
DI void rwkv_gemm_tile(char* smem, AL la, const bf16_t* Bt, int K, int ldb, bf16_t* dst, int ldd, int row0, int col0, int ncols_valid) {
  auto lb = [&](int tn, int k) -> u32x4 { return (col0 + tn) < ncols_valid ? ld16(Bt + (size_t)(col0 + tn) * ldb + k) : (u32x4){0u, 0u, 0u, 0u}; };
  auto ep = [&](const f32x4 (&acc)[4][2], int r0, int c0, int fr, int fq) {
#pragma unroll
    for (int m = 0; m < 4; ++m)
#pragma unroll
      for (int n = 0; n < 2; ++n)
#pragma unroll
        for (int j = 0; j < 4; ++j) {
          const int row = row0 + r0 + m * 16 + fq * 4 + j, col = col0 + c0 + n * 16 + fr;
          float v = acc[m][n][j];
          if (ACT == 1) v = 1.0f - 2.0f * __builtin_amdgcn_rcpf(1.0f + __expf(2.0f * v));
          if (ACT == 2) v = sigmoidf_(v);
          if (col < ncols_valid) dst[(size_t)row * ldd + col] = f2bf(v);
        }
  };
  sgemm_tile(smem, K, la, lb, ep);
}
DI void phase_rwkv_mix(KP p, char* smem) {
  char* const ws = ows(p);
  const int lane = otid() & 63, wid = otid() >> 6;
  const bf16_t* hb = (const bf16_t*)(ws + OFF_H);
  const float* mu = gin(p, 18);
  bf16_t* XR = (bf16_t*)(ws + OFF_U + U3_XR);
  bf16_t* XK = (bf16_t*)(ws + OFF_U + U3_XK);
  bf16_t* XV = (bf16_t*)(ws + OFF_U + U3_XV);
  const int ch0 = lane * 16;
  for (int r = obid() * 8 + wid; r < TT; r += gridDim.x * 8) {
    int s, L;
    if (r < TL) { s = r & 4095; L = 4096; } else { s = (r - TL) & 255; L = 256; }
    const bf16_t* hp = hb + (size_t)r * DM + ch0;
    float c[16], pv[16], nx[16];
    {
      const u32x4 a = ld16(hp), b = ld16(hp + 8);
      c[0] = bflo(a.x); c[1] = bfhi(a.x); c[2] = bflo(a.y); c[3] = bfhi(a.y); c[4] = bflo(a.z); c[5] = bfhi(a.z); c[6] = bflo(a.w); c[7] = bfhi(a.w);
      c[8] = bflo(b.x); c[9] = bfhi(b.x); c[10] = bflo(b.y); c[11] = bfhi(b.y); c[12] = bflo(b.z); c[13] = bfhi(b.z); c[14] = bflo(b.w); c[15] = bfhi(b.w);
    }
#pragma unroll
    for (int j = 0; j < 16; ++j) { pv[j] = 0.f; nx[j] = 0.f; }
    if (s > 0) {
      const u32x4 a = ld16(hp - DM), b = ld16(hp - DM + 8);
      pv[0] = bflo(a.x); pv[1] = bfhi(a.x); pv[2] = bflo(a.y); pv[3] = bfhi(a.y); pv[4] = bflo(a.z); pv[5] = bfhi(a.z); pv[6] = bflo(a.w); pv[7] = bfhi(a.w);
      pv[8] = bflo(b.x); pv[9] = bfhi(b.x); pv[10] = bflo(b.y); pv[11] = bfhi(b.y); pv[12] = bflo(b.z); pv[13] = bfhi(b.z); pv[14] = bflo(b.w); pv[15] = bfhi(b.w);
    }
    if (s < L - 1) {
      const u32x4 a = ld16(hp + DM), b = ld16(hp + DM + 8);
      nx[0] = bflo(a.x); nx[1] = bfhi(a.x); nx[2] = bflo(a.y); nx[3] = bfhi(a.y); nx[4] = bflo(a.z); nx[5] = bfhi(a.z); nx[6] = bflo(a.w); nx[7] = bfhi(a.w);
      nx[8] = bflo(b.x); nx[9] = bfhi(b.x); nx[10] = bflo(b.y); nx[11] = bfhi(b.y); nx[12] = bflo(b.z); nx[13] = bfhi(b.z); nx[14] = bflo(b.w); nx[15] = bfhi(b.w);
    }
#pragma unroll
    for (int q = 0; q < 3; ++q) {
      const int mixi = q == 0 ? 0 : q + 1;
      if (q == 0 && r >= TL) continue;
      unsigned char* dst = (unsigned char*)(q == 0 ? XR : q == 1 ? XK : XV) + (size_t)r * DM + ch0;
      const float* m0 = mu + (size_t)(0 * 6 + mixi) * DM + ch0;
      const float* m1 = mu + (size_t)(1 * 6 + mixi) * DM + ch0;
      float o[16];
#pragma unroll
      for (int j4 = 0; j4 < 4; ++j4) {
        const f32x4 a = *(const f32x4*)(m0 + 4 * j4), b = *(const f32x4*)(m1 + 4 * j4);
#pragma unroll
        for (int j = 0; j < 4; ++j) { const int k = 4 * j4 + j; o[k] = c[k] + (pv[k] - c[k]) * a[j] + (nx[k] - c[k]) * b[j]; }
      }
      u32x4 w0;
      w0.x = pk4_fp8(o[0] * X8_SCALE, o[1] * X8_SCALE, o[2] * X8_SCALE, o[3] * X8_SCALE); w0.y = pk4_fp8(o[4] * X8_SCALE, o[5] * X8_SCALE, o[6] * X8_SCALE, o[7] * X8_SCALE);
      w0.z = pk4_fp8(o[8] * X8_SCALE, o[9] * X8_SCALE, o[10] * X8_SCALE, o[11] * X8_SCALE); w0.w = pk4_fp8(o[12] * X8_SCALE, o[13] * X8_SCALE, o[14] * X8_SCALE, o[15] * X8_SCALE);
      *(u32x4*)dst = w0;
    }
  }
}
struct RkvSched {
  const char* X0; const char* X1; const char* X2; const char* W; int G, c;
  DI bool next(int i, fg::Unit& u) const {
    int pmg, pn; if (!fg::static_order(i, G, c, 800, 4, pmg, pn)) return false;
    const int job = (pmg >= 256) + (pmg >= 528);
    u.pm = pmg - (job ? 256 + (job - 1) * 272 : 0); u.pn = pn; u.aux = job;
    u.A = X0 + (size_t)job * SZ_TT + (size_t)u.pm * 256 * 1024;
    u.B = W + (size_t)job * 1024 * 1024 * 2 + (size_t)u.pn * 256 * 1024; return true;
  }
  DI const LAS int* rows(int) const { return nullptr; }
};
DI void phase_rwkv_rkv(KP p, char* smem) {
  char* const ws = ows(p);
  LAS unsigned char* lds = (LAS unsigned char*)smem;
  char* U = ws + OFF_U;
  RkvSched S; S.X0 = U + U3_XR; S.X1 = U + U3_XK; S.X2 = U + U3_XV; S.W = ws + OFF_WMIX + W_R * 2; S.G = gridDim.x; S.c = obid();
  auto ep = [&](const f32x16 (&acc)[2][2][2], const fg::Unit& u, int wr, int wc, int r, int h) {
    bf16_t* dst = (bf16_t*)(U + (u.aux ? SZ_TL + (size_t)(u.aux - 1) * SZ_TT : (size_t)0));
    constexpr float inv = 1.0f / (X8_SCALE * 32.0f);
#pragma unroll
    for (int ai = 0; ai < 2; ++ai)
#pragma unroll
      for (int m = 0; m < 2; ++m) {
        const size_t row = (size_t)u.pm * 256 + ai * 128 + wr * 64 + m * 32 + r;
#pragma unroll
        for (int bj = 0; bj < 2; ++bj) {
          const f32x16& a = acc[ai][bj][m];
          u32x4 w0, w1;
          w0.x = pk2(a[0] * inv, a[1] * inv); w0.y = pk2(a[2] * inv, a[3] * inv); w0.z = pk2(a[4] * inv, a[5] * inv); w0.w = pk2(a[6] * inv, a[7] * inv);
          w1.x = pk2(a[8] * inv, a[9] * inv); w1.y = pk2(a[10] * inv, a[11] * inv); w1.z = pk2(a[12] * inv, a[13] * inv); w1.w = pk2(a[14] * inv, a[15] * inv);
          bf16_t* q = dst + row * DM + u.pn * 256 + bj * 128 + wc * 32 + 16 * h;
          *(u32x4*)q = w0; *(u32x4*)(q + 8) = w1;
        }
      }
  };
  fg::gemm_phase_f8<false, true>(lds, 512, 512, 512, S, ep);
}

DI void phase_rwkv_feat1(KP p, char* smem) {
  char* const ws = ows(p);
  const bf16_t* hb = (const bf16_t*)(ws + OFF_H);
  const bf16_t* wm = (const bf16_t*)(ws + OFF_WMIX);
  const float* mu = gin(p, 18);
  char* U = ws + OFF_U;
  const int n3 = 544, n4 = n3 + 544, n5 = n4 + 512;
  for (int t = obid(); t < n5; t += gridDim.x) {
    if (t < n3) {
      const int row0 = t * 128;
      auto la = [&](int trow, int k) -> u32x4 { return rwkv_mix_load(hb, mu, 1, row0 + trow, k); };
      rwkv_gemm_tile<1>(smem, la, wm + W_WA1, 1024, 1024, (bf16_t*)(U + U3_LW), 128, row0, 0, 128);
    } else if (t < n4) {
      const int row0 = (t - n3) * 128;
      auto la = [&](int trow, int k) -> u32x4 { return rwkv_mix_load(hb, mu, 4, row0 + trow, k); };
      rwkv_gemm_tile<0>(smem, la, wm + W_AA1, 1024, 1024, (bf16_t*)(U + U3_LA), 128, row0, 0, 128);
    } else {
      const int row0 = (t - n4) * 128;
      auto la = [&](int trow, int k) -> u32x4 { return rwkv_mix_load(hb, mu, 5, row0 + trow, k); };
      rwkv_gemm_tile<2>(smem, la, wm + W_G1, 1024, 1024, (bf16_t*)(U + U3_LG), 128, row0, 0, 128);
    }
  }
}
struct Feat2Sched {
  const char* U; const char* W; int G, c;
  DI bool next(int i, fg::Unit& u) const {
    const int L = i * G + c; if (L >= 2176 + 2176 + 1024) return false;
    const int job = (L >= 2176) + (L >= 4352), loc = L - job * 2176;
    if (job < 2) { u.pm = loc >> 3; u.pn = loc & 7; } else { u.pm = loc >> 2; u.pn = loc & 3; }
    u.aux = job;
    u.A = U + (job == 0 ? U3_LW : job == 1 ? U3_LA : U3_LG) + (size_t)u.pm * 256 * 128 * 2;
    u.B = W + ((job == 0 ? W_WA2 : job == 1 ? W_AA2 : W_G2) + (size_t)u.pn * 256 * 128) * 2; return true;
  }
  DI const LAS int* rows(int) const { return nullptr; }
};
DI void phase_rwkv_feat2(KP p, char* smem) {
  char* const ws = ows(p);
  LAS unsigned char* lds = (LAS unsigned char*)smem;
  char* U = ws + OFF_U;
  Feat2Sched S; S.U = U; S.W = ws + OFF_WMIX; S.G = gridDim.x; S.c = obid();
  const float* w0 = gin(p, 20);
  const float* a0 = gin(p, 23);
  auto ep = [&](const f32x4 (&acc)[2][2][4][2], const fg::Unit& u, int wr, int wc, int fr, int fq) {
    const int job = u.aux, d = u.pn >> 2;
    const int colu = (job < 2 ? (u.pn & 3) : u.pn) * 256 + wc * 32 + 8 * fq;
    bf16_t* dst = (bf16_t*)(U + (job == 0 ? (d ? U3_LD1 : U3_LD0) : job == 1 ? (d ? U3_A1 : U3_A0) : U3_G));
    const float* bias = (job == 0 ? w0 : a0) + d * 1024;
#pragma unroll
    for (int ai = 0; ai < 2; ++ai)
#pragma unroll
      for (int m = 0; m < 4; ++m) {
        const size_t row = (size_t)u.pm * 256 + ai * 128 + wr * 64 + m * 16 + fr;
#pragma unroll
        for (int bj = 0; bj < 2; ++bj) {
          f32x4 x0 = acc[ai][bj][m][0], x1 = acc[ai][bj][m][1];
          if (job < 2) {
            const f32x4 b0 = *(const f32x4*)(bias + colu + bj * 128), b1 = *(const f32x4*)(bias + colu + bj * 128 + 4);
            const float sc_ = job == 0 ? -0.60653065971f : 1.0f;
#pragma unroll
            for (int j = 0; j < 4; ++j) { x0[j] = sc_ * sigmoidf_(x0[j] + b0[j]); x1[j] = sc_ * sigmoidf_(x1[j] + b1[j]); }
          }
          u32x4 w; w.x = pk2(x0[0], x0[1]); w.y = pk2(x0[2], x0[3]); w.z = pk2(x1[0], x1[1]); w.w = pk2(x1[2], x1[3]);
          *(u32x4*)(dst + row * DM + colu + bj * 128) = w;
        }
      }
  };
  fg::gemm_phase<false, true>(lds, 128, 128, 128, S, ep);
}

constexpr int C3_L = 32, C3_LDK = 72, C3_LDT = 40, C3_LDY = 36;
constexpr int C3_BT = 0, C3_RT = 4608, C3_KT = 9216, C3_CT = 13824, C3_KHT = 18432, C3_CHT = 23552, C3_VT = 28672, C3_GKB = 33792, C3_GKR = 36352,
              C3_GCR = 38912, C3_S0 = 41472, C3_U = 50688, C3_MCB = 55808, C3_Y = 59904, C3_E = 69120, C3_TOT = 69376, C3_SCAN = 70400;
constexpr int SC_LDS = 2 * C3_SCAN;
DI void lds_bar() { asm volatile("s_waitcnt lgkmcnt(0)" ::: "memory"); __builtin_amdgcn_s_barrier(); asm volatile("" ::: "memory"); }
#define DPP_ADD(s, ctrl) ((s) + __builtin_bit_cast(float, __builtin_amdgcn_update_dpp(0, __builtin_bit_cast(int, (s)), (ctrl), 0xF, 0xF, true)))
DI float wave_sum_dpp(float s) {
  s = DPP_ADD(s, 0xB1); s = DPP_ADD(s, 0x4E); s = DPP_ADD(s, 0x141); s = DPP_ADD(s, 0x140);
  const int si = __builtin_bit_cast(int, s);
  const float a0 = __builtin_bit_cast(float, __builtin_amdgcn_readlane(si, 0)), a1 = __builtin_bit_cast(float, __builtin_amdgcn_readlane(si, 16));
  const float a2 = __builtin_bit_cast(float, __builtin_amdgcn_readlane(si, 32)), a3 = __builtin_bit_cast(float, __builtin_amdgcn_readlane(si, 48));
  return (a0 + a1) + (a2 + a3);
}
DI void phase_rwkv_scan(KP p, char* smem) {
  char* const ws = ows(p);
  const int tid = otid(), lane = tid & 63, wid = tid >> 6, sc = wid >> 2, w4 = wid & 3, r = lane & 31, h = lane >> 5;
  char* sb = smem + sc * C3_SCAN;
  bf16_t* Bt = (bf16_t*)(sb + C3_BT); bf16_t* Rt = (bf16_t*)(sb + C3_RT); bf16_t* Kt = (bf16_t*)(sb + C3_KT); bf16_t* Ct = (bf16_t*)(sb + C3_CT);
  bf16_t* KhT = (bf16_t*)(sb + C3_KHT); bf16_t* ChT = (bf16_t*)(sb + C3_CHT); bf16_t* Vt = (bf16_t*)(sb + C3_VT);
  bf16_t* GkbT = (bf16_t*)(sb + C3_GKB); bf16_t* GkrT = (bf16_t*)(sb + C3_GKR); bf16_t* GcrT = (bf16_t*)(sb + C3_GCR);
  bf16_t* S0b = (bf16_t*)(sb + C3_S0); bf16_t* Ub = (bf16_t*)(sb + C3_U);
  float* McbP = (float*)(sb + C3_MCB); float* Yb = (float*)(sb + C3_Y); float* Eb = (float*)(sb + C3_E); float* Tot = (float*)(sb + C3_TOT);
  char* U = ws + OFF_U;
  const bf16_t* Kx = (const bf16_t*)(U + U3_K);
  const bf16_t* Vx = (const bf16_t*)(U + U3_V);
  const bf16_t* Rx = (const bf16_t*)(U + U3_R);
  const int ti = w4 >> 1, tj = w4 & 1;
  const int tio = w4 & 1;
  const int sv = w4 * 16 + (lane >> 2), jq = lane & 3;
  for (int base = obid() * 2; base < 512; base += gridDim.x * 2) {
    const int item = base + sc, dir = item & 1, head = (item >> 1) & 15, b = item >> 5;
    const bf16_t* Ax = (const bf16_t*)(U + (dir ? U3_A1 : U3_A0));
    const bf16_t* Lx = (const bf16_t*)(U + (dir ? U3_LD1 : U3_LD0));
    bf16_t* Ox = (bf16_t*)(U + (dir ? U3_O1 : U3_O0));
    const int ch = head * 64 + lane;
    const float kkw = gin(p, 28)[ch], kaw = gin(p, 29)[ch];
    auto rowof = [&](int n) -> int {
      if (n < 256) { const int c = dir ? 255 - n : n; return TL + b * 256 + c; }
      const int s = dir ? 4095 - (n - 256) : n - 256; return b * 4096 + s;
    };
    f32x16 S;
#pragma unroll
    for (int i = 0; i < 16; ++i) S[i] = 0.f;
    for (int i = lane; i < 64 * C3_LDK / 4; i += 64) if (w4 == 0) ((unsigned long long*)S0b)[i] = 0ull;
    bf16_t pk_[8], pa_[8], pl_[8], pv_[8], pr_[8];
    auto prefetch = [&](int c) {
#pragma unroll
      for (int q = 0; q < 8; ++q) {
        const int n = c * C3_L + w4 * 8 + q;
        const size_t off = (size_t)rowof(n) * DM + ch;
        pk_[q] = Kx[off]; pa_[q] = Ax[off]; pl_[q] = Lx[off]; pv_[q] = Vx[off];
        pr_[q] = n >= 256 ? Rx[off] : (bf16_t)0;
      }
    };
    constexpr int NCH = 4352 / C3_L;
    prefetch(0);
    lds_bar();
    for (int c = 0; c < NCH; ++c) {
      float kkv[8], cv[8], kdv[8], lv[8], cl[8], rv[8], vv[8];
      {
        float run = 0.f;
#pragma unroll
        for (int q = 0; q < 8; ++q) {
          const float kv = bf2f(pk_[q]), av = bf2f(pa_[q]);
          lv[q] = bf2f(pl_[q]); rv[q] = bf2f(pr_[q]); vv[q] = bf2f(pv_[q]);
          const float kkr = kv * kkw;
          kkv[q] = kkr * __builtin_amdgcn_rsqf(fmaxf(wave_sum_dpp(kkr * kkr), 1e-24f));
          cv[q] = kkv[q] * av;
          kdv[q] = kv * (1.0f + (av - 1.0f) * kaw);
          run += lv[q]; cl[q] = run;
        }
        Tot[w4 * 64 + lane] = run;
      }
      if (c + 1 < NCH) prefetch(c + 1);
      lds_bar();
      {
        const float t0 = Tot[lane], t1 = Tot[64 + lane], t2 = Tot[128 + lane], t3 = Tot[192 + lane];
        const float cumL = (t0 + t1) + (t2 + t3);
        const float off = w4 == 0 ? 0.f : (w4 == 1 ? t0 : (w4 == 2 ? t0 + t1 : (t0 + t1) + t2));
        float kh[8], chh[8];
#pragma unroll
        for (int q = 0; q < 8; ++q) {
          const int t = w4 * 8 + q;
          const float cumt = off + cl[q], cump = cumt - lv[q];
          const float e1 = __expf(cump), e2 = __expf(cumt), e3 = __expf(-cumt), e4 = __expf(cumL - cumt);
          Bt[t * C3_LDK + lane] = f2bf(kkv[q] * e1);
          Rt[t * C3_LDK + lane] = f2bf(rv[q] * e2);
          Kt[t * C3_LDK + lane] = f2bf(kdv[q] * e3);
          Ct[t * C3_LDK + lane] = f2bf(cv[q] * e3);
          kh[q] = kdv[q] * e4; chh[q] = cv[q] * e4;
        }
        u32x4 w;
        w.x = pk2(kh[0], kh[1]); w.y = pk2(kh[2], kh[3]); w.z = pk2(kh[4], kh[5]); w.w = pk2(kh[6], kh[7]);
        *(u32x4*)(KhT + lane * C3_LDT + w4 * 8) = w;
        w.x = pk2(chh[0], chh[1]); w.y = pk2(chh[2], chh[3]); w.z = pk2(chh[4], chh[5]); w.w = pk2(chh[6], chh[7]);
        *(u32x4*)(ChT + lane * C3_LDT + w4 * 8) = w;
        w.x = pk2(vv[0], vv[1]); w.y = pk2(vv[2], vv[3]); w.z = pk2(vv[4], vv[5]); w.w = pk2(vv[6], vv[7]);
        *(u32x4*)(Vt + lane * C3_LDT + w4 * 8) = w;
        if (w4 == 0) Eb[lane] = __expf(cumL);
      }
      lds_bar();
      {
        const bf16_t* Ag = (w4 & 1) ? Kt : Ct;
        const bf16_t* Bg = (w4 & 2) ? Rt : Bt;
        f32x16 X;
#pragma unroll
        for (int i = 0; i < 16; ++i) X[i] = 0.f;
#pragma unroll
        for (int s = 0; s < 4; ++s) {
          const bf16x8 a = *(const bf16x8*)(Ag + r * C3_LDK + 16 * s + 8 * h);
          const bf16x8 bq = *(const bf16x8*)(Bg + r * C3_LDK + 16 * s + 8 * h);
          X = MFMA32(a, bq, X);
        }
        const bool incl = (w4 & 2) != 0;
#pragma unroll
        for (int i = 0; i < 16; ++i) { const int jr = (i & 3) + 8 * (i >> 2) + 4 * h; if (!(jr < r || (incl && jr == r))) X[i] = 0.f; }
        if (w4 == 0) {
#pragma unroll
          for (int i = 0; i < 16; ++i) { const int jr = (i & 3) + 8 * (i >> 2) + 4 * h; McbP[r * 32 + (jr & 3) * 8 + (jr >> 2)] = X[i]; }
        } else {
          bf16_t* G = w4 == 1 ? GkbT : (w4 == 2 ? GcrT : GkrT);
#pragma unroll
          for (int g = 0; g < 4; ++g) { u32x2 w; w.x = pk2(X[4 * g], X[4 * g + 1]); w.y = pk2(X[4 * g + 2], X[4 * g + 3]); *(u32x2*)(G + r * C3_LDT + 8 * g + 4 * h) = w; }
        }
      }
      lds_bar();
      f32x16 XO;
      {
        const bf16_t* Bq = (w4 & 2) ? Rt : Bt;
        const bf16_t* Gq = (w4 & 2) ? GkrT : GkbT;
#pragma unroll
        for (int i = 0; i < 16; ++i) XO[i] = 0.f;
#pragma unroll
        for (int s = 0; s < 4; ++s) {
          const bf16x8 a = *(const bf16x8*)(S0b + (32 * tio + r) * C3_LDK + 16 * s + 8 * h);
          const bf16x8 bq = *(const bf16x8*)(Bq + r * C3_LDK + 16 * s + 8 * h);
          XO = MFMA32(a, bq, XO);
        }
#pragma unroll
        for (int s = 0; s < 2; ++s) {
          const bf16x8 a = *(const bf16x8*)(Vt + (32 * tio + r) * C3_LDT + 16 * s + 8 * h);
          const bf16x8 bq = *(const bf16x8*)(Gq + r * C3_LDT + 16 * s + 8 * h);
          XO = MFMA32(a, bq, XO);
        }
        if (w4 < 2) {
#pragma unroll
          for (int i = 0; i < 16; ++i) Yb[(32 * tio + (i & 3) + 8 * (i >> 2) + 4 * h) * C3_LDY + r] = XO[i];
        }
      }
      lds_bar();
      {
        float u[8];
#pragma unroll
        for (int jj = 0; jj < 8; ++jj) u[jj] = 0.f;
        const unsigned ma = (unsigned)(size_t)(McbP + jq * 8);
        f32x4 yv[8];
#pragma unroll
        for (int i = 0; i < 8; ++i) yv[i] = *(const f32x4*)(Yb + sv * C3_LDY + 4 * i);
        f32x4 mA[4], mB[4];
#define C3_MLOAD(t_) asm volatile("ds_read_b128 %0, %2 offset:%c3\n\tds_read_b128 %1, %2 offset:%c4" : "=&v"(mA[(t_) & 3]), "=&v"(mB[(t_) & 3]) : "v"(ma), "i"((t_) * 128), "i"((t_) * 128 + 16) : "memory")
        C3_MLOAD(1); C3_MLOAD(2); C3_MLOAD(3);
        if (jq == 0) u[0] = yv[0][0];
#pragma unroll
        for (int t = 1; t < 32; ++t) {
          if (t + 3 < 32) { C3_MLOAD(t + 3); asm volatile("s_waitcnt lgkmcnt(6)" ::: "memory"); }
          else if (t + 2 < 32) asm volatile("s_waitcnt lgkmcnt(4)" ::: "memory");
          else if (t + 1 < 32) asm volatile("s_waitcnt lgkmcnt(2)" ::: "memory");
          else asm volatile("s_waitcnt lgkmcnt(0)" ::: "memory");
          asm volatile("" :: "v"(mA[t & 3]), "v"(mB[t & 3]));
          __builtin_amdgcn_sched_barrier(0);
          const f32x4 m0 = mA[t & 3], m1 = mB[t & 3];
          const int jl = (t - 1) >> 2;
          float part = 0.f;
#pragma unroll
          for (int jj = 0; jj < 8; ++jj) if (jj != jl && jj * 4 < t) part += u[jj] * (jj < 4 ? m0[jj] : m1[jj - 4]);
          part += u[jl] * (jl < 4 ? m0[jl] : m1[jl - 4]);
          part = DPP_ADD(part, 0xB1); part = DPP_ADD(part, 0x4E);
          const float ut = yv[t >> 2][t & 3] - part;
          u[t >> 2] = (jq == (t & 3)) ? ut : u[t >> 2];
        }
#undef C3_MLOAD
#pragma unroll
        for (int jj = 0; jj < 8; ++jj) Ub[sv * C3_LDT + jq + 4 * jj] = f2bf(u[jj]);
      }
      lds_bar();
      if (w4 >= 2) {
        f32x16 X2;
#pragma unroll
        for (int i = 0; i < 16; ++i) X2[i] = 0.f;
#pragma unroll
        for (int s = 0; s < 2; ++s) {
          const bf16x8 a = *(const bf16x8*)(Ub + (32 * tio + r) * C3_LDT + 16 * s + 8 * h);
          const bf16x8 bq = *(const bf16x8*)(GcrT + r * C3_LDT + 16 * s + 8 * h);
          X2 = MFMA32(a, bq, X2);
        }
        if (c * C3_L >= 256) {
          const size_t orow = (size_t)rowof(c * C3_L + r) * DM + head * 64 + 32 * tio + 4 * h;
#pragma unroll
          for (int g = 0; g < 4; ++g) {
            u32x2 w; w.x = pk2(XO[4 * g] - X2[4 * g], XO[4 * g + 1] - X2[4 * g + 1]); w.y = pk2(XO[4 * g + 2] - X2[4 * g + 2], XO[4 * g + 3] - X2[4 * g + 3]);
            *(u32x2*)(Ox + orow + 8 * g) = w;
          }
        }
      }
      {
        f32x16 P1, P2;
#pragma unroll
        for (int i = 0; i < 16; ++i) { P1[i] = 0.f; P2[i] = 0.f; }
#pragma unroll
        for (int s = 0; s < 2; ++s) {
          const bf16x8 av = *(const bf16x8*)(Vt + (32 * ti + r) * C3_LDT + 16 * s + 8 * h);
          const bf16x8 bk = *(const bf16x8*)(KhT + (32 * tj + r) * C3_LDT + 16 * s + 8 * h);
          P1 = MFMA32(av, bk, P1);
          const bf16x8 au = *(const bf16x8*)(Ub + (32 * ti + r) * C3_LDT + 16 * s + 8 * h);
          const bf16x8 bc = *(const bf16x8*)(ChT + (32 * tj + r) * C3_LDT + 16 * s + 8 * h);
          P2 = MFMA32(au, bc, P2);
        }
        const float ek = Eb[32 * tj + r];
#pragma unroll
        for (int i = 0; i < 16; ++i) {
          S[i] = S[i] * ek + P1[i] - P2[i];
          S0b[(32 * ti + (i & 3) + 8 * (i >> 2) + 4 * h) * C3_LDK + 32 * tj + r] = f2bf(S[i]);
        }
      }
      lds_bar();
    }
  }
}

DI void phase_rwkv_out(KP p, char* smem) {
  char* const ws = ows(p);
  const int lane = otid() & 63, wid = otid() >> 6;
  char* U = ws + OFF_U;
  const bf16_t *Rx = (const bf16_t*)(U + U3_R), *Kx = (const bf16_t*)(U + U3_K), *Vx = (const bf16_t*)(U + U3_V), *A0 = (const bf16_t*)(U + U3_A0),
               *A1 = (const bf16_t*)(U + U3_A1), *Gx = (const bf16_t*)(U + U3_G), *O0 = (const bf16_t*)(U + U3_O0), *O1 = (const bf16_t*)(U + U3_O1);
  bf16_t* Z = (bf16_t*)(ws + OFF_H);
  const int ch0 = lane * 16;
  float ka[16], rk[16], lw[16], lb[16];
#pragma unroll
  for (int j = 0; j < 16; ++j) { ka[j] = gin(p, 29)[ch0 + j]; rk[j] = gin(p, 30)[ch0 + j]; lw[j] = gin(p, 31)[ch0 + j]; lb[j] = gin(p, 32)[ch0 + j]; }
  auto ld16f = [&](const bf16_t* base, size_t off, float (&o)[16]) {
    const u32x4 a = ld16(base + off), b = ld16(base + off + 8);
    o[0] = bflo(a.x); o[1] = bfhi(a.x); o[2] = bflo(a.y); o[3] = bfhi(a.y); o[4] = bflo(a.z); o[5] = bfhi(a.z); o[6] = bflo(a.w); o[7] = bfhi(a.w);
    o[8] = bflo(b.x); o[9] = bfhi(b.x); o[10] = bflo(b.y); o[11] = bfhi(b.y); o[12] = bflo(b.z); o[13] = bfhi(b.z); o[14] = bflo(b.w); o[15] = bfhi(b.w);
  };
  for (int r = obid() * 8 + wid; r < TL; r += gridDim.x * 8) {
    const size_t off = (size_t)r * DM + ch0;
    float o0[16], o1[16], rr[16], kk[16], vv[16], a0[16], a1[16], gg[16];
    ld16f(O0, off, o0); ld16f(O1, off, o1); ld16f(Rx, off, rr); ld16f(Kx, off, kk); ld16f(Vx, off, vv); ld16f(A0, off, a0); ld16f(A1, off, a1); ld16f(Gx, off, gg);
    float s = 0.f, bs = 0.f;
#pragma unroll
    for (int j = 0; j < 16; ++j) {
      o0[j] += o1[j]; s += o0[j];
      const float kd0 = kk[j] * (1.0f + (a0[j] - 1.0f) * ka[j]), kd1 = kk[j] * (1.0f + (a1[j] - 1.0f) * ka[j]);
      bs += rr[j] * (kd0 + kd1) * rk[j];
    }
    s += __shfl_xor(s, 1); s += __shfl_xor(s, 2);
    bs += __shfl_xor(bs, 1); bs += __shfl_xor(bs, 2);
    const float mean = s * (1.0f / 64.0f);
    float q = 0.f;
#pragma unroll
    for (int j = 0; j < 16; ++j) { const float d = o0[j] - mean; q += d * d; }
    q += __shfl_xor(q, 1); q += __shfl_xor(q, 2);
    const float rstd = rsqrtf(q * (1.0f / 64.0f) + 64e-5f);
    float z[16];
#pragma unroll
    for (int j = 0; j < 16; ++j) z[j] = ((o0[j] - mean) * rstd * lw[j] + lb[j] + bs * vv[j]) * gg[j];
    u32x4 w0, w1;
    w0.x = pk2(z[0], z[1]); w0.y = pk2(z[2], z[3]); w0.z = pk2(z[4], z[5]); w0.w = pk2(z[6], z[7]);
    w1.x = pk2(z[8], z[9]); w1.y = pk2(z[10], z[11]); w1.z = pk2(z[12], z[13]); w1.w = pk2(z[14], z[15]);
    *(u32x4*)(Z + off) = w0; *(u32x4*)(Z + off + 8) = w1;
  }
}

#define XB_TMO      128
#define XB_XCNT(j)  (256  + 64 * (j))
#define XB_XSUB(j)  (1280 + 64 * (j))
#define XB_XGEN(j)  (2304 + 64 * (j))
#define XB_TOP      3328
#define XB_TOPGEN   3392
#define XCD_BAR_WORDS 3456
#define XB_SPIN_CAP (1u << 22)
#define LAS __attribute__((address_space(3)))
__device__ __forceinline__ unsigned xb_ld(unsigned* p)              { return __hip_atomic_load(p, __ATOMIC_RELAXED, __HIP_MEMORY_SCOPE_AGENT); }
__device__ __forceinline__ unsigned xb_add(unsigned* p, unsigned v) { return __hip_atomic_fetch_add(p, v, __ATOMIC_RELAXED, __HIP_MEMORY_SCOPE_AGENT); }
__device__ __forceinline__ unsigned xb_xcc_id() { return (unsigned)__builtin_amdgcn_s_getreg((3 << 11) | 20) & 0xFu; }
#define XB_SPIN(cond, bar) do { unsigned _sp = 0; while (cond) { __builtin_amdgcn_s_sleep(1); \
    if ((++_sp & 255u) == 0u) { if (xb_ld(&(bar)[XB_TMO])) break; if (_sp > XB_SPIN_CAP) { atomicAdd(&(bar)[XB_TMO], 1u); break; } } } } while (0)
struct XcdBarrier { unsigned* bar; unsigned x; volatile LAS unsigned* st; };
__device__ __forceinline__ XcdBarrier xcd_barrier_post(unsigned* bar, volatile LAS unsigned* st) {
    XcdBarrier b; b.bar = bar; b.x = xb_xcc_id(); b.st = st;
    if (otid() == 0) (void)xb_add(&bar[XB_XCNT(b.x)], 1u);
    return b;
}
__device__ __forceinline__ void xcd_barrier_complete(unsigned* bar, unsigned x, unsigned& nloc, unsigned& nx) {
    const unsigned G = gridDim.x * gridDim.y * gridDim.z;
    unsigned sum, cnt, mine, sp = 0u;
    for (;;) {
        sum = 0u; cnt = 0u; mine = 0u;
#pragma unroll
        for (unsigned j = 0; j < 16; ++j) { const unsigned c = xb_ld(&bar[XB_XCNT(j)]); sum += c; cnt += (c > 0u) ? 1u : 0u; mine = (j == x) ? c : mine; }
        if (sum == G) break;
        __builtin_amdgcn_s_sleep(1);
        if ((++sp & 255u) == 0u) { if (xb_ld(&bar[XB_TMO])) break; if (sp > XB_SPIN_CAP) { atomicAdd(&bar[XB_TMO], 1u); break; } }
    }
    nloc = mine > 0u ? mine : 1u; nx = cnt > 0u ? cnt : 1u;
}
__device__ __forceinline__ void xcd_barrier(const XcdBarrier& b) {
    asm volatile("s_waitcnt vmcnt(0)" ::: "memory");
    __syncthreads();
    if (otid() == 0) {
        unsigned* bar = b.bar;
        __builtin_amdgcn_s_waitcnt(0);
        unsigned nloc = b.st[0], nx = b.st[1];
        if (nloc == 0u) { xcd_barrier_complete(bar, b.x, nloc, nx); b.st[0] = nloc; b.st[1] = nx; }
        const unsigned old = xb_add(&bar[XB_XSUB(b.x)], 1u);
        const unsigned gen = old / nloc;
        if (old + 1u == (gen + 1u) * nloc) {
            __builtin_amdgcn_fence(__ATOMIC_RELEASE, "agent");
            asm volatile("s_waitcnt vmcnt(0)" ::: "memory");
            const unsigned og = xb_add(&bar[XB_TOP], 1u);
            const unsigned tg = og / nx;
            if (og + 1u == (tg + 1u) * nx) xb_add(&bar[XB_TOPGEN], 1u);
            else XB_SPIN(xb_ld(&bar[XB_TOPGEN]) == tg, bar);
            __builtin_amdgcn_fence(__ATOMIC_ACQUIRE, "agent");
            xb_add(&bar[XB_XGEN(b.x)], 1u);
            asm volatile("s_waitcnt vmcnt(0)" ::: "memory");
        } else {
            XB_SPIN(xb_ld(&bar[XB_XGEN(b.x)]) == gen, bar);
            __builtin_amdgcn_fence(__ATOMIC_ACQUIRE, "agent");
            asm volatile("s_waitcnt vmcnt(0)" ::: "memory");
        }
    }
    __syncthreads();
}

DI void gbar(const XcdBarrier& b0) {
  XcdBarrier b = b0;
  unsigned long long pb = (unsigned long long)b.bar; asm volatile("" : "+s"(pb)); b.bar = (unsigned*)pb;
  unsigned x = b.x; asm volatile("" : "+s"(x)); b.x = x;
  xcd_barrier(b);
}

constexpr int cmaxi(int a, int b) { return a > b ? a : b; }
constexpr int FUSED_LDS = 256 + cmaxi(cmaxi(MOD_LDS, A1_LDS), cmaxi(cmaxi(SC_LDS, R2_LDS), FG_LDS + MOE_UMAX * 1024 + 256));
#ifndef PROBE_GROUP
#define PROBE_GROUP 0
#endif
#define PROBE(g, stmt) do { if constexpr (PROBE_GROUP == (g)) { stmt; gbar(bar); } } while (0)
template <int layer>
DI void run_layer(const XcdBarrier& bar, char* smem) {
  char* U = ows(kparams()) + OFF_U;
  const bf16_t* wm = (const bf16_t*)(ows(kparams()) + OFF_WMIX);
  if constexpr (layer == 0) phase_norm1<0, false, true>(kparams(), layer, smem); else phase_norm1<1, false, layer == 1>(kparams(), layer, smem);
  gbar(bar);
  PROBE(1, (phase_norm1<(layer == 0 ? 0 : 1), true, (layer <= 1)>(kparams(), layer, smem)));
  if constexpr (layer == 0) {
    phase_qkv_win8(kparams(), smem);
    gbar(bar);
    PROBE(3, phase_qkv_win8(kparams(), smem));
    phase_attn_win(kparams(), smem);
    gbar(bar);
    PROBE(4, phase_attn_win(kparams(), smem));
    phase_oproj(kparams(), 0, (const bf16_t*)(U + U0_O), wm + W_WINO, TT, smem);
    gbar(bar);
    PROBE(3, (phase_oproj<true>(kparams(), 0, (const bf16_t*)(U + U0_O), wm + W_WINO, TT, smem)));
  } else if constexpr (layer == 1) {
    phase_qkv_diff8(kparams(), smem);
    gbar(bar);
    PROBE(3, phase_qkv_diff8(kparams(), smem));
    phase_attn_diff(kparams(), smem);
    gbar(bar);
    PROBE(10, phase_attn_diff(kparams(), smem));
    phase_oproj8(kparams(), 1, U + U1_O, (const char*)(wm + W_DIFFO), TT, smem);
    gbar(bar);
    PROBE(3, (phase_oproj8<true>(kparams(), 1, U + U1_O, (const char*)(wm + W_DIFFO), TT, smem)));
  } else if constexpr (layer == 2) {
    phase_pool_pre(kparams(), smem);
    gbar(bar);
    PROBE(6, phase_pool_pre(kparams(), smem));
    phase_pool(kparams(), smem);
    gbar(bar);
    PROBE(6, phase_pool<true>(kparams(), smem));
  } else {
    phase_rwkv_mix(kparams(), smem);
    gbar(bar);
    PROBE(7, phase_rwkv_mix(kparams(), smem));
    phase_rwkv_rkv(kparams(), smem);
    __syncthreads();
    phase_rwkv_feat1(kparams(), smem);
    gbar(bar);
    PROBE(7, phase_rwkv_rkv(kparams(), smem));
    PROBE(8, phase_rwkv_feat1(kparams(), smem));
    phase_rwkv_feat2(kparams(), smem);
    gbar(bar);
    PROBE(8, phase_rwkv_feat2(kparams(), smem));
    phase_rwkv_scan(kparams(), smem);
    gbar(bar);
    PROBE(11, phase_rwkv_scan(kparams(), smem));
    phase_rwkv_out(kparams(), smem);
    gbar(bar);
    PROBE(9, phase_rwkv_out(kparams(), smem));
    phase_oproj(kparams(), 3, (const bf16_t*)(ows(kparams()) + OFF_H), wm + W_RO, TL, smem);
    gbar(bar);
    PROBE(3, (phase_oproj<true>(kparams(), 3, (const bf16_t*)(ows(kparams()) + OFF_H), wm + W_RO, TL, smem)));
  }
  phase_norm2_router(kparams(), layer, smem);
  __syncthreads();
  phase_cvt_moe(kparams(), layer, smem);
  gbar(bar);
  PROBE(2, phase_norm2_router<true>(kparams(), layer, smem));
  PROBE(5, phase_cvt_moe(kparams(), layer, smem));
  phase_moe_up(kparams(), layer, smem);
  gbar(bar);
  phase_moe_down(kparams(), layer, smem);
  gbar(bar);
  PROBE(12, phase_moe_up(kparams(), layer, smem));
  PROBE(12, phase_moe_down(kparams(), layer, smem));
}

__global__ __launch_bounds__(NTH, 2) void k_fused(Params p_unused) {
  extern __shared__ __attribute__((aligned(16))) char smem_all[];
  if (threadIdx.x == 0) *(uint4*)smem_all = make_uint4(0u, 0u, 0u, 0u);
  __syncthreads();
  XcdBarrier bar = xcd_barrier_post((unsigned*)(ows(kparams()) + OFF_BAR), (volatile LAS unsigned*)smem_all);
  char* smem = smem_all + 256;
  phase_cvt_mix(kparams(), smem);
  __syncthreads();
  phase_mod(kparams(), smem);
  gbar(bar);
  PROBE(5, phase_cvt_mix(kparams(), smem));
  PROBE(5, phase_mod(kparams(), smem));
  run_layer<0>(bar, smem);
  run_layer<1>(bar, smem);
  run_layer<2>(bar, smem);
  run_layer<3>(bar, smem);
  phase_norm1<3>(kparams(), 3, smem);
  PROBE(1, (gbar(bar), phase_norm1<3, true>(kparams(), 3, smem)));
}

static void fill_params(Params& p, void* const* d_in, void* d_out, void* d_ws) {
  for (int i = 0; i < 40; ++i) p.in[i] = (const float*)d_in[i];
  p.out = (float*)d_out;
  p.ws = (char*)d_ws;
  bf16_t* wm = (bf16_t*)(p.ws + OFF_WMIX);
  int nj = 0, item = 0;
  auto add = [&](const float* src, size_t dstoff, int K, int N, int ld, int dld = 0, int f8 = 0) {
    p.jobs[nj].src = src; p.jobs[nj].dst = wm + dstoff; p.jobs[nj].K = K; p.jobs[nj].N = N; p.jobs[nj].ld = ld; p.jobs[nj].item0 = item; p.jobs[nj].dld = dld ? dld : K; p.jobs[nj].pad_ = f8;
    item += (K / 64) * (N / 64); ++nj;
  };
  add(p.in[8], W_WINQKV, 1024, 1536, 1536, 0, 1);
  add(p.in[10], W_WINO, 1024, 1024, 1024);
  add(p.in[11], W_DIFFQKV, 1024, 3072, 3072, 0, 1);
  add(p.in[14], W_DIFFO, 1024, 1024, 1024, 0, 1);
  for (int g = 0; g < 4; ++g) add(p.in[15] + (size_t)g * 65536, W_POOL + (size_t)g * 65536, 256, 256, 256);
  add(p.in[19], W_R, 1024, 1024, 1024, 0, 1);
  add(p.in[19] + (size_t)1 * 1024 * 1024, W_K, 1024, 1024, 1024, 0, 1);
  add(p.in[19] + (size_t)2 * 1024 * 1024, W_V, 1024, 1024, 1024, 0, 1);
  for (int d = 0; d < 2; ++d) add(p.in[21] + (size_t)d * 1024 * 64, W_WA1 + (size_t)d * 64 * 1024, 1024, 64, 64);
  for (int d = 0; d < 2; ++d) add(p.in[24] + (size_t)d * 1024 * 64, W_AA1 + (size_t)d * 64 * 1024, 1024, 64, 64);
  add(p.in[26], W_G1, 1024, 128, 128);
  for (int d = 0; d < 2; ++d) add(p.in[22] + (size_t)d * 64 * 1024, W_WA2 + (size_t)d * 1024 * 128 + d * 64, 64, 1024, 1024, 128);
  for (int d = 0; d < 2; ++d) add(p.in[25] + (size_t)d * 64 * 1024, W_AA2 + (size_t)d * 1024 * 128 + d * 64, 64, 1024, 1024, 128);
  add(p.in[27], W_G2, 128, 1024, 1024);
  add(p.in[33], W_RO, 1024, 1024, 1024);
  p.njobs = nj; p.nitems = item;
}

extern "C" void kernel_launch(void* const* d_in, const int* in_sizes, int n_in, void* d_out, int out_size, void* d_ws, size_t ws_size, hipStream_t stream) {
  if (ws_size < WS_NEED || n_in < 40) return;
  Params p{};
  fill_params(p, d_in, d_out, d_ws);
  (void)hipMemsetAsync(p.ws, 0, 32768, stream);
  (void)hipMemsetAsync(p.ws + OFF_H8 + (size_t)TT * DM, 0, 8 * DM, stream);
  static int grid = 0;
  if (!grid) {
    int dev = 0, cus = 0, per_cu = 0;
    (void)hipGetDevice(&dev);
    (void)hipDeviceGetAttribute(&cus, hipDeviceAttributeMultiprocessorCount, dev);
    (void)hipFuncSetAttribute((const void*)k_fused, hipFuncAttributeMaxDynamicSharedMemorySize, FUSED_LDS);
    (void)hipOccupancyMaxActiveBlocksPerMultiprocessor(&per_cu, (const void*)k_fused, NTH, FUSED_LDS);
    grid = cus * (per_cu < 1 ? per_cu : 1);
  }
  if (grid <= 0) return;
  hipLaunchKernelGGL(k_fused, dim3(grid), dim3(NTH), FUSED_LDS, stream, p);
}
```

```cpp
#include <hip/hip_runtime.h>
#include <stdint.h>
#include <stddef.h>

typedef unsigned short bf16_t;
typedef short bf16x8 __attribute__((ext_vector_type(8)));
typedef short s16x4 __attribute__((ext_vector_type(4)));
typedef float f32x4 __attribute__((ext_vector_type(4)));
typedef float f32x16 __attribute__((ext_vector_type(16)));
typedef unsigned u32x4 __attribute__((ext_vector_type(4)));
typedef unsigned u32x2 __attribute__((ext_vector_type(2)));
typedef float f32x2 __attribute__((ext_vector_type(2)));
#define DI __device__ __forceinline__

constexpr int DM = 1024, NBATCH = 16, SEQ = 4096, CTX = 256;
constexpr int TL = NBATCH * SEQ, TC = NBATCH * CTX, TT = TL + TC;
constexpr int NTH = 512;
constexpr int MOE_PAD = 256;
constexpr int MOE_ROWS = 2 * TT + 32 * MOE_PAD;
constexpr int CAP = TT;

constexpr size_t al256(size_t x) { return (x + 255) & ~(size_t)255; }
constexpr size_t OFF_BAR = 0;
constexpr size_t OFF_CNT = 16384;
constexpr size_t OFF_MOD = 32768;
constexpr size_t OFF_ROPE = al256(OFF_MOD + (size_t)4 * 17 * 6144 * 4);
constexpr size_t OFF_XB = al256(OFF_ROPE + 2 * 64 * 16 * 4);
constexpr size_t OFF_H = al256(OFF_XB + (size_t)TT * DM * 2);
constexpr size_t OFF_H8 = al256(OFF_H + (size_t)(TT + 8) * DM * 2);
constexpr size_t OFF_TOK = al256(OFF_H8 + (size_t)(TT + 8) * DM);
constexpr size_t OFF_ROWL = al256(OFF_TOK + (size_t)TT * 32);
constexpr size_t OFF_WMIX = al256(OFF_ROWL + (size_t)32 * CAP * 4);
constexpr size_t W_WINQKV = 0;
constexpr size_t W_WINO = W_WINQKV + (size_t)1536 * 1024;
constexpr size_t W_DIFFQKV = W_WINO + (size_t)1024 * 1024;
constexpr size_t W_DIFFO = W_DIFFQKV + (size_t)3072 * 1024;
constexpr size_t W_POOL = W_DIFFO + (size_t)1024 * 1024;
constexpr size_t W_R = W_POOL + (size_t)4 * 256 * 256;
constexpr size_t W_K = W_R + (size_t)1024 * 1024;
constexpr size_t W_V = W_K + (size_t)1024 * 1024;
constexpr size_t W_WA1 = W_V + (size_t)1024 * 1024;
constexpr size_t W_AA1 = W_WA1 + (size_t)128 * 1024;
constexpr size_t W_G1 = W_AA1 + (size_t)128 * 1024;
constexpr size_t W_WA2 = W_G1 + (size_t)128 * 1024;
constexpr size_t W_AA2 = W_WA2 + (size_t)2048 * 128;
constexpr size_t W_G2 = W_AA2 + (size_t)2048 * 128;
constexpr size_t W_RO = W_G2 + (size_t)1024 * 128;
constexpr size_t W_MIX_END = W_RO + (size_t)1024 * 1024;
constexpr size_t OFF_WR = al256(OFF_WMIX + W_MIX_END * 2);
constexpr size_t OFF_WMOE = al256(OFF_WR + (size_t)4 * 2 * 48 * 1024 * 2);
constexpr size_t WMOE_DOWN = (size_t)32 * 1024 * 1024;
constexpr size_t OFF_U = al256(OFF_WMOE + ((size_t)32 * 1024 * 1024 + (size_t)32 * 1024 * 512) * 2);
constexpr size_t SZ_TT = (size_t)TT * DM * 2, SZ_TL = (size_t)TL * DM * 2;
constexpr size_t U0_Q = 0, U0_K = U0_Q + SZ_TT, U0_V = U0_K + (size_t)TT * 256 * 2, U0_O = U0_V + (size_t)TT * 256 * 2, U0_END = U0_O + SZ_TT;
constexpr size_t U1_Q = 0, U1_K = U1_Q + SZ_TT, U1_V = U1_K + SZ_TT, U1_O = U1_V + SZ_TT, U1_END = U1_O + SZ_TT;
constexpr size_t U2_Y = 0, U2_END = SZ_TT;
constexpr size_t U3_R = 0, U3_K = U3_R + SZ_TL, U3_V = U3_K + SZ_TT, U3_A0 = U3_V + SZ_TT, U3_A1 = U3_A0 + SZ_TT, U3_LD0 = U3_A1 + SZ_TT,
                 U3_LD1 = U3_LD0 + SZ_TT, U3_LW = U3_LD1 + SZ_TT, U3_LA = U3_LW + (size_t)TT * 128 * 2, U3_LG = U3_LA + (size_t)TT * 128 * 2,
                 U3_G = U3_LG + (size_t)TL * 128 * 2, U3_O0 = U3_G + SZ_TL, U3_O1 = U3_O0 + SZ_TL, U3_END = U3_O1 + SZ_TL;
constexpr size_t U3_XR = U3_A0, U3_XK = U3_A1, U3_XV = U3_LD0;
constexpr size_t UM_ACT = 0, UM_YB = UM_ACT + (size_t)MOE_ROWS * 512 * 2, UM_END = UM_YB + (size_t)MOE_ROWS * 1024 * 2;
constexpr size_t cmax(size_t a, size_t b) { return a > b ? a : b; }
constexpr size_t U_SIZE = cmax(cmax(cmax(U0_END, U1_END), U2_END), cmax(U3_END, UM_END));
constexpr size_t WS_NEED = OFF_U + U_SIZE;

struct CvtJob { const float* src; bf16_t* dst; int K, N, ld, item0, dld, pad_; };
constexpr int NJOBS = 24;
struct Params {
  const float* in[40];
  float* out;
  char* ws;
  CvtJob jobs[NJOBS];
  int njobs, nitems;
};

typedef const __attribute__((address_space(4))) Params* KP;
DI KP kparams() { KP q = (KP)__builtin_amdgcn_kernarg_segment_ptr(); asm volatile("" : "+s"(q)); return q; }
DI char* ows(KP p) {
  const unsigned long long w = (unsigned long long)p->ws;
  unsigned lo = (unsigned)w, hi = (unsigned)(w >> 32);
  asm volatile("" : "+v"(lo), "+v"(hi));
  lo = __builtin_amdgcn_readfirstlane(lo); hi = __builtin_amdgcn_readfirstlane(hi);
  return (char*)(__attribute__((address_space(1))) char*)(((unsigned long long)hi << 32) | lo);
}
DI const float* gin(KP p, int i) { return (const float*)(__attribute__((address_space(1))) const float*)p->in[i]; }
DI float* gout(KP p) { return (float*)(__attribute__((address_space(1))) float*)p->out; }
DI int otid() { int t = threadIdx.x; asm volatile("" : "+v"(t)); return t; }
DI int obid() { int b = blockIdx.x; asm volatile("" : "+s"(b)); return b; }
DI unsigned pk2(float lo, float hi) {
  typedef __bf16 bf2 __attribute__((ext_vector_type(2)));
  typedef float f2 __attribute__((ext_vector_type(2)));
  f2 v = {lo, hi};
  return __builtin_bit_cast(unsigned, __builtin_convertvector(v, bf2));
}
DI float clamp8(float x) { return __builtin_amdgcn_fmed3f(x, -440.0f, 440.0f); }
DI void swap32(float x, float& a, float& b) {
  a = x; b = x;
  asm volatile("s_nop 1\n\tv_permlane32_swap_b32 %0, %1\n\ts_nop 1" : "+v"(a), "+v"(b));
}
DI unsigned pk4_fp8_nc(float a, float b, float c, float d) { int w; asm("" : "=v"(w)); w = __builtin_amdgcn_cvt_pk_fp8_f32(a, b, w, false); w = __builtin_amdgcn_cvt_pk_fp8_f32(c, d, w, true); return (unsigned)w; }
DI unsigned pk4_fp8(float a, float b, float c, float d) { int w = __builtin_amdgcn_cvt_pk_fp8_f32(clamp8(a), clamp8(b), 0, false); w = __builtin_amdgcn_cvt_pk_fp8_f32(clamp8(c), clamp8(d), w, true); return (unsigned)w; }
DI bf16_t f2bf(float x) { return (bf16_t)(pk2(x, 0.f) & 0xffffu); }
DI float bf2f(bf16_t b) { return __uint_as_float(((unsigned)b) << 16); }
DI float bflo(unsigned u) { return __uint_as_float(u << 16); }
DI float bfhi(unsigned u) { return __uint_as_float(u & 0xffff0000u); }
DI float wave_sum(float v) {
#pragma unroll
  for (int o = 32; o >= 1; o >>= 1) v += __shfl_xor(v, o);
  return v;
}
DI float sigmoidf_(float x) { return __builtin_amdgcn_rcpf(1.0f + __expf(-x)); }
DI int row_bi(int r) { return r < TL ? (r >> 12) : 16; }
DI bf16_t* xrow_ptr(KP p, char* ws, int r) { return (bf16_t*)(ws + OFF_XB) + (size_t)r * DM; }
DI f32x4 ldbf4(const bf16_t* q) { const u32x2 w = *(const u32x2*)q; return (f32x4){bflo(w.x), bfhi(w.x), bflo(w.y), bfhi(w.y)}; }
DI void stbf4(bf16_t* q, const f32x4& v) { u32x2 w; w.x = pk2(v[0], v[1]); w.y = pk2(v[2], v[3]); *(u32x2*)q = w; }
DI const float* modp(char* ws, int layer, int bi, int which) { return (const float*)(ws + OFF_MOD) + ((size_t)(layer * 17 + bi) * 6 + which) * DM; }
#define MFMA16(a, b, c) __builtin_amdgcn_mfma_f32_16x16x32_bf16((a), (b), (c), 0, 0, 0)
#define MFMA32(a, b, c) __builtin_amdgcn_mfma_f32_32x32x16_bf16((a), (b), (c), 0, 0, 0)

constexpr int SGLD = 72;
constexpr int SG_LDS = 2 * 128 * SGLD * 2;
template <class AL, class BL, class EP>
DI void sgemm_tile(char* smem, int K, AL la, BL lb, EP ep) {
  bf16_t* sA = (bf16_t*)smem;
  bf16_t* sB = sA + 128 * SGLD;
  const int tid = otid(), lane = tid & 63, wid = tid >> 6, wr = wid >> 2, wc = wid & 3, fr = lane & 15, fq = lane >> 4;
  f32x4 acc[4][2];
#pragma unroll
  for (int m = 0; m < 4; ++m)
#pragma unroll
    for (int n = 0; n < 2; ++n) acc[m][n] = (f32x4){0.f, 0.f, 0.f, 0.f};
  const int r_ = tid >> 3, k_ = (tid & 7) * 8;
  u32x4 ra0 = la(r_, k_), ra1 = la(r_ + 64, k_), rb0 = lb(r_, k_), rb1 = lb(r_ + 64, k_);
  const int nk = K >> 6;
  for (int kt = 0; kt < nk; ++kt) {
    __syncthreads();
    *(u32x4*)(sA + r_ * SGLD + k_) = ra0;
    *(u32x4*)(sA + (r_ + 64) * SGLD + k_) = ra1;
    *(u32x4*)(sB + r_ * SGLD + k_) = rb0;
    *(u32x4*)(sB + (r_ + 64) * SGLD + k_) = rb1;
    __syncthreads();
    if (kt + 1 < nk) {
      const int kk = (kt + 1) * 64 + k_;
      ra0 = la(r_, kk); ra1 = la(r_ + 64, kk); rb0 = lb(r_, kk); rb1 = lb(r_ + 64, kk);
    }
#pragma unroll
    for (int ks = 0; ks < 2; ++ks) {
      bf16x8 af[4], bq[2];
#pragma unroll
      for (int m = 0; m < 4; ++m) af[m] = *(const bf16x8*)(sA + (wr * 64 + m * 16 + fr) * SGLD + ks * 32 + fq * 8);
#pragma unroll
      for (int n = 0; n < 2; ++n) bq[n] = *(const bf16x8*)(sB + (wc * 32 + n * 16 + fr) * SGLD + ks * 32 + fq * 8);
#pragma unroll
      for (int m = 0; m < 4; ++m)
#pragma unroll
        for (int n = 0; n < 2; ++n) acc[m][n] = MFMA16(af[m], bq[n], acc[m][n]);
    }
  }
  ep(acc, wr * 64, wc * 32, fr, fq);
}
DI u32x4 ld16(const bf16_t* p) { return *(const u32x4*)p; }

#define LAS __attribute__((address_space(3)))
namespace fg {
typedef int v8i_t __attribute__((ext_vector_type(8)));
typedef int v4i_t __attribute__((ext_vector_type(4)));
constexpr int BM = 256, BK = 64, HALF = 128, HTB = HALF * BK * 2, STAGE_BYTES = 8 * HTB, NXCD = 8, WGM = 8;
DI int lds_byte(int r, int c) { const int st = (r >> 4) * 2 + (c >> 5), rr = r & 15, cc = c & 31, ob = rr * 64 + cc * 2; return st * 1024 + (ob ^ (((ob >> 9) & 1) << 5)); }
DI void stage_rc(int b, int& R, int& C) { const int st = b / 1024, sb = b % 1024, swz = sb ^ (((sb >> 9) & 1) << 5); R = (st >> 1) * 16 + swz / 64; C = (st & 1) * 32 + (swz % 64) / 2; }
struct Unit { const char* A; const char* B; int pm, pn, aux; };
DI bool static_order(int i, int G, int c, int nM, int nN, int& pm, int& pn) {
  const int nwg = nM * nN;
  const long L = (long)i * G + c; if (L >= nwg) return false;
  int wgid = (int)L; { const int q = nwg / NXCD, r = nwg % NXCD, xcd = wgid % NXCD, off = wgid / NXCD; wgid = (xcd < r ? xcd * (q + 1) : r * (q + 1) + (xcd - r) * q) + off; }
  const int nig = WGM * nN, gid = wgid / nig, fm = gid * WGM, gsz = (nM - fm) < WGM ? (nM - fm) : WGM;
  pm = fm + ((wgid % nig) % gsz); pn = (wgid % nig) / gsz; return true;
}
struct DenseSched {
  const char* A; const char* B; int nM, nN, G, c; size_t tA, tB;
  DI bool next(int i, Unit& u) const { int pm, pn; if (!static_order(i, G, c, nM, nN, pm, pn)) return false; u.pm = pm; u.pn = pn; u.aux = 0; u.A = A + (size_t)pm * tA; u.B = B + (size_t)pn * tB; return true; }
  DI const LAS int* rows(int) const { return nullptr; }
};

DI int perm32(int rho) { const int n = rho >> 4, i = rho & 15; return 8 * (i >> 2) + 4 * n + (i & 3); }
template <bool GATHER, bool PERM = false, class Epi, class Sched>
DI void gemm_phase(LAS unsigned char* lds, const int K, const int lda, const int ldb, const Sched& S, const Epi& E) {
  const int tid = otid(), wid = __builtin_amdgcn_readfirstlane(tid >> 6), lane = tid & 63, wr = wid >> 2, wc = wid & 3, fr = lane & 15, fq = lane >> 4;
  const int nt = K / BK;
  unsigned voffA[2], voffB[2]; int sR[2], sC[2];
#pragma unroll
  for (int i = 0; i < 2; ++i) { int R, C; stage_rc(tid * 16 + i * 8192, R, C); sR[i] = R; sC[i] = C; voffA[i] = (unsigned)(R * lda + C) * 2u; const int Rb = PERM ? ((R & ~31) + perm32(R & 31)) : R; voffB[i] = (unsigned)(Rb * ldb + C) * 2u; }
  const size_t kstep = (size_t)(BK * 2), hstepA = (size_t)HALF * lda * 2, hstepB = (size_t)HALF * ldb * 2;
  const unsigned ldsw = (unsigned)wid * 1024u;
  const int aoff = lds_byte(wr * 64 + fr, fq * 8), boff = lds_byte(wc * 32 + fr, fq * 8);
#define FG_SA(b, h) (((b) * 2 + (h)) * HTB)
#define FG_SB(b, h) ((4 + (b) * 2 + (h)) * HTB)
#define FG_GLDS(gp, bufoff, i_) __builtin_amdgcn_global_load_lds((const unsigned*)(gp), (LAS unsigned*)(lds + (bufoff) + ldsw + (i_) * 8192), 16, 0, 0)
#define FG_STAGE_B(bufoff, gbase) do { const char* _gb = (gbase); FG_GLDS(_gb + voffB[0], bufoff, 0); FG_GLDS(_gb + voffB[1], bufoff, 1); } while (0)
#define FG_STAGE_A(bufoff, NX, H, KB) do { \
    if constexpr (GATHER) { const char* _gb = ((NX) ? nA : cA) + (KB); FG_GLDS(_gb + ((NX) ? gn[H][0] : gc[H][0]), bufoff, 0); FG_GLDS(_gb + ((NX) ? gn[H][1] : gc[H][1]), bufoff, 1); } \
    else { const char* _gb = ((NX) ? nA : cA) + (size_t)(H) * hstepA + (KB); FG_GLDS(_gb + voffA[0], bufoff, 0); FG_GLDS(_gb + voffA[1], bufoff, 1); } } while (0)
#define FG_LDA(dst, b, h) do { _Pragma("unroll") for (int m = 0; m < 4; ++m) _Pragma("unroll") for (int k = 0; k < 2; ++k) dst[m][k] = *(const LAS bf16x8*)(lds + FG_SA(b, h) + aoff + m * 2048 + k * 1024); } while (0)
#define FG_LDB(dst, b, h) do { _Pragma("unroll") for (int n = 0; n < 2; ++n) _Pragma("unroll") for (int k = 0; k < 2; ++k) dst[n][k] = *(const LAS bf16x8*)(lds + FG_SB(b, h) + boff + n * 2048 + k * 1024); } while (0)
#define FG_MMA(ai, bj, At, Bt) do { __builtin_amdgcn_s_setprio(1); _Pragma("unroll") for (int m = 0; m < 4; ++m) _Pragma("unroll") for (int n = 0; n < 2; ++n) _Pragma("unroll") for (int k = 0; k < 2; ++k) \
    acc[ai][bj][m][n] = __builtin_amdgcn_mfma_f32_16x16x32_bf16(Bt[n][k], At[m][k], acc[ai][bj][m][n], 0, 0, 0); __builtin_amdgcn_s_setprio(0); } while (0)
#define FG_WAIT_V(n) asm volatile("s_waitcnt vmcnt(" #n ")" ::: "memory")
#define FG_WAIT_L(n) asm volatile("s_waitcnt lgkmcnt(" #n ")" ::: "memory")
#define FG_BAR __builtin_amdgcn_s_barrier()
#define FG_SCHED __builtin_amdgcn_sched_barrier(0)
  Unit cur, nxt; int ui = 0;
  if (!S.next(0, cur)) return;
  f32x4 acc[2][2][4][2];
#pragma unroll
  for (int a = 0; a < 2; ++a)
#pragma unroll
    for (int b = 0; b < 2; ++b)
#pragma unroll
      for (int m = 0; m < 4; ++m)
#pragma unroll
        for (int n = 0; n < 2; ++n) acc[a][b][m][n] = (f32x4){0.f, 0.f, 0.f, 0.f};
  bf16x8 At[4][2], B0[2][2], B1[2][2];
  const char* cA = cur.A; const char* cB = cur.B;
  const char* nA = cA; const char* nB = cB;
  unsigned gc[2][2] = {{0u, 0u}, {0u, 0u}}, gn[2][2] = {{0u, 0u}, {0u, 0u}};
  if constexpr (GATHER) {
    const LAS int* rw = S.rows(0);
#pragma unroll
    for (int h = 0; h < 2; ++h)
#pragma unroll
      for (int i = 0; i < 2; ++i) { gc[h][i] = (unsigned)(rw[h * HALF + sR[i]] * lda + sC[i]) * 2u; gn[h][i] = gc[h][i]; }
  }
  FG_STAGE_B(FG_SB(0, 0), cB); FG_STAGE_B(FG_SB(0, 1), cB + hstepB); FG_STAGE_A(FG_SA(0, 0), false, 0, 0); FG_STAGE_A(FG_SA(0, 1), false, 1, 0);
  if (wr == 1) FG_BAR;
  FG_WAIT_V(2); FG_BAR;
  FG_STAGE_B(FG_SB(1, 0), cB + kstep); FG_STAGE_A(FG_SA(1, 0), false, 0, kstep); FG_STAGE_B(FG_SB(1, 1), cB + hstepB + kstep);
  FG_WAIT_V(6); FG_BAR;
  for (;;) {
    const bool has_next = S.next(ui + 1, nxt);
    nA = has_next ? nxt.A : cA; nB = has_next ? nxt.B : cB;
    if constexpr (GATHER) {
      if (has_next) {
        const LAS int* rw = S.rows(ui + 1);
#pragma unroll
        for (int h = 0; h < 2; ++h)
#pragma unroll
          for (int i = 0; i < 2; ++i) gn[h][i] = (unsigned)(rw[h * HALF + sR[i]] * lda + sC[i]) * 2u;
      } else {
#pragma unroll
        for (int h = 0; h < 2; ++h)
#pragma unroll
          for (int i = 0; i < 2; ++i) gn[h][i] = gc[h][i];
      }
      FG_WAIT_L(0);
    }
    for (int t = 0; t < nt; t += 2) {
      const bool last = (t == nt - 2);
      const size_t k1 = (size_t)(t + 1) * kstep;
      const size_t k2 = last ? 0 : (size_t)(t + 2) * kstep, k3 = k2 + kstep;
      const char* b2 = last ? nB : cB + (size_t)(t + 2) * kstep; const char* b3 = b2 + kstep;
      FG_LDB(B0, 0, 0); FG_LDB(B1, 0, 1); FG_SCHED; FG_LDA(At, 0, 0); FG_STAGE_A(FG_SA(1, 1), false, 1, k1);
      FG_WAIT_V(8); FG_WAIT_L(0); FG_BAR; FG_MMA(0, 0, At, B0); FG_MMA(0, 1, At, B1); FG_BAR; FG_SCHED;
      FG_LDA(At, 0, 1); FG_STAGE_B(FG_SB(0, 0), b2); FG_STAGE_B(FG_SB(0, 1), b2 + hstepB); FG_STAGE_A(FG_SA(0, 0), last, 0, k2);
      FG_WAIT_V(8); FG_WAIT_L(0); FG_BAR; FG_MMA(1, 0, At, B0); FG_MMA(1, 1, At, B1); FG_BAR; FG_SCHED;
      FG_LDB(B0, 1, 0); FG_LDB(B1, 1, 1); FG_SCHED; FG_LDA(At, 1, 0); FG_STAGE_A(FG_SA(0, 1), last, 1, k2);
      FG_WAIT_V(8); FG_WAIT_L(0); FG_BAR; FG_MMA(0, 0, At, B0); FG_MMA(0, 1, At, B1); FG_BAR; FG_SCHED;
      FG_LDA(At, 1, 1); FG_STAGE_B(FG_SB(1, 0), b3); FG_STAGE_B(FG_SB(1, 1), b3 + hstepB); FG_STAGE_A(FG_SA(1, 0), last, 0, k3);
      FG_WAIT_V(8); FG_WAIT_L(0); FG_BAR; FG_MMA(1, 0, At, B0); FG_MMA(1, 1, At, B1); FG_BAR; FG_SCHED;
    }
    if (wr == 0) FG_BAR;
    E(acc, cur, wr, wc, fr, fq);
    if (!has_next) break;
#pragma unroll
    for (int a = 0; a < 2; ++a)
#pragma unroll
      for (int b = 0; b < 2; ++b)
#pragma unroll
        for (int m = 0; m < 4; ++m)
#pragma unroll
          for (int n = 0; n < 2; ++n) acc[a][b][m][n] = (f32x4){0.f, 0.f, 0.f, 0.f};
    cur = nxt; cA = nA; cB = nB; ++ui;
    if constexpr (GATHER) {
#pragma unroll
      for (int h = 0; h < 2; ++h)
#pragma unroll
        for (int i = 0; i < 2; ++i) gc[h][i] = gn[h][i];
    }
    if (wr == 1) FG_BAR;
  }
  FG_WAIT_V(0);
  FG_BAR;
#undef FG_SA
#undef FG_SB
#undef FG_GLDS
#undef FG_STAGE_A
#undef FG_STAGE_B
#undef FG_LDA
#undef FG_LDB
#undef FG_MMA
#undef FG_WAIT_V
#undef FG_WAIT_L
#undef FG_BAR
#undef FG_SCHED
}
DI int perm32f8(int s_) { return 16 * ((s_ >> 2) & 1) + (s_ & 3) + 4 * (s_ >> 3); }
template <bool GATHER, bool PERM = false, class Epi, class Sched>
DI void gemm_phase_f8(LAS unsigned char* lds, const int K, const int lda, const int ldb, const Sched& S, const Epi& E) {
  const int tid = otid(), wid = __builtin_amdgcn_readfirstlane(tid >> 6), lane = tid & 63, wr = wid >> 2, wc = wid & 3, fr = lane & 15, fq = lane >> 4;
  const int nt = K / BK;
  unsigned voffA[2], voffB[2]; int sR[2], sC[2];
#pragma unroll
  for (int i = 0; i < 2; ++i) { int R, C; stage_rc(tid * 16 + i * 8192, R, C); sR[i] = R; sC[i] = C; voffA[i] = (unsigned)(R * lda + C) * 2u; const int Rb = PERM ? ((R & ~31) + perm32f8(R & 31)) : R; voffB[i] = (unsigned)(Rb * ldb + C) * 2u; }
  const size_t kstep = (size_t)(BK * 2), hstepA = (size_t)HALF * lda * 2, hstepB = (size_t)HALF * ldb * 2;
  const unsigned ldsw = (unsigned)wid * 1024u;
  const int r32 = lane & 31, g32 = lane >> 5;
  const int aoff = lds_byte(wr * 64 + r32, 16 * g32), boff = lds_byte(wc * 32 + r32, 16 * g32);
#define FG_SA(b, h) (((b) * 2 + (h)) * HTB)
#define FG_SB(b, h) ((4 + (b) * 2 + (h)) * HTB)
#define FG_GLDS(gp, bufoff, i_) __builtin_amdgcn_global_load_lds((const unsigned*)(gp), (LAS unsigned*)(lds + (bufoff) + ldsw + (i_) * 8192), 16, 0, 0)
#define FG_STAGE_B(bufoff, gbase) do { const char* _gb = (gbase); FG_GLDS(_gb + voffB[0], bufoff, 0); FG_GLDS(_gb + voffB[1], bufoff, 1); } while (0)
#define FG_STAGE_A(bufoff, NX, H, KB) do { \
    if constexpr (GATHER) { const char* _gb = ((NX) ? nA : cA) + (KB); FG_GLDS(_gb + ((NX) ? gn[H][0] : gc[H][0]), bufoff, 0); FG_GLDS(_gb + ((NX) ? gn[H][1] : gc[H][1]), bufoff, 1); } \
    else { const char* _gb = ((NX) ? nA : cA) + (size_t)(H) * hstepA + (KB); FG_GLDS(_gb + voffA[0], bufoff, 0); FG_GLDS(_gb + voffA[1], bufoff, 1); } } while (0)
#define FG_LDA(dst, b, h) do { _Pragma("unroll") for (int m = 0; m < 2; ++m) _Pragma("unroll") for (int k = 0; k < 2; ++k) { const LAS v4i_t* q_ = (const LAS v4i_t*)(lds + FG_SA(b, h) + aoff + m * 4096 + k * 1024); dst[m][k] = __builtin_shufflevector(q_[0], q_[1], 0, 1, 2, 3, 4, 5, 6, 7); } } while (0)
#define FG_LDB(dst, b, h) do { _Pragma("unroll") for (int k = 0; k < 2; ++k) { const LAS v4i_t* q_ = (const LAS v4i_t*)(lds + FG_SB(b, h) + boff + k * 1024); dst[k] = __builtin_shufflevector(q_[0], q_[1], 0, 1, 2, 3, 4, 5, 6, 7); } } while (0)
#define FG_MMA(ai, bj, At, Bt) do { __builtin_amdgcn_s_setprio(1); _Pragma("unroll") for (int m = 0; m < 2; ++m) _Pragma("unroll") for (int k = 0; k < 2; ++k) \
    acc[ai][bj][m] = __builtin_amdgcn_mfma_scale_f32_32x32x64_f8f6f4(Bt[k], At[m][k], acc[ai][bj][m], 0, 0, 0, 0x7f7f7f7f, 0, 0x7f7f7f7f); __builtin_amdgcn_s_setprio(0); } while (0)
#define FG_WAIT_V(n) asm volatile("s_waitcnt vmcnt(" #n ")" ::: "memory")
#define FG_WAIT_L(n) asm volatile("s_waitcnt lgkmcnt(" #n ")" ::: "memory")
#define FG_BAR __builtin_amdgcn_s_barrier()
#define FG_SCHED __builtin_amdgcn_sched_barrier(0)
  Unit cur, nxt; int ui = 0;
  if (!S.next(0, cur)) return;
  f32x16 acc[2][2][2];
#pragma unroll
  for (int a = 0; a < 2; ++a)
#pragma unroll
    for (int b = 0; b < 2; ++b)
#pragma unroll
      for (int m = 0; m < 2; ++m)
#pragma unroll
        for (int n = 0; n < 16; ++n) acc[a][b][m][n] = 0.f;
  v8i_t At[2][2], B0[2], B1[2];
  const char* cA = cur.A; const char* cB = cur.B;
  const char* nA = cA; const char* nB = cB;
  unsigned gc[2][2] = {{0u, 0u}, {0u, 0u}}, gn[2][2] = {{0u, 0u}, {0u, 0u}};
  if constexpr (GATHER) {
    const LAS int* rw = S.rows(0);
#pragma unroll
    for (int h = 0; h < 2; ++h)
#pragma unroll
      for (int i = 0; i < 2; ++i) { gc[h][i] = (unsigned)(rw[h * HALF + sR[i]] * lda + sC[i]) * 2u; gn[h][i] = gc[h][i]; }
  }
  FG_STAGE_B(FG_SB(0, 0), cB); FG_STAGE_B(FG_SB(0, 1), cB + hstepB); FG_STAGE_A(FG_SA(0, 0), false, 0, 0); FG_STAGE_A(FG_SA(0, 1), false, 1, 0);
  if (wr == 1) FG_BAR;
  FG_WAIT_V(2); FG_BAR;
  FG_STAGE_B(FG_SB(1, 0), cB + kstep); FG_STAGE_A(FG_SA(1, 0), false, 0, kstep); FG_STAGE_B(FG_SB(1, 1), cB + hstepB + kstep);
  FG_WAIT_V(6); FG_BAR;
  for (;;) {
    const bool has_next = S.next(ui + 1, nxt);
    nA = has_next ? nxt.A : cA; nB = has_next ? nxt.B : cB;
    if constexpr (GATHER) {
      if (has_next) {
        const LAS int* rw = S.rows(ui + 1);
#pragma unroll
        for (int h = 0; h < 2; ++h)
#pragma unroll
          for (int i = 0; i < 2; ++i) gn[h][i] = (unsigned)(rw[h * HALF + sR[i]] * lda + sC[i]) * 2u;
      } else {
#pragma unroll
        for (int h = 0; h < 2; ++h)
#pragma unroll
          for (int i = 0; i < 2; ++i) gn[h][i] = gc[h][i];
      }
      FG_WAIT_L(0);
    }
#pragma nounroll
    for (int t = 0; t < nt; t += 2) {
      const bool last = (t == nt - 2);
      const size_t k1 = (size_t)(t + 1) * kstep;
      const size_t k2 = last ? 0 : (size_t)(t + 2) * kstep, k3 = k2 + kstep;
      const char* b2 = last ? nB : cB + (size_t)(t + 2) * kstep; const char* b3 = b2 + kstep;
      FG_LDB(B0, 0, 0); FG_LDB(B1, 0, 1); FG_SCHED; FG_LDA(At, 0, 0); FG_STAGE_A(FG_SA(1, 1), false, 1, k1);
      FG_WAIT_V(8); FG_WAIT_L(0); FG_BAR; FG_MMA(0, 0, At, B0); FG_MMA(0, 1, At, B1); FG_BAR; FG_SCHED;
      FG_LDA(At, 0, 1); FG_STAGE_B(FG_SB(0, 0), b2); FG_STAGE_B(FG_SB(0, 1), b2 + hstepB); FG_STAGE_A(FG_SA(0, 0), last, 0, k2);
      FG_WAIT_V(8); FG_WAIT_L(0); FG_BAR; FG_MMA(1, 0, At, B0); FG_MMA(1, 1, At, B1); FG_BAR; FG_SCHED;
      FG_LDB(B0, 1, 0); FG_LDB(B1, 1, 1); FG_SCHED; FG_LDA(At, 1, 0); FG_STAGE_A(FG_SA(0, 1), last, 1, k2);
      FG_WAIT_V(8); FG_WAIT_L(0); FG_BAR; FG_MMA(0, 0, At, B0); FG_MMA(0, 1, At, B1); FG_BAR; FG_SCHED;
      FG_LDA(At, 1, 1); FG_STAGE_B(FG_SB(1, 0), b3); FG_STAGE_B(FG_SB(1, 1), b3 + hstepB); FG_STAGE_A(FG_SA(1, 0), last, 0, k3);
      FG_WAIT_V(8); FG_WAIT_L(0); FG_BAR; FG_MMA(1, 0, At, B0); FG_MMA(1, 1, At, B1); FG_BAR; FG_SCHED;
    }
    if (wr == 0) FG_BAR;
    E(acc, cur, wr, wc, r32, g32);
    if (!has_next) break;
#pragma unroll
    for (int a = 0; a < 2; ++a)
#pragma unroll
      for (int b = 0; b < 2; ++b)
#pragma unroll
        for (int m = 0; m < 2; ++m)
#pragma unroll
          for (int n = 0; n < 16; ++n) acc[a][b][m][n] = 0.f;
    cur = nxt; cA = nA; cB = nB; ++ui;
    if constexpr (GATHER) {
#pragma unroll
      for (int h = 0; h < 2; ++h)
#pragma unroll
        for (int i = 0; i < 2; ++i) gc[h][i] = gn[h][i];
    }
    if (wr == 1) FG_BAR;
  }
  FG_WAIT_V(0);
  FG_BAR;
#undef FG_SA
#undef FG_SB
#undef FG_GLDS
#undef FG_STAGE_A
#undef FG_STAGE_B
#undef FG_LDA
#undef FG_LDB
#undef FG_MMA
#undef FG_WAIT_V
#undef FG_WAIT_L
#undef FG_BAR
#undef FG_SCHED
}
}

DI void cvt_tile(char* smem, const float* src, int ld, bf16_t* dst, int K, int N, int item, int dld, int f8) {
  float* tile = (float*)smem;
  const int ntn = N >> 6, kt = item / ntn, nt = item % ntn, k0 = kt * 64, n0 = nt * 64, tid = otid();
  __syncthreads();
#pragma unroll
  for (int i = 0; i < 8; ++i) { const int idx = tid + i * NTH, r = idx >> 6, c = idx & 63; tile[r * 65 + c] = src[(size_t)(k0 + r) * ld + n0 + c]; }
  __syncthreads();
  const int n = tid >> 3, k8 = (tid & 7) * 8;
  if (f8) {
    u32x2 o8;
    o8.x = pk4_fp8(tile[(k8 + 0) * 65 + n] * 32.f, tile[(k8 + 1) * 65 + n] * 32.f, tile[(k8 + 2) * 65 + n] * 32.f, tile[(k8 + 3) * 65 + n] * 32.f);
    o8.y = pk4_fp8(tile[(k8 + 4) * 65 + n] * 32.f, tile[(k8 + 5) * 65 + n] * 32.f, tile[(k8 + 6) * 65 + n] * 32.f, tile[(k8 + 7) * 65 + n] * 32.f);
    *(u32x2*)((unsigned char*)dst + (size_t)(n0 + n) * dld + k0 + k8) = o8;
    return;
  }
  u32x4 o;
  o.x = pk2(tile[(k8 + 0) * 65 + n], tile[(k8 + 1) * 65 + n]);
  o.y = pk2(tile[(k8 + 2) * 65 + n], tile[(k8 + 3) * 65 + n]);
  o.z = pk2(tile[(k8 + 4) * 65 + n], tile[(k8 + 5) * 65 + n]);
  o.w = pk2(tile[(k8 + 6) * 65 + n], tile[(k8 + 7) * 65 + n]);
  *(u32x4*)(dst + (size_t)(n0 + n) * dld + k0 + k8) = o;
}
DI void phase_cvt_mix(KP p, char* smem) {
  char* const ws = ows(p);
  {
    bf16_t* wz = (bf16_t*)(ws + OFF_WMIX) + W_WA2;
    for (int i = obid() * NTH + otid(); i < 2 * 2048 * 8; i += gridDim.x * NTH) {
      const int row = i >> 3, c8 = i & 7, d = (row & 2047) >> 10;
      *(u32x4*)(wz + (size_t)row * 128 + (1 - d) * 64 + c8 * 8) = (u32x4){0u, 0u, 0u, 0u};
    }
  }
  for (int it = obid(); it < p->nitems; it += gridDim.x) {
    int j = 0;
    while (j + 1 < p->njobs && p->jobs[j + 1].item0 <= it) ++j;
    cvt_tile(smem, (const float*)(__attribute__((address_space(1))) const float*)p->jobs[j].src, p->jobs[j].ld, (bf16_t*)(__attribute__((address_space(1))) bf16_t*)p->jobs[j].dst, p->jobs[j].K, p->jobs[j].N, it - p->jobs[j].item0, p->jobs[j].dld, p->jobs[j].pad_);
  }
}
constexpr float O8_SCALE = 4.0f;
constexpr float X8_SCALE = 4.0f;
constexpr float W8_SCALE = 32.0f, A8_SCALE = 4.0f, WD8_SCALE = 16.0f;
DI int up_src_col(int np) {
  const int slab = np >> 5, pos = np & 31, q = pos & 15, hh = (q >> 2) & 1, i = (q & 3) + 4 * (q >> 3);
  return (pos >> 4) * 512 + slab * 16 + 8 * hh + i;
}
DI void phase_cvt_moe(KP p, int layer, char* smem) {
  char* const ws = ows(p);
  float* tile = (float*)smem;
  bf16_t* wm = (bf16_t*)(ws + OFF_WMOE);
  const int tid = otid();
  const int NUP = 32 * 256, NDN = 32 * 128;
  for (int it = obid(); it < NUP + NDN; it += gridDim.x) {
    if (it < NUP) {
      const int e = it >> 8, t = it & 255, kt = t >> 4, nt = t & 15, k0 = kt * 64, n0 = nt * 64;
      const float* src = gin(p, 38) + ((size_t)(layer * 32 + e) * 1024) * 1024;
      __syncthreads();
#pragma unroll
      for (int i = 0; i < 8; ++i) { const int idx = tid + i * NTH, r = idx >> 6, c = idx & 63; tile[r * 65 + c] = src[(size_t)(k0 + r) * 1024 + up_src_col(n0 + c)]; }
      __syncthreads();
      const int n = tid >> 3, k8 = (tid & 7) * 8;
      u32x2 o;
      o.x = pk4_fp8(tile[(k8 + 0) * 65 + n] * W8_SCALE, tile[(k8 + 1) * 65 + n] * W8_SCALE, tile[(k8 + 2) * 65 + n] * W8_SCALE, tile[(k8 + 3) * 65 + n] * W8_SCALE);
      o.y = pk4_fp8(tile[(k8 + 4) * 65 + n] * W8_SCALE, tile[(k8 + 5) * 65 + n] * W8_SCALE, tile[(k8 + 6) * 65 + n] * W8_SCALE, tile[(k8 + 7) * 65 + n] * W8_SCALE);
      *(u32x2*)((unsigned char*)wm + (size_t)e * 1024 * 1024 + (size_t)(n0 + n) * 1024 + k0 + k8) = o;
    } else {
      const int i2 = it - NUP, e = i2 >> 7, t = i2 & 127;
      const int kt = t >> 4, nt = t & 15, k0 = kt * 64, n0 = nt * 64;
      const float* src = gin(p, 39) + ((size_t)(layer * 32 + e) * 512) * 1024;
      __syncthreads();
#pragma unroll
      for (int i = 0; i < 8; ++i) { const int idx = tid + i * NTH, r = idx >> 6, c = idx & 63; tile[r * 65 + c] = src[(size_t)(k0 + r) * 1024 + n0 + c]; }
      __syncthreads();
      const int n = tid >> 3, k8 = (tid & 7) * 8;
      u32x2 o;
      o.x = pk4_fp8(tile[(k8 + 0) * 65 + n] * WD8_SCALE, tile[(k8 + 1) * 65 + n] * WD8_SCALE, tile[(k8 + 2) * 65 + n] * WD8_SCALE, tile[(k8 + 3) * 65 + n] * WD8_SCALE);
      o.y = pk4_fp8(tile[(k8 + 4) * 65 + n] * WD8_SCALE, tile[(k8 + 5) * 65 + n] * WD8_SCALE, tile[(k8 + 6) * 65 + n] * WD8_SCALE, tile[(k8 + 7) * 65 + n] * WD8_SCALE);
      *(u32x2*)((unsigned char*)(wm + WMOE_DOWN) + (size_t)e * 1024 * 512 + (size_t)(n0 + n) * 512 + k0 + k8) = o;
    }
  }
}

constexpr int MOD_LDS = 17 * 1024 * 4 + 8 * 17 * 64 * 4;
DI void phase_mod(KP p, char* smem) {
  char* const ws = ows(p);
  float* sc = (float*)smem;
  float* red = sc + 17 * 1024;
  const int tid = otid();
  for (int i = tid; i < 17 * 1024; i += NTH) {
    const int bi = i >> 10, k = i & 1023;
    const float v = bi < 16 ? gin(p, 1)[bi * 1024 + k] : gin(p, 3)[k];
    sc[i] = v / (1.0f + __expf(-v));
  }
  __syncthreads();
  const int col = tid & 63, ks = tid >> 6;
  for (int it = obid(); it < 4 * 96; it += gridDim.x) {
    const int l = it / 96, j = (it % 96) * 64 + col;
    const float* w = gin(p, 4) + (size_t)l * 1024 * 6144 + j;
    float acc[17];
#pragma unroll
    for (int b = 0; b < 17; ++b) acc[b] = 0.f;
    for (int k = ks * 128; k < ks * 128 + 128; ++k) {
      const float wv = w[(size_t)k * 6144];
#pragma unroll
      for (int b = 0; b < 17; ++b) acc[b] += sc[b * 1024 + k] * wv;
    }
    __syncthreads();
#pragma unroll
    for (int b = 0; b < 17; ++b) red[(ks * 17 + b) * 64 + col] = acc[b];
    __syncthreads();
    for (int o = tid; o < 17 * 64; o += NTH) {
      const int b = o >> 6, c = o & 63;
      float s = 0.f;
#pragma unroll
      for (int q = 0; q < 8; ++q) s += red[(q * 17 + b) * 64 + c];
      const int jj = (it % 96) * 64 + c;
      ((float*)(ws + OFF_MOD))[(size_t)(l * 17 + b) * 6144 + jj] = s + gin(p, 5)[l * 6144 + jj];
    }
  }
  {
    bf16_t* wr = (bf16_t*)(ws + OFF_WR);
    for (int i = obid() * NTH + tid; i < 4 * 48 * 1024; i += gridDim.x * NTH) {
      const int l = i / (48 * 1024), n = (i / 1024) % 48, k = i & 1023;
      float w = 0.f;
      if (n < 4) w = gin(p, 34)[((size_t)l * 1024 + k) * 4 + n];
      else if (n < 36) w = gin(p, 36)[((size_t)l * 1024 + k) * 32 + (n - 4)];
      const bf16_t hi = f2bf(w);
      wr[((size_t)(l * 2 + 0) * 48 + n) * 1024 + k] = hi;
      wr[((size_t)(l * 2 + 1) * 48 + n) * 1024 + k] = f2bf(w - bf2f(hi));
    }
  }
  if (obid() == 0) {
    float* rc = (float*)(ws + OFF_ROPE);
    for (int i = tid; i < 1024; i += NTH) {
      const int pos = i >> 4, f = i & 15;
      const float inv = powf(10000.0f, -(float)f / 16.0f);
      const float ang = (float)pos * inv;
      rc[i] = cosf(ang); rc[1024 + i] = sinf(ang);
    }
  }
}

DI void moe_blkstart(char* ws, int layer, int* bs  ) {
  if (otid() == 0) {
    const int* cnt = (const int*)(ws + OFF_CNT) + layer * 32;
    int s = 0;
    for (int e = 0; e < 32; ++e) { bs[e] = s; s += (cnt[e] + MOE_PAD - 1) / MOE_PAD; }
    bs[32] = s;
  }
  __syncthreads();
}
template <int MODE, bool DRY = false, bool OUT8 = false>
DI void phase_norm1(KP p, int layer, char* smem) {
  char* const ws = ows(p);
  int* bs = (int*)smem;
  if (MODE != 0) moe_blkstart(ws, MODE == 3 ? 3 : layer - 1, bs);
  const int lane = otid() & 63, wid = otid() >> 6;
  const int nrows = MODE == 3 ? TL : TT;
  const bf16_t* yb = (const bf16_t*)(ws + OFF_U + UM_YB);
  const int* tok = (const int*)(ws + OFF_TOK);
  bf16_t* hb = (bf16_t*)(ws + OFF_H);
  const int stride = gridDim.x * 8;
  for (int rA = obid() * 8 + wid; rA < nrows; rA += 2 * stride) {
    const int rB = rA + stride;
    const bool hasB = rB < nrows;
    const int rr[2] = {rA, hasB ? rB : rA};
    f32x4 v[2][4];
    int4 t0[2], t1[2];
#pragma unroll
    for (int k = 0; k < 2; ++k) {
      const int r = rr[k];
      if (MODE == 0) {
        const float* src = r < TL ? gin(p, 0) + (size_t)r * DM : gin(p, 2) + (size_t)(r - TL) * DM;
#pragma unroll
        for (int i = 0; i < 4; ++i) v[k][i] = *(const f32x4*)(src + (i * 64 + lane) * 4);
      } else {
        const bf16_t* xr = xrow_ptr(p, ws, r);
#pragma unroll
        for (int i = 0; i < 4; ++i) v[k][i] = ldbf4(xr + (i * 64 + lane) * 4);
        t0[k] = *(const int4*)(tok + (size_t)r * 8);
        t1[k] = *(const int4*)(tok + (size_t)r * 8 + 4);
      }
    }
    if (MODE == 1 || MODE == 3) {
      const int pl = MODE == 3 ? 3 : layer - 1;
      u32x2 ya[2][4], yc[2][4];
#pragma unroll
      for (int k = 0; k < 2; ++k) {
        const size_t d0 = (size_t)(bs[t0[k].x] * MOE_PAD + t0[k].y), d1 = (size_t)(bs[t0[k].z] * MOE_PAD + t0[k].w);
#pragma unroll
        for (int i = 0; i < 4; ++i) { const int ch = (i * 64 + lane) * 4; ya[k][i] = *(const u32x2*)(yb + d0 * DM + ch); yc[k][i] = *(const u32x2*)(yb + d1 * DM + ch); }
      }
#pragma unroll
      for (int k = 0; k < 2; ++k) {
        const float w0 = __int_as_float(t1[k].x), w1 = __int_as_float(t1[k].y);
        const float* g2 = modp(ws, pl, row_bi(rr[k]), 5);
#pragma unroll
        for (int i = 0; i < 4; ++i) {
          const int ch = (i * 64 + lane) * 4;
          const u32x2 a = ya[k][i], b = yc[k][i];
          const f32x4 g = *(const f32x4*)(g2 + ch);
          v[k][i][0] += g[0] * (w0 * bflo(a.x) + w1 * bflo(b.x));
          v[k][i][1] += g[1] * (w0 * bfhi(a.x) + w1 * bfhi(b.x));
          v[k][i][2] += g[2] * (w0 * bflo(a.y) + w1 * bflo(b.y));
          v[k][i][3] += g[3] * (w0 * bfhi(a.y) + w1 * bfhi(b.y));
        }
      }
    }
#pragma unroll
    for (int k = 0; k < 2; ++k) {
      if (k == 1 && !hasB) break;
      const int r = rr[k], bi = row_bi(r);
      bf16_t* xr = xrow_ptr(p, ws, r);
      if ((MODE == 0 || MODE == 1) && !DRY) {
#pragma unroll
        for (int i = 0; i < 4; ++i) stbf4(xr + (i * 64 + lane) * 4, v[k][i]);
      }
      float ss = 0.f;
#pragma unroll
      for (int i = 0; i < 4; ++i) ss += v[k][i][0] * v[k][i][0] + v[k][i][1] * v[k][i][1] + v[k][i][2] * v[k][i][2] + v[k][i][3] * v[k][i][3];
      ss = wave_sum(ss);
      const float rs = rsqrtf(ss * (1.0f / 1024.0f) + 1e-6f);
      if (MODE == 3) {
#pragma unroll
        for (int i = 0; i < 4; ++i) {
          const int ch = (i * 64 + lane) * 4;
          const f32x4 g = *(const f32x4*)(gin(p, 7) + ch);
          f32x4 o; o[0] = v[k][i][0] * rs * g[0]; o[1] = v[k][i][1] * rs * g[1]; o[2] = v[k][i][2] * rs * g[2]; o[3] = v[k][i][3] * rs * g[3];
          if (!DRY) *(f32x4*)(gout(p) + (size_t)r * DM + ch) = o; else asm volatile("" :: "v"(o[0]), "v"(o[1]), "v"(o[2]), "v"(o[3]));
        }
      } else {
        const float* gn = gin(p, 6) + (size_t)(layer * 2 + 0) * DM;
        const float* sh = modp(ws, layer, bi, 0);
        const float* sc = modp(ws, layer, bi, 1);
#pragma unroll
        for (int i = 0; i < 4; ++i) {
          const int ch = (i * 64 + lane) * 4;
          const f32x4 g = *(const f32x4*)(gn + ch), s1 = *(const f32x4*)(sc + ch), s0 = *(const f32x4*)(sh + ch);
          float o[4];
#pragma unroll
          for (int j = 0; j < 4; ++j) o[j] = v[k][i][j] * rs * g[j] * (1.0f + s1[j]) + s0[j];
          if constexpr (OUT8) {
            const unsigned w8 = pk4_fp8(o[0] * X8_SCALE, o[1] * X8_SCALE, o[2] * X8_SCALE, o[3] * X8_SCALE);
            if (!DRY) *(unsigned*)((unsigned char*)(ws + OFF_H8) + (size_t)r * DM + ch) = w8; else asm volatile("" :: "v"(w8));
          } else {
            u32x2 w; w.x = pk2(o[0], o[1]); w.y = pk2(o[2], o[3]);
            if (!DRY) *(u32x2*)(hb + (size_t)r * DM + ch) = w; else asm volatile("" :: "v"(w.x), "v"(w.y));
          }
        }
      }
    }
  }
}

constexpr int R2_TLD = 1032;
constexpr int R2_LLD = 49;
constexpr int R2_LDS = 64 * R2_TLD * 2 + 64 * R2_LLD * 4;
template <bool DRY = false>
DI void phase_norm2_router(KP p, int layer, char* smem) {
  char* const ws = ows(p);
  const int tid = otid(), lane = tid & 63, wid = tid >> 6, fr = lane & 15, fq = lane >> 4;
  bf16_t* tile = (bf16_t*)smem;
  float* lgt = (float*)(smem + 64 * R2_TLD * 2);
  const int nrows = layer == 3 ? TL : TT;
  unsigned char* h8 = (unsigned char*)(ws + OFF_H8);
  int* tok = (int*)(ws + OFF_TOK);
  int* rowl = (int*)(ws + OFF_ROWL);
  int* cnt = (int*)(ws + OFF_CNT) + layer * 32;
  const float* bg = gin(p, 35) + layer * 4;
  const float* be = gin(p, 37) + layer * 32;
  const float* gn = gin(p, 6) + (size_t)(layer * 2 + 1) * DM;
  const bf16_t* wrh = (const bf16_t*)(ws + OFF_WR) + (size_t)layer * 2 * 48 * 1024;
  const bf16_t* wrl = wrh + 48 * 1024;
  bf16x8 bh[4][3], bl[4][3];
#pragma unroll
  for (int ks = 0; ks < 4; ++ks)
#pragma unroll
    for (int nt = 0; nt < 3; ++nt) {
      const size_t o = (size_t)(nt * 16 + fr) * 1024 + wid * 128 + ks * 32 + fq * 8;
      bh[ks][nt] = *(const bf16x8*)(wrh + o); bl[ks][nt] = *(const bf16x8*)(wrl + o);
    }
  for (int rbase = obid() * 64; rbase < nrows; rbase += gridDim.x * 64) {
    const int bi = row_bi(rbase);
    const float* sh = modp(ws, layer, bi, 3);
    const float* sc = modp(ws, layer, bi, 4);
    f32x4 gs[4], s0[4];
#pragma unroll
    for (int i = 0; i < 4; ++i) {
      const int ch = (i * 64 + lane) * 4;
      const f32x4 g = *(const f32x4*)(gn + ch), s1 = *(const f32x4*)(sc + ch);
      gs[i] = g * (1.0f + s1); s0[i] = *(const f32x4*)(sh + ch);
    }
#pragma unroll 2
    for (int q = 0; q < 8; ++q) {
      const int lr = wid * 8 + q, r = rbase + lr;
      const bf16_t* xr = xrow_ptr(p, ws, r);
      f32x4 v[4];
      float ss = 0.f;
#pragma unroll
      for (int i = 0; i < 4; ++i) { v[i] = ldbf4(xr + (i * 64 + lane) * 4); ss += v[i][0] * v[i][0] + v[i][1] * v[i][1] + v[i][2] * v[i][2] + v[i][3] * v[i][3]; }
      ss = wave_sum(ss);
      const float rs = rsqrtf(ss * (1.0f / 1024.0f) + 1e-6f);
#pragma unroll
      for (int i = 0; i < 4; ++i) {
        const int ch = (i * 64 + lane) * 4;
        const f32x4 o = v[i] * rs * gs[i] + s0[i];
        u32x2 w; w.x = pk2(o[0], o[1]); w.y = pk2(o[2], o[3]);
        *(unsigned*)(h8 + (size_t)r * DM + ch) = pk4_fp8(o[0], o[1], o[2], o[3]);
        *(u32x2*)(tile + lr * R2_TLD + ch) = w;
      }
    }
    __syncthreads();
    {
      f32x4 acc[4][3];
#pragma unroll
      for (int rt = 0; rt < 4; ++rt)
#pragma unroll
        for (int nt = 0; nt < 3; ++nt) acc[rt][nt] = (f32x4){0.f, 0.f, 0.f, 0.f};
#pragma unroll
      for (int ks = 0; ks < 4; ++ks)
#pragma unroll
        for (int rt = 0; rt < 4; ++rt) {
          const bf16x8 a = *(const bf16x8*)(tile + (rt * 16 + fr) * R2_TLD + wid * 128 + ks * 32 + fq * 8);
#pragma unroll
          for (int nt = 0; nt < 3; ++nt) { acc[rt][nt] = MFMA16(a, bh[ks][nt], acc[rt][nt]); acc[rt][nt] = MFMA16(a, bl[ks][nt], acc[rt][nt]); }
        }
      __syncthreads();
      float* part = (float*)smem + wid * 64 * R2_LLD;
#pragma unroll
      for (int rt = 0; rt < 4; ++rt)
#pragma unroll
        for (int nt = 0; nt < 3; ++nt)
#pragma unroll
          for (int j = 0; j < 4; ++j) part[(rt * 16 + fq * 4 + j) * R2_LLD + nt * 16 + fr] = acc[rt][nt][j];
    }
    __syncthreads();
    for (int i = tid; i < 64 * 36; i += NTH) {
      const int row = i / 36, col = i - row * 36;
      const float* pp = (const float*)smem + row * R2_LLD + col;
      float sacc = 0.f;
#pragma unroll
      for (int w = 0; w < 8; ++w) sacc += pp[w * 64 * R2_LLD];
      lgt[row * R2_LLD + col] = sacc;
    }
    __syncthreads();
    if (wid == 0) {
      const int r = rbase + lane;
      float* lr_ = lgt + lane * R2_LLD;
      float lg[4];
#pragma unroll
      for (int q = 0; q < 4; ++q) lg[q] = lr_[q] + bg[q];
      int gsel = 0; float gm = lg[0];
#pragma unroll
      for (int q = 1; q < 4; ++q) if (lg[q] > gm) { gm = lg[q]; gsel = q; }
      float gden = 0.f;
#pragma unroll
      for (int q = 0; q < 4; ++q) gden += __expf(lg[q] - gm);
      const float pgrp = 1.0f / gden;
      float le[8];
#pragma unroll
      for (int q = 0; q < 8; ++q) le[q] = lr_[4 + gsel * 8 + q] + be[gsel * 8 + q];
      int i0 = 0; float m0 = le[0];
#pragma unroll
      for (int q = 1; q < 8; ++q) if (le[q] > m0) { m0 = le[q]; i0 = q; }
      int i1 = -1; float m1 = -3.0e38f;
#pragma unroll
      for (int q = 0; q < 8; ++q) if (q != i0 && le[q] > m1) { m1 = le[q]; i1 = q; }
      const float e1 = __expf(m1 - m0);
      const float w0 = pgrp / (1.0f + e1), w1 = pgrp * e1 / (1.0f + e1);
      if (DRY) asm volatile("" :: "v"(w0), "v"(w1), "v"(i0), "v"(i1), "v"(gsel));
      if (!DRY) {
        const int ea = gsel * 8 + i0, eb = gsel * 8 + i1;
        const int pa = atomicAdd(&cnt[ea], 1), pb = atomicAdd(&cnt[eb], 1);
        rowl[(size_t)ea * CAP + pa] = r; rowl[(size_t)eb * CAP + pb] = r;
        int4 t0; t0.x = ea; t0.y = pa; t0.z = eb; t0.w = pb;
        int4 t1; t1.x = __float_as_int(w0); t1.y = __float_as_int(w1); t1.z = 0; t1.w = 0;
        *(int4*)(tok + (size_t)r * 8) = t0; *(int4*)(tok + (size_t)r * 8 + 4) = t1;
      }
    }
  }
}

DI void st_bf16x4(bf16_t* p, const f32x4& v) { u32x2 w; w.x = pk2(v[0], v[1]); w.y = pk2(v[2], v[3]); *(u32x2*)p = w; }
constexpr int FG_LDS = fg::STAGE_BYTES;
constexpr int MOE_UMAX = 12;

struct MoeSched {
  const char* A; const char* B; const LAS int* bs; const LAS int* rowtab; int G, c, ntile; size_t tA, eB, tB;
  DI bool next(int i, fg::Unit& u) const {
    const int rt = (G & 31) ? (i * G + c) >> 2 : i * (G >> 2) + (c & 7) * (G >> 5) + (c >> 5), ct = (G & 31) ? (i * G + c) & 3 : (c >> 3) & 3;
    if (rt >= ntile) return false;
    int e = 0;
#pragma unroll 1
    while (e < 31 && bs[e + 1] <= rt) ++e;
    u.pm = rt; u.pn = ct; u.aux = e; u.A = A + (size_t)rt * tA; u.B = B + (size_t)e * eB + (size_t)ct * tB; return true;
  }
  DI const LAS int* rows(int i) const { return rowtab + i * 256; }
};
DI void phase_moe_up(KP p, int layer, char* smem) {
  char* const ws = ows(p);
  LAS unsigned char* lds = (LAS unsigned char*)smem;
  LAS int* rowtab = (LAS int*)(lds + FG_LDS);
  int* bs = (int*)(smem + FG_LDS + MOE_UMAX * 1024);
  moe_blkstart(ws, layer, bs);
  const int* cnt = (const int*)(ws + OFF_CNT) + layer * 32;
  const int* rowl = (const int*)(ws + OFF_ROWL);
  unsigned char* act8 = (unsigned char*)(ws + OFF_U + UM_ACT);
  MoeSched S;
  S.A = ws + OFF_H8; S.B = ws + OFF_WMOE; S.bs = (const LAS int*)bs; S.rowtab = rowtab; S.G = gridDim.x; S.c = obid(); S.ntile = bs[32];
  S.tA = 0; S.eB = (size_t)1024 * 1024; S.tB = (size_t)256 * 1024;
  {
    const int tid = otid();
    fg::Unit u;
    for (int i = 0; i < MOE_UMAX && S.next(i, u); ++i) {
      if (tid < 256) {
        const int e = u.aux, pos = (u.pm - bs[e]) * 256 + tid;
        rowtab[i * 256 + tid] = pos < cnt[e] ? rowl[(size_t)e * CAP + pos] : TT;
      }
    }
    __syncthreads();
  }
  auto ep = [&](const f32x16 (&acc)[2][2][2], const fg::Unit& u, int wr, int wc, int r, int h) {
    constexpr float inv = 1.0f / W8_SCALE;
#pragma unroll
    for (int ai = 0; ai < 2; ++ai)
#pragma unroll
      for (int m = 0; m < 2; ++m) {
        const size_t row = (size_t)u.pm * 256 + ai * 128 + wr * 64 + m * 32 + r;
#pragma unroll
        for (int bj = 0; bj < 2; ++bj) {
          const int acol = ((u.pn * 256 + bj * 128 + wc * 32) >> 5) * 16 + 8 * h;
          float o[8];
#pragma unroll
          for (int i = 0; i < 8; ++i) { const float g = acc[ai][bj][m][i] * inv, uu = acc[ai][bj][m][i + 8] * inv; o[i] = g * __builtin_amdgcn_rcpf(1.0f + __expf(-g)) * uu; }
          u32x2 w8; w8.x = pk4_fp8(o[0] * A8_SCALE, o[1] * A8_SCALE, o[2] * A8_SCALE, o[3] * A8_SCALE); w8.y = pk4_fp8(o[4] * A8_SCALE, o[5] * A8_SCALE, o[6] * A8_SCALE, o[7] * A8_SCALE);
          *(u32x2*)(act8 + row * 512 + acol) = w8;
        }
      }
  };
  fg::gemm_phase_f8<true>(lds, 512, 512, 512, S, ep);
}
DI void phase_moe_down(KP p, int layer, char* smem) {
  char* const ws = ows(p);
  LAS unsigned char* lds = (LAS unsigned char*)smem;
  int* bs = (int*)(smem + FG_LDS + MOE_UMAX * 1024);
  moe_blkstart(ws, layer, bs);
  bf16_t* yb = (bf16_t*)(ws + OFF_U + UM_YB);
  MoeSched S;
  S.A = ws + OFF_U + UM_ACT; S.B = ws + OFF_WMOE + WMOE_DOWN * 2; S.bs = (const LAS int*)bs; S.rowtab = nullptr; S.G = gridDim.x; S.c = obid(); S.ntile = bs[32];
  S.tA = (size_t)256 * 512; S.eB = (size_t)1024 * 512; S.tB = (size_t)256 * 512;
  auto ep = [&](const f32x16 (&acc)[2][2][2], const fg::Unit& u, int wr, int wc, int r, int h) {
    constexpr float inv = 1.0f / (A8_SCALE * WD8_SCALE);
#pragma unroll
    for (int ai = 0; ai < 2; ++ai)
#pragma unroll
      for (int m = 0; m < 2; ++m) {
        const size_t row = (size_t)u.pm * 256 + ai * 128 + wr * 64 + m * 32 + r;
#pragma unroll
        for (int bj = 0; bj < 2; ++bj) {
          const f32x16& a = acc[ai][bj][m];
          u32x4 w0, w1;
          w0.x = pk2(a[0] * inv, a[1] * inv); w0.y = pk2(a[2] * inv, a[3] * inv); w0.z = pk2(a[4] * inv, a[5] * inv); w0.w = pk2(a[6] * inv, a[7] * inv);
          w1.x = pk2(a[8] * inv, a[9] * inv); w1.y = pk2(a[10] * inv, a[11] * inv); w1.z = pk2(a[12] * inv, a[13] * inv); w1.w = pk2(a[14] * inv, a[15] * inv);
          bf16_t* q = yb + row * DM + u.pn * 256 + bj * 128 + wc * 32 + 16 * h;
          *(u32x4*)q = w0; *(u32x4*)(q + 8) = w1;
        }
      }
  };
  fg::gemm_phase_f8<false, true>(lds, 256, 256, 256, S, ep);
}

template <int NKC>
DI void phase_qkv(KP p, const bf16_t* Wt, bf16_t* Q, bf16_t* Kb, bf16_t* Vb, char* smem) {
  char* const ws = ows(p);
  LAS unsigned char* lds = (LAS unsigned char*)smem;
  constexpr int N = 1024 + 2 * NKC;
  const float* rc = (const float*)(ws + OFF_ROPE);
  fg::DenseSched S;
  S.A = ws + OFF_H; S.B = (const char*)Wt; S.nM = TT / 256; S.nN = N / 256; S.G = gridDim.x; S.c = obid(); S.tA = (size_t)256 * 1024 * 2; S.tB = (size_t)256 * 1024 * 2;
  auto ep = [&](const f32x4 (&acc)[2][2][4][2], const fg::Unit& u, int wr, int wc, int fr, int fq) {
#pragma unroll
    for (int bj = 0; bj < 2; ++bj) {
      const int colb = u.pn * 256 + bj * 128 + wc * 32;
      if (colb < 1024 + NKC) {
        const bool isq = colb < 1024;
        bf16_t* dst = isq ? Q : Kb;
        const int ldd = isq ? 1024 : NKC, cc2 = (isq ? colb : colb - 1024) + 8 * fq;
        const float qs = isq ? 0.125f : 1.0f;
#pragma unroll
        for (int ai = 0; ai < 2; ++ai)
#pragma unroll
          for (int m = 0; m < 4; ++m) {
            const int row = u.pm * 256 + ai * 128 + wr * 64 + m * 16 + fr;
            f32x4 x0 = acc[ai][bj][m][0], x1 = acc[ai][bj][m][1];
            if (row < TL) {
              const int s = row & 4095, idx = (colb & 32) ? (s & 63) : (s >> 6);
              const f32x4 c = *(const f32x4*)(rc + idx * 16 + 4 * fq), sn = *(const f32x4*)(rc + 1024 + idx * 16 + 4 * fq);
              const f32x4 o0 = x0 * c - x1 * sn, o1 = x1 * c + x0 * sn;
              x0 = o0; x1 = o1;
            }
            const f32x4 y0 = x0 * qs, y1 = x1 * qs;
            if (NKC == 1024 && !isq) {
              u32x2 w8; w8.x = pk4_fp8(y0[0], y0[1], y0[2], y0[3]); w8.y = pk4_fp8(y1[0], y1[1], y1[2], y1[3]);
              *(u32x2*)((unsigned char*)Kb + (size_t)row * 1024 + cc2) = w8;
            } else {
              u32x4 w; w.x = pk2(y0[0], y0[1]); w.y = pk2(y0[2], y0[3]); w.z = pk2(y1[0], y1[1]); w.w = pk2(y1[2], y1[3]);
              *(u32x4*)(dst + (size_t)row * ldd + cc2) = w;
            }
          }
      } else {
        const int cv = colb - (1024 + NKC) + 4 * fq;
        if constexpr (NKC == 1024) {
          unsigned char* Vt = (unsigned char*)Vb;
          const int tq = fr & 3;
#pragma unroll
          for (int ai = 0; ai < 2; ++ai)
#pragma unroll
            for (int m = 0; m < 4; ++m) {
              const int row = u.pm * 256 + ai * 128 + wr * 64 + m * 16 + fr, rowq = row & ~3;
              size_t base; int kq;
              if (rowq < TL) { const int b = rowq >> 12, s0 = rowq & 4095; base = (size_t)b * 1024 * 4096 + (size_t)(s0 >> 6) * 64; kq = (s0 & 63) >> 2; }
              else { const int rc2 = rowq - TL, b = rc2 >> 8, c0 = rc2 & 255; base = (size_t)16 * 1024 * 4096 + (size_t)b * 1024 * 256 + (size_t)(c0 >> 6) * 64; kq = (c0 & 63) >> 2; }
              const size_t rstride = rowq < TL ? 4096 : 256;
              const int pos = 32 * (kq & 1) + 16 * (kq >> 3) + 4 * ((kq >> 1) & 3);
#pragma unroll
              for (int n = 0; n < 2; ++n) {
                const f32x4 a = acc[ai][bj][m][n];
                const int d = (int)pk4_fp8(a[0], a[1], a[2], a[3]);
                const int d0 = __builtin_amdgcn_update_dpp(0, d, 0x00, 0xF, 0xF, true), d1 = __builtin_amdgcn_update_dpp(0, d, 0x55, 0xF, 0xF, true);
                const int d2 = __builtin_amdgcn_update_dpp(0, d, 0xAA, 0xF, 0xF, true), d3 = __builtin_amdgcn_update_dpp(0, d, 0xFF, 0xF, 0xF, true);
                const int sh = 8 * tq;
                const unsigned w = ((unsigned)(d0 >> sh) & 0xffu) | (((unsigned)(d1 >> sh) & 0xffu) << 8) | (((unsigned)(d2 >> sh) & 0xffu) << 16) | (((unsigned)(d3 >> sh) & 0xffu) << 24);
                *(unsigned*)(Vt + base + (size_t)(cv + 16 * n + tq) * rstride + pos) = w;
              }
            }
        } else {
#pragma unroll
          for (int ai = 0; ai < 2; ++ai)
#pragma unroll
            for (int m = 0; m < 4; ++m) {
              const int row = u.pm * 256 + ai * 128 + wr * 64 + m * 16 + fr;
              st_bf16x4(Vb + (size_t)row * NKC + cv, acc[ai][bj][m][0]);
              st_bf16x4(Vb + (size_t)row * NKC + cv + 16, acc[ai][bj][m][1]);
            }
        }
      }
    }
  };
  fg::gemm_phase<false>(lds, 1024, 1024, 1024, S, ep);
}

DI void phase_qkv_diff8(KP p, char* smem) {
  char* const ws = ows(p);
  LAS unsigned char* lds = (LAS unsigned char*)smem;
  const float* rc = (const float*)(ws + OFF_ROPE);
  bf16_t* Q = (bf16_t*)(ws + OFF_U + U1_Q);
  unsigned char* K8 = (unsigned char*)(ws + OFF_U + U1_K);
  unsigned char* Vt = (unsigned char*)(ws + OFF_U + U1_V);
  fg::DenseSched S;
  S.A = ws + OFF_H8; S.B = ws + OFF_WMIX + W_DIFFQKV * 2; S.nM = TT / 256; S.nN = 12; S.G = gridDim.x; S.c = obid(); S.tA = (size_t)256 * 1024; S.tB = (size_t)256 * 1024;
  auto ep = [&](const f32x16 (&acc)[2][2][2], const fg::Unit& u, int wr, int wc, int r, int h) {
    constexpr float inv = 1.0f / (X8_SCALE * 32.0f);
#pragma unroll
    for (int bj = 0; bj < 2; ++bj) {
      const int colb = u.pn * 256 + bj * 128 + wc * 32;
      if (colb < 2048) {
        const bool isq = colb < 1024;
        const float qs = (isq ? 0.125f : 1.0f) * inv;
#pragma unroll
        for (int ai = 0; ai < 2; ++ai)
#pragma unroll
          for (int m = 0; m < 2; ++m) {
            const int row = u.pm * 256 + ai * 128 + wr * 64 + m * 32 + r;
            const f32x16& a = acc[ai][bj][m];
            float y[16];
            if (row < TL) {
              const int s = row & 4095, idx = (colb & 32) ? (s & 63) : (s >> 6);
              const f32x4 c0 = *(const f32x4*)(rc + idx * 16 + 4 * h), c1 = *(const f32x4*)(rc + idx * 16 + 8 + 4 * h);
              const f32x4 s0 = *(const f32x4*)(rc + 1024 + idx * 16 + 4 * h), s1 = *(const f32x4*)(rc + 1024 + idx * 16 + 8 + 4 * h);
#pragma unroll
              for (int i = 0; i < 8; ++i) {
                const float cc = i < 4 ? c0[i & 3] : c1[i & 3], sn = i < 4 ? s0[i & 3] : s1[i & 3];
                y[i] = (a[i] * cc - a[i + 8] * sn) * qs; y[i + 8] = (a[i + 8] * cc + a[i] * sn) * qs;
              }
            } else {
#pragma unroll
              for (int i = 0; i < 16; ++i) y[i] = a[i] * qs;
            }
            if (isq) {
              u32x4 w0, w1;
              w0.x = pk2(y[0], y[1]); w0.y = pk2(y[2], y[3]); w0.z = pk2(y[4], y[5]); w0.w = pk2(y[6], y[7]);
              w1.x = pk2(y[8], y[9]); w1.y = pk2(y[10], y[11]); w1.z = pk2(y[12], y[13]); w1.w = pk2(y[14], y[15]);
              bf16_t* q = Q + (size_t)row * 1024 + colb + 16 * h;
              *(u32x4*)q = w0; *(u32x4*)(q + 8) = w1;
            } else {
              u32x4 w8;
              w8.x = pk4_fp8(y[0], y[1], y[2], y[3]); w8.y = pk4_fp8(y[4], y[5], y[6], y[7]); w8.z = pk4_fp8(y[8], y[9], y[10], y[11]); w8.w = pk4_fp8(y[12], y[13], y[14], y[15]);
              *(u32x4*)(K8 + (size_t)row * 1024 + (colb - 1024) + 16 * h) = w8;
            }
          }
      } else {
        const int cv = colb - 2048 + 4 * h, tq = r & 3;
#pragma unroll
        for (int ai = 0; ai < 2; ++ai)
#pragma unroll
          for (int m = 0; m < 2; ++m) {
            const int row = u.pm * 256 + ai * 128 + wr * 64 + m * 32 + r, rowq = row & ~3;
            size_t base; int kq;
            if (rowq < TL) { const int b = rowq >> 12, s0 = rowq & 4095; base = (size_t)b * 1024 * 4096 + (size_t)(s0 >> 6) * 64; kq = (s0 & 63) >> 2; }
            else { const int rc2 = rowq - TL, b = rc2 >> 8, c0 = rc2 & 255; base = (size_t)16 * 1024 * 4096 + (size_t)b * 1024 * 256 + (size_t)(c0 >> 6) * 64; kq = (c0 & 63) >> 2; }
            const size_t rstride = rowq < TL ? 4096 : 256;
            const int pos = 32 * (kq & 1) + 16 * (kq >> 3) + 4 * ((kq >> 1) & 3);
            const f32x16& a = acc[ai][bj][m];
#pragma unroll
            for (int g = 0; g < 4; ++g) {
              const int d = (int)pk4_fp8(a[4 * g] * inv, a[4 * g + 1] * inv, a[4 * g + 2] * inv, a[4 * g + 3] * inv);
              const int d0 = __builtin_amdgcn_update_dpp(0, d, 0x00, 0xF, 0xF, true), d1 = __builtin_amdgcn_update_dpp(0, d, 0x55, 0xF, 0xF, true);
              const int d2 = __builtin_amdgcn_update_dpp(0, d, 0xAA, 0xF, 0xF, true), d3 = __builtin_amdgcn_update_dpp(0, d, 0xFF, 0xF, 0xF, true);
              const int sh = 8 * tq;
              const unsigned w = ((unsigned)(d0 >> sh) & 0xffu) | (((unsigned)(d1 >> sh) & 0xffu) << 8) | (((unsigned)(d2 >> sh) & 0xffu) << 16) | (((unsigned)(d3 >> sh) & 0xffu) << 24);
              *(unsigned*)(Vt + base + (size_t)(cv + 8 * g + tq) * rstride + pos) = w;
            }
          }
      }
    }
  };
  fg::gemm_phase_f8<false, false>(lds, 512, 512, 512, S, ep);
}

DI void phase_qkv_win8(KP p, char* smem) {
  char* const ws = ows(p);
  LAS unsigned char* lds = (LAS unsigned char*)smem;
  const float* rc = (const float*)(ws + OFF_ROPE);
  bf16_t* Q = (bf16_t*)(ws + OFF_U + U0_Q);
  bf16_t* Kb = (bf16_t*)(ws + OFF_U + U0_K);
  bf16_t* Vb = (bf16_t*)(ws + OFF_U + U0_V);
  fg::DenseSched S;
  S.A = ws + OFF_H8; S.B = ws + OFF_WMIX + W_WINQKV * 2; S.nM = TT / 256; S.nN = 6; S.G = gridDim.x; S.c = obid(); S.tA = (size_t)256 * 1024; S.tB = (size_t)256 * 1024;
  auto ep = [&](const f32x16 (&acc)[2][2][2], const fg::Unit& u, int wr, int wc, int r, int h) {
    constexpr float inv = 1.0f / (X8_SCALE * 32.0f);
#pragma unroll
    for (int bj = 0; bj < 2; ++bj) {
      const int colb = u.pn * 256 + bj * 128 + wc * 32;
      if (colb < 1280) {
        const bool isq = colb < 1024;
        const float qs = (isq ? 0.125f : 1.0f) * inv;
        bf16_t* dst = isq ? Q + colb + 16 * h : Kb + (colb - 1024) + 16 * h;
        const int ldd = isq ? 1024 : 256;
#pragma unroll
        for (int ai = 0; ai < 2; ++ai)
#pragma unroll
          for (int m = 0; m < 2; ++m) {
            const int row = u.pm * 256 + ai * 128 + wr * 64 + m * 32 + r;
            const f32x16& a = acc[ai][bj][m];
            float y[16];
            if (row < TL) {
              const int s = row & 4095, idx = (colb & 32) ? (s & 63) : (s >> 6);
              const f32x4 c0 = *(const f32x4*)(rc + idx * 16 + 4 * h), c1 = *(const f32x4*)(rc + idx * 16 + 8 + 4 * h);
              const f32x4 s0 = *(const f32x4*)(rc + 1024 + idx * 16 + 4 * h), s1 = *(const f32x4*)(rc + 1024 + idx * 16 + 8 + 4 * h);
#pragma unroll
              for (int i = 0; i < 8; ++i) {
                const float cc = i < 4 ? c0[i & 3] : c1[i & 3], sn = i < 4 ? s0[i & 3] : s1[i & 3];
                y[i] = (a[i] * cc - a[i + 8] * sn) * qs; y[i + 8] = (a[i + 8] * cc + a[i] * sn) * qs;
              }
            } else {
#pragma unroll
              for (int i = 0; i < 16; ++i) y[i] = a[i] * qs;
            }
            u32x4 w0, w1;
            w0.x = pk2(y[0], y[1]); w0.y = pk2(y[2], y[3]); w0.z = pk2(y[4], y[5]); w0.w = pk2(y[6], y[7]);
            w1.x = pk2(y[8], y[9]); w1.y = pk2(y[10], y[11]); w1.z = pk2(y[12], y[13]); w1.w = pk2(y[14], y[15]);
            bf16_t* q = dst + (size_t)row * ldd;
            *(u32x4*)q = w0; *(u32x4*)(q + 8) = w1;
          }
      } else {
        const int cv = colb - 1280 + 4 * h;
#pragma unroll
        for (int ai = 0; ai < 2; ++ai)
#pragma unroll
          for (int m = 0; m < 2; ++m) {
            const int row = u.pm * 256 + ai * 128 + wr * 64 + m * 32 + r;
            const f32x16& a = acc[ai][bj][m];
#pragma unroll
            for (int g = 0; g < 4; ++g) {
              f32x4 v4; v4[0] = a[4 * g] * inv; v4[1] = a[4 * g + 1] * inv; v4[2] = a[4 * g + 2] * inv; v4[3] = a[4 * g + 3] * inv;
              st_bf16x4(Vb + (size_t)row * 256 + cv + 8 * g, v4);
            }
          }
      }
    }
  };
  fg::gemm_phase_f8<false, false>(lds, 512, 512, 512, S, ep);
}

template <bool DRY = false>
DI void phase_oproj(KP p, int layer, const bf16_t* A, const bf16_t* Wt, int nrows, char* smem) {
  char* const ws = ows(p);
  LAS unsigned char* lds = (LAS unsigned char*)smem;
  fg::DenseSched S;
  S.A = (const char*)A; S.B = (const char*)Wt; S.nM = nrows / 256; S.nN = 4; S.G = gridDim.x; S.c = obid(); S.tA = (size_t)256 * 1024 * 2; S.tB = (size_t)256 * 1024 * 2;
  auto ep = [&](const f32x4 (&acc)[2][2][4][2], const fg::Unit& u, int wr, int wc, int fr, int fq) {
    const int row0 = u.pm * 256 + wr * 64 + fr, colb = u.pn * 256 + wc * 32 + 4 * fq;
    const float* g1 = modp(ws, layer, row_bi(row0), 2) + colb;
    f32x4 g[2][2];
#pragma unroll
    for (int bj = 0; bj < 2; ++bj)
#pragma unroll
      for (int n = 0; n < 2; ++n) g[bj][n] = *(const f32x4*)(g1 + bj * 128 + n * 16);
    f32x4 xa[2][2], xb[2][2];
    bf16_t* xr = xrow_ptr(p, ws, row0) + colb;
#pragma unroll
    for (int bj = 0; bj < 2; ++bj)
#pragma unroll
      for (int n = 0; n < 2; ++n) xa[bj][n] = ldbf4(xr + bj * 128 + n * 16);
#pragma unroll
    for (int rr = 0; rr < 8; ++rr) {
      const int ai = rr >> 2, m = rr & 3;
      bf16_t* xn = xr;
      if (rr + 1 < 8) {
        xn = xrow_ptr(p, ws, row0 + ((rr + 1) >> 2) * 128 + ((rr + 1) & 3) * 16) + colb;
#pragma unroll
        for (int bj = 0; bj < 2; ++bj)
#pragma unroll
          for (int n = 0; n < 2; ++n) xb[bj][n] = ldbf4(xn + bj * 128 + n * 16);
      }
#pragma unroll
      for (int bj = 0; bj < 2; ++bj)
#pragma unroll
        for (int n = 0; n < 2; ++n) {
          const f32x4 x = xa[bj][n] + g[bj][n] * acc[ai][bj][m][n];
          if (!DRY) stbf4(xr + bj * 128 + n * 16, x); else asm volatile("" :: "v"(x[0]), "v"(x[1]), "v"(x[2]), "v"(x[3]));
        }
#pragma unroll
      for (int bj = 0; bj < 2; ++bj)
#pragma unroll
        for (int n = 0; n < 2; ++n) xa[bj][n] = xb[bj][n];
      xr = xn;
    }
  };
  fg::gemm_phase<false>(lds, 1024, 1024, 1024, S, ep);
}

template <bool DRY = false>
DI void phase_oproj8(KP p, int layer, const char* A8, const char* W8, int nrows, char* smem) {
  char* const ws = ows(p);
  LAS unsigned char* lds = (LAS unsigned char*)smem;
  fg::DenseSched S;
  S.A = A8; S.B = W8; S.nM = nrows / 256; S.nN = 4; S.G = gridDim.x; S.c = obid(); S.tA = (size_t)256 * 1024; S.tB = (size_t)256 * 1024;
  auto ep = [&](const f32x16 (&acc)[2][2][2], const fg::Unit& u, int wr, int wc, int r, int h) {
    constexpr float inv = 1.0f / (O8_SCALE * 32.0f);
    const int row0 = u.pm * 256 + wr * 64 + r, colb = u.pn * 256 + wc * 32 + 16 * h;
    const float* g1 = modp(ws, layer, row_bi(row0), 2) + colb;
#pragma unroll
    for (int bj = 0; bj < 2; ++bj) {
      f32x4 g[4];
#pragma unroll
      for (int q = 0; q < 4; ++q) g[q] = *(const f32x4*)(g1 + bj * 128 + 4 * q) * inv;
#pragma unroll
      for (int ai = 0; ai < 2; ++ai)
#pragma unroll
        for (int m = 0; m < 2; ++m) {
          bf16_t* xr = xrow_ptr(p, ws, row0 + ai * 128 + m * 32) + colb + bj * 128;
          const u32x4 x0 = ld16(xr), x1 = ld16(xr + 8);
          const f32x16& a = acc[ai][bj][m];
          u32x4 w0, w1;
          w0.x = pk2(bflo(x0.x) + g[0][0] * a[0], bfhi(x0.x) + g[0][1] * a[1]); w0.y = pk2(bflo(x0.y) + g[0][2] * a[2], bfhi(x0.y) + g[0][3] * a[3]);
          w0.z = pk2(bflo(x0.z) + g[1][0] * a[4], bfhi(x0.z) + g[1][1] * a[5]); w0.w = pk2(bflo(x0.w) + g[1][2] * a[6], bfhi(x0.w) + g[1][3] * a[7]);
          w1.x = pk2(bflo(x1.x) + g[2][0] * a[8], bfhi(x1.x) + g[2][1] * a[9]); w1.y = pk2(bflo(x1.y) + g[2][2] * a[10], bfhi(x1.y) + g[2][3] * a[11]);
          w1.z = pk2(bflo(x1.z) + g[3][0] * a[12], bfhi(x1.z) + g[3][1] * a[13]); w1.w = pk2(bflo(x1.w) + g[3][2] * a[14], bfhi(x1.w) + g[3][3] * a[15]);
          if (!DRY) { *(u32x4*)xr = w0; *(u32x4*)(xr + 8) = w1; } else asm volatile("" :: "v"(w0), "v"(w1));
        }
    }
  };
  fg::gemm_phase_f8<false, true>(lds, 512, 512, 512, S, ep);
}

DI void phase_pool_pre(KP p, char* smem) {
  char* const ws = ows(p);
  const int lane = otid() & 63, wid = otid() >> 6;
  const bf16_t* hb = (const bf16_t*)(ws + OFF_H);
  bf16_t* Y = (bf16_t*)(ws + OFF_U + U2_Y);
  const int ch0 = lane * 16, half = 1 << (lane >> 4);
  for (int r = obid() * 8 + wid; r < TT; r += gridDim.x * 8) {
    int s, L;
    if (r < TL) { s = r & 4095; L = 4096; } else { s = (r - TL) & 255; L = 256; }
    const int lo = s - half < 0 ? 0 : s - half, hi = s + half > L ? L : s + half;
    const bf16_t* base = hb + (size_t)(r - s) * DM + ch0;
    float a[16];
#pragma unroll
    for (int j = 0; j < 16; ++j) a[j] = 0.f;
    for (int q = lo; q < hi; ++q) {
      const u32x4 v0 = ld16(base + (size_t)q * DM), v1 = ld16(base + (size_t)q * DM + 8);
      a[0] += bflo(v0.x); a[1] += bfhi(v0.x); a[2] += bflo(v0.y); a[3] += bfhi(v0.y); a[4] += bflo(v0.z); a[5] += bfhi(v0.z); a[6] += bflo(v0.w); a[7] += bfhi(v0.w);
      a[8] += bflo(v1.x); a[9] += bfhi(v1.x); a[10] += bflo(v1.y); a[11] += bfhi(v1.y); a[12] += bflo(v1.z); a[13] += bfhi(v1.z); a[14] += bflo(v1.w); a[15] += bfhi(v1.w);
    }
    const float inv = 1.0f / (float)(hi - lo);
    const u32x4 c0 = ld16(base + (size_t)s * DM), c1 = ld16(base + (size_t)s * DM + 8);
    u32x4 o0, o1;
    o0.x = pk2(a[0] * inv - bflo(c0.x), a[1] * inv - bfhi(c0.x)); o0.y = pk2(a[2] * inv - bflo(c0.y), a[3] * inv - bfhi(c0.y));
    o0.z = pk2(a[4] * inv - bflo(c0.z), a[5] * inv - bfhi(c0.z)); o0.w = pk2(a[6] * inv - bflo(c0.w), a[7] * inv - bfhi(c0.w));
    o1.x = pk2(a[8] * inv - bflo(c1.x), a[9] * inv - bfhi(c1.x)); o1.y = pk2(a[10] * inv - bflo(c1.y), a[11] * inv - bfhi(c1.y));
    o1.z = pk2(a[12] * inv - bflo(c1.z), a[13] * inv - bfhi(c1.z)); o1.w = pk2(a[14] * inv - bflo(c1.w), a[15] * inv - bfhi(c1.w));
    *(u32x4*)(Y + (size_t)r * DM + ch0) = o0; *(u32x4*)(Y + (size_t)r * DM + ch0 + 8) = o1;
  }
}
struct PoolSched {
  const char* A; const char* B; int G, c;
  DI bool next(int i, fg::Unit& u) const {
    const int L = i * G + c; if (L >= (TT / 256) * 4) return false;
    const int pm = L >> 2, g = L & 3;
    u.pm = pm; u.pn = g; u.aux = 0; u.A = A + ((size_t)pm * 256 * 1024 + g * 256) * 2; u.B = B + (size_t)g * 65536 * 2; return true;
  }
  DI const LAS int* rows(int) const { return nullptr; }
};
template <bool DRY = false>
DI void phase_pool(KP p, char* smem) {
  char* const ws = ows(p);
  LAS unsigned char* lds = (LAS unsigned char*)smem;
  const float* pb = gin(p, 16);
  const float* psc = gin(p, 17);
  PoolSched S; S.A = ws + OFF_U + U2_Y; S.B = ws + OFF_WMIX + W_POOL * 2; S.G = gridDim.x; S.c = obid();
  auto ep = [&](const f32x4 (&acc)[2][2][4][2], const fg::Unit& u, int wr, int wc, int fr, int fq) {
    const int row0 = u.pm * 256 + wr * 64 + fr, colb = u.pn * 256 + wc * 32 + 4 * fq;
    const float* g1 = modp(ws, 2, row_bi(row0), 2) + colb;
    f32x4 g[2][2], bb[2][2];
#pragma unroll
    for (int bj = 0; bj < 2; ++bj)
#pragma unroll
      for (int n = 0; n < 2; ++n) {
        const f32x4 s4 = *(const f32x4*)(psc + colb + bj * 128 + n * 16);
        g[bj][n] = *(const f32x4*)(g1 + bj * 128 + n * 16) * s4;
        bb[bj][n] = *(const f32x4*)(pb + colb + bj * 128 + n * 16) * g[bj][n];
      }
    f32x4 xa[2][2], xb[2][2];
    bf16_t* xr = xrow_ptr(p, ws, row0) + colb;
#pragma unroll
    for (int bj = 0; bj < 2; ++bj)
#pragma unroll
      for (int n = 0; n < 2; ++n) xa[bj][n] = ldbf4(xr + bj * 128 + n * 16);
#pragma unroll
    for (int rr = 0; rr < 8; ++rr) {
      const int ai = rr >> 2, m = rr & 3;
      bf16_t* xn = xr;
      if (rr + 1 < 8) {
        xn = xrow_ptr(p, ws, row0 + ((rr + 1) >> 2) * 128 + ((rr + 1) & 3) * 16) + colb;
#pragma unroll
        for (int bj = 0; bj < 2; ++bj)
#pragma unroll
          for (int n = 0; n < 2; ++n) xb[bj][n] = ldbf4(xn + bj * 128 + n * 16);
      }
#pragma unroll
      for (int bj = 0; bj < 2; ++bj)
#pragma unroll
        for (int n = 0; n < 2; ++n) {
          const f32x4 x = xa[bj][n] + (g[bj][n] * acc[ai][bj][m][n] + bb[bj][n]);
          if (!DRY) stbf4(xr + bj * 128 + n * 16, x); else asm volatile("" :: "v"(x[0]), "v"(x[1]), "v"(x[2]), "v"(x[3]));
        }
#pragma unroll
      for (int bj = 0; bj < 2; ++bj)
#pragma unroll
        for (int n = 0; n < 2; ++n) xa[bj][n] = xb[bj][n];
      xr = xn;
    }
  };
  fg::gemm_phase<false>(lds, 256, 1024, 256, S, ep);
}

typedef short v4i16_t __attribute__((ext_vector_type(4)));
DI s16x4 tr_read(const bf16_t* p) { return __builtin_bit_cast(s16x4, __builtin_amdgcn_ds_read_tr16_b64_v4i16((LAS v4i16_t*)p)); }
DI bf16x8 pack8(const f32x16& x, int s) {
  u32x4 q;
  q.x = pk2(x[8 * s + 0], x[8 * s + 1]); q.y = pk2(x[8 * s + 2], x[8 * s + 3]);
  q.z = pk2(x[8 * s + 4], x[8 * s + 5]); q.w = pk2(x[8 * s + 6], x[8 * s + 7]);
  return __builtin_bit_cast(bf16x8, q);
}
template <int DT, int VLD_, bool MASK>
DI void attn_tile(const bf16_t* sK, int kld, const bf16_t* vbase, const bf16x8 (&qf)[4], f32x16 (&Y)[DT], float& m, float& l, int r, int h, int qpos, int kpos0) {
  f32x16 X[2];
#pragma unroll
  for (int sub = 0; sub < 2; ++sub) {
#pragma unroll
    for (int i = 0; i < 16; ++i) X[sub][i] = 0.f;
#pragma unroll
    for (int s = 0; s < 4; ++s) {
      const bf16x8 a = *(const bf16x8*)(sK + (sub * 32 + r) * kld + 16 * s + 8 * h);
      X[sub] = MFMA32(a, qf[s], X[sub]);
    }
  }
  if (MASK) {
#pragma unroll
    for (int sub = 0; sub < 2; ++sub)
#pragma unroll
      for (int i = 0; i < 16; ++i) {
        const int kp = kpos0 + sub * 32 + (i & 3) + 8 * (i >> 2) + 4 * h;
        const int d = qpos - kp;
        if (d > 128 || d < -128) X[sub][i] = -1e30f;
      }
  }
  float mx = m;
#pragma unroll
  for (int sub = 0; sub < 2; ++sub)
#pragma unroll
    for (int i = 0; i < 16; ++i) mx = fmaxf(mx, X[sub][i]);
  mx = fmaxf(mx, __shfl_xor(mx, 32));
  const float alpha = __expf(m - mx);
  m = mx;
  float ps = 0.f;
#pragma unroll
  for (int sub = 0; sub < 2; ++sub)
#pragma unroll
    for (int i = 0; i < 16; ++i) { const float pv = __expf(X[sub][i] - mx); X[sub][i] = pv; ps += pv; }
  l = l * alpha + ps;
#pragma unroll
  for (int dt = 0; dt < DT; ++dt)
#pragma unroll
    for (int i = 0; i < 16; ++i) Y[dt][i] *= alpha;
#pragma unroll
  for (int sub = 0; sub < 2; ++sub)
#pragma unroll
    for (int s = 0; s < 2; ++s) {
      const bf16x8 pf = pack8(X[sub], s);
#pragma unroll
      for (int dt = 0; dt < DT; ++dt) {
        const bf16_t* vp = vbase + (sub * 32 + 16 * s) * VLD_ + dt * 32;
        const s16x4 lo = tr_read(vp), hi = tr_read(vp + 8 * VLD_);
        const bf16x8 vf = __builtin_shufflevector(lo, hi, 0, 1, 2, 3, 4, 5, 6, 7);
        Y[dt] = MFMA32(vf, pf, Y[dt]);
      }
    }
}

constexpr int A0_KLD = 72, A0_VLD = 96;
constexpr int A0_LDS = 64 * A0_KLD * 2 + 64 * A0_VLD * 2;
DI void phase_attn_win(KP p, char* smem) {
  char* const ws = ows(p);
  bf16_t* sK = (bf16_t*)smem;
  bf16_t* sV = sK + 64 * A0_KLD;
  const bf16_t* Q = (const bf16_t*)(ws + OFF_U + U0_Q);
  const bf16_t* Kb = (const bf16_t*)(ws + OFF_U + U0_K);
  const bf16_t* Vb = (const bf16_t*)(ws + OFF_U + U0_V);
  bf16_t* O = (bf16_t*)(ws + OFF_U + U0_O);
  const float* sink = gin(p, 9);
  const int tid = otid(), lane = tid & 63, wid = tid >> 6, r = lane & 31, h = lane >> 5;
  const bf16_t* vbase = sV + (4 * h + ((lane & 15) >> 2)) * A0_VLD + 16 * ((lane >> 4) & 1) + 4 * (lane & 3);
  const int NLAT = 16 * 4 * 32 * 2, NCTX = 16 * 16;
  for (int it = obid(); it < NLAT + NCTX; it += gridDim.x) {
    const bool lat = it < NLAT;
    int b, kvh, qb = 0, head, qrow, qpos;
    if (lat) {
      b = it >> 8; kvh = (it >> 6) & 3; qb = (it >> 1) & 31; const int hp = it & 1;
      head = kvh * 4 + hp * 2 + (wid >> 2);
      qpos = qb * 128 + (wid & 3) * 32 + r; qrow = b * 4096 + qpos;
    } else {
      const int i2 = it - NLAT; b = i2 >> 4; head = i2 & 15; kvh = head >> 2;
      qpos = wid * 32 + r; qrow = TL + b * 256 + qpos;
    }
    bf16x8 qf[4];
#pragma unroll
    for (int s = 0; s < 4; ++s) qf[s] = *(const bf16x8*)(Q + (size_t)qrow * DM + head * 64 + 16 * s + 8 * h);
    f32x16 Y[2];
#pragma unroll
    for (int dt = 0; dt < 2; ++dt)
#pragma unroll
      for (int i = 0; i < 16; ++i) Y[dt][i] = 0.f;
    float m = sink[head], l = h == 0 ? 1.0f : 0.0f;
    const int kr = tid >> 3, k8 = (tid & 7) * 8;
    auto tile_ok = [&](int t) -> bool { if (t >= 6) return true; if (!lat) return false; const int kt = 2 * qb - 2 + t; return kt >= 0 && kt < 64; };
    auto trow = [&](int t) -> size_t { return t < 6 ? (size_t)b * 4096 + (2 * qb - 2 + t) * 64 + kr : (size_t)TL + b * 256 + (t - 6) * 64 + kr; };
    int t = 0;
    while (t < 10 && !tile_ok(t)) ++t;
    u32x4 rk = ld16(Kb + trow(t) * 256 + kvh * 64 + k8), rv = ld16(Vb + trow(t) * 256 + kvh * 64 + k8);
    while (t < 10) {
      __syncthreads();
      *(u32x4*)(sK + kr * A0_KLD + k8) = rk;
      *(u32x4*)(sV + kr * A0_VLD + k8) = rv;
      __syncthreads();
      int tn = t + 1;
      while (tn < 10 && !tile_ok(tn)) ++tn;
      if (tn < 10) { rk = ld16(Kb + trow(tn) * 256 + kvh * 64 + k8); rv = ld16(Vb + trow(tn) * 256 + kvh * 64 + k8); }
      if (t < 6) attn_tile<2, A0_VLD, true>(sK, A0_KLD, vbase, qf, Y, m, l, r, h, qpos, (2 * qb - 2 + t) * 64);
      else attn_tile<2, A0_VLD, false>(sK, A0_KLD, vbase, qf, Y, m, l, r, h, 0, 0);
      t = tn;
    }
    const float lt = l + __shfl_xor(l, 32);
    const float inv = 1.0f / lt;
#pragma unroll
    for (int dt = 0; dt < 2; ++dt)
#pragma unroll
      for (int g = 0; g < 4; ++g) {
        u32x2 w; w.x = pk2(Y[dt][4 * g] * inv, Y[dt][4 * g + 1] * inv); w.y = pk2(Y[dt][4 * g + 2] * inv, Y[dt][4 * g + 3] * inv);
        *(u32x2*)(O + (size_t)qrow * DM + head * 64 + dt * 32 + 8 * g + 4 * h) = w;
      }
  }
}

constexpr int A1_KLD = 136, A1_VLD = 160;
constexpr int A1_K8LD = 144;
constexpr int A1_V8LD = 80;
constexpr int A1_KB = 64 * A1_K8LD, A1_VB = 128 * A1_V8LD;
constexpr int A1_LDS = 2 * A1_KB + 2 * A1_VB + 4 * 128 * 32 * 4;
DI void qk_tile(const bf16_t* sK, int kld, const bf16x8 (&qf)[4], f32x16 (&X)[2], int r, int h) {
  bf16x8 kf[2][4];
#pragma unroll
  for (int sub = 0; sub < 2; ++sub)
#pragma unroll
    for (int s = 0; s < 4; ++s) kf[sub][s] = *(const bf16x8*)(sK + (sub * 32 + r) * kld + 16 * s + 8 * h);
#pragma unroll
  for (int sub = 0; sub < 2; ++sub) {
#pragma unroll
    for (int i = 0; i < 16; ++i) X[sub][i] = 0.f;
#pragma unroll
    for (int s = 0; s < 4; ++s) X[sub] = MFMA32(kf[sub][s], qf[s], X[sub]);
  }
}
typedef int v8i_t __attribute__((ext_vector_type(8)));
typedef int v4i_t __attribute__((ext_vector_type(4)));
DI void qk8_tile(const unsigned char* sK8, int kld8, const v8i_t& q8, f32x16 (&X)[2], int r, int h) {
  v8i_t kf[2];
#pragma unroll
  for (int sub = 0; sub < 2; ++sub) { const v4i_t* q_ = (const v4i_t*)(sK8 + (sub * 32 + r) * kld8 + 32 * h); kf[sub] = __builtin_shufflevector(q_[0], q_[1], 0, 1, 2, 3, 4, 5, 6, 7); }
#pragma unroll
  for (int sub = 0; sub < 2; ++sub) {
    f32x16 z;
#pragma unroll
    for (int i = 0; i < 16; ++i) z[i] = 0.f;
    X[sub] = __builtin_amdgcn_mfma_scale_f32_32x32x64_f8f6f4(kf[sub], q8, z, 0, 0, 0, 0x7f7f7f7f, 0, 0x7f7f7f7f);
  }
}
template <int DT, int QSC = 1, int PSH = 0>
DI void softmax_lazy(f32x16 (&X)[2], f32x16 (&Y)[DT], float& m, float& l) {
  constexpr float THR = 4.0f * QSC, L2E = 1.44269504089f / QSC;
  float c0 = X[0][0], c1 = X[0][1], c2 = X[0][2], c3 = X[0][3];
#pragma unroll
  for (int i = 4; i < 16; i += 4) { c0 = fmaxf(c0, X[0][i]); c1 = fmaxf(c1, X[0][i + 1]); c2 = fmaxf(c2, X[0][i + 2]); c3 = fmaxf(c3, X[0][i + 3]); }
#pragma unroll
  for (int i = 0; i < 16; i += 4) { c0 = fmaxf(c0, X[1][i]); c1 = fmaxf(c1, X[1][i + 1]); c2 = fmaxf(c2, X[1][i + 2]); c3 = fmaxf(c3, X[1][i + 3]); }
  float mx = fmaxf(fmaxf(c0, c1), fmaxf(c2, c3));
  { float a, b; swap32(mx, a, b); mx = fmaxf(a, b); }
  if (__builtin_amdgcn_ballot_w64(mx > m + THR) != 0ull) {
    const float mn = fmaxf(m, mx);
    const float alpha = __builtin_amdgcn_exp2f((m - mn) * L2E);
    m = mn; l *= alpha;
#pragma unroll
    for (int dt = 0; dt < DT; ++dt)
#pragma unroll
      for (int i = 0; i < 16; ++i) Y[dt][i] *= alpha;
  }
  const float nm = fmaf(-m, L2E, (float)PSH);
  float ps0 = 0.f, ps1 = 0.f, ps2 = 0.f, ps3 = 0.f;
#pragma unroll
  for (int sub = 0; sub < 2; ++sub)
#pragma unroll
    for (int i = 0; i < 16; i += 4) {
      const float p0 = __builtin_amdgcn_exp2f(fmaf(X[sub][i], L2E, nm)), p1 = __builtin_amdgcn_exp2f(fmaf(X[sub][i + 1], L2E, nm));
      const float p2 = __builtin_amdgcn_exp2f(fmaf(X[sub][i + 2], L2E, nm)), p3 = __builtin_amdgcn_exp2f(fmaf(X[sub][i + 3], L2E, nm));
      X[sub][i] = p0; X[sub][i + 1] = p1; X[sub][i + 2] = p2; X[sub][i + 3] = p3;
      asm("v_add_f32 %0, %1, %0" : "+v"(ps0) : "v"(p0));
      asm("v_add_f32 %0, %1, %0" : "+v"(ps1) : "v"(p1));
      asm("v_add_f32 %0, %1, %0" : "+v"(ps2) : "v"(p2));
      asm("v_add_f32 %0, %1, %0" : "+v"(ps3) : "v"(p3));
    }
  asm("v_add_f32 %0, %1, %0" : "+v"(ps0) : "v"(ps1));
  asm("v_add_f32 %0, %1, %0" : "+v"(ps2) : "v"(ps3));
  l += ps0 + ps2;
}
template <int DT, int VLD_>
DI void pv_tile(const f32x16 (&X)[2], const bf16_t* vbase, f32x16 (&Y)[DT]) {
#pragma unroll
  for (int sub = 0; sub < 2; ++sub)
#pragma unroll
    for (int s = 0; s < 2; ++s) {
      const bf16x8 pf = pack8(X[sub], s);
#pragma unroll
      for (int dt = 0; dt < DT; ++dt) {
        const bf16_t* vp = vbase + (sub * 32 + 16 * s) * VLD_ + dt * 32;
        const s16x4 lo = tr_read(vp), hi = tr_read(vp + 8 * VLD_);
        const bf16x8 vf = __builtin_shufflevector(lo, hi, 0, 1, 2, 3, 4, 5, 6, 7);
        Y[dt] = MFMA32(vf, pf, Y[dt]);
      }
    }
}
DI void phase_attn_diff(KP p, char* smem) {
  char* const ws = ows(p);
  unsigned char* sK = (unsigned char*)smem;
  unsigned char* sV = (unsigned char*)(smem + 2 * A1_KB);
  float* comb = (float*)(smem + 2 * A1_KB + 2 * A1_VB);
  const bf16_t* Q = (const bf16_t*)(ws + OFF_U + U1_Q);
  const unsigned char* K8 = (const unsigned char*)(ws + OFF_U + U1_K);
  const unsigned char* Vt = (const unsigned char*)(ws + OFF_U + U1_V);
  bf16_t* O = (bf16_t*)(ws + OFF_U + U1_O);
  const int tid = otid(), lane = tid & 63, wid = tid >> 6, r = lane & 31, h = lane >> 5, grp = wid >> 2;
  const float lambda_init = 0.8f - 0.6f * 0.74081822068f;
  float lam_full;
  {
    const float* lf = gin(p, 12);
    float s1 = 0.f, s2 = 0.f;
    for (int i = 0; i < 64; ++i) { s1 += lf[i] * lf[64 + i]; s2 += lf[128 + i] * lf[192 + i]; }
    lam_full = expf(s1) - expf(s2) + lambda_init;
  }
  const float* subg = gin(p, 13);
  const int NLAT = 16 * 8 * 32, NCTX = 16 * 8 * 2;
  const int kr = tid >> 3, kc = (tid & 7) * 16;
  for (int it = obid(); it < NLAT + NCTX; it += gridDim.x) {
    const bool lat = it < NLAT;
    int b, head, qrow, t0;
    const int nt = 68;
    if (lat) { b = it >> 8; head = (it >> 5) & 7; const int qb = it & 31; qrow = b * 4096 + qb * 128 + (wid & 3) * 32 + r; t0 = 0; }
    else { const int i2 = it - NLAT; b = i2 >> 4; head = (i2 >> 1) & 7; const int hf = i2 & 1; qrow = TL + b * 256 + hf * 128 + (wid & 3) * 32 + r; t0 = 64; }
    v8i_t q8;
    {
      const bf16_t* qp = Q + (size_t)qrow * DM + head * 128 + grp * 64 + 32 * h;
#pragma unroll
      for (int c4 = 0; c4 < 4; ++c4) {
        const u32x4 w = ld16(qp + 8 * c4);
        q8[2 * c4] = (int)pk4_fp8(bflo(w.x) * 8.f, bfhi(w.x) * 8.f, bflo(w.y) * 8.f, bfhi(w.y) * 8.f);
        q8[2 * c4 + 1] = (int)pk4_fp8(bflo(w.z) * 8.f, bfhi(w.z) * 8.f, bflo(w.w) * 8.f, bfhi(w.w) * 8.f);
      }
    }
    f32x16 Y[4];
#pragma unroll
    for (int dt = 0; dt < 4; ++dt)
#pragma unroll
      for (int i = 0; i < 16; ++i) Y[dt][i] = 0.f;
    float m = -1e30f, l = 0.f;
    auto goff = [&](int t) -> size_t { return (t < 64 ? (size_t)b * 4096 + t * 64 + kr : (size_t)TL + b * 256 + (t - 64) * 64 + kr) * 1024 + head * 128 + kc; };
    auto stK = [&](int t, const u32x4& a) { *(u32x4*)(sK + (t & 1) * A1_KB + kr * A1_K8LD + kc) = a; };
    const int vd = tid >> 2, vcx = (tid & 3) * 16;
    auto voff = [&](int t) -> size_t { return t < 64 ? ((size_t)(b * 1024 + head * 128 + vd) * 4096 + (size_t)t * 64 + vcx) : ((size_t)16 * 1024 * 4096 + (size_t)(b * 1024 + head * 128 + vd) * 256 + (size_t)(t - 64) * 64 + vcx); };
    auto stV = [&](int t, const u32x4& a) { *(u32x4*)(sV + (t & 1) * A1_VB + vd * A1_V8LD + vcx) = a; };
    u32x4 rk0, rv0;
    __syncthreads();
    rk0 = *(const u32x4*)(K8 + goff(t0)); stK(t0, rk0);
    rk0 = *(const u32x4*)(K8 + goff(t0 + 1)); stK(t0 + 1, rk0);
    rk0 = *(const u32x4*)(K8 + goff(t0 + 2));
    rv0 = *(const u32x4*)(Vt + voff(t0));
    __syncthreads();
    f32x16 Xn[2];
    qk8_tile(sK + (t0 & 1) * A1_KB + grp * 64, A1_K8LD, q8, Xn, r, h);
    __syncthreads();
    v8i_t p8;
    auto pv8 = [&](int t) __attribute__((always_inline)) {
      const unsigned char* vb8 = sV + (t & 1) * A1_VB + r * A1_V8LD + 32 * h;
#pragma unroll
      for (int dt = 0; dt < 4; ++dt) {
        const v4i_t* q_ = (const v4i_t*)(vb8 + dt * 32 * A1_V8LD);
        const v8i_t vf = __builtin_shufflevector(q_[0], q_[1], 0, 1, 2, 3, 4, 5, 6, 7);
        Y[dt] = __builtin_amdgcn_mfma_scale_f32_32x32x64_f8f6f4(vf, p8, Y[dt], 0, 0, 0, 0x7f7f7f7f, 0, 0x7f7f7f7f);
      }
    };
    for (int t = t0; t < nt; ++t) {
      if (t + 2 < nt) stK(t + 2, rk0);
      stV(t, rv0);
      if (t + 3 < nt) rk0 = *(const u32x4*)(K8 + goff(t + 3));
      if (t + 1 < nt) rv0 = *(const u32x4*)(Vt + voff(t + 1));
      f32x16 X[2];
      X[0] = Xn[0]; X[1] = Xn[1];
      if (t + 1 < nt) qk8_tile(sK + ((t + 1) & 1) * A1_KB + grp * 64, A1_K8LD, q8, Xn, r, h);
      if (t > t0) pv8(t - 1);
      softmax_lazy<4, 8, 2>(X, Y, m, l);
#pragma unroll
      for (int sub = 0; sub < 2; ++sub)
#pragma unroll
        for (int g4 = 0; g4 < 4; ++g4) p8[4 * sub + g4] = (int)pk4_fp8_nc(X[sub][4 * g4], X[sub][4 * g4 + 1], X[sub][4 * g4 + 2], X[sub][4 * g4 + 3]);
      __syncthreads();
    }
    pv8(nt - 1);
    const float lt = l + __shfl_xor(l, 32);
    const float inv = 1.0f / lt;
    if (grp == 1) {
#pragma unroll
      for (int dt = 0; dt < 4; ++dt)
#pragma unroll
        for (int i = 0; i < 16; ++i) comb[(((wid & 3) * 128) + dt * 32 + (i & 3) + 8 * (i >> 2) + 4 * h) * 32 + r] = Y[dt][i] * inv;
    }
    __syncthreads();
    if (grp == 0) {
      float ss = 0.f;
#pragma unroll
      for (int dt = 0; dt < 4; ++dt)
#pragma unroll
        for (int i = 0; i < 16; ++i) {
          const float o2 = comb[(((wid & 3) * 128) + dt * 32 + (i & 3) + 8 * (i >> 2) + 4 * h) * 32 + r];
          const float vv = Y[dt][i] * inv - lam_full * o2;
          Y[dt][i] = vv; ss += vv * vv;
        }
      ss += __shfl_xor(ss, 32);
      const float rs = rsqrtf(ss * (1.0f / 128.0f) + 1e-6f) * (1.0f - lambda_init);
#pragma unroll
      for (int dt = 0; dt < 4; ++dt)
#pragma unroll
        for (int g = 0; g < 4; ++g) {
          const int d0 = dt * 32 + 8 * g + 4 * h;
          const f32x4 sg = *(const f32x4*)(subg + d0);
          const float r8 = rs * O8_SCALE;
          *(unsigned*)((unsigned char*)O + (size_t)qrow * DM + head * 128 + d0) = pk4_fp8(Y[dt][4 * g] * r8 * sg[0], Y[dt][4 * g + 1] * r8 * sg[1], Y[dt][4 * g + 2] * r8 * sg[2], Y[dt][4 * g + 3] * r8 * sg[3]);
        }
    }
  }
}

DI u32x4 rwkv_mix_load(const bf16_t* hb, const float* mu, int mixi, int row, int k) {
  int s, L;
  if (row < TL) { s = row & 4095; L = 4096; } else { s = (row - TL) & 255; L = 256; }
  const bf16_t* hp = hb + (size_t)row * DM + k;
  const u32x4 c = ld16(hp);
  u32x4 pv = (u32x4){0u, 0u, 0u, 0u}, nx = (u32x4){0u, 0u, 0u, 0u};
  if (s > 0) pv = ld16(hp - DM);
  if (s < L - 1) nx = ld16(hp + DM);
  const float* m0 = mu + (size_t)(0 * 6 + mixi) * DM + k;
  const float* m1 = mu + (size_t)(1 * 6 + mixi) * DM + k;
  const f32x4 a0 = *(const f32x4*)m0, a1 = *(const f32x4*)(m0 + 4), b0 = *(const f32x4*)m1, b1 = *(const f32x4*)(m1 + 4);
  float cv[8] = {bflo(c.x), bfhi(c.x), bflo(c.y), bfhi(c.y), bflo(c.z), bfhi(c.z), bflo(c.w), bfhi(c.w)};
  float pvv[8] = {bflo(pv.x), bfhi(pv.x), bflo(pv.y), bfhi(pv.y), bflo(pv.z), bfhi(pv.z), bflo(pv.w), bfhi(pv.w)};
  float nv[8] = {bflo(nx.x), bfhi(nx.x), bflo(nx.y), bfhi(nx.y), bflo(nx.z), bfhi(nx.z), bflo(nx.w), bfhi(nx.w)};
  float mu0[8] = {a0[0], a0[1], a0[2], a0[3], a1[0], a1[1], a1[2], a1[3]};
  float mu1[8] = {b0[0], b0[1], b0[2], b0[3], b1[0], b1[1], b1[2], b1[3]};
  float o[8];
#pragma unroll
  for (int j = 0; j < 8; ++j) o[j] = cv[j] + (pvv[j] - cv[j]) * mu0[j] + (nv[j] - cv[j]) * mu1[j];
  u32x4 w; w.x = pk2(o[0], o[1]); w.y = pk2(o[2], o[3]); w.z = pk2(o[4], o[5]); w.w = pk2(o[6], o[7]);
  return w;
}
template <int ACT  , class AL>
DI void rwkv_gemm_tile(char* smem, AL la, const bf16_t* Bt, int K, int ldb, bf16_t* dst, int ldd, int row0, int col0, int ncols_valid) {
  auto lb = [&](int tn, int k) -> u32x4 { return (col0 + tn) < ncols_valid ? ld16(Bt + (size_t)(col0 + tn) * ldb + k) : (u32x4){0u, 0u, 0u, 0u}; };
  auto ep = [&](const f32x4 (&acc)[4][2], int r0, int c0, int fr, int fq) {
#pragma unroll
    for (int m = 0; m < 4; ++m)
#pragma unroll
      for (int n = 0; n < 2; ++n)
#pragma unroll
        for (int j = 0; j < 4; ++j) {
          const int row = row0 + r0 + m * 16 + fq * 4 + j, col = col0 + c0 + n * 16 + fr;
          float v = acc[m][n][j];
          if (ACT == 1) v = 1.0f - 2.0f * __builtin_amdgcn_rcpf(1.0f + __expf(2.0f * v));
          if (ACT == 2) v = sigmoidf_(v);
          if (col < ncols_valid) dst[(size_t)row * ldd + col] = f2bf(v);
        }
  };
  sgemm_tile(smem, K, la, lb, ep);
}
DI void phase_rwkv_mix(KP p, char* smem) {
  char* const ws = ows(p);
  const int lane = otid() & 63, wid = otid() >> 6;
  const bf16_t* hb = (const bf16_t*)(ws + OFF_H);
  const float* mu = gin(p, 18);
  bf16_t* XR = (bf16_t*)(ws + OFF_U + U3_XR);
  bf16_t* XK = (bf16_t*)(ws + OFF_U + U3_XK);
  bf16_t* XV = (bf16_t*)(ws + OFF_U + U3_XV);
  const int ch0 = lane * 16;
  for (int r = obid() * 8 + wid; r < TT; r += gridDim.x * 8) {
    int s, L;
    if (r < TL) { s = r & 4095; L = 4096; } else { s = (r - TL) & 255; L = 256; }
    const bf16_t* hp = hb + (size_t)r * DM + ch0;
    float c[16], pv[16], nx[16];
    {
      const u32x4 a = ld16(hp), b = ld16(hp + 8);
      c[0] = bflo(a.x); c[1] = bfhi(a.x); c[2] = bflo(a.y); c[3] = bfhi(a.y); c[4] = bflo(a.z); c[5] = bfhi(a.z); c[6] = bflo(a.w); c[7] = bfhi(a.w);
      c[8] = bflo(b.x); c[9] = bfhi(b.x); c[10] = bflo(b.y); c[11] = bfhi(b.y); c[12] = bflo(b.z); c[13] = bfhi(b.z); c[14] = bflo(b.w); c[15] = bfhi(b.w);
    }
#pragma unroll
    for (int j = 0; j < 16; ++j) { pv[j] = 0.f; nx[j] = 0.f; }
    if (s > 0) {
      const u32x4 a = ld16(hp - DM), b = ld16(hp - DM + 8);
      pv[0] = bflo(a.x); pv[1] = bfhi(a.x); pv[2] = bflo(a.y); pv[3] = bfhi(a.y); pv[4] = bflo(a.z); pv[5] = bfhi(a.z); pv[6] = bflo(a.w); pv[7] = bfhi(a.w);
      pv[8] = bflo(b.x); pv[9] = bfhi(b.x); pv[10] = bflo(b.y); pv[11] = bfhi(b.y); pv[12] = bflo(b.z); pv[13] = bfhi(b.z); pv[14] = bflo(b.w); pv[15] = bfhi(b.w);
    }
    if (s < L - 1) {
      const u32x4 a = ld16(hp + DM), b = ld16(hp + DM + 8);
      nx[0] = bflo(a.x); nx[1] = bfhi(a.x); nx[2] = bflo(a.y); nx[3] = bfhi(a.y); nx[4] = bflo(a.z); nx[5] = bfhi(a.z); nx[6] = bflo(a.w); nx[7] = bfhi(a.w);
      nx[8] = bflo(b.x); nx[9] = bfhi(b.x); nx[10] = bflo(b.y); nx[11] = bfhi(b.y); nx[12] = bflo(b.z); nx[13] = bfhi(b.z); nx[14] = bflo(b.w); nx[15] = bfhi(b.w);
    }
#pragma unroll
    for (int q = 0; q < 3; ++q) {
      const int mixi = q == 0 ? 0 : q + 1;
      if (q == 0 && r >= TL) continue;
      unsigned char* dst = (unsigned char*)(q == 0 ? XR : q == 1 ? XK : XV) + (size_t)r * DM + ch0;
      const float* m0 = mu + (size_t)(0 * 6 + mixi) * DM + ch0;
      const float* m1 = mu + (size_t)(1 * 6 + mixi) * DM + ch0;
      float o[16];
#pragma unroll
      for (int j4 = 0; j4 < 4; ++j4) {
        const f32x4 a = *(const f32x4*)(m0 + 4 * j4), b = *(const f32x4*)(m1 + 4 * j4);
#pragma unroll
        for (int j = 0; j < 4; ++j) { const int k = 4 * j4 + j; o[k] = c[k] + (pv[k] - c[k]) * a[j] + (nx[k] - c[k]) * b[j]; }
      }
      u32x4 w0;
      w0.x = pk4_fp8(o[0] * X8_SCALE, o[1] * X8_SCALE, o[2] * X8_SCALE, o[3] * X8_SCALE); w0.y = pk4_fp8(o[4] * X8_SCALE, o[5] * X8_SCALE, o[6] * X8_SCALE, o[7] * X8_SCALE);
      w0.z = pk4_fp8(o[8] * X8_SCALE, o[9] * X8_SCALE, o[10] * X8_SCALE, o[11] * X8_SCALE); w0.w = pk4_fp8(o[12] * X8_SCALE, o[13] * X8_SCALE, o[14] * X8_SCALE, o[15] * X8_SCALE);
      *(u32x4*)dst = w0;
    }
  }
}
struct RkvSched {
  const char* X0; const char* X1; const char* X2; const char* W; int G, c;
  DI bool next(int i, fg::Unit& u) const {
    int pmg, pn; if (!fg::static_order(i, G, c, 800, 4, pmg, pn)) return false;
    const int job = (pmg >= 256) + (pmg >= 528);
    u.pm = pmg - (job ? 256 + (job - 1) * 272 : 0); u.pn = pn; u.aux = job;
    u.A = X0 + (size_t)job * SZ_TT + (size_t)u.pm * 256 * 1024;
    u.B = W + (size_t)job * 1024 * 1024 * 2 + (size_t)u.pn * 256 * 1024; return true;
  }
  DI const LAS int* rows(int) const { return nullptr; }
};
DI void phase_rwkv_rkv(KP p, char* smem) {
  char* const ws = ows(p);
  LAS unsigned char* lds = (LAS unsigned char*)smem;
  char* U = ws + OFF_U;
  RkvSched S; S.X0 = U + U3_XR; S.X1 = U + U3_XK; S.X2 = U + U3_XV; S.W = ws + OFF_WMIX + W_R * 2; S.G = gridDim.x; S.c = obid();
  auto ep = [&](const f32x16 (&acc)[2][2][2], const fg::Unit& u, int wr, int wc, int r, int h) {
    bf16_t* dst = (bf16_t*)(U + (u.aux ? SZ_TL + (size_t)(u.aux - 1) * SZ_TT : (size_t)0));
    constexpr float inv = 1.0f / (X8_SCALE * 32.0f);
#pragma unroll
    for (int ai = 0; ai < 2; ++ai)
#pragma unroll
      for (int m = 0; m < 2; ++m) {
        const size_t row = (size_t)u.pm * 256 + ai * 128 + wr * 64 + m * 32 + r;
#pragma unroll
        for (int bj = 0; bj < 2; ++bj) {
          const f32x16& a = acc[ai][bj][m];
          u32x4 w0, w1;
          w0.x = pk2(a[0] * inv, a[1] * inv); w0.y = pk2(a[2] * inv, a[3] * inv); w0.z = pk2(a[4] * inv, a[5] * inv); w0.w = pk2(a[6] * inv, a[7] * inv);
          w1.x = pk2(a[8] * inv, a[9] * inv); w1.y = pk2(a[10] * inv, a[11] * inv); w1.z = pk2(a[12] * inv, a[13] * inv); w1.w = pk2(a[14] * inv, a[15] * inv);
          bf16_t* q = dst + row * DM + u.pn * 256 + bj * 128 + wc * 32 + 16 * h;
          *(u32x4*)q = w0; *(u32x4*)(q + 8) = w1;
        }
      }
  };
  fg::gemm_phase_f8<false, true>(lds, 512, 512, 512, S, ep);
}

DI void phase_rwkv_feat1(KP p, char* smem) {
  char* const ws = ows(p);
  const bf16_t* hb = (const bf16_t*)(ws + OFF_H);
  const bf16_t* wm = (const bf16_t*)(ws + OFF_WMIX);
  const float* mu = gin(p, 18);
  char* U = ws + OFF_U;
  const int n3 = 544, n4 = n3 + 544, n5 = n4 + 512;
  for (int t = obid(); t < n5; t += gridDim.x) {
    if (t < n3) {
      const int row0 = t * 128;
      auto la = [&](int trow, int k) -> u32x4 { return rwkv_mix_load(hb, mu, 1, row0 + trow, k); };
      rwkv_gemm_tile<1>(smem, la, wm + W_WA1, 1024, 1024, (bf16_t*)(U + U3_LW), 128, row0, 0, 128);
    } else if (t < n4) {
      const int row0 = (t - n3) * 128;
      auto la = [&](int trow, int k) -> u32x4 { return rwkv_mix_load(hb, mu, 4, row0 + trow, k); };
      rwkv_gemm_tile<0>(smem, la, wm + W_AA1, 1024, 1024, (bf16_t*)(U + U3_LA), 128, row0, 0, 128);
    } else {
      const int row0 = (t - n4) * 128;
      auto la = [&](int trow, int k) -> u32x4 { return rwkv_mix_load(hb, mu, 5, row0 + trow, k); };
      rwkv_gemm_tile<2>(smem, la, wm + W_G1, 1024, 1024, (bf16_t*)(U + U3_LG), 128, row0, 0, 128);
    }
  }
}
struct Feat2Sched {
  const char* U; const char* W; int G, c;
  DI bool next(int i, fg::Unit& u) const {
    const int L = i * G + c; if (L >= 2176 + 2176 + 1024) return false;
    const int job = (L >= 2176) + (L >= 4352), loc = L - job * 2176;
    if (job < 2) { u.pm = loc >> 3; u.pn = loc & 7; } else { u.pm = loc >> 2; u.pn = loc & 3; }
    u.aux = job;
    u.A = U + (job == 0 ? U3_LW : job == 1 ? U3_LA : U3_LG) + (size_t)u.pm * 256 * 128 * 2;
    u.B = W + ((job == 0 ? W_WA2 : job == 1 ? W_AA2 : W_G2) + (size_t)u.pn * 256 * 128) * 2; return true;
  }
  DI const LAS int* rows(int) const { return nullptr; }
};
DI void phase_rwkv_feat2(KP p, char* smem) {
  char* const ws = ows(p);
  LAS unsigned char* lds = (LAS unsigned char*)smem;
  char* U = ws + OFF_U;
  Feat2Sched S; S.U = U; S.W = ws + OFF_WMIX; S.G = gridDim.x; S.c = obid();
  const float* w0 = gin(p, 20);
  const float* a0 = gin(p, 23);
  auto ep = [&](const f32x4 (&acc)[2][2][4][2], const fg::Unit& u, int wr, int wc, int fr, int fq) {
    const int job = u.aux, d = u.pn >> 2;
    const int colu = (job < 2 ? (u.pn & 3) : u.pn) * 256 + wc * 32 + 8 * fq;
    bf16_t* dst = (bf16_t*)(U + (job == 0 ? (d ? U3_LD1 : U3_LD0) : job == 1 ? (d ? U3_A1 : U3_A0) : U3_G));
    const float* bias = (job == 0 ? w0 : a0) + d * 1024;
#pragma unroll
    for (int ai = 0; ai < 2; ++ai)
#pragma unroll
      for (int m = 0; m < 4; ++m) {
        const size_t row = (size_t)u.pm * 256 + ai * 128 + wr * 64 + m * 16 + fr;
#pragma unroll
        for (int bj = 0; bj < 2; ++bj) {
          f32x4 x0 = acc[ai][bj][m][0], x1 = acc[ai][bj][m][1];
          if (job < 2) {
            const f32x4 b0 = *(const f32x4*)(bias + colu + bj * 128), b1 = *(const f32x4*)(bias + colu + bj * 128 + 4);
            const float sc_ = job == 0 ? -0.60653065971f : 1.0f;
#pragma unroll
            for (int j = 0; j < 4; ++j) { x0[j] = sc_ * sigmoidf_(x0[j] + b0[j]); x1[j] = sc_ * sigmoidf_(x1[j] + b1[j]); }
          }
          u32x4 w; w.x = pk2(x0[0], x0[1]); w.y = pk2(x0[2], x0[3]); w.z = pk2(x1[0], x1[1]); w.w = pk2(x1[2], x1[3]);
          *(u32x4*)(dst + row * DM + colu + bj * 128) = w;
        }
      }
  };
  fg::gemm_phase<false, true>(lds, 128, 128, 128, S, ep);
}

constexpr int C3_L = 32, C3_LDK = 72, C3_LDT = 40, C3_LDY = 36;
constexpr int C3_BT = 0, C3_RT = 4608, C3_KT = 9216, C3_CT = 13824, C3_KHT = 18432, C3_CHT = 23552, C3_VT = 28672, C3_GKB = 33792, C3_GKR = 36352,
              C3_GCR = 38912, C3_S0 = 41472, C3_U = 50688, C3_MCB = 55808, C3_Y = 59904, C3_E = 69120, C3_TOT = 69376, C3_SCAN = 70400;
constexpr int SC_LDS = 2 * C3_SCAN;
DI void lds_bar() { asm volatile("s_waitcnt lgkmcnt(0)" ::: "memory"); __builtin_amdgcn_s_barrier(); asm volatile("" ::: "memory"); }
#define DPP_ADD(s, ctrl) ((s) + __builtin_bit_cast(float, __builtin_amdgcn_update_dpp(0, __builtin_bit_cast(int, (s)), (ctrl), 0xF, 0xF, true)))
DI float wave_sum_dpp(float s) {
  s = DPP_ADD(s, 0xB1); s = DPP_ADD(s, 0x4E); s = DPP_ADD(s, 0x141); s = DPP_ADD(s, 0x140);
  const int si = __builtin_bit_cast(int, s);
  const float a0 = __builtin_bit_cast(float, __builtin_amdgcn_readlane(si, 0)), a1 = __builtin_bit_cast(float, __builtin_amdgcn_readlane(si, 16));
  const float a2 = __builtin_bit_cast(float, __builtin_amdgcn_readlane(si, 32)), a3 = __builtin_bit_cast(float, __builtin_amdgcn_readlane(si, 48));
  return (a0 + a1) + (a2 + a3);
}
DI void phase_rwkv_scan(KP p, char* smem) {
  char* const ws = ows(p);
  const int tid = otid(), lane = tid & 63, wid = tid >> 6, sc = wid >> 2, w4 = wid & 3, r = lane & 31, h = lane >> 5;
  char* sb = smem + sc * C3_SCAN;
  bf16_t* Bt = (bf16_t*)(sb + C3_BT); bf16_t* Rt = (bf16_t*)(sb + C3_RT); bf16_t* Kt = (bf16_t*)(sb + C3_KT); bf16_t* Ct = (bf16_t*)(sb + C3_CT);
  bf16_t* KhT = (bf16_t*)(sb + C3_KHT); bf16_t* ChT = (bf16_t*)(sb + C3_CHT); bf16_t* Vt = (bf16_t*)(sb + C3_VT);
  bf16_t* GkbT = (bf16_t*)(sb + C3_GKB); bf16_t* GkrT = (bf16_t*)(sb + C3_GKR); bf16_t* GcrT = (bf16_t*)(sb + C3_GCR);
  bf16_t* S0b = (bf16_t*)(sb + C3_S0); bf16_t* Ub = (bf16_t*)(sb + C3_U);
  float* McbP = (float*)(sb + C3_MCB); float* Yb = (float*)(sb + C3_Y); float* Eb = (float*)(sb + C3_E); float* Tot = (float*)(sb + C3_TOT);
  char* U = ws + OFF_U;
  const bf16_t* Kx = (const bf16_t*)(U + U3_K);
  const bf16_t* Vx = (const bf16_t*)(U + U3_V);
  const bf16_t* Rx = (const bf16_t*)(U + U3_R);
  const int ti = w4 >> 1, tj = w4 & 1;
  const int tio = w4 & 1;
  const int sv = w4 * 16 + (lane >> 2), jq = lane & 3;
  for (int base = obid() * 2; base < 512; base += gridDim.x * 2) {
    const int item = base + sc, dir = item & 1, head = (item >> 1) & 15, b = item >> 5;
    const bf16_t* Ax = (const bf16_t*)(U + (dir ? U3_A1 : U3_A0));
    const bf16_t* Lx = (const bf16_t*)(U + (dir ? U3_LD1 : U3_LD0));
    bf16_t* Ox = (bf16_t*)(U + (dir ? U3_O1 : U3_O0));
    const int ch = head * 64 + lane;
    const float kkw = gin(p, 28)[ch], kaw = gin(p, 29)[ch];
    auto rowof = [&](int n) -> int {
      if (n < 256) { const int c = dir ? 255 - n : n; return TL + b * 256 + c; }
      const int s = dir ? 4095 - (n - 256) : n - 256; return b * 4096 + s;
    };
    f32x16 S;
#pragma unroll
    for (int i = 0; i < 16; ++i) S[i] = 0.f;
    for (int i = lane; i < 64 * C3_LDK / 4; i += 64) if (w4 == 0) ((unsigned long long*)S0b)[i] = 0ull;
    bf16_t pk_[8], pa_[8], pl_[8], pv_[8], pr_[8];
    auto prefetch = [&](int c) {
#pragma unroll
      for (int q = 0; q < 8; ++q) {
        const int n = c * C3_L + w4 * 8 + q;
        const size_t off = (size_t)rowof(n) * DM + ch;
        pk_[q] = Kx[off]; pa_[q] = Ax[off]; pl_[q] = Lx[off]; pv_[q] = Vx[off];
        pr_[q] = n >= 256 ? Rx[off] : (bf16_t)0;
      }
    };
    constexpr int NCH = 4352 / C3_L;
    prefetch(0);
    lds_bar();
    for (int c = 0; c < NCH; ++c) {
      float kkv[8], cv[8], kdv[8], lv[8], cl[8], rv[8], vv[8];
      {
        float run = 0.f;
#pragma unroll
        for (int q = 0; q < 8; ++q) {
          const float kv = bf2f(pk_[q]), av = bf2f(pa_[q]);
          lv[q] = bf2f(pl_[q]); rv[q] = bf2f(pr_[q]); vv[q] = bf2f(pv_[q]);
          const float kkr = kv * kkw;
          kkv[q] = kkr * __builtin_amdgcn_rsqf(fmaxf(wave_sum_dpp(kkr * kkr), 1e-24f));
          cv[q] = kkv[q] * av;
          kdv[q] = kv * (1.0f + (av - 1.0f) * kaw);
          run += lv[q]; cl[q] = run;
        }
        Tot[w4 * 64 + lane] = run;
      }
      if (c + 1 < NCH) prefetch(c + 1);
      lds_bar();
      {
        const float t0 = Tot[lane], t1 = Tot[64 + lane], t2 = Tot[128 + lane], t3 = Tot[192 + lane];
        const float cumL = (t0 + t1) + (t2 + t3);
        const float off = w4 == 0 ? 0.f : (w4 == 1 ? t0 : (w4 == 2 ? t0 + t1 : (t0 + t1) + t2));
        float kh[8], chh[8];
#pragma unroll
        for (int q = 0; q < 8; ++q) {
          const int t = w4 * 8 + q;
          const float cumt = off + cl[q], cump = cumt - lv[q];
          const float e1 = __expf(cump), e2 = __expf(cumt), e3 = __expf(-cumt), e4 = __expf(cumL - cumt);
          Bt[t * C3_LDK + lane] = f2bf(kkv[q] * e1);
          Rt[t * C3_LDK + lane] = f2bf(rv[q] * e2);
          Kt[t * C3_LDK + lane] = f2bf(kdv[q] * e3);
          Ct[t * C3_LDK + lane] = f2bf(cv[q] * e3);
          kh[q] = kdv[q] * e4; chh[q] = cv[q] * e4;
        }
        u32x4 w;
        w.x = pk2(kh[0], kh[1]); w.y = pk2(kh[2], kh[3]); w.z = pk2(kh[4], kh[5]); w.w = pk2(kh[6], kh[7]);
        *(u32x4*)(KhT + lane * C3_LDT + w4 * 8) = w;
        w.x = pk2(chh[0], chh[1]); w.y = pk2(chh[2], chh[3]); w.z = pk2(chh[4], chh[5]); w.w = pk2(chh[6], chh[7]);
        *(u32x4*)(ChT + lane * C3_LDT + w4 * 8) = w;
        w.x = pk2(vv[0], vv[1]); w.y = pk2(vv[2], vv[3]); w.z = pk2(vv[4], vv[5]); w.w = pk2(vv[6], vv[7]);
        *(u32x4*)(Vt + lane * C3_LDT + w4 * 8) = w;
        if (w4 == 0) Eb[lane] = __expf(cumL);
      }
      lds_bar();
      {
        const bf16_t* Ag = (w4 & 1) ? Kt : Ct;
        const bf16_t* Bg = (w4 & 2) ? Rt : Bt;
        f32x16 X;
#pragma unroll
        for (int i = 0; i < 16; ++i) X[i] = 0.f;
#pragma unroll
        for (int s = 0; s < 4; ++s) {
          const bf16x8 a = *(const bf16x8*)(Ag + r * C3_LDK + 16 * s + 8 * h);
          const bf16x8 bq = *(const bf16x8*)(Bg + r * C3_LDK + 16 * s + 8 * h);
          X = MFMA32(a, bq, X);
        }
        const bool incl = (w4 & 2) != 0;
#pragma unroll
        for (int i = 0; i < 16; ++i) { const int jr = (i & 3) + 8 * (i >> 2) + 4 * h; if (!(jr < r || (incl && jr == r))) X[i] = 0.f; }
        if (w4 == 0) {
#pragma unroll
          for (int i = 0; i < 16; ++i) { const int jr = (i & 3) + 8 * (i >> 2) + 4 * h; McbP[r * 32 + (jr & 3) * 8 + (jr >> 2)] = X[i]; }
        } else {
          bf16_t* G = w4 == 1 ? GkbT : (w4 == 2 ? GcrT : GkrT);
#pragma unroll
          for (int g = 0; g < 4; ++g) { u32x2 w; w.x = pk2(X[4 * g], X[4 * g + 1]); w.y = pk2(X[4 * g + 2], X[4 * g + 3]); *(u32x2*)(G + r * C3_LDT + 8 * g + 4 * h) = w; }
        }
      }
      lds_bar();
      f32x16 XO;
      {
        const bf16_t* Bq = (w4 & 2) ? Rt : Bt;
        const bf16_t* Gq = (w4 & 2) ? GkrT : GkbT;
#pragma unroll
        for (int i = 0; i < 16; ++i) XO[i] = 0.f;
#pragma unroll
        for (int s = 0; s < 4; ++s) {
          const bf16x8 a = *(const bf16x8*)(S0b + (32 * tio + r) * C3_LDK + 16 * s + 8 * h);
          const bf16x8 bq = *(const bf16x8*)(Bq + r * C3_LDK + 16 * s + 8 * h);
          XO = MFMA32(a, bq, XO);
        }
#pragma unroll
        for (int s = 0; s < 2; ++s) {
          const bf16x8 a = *(const bf16x8*)(Vt + (32 * tio + r) * C3_LDT + 16 * s + 8 * h);
          const bf16x8 bq = *(const bf16x8*)(Gq + r * C3_LDT + 16 * s + 8 * h);
          XO = MFMA32(a, bq, XO);
        }
        if (w4 < 2) {
#pragma unroll
          for (int i = 0; i < 16; ++i) Yb[(32 * tio + (i & 3) + 8 * (i >> 2) + 4 * h) * C3_LDY + r] = XO[i];
        }
      }
      lds_bar();
      {
        float u[8];
#pragma unroll
        for (int jj = 0; jj < 8; ++jj) u[jj] = 0.f;
        const unsigned ma = (unsigned)(size_t)(McbP + jq * 8);
        f32x4 yv[8];
#pragma unroll
        for (int i = 0; i < 8; ++i) yv[i] = *(const f32x4*)(Yb + sv * C3_LDY + 4 * i);
        f32x4 mA[4], mB[4];
#define C3_MLOAD(t_) asm volatile("ds_read_b128 %0, %2 offset:%c3\n\tds_read_b128 %1, %2 offset:%c4" : "=&v"(mA[(t_) & 3]), "=&v"(mB[(t_) & 3]) : "v"(ma), "i"((t_) * 128), "i"((t_) * 128 + 16) : "memory")
        C3_MLOAD(1); C3_MLOAD(2); C3_MLOAD(3);
        if (jq == 0) u[0] = yv[0][0];
#pragma unroll
        for (int t = 1; t < 32; ++t) {
          if (t + 3 < 32) { C3_MLOAD(t + 3); asm volatile("s_waitcnt lgkmcnt(6)" ::: "memory"); }
          else if (t + 2 < 32) asm volatile("s_waitcnt lgkmcnt(4)" ::: "memory");
          else if (t + 1 < 32) asm volatile("s_waitcnt lgkmcnt(2)" ::: "memory");
          else asm volatile("s_waitcnt lgkmcnt(0)" ::: "memory");
          asm volatile("" :: "v"(mA[t & 3]), "v"(mB[t & 3]));
          __builtin_amdgcn_sched_barrier(0);
          const f32x4 m0 = mA[t & 3], m1 = mB[t & 3];
          const int jl = (t - 1) >> 2;
          float part = 0.f;
#pragma unroll
          for (int jj = 0; jj < 8; ++jj) if (jj != jl && jj * 4 < t) part += u[jj] * (jj < 4 ? m0[jj] : m1[jj - 4]);
          part += u[jl] * (jl < 4 ? m0[jl] : m1[jl - 4]);
          part = DPP_ADD(part, 0xB1); part = DPP_ADD(part, 0x4E);
          const float ut = yv[t >> 2][t & 3] - part;
          u[t >> 2] = (jq == (t & 3)) ? ut : u[t >> 2];
        }
#undef C3_MLOAD
#pragma unroll
        for (int jj = 0; jj < 8; ++jj) Ub[sv * C3_LDT + jq + 4 * jj] = f2bf(u[jj]);
      }
      lds_bar();
      if (w4 >= 2) {
        f32x16 X2;
#pragma unroll
        for (int i = 0; i < 16; ++i) X2[i] = 0.f;
#pragma unroll
        for (int s = 0; s < 2; ++s) {
          const bf16x8 a = *(const bf16x8*)(Ub + (32 * tio + r) * C3_LDT + 16 * s + 8 * h);
          const bf16x8 bq = *(const bf16x8*)(GcrT + r * C3_LDT + 16 * s + 8 * h);
          X2 = MFMA32(a, bq, X2);
        }
        if (c * C3_L >= 256) {
          const size_t orow = (size_t)rowof(c * C3_L + r) * DM + head * 64 + 32 * tio + 4 * h;
#pragma unroll
          for (int g = 0; g < 4; ++g) {
            u32x2 w; w.x = pk2(XO[4 * g] - X2[4 * g], XO[4 * g + 1] - X2[4 * g + 1]); w.y = pk2(XO[4 * g + 2] - X2[4 * g + 2], XO[4 * g + 3] - X2[4 * g + 3]);
            *(u32x2*)(Ox + orow + 8 * g) = w;
          }
        }
      }
      {
        f32x16 P1, P2;
#pragma unroll
        for (int i = 0; i < 16; ++i) { P1[i] = 0.f; P2[i] = 0.f; }
#pragma unroll
        for (int s = 0; s < 2; ++s) {
          const bf16x8 av = *(const bf16x8*)(Vt + (32 * ti + r) * C3_LDT + 16 * s + 8 * h);
          const bf16x8 bk = *(const bf16x8*)(KhT + (32 * tj + r) * C3_LDT + 16 * s + 8 * h);
          P1 = MFMA32(av, bk, P1);
          const bf16x8 au = *(const bf16x8*)(Ub + (32 * ti + r) * C3_LDT + 16 * s + 8 * h);
          const bf16x8 bc = *(const bf16x8*)(ChT + (32 * tj + r) * C3_LDT + 16 * s + 8 * h);
          P2 = MFMA32(au, bc, P2);
        }
        const float ek = Eb[32 * tj + r];
#pragma unroll
        for (int i = 0; i < 16; ++i) {
          S[i] = S[i] * ek + P1[i] - P2[i];
          S0b[(32 * ti + (i & 3) + 8 * (i >> 2) + 4 * h) * C3_LDK + 32 * tj + r] = f2bf(S[i]);
        }
      }
      lds_bar();
    }
  }
}

DI void phase_rwkv_out(KP p, char* smem) {
  char* const ws = ows(p);
  const int lane = otid() & 63, wid = otid() >> 6;
  char* U = ws + OFF_U;
  const bf16_t *Rx = (const bf16_t*)(U + U3_R), *Kx = (const bf16_t*)(U + U3_K), *Vx = (const bf16_t*)(U + U3_V), *A0 = (const bf16_t*)(U + U3_A0),
               *A1 = (const bf16_t*)(U + U3_A1), *Gx = (const bf16_t*)(U + U3_G), *O0 = (const bf16_t*)(U + U3_O0), *O1 = (const bf16_t*)(U + U3_O1);
  bf16_t* Z = (bf16_t*)(ws + OFF_H);
  const int ch0 = lane * 16;
  float ka[16], rk[16], lw[16], lb[16];
#pragma unroll
  for (int j = 0; j < 16; ++j) { ka[j] = gin(p, 29)[ch0 + j]; rk[j] = gin(p, 30)[ch0 + j]; lw[j] = gin(p, 31)[ch0 + j]; lb[j] = gin(p, 32)[ch0 + j]; }
  auto ld16f = [&](const bf16_t* base, size_t off, float (&o)[16]) {
    const u32x4 a = ld16(base + off), b = ld16(base + off + 8);
    o[0] = bflo(a.x); o[1] = bfhi(a.x); o[2] = bflo(a.y); o[3] = bfhi(a.y); o[4] = bflo(a.z); o[5] = bfhi(a.z); o[6] = bflo(a.w); o[7] = bfhi(a.w);
    o[8] = bflo(b.x); o[9] = bfhi(b.x); o[10] = bflo(b.y); o[11] = bfhi(b.y); o[12] = bflo(b.z); o[13] = bfhi(b.z); o[14] = bflo(b.w); o[15] = bfhi(b.w);
  };
  for (int r = obid() * 8 + wid; r < TL; r += gridDim.x * 8) {
    const size_t off = (size_t)r * DM + ch0;
    float o0[16], o1[16], rr[16], kk[16], vv[16], a0[16], a1[16], gg[16];
    ld16f(O0, off, o0); ld16f(O1, off, o1); ld16f(Rx, off, rr); ld16f(Kx, off, kk); ld16f(Vx, off, vv); ld16f(A0, off, a0); ld16f(A1, off, a1); ld16f(Gx, off, gg);
    float s = 0.f, bs = 0.f;
#pragma unroll
    for (int j = 0; j < 16; ++j) {
      o0[j] += o1[j]; s += o0[j];
      const float kd0 = kk[j] * (1.0f + (a0[j] - 1.0f) * ka[j]), kd1 = kk[j] * (1.0f + (a1[j] - 1.0f) * ka[j]);
      bs += rr[j] * (kd0 + kd1) * rk[j];
    }
    s += __shfl_xor(s, 1); s += __shfl_xor(s, 2);
    bs += __shfl_xor(bs, 1); bs += __shfl_xor(bs, 2);
    const float mean = s * (1.0f / 64.0f);
    float q = 0.f;
#pragma unroll
    for (int j = 0; j < 16; ++j) { const float d = o0[j] - mean; q += d * d; }
    q += __shfl_xor(q, 1); q += __shfl_xor(q, 2);
    const float rstd = rsqrtf(q * (1.0f / 64.0f) + 64e-5f);
    float z[16];
#pragma unroll
    for (int j = 0; j < 16; ++j) z[j] = ((o0[j] - mean) * rstd * lw[j] + lb[j] + bs * vv[j]) * gg[j];
    u32x4 w0;
    w0.x = pk4_fp8(z[0] * O8_SCALE, z[1] * O8_SCALE, z[2] * O8_SCALE, z[3] * O8_SCALE); w0.y = pk4_fp8(z[4] * O8_SCALE, z[5] * O8_SCALE, z[6] * O8_SCALE, z[7] * O8_SCALE);
    w0.z = pk4_fp8(z[8] * O8_SCALE, z[9] * O8_SCALE, z[10] * O8_SCALE, z[11] * O8_SCALE); w0.w = pk4_fp8(z[12] * O8_SCALE, z[13] * O8_SCALE, z[14] * O8_SCALE, z[15] * O8_SCALE);
    *(u32x4*)((unsigned char*)Z + off) = w0;
  }
}

#define XB_TMO      128
#define XB_XCNT(j)  (256  + 64 * (j))
#define XB_XSUB(j)  (1280 + 64 * (j))
#define XB_XGEN(j)  (2304 + 64 * (j))
#define XB_TOP      3328
#define XB_TOPGEN   3392
#define XCD_BAR_WORDS 3456
#define XB_SPIN_CAP (1u << 22)
#define LAS __attribute__((address_space(3)))
__device__ __forceinline__ unsigned xb_ld(unsigned* p)              { return __hip_atomic_load(p, __ATOMIC_RELAXED, __HIP_MEMORY_SCOPE_AGENT); }
__device__ __forceinline__ unsigned xb_add(unsigned* p, unsigned v) { return __hip_atomic_fetch_add(p, v, __ATOMIC_RELAXED, __HIP_MEMORY_SCOPE_AGENT); }
__device__ __forceinline__ unsigned xb_xcc_id() { return (unsigned)__builtin_amdgcn_s_getreg((3 << 11) | 20) & 0xFu; }
#define XB_SPIN(cond, bar) do { unsigned _sp = 0; while (cond) { __builtin_amdgcn_s_sleep(1); \
    if ((++_sp & 255u) == 0u) { if (xb_ld(&(bar)[XB_TMO])) break; if (_sp > XB_SPIN_CAP) { atomicAdd(&(bar)[XB_TMO], 1u); break; } } } } while (0)
struct XcdBarrier { unsigned* bar; unsigned x; volatile LAS unsigned* st; };
__device__ __forceinline__ XcdBarrier xcd_barrier_post(unsigned* bar, volatile LAS unsigned* st) {
    XcdBarrier b; b.bar = bar; b.x = xb_xcc_id(); b.st = st;
    if (otid() == 0) (void)xb_add(&bar[XB_XCNT(b.x)], 1u);
    return b;
}
__device__ __forceinline__ void xcd_barrier_complete(unsigned* bar, unsigned x, unsigned& nloc, unsigned& nx) {
    const unsigned G = gridDim.x * gridDim.y * gridDim.z;
    unsigned sum, cnt, mine, sp = 0u;
    for (;;) {
        sum = 0u; cnt = 0u; mine = 0u;
#pragma unroll
        for (unsigned j = 0; j < 16; ++j) { const unsigned c = xb_ld(&bar[XB_XCNT(j)]); sum += c; cnt += (c > 0u) ? 1u : 0u; mine = (j == x) ? c : mine; }
        if (sum == G) break;
        __builtin_amdgcn_s_sleep(1);
        if ((++sp & 255u) == 0u) { if (xb_ld(&bar[XB_TMO])) break; if (sp > XB_SPIN_CAP) { atomicAdd(&bar[XB_TMO], 1u); break; } }
    }
    nloc = mine > 0u ? mine : 1u; nx = cnt > 0u ? cnt : 1u;
}
__device__ __forceinline__ void xcd_barrier(const XcdBarrier& b) {
    asm volatile("s_waitcnt vmcnt(0)" ::: "memory");
    __syncthreads();
    if (otid() == 0) {
        unsigned* bar = b.bar;
        __builtin_amdgcn_s_waitcnt(0);
        unsigned nloc = b.st[0], nx = b.st[1];
        if (nloc == 0u) { xcd_barrier_complete(bar, b.x, nloc, nx); b.st[0] = nloc; b.st[1] = nx; }
        const unsigned old = xb_add(&bar[XB_XSUB(b.x)], 1u);
        const unsigned gen = old / nloc;
        if (old + 1u == (gen + 1u) * nloc) {
            __builtin_amdgcn_fence(__ATOMIC_RELEASE, "agent");
            asm volatile("s_waitcnt vmcnt(0)" ::: "memory");
            const unsigned og = xb_add(&bar[XB_TOP], 1u);
            const unsigned tg = og / nx;
            if (og + 1u == (tg + 1u) * nx) xb_add(&bar[XB_TOPGEN], 1u);
            else XB_SPIN(xb_ld(&bar[XB_TOPGEN]) == tg, bar);
            __builtin_amdgcn_fence(__ATOMIC_ACQUIRE, "agent");
            xb_add(&bar[XB_XGEN(b.x)], 1u);
            asm volatile("s_waitcnt vmcnt(0)" ::: "memory");
        } else {
            XB_SPIN(xb_ld(&bar[XB_XGEN(b.x)]) == gen, bar);
            __builtin_amdgcn_fence(__ATOMIC_ACQUIRE, "agent");
            asm volatile("s_waitcnt vmcnt(0)" ::: "memory");
        }
    }
    __syncthreads();
}

DI void gbar(const XcdBarrier& b0) {
  XcdBarrier b = b0;
  unsigned long long pb = (unsigned long long)b.bar; asm volatile("" : "+s"(pb)); b.bar = (unsigned*)pb;
  unsigned x = b.x; asm volatile("" : "+s"(x)); b.x = x;
  xcd_barrier(b);
}

constexpr int cmaxi(int a, int b) { return a > b ? a : b; }
constexpr int FUSED_LDS = 256 + cmaxi(cmaxi(MOD_LDS, A1_LDS), cmaxi(cmaxi(SC_LDS, R2_LDS), FG_LDS + MOE_UMAX * 1024 + 256));
#ifndef PROBE_GROUP
#define PROBE_GROUP 0
#endif
#define PROBE(g, stmt) do { if constexpr (PROBE_GROUP == (g)) { stmt; gbar(bar); } } while (0)
template <int layer>
DI void run_layer(const XcdBarrier& bar, char* smem) {
  char* U = ows(kparams()) + OFF_U;
  const bf16_t* wm = (const bf16_t*)(ows(kparams()) + OFF_WMIX);
  if constexpr (layer == 0) phase_norm1<0, false, true>(kparams(), layer, smem); else phase_norm1<1, false, layer == 1>(kparams(), layer, smem);
  gbar(bar);
  PROBE(1, (phase_norm1<(layer == 0 ? 0 : 1), true, (layer <= 1)>(kparams(), layer, smem)));
  if constexpr (layer == 0) {
    phase_qkv_win8(kparams(), smem);
    gbar(bar);
    PROBE(3, phase_qkv_win8(kparams(), smem));
    phase_attn_win(kparams(), smem);
    gbar(bar);
    PROBE(4, phase_attn_win(kparams(), smem));
    phase_oproj(kparams(), 0, (const bf16_t*)(U + U0_O), wm + W_WINO, TT, smem);
    gbar(bar);
    PROBE(3, (phase_oproj<true>(kparams(), 0, (const bf16_t*)(U + U0_O), wm + W_WINO, TT, smem)));
  } else if constexpr (layer == 1) {
    phase_qkv_diff8(kparams(), smem);
    gbar(bar);
    PROBE(3, phase_qkv_diff8(kparams(), smem));
    phase_attn_diff(kparams(), smem);
    gbar(bar);
    PROBE(10, phase_attn_diff(kparams(), smem));
    phase_oproj8(kparams(), 1, U + U1_O, (const char*)(wm + W_DIFFO), TT, smem);
    gbar(bar);
    PROBE(3, (phase_oproj8<true>(kparams(), 1, U + U1_O, (const char*)(wm + W_DIFFO), TT, smem)));
  } else if constexpr (layer == 2) {
    phase_pool_pre(kparams(), smem);
    gbar(bar);
    PROBE(6, phase_pool_pre(kparams(), smem));
    phase_pool(kparams(), smem);
    gbar(bar);
    PROBE(6, phase_pool<true>(kparams(), smem));
  } else {
    phase_rwkv_mix(kparams(), smem);
    gbar(bar);
    PROBE(7, phase_rwkv_mix(kparams(), smem));
    phase_rwkv_rkv(kparams(), smem);
    __syncthreads();
    phase_rwkv_feat1(kparams(), smem);
    gbar(bar);
    PROBE(7, phase_rwkv_rkv(kparams(), smem));
    PROBE(8, phase_rwkv_feat1(kparams(), smem));
    phase_rwkv_feat2(kparams(), smem);
    gbar(bar);
    PROBE(8, phase_rwkv_feat2(kparams(), smem));
    phase_rwkv_scan(kparams(), smem);
    gbar(bar);
    PROBE(11, phase_rwkv_scan(kparams(), smem));
    phase_rwkv_out(kparams(), smem);
    gbar(bar);
    PROBE(9, phase_rwkv_out(kparams(), smem));
    phase_oproj8(kparams(), 3, ows(kparams()) + OFF_H, (const char*)(wm + W_RO), TL, smem);
    gbar(bar);
    PROBE(3, (phase_oproj8<true>(kparams(), 3, ows(kparams()) + OFF_H, (const char*)(wm + W_RO), TL, smem)));
  }
  phase_norm2_router(kparams(), layer, smem);
  __syncthreads();
  phase_cvt_moe(kparams(), layer, smem);
  gbar(bar);
  PROBE(2, phase_norm2_router<true>(kparams(), layer, smem));
  PROBE(5, phase_cvt_moe(kparams(), layer, smem));
  phase_moe_up(kparams(), layer, smem);
  gbar(bar);
  phase_moe_down(kparams(), layer, smem);
  gbar(bar);
  PROBE(12, phase_moe_up(kparams(), layer, smem));
  PROBE(12, phase_moe_down(kparams(), layer, smem));
}

__global__ __launch_bounds__(NTH, 2) void k_fused(Params p_unused) {
  extern __shared__ __attribute__((aligned(16))) char smem_all[];
  if (threadIdx.x == 0) *(uint4*)smem_all = make_uint4(0u, 0u, 0u, 0u);
  __syncthreads();
  XcdBarrier bar = xcd_barrier_post((unsigned*)(ows(kparams()) + OFF_BAR), (volatile LAS unsigned*)smem_all);
  char* smem = smem_all + 256;
  phase_cvt_mix(kparams(), smem);
  __syncthreads();
  phase_mod(kparams(), smem);
  gbar(bar);
  PROBE(5, phase_cvt_mix(kparams(), smem));
  PROBE(5, phase_mod(kparams(), smem));
  run_layer<0>(bar, smem);
  run_layer<1>(bar, smem);
  run_layer<2>(bar, smem);
  run_layer<3>(bar, smem);
  phase_norm1<3>(kparams(), 3, smem);
  PROBE(1, (gbar(bar), phase_norm1<3, true>(kparams(), 3, smem)));
}

static void fill_params(Params& p, void* const* d_in, void* d_out, void* d_ws) {
  for (int i = 0; i < 40; ++i) p.in[i] = (const float*)d_in[i];
  p.out = (float*)d_out;
  p.ws = (char*)d_ws;
  bf16_t* wm = (bf16_t*)(p.ws + OFF_WMIX);
  int nj = 0, item = 0;
  auto add = [&](const float* src, size_t dstoff, int K, int N, int ld, int dld = 0, int f8 = 0) {
    p.jobs[nj].src = src; p.jobs[nj].dst = wm + dstoff; p.jobs[nj].K = K; p.jobs[nj].N = N; p.jobs[nj].ld = ld; p.jobs[nj].item0 = item; p.jobs[nj].dld = dld ? dld : K; p.jobs[nj].pad_ = f8;
    item += (K / 64) * (N / 64); ++nj;
  };
  add(p.in[8], W_WINQKV, 1024, 1536, 1536, 0, 1);
  add(p.in[10], W_WINO, 1024, 1024, 1024);
  add(p.in[11], W_DIFFQKV, 1024, 3072, 3072, 0, 1);
  add(p.in[14], W_DIFFO, 1024, 1024, 1024, 0, 1);
  for (int g = 0; g < 4; ++g) add(p.in[15] + (size_t)g * 65536, W_POOL + (size_t)g * 65536, 256, 256, 256);
  add(p.in[19], W_R, 1024, 1024, 1024, 0, 1);
  add(p.in[19] + (size_t)1 * 1024 * 1024, W_K, 1024, 1024, 1024, 0, 1);
  add(p.in[19] + (size_t)2 * 1024 * 1024, W_V, 1024, 1024, 1024, 0, 1);
  for (int d = 0; d < 2; ++d) add(p.in[21] + (size_t)d * 1024 * 64, W_WA1 + (size_t)d * 64 * 1024, 1024, 64, 64);
  for (int d = 0; d < 2; ++d) add(p.in[24] + (size_t)d * 1024 * 64, W_AA1 + (size_t)d * 64 * 1024, 1024, 64, 64);
  add(p.in[26], W_G1, 1024, 128, 128);
  for (int d = 0; d < 2; ++d) add(p.in[22] + (size_t)d * 64 * 1024, W_WA2 + (size_t)d * 1024 * 128 + d * 64, 64, 1024, 1024, 128);
  for (int d = 0; d < 2; ++d) add(p.in[25] + (size_t)d * 64 * 1024, W_AA2 + (size_t)d * 1024 * 128 + d * 64, 64, 1024, 1024, 128);
  add(p.in[27], W_G2, 128, 1024, 1024);
  add(p.in[33], W_RO, 1024, 1024, 1024, 0, 1);
  p.njobs = nj; p.nitems = item;
}

extern "C" void kernel_launch(void* const* d_in, const int* in_sizes, int n_in, void* d_out, int out_size, void* d_ws, size_t ws_size, hipStream_t stream) {
  if (ws_size < WS_NEED || n_in < 40) return;
  Params p{};
  fill_params(p, d_in, d_out, d_ws);
  (void)hipMemsetAsync(p.ws, 0, 32768, stream);
  (void)hipMemsetAsync(p.ws + OFF_H8 + (size_t)TT * DM, 0, 8 * DM, stream);
  static int grid = 0;
  if (!grid) {
    int dev = 0, cus = 0, per_cu = 0;
    (void)hipGetDevice(&dev);
    (void)hipDeviceGetAttribute(&cus, hipDeviceAttributeMultiprocessorCount, dev);
    (void)hipFuncSetAttribute((const void*)k_fused, hipFuncAttributeMaxDynamicSharedMemorySize, FUSED_LDS);
    (void)hipOccupancyMaxActiveBlocksPerMultiprocessor(&per_cu, (const void*)k_fused, NTH, FUSED_LDS);
    grid = cus * (per_cu < 1 ? per_cu : 1);
  }
  if (grid <= 0) return;
  hipLaunchKernelGGL(k_fused, dim3(grid), dim3(NTH), FUSED_LDS, stream, p);
}
```

```cpp
#include <hip/hip_runtime.h>
#include <stdint.h>
#include <stddef.h>

typedef unsigned short bf16_t;
typedef short bf16x8 __attribute__((ext_vector_type(8)));
typedef short s16x4 __attribute__((ext_vector_type(4)));
typedef float f32x4 __attribute__((ext_vector_type(4)));
typedef float f32x16 __attribute__((ext_vector_type(16)));
typedef unsigned u32x4 __attribute__((ext_vector_type(4)));
typedef unsigned u32x2 __attribute__((ext_vector_type(2)));
typedef float f32x2 __attribute__((ext_vector_type(2)));
#define DI __device__ __forceinline__

constexpr int DM = 1024, NBATCH = 16, SEQ = 4096, CTX = 256;
constexpr int TL = NBATCH * SEQ, TC = NBATCH * CTX, TT = TL + TC;
constexpr int NTH = 512;
constexpr int MOE_PAD = 256;
constexpr int MOE_ROWS = 2 * TT + 32 * MOE_PAD;
constexpr int CAP = TT;

constexpr size_t al256(size_t x) { return (x + 255) & ~(size_t)255; }
constexpr size_t OFF_BAR = 0;
constexpr size_t OFF_CNT = 16384;
constexpr size_t OFF_MOD = 32768;
constexpr size_t OFF_ROPE = al256(OFF_MOD + (size_t)4 * 17 * 6144 * 4);
constexpr size_t OFF_XB = al256(OFF_ROPE + 2 * 64 * 16 * 4);
constexpr size_t OFF_H = al256(OFF_XB + (size_t)TT * DM * 2);
constexpr size_t OFF_H8 = al256(OFF_H + (size_t)(TT + 8) * DM * 2);
constexpr size_t OFF_TOK = al256(OFF_H8 + (size_t)(TT + 8) * DM);
constexpr size_t OFF_ROWL = al256(OFF_TOK + (size_t)TT * 32);
constexpr size_t OFF_WMIX = al256(OFF_ROWL + (size_t)32 * CAP * 4);
constexpr size_t W_WINQKV = 0;
constexpr size_t W_WINO = W_WINQKV + (size_t)1536 * 1024;
constexpr size_t W_DIFFQKV = W_WINO + (size_t)1024 * 1024;
constexpr size_t W_DIFFO = W_DIFFQKV + (size_t)3072 * 1024;
constexpr size_t W_POOL = W_DIFFO + (size_t)1024 * 1024;
constexpr size_t W_R = W_POOL + (size_t)4 * 256 * 256;
constexpr size_t W_K = W_R + (size_t)1024 * 1024;
constexpr size_t W_V = W_K + (size_t)1024 * 1024;
constexpr size_t W_WA1 = W_V + (size_t)1024 * 1024;
constexpr size_t W_AA1 = W_WA1 + (size_t)128 * 1024;
constexpr size_t W_G1 = W_AA1 + (size_t)128 * 1024;
constexpr size_t W_WA2 = W_G1 + (size_t)128 * 1024;
constexpr size_t W_AA2 = W_WA2 + (size_t)2048 * 128;
constexpr size_t W_G2 = W_AA2 + (size_t)2048 * 128;
constexpr size_t W_RO = W_G2 + (size_t)1024 * 128;
constexpr size_t W_MIX_END = W_RO + (size_t)1024 * 1024;
constexpr size_t OFF_WR = al256(OFF_WMIX + W_MIX_END * 2);
constexpr size_t OFF_WMOE = al256(OFF_WR + (size_t)4 * 2 * 48 * 1024 * 2);
constexpr size_t WMOE_DOWN = (size_t)32 * 1024 * 1024;
constexpr size_t OFF_U = al256(OFF_WMOE + ((size_t)32 * 1024 * 1024 + (size_t)32 * 1024 * 512) * 2);
constexpr size_t SZ_TT = (size_t)TT * DM * 2, SZ_TL = (size_t)TL * DM * 2;
constexpr size_t U0_Q = 0, U0_K = U0_Q + SZ_TT, U0_V = U0_K + (size_t)TT * 256 * 2, U0_O = U0_V + (size_t)TT * 256 * 2, U0_END = U0_O + SZ_TT;
constexpr size_t U1_Q = 0, U1_K = U1_Q + SZ_TT, U1_V = U1_K + SZ_TT, U1_O = U1_V + SZ_TT, U1_END = U1_O + SZ_TT;
constexpr size_t U2_Y = 0, U2_END = SZ_TT;
constexpr size_t U3_R = 0, U3_K = U3_R + SZ_TL, U3_V = U3_K + SZ_TT, U3_A0 = U3_V + SZ_TT, U3_A1 = U3_A0 + SZ_TT, U3_LD0 = U3_A1 + SZ_TT,
                 U3_LD1 = U3_LD0 + SZ_TT, U3_LW = U3_LD1 + SZ_TT, U3_LA = U3_LW + (size_t)TT * 128 * 2, U3_LG = U3_LA + (size_t)TT * 128 * 2,
                 U3_G = U3_LG + (size_t)TL * 128 * 2, U3_O0 = U3_G + SZ_TL, U3_O1 = U3_O0 + SZ_TL, U3_END = U3_O1 + SZ_TL;
constexpr size_t U3_XR = U3_A0, U3_XK = U3_A1, U3_XV = U3_LD0;
constexpr size_t UM_ACT = 0, UM_YB = UM_ACT + (size_t)MOE_ROWS * 512 * 2, UM_END = UM_YB + (size_t)MOE_ROWS * 1024 * 2;
constexpr size_t cmax(size_t a, size_t b) { return a > b ? a : b; }
constexpr size_t U_SIZE = cmax(cmax(cmax(U0_END, U1_END), U2_END), cmax(U3_END, UM_END));
constexpr size_t WS_NEED = OFF_U + U_SIZE;

struct CvtJob { const float* src; bf16_t* dst; int K, N, ld, item0, dld, pad_; };
constexpr int NJOBS = 24;
struct Params {
  const float* in[40];
  float* out;
  char* ws;
  CvtJob jobs[NJOBS];
  int njobs, nitems;
};

typedef const __attribute__((address_space(4))) Params* KP;
DI KP kparams() { KP q = (KP)__builtin_amdgcn_kernarg_segment_ptr(); asm volatile("" : "+s"(q)); return q; }
DI char* ows(KP p) {
  const unsigned long long w = (unsigned long long)p->ws;
  unsigned lo = (unsigned)w, hi = (unsigned)(w >> 32);
  asm volatile("" : "+v"(lo), "+v"(hi));
  lo = __builtin_amdgcn_readfirstlane(lo); hi = __builtin_amdgcn_readfirstlane(hi);
  return (char*)(__attribute__((address_space(1))) char*)(((unsigned long long)hi << 32) | lo);
}
DI const float* gin(KP p, int i) { return (const float*)(__attribute__((address_space(1))) const float*)p->in[i]; }
DI float* gout(KP p) { return (float*)(__attribute__((address_space(1))) float*)p->out; }
DI int otid() { int t = threadIdx.x; asm volatile("" : "+v"(t)); return t; }
DI int obid() { int b = blockIdx.x; asm volatile("" : "+s"(b)); return b; }
DI unsigned pk2(float lo, float hi) {
  typedef __bf16 bf2 __attribute__((ext_vector_type(2)));
  typedef float f2 __attribute__((ext_vector_type(2)));
  f2 v = {lo, hi};
  return __builtin_bit_cast(unsigned, __builtin_convertvector(v, bf2));
}
DI float clamp8(float x) { return __builtin_amdgcn_fmed3f(x, -440.0f, 440.0f); }
DI void swap32(float x, float& a, float& b) {
  a = x; b = x;
  asm volatile("s_nop 1\n\tv_permlane32_swap_b32 %0, %1\n\ts_nop 1" : "+v"(a), "+v"(b));
}
DI unsigned pk4_fp8_nc(float a, float b, float c, float d) { int w; asm("" : "=v"(w)); w = __builtin_amdgcn_cvt_pk_fp8_f32(a, b, w, false); w = __builtin_amdgcn_cvt_pk_fp8_f32(c, d, w, true); return (unsigned)w; }
DI unsigned pk4_fp8(float a, float b, float c, float d) { int w = __builtin_amdgcn_cvt_pk_fp8_f32(clamp8(a), clamp8(b), 0, false); w = __builtin_amdgcn_cvt_pk_fp8_f32(clamp8(c), clamp8(d), w, true); return (unsigned)w; }
DI bf16_t f2bf(float x) { return (bf16_t)(pk2(x, 0.f) & 0xffffu); }
DI float bf2f(bf16_t b) { return __uint_as_float(((unsigned)b) << 16); }
DI float bflo(unsigned u) { return __uint_as_float(u << 16); }
DI float bfhi(unsigned u) { return __uint_as_float(u & 0xffff0000u); }
DI float wave_sum(float v) {
#pragma unroll
  for (int o = 32; o >= 1; o >>= 1) v += __shfl_xor(v, o);
  return v;
}
DI float sigmoidf_(float x) { return __builtin_amdgcn_rcpf(1.0f + __expf(-x)); }
DI int row_bi(int r) { return r < TL ? (r >> 12) : 16; }
DI bf16_t* xrow_ptr(KP p, char* ws, int r) { return (bf16_t*)(ws + OFF_XB) + (size_t)r * DM; }
DI f32x4 ldbf4(const bf16_t* q) { const u32x2 w = *(const u32x2*)q; return (f32x4){bflo(w.x), bfhi(w.x), bflo(w.y), bfhi(w.y)}; }
DI void stbf4(bf16_t* q, const f32x4& v) { u32x2 w; w.x = pk2(v[0], v[1]); w.y = pk2(v[2], v[3]); *(u32x2*)q = w; }
DI const float* modp(char* ws, int layer, int bi, int which) { return (const float*)(ws + OFF_MOD) + ((size_t)(layer * 17 + bi) * 6 + which) * DM; }
#define MFMA16(a, b, c) __builtin_amdgcn_mfma_f32_16x16x32_bf16((a), (b), (c), 0, 0, 0)
#define MFMA32(a, b, c) __builtin_amdgcn_mfma_f32_32x32x16_bf16((a), (b), (c), 0, 0, 0)

constexpr int SGLD = 72;
constexpr int SG_LDS = 2 * 128 * SGLD * 2;
template <class AL, class BL, class EP>
DI void sgemm_tile(char* smem, int K, AL la, BL lb, EP ep) {
  bf16_t* sA = (bf16_t*)smem;
  bf16_t* sB = sA + 128 * SGLD;
  const int tid = otid(), lane = tid & 63, wid = tid >> 6, wr = wid >> 2, wc = wid & 3, fr = lane & 15, fq = lane >> 4;
  f32x4 acc[4][2];
#pragma unroll
  for (int m = 0; m < 4; ++m)
#pragma unroll
    for (int n = 0; n < 2; ++n) acc[m][n] = (f32x4){0.f, 0.f, 0.f, 0.f};
  const int r_ = tid >> 3, k_ = (tid & 7) * 8;
  u32x4 ra0 = la(r_, k_), ra1 = la(r_ + 64, k_), rb0 = lb(r_, k_), rb1 = lb(r_ + 64, k_);
  const int nk = K >> 6;
  for (int kt = 0; kt < nk; ++kt) {
    __syncthreads();
    *(u32x4*)(sA + r_ * SGLD + k_) = ra0;
    *(u32x4*)(sA + (r_ + 64) * SGLD + k_) = ra1;
    *(u32x4*)(sB + r_ * SGLD + k_) = rb0;
    *(u32x4*)(sB + (r_ + 64) * SGLD + k_) = rb1;
    __syncthreads();
    if (kt + 1 < nk) {
      const int kk = (kt + 1) * 64 + k_;
      ra0 = la(r_, kk); ra1 = la(r_ + 64, kk); rb0 = lb(r_, kk); rb1 = lb(r_ + 64, kk);
    }
#pragma unroll
    for (int ks = 0; ks < 2; ++ks) {
      bf16x8 af[4], bq[2];
#pragma unroll
      for (int m = 0; m < 4; ++m) af[m] = *(const bf16x8*)(sA + (wr * 64 + m * 16 + fr) * SGLD + ks * 32 + fq * 8);
#pragma unroll
      for (int n = 0; n < 2; ++n) bq[n] = *(const bf16x8*)(sB + (wc * 32 + n * 16 + fr) * SGLD + ks * 32 + fq * 8);
#pragma unroll
      for (int m = 0; m < 4; ++m)
#pragma unroll
        for (int n = 0; n < 2; ++n) acc[m][n] = MFMA16(af[m], bq[n], acc[m][n]);
    }
  }
  ep(acc, wr * 64, wc * 32, fr, fq);
}
DI u32x4 ld16(const bf16_t* p) { return *(const u32x4*)p; }

#define LAS __attribute__((address_space(3)))
namespace fg {
typedef int v8i_t __attribute__((ext_vector_type(8)));
typedef int v4i_t __attribute__((ext_vector_type(4)));
constexpr int BM = 256, BK = 64, HALF = 128, HTB = HALF * BK * 2, STAGE_BYTES = 8 * HTB, NXCD = 8, WGM = 8;
DI int lds_byte(int r, int c) { const int st = (r >> 4) * 2 + (c >> 5), rr = r & 15, cc = c & 31, ob = rr * 64 + cc * 2; return st * 1024 + (ob ^ (((ob >> 9) & 1) << 5)); }
DI void stage_rc(int b, int& R, int& C) { const int st = b / 1024, sb = b % 1024, swz = sb ^ (((sb >> 9) & 1) << 5); R = (st >> 1) * 16 + swz / 64; C = (st & 1) * 32 + (swz % 64) / 2; }
struct Unit { const char* A; const char* B; int pm, pn, aux; };
DI bool static_order(int i, int G, int c, int nM, int nN, int& pm, int& pn) {
  const int nwg = nM * nN;
  const long L = (long)i * G + c; if (L >= nwg) return false;
  int wgid = (int)L; { const int q = nwg / NXCD, r = nwg % NXCD, xcd = wgid % NXCD, off = wgid / NXCD; wgid = (xcd < r ? xcd * (q + 1) : r * (q + 1) + (xcd - r) * q) + off; }
  const int nig = WGM * nN, gid = wgid / nig, fm = gid * WGM, gsz = (nM - fm) < WGM ? (nM - fm) : WGM;
  pm = fm + ((wgid % nig) % gsz); pn = (wgid % nig) / gsz; return true;
}
struct DenseSched {
  const char* A; const char* B; int nM, nN, G, c; size_t tA, tB;
  DI bool next(int i, Unit& u) const { int pm, pn; if (!static_order(i, G, c, nM, nN, pm, pn)) return false; u.pm = pm; u.pn = pn; u.aux = 0; u.A = A + (size_t)pm * tA; u.B = B + (size_t)pn * tB; return true; }
  DI const LAS int* rows(int) const { return nullptr; }
};

DI int perm32(int rho) { const int n = rho >> 4, i = rho & 15; return 8 * (i >> 2) + 4 * n + (i & 3); }
template <bool GATHER, bool PERM = false, class Epi, class Sched>
DI void gemm_phase(LAS unsigned char* lds, const int K, const int lda, const int ldb, const Sched& S, const Epi& E) {
  const int tid = otid(), wid = __builtin_amdgcn_readfirstlane(tid >> 6), lane = tid & 63, wr = wid >> 2, wc = wid & 3, fr = lane & 15, fq = lane >> 4;
  const int nt = K / BK;
  unsigned voffA[2], voffB[2]; int sR[2], sC[2];
#pragma unroll
  for (int i = 0; i < 2; ++i) { int R, C; stage_rc(tid * 16 + i * 8192, R, C); sR[i] = R; sC[i] = C; voffA[i] = (unsigned)(R * lda + C) * 2u; const int Rb = PERM ? ((R & ~31) + perm32(R & 31)) : R; voffB[i] = (unsigned)(Rb * ldb + C) * 2u; }
  const size_t kstep = (size_t)(BK * 2), hstepA = (size_t)HALF * lda * 2, hstepB = (size_t)HALF * ldb * 2;
  const unsigned ldsw = (unsigned)wid * 1024u;
  const int aoff = lds_byte(wr * 64 + fr, fq * 8), boff = lds_byte(wc * 32 + fr, fq * 8);
#define FG_SA(b, h) (((b) * 2 + (h)) * HTB)
#define FG_SB(b, h) ((4 + (b) * 2 + (h)) * HTB)
#define FG_GLDS(gp, bufoff, i_) __builtin_amdgcn_global_load_lds((const unsigned*)(gp), (LAS unsigned*)(lds + (bufoff) + ldsw + (i_) * 8192), 16, 0, 0)
#define FG_STAGE_B(bufoff, gbase) do { const char* _gb = (gbase); FG_GLDS(_gb + voffB[0], bufoff, 0); FG_GLDS(_gb + voffB[1], bufoff, 1); } while (0)
#define FG_STAGE_A(bufoff, NX, H, KB) do { \
    if constexpr (GATHER) { const char* _gb = ((NX) ? nA : cA) + (KB); FG_GLDS(_gb + ((NX) ? gn[H][0] : gc[H][0]), bufoff, 0); FG_GLDS(_gb + ((NX) ? gn[H][1] : gc[H][1]), bufoff, 1); } \
    else { const char* _gb = ((NX) ? nA : cA) + (size_t)(H) * hstepA + (KB); FG_GLDS(_gb + voffA[0], bufoff, 0); FG_GLDS(_gb + voffA[1], bufoff, 1); } } while (0)
#define FG_LDA(dst, b, h) do { _Pragma("unroll") for (int m = 0; m < 4; ++m) _Pragma("unroll") for (int k = 0; k < 2; ++k) dst[m][k] = *(const LAS bf16x8*)(lds + FG_SA(b, h) + aoff + m * 2048 + k * 1024); } while (0)
#define FG_LDB(dst, b, h) do { _Pragma("unroll") for (int n = 0; n < 2; ++n) _Pragma("unroll") for (int k = 0; k < 2; ++k) dst[n][k] = *(const LAS bf16x8*)(lds + FG_SB(b, h) + boff + n * 2048 + k * 1024); } while (0)
#define FG_MMA(ai, bj, At, Bt) do { __builtin_amdgcn_s_setprio(1); _Pragma("unroll") for (int m = 0; m < 4; ++m) _Pragma("unroll") for (int n = 0; n < 2; ++n) _Pragma("unroll") for (int k = 0; k < 2; ++k) \
    acc[ai][bj][m][n] = __builtin_amdgcn_mfma_f32_16x16x32_bf16(Bt[n][k], At[m][k], acc[ai][bj][m][n], 0, 0, 0); __builtin_amdgcn_s_setprio(0); } while (0)
#define FG_WAIT_V(n) asm volatile("s_waitcnt vmcnt(" #n ")" ::: "memory")
#define FG_WAIT_L(n) asm volatile("s_waitcnt lgkmcnt(" #n ")" ::: "memory")
#define FG_BAR __builtin_amdgcn_s_barrier()
#define FG_SCHED __builtin_amdgcn_sched_barrier(0)
  Unit cur, nxt; int ui = 0;
  if (!S.next(0, cur)) return;
  f32x4 acc[2][2][4][2];
#pragma unroll
  for (int a = 0; a < 2; ++a)
#pragma unroll
    for (int b = 0; b < 2; ++b)
#pragma unroll
      for (int m = 0; m < 4; ++m)
#pragma unroll
        for (int n = 0; n < 2; ++n) acc[a][b][m][n] = (f32x4){0.f, 0.f, 0.f, 0.f};
  bf16x8 At[4][2], B0[2][2], B1[2][2];
  const char* cA = cur.A; const char* cB = cur.B;
  const char* nA = cA; const char* nB = cB;
  unsigned gc[2][2] = {{0u, 0u}, {0u, 0u}}, gn[2][2] = {{0u, 0u}, {0u, 0u}};
  if constexpr (GATHER) {
    const LAS int* rw = S.rows(0);
#pragma unroll
    for (int h = 0; h < 2; ++h)
#pragma unroll
      for (int i = 0; i < 2; ++i) { gc[h][i] = (unsigned)(rw[h * HALF + sR[i]] * lda + sC[i]) * 2u; gn[h][i] = gc[h][i]; }
  }
  FG_STAGE_B(FG_SB(0, 0), cB); FG_STAGE_B(FG_SB(0, 1), cB + hstepB); FG_STAGE_A(FG_SA(0, 0), false, 0, 0); FG_STAGE_A(FG_SA(0, 1), false, 1, 0);
  if (wr == 1) FG_BAR;
  FG_WAIT_V(2); FG_BAR;
  FG_STAGE_B(FG_SB(1, 0), cB + kstep); FG_STAGE_A(FG_SA(1, 0), false, 0, kstep); FG_STAGE_B(FG_SB(1, 1), cB + hstepB + kstep);
  FG_WAIT_V(6); FG_BAR;
  for (;;) {
    const bool has_next = S.next(ui + 1, nxt);
    nA = has_next ? nxt.A : cA; nB = has_next ? nxt.B : cB;
    if constexpr (GATHER) {
      if (has_next) {
        const LAS int* rw = S.rows(ui + 1);
#pragma unroll
        for (int h = 0; h < 2; ++h)
#pragma unroll
          for (int i = 0; i < 2; ++i) gn[h][i] = (unsigned)(rw[h * HALF + sR[i]] * lda + sC[i]) * 2u;
      } else {
#pragma unroll
        for (int h = 0; h < 2; ++h)
#pragma unroll
          for (int i = 0; i < 2; ++i) gn[h][i] = gc[h][i];
      }
      FG_WAIT_L(0);
    }
    for (int t = 0; t < nt; t += 2) {
      const bool last = (t == nt - 2);
      const size_t k1 = (size_t)(t + 1) * kstep;
      const size_t k2 = last ? 0 : (size_t)(t + 2) * kstep, k3 = k2 + kstep;
      const char* b2 = last ? nB : cB + (size_t)(t + 2) * kstep; const char* b3 = b2 + kstep;
      FG_LDB(B0, 0, 0); FG_LDB(B1, 0, 1); FG_SCHED; FG_LDA(At, 0, 0); FG_STAGE_A(FG_SA(1, 1), false, 1, k1);
      FG_WAIT_V(8); FG_WAIT_L(0); FG_BAR; FG_MMA(0, 0, At, B0); FG_MMA(0, 1, At, B1); FG_BAR; FG_SCHED;
      FG_LDA(At, 0, 1); FG_STAGE_B(FG_SB(0, 0), b2); FG_STAGE_B(FG_SB(0, 1), b2 + hstepB); FG_STAGE_A(FG_SA(0, 0), last, 0, k2);
      FG_WAIT_V(8); FG_WAIT_L(0); FG_BAR; FG_MMA(1, 0, At, B0); FG_MMA(1, 1, At, B1); FG_BAR; FG_SCHED;
      FG_LDB(B0, 1, 0); FG_LDB(B1, 1, 1); FG_SCHED; FG_LDA(At, 1, 0); FG_STAGE_A(FG_SA(0, 1), last, 1, k2);
      FG_WAIT_V(8); FG_WAIT_L(0); FG_BAR; FG_MMA(0, 0, At, B0); FG_MMA(0, 1, At, B1); FG_BAR; FG_SCHED;
      FG_LDA(At, 1, 1); FG_STAGE_B(FG_SB(1, 0), b3); FG_STAGE_B(FG_SB(1, 1), b3 + hstepB); FG_STAGE_A(FG_SA(1, 0), last, 0, k3);
      FG_WAIT_V(8); FG_WAIT_L(0); FG_BAR; FG_MMA(1, 0, At, B0); FG_MMA(1, 1, At, B1); FG_BAR; FG_SCHED;
    }
    if (wr == 0) FG_BAR;
    E(acc, cur, wr, wc, fr, fq);
    if (!has_next) break;
#pragma unroll
    for (int a = 0; a < 2; ++a)
#pragma unroll
      for (int b = 0; b < 2; ++b)
#pragma unroll
        for (int m = 0; m < 4; ++m)
#pragma unroll
          for (int n = 0; n < 2; ++n) acc[a][b][m][n] = (f32x4){0.f, 0.f, 0.f, 0.f};
    cur = nxt; cA = nA; cB = nB; ++ui;
    if constexpr (GATHER) {
#pragma unroll
      for (int h = 0; h < 2; ++h)
#pragma unroll
        for (int i = 0; i < 2; ++i) gc[h][i] = gn[h][i];
    }
    if (wr == 1) FG_BAR;
  }
  FG_WAIT_V(0);
  FG_BAR;
#undef FG_SA
#undef FG_SB
#undef FG_GLDS
#undef FG_STAGE_A
#undef FG_STAGE_B
#undef FG_LDA
#undef FG_LDB
#undef FG_MMA
#undef FG_WAIT_V
#undef FG_WAIT_L
#undef FG_BAR
#undef FG_SCHED
}
DI int perm32f8(int s_) { return 16 * ((s_ >> 2) & 1) + (s_ & 3) + 4 * (s_ >> 3); }
template <bool GATHER, bool PERM = false, class Epi, class Sched>
DI void gemm_phase_f8(LAS unsigned char* lds, const int K, const int lda, const int ldb, const Sched& S, const Epi& E) {
  const int tid = otid(), wid = __builtin_amdgcn_readfirstlane(tid >> 6), lane = tid & 63, wr = wid >> 2, wc = wid & 3, fr = lane & 15, fq = lane >> 4;
  const int nt = K / BK;
  unsigned voffA[2], voffB[2]; int sR[2], sC[2];
#pragma unroll
  for (int i = 0; i < 2; ++i) { int R, C; stage_rc(tid * 16 + i * 8192, R, C); sR[i] = R; sC[i] = C; voffA[i] = (unsigned)(R * lda + C) * 2u; const int Rb = PERM ? ((R & ~31) + perm32f8(R & 31)) : R; voffB[i] = (unsigned)(Rb * ldb + C) * 2u; }
  const size_t kstep = (size_t)(BK * 2), hstepA = (size_t)HALF * lda * 2, hstepB = (size_t)HALF * ldb * 2;
  const unsigned ldsw = (unsigned)wid * 1024u;
  const int r32 = lane & 31, g32 = lane >> 5;
  const int aoff = lds_byte(wr * 64 + r32, 16 * g32), boff = lds_byte(wc * 32 + r32, 16 * g32);
#define FG_SA(b, h) (((b) * 2 + (h)) * HTB)
#define FG_SB(b, h) ((4 + (b) * 2 + (h)) * HTB)
#define FG_GLDS(gp, bufoff, i_) __builtin_amdgcn_global_load_lds((const unsigned*)(gp), (LAS unsigned*)(lds + (bufoff) + ldsw + (i_) * 8192), 16, 0, 0)
#define FG_STAGE_B(bufoff, gbase) do { const char* _gb = (gbase); FG_GLDS(_gb + voffB[0], bufoff, 0); FG_GLDS(_gb + voffB[1], bufoff, 1); } while (0)
#define FG_STAGE_A(bufoff, NX, H, KB) do { \
    if constexpr (GATHER) { const char* _gb = ((NX) ? nA : cA) + (KB); FG_GLDS(_gb + ((NX) ? gn[H][0] : gc[H][0]), bufoff, 0); FG_GLDS(_gb + ((NX) ? gn[H][1] : gc[H][1]), bufoff, 1); } \
    else { const char* _gb = ((NX) ? nA : cA) + (size_t)(H) * hstepA + (KB); FG_GLDS(_gb + voffA[0], bufoff, 0); FG_GLDS(_gb + voffA[1], bufoff, 1); } } while (0)
#define FG_LDA(dst, b, h) do { _Pragma("unroll") for (int m = 0; m < 2; ++m) _Pragma("unroll") for (int k = 0; k < 2; ++k) { const LAS v4i_t* q_ = (const LAS v4i_t*)(lds + FG_SA(b, h) + aoff + m * 4096 + k * 1024); dst[m][k] = __builtin_shufflevector(q_[0], q_[1], 0, 1, 2, 3, 4, 5, 6, 7); } } while (0)
#define FG_LDB(dst, b, h) do { _Pragma("unroll") for (int k = 0; k < 2; ++k) { const LAS v4i_t* q_ = (const LAS v4i_t*)(lds + FG_SB(b, h) + boff + k * 1024); dst[k] = __builtin_shufflevector(q_[0], q_[1], 0, 1, 2, 3, 4, 5, 6, 7); } } while (0)
#define FG_MMA(ai, bj, At, Bt) do { __builtin_amdgcn_s_setprio(1); _Pragma("unroll") for (int m = 0; m < 2; ++m) _Pragma("unroll") for (int k = 0; k < 2; ++k) \
    acc[ai][bj][m] = __builtin_amdgcn_mfma_scale_f32_32x32x64_f8f6f4(Bt[k], At[m][k], acc[ai][bj][m], 0, 0, 0, 0x7f7f7f7f, 0, 0x7f7f7f7f); __builtin_amdgcn_s_setprio(0); } while (0)
#define FG_WAIT_V(n) asm volatile("s_waitcnt vmcnt(" #n ")" ::: "memory")
#define FG_WAIT_L(n) asm volatile("s_waitcnt lgkmcnt(" #n ")" ::: "memory")
#define FG_BAR __builtin_amdgcn_s_barrier()
#define FG_SCHED __builtin_amdgcn_sched_barrier(0)
  Unit cur, nxt; int ui = 0;
  if (!S.next(0, cur)) return;
  f32x16 acc[2][2][2];
#pragma unroll
  for (int a = 0; a < 2; ++a)
#pragma unroll
    for (int b = 0; b < 2; ++b)
#pragma unroll
      for (int m = 0; m < 2; ++m)
#pragma unroll
        for (int n = 0; n < 16; ++n) acc[a][b][m][n] = 0.f;
  v8i_t At[2][2], B0[2], B1[2];
  const char* cA = cur.A; const char* cB = cur.B;
  const char* nA = cA; const char* nB = cB;
  unsigned gc[2][2] = {{0u, 0u}, {0u, 0u}}, gn[2][2] = {{0u, 0u}, {0u, 0u}};
  if constexpr (GATHER) {
    const LAS int* rw = S.rows(0);
#pragma unroll
    for (int h = 0; h < 2; ++h)
#pragma unroll
      for (int i = 0; i < 2; ++i) { gc[h][i] = (unsigned)(rw[h * HALF + sR[i]] * lda + sC[i]) * 2u; gn[h][i] = gc[h][i]; }
  }
  FG_STAGE_B(FG_SB(0, 0), cB); FG_STAGE_B(FG_SB(0, 1), cB + hstepB); FG_STAGE_A(FG_SA(0, 0), false, 0, 0); FG_STAGE_A(FG_SA(0, 1), false, 1, 0);
  if (wr == 1) FG_BAR;
  FG_WAIT_V(2); FG_BAR;
  FG_STAGE_B(FG_SB(1, 0), cB + kstep); FG_STAGE_A(FG_SA(1, 0), false, 0, kstep); FG_STAGE_B(FG_SB(1, 1), cB + hstepB + kstep);
  FG_WAIT_V(6); FG_BAR;
  for (;;) {
    const bool has_next = S.next(ui + 1, nxt);
    nA = has_next ? nxt.A : cA; nB = has_next ? nxt.B : cB;
    if constexpr (GATHER) {
      if (has_next) {
        const LAS int* rw = S.rows(ui + 1);
#pragma unroll
        for (int h = 0; h < 2; ++h)
#pragma unroll
          for (int i = 0; i < 2; ++i) gn[h][i] = (unsigned)(rw[h * HALF + sR[i]] * lda + sC[i]) * 2u;
      } else {
#pragma unroll
        for (int h = 0; h < 2; ++h)
#pragma unroll
          for (int i = 0; i < 2; ++i) gn[h][i] = gc[h][i];
      }
      FG_WAIT_L(0);
    }
#pragma nounroll
    for (int t = 0; t < nt; t += 2) {
      const bool last = (t == nt - 2);
      const size_t k1 = (size_t)(t + 1) * kstep;
      const size_t k2 = last ? 0 : (size_t)(t + 2) * kstep, k3 = k2 + kstep;
      const char* b2 = last ? nB : cB + (size_t)(t + 2) * kstep; const char* b3 = b2 + kstep;
      FG_LDB(B0, 0, 0); FG_LDB(B1, 0, 1); FG_SCHED; FG_LDA(At, 0, 0); FG_STAGE_A(FG_SA(1, 1), false, 1, k1);
      FG_WAIT_V(8); FG_WAIT_L(0); FG_BAR; FG_MMA(0, 0, At, B0); FG_MMA(0, 1, At, B1); FG_BAR; FG_SCHED;
      FG_LDA(At, 0, 1); FG_STAGE_B(FG_SB(0, 0), b2); FG_STAGE_B(FG_SB(0, 1), b2 + hstepB); FG_STAGE_A(FG_SA(0, 0), last, 0, k2);
      FG_WAIT_V(8); FG_WAIT_L(0); FG_BAR; FG_MMA(1, 0, At, B0); FG_MMA(1, 1, At, B1); FG_BAR; FG_SCHED;
      FG_LDB(B0, 1, 0); FG_LDB(B1, 1, 1); FG_SCHED; FG_LDA(At, 1, 0); FG_STAGE_A(FG_SA(0, 1), last, 1, k2);
      FG_WAIT_V(8); FG_WAIT_L(0); FG_BAR; FG_MMA(0, 0, At, B0); FG_MMA(0, 1, At, B1); FG_BAR; FG_SCHED;
      FG_LDA(At, 1, 1); FG_STAGE_B(FG_SB(1, 0), b3); FG_STAGE_B(FG_SB(1, 1), b3 + hstepB); FG_STAGE_A(FG_SA(1, 0), last, 0, k3);
      FG_WAIT_V(8); FG_WAIT_L(0); FG_BAR; FG_MMA(1, 0, At, B0); FG_MMA(1, 1, At, B1); FG_BAR; FG_SCHED;
    }
    if (wr == 0) FG_BAR;
    E(acc, cur, wr, wc, r32, g32);
    if (!has_next) break;
#pragma unroll
    for (int a = 0; a < 2; ++a)
#pragma unroll
      for (int b = 0; b < 2; ++b)
#pragma unroll
        for (int m = 0; m < 2; ++m)
#pragma unroll
          for (int n = 0; n < 16; ++n) acc[a][b][m][n] = 0.f;
    cur = nxt; cA = nA; cB = nB; ++ui;
    if constexpr (GATHER) {
#pragma unroll
      for (int h = 0; h < 2; ++h)
#pragma unroll
        for (int i = 0; i < 2; ++i) gc[h][i] = gn[h][i];
    }
    if (wr == 1) FG_BAR;
  }
  FG_WAIT_V(0);
  FG_BAR;
#undef FG_SA
#undef FG_SB
#undef FG_GLDS
#undef FG_STAGE_A
#undef FG_STAGE_B
#undef FG_LDA
#undef FG_LDB
#undef FG_MMA
#undef FG_WAIT_V
#undef FG_WAIT_L
#undef FG_BAR
#undef FG_SCHED
}
}

DI void cvt_tile(char* smem, const float* src, int ld, bf16_t* dst, int K, int N, int item, int dld, int f8) {
  float* tile = (float*)smem;
  const int ntn = N >> 6, kt = item / ntn, nt = item % ntn, k0 = kt * 64, n0 = nt * 64, tid = otid();
  __syncthreads();
#pragma unroll
  for (int i = 0; i < 8; ++i) { const int idx = tid + i * NTH, r = idx >> 6, c = idx & 63; tile[r * 65 + c] = src[(size_t)(k0 + r) * ld + n0 + c]; }
  __syncthreads();
  const int n = tid >> 3, k8 = (tid & 7) * 8;
  if (f8) {
    u32x2 o8;
    o8.x = pk4_fp8(tile[(k8 + 0) * 65 + n] * 32.f, tile[(k8 + 1) * 65 + n] * 32.f, tile[(k8 + 2) * 65 + n] * 32.f, tile[(k8 + 3) * 65 + n] * 32.f);
    o8.y = pk4_fp8(tile[(k8 + 4) * 65 + n] * 32.f, tile[(k8 + 5) * 65 + n] * 32.f, tile[(k8 + 6) * 65 + n] * 32.f, tile[(k8 + 7) * 65 + n] * 32.f);
    *(u32x2*)((unsigned char*)dst + (size_t)(n0 + n) * dld + k0 + k8) = o8;
    return;
  }
  u32x4 o;
  o.x = pk2(tile[(k8 + 0) * 65 + n], tile[(k8 + 1) * 65 + n]);
  o.y = pk2(tile[(k8 + 2) * 65 + n], tile[(k8 + 3) * 65 + n]);
  o.z = pk2(tile[(k8 + 4) * 65 + n], tile[(k8 + 5) * 65 + n]);
  o.w = pk2(tile[(k8 + 6) * 65 + n], tile[(k8 + 7) * 65 + n]);
  *(u32x4*)(dst + (size_t)(n0 + n) * dld + k0 + k8) = o;
}
DI void phase_cvt_mix(KP p, char* smem) {
  char* const ws = ows(p);
  {
    bf16_t* wz = (bf16_t*)(ws + OFF_WMIX) + W_WA2;
    for (int i = obid() * NTH + otid(); i < 2 * 2048 * 8; i += gridDim.x * NTH) {
      const int row = i >> 3, c8 = i & 7, d = (row & 2047) >> 10;
      *(u32x4*)(wz + (size_t)row * 128 + (1 - d) * 64 + c8 * 8) = (u32x4){0u, 0u, 0u, 0u};
    }
  }
  for (int it = obid(); it < p->nitems; it += gridDim.x) {
    int j = 0;
    while (j + 1 < p->njobs && p->jobs[j + 1].item0 <= it) ++j;
    cvt_tile(smem, (const float*)(__attribute__((address_space(1))) const float*)p->jobs[j].src, p->jobs[j].ld, (bf16_t*)(__attribute__((address_space(1))) bf16_t*)p->jobs[j].dst, p->jobs[j].K, p->jobs[j].N, it - p->jobs[j].item0, p->jobs[j].dld, p->jobs[j].pad_);
  }
}
constexpr float O8_SCALE = 4.0f;
constexpr float X8_SCALE = 4.0f;
constexpr float W8_SCALE = 32.0f, A8_SCALE = 4.0f, WD8_SCALE = 16.0f;
DI int up_src_col(int np) {
  const int slab = np >> 5, pos = np & 31, q = pos & 15, hh = (q >> 2) & 1, i = (q & 3) + 4 * (q >> 3);
  return (pos >> 4) * 512 + slab * 16 + 8 * hh + i;
}
DI void phase_cvt_moe(KP p, int layer, char* smem) {
  char* const ws = ows(p);
  float* tile = (float*)smem;
  bf16_t* wm = (bf16_t*)(ws + OFF_WMOE);
  const int tid = otid();
  const int NUP = 32 * 256, NDN = 32 * 128;
  for (int it = obid(); it < NUP + NDN; it += gridDim.x) {
    if (it < NUP) {
      const int e = it >> 8, t = it & 255, kt = t >> 4, nt = t & 15, k0 = kt * 64, n0 = nt * 64;
      const float* src = gin(p, 38) + ((size_t)(layer * 32 + e) * 1024) * 1024;
      __syncthreads();
#pragma unroll
      for (int i = 0; i < 8; ++i) { const int idx = tid + i * NTH, r = idx >> 6, c = idx & 63; tile[r * 65 + c] = src[(size_t)(k0 + r) * 1024 + up_src_col(n0 + c)]; }
      __syncthreads();
      const int n = tid >> 3, k8 = (tid & 7) * 8;
      u32x2 o;
      o.x = pk4_fp8(tile[(k8 + 0) * 65 + n] * W8_SCALE, tile[(k8 + 1) * 65 + n] * W8_SCALE, tile[(k8 + 2) * 65 + n] * W8_SCALE, tile[(k8 + 3) * 65 + n] * W8_SCALE);
      o.y = pk4_fp8(tile[(k8 + 4) * 65 + n] * W8_SCALE, tile[(k8 + 5) * 65 + n] * W8_SCALE, tile[(k8 + 6) * 65 + n] * W8_SCALE, tile[(k8 + 7) * 65 + n] * W8_SCALE);
      *(u32x2*)((unsigned char*)wm + (size_t)e * 1024 * 1024 + (size_t)(n0 + n) * 1024 + k0 + k8) = o;
    } else {
      const int i2 = it - NUP, e = i2 >> 7, t = i2 & 127;
      const int kt = t >> 4, nt = t & 15, k0 = kt * 64, n0 = nt * 64;
      const float* src = gin(p, 39) + ((size_t)(layer * 32 + e) * 512) * 1024;
      __syncthreads();
#pragma unroll
      for (int i = 0; i < 8; ++i) { const int idx = tid + i * NTH, r = idx >> 6, c = idx & 63; tile[r * 65 + c] = src[(size_t)(k0 + r) * 1024 + n0 + c]; }
      __syncthreads();
      const int n = tid >> 3, k8 = (tid & 7) * 8;
      u32x2 o;
      o.x = pk4_fp8(tile[(k8 + 0) * 65 + n] * WD8_SCALE, tile[(k8 + 1) * 65 + n] * WD8_SCALE, tile[(k8 + 2) * 65 + n] * WD8_SCALE, tile[(k8 + 3) * 65 + n] * WD8_SCALE);
      o.y = pk4_fp8(tile[(k8 + 4) * 65 + n] * WD8_SCALE, tile[(k8 + 5) * 65 + n] * WD8_SCALE, tile[(k8 + 6) * 65 + n] * WD8_SCALE, tile[(k8 + 7) * 65 + n] * WD8_SCALE);
      *(u32x2*)((unsigned char*)(wm + WMOE_DOWN) + (size_t)e * 1024 * 512 + (size_t)(n0 + n) * 512 + k0 + k8) = o;
    }
  }
}

constexpr int MOD_LDS = 17 * 1024 * 4 + 8 * 17 * 64 * 4;
DI void phase_mod(KP p, char* smem) {
  char* const ws = ows(p);
  float* sc = (float*)smem;
  float* red = sc + 17 * 1024;
  const int tid = otid();
  for (int i = tid; i < 17 * 1024; i += NTH) {
    const int bi = i >> 10, k = i & 1023;
    const float v = bi < 16 ? gin(p, 1)[bi * 1024 + k] : gin(p, 3)[k];
    sc[i] = v / (1.0f + __expf(-v));
  }
  __syncthreads();
  const int col = tid & 63, ks = tid >> 6;
  for (int it = obid(); it < 4 * 96; it += gridDim.x) {
    const int l = it / 96, j = (it % 96) * 64 + col;
    const float* w = gin(p, 4) + (size_t)l * 1024 * 6144 + j;
    float acc[17];
#pragma unroll
    for (int b = 0; b < 17; ++b) acc[b] = 0.f;
    for (int k = ks * 128; k < ks * 128 + 128; ++k) {
      const float wv = w[(size_t)k * 6144];
#pragma unroll
      for (int b = 0; b < 17; ++b) acc[b] += sc[b * 1024 + k] * wv;
    }
    __syncthreads();
#pragma unroll
    for (int b = 0; b < 17; ++b) red[(ks * 17 + b) * 64 + col] = acc[b];
    __syncthreads();
    for (int o = tid; o < 17 * 64; o += NTH) {
      const int b = o >> 6, c = o & 63;
      float s = 0.f;
#pragma unroll
      for (int q = 0; q < 8; ++q) s += red[(q * 17 + b) * 64 + c];
      const int jj = (it % 96) * 64 + c;
      ((float*)(ws + OFF_MOD))[(size_t)(l * 17 + b) * 6144 + jj] = s + gin(p, 5)[l * 6144 + jj];
    }
  }
  {
    bf16_t* wr = (bf16_t*)(ws + OFF_WR);
    for (int i = obid() * NTH + tid; i < 4 * 48 * 1024; i += gridDim.x * NTH) {
      const int l = i / (48 * 1024), n = (i / 1024) % 48, k = i & 1023;
      float w = 0.f;
      if (n < 4) w = gin(p, 34)[((size_t)l * 1024 + k) * 4 + n];
      else if (n < 36) w = gin(p, 36)[((size_t)l * 1024 + k) * 32 + (n - 4)];
      const bf16_t hi = f2bf(w);
      wr[((size_t)(l * 2 + 0) * 48 + n) * 1024 + k] = hi;
      wr[((size_t)(l * 2 + 1) * 48 + n) * 1024 + k] = f2bf(w - bf2f(hi));
    }
  }
  if (obid() == 0) {
    float* rc = (float*)(ws + OFF_ROPE);
    for (int i = tid; i < 1024; i += NTH) {
      const int pos = i >> 4, f = i & 15;
      const float inv = powf(10000.0f, -(float)f / 16.0f);
      const float ang = (float)pos * inv;
      rc[i] = cosf(ang); rc[1024 + i] = sinf(ang);
    }
  }
}

DI void moe_blkstart(char* ws, int layer, int* bs  ) {
  if (otid() == 0) {
    const int* cnt = (const int*)(ws + OFF_CNT) + layer * 32;
    int s = 0;
    for (int e = 0; e < 32; ++e) { bs[e] = s; s += (cnt[e] + MOE_PAD - 1) / MOE_PAD; }
    bs[32] = s;
  }
  __syncthreads();
}
template <int MODE, bool DRY = false, bool OUT8 = false>
DI void phase_norm1(KP p, int layer, char* smem) {
  char* const ws = ows(p);
  int* bs = (int*)smem;
  if (MODE != 0) moe_blkstart(ws, MODE == 3 ? 3 : layer - 1, bs);
  const int lane = otid() & 63, wid = otid() >> 6;
  const int nrows = MODE == 3 ? TL : TT;
  const bf16_t* yb = (const bf16_t*)(ws + OFF_U + UM_YB);
  const int* tok = (const int*)(ws + OFF_TOK);
  bf16_t* hb = (bf16_t*)(ws + OFF_H);
  const int stride = gridDim.x * 8;
  for (int rA = obid() * 8 + wid; rA < nrows; rA += 2 * stride) {
    const int rB = rA + stride;
    const bool hasB = rB < nrows;
    const int rr[2] = {rA, hasB ? rB : rA};
    f32x4 v[2][4];
    int4 t0[2], t1[2];
#pragma unroll
    for (int k = 0; k < 2; ++k) {
      const int r = rr[k];
      if (MODE == 0) {
        const float* src = r < TL ? gin(p, 0) + (size_t)r * DM : gin(p, 2) + (size_t)(r - TL) * DM;
#pragma unroll
        for (int i = 0; i < 4; ++i) v[k][i] = *(const f32x4*)(src + (i * 64 + lane) * 4);
      } else {
        const bf16_t* xr = xrow_ptr(p, ws, r);
#pragma unroll
        for (int i = 0; i < 4; ++i) v[k][i] = ldbf4(xr + (i * 64 + lane) * 4);
        t0[k] = *(const int4*)(tok + (size_t)r * 8);
        t1[k] = *(const int4*)(tok + (size_t)r * 8 + 4);
      }
    }
    if (MODE == 1 || MODE == 3) {
      const int pl = MODE == 3 ? 3 : layer - 1;
      u32x2 ya[2][4], yc[2][4];
#pragma unroll
      for (int k = 0; k < 2; ++k) {
        const size_t d0 = (size_t)(bs[t0[k].x] * MOE_PAD + t0[k].y), d1 = (size_t)(bs[t0[k].z] * MOE_PAD + t0[k].w);
#pragma unroll
        for (int i = 0; i < 4; ++i) { const int ch = (i * 64 + lane) * 4; ya[k][i] = *(const u32x2*)(yb + d0 * DM + ch); yc[k][i] = *(const u32x2*)(yb + d1 * DM + ch); }
      }
#pragma unroll
      for (int k = 0; k < 2; ++k) {
        const float w0 = __int_as_float(t1[k].x), w1 = __int_as_float(t1[k].y);
        const float* g2 = modp(ws, pl, row_bi(rr[k]), 5);
#pragma unroll
        for (int i = 0; i < 4; ++i) {
          const int ch = (i * 64 + lane) * 4;
          const u32x2 a = ya[k][i], b = yc[k][i];
          const f32x4 g = *(const f32x4*)(g2 + ch);
          v[k][i][0] += g[0] * (w0 * bflo(a.x) + w1 * bflo(b.x));
          v[k][i][1] += g[1] * (w0 * bfhi(a.x) + w1 * bfhi(b.x));
          v[k][i][2] += g[2] * (w0 * bflo(a.y) + w1 * bflo(b.y));
          v[k][i][3] += g[3] * (w0 * bfhi(a.y) + w1 * bfhi(b.y));
        }
      }
    }
#pragma unroll
    for (int k = 0; k < 2; ++k) {
      if (k == 1 && !hasB) break;
      const int r = rr[k], bi = row_bi(r);
      bf16_t* xr = xrow_ptr(p, ws, r);
      if ((MODE == 0 || MODE == 1) && !DRY) {
#pragma unroll
        for (int i = 0; i < 4; ++i) stbf4(xr + (i * 64 + lane) * 4, v[k][i]);
      }
      float ss = 0.f;
#pragma unroll
      for (int i = 0; i < 4; ++i) ss += v[k][i][0] * v[k][i][0] + v[k][i][1] * v[k][i][1] + v[k][i][2] * v[k][i][2] + v[k][i][3] * v[k][i][3];
      ss = wave_sum(ss);
      const float rs = rsqrtf(ss * (1.0f / 1024.0f) + 1e-6f);
      if (MODE == 3) {
#pragma unroll
        for (int i = 0; i < 4; ++i) {
          const int ch = (i * 64 + lane) * 4;
          const f32x4 g = *(const f32x4*)(gin(p, 7) + ch);
          f32x4 o; o[0] = v[k][i][0] * rs * g[0]; o[1] = v[k][i][1] * rs * g[1]; o[2] = v[k][i][2] * rs * g[2]; o[3] = v[k][i][3] * rs * g[3];
          if (!DRY) *(f32x4*)(gout(p) + (size_t)r * DM + ch) = o; else asm volatile("" :: "v"(o[0]), "v"(o[1]), "v"(o[2]), "v"(o[3]));
        }
      } else {
        const float* gn = gin(p, 6) + (size_t)(layer * 2 + 0) * DM;
        const float* sh = modp(ws, layer, bi, 0);
        const float* sc = modp(ws, layer, bi, 1);
#pragma unroll
        for (int i = 0; i < 4; ++i) {
          const int ch = (i * 64 + lane) * 4;
          const f32x4 g = *(const f32x4*)(gn + ch), s1 = *(const f32x4*)(sc + ch), s0 = *(const f32x4*)(sh + ch);
          float o[4];
#pragma unroll
          for (int j = 0; j < 4; ++j) o[j] = v[k][i][j] * rs * g[j] * (1.0f + s1[j]) + s0[j];
          if constexpr (OUT8) {
            const unsigned w8 = pk4_fp8(o[0] * X8_SCALE, o[1] * X8_SCALE, o[2] * X8_SCALE, o[3] * X8_SCALE);
            if (!DRY) *(unsigned*)((unsigned char*)(ws + OFF_H8) + (size_t)r * DM + ch) = w8; else asm volatile("" :: "v"(w8));
          } else {
            u32x2 w; w.x = pk2(o[0], o[1]); w.y = pk2(o[2], o[3]);
            if (!DRY) *(u32x2*)(hb + (size_t)r * DM + ch) = w; else asm volatile("" :: "v"(w.x), "v"(w.y));
          }
        }
      }
    }
  }
}

constexpr int R2_TLD = 1032;
constexpr int R2_LLD = 49;
constexpr int R2_LDS = 64 * R2_TLD * 2 + 64 * R2_LLD * 4;
template <bool DRY = false>
DI void phase_norm2_router(KP p, int layer, char* smem) {
  char* const ws = ows(p);
  const int tid = otid(), lane = tid & 63, wid = tid >> 6, fr = lane & 15, fq = lane >> 4;
  bf16_t* tile = (bf16_t*)smem;
  float* lgt = (float*)(smem + 64 * R2_TLD * 2);
  const int nrows = layer == 3 ? TL : TT;
  unsigned char* h8 = (unsigned char*)(ws + OFF_H8);
  int* tok = (int*)(ws + OFF_TOK);
  int* rowl = (int*)(ws + OFF_ROWL);
  int* cnt = (int*)(ws + OFF_CNT) + layer * 32;
  const float* bg = gin(p, 35) + layer * 4;
  const float* be = gin(p, 37) + layer * 32;
  const float* gn = gin(p, 6) + (size_t)(layer * 2 + 1) * DM;
  const bf16_t* wrh = (const bf16_t*)(ws + OFF_WR) + (size_t)layer * 2 * 48 * 1024;
  const bf16_t* wrl = wrh + 48 * 1024;
  bf16x8 bh[4][3], bl[4][3];
#pragma unroll
  for (int ks = 0; ks < 4; ++ks)
#pragma unroll
    for (int nt = 0; nt < 3; ++nt) {
      const size_t o = (size_t)(nt * 16 + fr) * 1024 + wid * 128 + ks * 32 + fq * 8;
      bh[ks][nt] = *(const bf16x8*)(wrh + o); bl[ks][nt] = *(const bf16x8*)(wrl + o);
    }
  for (int rbase = obid() * 64; rbase < nrows; rbase += gridDim.x * 64) {
    const int bi = row_bi(rbase);
    const float* sh = modp(ws, layer, bi, 3);
    const float* sc = modp(ws, layer, bi, 4);
    f32x4 gs[4], s0[4];
#pragma unroll
    for (int i = 0; i < 4; ++i) {
      const int ch = (i * 64 + lane) * 4;
      const f32x4 g = *(const f32x4*)(gn + ch), s1 = *(const f32x4*)(sc + ch);
      gs[i] = g * (1.0f + s1); s0[i] = *(const f32x4*)(sh + ch);
    }
#pragma unroll 2
    for (int q = 0; q < 8; ++q) {
      const int lr = wid * 8 + q, r = rbase + lr;
      const bf16_t* xr = xrow_ptr(p, ws, r);
      f32x4 v[4];
      float ss = 0.f;
#pragma unroll
      for (int i = 0; i < 4; ++i) { v[i] = ldbf4(xr + (i * 64 + lane) * 4); ss += v[i][0] * v[i][0] + v[i][1] * v[i][1] + v[i][2] * v[i][2] + v[i][3] * v[i][3]; }
      ss = wave_sum(ss);
      const float rs = rsqrtf(ss * (1.0f / 1024.0f) + 1e-6f);
#pragma unroll
      for (int i = 0; i < 4; ++i) {
        const int ch = (i * 64 + lane) * 4;
        const f32x4 o = v[i] * rs * gs[i] + s0[i];
        u32x2 w; w.x = pk2(o[0], o[1]); w.y = pk2(o[2], o[3]);
        *(unsigned*)(h8 + (size_t)r * DM + ch) = pk4_fp8(o[0], o[1], o[2], o[3]);
        *(u32x2*)(tile + lr * R2_TLD + ch) = w;
      }
    }
    __syncthreads();
    {
      f32x4 acc[4][3];
#pragma unroll
      for (int rt = 0; rt < 4; ++rt)
#pragma unroll
        for (int nt = 0; nt < 3; ++nt) acc[rt][nt] = (f32x4){0.f, 0.f, 0.f, 0.f};
#pragma unroll
      for (int ks = 0; ks < 4; ++ks)
#pragma unroll
        for (int rt = 0; rt < 4; ++rt) {
          const bf16x8 a = *(const bf16x8*)(tile + (rt * 16 + fr) * R2_TLD + wid * 128 + ks * 32 + fq * 8);
#pragma unroll
          for (int nt = 0; nt < 3; ++nt) { acc[rt][nt] = MFMA16(a, bh[ks][nt], acc[rt][nt]); acc[rt][nt] = MFMA16(a, bl[ks][nt], acc[rt][nt]); }
        }
      __syncthreads();
      float* part = (float*)smem + wid * 64 * R2_LLD;
#pragma unroll
      for (int rt = 0; rt < 4; ++rt)
#pragma unroll
        for (int nt = 0; nt < 3; ++nt)
#pragma unroll
          for (int j = 0; j < 4; ++j) part[(rt * 16 + fq * 4 + j) * R2_LLD + nt * 16 + fr] = acc[rt][nt][j];
    }
    __syncthreads();
    for (int i = tid; i < 64 * 36; i += NTH) {
      const int row = i / 36, col = i - row * 36;
      const float* pp = (const float*)smem + row * R2_LLD + col;
      float sacc = 0.f;
#pragma unroll
      for (int w = 0; w < 8; ++w) sacc += pp[w * 64 * R2_LLD];
      lgt[row * R2_LLD + col] = sacc;
    }
    __syncthreads();
    if (wid == 0) {
      const int r = rbase + lane;
      float* lr_ = lgt + lane * R2_LLD;
      float lg[4];
#pragma unroll
      for (int q = 0; q < 4; ++q) lg[q] = lr_[q] + bg[q];
      int gsel = 0; float gm = lg[0];
#pragma unroll
      for (int q = 1; q < 4; ++q) if (lg[q] > gm) { gm = lg[q]; gsel = q; }
      float gden = 0.f;
#pragma unroll
      for (int q = 0; q < 4; ++q) gden += __expf(lg[q] - gm);
      const float pgrp = 1.0f / gden;
      float le[8];
#pragma unroll
      for (int q = 0; q < 8; ++q) le[q] = lr_[4 + gsel * 8 + q] + be[gsel * 8 + q];
      int i0 = 0; float m0 = le[0];
#pragma unroll
      for (int q = 1; q < 8; ++q) if (le[q] > m0) { m0 = le[q]; i0 = q; }
      int i1 = -1; float m1 = -3.0e38f;
#pragma unroll
      for (int q = 0; q < 8; ++q) if (q != i0 && le[q] > m1) { m1 = le[q]; i1 = q; }
      const float e1 = __expf(m1 - m0);
      const float w0 = pgrp / (1.0f + e1), w1 = pgrp * e1 / (1.0f + e1);
      if (DRY) asm volatile("" :: "v"(w0), "v"(w1), "v"(i0), "v"(i1), "v"(gsel));
      if (!DRY) {
        const int ea = gsel * 8 + i0, eb = gsel * 8 + i1;
        const int pa = atomicAdd(&cnt[ea], 1), pb = atomicAdd(&cnt[eb], 1);
        rowl[(size_t)ea * CAP + pa] = r; rowl[(size_t)eb * CAP + pb] = r;
        int4 t0; t0.x = ea; t0.y = pa; t0.z = eb; t0.w = pb;
        int4 t1; t1.x = __float_as_int(w0); t1.y = __float_as_int(w1); t1.z = 0; t1.w = 0;
        *(int4*)(tok + (size_t)r * 8) = t0; *(int4*)(tok + (size_t)r * 8 + 4) = t1;
      }
    }
  }
}

DI void st_bf16x4(bf16_t* p, const f32x4& v) { u32x2 w; w.x = pk2(v[0], v[1]); w.y = pk2(v[2], v[3]); *(u32x2*)p = w; }
constexpr int FG_LDS = fg::STAGE_BYTES;
constexpr int MOE_UMAX = 12;

struct MoeSched {
  const char* A; const char* B; const LAS int* bs; const LAS int* rowtab; int G, c, ntile; size_t tA, eB, tB;
  DI bool next(int i, fg::Unit& u) const {
    const int rt = (G & 31) ? (i * G + c) >> 2 : i * (G >> 2) + (c & 7) * (G >> 5) + (c >> 5), ct = (G & 31) ? (i * G + c) & 3 : (c >> 3) & 3;
    if (rt >= ntile) return false;
    int e = 0;
#pragma unroll 1
    while (e < 31 && bs[e + 1] <= rt) ++e;
    u.pm = rt; u.pn = ct; u.aux = e; u.A = A + (size_t)rt * tA; u.B = B + (size_t)e * eB + (size_t)ct * tB; return true;
  }
  DI const LAS int* rows(int i) const { return rowtab + i * 256; }
};
DI void phase_moe_up(KP p, int layer, char* smem) {
  char* const ws = ows(p);
  LAS unsigned char* lds = (LAS unsigned char*)smem;
  LAS int* rowtab = (LAS int*)(lds + FG_LDS);
  int* bs = (int*)(smem + FG_LDS + MOE_UMAX * 1024);
  moe_blkstart(ws, layer, bs);
  const int* cnt = (const int*)(ws + OFF_CNT) + layer * 32;
  const int* rowl = (const int*)(ws + OFF_ROWL);
  unsigned char* act8 = (unsigned char*)(ws + OFF_U + UM_ACT);
  MoeSched S;
  S.A = ws + OFF_H8; S.B = ws + OFF_WMOE; S.bs = (const LAS int*)bs; S.rowtab = rowtab; S.G = gridDim.x; S.c = obid(); S.ntile = bs[32];
  S.tA = 0; S.eB = (size_t)1024 * 1024; S.tB = (size_t)256 * 1024;
  {
    const int tid = otid();
    fg::Unit u;
    for (int i = 0; i < MOE_UMAX && S.next(i, u); ++i) {
      if (tid < 256) {
        const int e = u.aux, pos = (u.pm - bs[e]) * 256 + tid;
        rowtab[i * 256 + tid] = pos < cnt[e] ? rowl[(size_t)e * CAP + pos] : TT;
      }
    }
    __syncthreads();
  }
  auto ep = [&](const f32x16 (&acc)[2][2][2], const fg::Unit& u, int wr, int wc, int r, int h) {
    constexpr float inv = 1.0f / W8_SCALE;
#pragma unroll
    for (int ai = 0; ai < 2; ++ai)
#pragma unroll
      for (int m = 0; m < 2; ++m) {
        const size_t row = (size_t)u.pm * 256 + ai * 128 + wr * 64 + m * 32 + r;
#pragma unroll
        for (int bj = 0; bj < 2; ++bj) {
          const int acol = ((u.pn * 256 + bj * 128 + wc * 32) >> 5) * 16 + 8 * h;
          float o[8];
#pragma unroll
          for (int i = 0; i < 8; ++i) { const float g = acc[ai][bj][m][i] * inv, uu = acc[ai][bj][m][i + 8] * inv; o[i] = g * __builtin_amdgcn_rcpf(1.0f + __expf(-g)) * uu; }
          u32x2 w8; w8.x = pk4_fp8(o[0] * A8_SCALE, o[1] * A8_SCALE, o[2] * A8_SCALE, o[3] * A8_SCALE); w8.y = pk4_fp8(o[4] * A8_SCALE, o[5] * A8_SCALE, o[6] * A8_SCALE, o[7] * A8_SCALE);
          *(u32x2*)(act8 + row * 512 + acol) = w8;
        }
      }
  };
  fg::gemm_phase_f8<true>(lds, 512, 512, 512, S, ep);
}
DI void phase_moe_down(KP p, int layer, char* smem) {
  char* const ws = ows(p);
  LAS unsigned char* lds = (LAS unsigned char*)smem;
  int* bs = (int*)(smem + FG_LDS + MOE_UMAX * 1024);
  moe_blkstart(ws, layer, bs);
  bf16_t* yb = (bf16_t*)(ws + OFF_U + UM_YB);
  MoeSched S;
  S.A = ws + OFF_U + UM_ACT; S.B = ws + OFF_WMOE + WMOE_DOWN * 2; S.bs = (const LAS int*)bs; S.rowtab = nullptr; S.G = gridDim.x; S.c = obid(); S.ntile = bs[32];
  S.tA = (size_t)256 * 512; S.eB = (size_t)1024 * 512; S.tB = (size_t)256 * 512;
  auto ep = [&](const f32x16 (&acc)[2][2][2], const fg::Unit& u, int wr, int wc, int r, int h) {
    constexpr float inv = 1.0f / (A8_SCALE * WD8_SCALE);
#pragma unroll
    for (int ai = 0; ai < 2; ++ai)
#pragma unroll
      for (int m = 0; m < 2; ++m) {
        const size_t row = (size_t)u.pm * 256 + ai * 128 + wr * 64 + m * 32 + r;
#pragma unroll
        for (int bj = 0; bj < 2; ++bj) {
          const f32x16& a = acc[ai][bj][m];
          u32x4 w0, w1;
          w0.x = pk2(a[0] * inv, a[1] * inv); w0.y = pk2(a[2] * inv, a[3] * inv); w0.z = pk2(a[4] * inv, a[5] * inv); w0.w = pk2(a[6] * inv, a[7] * inv);
          w1.x = pk2(a[8] * inv, a[9] * inv); w1.y = pk2(a[10] * inv, a[11] * inv); w1.z = pk2(a[12] * inv, a[13] * inv); w1.w = pk2(a[14] * inv, a[15] * inv);
          bf16_t* q = yb + row * DM + u.pn * 256 + bj * 128 + wc * 32 + 16 * h;
          *(u32x4*)q = w0; *(u32x4*)(q + 8) = w1;
        }
      }
  };
  fg::gemm_phase_f8<false, true>(lds, 256, 256, 256, S, ep);
}

template <int NKC>
DI void phase_qkv(KP p, const bf16_t* Wt, bf16_t* Q, bf16_t* Kb, bf16_t* Vb, char* smem) {
  char* const ws = ows(p);
  LAS unsigned char* lds = (LAS unsigned char*)smem;
  constexpr int N = 1024 + 2 * NKC;
  const float* rc = (const float*)(ws + OFF_ROPE);
  fg::DenseSched S;
  S.A = ws + OFF_H; S.B = (const char*)Wt; S.nM = TT / 256; S.nN = N / 256; S.G = gridDim.x; S.c = obid(); S.tA = (size_t)256 * 1024 * 2; S.tB = (size_t)256 * 1024 * 2;
  auto ep = [&](const f32x4 (&acc)[2][2][4][2], const fg::Unit& u, int wr, int wc, int fr, int fq) {
#pragma unroll
    for (int bj = 0; bj < 2; ++bj) {
      const int colb = u.pn * 256 + bj * 128 + wc * 32;
      if (colb < 1024 + NKC) {
        const bool isq = colb < 1024;
        bf16_t* dst = isq ? Q : Kb;
        const int ldd = isq ? 1024 : NKC, cc2 = (isq ? colb : colb - 1024) + 8 * fq;
        const float qs = isq ? 0.125f : 1.0f;
#pragma unroll
        for (int ai = 0; ai < 2; ++ai)
#pragma unroll
          for (int m = 0; m < 4; ++m) {
            const int row = u.pm * 256 + ai * 128 + wr * 64 + m * 16 + fr;
            f32x4 x0 = acc[ai][bj][m][0], x1 = acc[ai][bj][m][1];
            if (row < TL) {
              const int s = row & 4095, idx = (colb & 32) ? (s & 63) : (s >> 6);
              const f32x4 c = *(const f32x4*)(rc + idx * 16 + 4 * fq), sn = *(const f32x4*)(rc + 1024 + idx * 16 + 4 * fq);
              const f32x4 o0 = x0 * c - x1 * sn, o1 = x1 * c + x0 * sn;
              x0 = o0; x1 = o1;
            }
            const f32x4 y0 = x0 * qs, y1 = x1 * qs;
            if (NKC == 1024 && !isq) {
              u32x2 w8; w8.x = pk4_fp8(y0[0], y0[1], y0[2], y0[3]); w8.y = pk4_fp8(y1[0], y1[1], y1[2], y1[3]);
              *(u32x2*)((unsigned char*)Kb + (size_t)row * 1024 + cc2) = w8;
            } else {
              u32x4 w; w.x = pk2(y0[0], y0[1]); w.y = pk2(y0[2], y0[3]); w.z = pk2(y1[0], y1[1]); w.w = pk2(y1[2], y1[3]);
              *(u32x4*)(dst + (size_t)row * ldd + cc2) = w;
            }
          }
      } else {
        const int cv = colb - (1024 + NKC) + 4 * fq;
        if constexpr (NKC == 1024) {
          unsigned char* Vt = (unsigned char*)Vb;
          const int tq = fr & 3;
#pragma unroll
          for (int ai = 0; ai < 2; ++ai)
#pragma unroll
            for (int m = 0; m < 4; ++m) {
              const int row = u.pm * 256 + ai * 128 + wr * 64 + m * 16 + fr, rowq = row & ~3;
              size_t base; int kq;
              if (rowq < TL) { const int b = rowq >> 12, s0 = rowq & 4095; base = (size_t)b * 1024 * 4096 + (size_t)(s0 >> 6) * 64; kq = (s0 & 63) >> 2; }
              else { const int rc2 = rowq - TL, b = rc2 >> 8, c0 = rc2 & 255; base = (size_t)16 * 1024 * 4096 + (size_t)b * 1024 * 256 + (size_t)(c0 >> 6) * 64; kq = (c0 & 63) >> 2; }
              const size_t rstride = rowq < TL ? 4096 : 256;
              const int pos = 32 * (kq & 1) + 16 * (kq >> 3) + 4 * ((kq >> 1) & 3);
#pragma unroll
              for (int n = 0; n < 2; ++n) {
                const f32x4 a = acc[ai][bj][m][n];
                const int d = (int)pk4_fp8(a[0], a[1], a[2], a[3]);
                const int d0 = __builtin_amdgcn_update_dpp(0, d, 0x00, 0xF, 0xF, true), d1 = __builtin_amdgcn_update_dpp(0, d, 0x55, 0xF, 0xF, true);
                const int d2 = __builtin_amdgcn_update_dpp(0, d, 0xAA, 0xF, 0xF, true), d3 = __builtin_amdgcn_update_dpp(0, d, 0xFF, 0xF, 0xF, true);
                const int sh = 8 * tq;
                const unsigned w = ((unsigned)(d0 >> sh) & 0xffu) | (((unsigned)(d1 >> sh) & 0xffu) << 8) | (((unsigned)(d2 >> sh) & 0xffu) << 16) | (((unsigned)(d3 >> sh) & 0xffu) << 24);
                *(unsigned*)(Vt + base + (size_t)(cv + 16 * n + tq) * rstride + pos) = w;
              }
            }
        } else {
#pragma unroll
          for (int ai = 0; ai < 2; ++ai)
#pragma unroll
            for (int m = 0; m < 4; ++m) {
              const int row = u.pm * 256 + ai * 128 + wr * 64 + m * 16 + fr;
              st_bf16x4(Vb + (size_t)row * NKC + cv, acc[ai][bj][m][0]);
              st_bf16x4(Vb + (size_t)row * NKC + cv + 16, acc[ai][bj][m][1]);
            }
        }
      }
    }
  };
  fg::gemm_phase<false>(lds, 1024, 1024, 1024, S, ep);
}

DI void phase_qkv_diff8(KP p, char* smem) {
  char* const ws = ows(p);
  LAS unsigned char* lds = (LAS unsigned char*)smem;
  const float* rc = (const float*)(ws + OFF_ROPE);
  bf16_t* Q = (bf16_t*)(ws + OFF_U + U1_Q);
  unsigned char* K8 = (unsigned char*)(ws + OFF_U + U1_K);
  unsigned char* Vt = (unsigned char*)(ws + OFF_U + U1_V);
  fg::DenseSched S;
  S.A = ws + OFF_H8; S.B = ws + OFF_WMIX + W_DIFFQKV * 2; S.nM = TT / 256; S.nN = 12; S.G = gridDim.x; S.c = obid(); S.tA = (size_t)256 * 1024; S.tB = (size_t)256 * 1024;
  auto ep = [&](const f32x16 (&acc)[2][2][2], const fg::Unit& u, int wr, int wc, int r, int h) {
    constexpr float inv = 1.0f / (X8_SCALE * 32.0f);
#pragma unroll
    for (int bj = 0; bj < 2; ++bj) {
      const int colb = u.pn * 256 + bj * 128 + wc * 32;
      if (colb < 2048) {
        const bool isq = colb < 1024;
        const float qs = (isq ? 0.125f : 1.0f) * inv;
#pragma unroll
        for (int ai = 0; ai < 2; ++ai)
#pragma unroll
          for (int m = 0; m < 2; ++m) {
            const int row = u.pm * 256 + ai * 128 + wr * 64 + m * 32 + r;
            const f32x16& a = acc[ai][bj][m];
            float y[16];
            if (row < TL) {
              const int s = row & 4095, idx = (colb & 32) ? (s & 63) : (s >> 6);
              const f32x4 c0 = *(const f32x4*)(rc + idx * 16 + 4 * h), c1 = *(const f32x4*)(rc + idx * 16 + 8 + 4 * h);
              const f32x4 s0 = *(const f32x4*)(rc + 1024 + idx * 16 + 4 * h), s1 = *(const f32x4*)(rc + 1024 + idx * 16 + 8 + 4 * h);
#pragma unroll
              for (int i = 0; i < 8; ++i) {
                const float cc = i < 4 ? c0[i & 3] : c1[i & 3], sn = i < 4 ? s0[i & 3] : s1[i & 3];
                y[i] = (a[i] * cc - a[i + 8] * sn) * qs; y[i + 8] = (a[i + 8] * cc + a[i] * sn) * qs;
              }
            } else {
#pragma unroll
              for (int i = 0; i < 16; ++i) y[i] = a[i] * qs;
            }
            if (isq) {
              u32x4 w0, w1;
              w0.x = pk2(y[0], y[1]); w0.y = pk2(y[2], y[3]); w0.z = pk2(y[4], y[5]); w0.w = pk2(y[6], y[7]);
              w1.x = pk2(y[8], y[9]); w1.y = pk2(y[10], y[11]); w1.z = pk2(y[12], y[13]); w1.w = pk2(y[14], y[15]);
              bf16_t* q = Q + (size_t)row * 1024 + colb + 16 * h;
              *(u32x4*)q = w0; *(u32x4*)(q + 8) = w1;
            } else {
              u32x4 w8;
              w8.x = pk4_fp8(y[0], y[1], y[2], y[3]); w8.y = pk4_fp8(y[4], y[5], y[6], y[7]); w8.z = pk4_fp8(y[8], y[9], y[10], y[11]); w8.w = pk4_fp8(y[12], y[13], y[14], y[15]);
              *(u32x4*)(K8 + (size_t)row * 1024 + (colb - 1024) + 16 * h) = w8;
            }
          }
      } else {
        const int cv = colb - 2048 + 4 * h, tq = r & 3;
#pragma unroll
        for (int ai = 0; ai < 2; ++ai)
#pragma unroll
          for (int m = 0; m < 2; ++m) {
            const int row = u.pm * 256 + ai * 128 + wr * 64 + m * 32 + r, rowq = row & ~3;
            size_t base; int kq;
            if (rowq < TL) { const int b = rowq >> 12, s0 = rowq & 4095; base = (size_t)b * 1024 * 4096 + (size_t)(s0 >> 6) * 64; kq = (s0 & 63) >> 2; }
            else { const int rc2 = rowq - TL, b = rc2 >> 8, c0 = rc2 & 255; base = (size_t)16 * 1024 * 4096 + (size_t)b * 1024 * 256 + (size_t)(c0 >> 6) * 64; kq = (c0 & 63) >> 2; }
            const size_t rstride = rowq < TL ? 4096 : 256;
            const int pos = 32 * (kq & 1) + 16 * (kq >> 3) + 4 * ((kq >> 1) & 3);
            const f32x16& a = acc[ai][bj][m];
#pragma unroll
            for (int g = 0; g < 4; ++g) {
              const int d = (int)pk4_fp8(a[4 * g] * inv, a[4 * g + 1] * inv, a[4 * g + 2] * inv, a[4 * g + 3] * inv);
              const int d0 = __builtin_amdgcn_update_dpp(0, d, 0x00, 0xF, 0xF, true), d1 = __builtin_amdgcn_update_dpp(0, d, 0x55, 0xF, 0xF, true);
              const int d2 = __builtin_amdgcn_update_dpp(0, d, 0xAA, 0xF, 0xF, true), d3 = __builtin_amdgcn_update_dpp(0, d, 0xFF, 0xF, 0xF, true);
              const int sh = 8 * tq;
              const unsigned w = ((unsigned)(d0 >> sh) & 0xffu) | (((unsigned)(d1 >> sh) & 0xffu) << 8) | (((unsigned)(d2 >> sh) & 0xffu) << 16) | (((unsigned)(d3 >> sh) & 0xffu) << 24);
              *(unsigned*)(Vt + base + (size_t)(cv + 8 * g + tq) * rstride + pos) = w;
            }
          }
      }
    }
  };
  fg::gemm_phase_f8<false, false>(lds, 512, 512, 512, S, ep);
}

DI void phase_qkv_win8(KP p, char* smem) {
  char* const ws = ows(p);
  LAS unsigned char* lds = (LAS unsigned char*)smem;
  const float* rc = (const float*)(ws + OFF_ROPE);
  bf16_t* Q = (bf16_t*)(ws + OFF_U + U0_Q);
  bf16_t* Kb = (bf16_t*)(ws + OFF_U + U0_K);
  bf16_t* Vb = (bf16_t*)(ws + OFF_U + U0_V);
  fg::DenseSched S;
  S.A = ws + OFF_H8; S.B = ws + OFF_WMIX + W_WINQKV * 2; S.nM = TT / 256; S.nN = 6; S.G = gridDim.x; S.c = obid(); S.tA = (size_t)256 * 1024; S.tB = (size_t)256 * 1024;
  auto ep = [&](const f32x16 (&acc)[2][2][2], const fg::Unit& u, int wr, int wc, int r, int h) {
    constexpr float inv = 1.0f / (X8_SCALE * 32.0f);
#pragma unroll
    for (int bj = 0; bj < 2; ++bj) {
      const int colb = u.pn * 256 + bj * 128 + wc * 32;
      if (colb < 1280) {
        const bool isq = colb < 1024;
        const float qs = (isq ? 0.125f : 1.0f) * inv;
        bf16_t* dst = isq ? Q + colb + 16 * h : Kb + (colb - 1024) + 16 * h;
        const int ldd = isq ? 1024 : 256;
#pragma unroll
        for (int ai = 0; ai < 2; ++ai)
#pragma unroll
          for (int m = 0; m < 2; ++m) {
            const int row = u.pm * 256 + ai * 128 + wr * 64 + m * 32 + r;
            const f32x16& a = acc[ai][bj][m];
            float y[16];
            if (row < TL) {
              const int s = row & 4095, idx = (colb & 32) ? (s & 63) : (s >> 6);
              const f32x4 c0 = *(const f32x4*)(rc + idx * 16 + 4 * h), c1 = *(const f32x4*)(rc + idx * 16 + 8 + 4 * h);
              const f32x4 s0 = *(const f32x4*)(rc + 1024 + idx * 16 + 4 * h), s1 = *(const f32x4*)(rc + 1024 + idx * 16 + 8 + 4 * h);
#pragma unroll
              for (int i = 0; i < 8; ++i) {
                const float cc = i < 4 ? c0[i & 3] : c1[i & 3], sn = i < 4 ? s0[i & 3] : s1[i & 3];
                y[i] = (a[i] * cc - a[i + 8] * sn) * qs; y[i + 8] = (a[i + 8] * cc + a[i] * sn) * qs;
              }
            } else {
#pragma unroll
              for (int i = 0; i < 16; ++i) y[i] = a[i] * qs;
            }
            u32x4 w0, w1;
            w0.x = pk2(y[0], y[1]); w0.y = pk2(y[2], y[3]); w0.z = pk2(y[4], y[5]); w0.w = pk2(y[6], y[7]);
            w1.x = pk2(y[8], y[9]); w1.y = pk2(y[10], y[11]); w1.z = pk2(y[12], y[13]); w1.w = pk2(y[14], y[15]);
            bf16_t* q = dst + (size_t)row * ldd;
            *(u32x4*)q = w0; *(u32x4*)(q + 8) = w1;
          }
      } else {
        const int cv = colb - 1280 + 4 * h;
#pragma unroll
        for (int ai = 0; ai < 2; ++ai)
#pragma unroll
          for (int m = 0; m < 2; ++m) {
            const int row = u.pm * 256 + ai * 128 + wr * 64 + m * 32 + r;
            const f32x16& a = acc[ai][bj][m];
#pragma unroll
            for (int g = 0; g < 4; ++g) {
              f32x4 v4; v4[0] = a[4 * g] * inv; v4[1] = a[4 * g + 1] * inv; v4[2] = a[4 * g + 2] * inv; v4[3] = a[4 * g + 3] * inv;
              st_bf16x4(Vb + (size_t)row * 256 + cv + 8 * g, v4);
            }
          }
      }
    }
  };
  fg::gemm_phase_f8<false, false>(lds, 512, 512, 512, S, ep);
}

template <bool DRY = false>
DI void phase_oproj(KP p, int layer, const bf16_t* A, const bf16_t* Wt, int nrows, char* smem) {
  char* const ws = ows(p);
  LAS unsigned char* lds = (LAS unsigned char*)smem;
  fg::DenseSched S;
  S.A = (const char*)A; S.B = (const char*)Wt; S.nM = nrows / 256; S.nN = 4; S.G = gridDim.x; S.c = obid(); S.tA = (size_t)256 * 1024 * 2; S.tB = (size_t)256 * 1024 * 2;
  auto ep = [&](const f32x4 (&acc)[2][2][4][2], const fg::Unit& u, int wr, int wc, int fr, int fq) {
    const int row0 = u.pm * 256 + wr * 64 + fr, colb = u.pn * 256 + wc * 32 + 4 * fq;
    const float* g1 = modp(ws, layer, row_bi(row0), 2) + colb;
    f32x4 g[2][2];
#pragma unroll
    for (int bj = 0; bj < 2; ++bj)
#pragma unroll
      for (int n = 0; n < 2; ++n) g[bj][n] = *(const f32x4*)(g1 + bj * 128 + n * 16);
    f32x4 xa[2][2], xb[2][2];
    bf16_t* xr = xrow_ptr(p, ws, row0) + colb;
#pragma unroll
    for (int bj = 0; bj < 2; ++bj)
#pragma unroll
      for (int n = 0; n < 2; ++n) xa[bj][n] = ldbf4(xr + bj * 128 + n * 16);
#pragma unroll
    for (int rr = 0; rr < 8; ++rr) {
      const int ai = rr >> 2, m = rr & 3;
      bf16_t* xn = xr;
      if (rr + 1 < 8) {
        xn = xrow_ptr(p, ws, row0 + ((rr + 1) >> 2) * 128 + ((rr + 1) & 3) * 16) + colb;
#pragma unroll
        for (int bj = 0; bj < 2; ++bj)
#pragma unroll
          for (int n = 0; n < 2; ++n) xb[bj][n] = ldbf4(xn + bj * 128 + n * 16);
      }
#pragma unroll
      for (int bj = 0; bj < 2; ++bj)
#pragma unroll
        for (int n = 0; n < 2; ++n) {
          const f32x4 x = xa[bj][n] + g[bj][n] * acc[ai][bj][m][n];
          if (!DRY) stbf4(xr + bj * 128 + n * 16, x); else asm volatile("" :: "v"(x[0]), "v"(x[1]), "v"(x[2]), "v"(x[3]));
        }
#pragma unroll
      for (int bj = 0; bj < 2; ++bj)
#pragma unroll
        for (int n = 0; n < 2; ++n) xa[bj][n] = xb[bj][n];
      xr = xn;
    }
  };
  fg::gemm_phase<false>(lds, 1024, 1024, 1024, S, ep);
}

template <bool DRY = false>
DI void phase_oproj8(KP p, int layer, const char* A8, const char* W8, int nrows, char* smem) {
  char* const ws = ows(p);
  LAS unsigned char* lds = (LAS unsigned char*)smem;
  fg::DenseSched S;
  S.A = A8; S.B = W8; S.nM = nrows / 256; S.nN = 4; S.G = gridDim.x; S.c = obid(); S.tA = (size_t)256 * 1024; S.tB = (size_t)256 * 1024;
  auto ep = [&](const f32x16 (&acc)[2][2][2], const fg::Unit& u, int wr, int wc, int r, int h) {
    constexpr float inv = 1.0f / (O8_SCALE * 32.0f);
    const int row0 = u.pm * 256 + wr * 64 + r, colb = u.pn * 256 + wc * 32 + 16 * h;
    const float* g1 = modp(ws, layer, row_bi(row0), 2) + colb;
#pragma unroll
    for (int bj = 0; bj < 2; ++bj) {
      f32x4 g[4];
#pragma unroll
      for (int q = 0; q < 4; ++q) g[q] = *(const f32x4*)(g1 + bj * 128 + 4 * q) * inv;
#pragma unroll
      for (int ai = 0; ai < 2; ++ai)
#pragma unroll
        for (int m = 0; m < 2; ++m) {
          bf16_t* xr = xrow_ptr(p, ws, row0 + ai * 128 + m * 32) + colb + bj * 128;
          const u32x4 x0 = ld16(xr), x1 = ld16(xr + 8);
          const f32x16& a = acc[ai][bj][m];
          u32x4 w0, w1;
          w0.x = pk2(bflo(x0.x) + g[0][0] * a[0], bfhi(x0.x) + g[0][1] * a[1]); w0.y = pk2(bflo(x0.y) + g[0][2] * a[2], bfhi(x0.y) + g[0][3] * a[3]);
          w0.z = pk2(bflo(x0.z) + g[1][0] * a[4], bfhi(x0.z) + g[1][1] * a[5]); w0.w = pk2(bflo(x0.w) + g[1][2] * a[6], bfhi(x0.w) + g[1][3] * a[7]);
          w1.x = pk2(bflo(x1.x) + g[2][0] * a[8], bfhi(x1.x) + g[2][1] * a[9]); w1.y = pk2(bflo(x1.y) + g[2][2] * a[10], bfhi(x1.y) + g[2][3] * a[11]);
          w1.z = pk2(bflo(x1.z) + g[3][0] * a[12], bfhi(x1.z) + g[3][1] * a[13]); w1.w = pk2(bflo(x1.w) + g[3][2] * a[14], bfhi(x1.w) + g[3][3] * a[15]);
          if (!DRY) { *(u32x4*)xr = w0; *(u32x4*)(xr + 8) = w1; } else asm volatile("" :: "v"(w0), "v"(w1));
        }
    }
  };
  fg::gemm_phase_f8<false, true>(lds, 512, 512, 512, S, ep);
}

DI void phase_pool_pre(KP p, char* smem) {
  char* const ws = ows(p);
  const int lane = otid() & 63, wid = otid() >> 6;
  const bf16_t* hb = (const bf16_t*)(ws + OFF_H);
  bf16_t* Y = (bf16_t*)(ws + OFF_U + U2_Y);
  const int ch0 = lane * 16, half = 1 << (lane >> 4);
  for (int r = obid() * 8 + wid; r < TT; r += gridDim.x * 8) {
    int s, L;
    if (r < TL) { s = r & 4095; L = 4096; } else { s = (r - TL) & 255; L = 256; }
    const int lo = s - half < 0 ? 0 : s - half, hi = s + half > L ? L : s + half;
    const bf16_t* base = hb + (size_t)(r - s) * DM + ch0;
    float a[16];
#pragma unroll
    for (int j = 0; j < 16; ++j) a[j] = 0.f;
    for (int q = lo; q < hi; ++q) {
      const u32x4 v0 = ld16(base + (size_t)q * DM), v1 = ld16(base + (size_t)q * DM + 8);
      a[0] += bflo(v0.x); a[1] += bfhi(v0.x); a[2] += bflo(v0.y); a[3] += bfhi(v0.y); a[4] += bflo(v0.z); a[5] += bfhi(v0.z); a[6] += bflo(v0.w); a[7] += bfhi(v0.w);
      a[8] += bflo(v1.x); a[9] += bfhi(v1.x); a[10] += bflo(v1.y); a[11] += bfhi(v1.y); a[12] += bflo(v1.z); a[13] += bfhi(v1.z); a[14] += bflo(v1.w); a[15] += bfhi(v1.w);
    }
    const float inv = 1.0f / (float)(hi - lo);
    const u32x4 c0 = ld16(base + (size_t)s * DM), c1 = ld16(base + (size_t)s * DM + 8);
    u32x4 o0, o1;
    o0.x = pk2(a[0] * inv - bflo(c0.x), a[1] * inv - bfhi(c0.x)); o0.y = pk2(a[2] * inv - bflo(c0.y), a[3] * inv - bfhi(c0.y));
    o0.z = pk2(a[4] * inv - bflo(c0.z), a[5] * inv - bfhi(c0.z)); o0.w = pk2(a[6] * inv - bflo(c0.w), a[7] * inv - bfhi(c0.w));
    o1.x = pk2(a[8] * inv - bflo(c1.x), a[9] * inv - bfhi(c1.x)); o1.y = pk2(a[10] * inv - bflo(c1.y), a[11] * inv - bfhi(c1.y));
    o1.z = pk2(a[12] * inv - bflo(c1.z), a[13] * inv - bfhi(c1.z)); o1.w = pk2(a[14] * inv - bflo(c1.w), a[15] * inv - bfhi(c1.w));
    *(u32x4*)(Y + (size_t)r * DM + ch0) = o0; *(u32x4*)(Y + (size_t)r * DM + ch0 + 8) = o1;
  }
}
struct PoolSched {
  const char* A; const char* B; int G, c;
  DI bool next(int i, fg::Unit& u) const {
    const int L = i * G + c; if (L >= (TT / 256) * 4) return false;
    const int pm = L >> 2, g = L & 3;
    u.pm = pm; u.pn = g; u.aux = 0; u.A = A + ((size_t)pm * 256 * 1024 + g * 256) * 2; u.B = B + (size_t)g * 65536 * 2; return true;
  }
  DI const LAS int* rows(int) const { return nullptr; }
};
template <bool DRY = false>
DI void phase_pool(KP p, char* smem) {
  char* const ws = ows(p);
  LAS unsigned char* lds = (LAS unsigned char*)smem;
  const float* pb = gin(p, 16);
  const float* psc = gin(p, 17);
  PoolSched S; S.A = ws + OFF_U + U2_Y; S.B = ws + OFF_WMIX + W_POOL * 2; S.G = gridDim.x; S.c = obid();
  auto ep = [&](const f32x4 (&acc)[2][2][4][2], const fg::Unit& u, int wr, int wc, int fr, int fq) {
    const int row0 = u.pm * 256 + wr * 64 + fr, colb = u.pn * 256 + wc * 32 + 4 * fq;
    const float* g1 = modp(ws, 2, row_bi(row0), 2) + colb;
    f32x4 g[2][2], bb[2][2];
#pragma unroll
    for (int bj = 0; bj < 2; ++bj)
#pragma unroll
      for (int n = 0; n < 2; ++n) {
        const f32x4 s4 = *(const f32x4*)(psc + colb + bj * 128 + n * 16);
        g[bj][n] = *(const f32x4*)(g1 + bj * 128 + n * 16) * s4;
        bb[bj][n] = *(const f32x4*)(pb + colb + bj * 128 + n * 16) * g[bj][n];
      }
    f32x4 xa[2][2], xb[2][2];
    bf16_t* xr = xrow_ptr(p, ws, row0) + colb;
#pragma unroll
    for (int bj = 0; bj < 2; ++bj)
#pragma unroll
      for (int n = 0; n < 2; ++n) xa[bj][n] = ldbf4(xr + bj * 128 + n * 16);
#pragma unroll
    for (int rr = 0; rr < 8; ++rr) {
      const int ai = rr >> 2, m = rr & 3;
      bf16_t* xn = xr;
      if (rr + 1 < 8) {
        xn = xrow_ptr(p, ws, row0 + ((rr + 1) >> 2) * 128 + ((rr + 1) & 3) * 16) + colb;
#pragma unroll
        for (int bj = 0; bj < 2; ++bj)
#pragma unroll
          for (int n = 0; n < 2; ++n) xb[bj][n] = ldbf4(xn + bj * 128 + n * 16);
      }
#pragma unroll
      for (int bj = 0; bj < 2; ++bj)
#pragma unroll
        for (int n = 0; n < 2; ++n) {
          const f32x4 x = xa[bj][n] + (g[bj][n] * acc[ai][bj][m][n] + bb[bj][n]);
          if (!DRY) stbf4(xr + bj * 128 + n * 16, x); else asm volatile("" :: "v"(x[0]), "v"(x[1]), "v"(x[2]), "v"(x[3]));
        }
#pragma unroll
      for (int bj = 0; bj < 2; ++bj)
#pragma unroll
        for (int n = 0; n < 2; ++n) xa[bj][n] = xb[bj][n];
      xr = xn;
    }
  };
  fg::gemm_phase<false>(lds, 256, 1024, 256, S, ep);
}

typedef short v4i16_t __attribute__((ext_vector_type(4)));
DI s16x4 tr_read(const bf16_t* p) { return __builtin_bit_cast(s16x4, __builtin_amdgcn_ds_read_tr16_b64_v4i16((LAS v4i16_t*)p)); }
DI bf16x8 pack8(const f32x16& x, int s) {
  u32x4 q;
  q.x = pk2(x[8 * s + 0], x[8 * s + 1]); q.y = pk2(x[8 * s + 2], x[8 * s + 3]);
  q.z = pk2(x[8 * s + 4], x[8 * s + 5]); q.w = pk2(x[8 * s + 6], x[8 * s + 7]);
  return __builtin_bit_cast(bf16x8, q);
}
template <int DT, int VLD_, bool MASK>
DI void attn_tile(const bf16_t* sK, int kld, const bf16_t* vbase, const bf16x8 (&qf)[4], f32x16 (&Y)[DT], float& m, float& l, int r, int h, int qpos, int kpos0) {
  f32x16 X[2];
#pragma unroll
  for (int sub = 0; sub < 2; ++sub) {
#pragma unroll
    for (int i = 0; i < 16; ++i) X[sub][i] = 0.f;
#pragma unroll
    for (int s = 0; s < 4; ++s) {
      const bf16x8 a = *(const bf16x8*)(sK + (sub * 32 + r) * kld + 16 * s + 8 * h);
      X[sub] = MFMA32(a, qf[s], X[sub]);
    }
  }
  if (MASK) {
#pragma unroll
    for (int sub = 0; sub < 2; ++sub)
#pragma unroll
      for (int i = 0; i < 16; ++i) {
        const int kp = kpos0 + sub * 32 + (i & 3) + 8 * (i >> 2) + 4 * h;
        const int d = qpos - kp;
        if (d > 128 || d < -128) X[sub][i] = -1e30f;
      }
  }
  float mx = m;
#pragma unroll
  for (int sub = 0; sub < 2; ++sub)
#pragma unroll
    for (int i = 0; i < 16; ++i) mx = fmaxf(mx, X[sub][i]);
  mx = fmaxf(mx, __shfl_xor(mx, 32));
  const float alpha = __expf(m - mx);
  m = mx;
  float ps = 0.f;
#pragma unroll
  for (int sub = 0; sub < 2; ++sub)
#pragma unroll
    for (int i = 0; i < 16; ++i) { const float pv = __expf(X[sub][i] - mx); X[sub][i] = pv; ps += pv; }
  l = l * alpha + ps;
#pragma unroll
  for (int dt = 0; dt < DT; ++dt)
#pragma unroll
    for (int i = 0; i < 16; ++i) Y[dt][i] *= alpha;
#pragma unroll
  for (int sub = 0; sub < 2; ++sub)
#pragma unroll
    for (int s = 0; s < 2; ++s) {
      const bf16x8 pf = pack8(X[sub], s);
#pragma unroll
      for (int dt = 0; dt < DT; ++dt) {
        const bf16_t* vp = vbase + (sub * 32 + 16 * s) * VLD_ + dt * 32;
        const s16x4 lo = tr_read(vp), hi = tr_read(vp + 8 * VLD_);
        const bf16x8 vf = __builtin_shufflevector(lo, hi, 0, 1, 2, 3, 4, 5, 6, 7);
        Y[dt] = MFMA32(vf, pf, Y[dt]);
      }
    }
}

constexpr int A0_KLD = 72, A0_VLD = 96;
constexpr int A0_LDS = 64 * A0_KLD * 2 + 64 * A0_VLD * 2;
DI void phase_attn_win(KP p, char* smem) {
  char* const ws = ows(p);
  bf16_t* sK = (bf16_t*)smem;
  bf16_t* sV = sK + 64 * A0_KLD;
  const bf16_t* Q = (const bf16_t*)(ws + OFF_U + U0_Q);
  const bf16_t* Kb = (const bf16_t*)(ws + OFF_U + U0_K);
  const bf16_t* Vb = (const bf16_t*)(ws + OFF_U + U0_V);
  bf16_t* O = (bf16_t*)(ws + OFF_U + U0_O);
  const float* sink = gin(p, 9);
  const int tid = otid(), lane = tid & 63, wid = tid >> 6, r = lane & 31, h = lane >> 5;
  const bf16_t* vbase = sV + (4 * h + ((lane & 15) >> 2)) * A0_VLD + 16 * ((lane >> 4) & 1) + 4 * (lane & 3);
  const int NLAT = 16 * 4 * 32 * 2, NCTX = 16 * 16;
  for (int it = obid(); it < NLAT + NCTX; it += gridDim.x) {
    const bool lat = it < NLAT;
    int b, kvh, qb = 0, head, qrow, qpos;
    if (lat) {
      b = it >> 8; kvh = (it >> 6) & 3; qb = (it >> 1) & 31; const int hp = it & 1;
      head = kvh * 4 + hp * 2 + (wid >> 2);
      qpos = qb * 128 + (wid & 3) * 32 + r; qrow = b * 4096 + qpos;
    } else {
      const int i2 = it - NLAT; b = i2 >> 4; head = i2 & 15; kvh = head >> 2;
      qpos = wid * 32 + r; qrow = TL + b * 256 + qpos;
    }
    bf16x8 qf[4];
#pragma unroll
    for (int s = 0; s < 4; ++s) qf[s] = *(const bf16x8*)(Q + (size_t)qrow * DM + head * 64 + 16 * s + 8 * h);
    f32x16 Y[2];
#pragma unroll
    for (int dt = 0; dt < 2; ++dt)
#pragma unroll
      for (int i = 0; i < 16; ++i) Y[dt][i] = 0.f;
    float m = sink[head], l = h == 0 ? 1.0f : 0.0f;
    const int kr = tid >> 3, k8 = (tid & 7) * 8;
    auto tile_ok = [&](int t) -> bool { if (t >= 6) return true; if (!lat) return false; const int kt = 2 * qb - 2 + t; return kt >= 0 && kt < 64; };
    auto trow = [&](int t) -> size_t { return t < 6 ? (size_t)b * 4096 + (2 * qb - 2 + t) * 64 + kr : (size_t)TL + b * 256 + (t - 6) * 64 + kr; };
    int t = 0;
    while (t < 10 && !tile_ok(t)) ++t;
    u32x4 rk = ld16(Kb + trow(t) * 256 + kvh * 64 + k8), rv = ld16(Vb + trow(t) * 256 + kvh * 64 + k8);
    while (t < 10) {
      __syncthreads();
      *(u32x4*)(sK + kr * A0_KLD + k8) = rk;
      *(u32x4*)(sV + kr * A0_VLD + k8) = rv;
      __syncthreads();
      int tn = t + 1;
      while (tn < 10 && !tile_ok(tn)) ++tn;
      if (tn < 10) { rk = ld16(Kb + trow(tn) * 256 + kvh * 64 + k8); rv = ld16(Vb + trow(tn) * 256 + kvh * 64 + k8); }
      if (t < 6) attn_tile<2, A0_VLD, true>(sK, A0_KLD, vbase, qf, Y, m, l, r, h, qpos, (2 * qb - 2 + t) * 64);
      else attn_tile<2, A0_VLD, false>(sK, A0_KLD, vbase, qf, Y, m, l, r, h, 0, 0);
      t = tn;
    }
    const float lt = l + __shfl_xor(l, 32);
    const float inv = 1.0f / lt;
#pragma unroll
    for (int dt = 0; dt < 2; ++dt)
#pragma unroll
      for (int g = 0; g < 4; ++g) {
        const float i8 = inv * O8_SCALE;
        *(unsigned*)((unsigned char*)O + (size_t)qrow * DM + head * 64 + dt * 32 + 8 * g + 4 * h) = pk4_fp8(Y[dt][4 * g] * i8, Y[dt][4 * g + 1] * i8, Y[dt][4 * g + 2] * i8, Y[dt][4 * g + 3] * i8);
      }
  }
}

constexpr int A1_KLD = 136, A1_VLD = 160;
constexpr int A1_K8LD = 144;
constexpr int A1_V8LD = 80;
constexpr int A1_KB = 64 * A1_K8LD, A1_VB = 128 * A1_V8LD;
constexpr int A1_LDS = 2 * A1_KB + 2 * A1_VB + 4 * 128 * 32 * 4;
DI void qk_tile(const bf16_t* sK, int kld, const bf16x8 (&qf)[4], f32x16 (&X)[2], int r, int h) {
  bf16x8 kf[2][4];
#pragma unroll
  for (int sub = 0; sub < 2; ++sub)
#pragma unroll
    for (int s = 0; s < 4; ++s) kf[sub][s] = *(const bf16x8*)(sK + (sub * 32 + r) * kld + 16 * s + 8 * h);
#pragma unroll
  for (int sub = 0; sub < 2; ++sub) {
#pragma unroll
    for (int i = 0; i < 16; ++i) X[sub][i] = 0.f;
#pragma unroll
    for (int s = 0; s < 4; ++s) X[sub] = MFMA32(kf[sub][s], qf[s], X[sub]);
  }
}
typedef int v8i_t __attribute__((ext_vector_type(8)));
typedef int v4i_t __attribute__((ext_vector_type(4)));
DI void qk8_tile(const unsigned char* sK8, int kld8, const v8i_t& q8, f32x16 (&X)[2], int r, int h) {
  v8i_t kf[2];
#pragma unroll
  for (int sub = 0; sub < 2; ++sub) { const v4i_t* q_ = (const v4i_t*)(sK8 + (sub * 32 + r) * kld8 + 32 * h); kf[sub] = __builtin_shufflevector(q_[0], q_[1], 0, 1, 2, 3, 4, 5, 6, 7); }
#pragma unroll
  for (int sub = 0; sub < 2; ++sub) {
    f32x16 z;
#pragma unroll
    for (int i = 0; i < 16; ++i) z[i] = 0.f;
    X[sub] = __builtin_amdgcn_mfma_scale_f32_32x32x64_f8f6f4(kf[sub], q8, z, 0, 0, 0, 0x7f7f7f7f, 0, 0x7f7f7f7f);
  }
}
template <int DT, int QSC = 1, int PSH = 0>
DI void softmax_lazy(f32x16 (&X)[2], f32x16 (&Y)[DT], float& m, float& l) {
  constexpr float THR = 4.0f * QSC, L2E = 1.44269504089f / QSC;
  float c0 = X[0][0], c1 = X[0][1], c2 = X[0][2], c3 = X[0][3];
#pragma unroll
  for (int i = 4; i < 16; i += 4) { c0 = fmaxf(c0, X[0][i]); c1 = fmaxf(c1, X[0][i + 1]); c2 = fmaxf(c2, X[0][i + 2]); c3 = fmaxf(c3, X[0][i + 3]); }
#pragma unroll
  for (int i = 0; i < 16; i += 4) { c0 = fmaxf(c0, X[1][i]); c1 = fmaxf(c1, X[1][i + 1]); c2 = fmaxf(c2, X[1][i + 2]); c3 = fmaxf(c3, X[1][i + 3]); }
  float mx = fmaxf(fmaxf(c0, c1), fmaxf(c2, c3));
  { float a, b; swap32(mx, a, b); mx = fmaxf(a, b); }
  if (__builtin_amdgcn_ballot_w64(mx > m + THR) != 0ull) {
    const float mn = fmaxf(m, mx);
    const float alpha = __builtin_amdgcn_exp2f((m - mn) * L2E);
    m = mn; l *= alpha;
#pragma unroll
    for (int dt = 0; dt < DT; ++dt)
#pragma unroll
      for (int i = 0; i < 16; ++i) Y[dt][i] *= alpha;
  }
  const float nm = fmaf(-m, L2E, (float)PSH);
  float ps0 = 0.f, ps1 = 0.f, ps2 = 0.f, ps3 = 0.f;
#pragma unroll
  for (int sub = 0; sub < 2; ++sub)
#pragma unroll
    for (int i = 0; i < 16; i += 4) {
      const float p0 = __builtin_amdgcn_exp2f(fmaf(X[sub][i], L2E, nm)), p1 = __builtin_amdgcn_exp2f(fmaf(X[sub][i + 1], L2E, nm));
      const float p2 = __builtin_amdgcn_exp2f(fmaf(X[sub][i + 2], L2E, nm)), p3 = __builtin_amdgcn_exp2f(fmaf(X[sub][i + 3], L2E, nm));
      X[sub][i] = p0; X[sub][i + 1] = p1; X[sub][i + 2] = p2; X[sub][i + 3] = p3;
      asm("v_add_f32 %0, %1, %0" : "+v"(ps0) : "v"(p0));
      asm("v_add_f32 %0, %1, %0" : "+v"(ps1) : "v"(p1));
      asm("v_add_f32 %0, %1, %0" : "+v"(ps2) : "v"(p2));
      asm("v_add_f32 %0, %1, %0" : "+v"(ps3) : "v"(p3));
    }
  asm("v_add_f32 %0, %1, %0" : "+v"(ps0) : "v"(ps1));
  asm("v_add_f32 %0, %1, %0" : "+v"(ps2) : "v"(ps3));
  l += ps0 + ps2;
}
template <int DT, int VLD_>
DI void pv_tile(const f32x16 (&X)[2], const bf16_t* vbase, f32x16 (&Y)[DT]) {
#pragma unroll
  for (int sub = 0; sub < 2; ++sub)
#pragma unroll
    for (int s = 0; s < 2; ++s) {
      const bf16x8 pf = pack8(X[sub], s);
#pragma unroll
      for (int dt = 0; dt < DT; ++dt) {
        const bf16_t* vp = vbase + (sub * 32 + 16 * s) * VLD_ + dt * 32;
        const s16x4 lo = tr_read(vp), hi = tr_read(vp + 8 * VLD_);
        const bf16x8 vf = __builtin_shufflevector(lo, hi, 0, 1, 2, 3, 4, 5, 6, 7);
        Y[dt] = MFMA32(vf, pf, Y[dt]);
      }
    }
}
DI void phase_attn_diff(KP p, char* smem) {
  char* const ws = ows(p);
  unsigned char* sK = (unsigned char*)smem;
  unsigned char* sV = (unsigned char*)(smem + 2 * A1_KB);
  float* comb = (float*)(smem + 2 * A1_KB + 2 * A1_VB);
  const bf16_t* Q = (const bf16_t*)(ws + OFF_U + U1_Q);
  const unsigned char* K8 = (const unsigned char*)(ws + OFF_U + U1_K);
  const unsigned char* Vt = (const unsigned char*)(ws + OFF_U + U1_V);
  bf16_t* O = (bf16_t*)(ws + OFF_U + U1_O);
  const int tid = otid(), lane = tid & 63, wid = tid >> 6, r = lane & 31, h = lane >> 5, grp = wid >> 2;
  const float lambda_init = 0.8f - 0.6f * 0.74081822068f;
  float lam_full;
  {
    const float* lf = gin(p, 12);
    float s1 = 0.f, s2 = 0.f;
    for (int i = 0; i < 64; ++i) { s1 += lf[i] * lf[64 + i]; s2 += lf[128 + i] * lf[192 + i]; }
    lam_full = expf(s1) - expf(s2) + lambda_init;
  }
  const float* subg = gin(p, 13);
  const int NLAT = 16 * 8 * 32, NCTX = 16 * 8 * 2;
  const int kr = tid >> 3, kc = (tid & 7) * 16;
  for (int it = obid(); it < NLAT + NCTX; it += gridDim.x) {
    const bool lat = it < NLAT;
    int b, head, qrow, t0;
    const int nt = 68;
    if (lat) { b = it >> 8; head = (it >> 5) & 7; const int qb = it & 31; qrow = b * 4096 + qb * 128 + (wid & 3) * 32 + r; t0 = 0; }
    else { const int i2 = it - NLAT; b = i2 >> 4; head = (i2 >> 1) & 7; const int hf = i2 & 1; qrow = TL + b * 256 + hf * 128 + (wid & 3) * 32 + r; t0 = 64; }
    v8i_t q8;
    {
      const bf16_t* qp = Q + (size_t)qrow * DM + head * 128 + grp * 64 + 32 * h;
#pragma unroll
      for (int c4 = 0; c4 < 4; ++c4) {
        const u32x4 w = ld16(qp + 8 * c4);
        q8[2 * c4] = (int)pk4_fp8(bflo(w.x) * 8.f, bfhi(w.x) * 8.f, bflo(w.y) * 8.f, bfhi(w.y) * 8.f);
        q8[2 * c4 + 1] = (int)pk4_fp8(bflo(w.z) * 8.f, bfhi(w.z) * 8.f, bflo(w.w) * 8.f, bfhi(w.w) * 8.f);
      }
    }
    f32x16 Y[4];
#pragma unroll
    for (int dt = 0; dt < 4; ++dt)
#pragma unroll
      for (int i = 0; i < 16; ++i) Y[dt][i] = 0.f;
    float m = -1e30f, l = 0.f;
    auto goff = [&](int t) -> size_t { return (t < 64 ? (size_t)b * 4096 + t * 64 + kr : (size_t)TL + b * 256 + (t - 64) * 64 + kr) * 1024 + head * 128 + kc; };
    auto stK = [&](int t, const u32x4& a) { *(u32x4*)(sK + (t & 1) * A1_KB + kr * A1_K8LD + kc) = a; };
    const int vd = tid >> 2, vcx = (tid & 3) * 16;
    auto voff = [&](int t) -> size_t { return t < 64 ? ((size_t)(b * 1024 + head * 128 + vd) * 4096 + (size_t)t * 64 + vcx) : ((size_t)16 * 1024 * 4096 + (size_t)(b * 1024 + head * 128 + vd) * 256 + (size_t)(t - 64) * 64 + vcx); };
    auto stV = [&](int t, const u32x4& a) { *(u32x4*)(sV + (t & 1) * A1_VB + vd * A1_V8LD + vcx) = a; };
    u32x4 rk0, rv0;
    __syncthreads();
    rk0 = *(const u32x4*)(K8 + goff(t0)); stK(t0, rk0);
    rk0 = *(const u32x4*)(K8 + goff(t0 + 1)); stK(t0 + 1, rk0);
    rk0 = *(const u32x4*)(K8 + goff(t0 + 2));
    rv0 = *(const u32x4*)(Vt + voff(t0));
    __syncthreads();
    f32x16 Xn[2];
    qk8_tile(sK + (t0 & 1) * A1_KB + grp * 64, A1_K8LD, q8, Xn, r, h);
    __syncthreads();
    v8i_t p8;
    auto pv8 = [&](int t) __attribute__((always_inline)) {
      const unsigned char* vb8 = sV + (t & 1) * A1_VB + r * A1_V8LD + 32 * h;
#pragma unroll
      for (int dt = 0; dt < 4; ++dt) {
        const v4i_t* q_ = (const v4i_t*)(vb8 + dt * 32 * A1_V8LD);
        const v8i_t vf = __builtin_shufflevector(q_[0], q_[1], 0, 1, 2, 3, 4, 5, 6, 7);
        Y[dt] = __builtin_amdgcn_mfma_scale_f32_32x32x64_f8f6f4(vf, p8, Y[dt], 0, 0, 0, 0x7f7f7f7f, 0, 0x7f7f7f7f);
      }
    };
    for (int t = t0; t < nt; ++t) {
      if (t + 2 < nt) stK(t + 2, rk0);
      stV(t, rv0);
      if (t + 3 < nt) rk0 = *(const u32x4*)(K8 + goff(t + 3));
      if (t + 1 < nt) rv0 = *(const u32x4*)(Vt + voff(t + 1));
      f32x16 X[2];
      X[0] = Xn[0]; X[1] = Xn[1];
      if (t + 1 < nt) qk8_tile(sK + ((t + 1) & 1) * A1_KB + grp * 64, A1_K8LD, q8, Xn, r, h);
      if (t > t0) pv8(t - 1);
      softmax_lazy<4, 8, 2>(X, Y, m, l);
#pragma unroll
      for (int sub = 0; sub < 2; ++sub)
#pragma unroll
        for (int g4 = 0; g4 < 4; ++g4) p8[4 * sub + g4] = (int)pk4_fp8_nc(X[sub][4 * g4], X[sub][4 * g4 + 1], X[sub][4 * g4 + 2], X[sub][4 * g4 + 3]);
      __syncthreads();
    }
    pv8(nt - 1);
    const float lt = l + __shfl_xor(l, 32);
    const float inv = 1.0f / lt;
    if (grp == 1) {
#pragma unroll
      for (int dt = 0; dt < 4; ++dt)
#pragma unroll
        for (int i = 0; i < 16; ++i) comb[(((wid & 3) * 128) + dt * 32 + (i & 3) + 8 * (i >> 2) + 4 * h) * 32 + r] = Y[dt][i] * inv;
    }
    __syncthreads();
    if (grp == 0) {
      float ss = 0.f;
#pragma unroll
      for (int dt = 0; dt < 4; ++dt)
#pragma unroll
        for (int i = 0; i < 16; ++i) {
          const float o2 = comb[(((wid & 3) * 128) + dt * 32 + (i & 3) + 8 * (i >> 2) + 4 * h) * 32 + r];
          const float vv = Y[dt][i] * inv - lam_full * o2;
          Y[dt][i] = vv; ss += vv * vv;
        }
      ss += __shfl_xor(ss, 32);
      const float rs = rsqrtf(ss * (1.0f / 128.0f) + 1e-6f) * (1.0f - lambda_init);
#pragma unroll
      for (int dt = 0; dt < 4; ++dt)
#pragma unroll
        for (int g = 0; g < 4; ++g) {
          const int d0 = dt * 32 + 8 * g + 4 * h;
          const f32x4 sg = *(const f32x4*)(subg + d0);
          const float r8 = rs * O8_SCALE;
          *(unsigned*)((unsigned char*)O + (size_t)qrow * DM + head * 128 + d0) = pk4_fp8(Y[dt][4 * g] * r8 * sg[0], Y[dt][4 * g + 1] * r8 * sg[1], Y[dt][4 * g + 2] * r8 * sg[2], Y[dt][4 * g + 3] * r8 * sg[3]);
        }
    }
  }
}

DI u32x4 rwkv_mix_load(const bf16_t* hb, const float* mu, int mixi, int row, int k) {
  int s, L;
  if (row < TL) { s = row & 4095; L = 4096; } else { s = (row - TL) & 255; L = 256; }
  const bf16_t* hp = hb + (size_t)row * DM + k;
  const u32x4 c = ld16(hp);
  u32x4 pv = (u32x4){0u, 0u, 0u, 0u}, nx = (u32x4){0u, 0u, 0u, 0u};
  if (s > 0) pv = ld16(hp - DM);
  if (s < L - 1) nx = ld16(hp + DM);
  const float* m0 = mu + (size_t)(0 * 6 + mixi) * DM + k;
  const float* m1 = mu + (size_t)(1 * 6 + mixi) * DM + k;
  const f32x4 a0 = *(const f32x4*)m0, a1 = *(const f32x4*)(m0 + 4), b0 = *(const f32x4*)m1, b1 = *(const f32x4*)(m1 + 4);
  float cv[8] = {bflo(c.x), bfhi(c.x), bflo(c.y), bfhi(c.y), bflo(c.z), bfhi(c.z), bflo(c.w), bfhi(c.w)};
  float pvv[8] = {bflo(pv.x), bfhi(pv.x), bflo(pv.y), bfhi(pv.y), bflo(pv.z), bfhi(pv.z), bflo(pv.w), bfhi(pv.w)};
  float nv[8] = {bflo(nx.x), bfhi(nx.x), bflo(nx.y), bfhi(nx.y), bflo(nx.z), bfhi(nx.z), bflo(nx.w), bfhi(nx.w)};
  float mu0[8] = {a0[0], a0[1], a0[2], a0[3], a1[0], a1[1], a1[2], a1[3]};
  float mu1[8] = {b0[0], b0[1], b0[2], b0[3], b1[0], b1[1], b1[2], b1[3]};
  float o[8];
#pragma unroll
  for (int j = 0; j < 8; ++j) o[j] = cv[j] + (pvv[j] - cv[j]) * mu0[j] + (nv[j] - cv[j]) * mu1[j];
  u32x4 w; w.x = pk2(o[0], o[1]); w.y = pk2(o[2], o[3]); w.z = pk2(o[4], o[5]); w.w = pk2(o[6], o[7]);
  return w;
}
template <int ACT  , class AL>
DI void rwkv_gemm_tile(char* smem, AL la, const bf16_t* Bt, int K, int ldb, bf16_t* dst, int ldd, int row0, int col0, int ncols_valid) {
  auto lb = [&](int tn, int k) -> u32x4 { return (col0 + tn) < ncols_valid ? ld16(Bt + (size_t)(col0 + tn) * ldb + k) : (u32x4){0u, 0u, 0u, 0u}; };
  auto ep = [&](const f32x4 (&acc)[4][2], int r0, int c0, int fr, int fq) {
#pragma unroll
    for (int m = 0; m < 4; ++m)
#pragma unroll
      for (int n = 0; n < 2; ++n)
#pragma unroll
        for (int j = 0; j < 4; ++j) {
          const int row = row0 + r0 + m * 16 + fq * 4 + j, col = col0 + c0 + n * 16 + fr;
          float v = acc[m][n][j];
          if (ACT == 1) v = 1.0f - 2.0f * __builtin_amdgcn_rcpf(1.0f + __expf(2.0f * v));
          if (ACT == 2) v = sigmoidf_(v);
          if (col < ncols_valid) dst[(size_t)row * ldd + col] = f2bf(v);
        }
  };
  sgemm_tile(smem, K, la, lb, ep);
}
DI void phase_rwkv_mix(KP p, char* smem) {
  char* const ws = ows(p);
  const int lane = otid() & 63, wid = otid() >> 6;
  const bf16_t* hb = (const bf16_t*)(ws + OFF_H);
  const float* mu = gin(p, 18);
  bf16_t* XR = (bf16_t*)(ws + OFF_U + U3_XR);
  bf16_t* XK = (bf16_t*)(ws + OFF_U + U3_XK);
  bf16_t* XV = (bf16_t*)(ws + OFF_U + U3_XV);
  const int ch0 = lane * 16;
  for (int r = obid() * 8 + wid; r < TT; r += gridDim.x * 8) {
    int s, L;
    if (r < TL) { s = r & 4095; L = 4096; } else { s = (r - TL) & 255; L = 256; }
    const bf16_t* hp = hb + (size_t)r * DM + ch0;
    float c[16], pv[16], nx[16];
    {
      const u32x4 a = ld16(hp), b = ld16(hp + 8);
      c[0] = bflo(a.x); c[1] = bfhi(a.x); c[2] = bflo(a.y); c[3] = bfhi(a.y); c[4] = bflo(a.z); c[5] = bfhi(a.z); c[6] = bflo(a.w); c[7] = bfhi(a.w);
      c[8] = bflo(b.x); c[9] = bfhi(b.x); c[10] = bflo(b.y); c[11] = bfhi(b.y); c[12] = bflo(b.z); c[13] = bfhi(b.z); c[14] = bflo(b.w); c[15] = bfhi(b.w);
    }
#pragma unroll
    for (int j = 0; j < 16; ++j) { pv[j] = 0.f; nx[j] = 0.f; }
    if (s > 0) {
      const u32x4 a = ld16(hp - DM), b = ld16(hp - DM + 8);
      pv[0] = bflo(a.x); pv[1] = bfhi(a.x); pv[2] = bflo(a.y); pv[3] = bfhi(a.y); pv[4] = bflo(a.z); pv[5] = bfhi(a.z); pv[6] = bflo(a.w); pv[7] = bfhi(a.w);
      pv[8] = bflo(b.x); pv[9] = bfhi(b.x); pv[10] = bflo(b.y); pv[11] = bfhi(b.y); pv[12] = bflo(b.z); pv[13] = bfhi(b.z); pv[14] = bflo(b.w); pv[15] = bfhi(b.w);
    }
    if (s < L - 1) {
      const u32x4 a = ld16(hp + DM), b = ld16(hp + DM + 8);
      nx[0] = bflo(a.x); nx[1] = bfhi(a.x); nx[2] = bflo(a.y); nx[3] = bfhi(a.y); nx[4] = bflo(a.z); nx[5] = bfhi(a.z); nx[6] = bflo(a.w); nx[7] = bfhi(a.w);
      nx[8] = bflo(b.x); nx[9] = bfhi(b.x); nx[10] = bflo(b.y); nx[11] = bfhi(b.y); nx[12] = bflo(b.z); nx[13] = bfhi(b.z); nx[14] = bflo(b.w); nx[15] = bfhi(b.w);
    }
#pragma unroll
    for (int q = 0; q < 3; ++q) {
      const int mixi = q == 0 ? 0 : q + 1;
      if (q == 0 && r >= TL) continue;
      unsigned char* dst = (unsigned char*)(q == 0 ? XR : q == 1 ? XK : XV) + (size_t)r * DM + ch0;
      const float* m0 = mu + (size_t)(0 * 6 + mixi) * DM + ch0;
      const float* m1 = mu + (size_t)(1 * 6 + mixi) * DM + ch0;
      float o[16];
#pragma unroll
      for (int j4 = 0; j4 < 4; ++j4) {
        const f32x4 a = *(const f32x4*)(m0 + 4 * j4), b = *(const f32x4*)(m1 + 4 * j4);
#pragma unroll
        for (int j = 0; j < 4; ++j) { const int k = 4 * j4 + j; o[k] = c[k] + (pv[k] - c[k]) * a[j] + (nx[k] - c[k]) * b[j]; }
      }
      u32x4 w0;
      w0.x = pk4_fp8(o[0] * X8_SCALE, o[1] * X8_SCALE, o[2] * X8_SCALE, o[3] * X8_SCALE); w0.y = pk4_fp8(o[4] * X8_SCALE, o[5] * X8_SCALE, o[6] * X8_SCALE, o[7] * X8_SCALE);
      w0.z = pk4_fp8(o[8] * X8_SCALE, o[9] * X8_SCALE, o[10] * X8_SCALE, o[11] * X8_SCALE); w0.w = pk4_fp8(o[12] * X8_SCALE, o[13] * X8_SCALE, o[14] * X8_SCALE, o[15] * X8_SCALE);
      *(u32x4*)dst = w0;
    }
  }
}
struct RkvSched {
  const char* X0; const char* X1; const char* X2; const char* W; int G, c;
  DI bool next(int i, fg::Unit& u) const {
    int pmg, pn; if (!fg::static_order(i, G, c, 800, 4, pmg, pn)) return false;
    const int job = (pmg >= 256) + (pmg >= 528);
    u.pm = pmg - (job ? 256 + (job - 1) * 272 : 0); u.pn = pn; u.aux = job;
    u.A = X0 + (size_t)job * SZ_TT + (size_t)u.pm * 256 * 1024;
    u.B = W + (size_t)job * 1024 * 1024 * 2 + (size_t)u.pn * 256 * 1024; return true;
  }
  DI const LAS int* rows(int) const { return nullptr; }
};
DI void phase_rwkv_rkv(KP p, char* smem) {
  char* const ws = ows(p);
  LAS unsigned char* lds = (LAS unsigned char*)smem;
  char* U = ws + OFF_U;
  RkvSched S; S.X0 = U + U3_XR; S.X1 = U + U3_XK; S.X2 = U + U3_XV; S.W = ws + OFF_WMIX + W_R * 2; S.G = gridDim.x; S.c = obid();
  auto ep = [&](const f32x16 (&acc)[2][2][2], const fg::Unit& u, int wr, int wc, int r, int h) {
    bf16_t* dst = (bf16_t*)(U + (u.aux ? SZ_TL + (size_t)(u.aux - 1) * SZ_TT : (size_t)0));
    constexpr float inv = 1.0f / (X8_SCALE * 32.0f);
#pragma unroll
    for (int ai = 0; ai < 2; ++ai)
#pragma unroll
      for (int m = 0; m < 2; ++m) {
        const size_t row = (size_t)u.pm * 256 + ai * 128 + wr * 64 + m * 32 + r;
#pragma unroll
        for (int bj = 0; bj < 2; ++bj) {
          const f32x16& a = acc[ai][bj][m];
          u32x4 w0, w1;
          w0.x = pk2(a[0] * inv, a[1] * inv); w0.y = pk2(a[2] * inv, a[3] * inv); w0.z = pk2(a[4] * inv, a[5] * inv); w0.w = pk2(a[6] * inv, a[7] * inv);
          w1.x = pk2(a[8] * inv, a[9] * inv); w1.y = pk2(a[10] * inv, a[11] * inv); w1.z = pk2(a[12] * inv, a[13] * inv); w1.w = pk2(a[14] * inv, a[15] * inv);
          bf16_t* q = dst + row * DM + u.pn * 256 + bj * 128 + wc * 32 + 16 * h;
          *(u32x4*)q = w0; *(u32x4*)(q + 8) = w1;
        }
      }
  };
  fg::gemm_phase_f8<false, true>(lds, 512, 512, 512, S, ep);
}

DI void phase_rwkv_feat1(KP p, char* smem) {
  char* const ws = ows(p);
  const bf16_t* hb = (const bf16_t*)(ws + OFF_H);
  const bf16_t* wm = (const bf16_t*)(ws + OFF_WMIX);
  const float* mu = gin(p, 18);
  char* U = ws + OFF_U;
  const int n3 = 544, n4 = n3 + 544, n5 = n4 + 512;
  for (int t = obid(); t < n5; t += gridDim.x) {
    if (t < n3) {
      const int row0 = t * 128;
      auto la = [&](int trow, int k) -> u32x4 { return rwkv_mix_load(hb, mu, 1, row0 + trow, k); };
      rwkv_gemm_tile<1>(smem, la, wm + W_WA1, 1024, 1024, (bf16_t*)(U + U3_LW), 128, row0, 0, 128);
    } else if (t < n4) {
      const int row0 = (t - n3) * 128;
      auto la = [&](int trow, int k) -> u32x4 { return rwkv_mix_load(hb, mu, 4, row0 + trow, k); };
      rwkv_gemm_tile<0>(smem, la, wm + W_AA1, 1024, 1024, (bf16_t*)(U + U3_LA), 128, row0, 0, 128);
    } else {
      const int row0 = (t - n4) * 128;
      auto la = [&](int trow, int k) -> u32x4 { return rwkv_mix_load(hb, mu, 5, row0 + trow, k); };
      rwkv_gemm_tile<2>(smem, la, wm + W_G1, 1024, 1024, (bf16_t*)(U + U3_LG), 128, row0, 0, 128);
    }
  }
}
struct Feat2Sched {
  const char* U; const char* W; int G, c;
  DI bool next(int i, fg::Unit& u) const {
    const int L = i * G + c; if (L >= 2176 + 2176 + 1024) return false;
    const int job = (L >= 2176) + (L >= 4352), loc = L - job * 2176;
    if (job < 2) { u.pm = loc >> 3; u.pn = loc & 7; } else { u.pm = loc >> 2; u.pn = loc & 3; }
    u.aux = job;
    u.A = U + (job == 0 ? U3_LW : job == 1 ? U3_LA : U3_LG) + (size_t)u.pm * 256 * 128 * 2;
    u.B = W + ((job == 0 ? W_WA2 : job == 1 ? W_AA2 : W_G2) + (size_t)u.pn * 256 * 128) * 2; return true;
  }
  DI const LAS int* rows(int) const { return nullptr; }
};
DI void phase_rwkv_feat2(KP p, char* smem) {
  char* const ws = ows(p);
  LAS unsigned char* lds = (LAS unsigned char*)smem;
  char* U = ws + OFF_U;
  Feat2Sched S; S.U = U; S.W = ws + OFF_WMIX; S.G = gridDim.x; S.c = obid();
  const float* w0 = gin(p, 20);
  const float* a0 = gin(p, 23);
  auto ep = [&](const f32x4 (&acc)[2][2][4][2], const fg::Unit& u, int wr, int wc, int fr, int fq) {
    const int job = u.aux, d = u.pn >> 2;
    const int colu = (job < 2 ? (u.pn & 3) : u.pn) * 256 + wc * 32 + 8 * fq;
    bf16_t* dst = (bf16_t*)(U + (job == 0 ? (d ? U3_LD1 : U3_LD0) : job == 1 ? (d ? U3_A1 : U3_A0) : U3_G));
    const float* bias = (job == 0 ? w0 : a0) + d * 1024;
#pragma unroll
    for (int ai = 0; ai < 2; ++ai)
#pragma unroll
      for (int m = 0; m < 4; ++m) {
        const size_t row = (size_t)u.pm * 256 + ai * 128 + wr * 64 + m * 16 + fr;
#pragma unroll
        for (int bj = 0; bj < 2; ++bj) {
          f32x4 x0 = acc[ai][bj][m][0], x1 = acc[ai][bj][m][1];
          if (job < 2) {
            const f32x4 b0 = *(const f32x4*)(bias + colu + bj * 128), b1 = *(const f32x4*)(bias + colu + bj * 128 + 4);
            const float sc_ = job == 0 ? -0.60653065971f : 1.0f;
#pragma unroll
            for (int j = 0; j < 4; ++j) { x0[j] = sc_ * sigmoidf_(x0[j] + b0[j]); x1[j] = sc_ * sigmoidf_(x1[j] + b1[j]); }
          }
          u32x4 w; w.x = pk2(x0[0], x0[1]); w.y = pk2(x0[2], x0[3]); w.z = pk2(x1[0], x1[1]); w.w = pk2(x1[2], x1[3]);
          *(u32x4*)(dst + row * DM + colu + bj * 128) = w;
        }
      }
  };
  fg::gemm_phase<false, true>(lds, 128, 128, 128, S, ep);
}

constexpr int C3_L = 32, C3_LDK = 72, C3_LDT = 40, C3_LDY = 36;
constexpr int C3_BT = 0, C3_RT = 4608, C3_KT = 9216, C3_CT = 13824, C3_KHT = 18432, C3_CHT = 23552, C3_VT = 28672, C3_GKB = 33792, C3_GKR = 36352,
              C3_GCR = 38912, C3_S0 = 41472, C3_U = 50688, C3_MCB = 55808, C3_Y = 59904, C3_E = 69120, C3_TOT = 69376, C3_SCAN = 70400;
constexpr int SC_LDS = 2 * C3_SCAN;
DI void lds_bar() { asm volatile("s_waitcnt lgkmcnt(0)" ::: "memory"); __builtin_amdgcn_s_barrier(); asm volatile("" ::: "memory"); }
#define DPP_ADD(s, ctrl) ((s) + __builtin_bit_cast(float, __builtin_amdgcn_update_dpp(0, __builtin_bit_cast(int, (s)), (ctrl), 0xF, 0xF, true)))
DI float wave_sum_dpp(float s) {
  s = DPP_ADD(s, 0xB1); s = DPP_ADD(s, 0x4E); s = DPP_ADD(s, 0x141); s = DPP_ADD(s, 0x140);
  const int si = __builtin_bit_cast(int, s);
  const float a0 = __builtin_bit_cast(float, __builtin_amdgcn_readlane(si, 0)), a1 = __builtin_bit_cast(float, __builtin_amdgcn_readlane(si, 16));
  const float a2 = __builtin_bit_cast(float, __builtin_amdgcn_readlane(si, 32)), a3 = __builtin_bit_cast(float, __builtin_amdgcn_readlane(si, 48));
  return (a0 + a1) + (a2 + a3);
}
DI void phase_rwkv_scan(KP p, char* smem) {
  char* const ws = ows(p);
  const int tid = otid(), lane = tid & 63, wid = tid >> 6, sc = wid >> 2, w4 = wid & 3, r = lane & 31, h = lane >> 5;
  char* sb = smem + sc * C3_SCAN;
  bf16_t* Bt = (bf16_t*)(sb + C3_BT); bf16_t* Rt = (bf16_t*)(sb + C3_RT); bf16_t* Kt = (bf16_t*)(sb + C3_KT); bf16_t* Ct = (bf16_t*)(sb + C3_CT);
  bf16_t* KhT = (bf16_t*)(sb + C3_KHT); bf16_t* ChT = (bf16_t*)(sb + C3_CHT); bf16_t* Vt = (bf16_t*)(sb + C3_VT);
  bf16_t* GkbT = (bf16_t*)(sb + C3_GKB); bf16_t* GkrT = (bf16_t*)(sb + C3_GKR); bf16_t* GcrT = (bf16_t*)(sb + C3_GCR);
  bf16_t* S0b = (bf16_t*)(sb + C3_S0); bf16_t* Ub = (bf16_t*)(sb + C3_U);
  float* McbP = (float*)(sb + C3_MCB); float* Yb = (float*)(sb + C3_Y); float* Eb = (float*)(sb + C3_E); float* Tot = (float*)(sb + C3_TOT);
  char* U = ws + OFF_U;
  const bf16_t* Kx = (const bf16_t*)(U + U3_K);
  const bf16_t* Vx = (const bf16_t*)(U + U3_V);
  const bf16_t* Rx = (const bf16_t*)(U + U3_R);
  const int ti = w4 >> 1, tj = w4 & 1;
  const int tio = w4 & 1;
  const int sv = w4 * 16 + (lane >> 2), jq = lane & 3;
  for (int base = obid() * 2; base < 512; base += gridDim.x * 2) {
    const int item = base + sc, dir = item & 1, head = (item >> 1) & 15, b = item >> 5;
    const bf16_t* Ax = (const bf16_t*)(U + (dir ? U3_A1 : U3_A0));
    const bf16_t* Lx = (const bf16_t*)(U + (dir ? U3_LD1 : U3_LD0));
    bf16_t* Ox = (bf16_t*)(U + (dir ? U3_O1 : U3_O0));
    const int ch = head * 64 + lane;
    const float kkw = gin(p, 28)[ch], kaw = gin(p, 29)[ch];
    auto rowof = [&](int n) -> int {
      if (n < 256) { const int c = dir ? 255 - n : n; return TL + b * 256 + c; }
      const int s = dir ? 4095 - (n - 256) : n - 256; return b * 4096 + s;
    };
    f32x16 S;
#pragma unroll
    for (int i = 0; i < 16; ++i) S[i] = 0.f;
    for (int i = lane; i < 64 * C3_LDK / 4; i += 64) if (w4 == 0) ((unsigned long long*)S0b)[i] = 0ull;
    bf16_t pk_[8], pa_[8], pl_[8], pv_[8], pr_[8];
    auto prefetch = [&](int c) {
#pragma unroll
      for (int q = 0; q < 8; ++q) {
        const int n = c * C3_L + w4 * 8 + q;
        const size_t off = (size_t)rowof(n) * DM + ch;
        pk_[q] = Kx[off]; pa_[q] = Ax[off]; pl_[q] = Lx[off]; pv_[q] = Vx[off];
        pr_[q] = n >= 256 ? Rx[off] : (bf16_t)0;
      }
    };
    constexpr int NCH = 4352 / C3_L;
    prefetch(0);
    lds_bar();
    for (int c = 0; c < NCH; ++c) {
      float kkv[8], cv[8], kdv[8], lv[8], cl[8], rv[8], vv[8];
      {
        float run = 0.f;
#pragma unroll
        for (int q = 0; q < 8; ++q) {
          const float kv = bf2f(pk_[q]), av = bf2f(pa_[q]);
          lv[q] = bf2f(pl_[q]); rv[q] = bf2f(pr_[q]); vv[q] = bf2f(pv_[q]);
          const float kkr = kv * kkw;
          kkv[q] = kkr * __builtin_amdgcn_rsqf(fmaxf(wave_sum_dpp(kkr * kkr), 1e-24f));
          cv[q] = kkv[q] * av;
          kdv[q] = kv * (1.0f + (av - 1.0f) * kaw);
          run += lv[q]; cl[q] = run;
        }
        Tot[w4 * 64 + lane] = run;
      }
      if (c + 1 < NCH) prefetch(c + 1);
      lds_bar();
      {
        const float t0 = Tot[lane], t1 = Tot[64 + lane], t2 = Tot[128 + lane], t3 = Tot[192 + lane];
        const float cumL = (t0 + t1) + (t2 + t3);
        const float off = w4 == 0 ? 0.f : (w4 == 1 ? t0 : (w4 == 2 ? t0 + t1 : (t0 + t1) + t2));
        float kh[8], chh[8];
#pragma unroll
        for (int q = 0; q < 8; ++q) {
          const int t = w4 * 8 + q;
          const float cumt = off + cl[q], cump = cumt - lv[q];
          const float e1 = __expf(cump), e2 = __expf(cumt), e3 = __expf(-cumt), e4 = __expf(cumL - cumt);
          Bt[t * C3_LDK + lane] = f2bf(kkv[q] * e1);
          Rt[t * C3_LDK + lane] = f2bf(rv[q] * e2);
          Kt[t * C3_LDK + lane] = f2bf(kdv[q] * e3);
          Ct[t * C3_LDK + lane] = f2bf(cv[q] * e3);
          kh[q] = kdv[q] * e4; chh[q] = cv[q] * e4;
        }
        u32x4 w;
        w.x = pk2(kh[0], kh[1]); w.y = pk2(kh[2], kh[3]); w.z = pk2(kh[4], kh[5]); w.w = pk2(kh[6], kh[7]);
        *(u32x4*)(KhT + lane * C3_LDT + w4 * 8) = w;
        w.x = pk2(chh[0], chh[1]); w.y = pk2(chh[2], chh[3]); w.z = pk2(chh[4], chh[5]); w.w = pk2(chh[6], chh[7]);
        *(u32x4*)(ChT + lane * C3_LDT + w4 * 8) = w;
        w.x = pk2(vv[0], vv[1]); w.y = pk2(vv[2], vv[3]); w.z = pk2(vv[4], vv[5]); w.w = pk2(vv[6], vv[7]);
        *(u32x4*)(Vt + lane * C3_LDT + w4 * 8) = w;
        if (w4 == 0) Eb[lane] = __expf(cumL);
      }
      lds_bar();
      {
        const bf16_t* Ag = (w4 & 1) ? Kt : Ct;
        const bf16_t* Bg = (w4 & 2) ? Rt : Bt;
        f32x16 X;
#pragma unroll
        for (int i = 0; i < 16; ++i) X[i] = 0.f;
#pragma unroll
        for (int s = 0; s < 4; ++s) {
          const bf16x8 a = *(const bf16x8*)(Ag + r * C3_LDK + 16 * s + 8 * h);
          const bf16x8 bq = *(const bf16x8*)(Bg + r * C3_LDK + 16 * s + 8 * h);
          X = MFMA32(a, bq, X);
        }
        const bool incl = (w4 & 2) != 0;
#pragma unroll
        for (int i = 0; i < 16; ++i) { const int jr = (i & 3) + 8 * (i >> 2) + 4 * h; if (!(jr < r || (incl && jr == r))) X[i] = 0.f; }
        if (w4 == 0) {
#pragma unroll
          for (int i = 0; i < 16; ++i) { const int jr = (i & 3) + 8 * (i >> 2) + 4 * h; McbP[r * 32 + (jr & 3) * 8 + (jr >> 2)] = X[i]; }
        } else {
          bf16_t* G = w4 == 1 ? GkbT : (w4 == 2 ? GcrT : GkrT);
#pragma unroll
          for (int g = 0; g < 4; ++g) { u32x2 w; w.x = pk2(X[4 * g], X[4 * g + 1]); w.y = pk2(X[4 * g + 2], X[4 * g + 3]); *(u32x2*)(G + r * C3_LDT + 8 * g + 4 * h) = w; }
        }
      }
      lds_bar();
      f32x16 XO;
      {
        const bf16_t* Bq = (w4 & 2) ? Rt : Bt;
        const bf16_t* Gq = (w4 & 2) ? GkrT : GkbT;
#pragma unroll
        for (int i = 0; i < 16; ++i) XO[i] = 0.f;
#pragma unroll
        for (int s = 0; s < 4; ++s) {
          const bf16x8 a = *(const bf16x8*)(S0b + (32 * tio + r) * C3_LDK + 16 * s + 8 * h);
          const bf16x8 bq = *(const bf16x8*)(Bq + r * C3_LDK + 16 * s + 8 * h);
          XO = MFMA32(a, bq, XO);
        }
#pragma unroll
        for (int s = 0; s < 2; ++s) {
          const bf16x8 a = *(const bf16x8*)(Vt + (32 * tio + r) * C3_LDT + 16 * s + 8 * h);
          const bf16x8 bq = *(const bf16x8*)(Gq + r * C3_LDT + 16 * s + 8 * h);
          XO = MFMA32(a, bq, XO);
        }
        if (w4 < 2) {
#pragma unroll
          for (int i = 0; i < 16; ++i) Yb[(32 * tio + (i & 3) + 8 * (i >> 2) + 4 * h) * C3_LDY + r] = XO[i];
        }
      }
      lds_bar();
      {
        float u[8];
#pragma unroll
        for (int jj = 0; jj < 8; ++jj) u[jj] = 0.f;
        const unsigned ma = (unsigned)(size_t)(McbP + jq * 8);
        f32x4 yv[8];
#pragma unroll
        for (int i = 0; i < 8; ++i) yv[i] = *(const f32x4*)(Yb + sv * C3_LDY + 4 * i);
        f32x4 mA[4], mB[4];
#define C3_MLOAD(t_) asm volatile("ds_read_b128 %0, %2 offset:%c3\n\tds_read_b128 %1, %2 offset:%c4" : "=&v"(mA[(t_) & 3]), "=&v"(mB[(t_) & 3]) : "v"(ma), "i"((t_) * 128), "i"((t_) * 128 + 16) : "memory")
        C3_MLOAD(1); C3_MLOAD(2); C3_MLOAD(3);
        if (jq == 0) u[0] = yv[0][0];
#pragma unroll
        for (int t = 1; t < 32; ++t) {
          if (t + 3 < 32) { C3_MLOAD(t + 3); asm volatile("s_waitcnt lgkmcnt(6)" ::: "memory"); }
          else if (t + 2 < 32) asm volatile("s_waitcnt lgkmcnt(4)" ::: "memory");
          else if (t + 1 < 32) asm volatile("s_waitcnt lgkmcnt(2)" ::: "memory");
          else asm volatile("s_waitcnt lgkmcnt(0)" ::: "memory");
          asm volatile("" :: "v"(mA[t & 3]), "v"(mB[t & 3]));
          __builtin_amdgcn_sched_barrier(0);
          const f32x4 m0 = mA[t & 3], m1 = mB[t & 3];
          const int jl = (t - 1) >> 2;
          float part = 0.f;
#pragma unroll
          for (int jj = 0; jj < 8; ++jj) if (jj != jl && jj * 4 < t) part += u[jj] * (jj < 4 ? m0[jj] : m1[jj - 4]);
          part += u[jl] * (jl < 4 ? m0[jl] : m1[jl - 4]);
          part = DPP_ADD(part, 0xB1); part = DPP_ADD(part, 0x4E);
          const float ut = yv[t >> 2][t & 3] - part;
          u[t >> 2] = (jq == (t & 3)) ? ut : u[t >> 2];
        }
#undef C3_MLOAD
#pragma unroll
        for (int jj = 0; jj < 8; ++jj) Ub[sv * C3_LDT + jq + 4 * jj] = f2bf(u[jj]);
      }
      lds_bar();
      if (w4 >= 2) {
        f32x16 X2;
#pragma unroll
        for (int i = 0; i < 16; ++i) X2[i] = 0.f;
#pragma unroll
        for (int s = 0; s < 2; ++s) {
          const bf16x8 a = *(const bf16x8*)(Ub + (32 * tio + r) * C3_LDT + 16 * s + 8 * h);
          const bf16x8 bq = *(const bf16x8*)(GcrT + r * C3_LDT + 16 * s + 8 * h);
          X2 = MFMA32(a, bq, X2);
        }
        if (c * C3_L >= 256) {
          const size_t orow = (size_t)rowof(c * C3_L + r) * DM + head * 64 + 32 * tio + 4 * h;
#pragma unroll
          for (int g = 0; g < 4; ++g) {
            u32x2 w; w.x = pk2(XO[4 * g] - X2[4 * g], XO[4 * g + 1] - X2[4 * g + 1]); w.y = pk2(XO[4 * g + 2] - X2[4 * g + 2], XO[4 * g + 3] - X2[4 * g + 3]);
            *(u32x2*)(Ox + orow + 8 * g) = w;
          }
        }
      }
      {
        f32x16 P1, P2;
#pragma unroll
        for (int i = 0; i < 16; ++i) { P1[i] = 0.f; P2[i] = 0.f; }
#pragma unroll
        for (int s = 0; s < 2; ++s) {
          const bf16x8 av = *(const bf16x8*)(Vt + (32 * ti + r) * C3_LDT + 16 * s + 8 * h);
          const bf16x8 bk = *(const bf16x8*)(KhT + (32 * tj + r) * C3_LDT + 16 * s + 8 * h);
          P1 = MFMA32(av, bk, P1);
          const bf16x8 au = *(const bf16x8*)(Ub + (32 * ti + r) * C3_LDT + 16 * s + 8 * h);
          const bf16x8 bc = *(const bf16x8*)(ChT + (32 * tj + r) * C3_LDT + 16 * s + 8 * h);
          P2 = MFMA32(au, bc, P2);
        }
        const float ek = Eb[32 * tj + r];
#pragma unroll
        for (int i = 0; i < 16; ++i) {
          S[i] = S[i] * ek + P1[i] - P2[i];
          S0b[(32 * ti + (i & 3) + 8 * (i >> 2) + 4 * h) * C3_LDK + 32 * tj + r] = f2bf(S[i]);
        }
      }
      lds_bar();
    }
  }
}

DI void phase_rwkv_out(KP p, char* smem) {
  char* const ws = ows(p);
  const int lane = otid() & 63, wid = otid() >> 6;
  char* U = ws + OFF_U;
  const bf16_t *Rx = (const bf16_t*)(U + U3_R), *Kx = (const bf16_t*)(U + U3_K), *Vx = (const bf16_t*)(U + U3_V), *A0 = (const bf16_t*)(U + U3_A0),
               *A1 = (const bf16_t*)(U + U3_A1), *Gx = (const bf16_t*)(U + U3_G), *O0 = (const bf16_t*)(U + U3_O0), *O1 = (const bf16_t*)(U + U3_O1);
  bf16_t* Z = (bf16_t*)(ws + OFF_H);
  const int ch0 = lane * 16;
  float ka[16], rk[16], lw[16], lb[16];
#pragma unroll
  for (int j = 0; j < 16; ++j) { ka[j] = gin(p, 29)[ch0 + j]; rk[j] = gin(p, 30)[ch0 + j]; lw[j] = gin(p, 31)[ch0 + j]; lb[j] = gin(p, 32)[ch0 + j]; }
  auto ld16f = [&](const bf16_t* base, size_t off, float (&o)[16]) {
    const u32x4 a = ld16(base + off), b = ld16(base + off + 8);
    o[0] = bflo(a.x); o[1] = bfhi(a.x); o[2] = bflo(a.y); o[3] = bfhi(a.y); o[4] = bflo(a.z); o[5] = bfhi(a.z); o[6] = bflo(a.w); o[7] = bfhi(a.w);
    o[8] = bflo(b.x); o[9] = bfhi(b.x); o[10] = bflo(b.y); o[11] = bfhi(b.y); o[12] = bflo(b.z); o[13] = bfhi(b.z); o[14] = bflo(b.w); o[15] = bfhi(b.w);
  };
  for (int r = obid() * 8 + wid; r < TL; r += gridDim.x * 8) {
    const size_t off = (size_t)r * DM + ch0;
    float o0[16], o1[16], rr[16], kk[16], vv[16], a0[16], a1[16], gg[16];
    ld16f(O0, off, o0); ld16f(O1, off, o1); ld16f(Rx, off, rr); ld16f(Kx, off, kk); ld16f(Vx, off, vv); ld16f(A0, off, a0); ld16f(A1, off, a1); ld16f(Gx, off, gg);
    float s = 0.f, bs = 0.f;
#pragma unroll
    for (int j = 0; j < 16; ++j) {
      o0[j] += o1[j]; s += o0[j];
      const float kd0 = kk[j] * (1.0f + (a0[j] - 1.0f) * ka[j]), kd1 = kk[j] * (1.0f + (a1[j] - 1.0f) * ka[j]);
      bs += rr[j] * (kd0 + kd1) * rk[j];
    }
    s += __shfl_xor(s, 1); s += __shfl_xor(s, 2);
    bs += __shfl_xor(bs, 1); bs += __shfl_xor(bs, 2);
    const float mean = s * (1.0f / 64.0f);
    float q = 0.f;
#pragma unroll
    for (int j = 0; j < 16; ++j) { const float d = o0[j] - mean; q += d * d; }
    q += __shfl_xor(q, 1); q += __shfl_xor(q, 2);
    const float rstd = rsqrtf(q * (1.0f / 64.0f) + 64e-5f);
    float z[16];
#pragma unroll
    for (int j = 0; j < 16; ++j) z[j] = ((o0[j] - mean) * rstd * lw[j] + lb[j] + bs * vv[j]) * gg[j];
    u32x4 w0;
    w0.x = pk4_fp8(z[0] * O8_SCALE, z[1] * O8_SCALE, z[2] * O8_SCALE, z[3] * O8_SCALE); w0.y = pk4_fp8(z[4] * O8_SCALE, z[5] * O8_SCALE, z[6] * O8_SCALE, z[7] * O8_SCALE);
    w0.z = pk4_fp8(z[8] * O8_SCALE, z[9] * O8_SCALE, z[10] * O8_SCALE, z[11] * O8_SCALE); w0.w = pk4_fp8(z[12] * O8_SCALE, z[13] * O8_SCALE, z[14] * O8_SCALE, z[15] * O8_SCALE);
    *(u32x4*)((unsigned char*)Z + off) = w0;
  }
}

#define XB_TMO      128
#define XB_XCNT(j)  (256  + 64 * (j))
#define XB_XSUB(j)  (1280 + 64 * (j))
#define XB_XGEN(j)  (2304 + 64 * (j))
#define XB_TOP      3328
#define XB_TOPGEN   3392
#define XCD_BAR_WORDS 3456
#define XB_SPIN_CAP (1u << 22)
#define LAS __attribute__((address_space(3)))
__device__ __forceinline__ unsigned xb_ld(unsigned* p)              { return __hip_atomic_load(p, __ATOMIC_RELAXED, __HIP_MEMORY_SCOPE_AGENT); }
__device__ __forceinline__ unsigned xb_add(unsigned* p, unsigned v) { return __hip_atomic_fetch_add(p, v, __ATOMIC_RELAXED, __HIP_MEMORY_SCOPE_AGENT); }
__device__ __forceinline__ unsigned xb_xcc_id() { return (unsigned)__builtin_amdgcn_s_getreg((3 << 11) | 20) & 0xFu; }
#define XB_SPIN(cond, bar) do { unsigned _sp = 0; while (cond) { __builtin_amdgcn_s_sleep(1); \
    if ((++_sp & 255u) == 0u) { if (xb_ld(&(bar)[XB_TMO])) break; if (_sp > XB_SPIN_CAP) { atomicAdd(&(bar)[XB_TMO], 1u); break; } } } } while (0)
struct XcdBarrier { unsigned* bar; unsigned x; volatile LAS unsigned* st; };
__device__ __forceinline__ XcdBarrier xcd_barrier_post(unsigned* bar, volatile LAS unsigned* st) {
    XcdBarrier b; b.bar = bar; b.x = xb_xcc_id(); b.st = st;
    if (otid() == 0) (void)xb_add(&bar[XB_XCNT(b.x)], 1u);
    return b;
}
__device__ __forceinline__ void xcd_barrier_complete(unsigned* bar, unsigned x, unsigned& nloc, unsigned& nx) {
    const unsigned G = gridDim.x * gridDim.y * gridDim.z;
    unsigned sum, cnt, mine, sp = 0u;
    for (;;) {
        sum = 0u; cnt = 0u; mine = 0u;
#pragma unroll
        for (unsigned j = 0; j < 16; ++j) { const unsigned c = xb_ld(&bar[XB_XCNT(j)]); sum += c; cnt += (c > 0u) ? 1u : 0u; mine = (j == x) ? c : mine; }
        if (sum == G) break;
        __builtin_amdgcn_s_sleep(1);
        if ((++sp & 255u) == 0u) { if (xb_ld(&bar[XB_TMO])) break; if (sp > XB_SPIN_CAP) { atomicAdd(&bar[XB_TMO], 1u); break; } }
    }
    nloc = mine > 0u ? mine : 1u; nx = cnt > 0u ? cnt : 1u;
}
__device__ __forceinline__ void xcd_barrier(const XcdBarrier& b) {
    asm volatile("s_waitcnt vmcnt(0)" ::: "memory");
    __syncthreads();
    if (otid() == 0) {
        unsigned* bar = b.bar;
        __builtin_amdgcn_s_waitcnt(0);
        unsigned nloc = b.st[0], nx = b.st[1];
        if (nloc == 0u) { xcd_barrier_complete(bar, b.x, nloc, nx); b.st[0] = nloc; b.st[1] = nx; }
        const unsigned old = xb_add(&bar[XB_XSUB(b.x)], 1u);
        const unsigned gen = old / nloc;
        if (old + 1u == (gen + 1u) * nloc) {
            __builtin_amdgcn_fence(__ATOMIC_RELEASE, "agent");
            asm volatile("s_waitcnt vmcnt(0)" ::: "memory");
            const unsigned og = xb_add(&bar[XB_TOP], 1u);
            const unsigned tg = og / nx;
            if (og + 1u == (tg + 1u) * nx) xb_add(&bar[XB_TOPGEN], 1u);
            else XB_SPIN(xb_ld(&bar[XB_TOPGEN]) == tg, bar);
            __builtin_amdgcn_fence(__ATOMIC_ACQUIRE, "agent");
            xb_add(&bar[XB_XGEN(b.x)], 1u);
            asm volatile("s_waitcnt vmcnt(0)" ::: "memory");
        } else {
            XB_SPIN(xb_ld(&bar[XB_XGEN(b.x)]) == gen, bar);
            __builtin_amdgcn_fence(__ATOMIC_ACQUIRE, "agent");
            asm volatile("s_waitcnt vmcnt(0)" ::: "memory");
        }
    }
    __syncthreads();
}

DI void gbar(const XcdBarrier& b0) {
  XcdBarrier b = b0;
  unsigned long long pb = (unsigned long long)b.bar; asm volatile("" : "+s"(pb)); b.bar = (unsigned*)pb;
  unsigned x = b.x; asm volatile("" : "+s"(x)); b.x = x;
  xcd_barrier(b);
}

constexpr int cmaxi(int a, int b) { return a > b ? a : b; }
constexpr int FUSED_LDS = 256 + cmaxi(cmaxi(MOD_LDS, A1_LDS), cmaxi(cmaxi(SC_LDS, R2_LDS), FG_LDS + MOE_UMAX * 1024 + 256));
#ifndef PROBE_GROUP
#define PROBE_GROUP 0
#endif
#define PROBE(g, stmt) do { if constexpr (PROBE_GROUP == (g)) { stmt; gbar(bar); } } while (0)
template <int layer>
DI void run_layer(const XcdBarrier& bar, char* smem) {
  char* U = ows(kparams()) + OFF_U;
  const bf16_t* wm = (const bf16_t*)(ows(kparams()) + OFF_WMIX);
  if constexpr (layer == 0) phase_norm1<0, false, true>(kparams(), layer, smem); else phase_norm1<1, false, layer == 1>(kparams(), layer, smem);
  gbar(bar);
  PROBE(1, (phase_norm1<(layer == 0 ? 0 : 1), true, (layer <= 1)>(kparams(), layer, smem)));
  if constexpr (layer == 0) {
    phase_qkv_win8(kparams(), smem);
    gbar(bar);
    PROBE(3, phase_qkv_win8(kparams(), smem));
    phase_attn_win(kparams(), smem);
    gbar(bar);
    PROBE(4, phase_attn_win(kparams(), smem));
    phase_oproj8(kparams(), 0, U + U0_O, (const char*)(wm + W_WINO), TT, smem);
    gbar(bar);
    PROBE(3, (phase_oproj8<true>(kparams(), 0, U + U0_O, (const char*)(wm + W_WINO), TT, smem)));
  } else if constexpr (layer == 1) {
    phase_qkv_diff8(kparams(), smem);
    gbar(bar);
    PROBE(3, phase_qkv_diff8(kparams(), smem));
    phase_attn_diff(kparams(), smem);
    gbar(bar);
    PROBE(10, phase_attn_diff(kparams(), smem));
    phase_oproj8(kparams(), 1, U + U1_O, (const char*)(wm + W_DIFFO), TT, smem);
    gbar(bar);
    PROBE(3, (phase_oproj8<true>(kparams(), 1, U + U1_O, (const char*)(wm + W_DIFFO), TT, smem)));
  } else if constexpr (layer == 2) {
    phase_pool_pre(kparams(), smem);
    gbar(bar);
    PROBE(6, phase_pool_pre(kparams(), smem));
    phase_pool(kparams(), smem);
    gbar(bar);
    PROBE(6, phase_pool<true>(kparams(), smem));
  } else {
    phase_rwkv_mix(kparams(), smem);
    gbar(bar);
    PROBE(7, phase_rwkv_mix(kparams(), smem));
    phase_rwkv_rkv(kparams(), smem);
    __syncthreads();
    phase_rwkv_feat1(kparams(), smem);
    gbar(bar);
    PROBE(7, phase_rwkv_rkv(kparams(), smem));
    PROBE(8, phase_rwkv_feat1(kparams(), smem));
    phase_rwkv_feat2(kparams(), smem);
    gbar(bar);
    PROBE(8, phase_rwkv_feat2(kparams(), smem));
    phase_rwkv_scan(kparams(), smem);
    gbar(bar);
    PROBE(11, phase_rwkv_scan(kparams(), smem));
    phase_rwkv_out(kparams(), smem);
    gbar(bar);
    PROBE(9, phase_rwkv_out(kparams(), smem));
    phase_oproj8(kparams(), 3, ows(kparams()) + OFF_H, (const char*)(wm + W_RO), TL, smem);
    gbar(bar);
    PROBE(3, (phase_oproj8<true>(kparams(), 3, ows(kparams()) + OFF_H, (const char*)(wm + W_RO), TL, smem)));
  }
  phase_norm2_router(kparams(), layer, smem);
  __syncthreads();
  phase_cvt_moe(kparams(), layer, smem);
  gbar(bar);
  PROBE(2, phase_norm2_router<true>(kparams(), layer, smem));
  PROBE(5, phase_cvt_moe(kparams(), layer, smem));
  phase_moe_up(kparams(), layer, smem);
  gbar(bar);
  phase_moe_down(kparams(), layer, smem);
  gbar(bar);
  PROBE(12, phase_moe_up(kparams(), layer, smem));
  PROBE(12, phase_moe_down(kparams(), layer, smem));
}

__global__ __launch_bounds__(NTH, 2) void k_fused(Params p_unused) {
  extern __shared__ __attribute__((aligned(16))) char smem_all[];
  if (threadIdx.x == 0) *(uint4*)smem_all = make_uint4(0u, 0u, 0u, 0u);
  __syncthreads();
  XcdBarrier bar = xcd_barrier_post((unsigned*)(ows(kparams()) + OFF_BAR), (volatile LAS unsigned*)smem_all);
  char* smem = smem_all + 256;
  phase_cvt_mix(kparams(), smem);
  __syncthreads();
  phase_mod(kparams(), smem);
  gbar(bar);
  PROBE(5, phase_cvt_mix(kparams(), smem));
  PROBE(5, phase_mod(kparams(), smem));
  run_layer<0>(bar, smem);
  run_layer<1>(bar, smem);
  run_layer<2>(bar, smem);
  run_layer<3>(bar, smem);
  phase_norm1<3>(kparams(), 3, smem);
  PROBE(1, (gbar(bar), phase_norm1<3, true>(kparams(), 3, smem)));
}

static void fill_params(Params& p, void* const* d_in, void* d_out, void* d_ws) {
  for (int i = 0; i < 40; ++i) p.in[i] = (const float*)d_in[i];
  p.out = (float*)d_out;
  p.ws = (char*)d_ws;
  bf16_t* wm = (bf16_t*)(p.ws + OFF_WMIX);
  int nj = 0, item = 0;
  auto add = [&](const float* src, size_t dstoff, int K, int N, int ld, int dld = 0, int f8 = 0) {
    p.jobs[nj].src = src; p.jobs[nj].dst = wm + dstoff; p.jobs[nj].K = K; p.jobs[nj].N = N; p.jobs[nj].ld = ld; p.jobs[nj].item0 = item; p.jobs[nj].dld = dld ? dld : K; p.jobs[nj].pad_ = f8;
    item += (K / 64) * (N / 64); ++nj;
  };
  add(p.in[8], W_WINQKV, 1024, 1536, 1536, 0, 1);
  add(p.in[10], W_WINO, 1024, 1024, 1024, 0, 1);
  add(p.in[11], W_DIFFQKV, 1024, 3072, 3072, 0, 1);
  add(p.in[14], W_DIFFO, 1024, 1024, 1024, 0, 1);
  for (int g = 0; g < 4; ++g) add(p.in[15] + (size_t)g * 65536, W_POOL + (size_t)g * 65536, 256, 256, 256);
  add(p.in[19], W_R, 1024, 1024, 1024, 0, 1);
  add(p.in[19] + (size_t)1 * 1024 * 1024, W_K, 1024, 1024, 1024, 0, 1);
  add(p.in[19] + (size_t)2 * 1024 * 1024, W_V, 1024, 1024, 1024, 0, 1);
  for (int d = 0; d < 2; ++d) add(p.in[21] + (size_t)d * 1024 * 64, W_WA1 + (size_t)d * 64 * 1024, 1024, 64, 64);
  for (int d = 0; d < 2; ++d) add(p.in[24] + (size_t)d * 1024 * 64, W_AA1 + (size_t)d * 64 * 1024, 1024, 64, 64);
  add(p.in[26], W_G1, 1024, 128, 128);
  for (int d = 0; d < 2; ++d) add(p.in[22] + (size_t)d * 64 * 1024, W_WA2 + (size_t)d * 1024 * 128 + d * 64, 64, 1024, 1024, 128);
  for (int d = 0; d < 2; ++d) add(p.in[25] + (size_t)d * 64 * 1024, W_AA2 + (size_t)d * 1024 * 128 + d * 64, 64, 1024, 1024, 128);
  add(p.in[27], W_G2, 128, 1024, 1024);
  add(p.in[33], W_RO, 1024, 1024, 1024, 0, 1);
  p.njobs = nj; p.nitems = item;
}

extern "C" void kernel_launch(void* const* d_in, const int* in_sizes, int n_in, void* d_out, int out_size, void* d_ws, size_t ws_size, hipStream_t stream) {
  if (ws_size < WS_NEED || n_in < 40) return;
  Params p{};
  fill_params(p, d_in, d_out, d_ws);
  (void)hipMemsetAsync(p.ws, 0, 32768, stream);
  (void)hipMemsetAsync(p.ws + OFF_H8 + (size_t)TT * DM, 0, 8 * DM, stream);
  static int grid = 0;
  if (!grid) {
    int dev = 0, cus = 0, per_cu = 0;
    (void)hipGetDevice(&dev);
    (void)hipDeviceGetAttribute(&cus, hipDeviceAttributeMultiprocessorCount, dev);
    (void)hipFuncSetAttribute((const void*)k_fused, hipFuncAttributeMaxDynamicSharedMemorySize, FUSED_LDS);
    (void)hipOccupancyMaxActiveBlocksPerMultiprocessor(&per_cu, (const void*)k_fused, NTH, FUSED_LDS);
    grid = cus * (per_cu < 1 ? per_cu : 1);
  }
  if (grid <= 0) return;
  hipLaunchKernelGGL(k_fused, dim3(grid), dim3(NTH), FUSED_LDS, stream, p);
}
```

```cpp
#include <hip/hip_runtime.h>
#include <stdint.h>
#include <stddef.h>

typedef unsigned short bf16_t;
typedef short bf16x8 __attribute__((ext_vector_type(8)));
typedef short s16x4 __attribute__((ext_vector_type(4)));
typedef float f32x4 __attribute__((ext_vector_type(4)));
typedef float f32x16 __attribute__((ext_vector_type(16)));
typedef unsigned u32x4 __attribute__((ext_vector_type(4)));
typedef unsigned u32x2 __attribute__((ext_vector_type(2)));
typedef float f32x2 __attribute__((ext_vector_type(2)));
#define DI __device__ __forceinline__

constexpr int DM = 1024, NBATCH = 16, SEQ = 4096, CTX = 256;
constexpr int TL = NBATCH * SEQ, TC = NBATCH * CTX, TT = TL + TC;
constexpr int NTH = 512;
constexpr int MOE_PAD = 256;
constexpr int MOE_ROWS = 2 * TT + 32 * MOE_PAD;
constexpr int CAP = TT;

constexpr size_t al256(size_t x) { return (x + 255) & ~(size_t)255; }
constexpr size_t OFF_BAR = 0;
constexpr size_t OFF_CNT = 16384;
constexpr size_t OFF_MOD = 32768;
constexpr size_t OFF_ROPE = al256(OFF_MOD + (size_t)4 * 17 * 6144 * 4);
constexpr size_t OFF_XB = al256(OFF_ROPE + 2 * 64 * 16 * 4);
constexpr size_t OFF_H = al256(OFF_XB + (size_t)TT * DM * 2);
constexpr size_t OFF_H8 = al256(OFF_H + (size_t)(TT + 8) * DM * 2);
constexpr size_t OFF_TOK = al256(OFF_H8 + (size_t)(TT + 8) * DM);
constexpr size_t OFF_ROWL = al256(OFF_TOK + (size_t)TT * 32);
constexpr size_t OFF_WMIX = al256(OFF_ROWL + (size_t)32 * CAP * 4);
constexpr size_t W_WINQKV = 0;
constexpr size_t W_WINO = W_WINQKV + (size_t)1536 * 1024;
constexpr size_t W_DIFFQKV = W_WINO + (size_t)1024 * 1024;
constexpr size_t W_DIFFO = W_DIFFQKV + (size_t)3072 * 1024;
constexpr size_t W_POOL = W_DIFFO + (size_t)1024 * 1024;
constexpr size_t W_R = W_POOL + (size_t)4 * 256 * 256;
constexpr size_t W_K = W_R + (size_t)1024 * 1024;
constexpr size_t W_V = W_K + (size_t)1024 * 1024;
constexpr size_t W_WA1 = W_V + (size_t)1024 * 1024;
constexpr size_t W_AA1 = W_WA1 + (size_t)128 * 1024;
constexpr size_t W_G1 = W_AA1 + (size_t)128 * 1024;
constexpr size_t W_WA2 = W_G1 + (size_t)128 * 1024;
constexpr size_t W_AA2 = W_WA2 + (size_t)2048 * 128;
constexpr size_t W_G2 = W_AA2 + (size_t)2048 * 128;
constexpr size_t W_RO = W_G2 + (size_t)1024 * 128;
constexpr size_t W_MIX_END = W_RO + (size_t)1024 * 1024;
constexpr size_t OFF_WR = al256(OFF_WMIX + W_MIX_END * 2);
constexpr size_t OFF_WMOE = al256(OFF_WR + (size_t)4 * 2 * 48 * 1024 * 2);
constexpr size_t WMOE_DOWN = (size_t)32 * 1024 * 1024;
constexpr size_t OFF_U = al256(OFF_WMOE + ((size_t)32 * 1024 * 1024 + (size_t)32 * 1024 * 512) * 2);
constexpr size_t SZ_TT = (size_t)TT * DM * 2, SZ_TL = (size_t)TL * DM * 2;
constexpr size_t U0_Q = 0, U0_K = U0_Q + SZ_TT, U0_V = U0_K + (size_t)TT * 256 * 2, U0_O = U0_V + (size_t)TT * 256 * 2, U0_END = U0_O + SZ_TT;
constexpr size_t U1_Q = 0, U1_K = U1_Q + SZ_TT, U1_V = U1_K + SZ_TT, U1_O = U1_V + SZ_TT, U1_END = U1_O + SZ_TT;
constexpr size_t U2_Y = 0, U2_END = SZ_TT;
constexpr size_t U3_R = 0, U3_K = U3_R + SZ_TL, U3_V = U3_K + SZ_TT, U3_A0 = U3_V + SZ_TT, U3_A1 = U3_A0 + SZ_TT, U3_LD0 = U3_A1 + SZ_TT,
                 U3_LD1 = U3_LD0 + SZ_TT, U3_LW = U3_LD1 + SZ_TT, U3_LA = U3_LW + (size_t)TT * 128 * 2, U3_LG = U3_LA + (size_t)TT * 128 * 2,
                 U3_G = U3_LG + (size_t)TL * 128 * 2, U3_O0 = U3_G + SZ_TL, U3_O1 = U3_O0 + SZ_TL, U3_END = U3_O1 + SZ_TL;
constexpr size_t U3_XR = U3_A0, U3_XK = U3_A1, U3_XV = U3_LD0;
constexpr size_t UM_ACT = 0, UM_YB = UM_ACT + (size_t)MOE_ROWS * 512 * 2, UM_END = UM_YB + (size_t)MOE_ROWS * 1024 * 2;
constexpr size_t cmax(size_t a, size_t b) { return a > b ? a : b; }
constexpr size_t U_SIZE = cmax(cmax(cmax(U0_END, U1_END), U2_END), cmax(U3_END, UM_END));
constexpr size_t WS_NEED = OFF_U + U_SIZE;

struct CvtJob { const float* src; bf16_t* dst; int K, N, ld, item0, dld, pad_; };
constexpr int NJOBS = 24;
struct Params {
  const float* in[40];
  float* out;
  char* ws;
  CvtJob jobs[NJOBS];
  int njobs, nitems;
};

typedef const __attribute__((address_space(4))) Params* KP;
DI KP kparams() { KP q = (KP)__builtin_amdgcn_kernarg_segment_ptr(); asm volatile("" : "+s"(q)); return q; }
DI char* ows(KP p) {
  const unsigned long long w = (unsigned long long)p->ws;
  unsigned lo = (unsigned)w, hi = (unsigned)(w >> 32);
  asm volatile("" : "+v"(lo), "+v"(hi));
  lo = __builtin_amdgcn_readfirstlane(lo); hi = __builtin_amdgcn_readfirstlane(hi);
  return (char*)(__attribute__((address_space(1))) char*)(((unsigned long long)hi << 32) | lo);
}
DI const float* gin(KP p, int i) { return (const float*)(__attribute__((address_space(1))) const float*)p->in[i]; }
DI float* gout(KP p) { return (float*)(__attribute__((address_space(1))) float*)p->out; }
DI int otid() { int t = threadIdx.x; asm volatile("" : "+v"(t)); return t; }
DI int obid() { int b = blockIdx.x; asm volatile("" : "+s"(b)); return b; }
DI unsigned pk2(float lo, float hi) {
  typedef __bf16 bf2 __attribute__((ext_vector_type(2)));
  typedef float f2 __attribute__((ext_vector_type(2)));
  f2 v = {lo, hi};
  return __builtin_bit_cast(unsigned, __builtin_convertvector(v, bf2));
}
DI float clamp8(float x) { return __builtin_amdgcn_fmed3f(x, -440.0f, 440.0f); }
DI void swap32(float x, float& a, float& b) {
  a = x; b = x;
  asm volatile("s_nop 1\n\tv_permlane32_swap_b32 %0, %1\n\ts_nop 1" : "+v"(a), "+v"(b));
}
DI unsigned pk4_fp8_nc(float a, float b, float c, float d) { int w; asm("" : "=v"(w)); w = __builtin_amdgcn_cvt_pk_fp8_f32(a, b, w, false); w = __builtin_amdgcn_cvt_pk_fp8_f32(c, d, w, true); return (unsigned)w; }
DI unsigned pk4_fp8(float a, float b, float c, float d) { int w = __builtin_amdgcn_cvt_pk_fp8_f32(clamp8(a), clamp8(b), 0, false); w = __builtin_amdgcn_cvt_pk_fp8_f32(clamp8(c), clamp8(d), w, true); return (unsigned)w; }
DI bf16_t f2bf(float x) { return (bf16_t)(pk2(x, 0.f) & 0xffffu); }
DI float bf2f(bf16_t b) { return __uint_as_float(((unsigned)b) << 16); }
DI float bflo(unsigned u) { return __uint_as_float(u << 16); }
DI float bfhi(unsigned u) { return __uint_as_float(u & 0xffff0000u); }
DI float wave_sum(float v) {
#pragma unroll
  for (int o = 32; o >= 1; o >>= 1) v += __shfl_xor(v, o);
  return v;
}
DI float sigmoidf_(float x) { return __builtin_amdgcn_rcpf(1.0f + __expf(-x)); }
DI int row_bi(int r) { return r < TL ? (r >> 12) : 16; }
DI bf16_t* xrow_ptr(KP p, char* ws, int r) { return (bf16_t*)(ws + OFF_XB) + (size_t)r * DM; }
DI f32x4 ldbf4(const bf16_t* q) { const u32x2 w = *(const u32x2*)q; return (f32x4){bflo(w.x), bfhi(w.x), bflo(w.y), bfhi(w.y)}; }
DI void stbf4(bf16_t* q, const f32x4& v) { u32x2 w; w.x = pk2(v[0], v[1]); w.y = pk2(v[2], v[3]); *(u32x2*)q = w; }
DI const float* modp(char* ws, int layer, int bi, int which) { return (const float*)(ws + OFF_MOD) + ((size_t)(layer * 17 + bi) * 6 + which) * DM; }
#define MFMA16(a, b, c) __builtin_amdgcn_mfma_f32_16x16x32_bf16((a), (b), (c), 0, 0, 0)
#define MFMA32(a, b, c) __builtin_amdgcn_mfma_f32_32x32x16_bf16((a), (b), (c), 0, 0, 0)

constexpr int SGLD = 72;
constexpr int SG_LDS = 2 * 128 * SGLD * 2;
template <class AL, class BL, class EP>
DI void sgemm_tile(char* smem, int K, AL la, BL lb, EP ep) {
  bf16_t* sA = (bf16_t*)smem;
  bf16_t* sB = sA + 128 * SGLD;
  const int tid = otid(), lane = tid & 63, wid = tid >> 6, wr = wid >> 2, wc = wid & 3, fr = lane & 15, fq = lane >> 4;
  f32x4 acc[4][2];
#pragma unroll
  for (int m = 0; m < 4; ++m)
#pragma unroll
    for (int n = 0; n < 2; ++n) acc[m][n] = (f32x4){0.f, 0.f, 0.f, 0.f};
  const int r_ = tid >> 3, k_ = (tid & 7) * 8;
  u32x4 ra0 = la(r_, k_), ra1 = la(r_ + 64, k_), rb0 = lb(r_, k_), rb1 = lb(r_ + 64, k_);
  const int nk = K >> 6;
  for (int kt = 0; kt < nk; ++kt) {
    __syncthreads();
    *(u32x4*)(sA + r_ * SGLD + k_) = ra0;
    *(u32x4*)(sA + (r_ + 64) * SGLD + k_) = ra1;
    *(u32x4*)(sB + r_ * SGLD + k_) = rb0;
    *(u32x4*)(sB + (r_ + 64) * SGLD + k_) = rb1;
    __syncthreads();
    if (kt + 1 < nk) {
      const int kk = (kt + 1) * 64 + k_;
      ra0 = la(r_, kk); ra1 = la(r_ + 64, kk); rb0 = lb(r_, kk); rb1 = lb(r_ + 64, kk);
    }
#pragma unroll
    for (int ks = 0; ks < 2; ++ks) {
      bf16x8 af[4], bq[2];
#pragma unroll
      for (int m = 0; m < 4; ++m) af[m] = *(const bf16x8*)(sA + (wr * 64 + m * 16 + fr) * SGLD + ks * 32 + fq * 8);
#pragma unroll
      for (int n = 0; n < 2; ++n) bq[n] = *(const bf16x8*)(sB + (wc * 32 + n * 16 + fr) * SGLD + ks * 32 + fq * 8);
#pragma unroll
      for (int m = 0; m < 4; ++m)
#pragma unroll
        for (int n = 0; n < 2; ++n) acc[m][n] = MFMA16(af[m], bq[n], acc[m][n]);
    }
  }
  ep(acc, wr * 64, wc * 32, fr, fq);
}
DI u32x4 ld16(const bf16_t* p) { return *(const u32x4*)p; }

#define LAS __attribute__((address_space(3)))
namespace fg {
typedef int v8i_t __attribute__((ext_vector_type(8)));
typedef int v4i_t __attribute__((ext_vector_type(4)));
constexpr int BM = 256, BK = 64, HALF = 128, HTB = HALF * BK * 2, STAGE_BYTES = 8 * HTB, NXCD = 8, WGM = 8;
DI int lds_byte(int r, int c) { const int st = (r >> 4) * 2 + (c >> 5), rr = r & 15, cc = c & 31, ob = rr * 64 + cc * 2; return st * 1024 + (ob ^ (((ob >> 9) & 1) << 5)); }
DI void stage_rc(int b, int& R, int& C) { const int st = b / 1024, sb = b % 1024, swz = sb ^ (((sb >> 9) & 1) << 5); R = (st >> 1) * 16 + swz / 64; C = (st & 1) * 32 + (swz % 64) / 2; }
struct Unit { const char* A; const char* B; int pm, pn, aux; };
DI bool static_order(int i, int G, int c, int nM, int nN, int& pm, int& pn) {
  const int nwg = nM * nN;
  const long L = (long)i * G + c; if (L >= nwg) return false;
  int wgid = (int)L; { const int q = nwg / NXCD, r = nwg % NXCD, xcd = wgid % NXCD, off = wgid / NXCD; wgid = (xcd < r ? xcd * (q + 1) : r * (q + 1) + (xcd - r) * q) + off; }
  const int nig = WGM * nN, gid = wgid / nig, fm = gid * WGM, gsz = (nM - fm) < WGM ? (nM - fm) : WGM;
  pm = fm + ((wgid % nig) % gsz); pn = (wgid % nig) / gsz; return true;
}
struct DenseSched {
  const char* A; const char* B; int nM, nN, G, c; size_t tA, tB;
  DI bool next(int i, Unit& u) const { int pm, pn; if (!static_order(i, G, c, nM, nN, pm, pn)) return false; u.pm = pm; u.pn = pn; u.aux = 0; u.A = A + (size_t)pm * tA; u.B = B + (size_t)pn * tB; return true; }
  DI const LAS int* rows(int) const { return nullptr; }
};

DI int perm32(int rho) { const int n = rho >> 4, i = rho & 15; return 8 * (i >> 2) + 4 * n + (i & 3); }
template <bool GATHER, bool PERM = false, class Epi, class Sched>
DI void gemm_phase(LAS unsigned char* lds, const int K, const int lda, const int ldb, const Sched& S, const Epi& E) {
  const int tid = otid(), wid = __builtin_amdgcn_readfirstlane(tid >> 6), lane = tid & 63, wr = wid >> 2, wc = wid & 3, fr = lane & 15, fq = lane >> 4;
  const int nt = K / BK;
  unsigned voffA[2], voffB[2]; int sR[2], sC[2];
#pragma unroll
  for (int i = 0; i < 2; ++i) { int R, C; stage_rc(tid * 16 + i * 8192, R, C); sR[i] = R; sC[i] = C; voffA[i] = (unsigned)(R * lda + C) * 2u; const int Rb = PERM ? ((R & ~31) + perm32(R & 31)) : R; voffB[i] = (unsigned)(Rb * ldb + C) * 2u; }
  const size_t kstep = (size_t)(BK * 2), hstepA = (size_t)HALF * lda * 2, hstepB = (size_t)HALF * ldb * 2;
  const unsigned ldsw = (unsigned)wid * 1024u;
  const int aoff = lds_byte(wr * 64 + fr, fq * 8), boff = lds_byte(wc * 32 + fr, fq * 8);
#define FG_SA(b, h) (((b) * 2 + (h)) * HTB)
#define FG_SB(b, h) ((4 + (b) * 2 + (h)) * HTB)
#define FG_GLDS(gp, bufoff, i_) __builtin_amdgcn_global_load_lds((const unsigned*)(gp), (LAS unsigned*)(lds + (bufoff) + ldsw + (i_) * 8192), 16, 0, 0)
#define FG_STAGE_B(bufoff, gbase) do { const char* _gb = (gbase); FG_GLDS(_gb + voffB[0], bufoff, 0); FG_GLDS(_gb + voffB[1], bufoff, 1); } while (0)
#define FG_STAGE_A(bufoff, NX, H, KB) do { \
    if constexpr (GATHER) { const char* _gb = ((NX) ? nA : cA) + (KB); FG_GLDS(_gb + ((NX) ? gn[H][0] : gc[H][0]), bufoff, 0); FG_GLDS(_gb + ((NX) ? gn[H][1] : gc[H][1]), bufoff, 1); } \
    else { const char* _gb = ((NX) ? nA : cA) + (size_t)(H) * hstepA + (KB); FG_GLDS(_gb + voffA[0], bufoff, 0); FG_GLDS(_gb + voffA[1], bufoff, 1); } } while (0)
#define FG_LDA(dst, b, h) do { _Pragma("unroll") for (int m = 0; m < 4; ++m) _Pragma("unroll") for (int k = 0; k < 2; ++k) dst[m][k] = *(const LAS bf16x8*)(lds + FG_SA(b, h) + aoff + m * 2048 + k * 1024); } while (0)
#define FG_LDB(dst, b, h) do { _Pragma("unroll") for (int n = 0; n < 2; ++n) _Pragma("unroll") for (int k = 0; k < 2; ++k) dst[n][k] = *(const LAS bf16x8*)(lds + FG_SB(b, h) + boff + n * 2048 + k * 1024); } while (0)
#define FG_MMA(ai, bj, At, Bt) do { __builtin_amdgcn_s_setprio(1); _Pragma("unroll") for (int m = 0; m < 4; ++m) _Pragma("unroll") for (int n = 0; n < 2; ++n) _Pragma("unroll") for (int k = 0; k < 2; ++k) \
    acc[ai][bj][m][n] = __builtin_amdgcn_mfma_f32_16x16x32_bf16(Bt[n][k], At[m][k], acc[ai][bj][m][n], 0, 0, 0); __builtin_amdgcn_s_setprio(0); } while (0)
#define FG_WAIT_V(n) asm volatile("s_waitcnt vmcnt(" #n ")" ::: "memory")
#define FG_WAIT_L(n) asm volatile("s_waitcnt lgkmcnt(" #n ")" ::: "memory")
#define FG_BAR __builtin_amdgcn_s_barrier()
#define FG_SCHED __builtin_amdgcn_sched_barrier(0)
  Unit cur, nxt; int ui = 0;
  if (!S.next(0, cur)) return;
  f32x4 acc[2][2][4][2];
#pragma unroll
  for (int a = 0; a < 2; ++a)
#pragma unroll
    for (int b = 0; b < 2; ++b)
#pragma unroll
      for (int m = 0; m < 4; ++m)
#pragma unroll
        for (int n = 0; n < 2; ++n) acc[a][b][m][n] = (f32x4){0.f, 0.f, 0.f, 0.f};
  bf16x8 At[4][2], B0[2][2], B1[2][2];
  const char* cA = cur.A; const char* cB = cur.B;
  const char* nA = cA; const char* nB = cB;
  unsigned gc[2][2] = {{0u, 0u}, {0u, 0u}}, gn[2][2] = {{0u, 0u}, {0u, 0u}};
  if constexpr (GATHER) {
    const LAS int* rw = S.rows(0);
#pragma unroll
    for (int h = 0; h < 2; ++h)
#pragma unroll
      for (int i = 0; i < 2; ++i) { gc[h][i] = (unsigned)(rw[h * HALF + sR[i]] * lda + sC[i]) * 2u; gn[h][i] = gc[h][i]; }
  }
  FG_STAGE_B(FG_SB(0, 0), cB); FG_STAGE_B(FG_SB(0, 1), cB + hstepB); FG_STAGE_A(FG_SA(0, 0), false, 0, 0); FG_STAGE_A(FG_SA(0, 1), false, 1, 0);
  if (wr == 1) FG_BAR;
  FG_WAIT_V(2); FG_BAR;
  FG_STAGE_B(FG_SB(1, 0), cB + kstep); FG_STAGE_A(FG_SA(1, 0), false, 0, kstep); FG_STAGE_B(FG_SB(1, 1), cB + hstepB + kstep);
  FG_WAIT_V(6); FG_BAR;
  for (;;) {
    const bool has_next = S.next(ui + 1, nxt);
    nA = has_next ? nxt.A : cA; nB = has_next ? nxt.B : cB;
    if constexpr (GATHER) {
      if (has_next) {
        const LAS int* rw = S.rows(ui + 1);
#pragma unroll
        for (int h = 0; h < 2; ++h)
#pragma unroll
          for (int i = 0; i < 2; ++i) gn[h][i] = (unsigned)(rw[h * HALF + sR[i]] * lda + sC[i]) * 2u;
      } else {
#pragma unroll
        for (int h = 0; h < 2; ++h)
#pragma unroll
          for (int i = 0; i < 2; ++i) gn[h][i] = gc[h][i];
      }
      FG_WAIT_L(0);
    }
    for (int t = 0; t < nt; t += 2) {
      const bool last = (t == nt - 2);
      const size_t k1 = (size_t)(t + 1) * kstep;
      const size_t k2 = last ? 0 : (size_t)(t + 2) * kstep, k3 = k2 + kstep;
      const char* b2 = last ? nB : cB + (size_t)(t + 2) * kstep; const char* b3 = b2 + kstep;
      FG_LDB(B0, 0, 0); FG_LDB(B1, 0, 1); FG_SCHED; FG_LDA(At, 0, 0); FG_STAGE_A(FG_SA(1, 1), false, 1, k1);
      FG_WAIT_V(8); FG_WAIT_L(0); FG_BAR; FG_MMA(0, 0, At, B0); FG_MMA(0, 1, At, B1); FG_BAR; FG_SCHED;
      FG_LDA(At, 0, 1); FG_STAGE_B(FG_SB(0, 0), b2); FG_STAGE_B(FG_SB(0, 1), b2 + hstepB); FG_STAGE_A(FG_SA(0, 0), last, 0, k2);
      FG_WAIT_V(8); FG_WAIT_L(0); FG_BAR; FG_MMA(1, 0, At, B0); FG_MMA(1, 1, At, B1); FG_BAR; FG_SCHED;
      FG_LDB(B0, 1, 0); FG_LDB(B1, 1, 1); FG_SCHED; FG_LDA(At, 1, 0); FG_STAGE_A(FG_SA(0, 1), last, 1, k2);
      FG_WAIT_V(8); FG_WAIT_L(0); FG_BAR; FG_MMA(0, 0, At, B0); FG_MMA(0, 1, At, B1); FG_BAR; FG_SCHED;
      FG_LDA(At, 1, 1); FG_STAGE_B(FG_SB(1, 0), b3); FG_STAGE_B(FG_SB(1, 1), b3 + hstepB); FG_STAGE_A(FG_SA(1, 0), last, 0, k3);
      FG_WAIT_V(8); FG_WAIT_L(0); FG_BAR; FG_MMA(1, 0, At, B0); FG_MMA(1, 1, At, B1); FG_BAR; FG_SCHED;
    }
    if (wr == 0) FG_BAR;
    E(acc, cur, wr, wc, fr, fq);
    if (!has_next) break;
#pragma unroll
    for (int a = 0; a < 2; ++a)
#pragma unroll
      for (int b = 0; b < 2; ++b)
#pragma unroll
        for (int m = 0; m < 4; ++m)
#pragma unroll
          for (int n = 0; n < 2; ++n) acc[a][b][m][n] = (f32x4){0.f, 0.f, 0.f, 0.f};
    cur = nxt; cA = nA; cB = nB; ++ui;
    if constexpr (GATHER) {
#pragma unroll
      for (int h = 0; h < 2; ++h)
#pragma unroll
        for (int i = 0; i < 2; ++i) gc[h][i] = gn[h][i];
    }
    if (wr == 1) FG_BAR;
  }
  FG_WAIT_V(0);
  FG_BAR;
#undef FG_SA
#undef FG_SB
#undef FG_GLDS
#undef FG_STAGE_A
#undef FG_STAGE_B
#undef FG_LDA
#undef FG_LDB
#undef FG_MMA
#undef FG_WAIT_V
#undef FG_WAIT_L
#undef FG_BAR
#undef FG_SCHED
}
DI int perm32f8(int s_) { return 16 * ((s_ >> 2) & 1) + (s_ & 3) + 4 * (s_ >> 3); }
template <bool GATHER, bool PERM = false, class Epi, class Sched>
DI void gemm_phase_f8(LAS unsigned char* lds, const int K, const int lda, const int ldb, const Sched& S, const Epi& E) {
  const int tid = otid(), wid = __builtin_amdgcn_readfirstlane(tid >> 6), lane = tid & 63, wr = wid >> 2, wc = wid & 3, fr = lane & 15, fq = lane >> 4;
  const int nt = K / BK;
  unsigned voffA[2], voffB[2]; int sR[2], sC[2];
#pragma unroll
  for (int i = 0; i < 2; ++i) { int R, C; stage_rc(tid * 16 + i * 8192, R, C); sR[i] = R; sC[i] = C; voffA[i] = (unsigned)(R * lda + C) * 2u; const int Rb = PERM ? ((R & ~31) + perm32f8(R & 31)) : R; voffB[i] = (unsigned)(Rb * ldb + C) * 2u; }
  const size_t kstep = (size_t)(BK * 2), hstepA = (size_t)HALF * lda * 2, hstepB = (size_t)HALF * ldb * 2;
  const unsigned ldsw = (unsigned)wid * 1024u;
  const int r32 = lane & 31, g32 = lane >> 5;
  const int aoff = lds_byte(wr * 64 + r32, 16 * g32), boff = lds_byte(wc * 32 + r32, 16 * g32);
#define FG_SA(b, h) (((b) * 2 + (h)) * HTB)
#define FG_SB(b, h) ((4 + (b) * 2 + (h)) * HTB)
#define FG_GLDS(gp, bufoff, i_) __builtin_amdgcn_global_load_lds((const unsigned*)(gp), (LAS unsigned*)(lds + (bufoff) + ldsw + (i_) * 8192), 16, 0, 0)
#define FG_STAGE_B(bufoff, gbase) do { const char* _gb = (gbase); FG_GLDS(_gb + voffB[0], bufoff, 0); FG_GLDS(_gb + voffB[1], bufoff, 1); } while (0)
#define FG_STAGE_A(bufoff, NX, H, KB) do { \
    if constexpr (GATHER) { const char* _gb = ((NX) ? nA : cA) + (KB); FG_GLDS(_gb + ((NX) ? gn[H][0] : gc[H][0]), bufoff, 0); FG_GLDS(_gb + ((NX) ? gn[H][1] : gc[H][1]), bufoff, 1); } \
    else { const char* _gb = ((NX) ? nA : cA) + (size_t)(H) * hstepA + (KB); FG_GLDS(_gb + voffA[0], bufoff, 0); FG_GLDS(_gb + voffA[1], bufoff, 1); } } while (0)
#define FG_LDA(dst, b, h) do { _Pragma("unroll") for (int m = 0; m < 2; ++m) _Pragma("unroll") for (int k = 0; k < 2; ++k) { const LAS v4i_t* q_ = (const LAS v4i_t*)(lds + FG_SA(b, h) + aoff + m * 4096 + k * 1024); dst[m][k] = __builtin_shufflevector(q_[0], q_[1], 0, 1, 2, 3, 4, 5, 6, 7); } } while (0)
#define FG_LDB(dst, b, h) do { _Pragma("unroll") for (int k = 0; k < 2; ++k) { const LAS v4i_t* q_ = (const LAS v4i_t*)(lds + FG_SB(b, h) + boff + k * 1024); dst[k] = __builtin_shufflevector(q_[0], q_[1], 0, 1, 2, 3, 4, 5, 6, 7); } } while (0)
#define FG_MMA(ai, bj, At, Bt) do { __builtin_amdgcn_s_setprio(1); _Pragma("unroll") for (int m = 0; m < 2; ++m) _Pragma("unroll") for (int k = 0; k < 2; ++k) \
    acc[ai][bj][m] = __builtin_amdgcn_mfma_scale_f32_32x32x64_f8f6f4(Bt[k], At[m][k], acc[ai][bj][m], 0, 0, 0, 0x7f7f7f7f, 0, 0x7f7f7f7f); __builtin_amdgcn_s_setprio(0); } while (0)
#define FG_WAIT_V(n) asm volatile("s_waitcnt vmcnt(" #n ")" ::: "memory")
#define FG_WAIT_L(n) asm volatile("s_waitcnt lgkmcnt(" #n ")" ::: "memory")
#define FG_BAR __builtin_amdgcn_s_barrier()
#define FG_SCHED __builtin_amdgcn_sched_barrier(0)
  Unit cur, nxt; int ui = 0;
  if (!S.next(0, cur)) return;
  f32x16 acc[2][2][2];
#pragma unroll
  for (int a = 0; a < 2; ++a)
#pragma unroll
    for (int b = 0; b < 2; ++b)
#pragma unroll
      for (int m = 0; m < 2; ++m)
#pragma unroll
        for (int n = 0; n < 16; ++n) acc[a][b][m][n] = 0.f;
  v8i_t At[2][2], B0[2], B1[2];
  const char* cA = cur.A; const char* cB = cur.B;
  const char* nA = cA; const char* nB = cB;
  unsigned gc[2][2] = {{0u, 0u}, {0u, 0u}}, gn[2][2] = {{0u, 0u}, {0u, 0u}};
  if constexpr (GATHER) {
    const LAS int* rw = S.rows(0);
#pragma unroll
    for (int h = 0; h < 2; ++h)
#pragma unroll
      for (int i = 0; i < 2; ++i) { gc[h][i] = (unsigned)(rw[h * HALF + sR[i]] * lda + sC[i]) * 2u; gn[h][i] = gc[h][i]; }
  }
  FG_STAGE_B(FG_SB(0, 0), cB); FG_STAGE_B(FG_SB(0, 1), cB + hstepB); FG_STAGE_A(FG_SA(0, 0), false, 0, 0); FG_STAGE_A(FG_SA(0, 1), false, 1, 0);
  if (wr == 1) FG_BAR;
  FG_WAIT_V(2); FG_BAR;
  FG_STAGE_B(FG_SB(1, 0), cB + kstep); FG_STAGE_A(FG_SA(1, 0), false, 0, kstep); FG_STAGE_B(FG_SB(1, 1), cB + hstepB + kstep);
  FG_WAIT_V(6); FG_BAR;
  for (;;) {
    const bool has_next = S.next(ui + 1, nxt);
    nA = has_next ? nxt.A : cA; nB = has_next ? nxt.B : cB;
    if constexpr (GATHER) {
      if (has_next) {
        const LAS int* rw = S.rows(ui + 1);
#pragma unroll
        for (int h = 0; h < 2; ++h)
#pragma unroll
          for (int i = 0; i < 2; ++i) gn[h][i] = (unsigned)(rw[h * HALF + sR[i]] * lda + sC[i]) * 2u;
      } else {
#pragma unroll
        for (int h = 0; h < 2; ++h)
#pragma unroll
          for (int i = 0; i < 2; ++i) gn[h][i] = gc[h][i];
      }
      FG_WAIT_L(0);
    }
#pragma nounroll
    for (int t = 0; t < nt; t += 2) {
      const bool last = (t == nt - 2);
      const size_t k1 = (size_t)(t + 1) * kstep;
      const size_t k2 = last ? 0 : (size_t)(t + 2) * kstep, k3 = k2 + kstep;
      const char* b2 = last ? nB : cB + (size_t)(t + 2) * kstep; const char* b3 = b2 + kstep;
      FG_LDB(B0, 0, 0); FG_LDB(B1, 0, 1); FG_SCHED; FG_LDA(At, 0, 0); FG_STAGE_A(FG_SA(1, 1), false, 1, k1);
      FG_WAIT_V(8); FG_WAIT_L(0); FG_BAR; FG_MMA(0, 0, At, B0); FG_MMA(0, 1, At, B1); FG_BAR; FG_SCHED;
      FG_LDA(At, 0, 1); FG_STAGE_B(FG_SB(0, 0), b2); FG_STAGE_B(FG_SB(0, 1), b2 + hstepB); FG_STAGE_A(FG_SA(0, 0), last, 0, k2);
      FG_WAIT_V(8); FG_WAIT_L(0); FG_BAR; FG_MMA(1, 0, At, B0); FG_MMA(1, 1, At, B1); FG_BAR; FG_SCHED;
      FG_LDB(B0, 1, 0); FG_LDB(B1, 1, 1); FG_SCHED; FG_LDA(At, 1, 0); FG_STAGE_A(FG_SA(0, 1), last, 1, k2);
      FG_WAIT_V(8); FG_WAIT_L(0); FG_BAR; FG_MMA(0, 0, At, B0); FG_MMA(0, 1, At, B1); FG_BAR; FG_SCHED;
      FG_LDA(At, 1, 1); FG_STAGE_B(FG_SB(1, 0), b3); FG_STAGE_B(FG_SB(1, 1), b3 + hstepB); FG_STAGE_A(FG_SA(1, 0), last, 0, k3);
      FG_WAIT_V(8); FG_WAIT_L(0); FG_BAR; FG_MMA(1, 0, At, B0); FG_MMA(1, 1, At, B1); FG_BAR; FG_SCHED;
    }
    if (wr == 0) FG_BAR;
    E(acc, cur, wr, wc, r32, g32);
    if (!has_next) break;
#pragma unroll
    for (int a = 0; a < 2; ++a)
#pragma unroll
      for (int b = 0; b < 2; ++b)
#pragma unroll
        for (int m = 0; m < 2; ++m)
#pragma unroll
          for (int n = 0; n < 16; ++n) acc[a][b][m][n] = 0.f;
    cur = nxt; cA = nA; cB = nB; ++ui;
    if constexpr (GATHER) {
#pragma unroll
      for (int h = 0; h < 2; ++h)
#pragma unroll
        for (int i = 0; i < 2; ++i) gc[h][i] = gn[h][i];
    }
    if (wr == 1) FG_BAR;
  }
  FG_WAIT_V(0);
  FG_BAR;
#undef FG_SA
#undef FG_SB
#undef FG_GLDS
#undef FG_STAGE_A
#undef FG_STAGE_B
#undef FG_LDA
#undef FG_LDB
#undef FG_MMA
#undef FG_WAIT_V
#undef FG_WAIT_L
#undef FG_BAR
#undef FG_SCHED
}
}

DI void cvt_tile(char* smem, const float* src, int ld, bf16_t* dst, int K, int N, int item, int dld, int f8) {
  float* tile = (float*)smem;
  const int ntn = N >> 6, kt = item / ntn, nt = item % ntn, k0 = kt * 64, n0 = nt * 64, tid = otid();
  __syncthreads();
#pragma unroll
  for (int i = 0; i < 8; ++i) { const int idx = tid + i * NTH, r = idx >> 6, c = idx & 63; tile[r * 65 + c] = src[(size_t)(k0 + r) * ld + n0 + c]; }
  __syncthreads();
  const int n = tid >> 3, k8 = (tid & 7) * 8;
  if (f8) {
    u32x2 o8;
    o8.x = pk4_fp8(tile[(k8 + 0) * 65 + n] * 32.f, tile[(k8 + 1) * 65 + n] * 32.f, tile[(k8 + 2) * 65 + n] * 32.f, tile[(k8 + 3) * 65 + n] * 32.f);
    o8.y = pk4_fp8(tile[(k8 + 4) * 65 + n] * 32.f, tile[(k8 + 5) * 65 + n] * 32.f, tile[(k8 + 6) * 65 + n] * 32.f, tile[(k8 + 7) * 65 + n] * 32.f);
    *(u32x2*)((unsigned char*)dst + (size_t)(n0 + n) * dld + k0 + k8) = o8;
    return;
  }
  u32x4 o;
  o.x = pk2(tile[(k8 + 0) * 65 + n], tile[(k8 + 1) * 65 + n]);
  o.y = pk2(tile[(k8 + 2) * 65 + n], tile[(k8 + 3) * 65 + n]);
  o.z = pk2(tile[(k8 + 4) * 65 + n], tile[(k8 + 5) * 65 + n]);
  o.w = pk2(tile[(k8 + 6) * 65 + n], tile[(k8 + 7) * 65 + n]);
  *(u32x4*)(dst + (size_t)(n0 + n) * dld + k0 + k8) = o;
}
DI void phase_cvt_mix(KP p, char* smem) {
  char* const ws = ows(p);
  {
    bf16_t* wz = (bf16_t*)(ws + OFF_WMIX) + W_WA2;
    for (int i = obid() * NTH + otid(); i < 2 * 2048 * 8; i += gridDim.x * NTH) {
      const int row = i >> 3, c8 = i & 7, d = (row & 2047) >> 10;
      *(u32x4*)(wz + (size_t)row * 128 + (1 - d) * 64 + c8 * 8) = (u32x4){0u, 0u, 0u, 0u};
    }
  }
  for (int it = obid(); it < p->nitems; it += gridDim.x) {
    int j = 0;
    while (j + 1 < p->njobs && p->jobs[j + 1].item0 <= it) ++j;
    cvt_tile(smem, (const float*)(__attribute__((address_space(1))) const float*)p->jobs[j].src, p->jobs[j].ld, (bf16_t*)(__attribute__((address_space(1))) bf16_t*)p->jobs[j].dst, p->jobs[j].K, p->jobs[j].N, it - p->jobs[j].item0, p->jobs[j].dld, p->jobs[j].pad_);
  }
}
constexpr float O8_SCALE = 4.0f;
constexpr float X8_SCALE = 4.0f;
constexpr float W8_SCALE = 32.0f, A8_SCALE = 4.0f, WD8_SCALE = 16.0f;
DI int up_src_col(int np) {
  const int slab = np >> 5, pos = np & 31, q = pos & 15, hh = (q >> 2) & 1, i = (q & 3) + 4 * (q >> 3);
  return (pos >> 4) * 512 + slab * 16 + 8 * hh + i;
}
DI void phase_cvt_moe(KP p, int layer, char* smem) {
  char* const ws = ows(p);
  float* tile = (float*)smem;
  bf16_t* wm = (bf16_t*)(ws + OFF_WMOE);
  const int tid = otid();
  const int NUP = 32 * 256, NDN = 32 * 128;
  for (int it = obid(); it < NUP + NDN; it += gridDim.x) {
    if (it < NUP) {
      const int e = it >> 8, t = it & 255, kt = t >> 4, nt = t & 15, k0 = kt * 64, n0 = nt * 64;
      const float* src = gin(p, 38) + ((size_t)(layer * 32 + e) * 1024) * 1024;
      __syncthreads();
#pragma unroll
      for (int i = 0; i < 8; ++i) { const int idx = tid + i * NTH, r = idx >> 6, c = idx & 63; tile[r * 65 + c] = src[(size_t)(k0 + r) * 1024 + up_src_col(n0 + c)]; }
      __syncthreads();
      const int n = tid >> 3, k8 = (tid & 7) * 8;
      u32x2 o;
      o.x = pk4_fp8(tile[(k8 + 0) * 65 + n] * W8_SCALE, tile[(k8 + 1) * 65 + n] * W8_SCALE, tile[(k8 + 2) * 65 + n] * W8_SCALE, tile[(k8 + 3) * 65 + n] * W8_SCALE);
      o.y = pk4_fp8(tile[(k8 + 4) * 65 + n] * W8_SCALE, tile[(k8 + 5) * 65 + n] * W8_SCALE, tile[(k8 + 6) * 65 + n] * W8_SCALE, tile[(k8 + 7) * 65 + n] * W8_SCALE);
      *(u32x2*)((unsigned char*)wm + (size_t)e * 1024 * 1024 + (size_t)(n0 + n) * 1024 + k0 + k8) = o;
    } else {
      const int i2 = it - NUP, e = i2 >> 7, t = i2 & 127;
      const int kt = t >> 4, nt = t & 15, k0 = kt * 64, n0 = nt * 64;
      const float* src = gin(p, 39) + ((size_t)(layer * 32 + e) * 512) * 1024;
      __syncthreads();
#pragma unroll
      for (int i = 0; i < 8; ++i) { const int idx = tid + i * NTH, r = idx >> 6, c = idx & 63; tile[r * 65 + c] = src[(size_t)(k0 + r) * 1024 + n0 + c]; }
      __syncthreads();
      const int n = tid >> 3, k8 = (tid & 7) * 8;
      u32x2 o;
      o.x = pk4_fp8(tile[(k8 + 0) * 65 + n] * WD8_SCALE, tile[(k8 + 1) * 65 + n] * WD8_SCALE, tile[(k8 + 2) * 65 + n] * WD8_SCALE, tile[(k8 + 3) * 65 + n] * WD8_SCALE);
      o.y = pk4_fp8(tile[(k8 + 4) * 65 + n] * WD8_SCALE, tile[(k8 + 5) * 65 + n] * WD8_SCALE, tile[(k8 + 6) * 65 + n] * WD8_SCALE, tile[(k8 + 7) * 65 + n] * WD8_SCALE);
      *(u32x2*)((unsigned char*)(wm + WMOE_DOWN) + (size_t)e * 1024 * 512 + (size_t)(n0 + n) * 512 + k0 + k8) = o;
    }
  }
}

constexpr int MOD_LDS = 17 * 1024 * 4 + 8 * 17 * 64 * 4;
DI void phase_mod(KP p, char* smem) {
  char* const ws = ows(p);
  float* sc = (float*)smem;
  float* red = sc + 17 * 1024;
  const int tid = otid();
  for (int i = tid; i < 17 * 1024; i += NTH) {
    const int bi = i >> 10, k = i & 1023;
    const float v = bi < 16 ? gin(p, 1)[bi * 1024 + k] : gin(p, 3)[k];
    sc[i] = v / (1.0f + __expf(-v));
  }
  __syncthreads();
  const int col = tid & 63, ks = tid >> 6;
  for (int it = obid(); it < 4 * 96; it += gridDim.x) {
    const int l = it / 96, j = (it % 96) * 64 + col;
    const float* w = gin(p, 4) + (size_t)l * 1024 * 6144 + j;
    float acc[17];
#pragma unroll
    for (int b = 0; b < 17; ++b) acc[b] = 0.f;
    for (int k = ks * 128; k < ks * 128 + 128; ++k) {
      const float wv = w[(size_t)k * 6144];
#pragma unroll
      for (int b = 0; b < 17; ++b) acc[b] += sc[b * 1024 + k] * wv;
    }
    __syncthreads();
#pragma unroll
    for (int b = 0; b < 17; ++b) red[(ks * 17 + b) * 64 + col] = acc[b];
    __syncthreads();
    for (int o = tid; o < 17 * 64; o += NTH) {
      const int b = o >> 6, c = o & 63;
      float s = 0.f;
#pragma unroll
      for (int q = 0; q < 8; ++q) s += red[(q * 17 + b) * 64 + c];
      const int jj = (it % 96) * 64 + c;
      ((float*)(ws + OFF_MOD))[(size_t)(l * 17 + b) * 6144 + jj] = s + gin(p, 5)[l * 6144 + jj];
    }
  }
  {
    bf16_t* wr = (bf16_t*)(ws + OFF_WR);
    for (int i = obid() * NTH + tid; i < 4 * 48 * 1024; i += gridDim.x * NTH) {
      const int l = i / (48 * 1024), n = (i / 1024) % 48, k = i & 1023;
      float w = 0.f;
      if (n < 4) w = gin(p, 34)[((size_t)l * 1024 + k) * 4 + n];
      else if (n < 36) w = gin(p, 36)[((size_t)l * 1024 + k) * 32 + (n - 4)];
      const bf16_t hi = f2bf(w);
      wr[((size_t)(l * 2 + 0) * 48 + n) * 1024 + k] = hi;
      wr[((size_t)(l * 2 + 1) * 48 + n) * 1024 + k] = f2bf(w - bf2f(hi));
    }
  }
  if (obid() == 0) {
    float* rc = (float*)(ws + OFF_ROPE);
    for (int i = tid; i < 1024; i += NTH) {
      const int pos = i >> 4, f = i & 15;
      const float inv = powf(10000.0f, -(float)f / 16.0f);
      const float ang = (float)pos * inv;
      rc[i] = cosf(ang); rc[1024 + i] = sinf(ang);
    }
  }
}

DI void moe_blkstart(char* ws, int layer, int* bs  ) {
  if (otid() == 0) {
    const int* cnt = (const int*)(ws + OFF_CNT) + layer * 32;
    int s = 0;
    for (int e = 0; e < 32; ++e) { bs[e] = s; s += (cnt[e] + MOE_PAD - 1) / MOE_PAD; }
    bs[32] = s;
  }
  __syncthreads();
}
template <int MODE, bool DRY = false, bool OUT8 = false>
DI void phase_norm1(KP p, int layer, char* smem) {
  char* const ws = ows(p);
  int* bs = (int*)smem;
  if (MODE != 0) moe_blkstart(ws, MODE == 3 ? 3 : layer - 1, bs);
  const int lane = otid() & 63, wid = otid() >> 6;
  const int nrows = MODE == 3 ? TL : TT;
  const bf16_t* yb = (const bf16_t*)(ws + OFF_U + UM_YB);
  const int* tok = (const int*)(ws + OFF_TOK);
  bf16_t* hb = (bf16_t*)(ws + OFF_H);
  const int stride = gridDim.x * 8;
  for (int rA = obid() * 8 + wid; rA < nrows; rA += 2 * stride) {
    const int rB = rA + stride;
    const bool hasB = rB < nrows;
    const int rr[2] = {rA, hasB ? rB : rA};
    f32x4 v[2][4];
    int4 t0[2], t1[2];
#pragma unroll
    for (int k = 0; k < 2; ++k) {
      const int r = rr[k];
      if (MODE == 0) {
        const float* src = r < TL ? gin(p, 0) + (size_t)r * DM : gin(p, 2) + (size_t)(r - TL) * DM;
#pragma unroll
        for (int i = 0; i < 4; ++i) v[k][i] = *(const f32x4*)(src + (i * 64 + lane) * 4);
      } else {
        const bf16_t* xr = xrow_ptr(p, ws, r);
#pragma unroll
        for (int i = 0; i < 4; ++i) v[k][i] = ldbf4(xr + (i * 64 + lane) * 4);
        t0[k] = *(const int4*)(tok + (size_t)r * 8);
        t1[k] = *(const int4*)(tok + (size_t)r * 8 + 4);
      }
    }
    if (MODE == 1 || MODE == 3) {
      const int pl = MODE == 3 ? 3 : layer - 1;
      u32x2 ya[2][4], yc[2][4];
#pragma unroll
      for (int k = 0; k < 2; ++k) {
        const size_t d0 = (size_t)(bs[t0[k].x] * MOE_PAD + t0[k].y), d1 = (size_t)(bs[t0[k].z] * MOE_PAD + t0[k].w);
#pragma unroll
        for (int i = 0; i < 4; ++i) { const int ch = (i * 64 + lane) * 4; ya[k][i] = *(const u32x2*)(yb + d0 * DM + ch); yc[k][i] = *(const u32x2*)(yb + d1 * DM + ch); }
      }
#pragma unroll
      for (int k = 0; k < 2; ++k) {
        const float w0 = __int_as_float(t1[k].x), w1 = __int_as_float(t1[k].y);
        const float* g2 = modp(ws, pl, row_bi(rr[k]), 5);
#pragma unroll
        for (int i = 0; i < 4; ++i) {
          const int ch = (i * 64 + lane) * 4;
          const u32x2 a = ya[k][i], b = yc[k][i];
          const f32x4 g = *(const f32x4*)(g2 + ch);
          v[k][i][0] += g[0] * (w0 * bflo(a.x) + w1 * bflo(b.x));
          v[k][i][1] += g[1] * (w0 * bfhi(a.x) + w1 * bfhi(b.x));
          v[k][i][2] += g[2] * (w0 * bflo(a.y) + w1 * bflo(b.y));
          v[k][i][3] += g[3] * (w0 * bfhi(a.y) + w1 * bfhi(b.y));
        }
      }
    }
#pragma unroll
    for (int k = 0; k < 2; ++k) {
      if (k == 1 && !hasB) break;
      const int r = rr[k], bi = row_bi(r);
      bf16_t* xr = xrow_ptr(p, ws, r);
      if ((MODE == 0 || MODE == 1) && !DRY) {
#pragma unroll
        for (int i = 0; i < 4; ++i) stbf4(xr + (i * 64 + lane) * 4, v[k][i]);
      }
      float ss = 0.f;
#pragma unroll
      for (int i = 0; i < 4; ++i) ss += v[k][i][0] * v[k][i][0] + v[k][i][1] * v[k][i][1] + v[k][i][2] * v[k][i][2] + v[k][i][3] * v[k][i][3];
      ss = wave_sum(ss);
      const float rs = rsqrtf(ss * (1.0f / 1024.0f) + 1e-6f);
      if (MODE == 3) {
#pragma unroll
        for (int i = 0; i < 4; ++i) {
          const int ch = (i * 64 + lane) * 4;
          const f32x4 g = *(const f32x4*)(gin(p, 7) + ch);
          f32x4 o; o[0] = v[k][i][0] * rs * g[0]; o[1] = v[k][i][1] * rs * g[1]; o[2] = v[k][i][2] * rs * g[2]; o[3] = v[k][i][3] * rs * g[3];
          if (!DRY) *(f32x4*)(gout(p) + (size_t)r * DM + ch) = o; else asm volatile("" :: "v"(o[0]), "v"(o[1]), "v"(o[2]), "v"(o[3]));
        }
      } else {
        const float* gn = gin(p, 6) + (size_t)(layer * 2 + 0) * DM;
        const float* sh = modp(ws, layer, bi, 0);
        const float* sc = modp(ws, layer, bi, 1);
#pragma unroll
        for (int i = 0; i < 4; ++i) {
          const int ch = (i * 64 + lane) * 4;
          const f32x4 g = *(const f32x4*)(gn + ch), s1 = *(const f32x4*)(sc + ch), s0 = *(const f32x4*)(sh + ch);
          float o[4];
#pragma unroll
          for (int j = 0; j < 4; ++j) o[j] = v[k][i][j] * rs * g[j] * (1.0f + s1[j]) + s0[j];
          if constexpr (OUT8) {
            const unsigned w8 = pk4_fp8(o[0] * X8_SCALE, o[1] * X8_SCALE, o[2] * X8_SCALE, o[3] * X8_SCALE);
            if (!DRY) *(unsigned*)((unsigned char*)(ws + OFF_H8) + (size_t)r * DM + ch) = w8; else asm volatile("" :: "v"(w8));
          } else {
            u32x2 w; w.x = pk2(o[0], o[1]); w.y = pk2(o[2], o[3]);
            if (!DRY) *(u32x2*)(hb + (size_t)r * DM + ch) = w; else asm volatile("" :: "v"(w.x), "v"(w.y));
          }
        }
      }
    }
  }
}

constexpr int R2_TLD = 1032;
constexpr int R2_LLD = 49;
constexpr int R2_LDS = 64 * R2_TLD * 2 + 64 * R2_LLD * 4;
template <bool DRY = false>
DI void phase_norm2_router(KP p, int layer, char* smem) {
  char* const ws = ows(p);
  const int tid = otid(), lane = tid & 63, wid = tid >> 6, fr = lane & 15, fq = lane >> 4;
  bf16_t* tile = (bf16_t*)smem;
  float* lgt = (float*)(smem + 64 * R2_TLD * 2);
  const int nrows = layer == 3 ? TL : TT;
  unsigned char* h8 = (unsigned char*)(ws + OFF_H8);
  int* tok = (int*)(ws + OFF_TOK);
  int* rowl = (int*)(ws + OFF_ROWL);
  int* cnt = (int*)(ws + OFF_CNT) + layer * 32;
  const float* bg = gin(p, 35) + layer * 4;
  const float* be = gin(p, 37) + layer * 32;
  const float* gn = gin(p, 6) + (size_t)(layer * 2 + 1) * DM;
  const bf16_t* wrh = (const bf16_t*)(ws + OFF_WR) + (size_t)layer * 2 * 48 * 1024;
  const bf16_t* wrl = wrh + 48 * 1024;
  bf16x8 bh[4][3], bl[4][3];
#pragma unroll
  for (int ks = 0; ks < 4; ++ks)
#pragma unroll
    for (int nt = 0; nt < 3; ++nt) {
      const size_t o = (size_t)(nt * 16 + fr) * 1024 + wid * 128 + ks * 32 + fq * 8;
      bh[ks][nt] = *(const bf16x8*)(wrh + o); bl[ks][nt] = *(const bf16x8*)(wrl + o);
    }
  for (int rbase = obid() * 64; rbase < nrows; rbase += gridDim.x * 64) {
    const int bi = row_bi(rbase);
    const float* sh = modp(ws, layer, bi, 3);
    const float* sc = modp(ws, layer, bi, 4);
    f32x4 gs[4], s0[4];
#pragma unroll
    for (int i = 0; i < 4; ++i) {
      const int ch = (i * 64 + lane) * 4;
      const f32x4 g = *(const f32x4*)(gn + ch), s1 = *(const f32x4*)(sc + ch);
      gs[i] = g * (1.0f + s1); s0[i] = *(const f32x4*)(sh + ch);
    }
#pragma unroll 2
    for (int q = 0; q < 8; ++q) {
      const int lr = wid * 8 + q, r = rbase + lr;
      const bf16_t* xr = xrow_ptr(p, ws, r);
      f32x4 v[4];
      float ss = 0.f;
#pragma unroll
      for (int i = 0; i < 4; ++i) { v[i] = ldbf4(xr + (i * 64 + lane) * 4); ss += v[i][0] * v[i][0] + v[i][1] * v[i][1] + v[i][2] * v[i][2] + v[i][3] * v[i][3]; }
      ss = wave_sum(ss);
      const float rs = rsqrtf(ss * (1.0f / 1024.0f) + 1e-6f);
#pragma unroll
      for (int i = 0; i < 4; ++i) {
        const int ch = (i * 64 + lane) * 4;
        const f32x4 o = v[i] * rs * gs[i] + s0[i];
        u32x2 w; w.x = pk2(o[0], o[1]); w.y = pk2(o[2], o[3]);
        *(unsigned*)(h8 + (size_t)r * DM + ch) = pk4_fp8(o[0], o[1], o[2], o[3]);
        *(u32x2*)(tile + lr * R2_TLD + ch) = w;
      }
    }
    __syncthreads();
    {
      f32x4 acc[4][3];
#pragma unroll
      for (int rt = 0; rt < 4; ++rt)
#pragma unroll
        for (int nt = 0; nt < 3; ++nt) acc[rt][nt] = (f32x4){0.f, 0.f, 0.f, 0.f};
#pragma unroll
      for (int ks = 0; ks < 4; ++ks)
#pragma unroll
        for (int rt = 0; rt < 4; ++rt) {
          const bf16x8 a = *(const bf16x8*)(tile + (rt * 16 + fr) * R2_TLD + wid * 128 + ks * 32 + fq * 8);
#pragma unroll
          for (int nt = 0; nt < 3; ++nt) { acc[rt][nt] = MFMA16(a, bh[ks][nt], acc[rt][nt]); acc[rt][nt] = MFMA16(a, bl[ks][nt], acc[rt][nt]); }
        }
      __syncthreads();
      float* part = (float*)smem + wid * 64 * R2_LLD;
#pragma unroll
      for (int rt = 0; rt < 4; ++rt)
#pragma unroll
        for (int nt = 0; nt < 3; ++nt)
#pragma unroll
          for (int j = 0; j < 4; ++j) part[(rt * 16 + fq * 4 + j) * R2_LLD + nt * 16 + fr] = acc[rt][nt][j];
    }
    __syncthreads();
    for (int i = tid; i < 64 * 36; i += NTH) {
      const int row = i / 36, col = i - row * 36;
      const float* pp = (const float*)smem + row * R2_LLD + col;
      float sacc = 0.f;
#pragma unroll
      for (int w = 0; w < 8; ++w) sacc += pp[w * 64 * R2_LLD];
      lgt[row * R2_LLD + col] = sacc;
    }
    __syncthreads();
    if (wid == 0) {
      const int r = rbase + lane;
      float* lr_ = lgt + lane * R2_LLD;
      float lg[4];
#pragma unroll
      for (int q = 0; q < 4; ++q) lg[q] = lr_[q] + bg[q];
      int gsel = 0; float gm = lg[0];
#pragma unroll
      for (int q = 1; q < 4; ++q) if (lg[q] > gm) { gm = lg[q]; gsel = q; }
      float gden = 0.f;
#pragma unroll
      for (int q = 0; q < 4; ++q) gden += __expf(lg[q] - gm);
      const float pgrp = 1.0f / gden;
      float le[8];
#pragma unroll
      for (int q = 0; q < 8; ++q) le[q] = lr_[4 + gsel * 8 + q] + be[gsel * 8 + q];
      int i0 = 0; float m0 = le[0];
#pragma unroll
      for (int q = 1; q < 8; ++q) if (le[q] > m0) { m0 = le[q]; i0 = q; }
      int i1 = -1; float m1 = -3.0e38f;
#pragma unroll
      for (int q = 0; q < 8; ++q) if (q != i0 && le[q] > m1) { m1 = le[q]; i1 = q; }
      const float e1 = __expf(m1 - m0);
      const float w0 = pgrp / (1.0f + e1), w1 = pgrp * e1 / (1.0f + e1);
      if (DRY) asm volatile("" :: "v"(w0), "v"(w1), "v"(i0), "v"(i1), "v"(gsel));
      if (!DRY) {
        const int ea = gsel * 8 + i0, eb = gsel * 8 + i1;
        const int pa = atomicAdd(&cnt[ea], 1), pb = atomicAdd(&cnt[eb], 1);
        rowl[(size_t)ea * CAP + pa] = r; rowl[(size_t)eb * CAP + pb] = r;
        int4 t0; t0.x = ea; t0.y = pa; t0.z = eb; t0.w = pb;
        int4 t1; t1.x = __float_as_int(w0); t1.y = __float_as_int(w1); t1.z = 0; t1.w = 0;
        *(int4*)(tok + (size_t)r * 8) = t0; *(int4*)(tok + (size_t)r * 8 + 4) = t1;
      }
    }
  }
}

DI void st_bf16x4(bf16_t* p, const f32x4& v) { u32x2 w; w.x = pk2(v[0], v[1]); w.y = pk2(v[2], v[3]); *(u32x2*)p = w; }
constexpr int FG_LDS = fg::STAGE_BYTES;
constexpr int MOE_UMAX = 12;

struct MoeSched {
  const char* A; const char* B; const LAS int* bs; const LAS int* rowtab; int G, c, ntile; size_t tA, eB, tB;
  DI bool next(int i, fg::Unit& u) const {
    const int rt = (G & 31) ? (i * G + c) >> 2 : i * (G >> 2) + (c & 7) * (G >> 5) + (c >> 5), ct = (G & 31) ? (i * G + c) & 3 : (c >> 3) & 3;
    if (rt >= ntile) return false;
    int e = 0;
#pragma unroll 1
    while (e < 31 && bs[e + 1] <= rt) ++e;
    u.pm = rt; u.pn = ct; u.aux = e; u.A = A + (size_t)rt * tA; u.B = B + (size_t)e * eB + (size_t)ct * tB; return true;
  }
  DI const LAS int* rows(int i) const { return rowtab + i * 256; }
};
DI void phase_moe_up(KP p, int layer, char* smem) {
  char* const ws = ows(p);
  LAS unsigned char* lds = (LAS unsigned char*)smem;
  LAS int* rowtab = (LAS int*)(lds + FG_LDS);
  int* bs = (int*)(smem + FG_LDS + MOE_UMAX * 1024);
  moe_blkstart(ws, layer, bs);
  const int* cnt = (const int*)(ws + OFF_CNT) + layer * 32;
  const int* rowl = (const int*)(ws + OFF_ROWL);
  unsigned char* act8 = (unsigned char*)(ws + OFF_U + UM_ACT);
  MoeSched S;
  S.A = ws + OFF_H8; S.B = ws + OFF_WMOE; S.bs = (const LAS int*)bs; S.rowtab = rowtab; S.G = gridDim.x; S.c = obid(); S.ntile = bs[32];
  S.tA = 0; S.eB = (size_t)1024 * 1024; S.tB = (size_t)256 * 1024;
  {
    const int tid = otid();
    fg::Unit u;
    for (int i = 0; i < MOE_UMAX && S.next(i, u); ++i) {
      if (tid < 256) {
        const int e = u.aux, pos = (u.pm - bs[e]) * 256 + tid;
        rowtab[i * 256 + tid] = pos < cnt[e] ? rowl[(size_t)e * CAP + pos] : TT;
      }
    }
    __syncthreads();
  }
  auto ep = [&](const f32x16 (&acc)[2][2][2], const fg::Unit& u, int wr, int wc, int r, int h) {
    constexpr float inv = 1.0f / W8_SCALE;
#pragma unroll
    for (int ai = 0; ai < 2; ++ai)
#pragma unroll
      for (int m = 0; m < 2; ++m) {
        const size_t row = (size_t)u.pm * 256 + ai * 128 + wr * 64 + m * 32 + r;
#pragma unroll
        for (int bj = 0; bj < 2; ++bj) {
          const int acol = ((u.pn * 256 + bj * 128 + wc * 32) >> 5) * 16 + 8 * h;
          float o[8];
#pragma unroll
          for (int i = 0; i < 8; ++i) { const float g = acc[ai][bj][m][i] * inv, uu = acc[ai][bj][m][i + 8] * inv; o[i] = g * __builtin_amdgcn_rcpf(1.0f + __expf(-g)) * uu; }
          u32x2 w8; w8.x = pk4_fp8(o[0] * A8_SCALE, o[1] * A8_SCALE, o[2] * A8_SCALE, o[3] * A8_SCALE); w8.y = pk4_fp8(o[4] * A8_SCALE, o[5] * A8_SCALE, o[6] * A8_SCALE, o[7] * A8_SCALE);
          *(u32x2*)(act8 + row * 512 + acol) = w8;
        }
      }
  };
  fg::gemm_phase_f8<true>(lds, 512, 512, 512, S, ep);
}
DI void phase_moe_down(KP p, int layer, char* smem) {
  char* const ws = ows(p);
  LAS unsigned char* lds = (LAS unsigned char*)smem;
  int* bs = (int*)(smem + FG_LDS + MOE_UMAX * 1024);
  moe_blkstart(ws, layer, bs);
  bf16_t* yb = (bf16_t*)(ws + OFF_U + UM_YB);
  MoeSched S;
  S.A = ws + OFF_U + UM_ACT; S.B = ws + OFF_WMOE + WMOE_DOWN * 2; S.bs = (const LAS int*)bs; S.rowtab = nullptr; S.G = gridDim.x; S.c = obid(); S.ntile = bs[32];
  S.tA = (size_t)256 * 512; S.eB = (size_t)1024 * 512; S.tB = (size_t)256 * 512;
  auto ep = [&](const f32x16 (&acc)[2][2][2], const fg::Unit& u, int wr, int wc, int r, int h) {
    constexpr float inv = 1.0f / (A8_SCALE * WD8_SCALE);
#pragma unroll
    for (int ai = 0; ai < 2; ++ai)
#pragma unroll
      for (int m = 0; m < 2; ++m) {
        const size_t row = (size_t)u.pm * 256 + ai * 128 + wr * 64 + m * 32 + r;
#pragma unroll
        for (int bj = 0; bj < 2; ++bj) {
          const f32x16& a = acc[ai][bj][m];
          u32x4 w0, w1;
          w0.x = pk2(a[0] * inv, a[1] * inv); w0.y = pk2(a[2] * inv, a[3] * inv); w0.z = pk2(a[4] * inv, a[5] * inv); w0.w = pk2(a[6] * inv, a[7] * inv);
          w1.x = pk2(a[8] * inv, a[9] * inv); w1.y = pk2(a[10] * inv, a[11] * inv); w1.z = pk2(a[12] * inv, a[13] * inv); w1.w = pk2(a[14] * inv, a[15] * inv);
          bf16_t* q = yb + row * DM + u.pn * 256 + bj * 128 + wc * 32 + 16 * h;
          *(u32x4*)q = w0; *(u32x4*)(q + 8) = w1;
        }
      }
  };
  fg::gemm_phase_f8<false, true>(lds, 256, 256, 256, S, ep);
}

template <int NKC>
DI void phase_qkv(KP p, const bf16_t* Wt, bf16_t* Q, bf16_t* Kb, bf16_t* Vb, char* smem) {
  char* const ws = ows(p);
  LAS unsigned char* lds = (LAS unsigned char*)smem;
  constexpr int N = 1024 + 2 * NKC;
  const float* rc = (const float*)(ws + OFF_ROPE);
  fg::DenseSched S;
  S.A = ws + OFF_H; S.B = (const char*)Wt; S.nM = TT / 256; S.nN = N / 256; S.G = gridDim.x; S.c = obid(); S.tA = (size_t)256 * 1024 * 2; S.tB = (size_t)256 * 1024 * 2;
  auto ep = [&](const f32x4 (&acc)[2][2][4][2], const fg::Unit& u, int wr, int wc, int fr, int fq) {
#pragma unroll
    for (int bj = 0; bj < 2; ++bj) {
      const int colb = u.pn * 256 + bj * 128 + wc * 32;
      if (colb < 1024 + NKC) {
        const bool isq = colb < 1024;
        bf16_t* dst = isq ? Q : Kb;
        const int ldd = isq ? 1024 : NKC, cc2 = (isq ? colb : colb - 1024) + 8 * fq;
        const float qs = isq ? 0.125f : 1.0f;
#pragma unroll
        for (int ai = 0; ai < 2; ++ai)
#pragma unroll
          for (int m = 0; m < 4; ++m) {
            const int row = u.pm * 256 + ai * 128 + wr * 64 + m * 16 + fr;
            f32x4 x0 = acc[ai][bj][m][0], x1 = acc[ai][bj][m][1];
            if (row < TL) {
              const int s = row & 4095, idx = (colb & 32) ? (s & 63) : (s >> 6);
              const f32x4 c = *(const f32x4*)(rc + idx * 16 + 4 * fq), sn = *(const f32x4*)(rc + 1024 + idx * 16 + 4 * fq);
              const f32x4 o0 = x0 * c - x1 * sn, o1 = x1 * c + x0 * sn;
              x0 = o0; x1 = o1;
            }
            const f32x4 y0 = x0 * qs, y1 = x1 * qs;
            if (NKC == 1024 && !isq) {
              u32x2 w8; w8.x = pk4_fp8(y0[0], y0[1], y0[2], y0[3]); w8.y = pk4_fp8(y1[0], y1[1], y1[2], y1[3]);
              *(u32x2*)((unsigned char*)Kb + (size_t)row * 1024 + cc2) = w8;
            } else {
              u32x4 w; w.x = pk2(y0[0], y0[1]); w.y = pk2(y0[2], y0[3]); w.z = pk2(y1[0], y1[1]); w.w = pk2(y1[2], y1[3]);
              *(u32x4*)(dst + (size_t)row * ldd + cc2) = w;
            }
          }
      } else {
        const int cv = colb - (1024 + NKC) + 4 * fq;
        if constexpr (NKC == 1024) {
          unsigned char* Vt = (unsigned char*)Vb;
          const int tq = fr & 3;
#pragma unroll
          for (int ai = 0; ai < 2; ++ai)
#pragma unroll
            for (int m = 0; m < 4; ++m) {
              const int row = u.pm * 256 + ai * 128 + wr * 64 + m * 16 + fr, rowq = row & ~3;
              size_t base; int kq;
              if (rowq < TL) { const int b = rowq >> 12, s0 = rowq & 4095; base = (size_t)b * 1024 * 4096 + (size_t)(s0 >> 6) * 64; kq = (s0 & 63) >> 2; }
              else { const int rc2 = rowq - TL, b = rc2 >> 8, c0 = rc2 & 255; base = (size_t)16 * 1024 * 4096 + (size_t)b * 1024 * 256 + (size_t)(c0 >> 6) * 64; kq = (c0 & 63) >> 2; }
              const size_t rstride = rowq < TL ? 4096 : 256;
              const int pos = 32 * (kq & 1) + 16 * (kq >> 3) + 4 * ((kq >> 1) & 3);
#pragma unroll
              for (int n = 0; n < 2; ++n) {
                const f32x4 a = acc[ai][bj][m][n];
                const int d = (int)pk4_fp8(a[0], a[1], a[2], a[3]);
                const int d0 = __builtin_amdgcn_update_dpp(0, d, 0x00, 0xF, 0xF, true), d1 = __builtin_amdgcn_update_dpp(0, d, 0x55, 0xF, 0xF, true);
                const int d2 = __builtin_amdgcn_update_dpp(0, d, 0xAA, 0xF, 0xF, true), d3 = __builtin_amdgcn_update_dpp(0, d, 0xFF, 0xF, 0xF, true);
                const int sh = 8 * tq;
                const unsigned w = ((unsigned)(d0 >> sh) & 0xffu) | (((unsigned)(d1 >> sh) & 0xffu) << 8) | (((unsigned)(d2 >> sh) & 0xffu) << 16) | (((unsigned)(d3 >> sh) & 0xffu) << 24);
                *(unsigned*)(Vt + base + (size_t)(cv + 16 * n + tq) * rstride + pos) = w;
              }
            }
        } else {
#pragma unroll
          for (int ai = 0; ai < 2; ++ai)
#pragma unroll
            for (int m = 0; m < 4; ++m) {
              const int row = u.pm * 256 + ai * 128 + wr * 64 + m * 16 + fr;
              st_bf16x4(Vb + (size_t)row * NKC + cv, acc[ai][bj][m][0]);
              st_bf16x4(Vb + (size_t)row * NKC + cv + 16, acc[ai][bj][m][1]);
            }
        }
      }
    }
  };
  fg::gemm_phase<false>(lds, 1024, 1024, 1024, S, ep);
}

DI void phase_qkv_diff8(KP p, char* smem) {
  char* const ws = ows(p);
  LAS unsigned char* lds = (LAS unsigned char*)smem;
  const float* rc = (const float*)(ws + OFF_ROPE);
  bf16_t* Q = (bf16_t*)(ws + OFF_U + U1_Q);
  unsigned char* K8 = (unsigned char*)(ws + OFF_U + U1_K);
  unsigned char* Vt = (unsigned char*)(ws + OFF_U + U1_V);
  fg::DenseSched S;
  S.A = ws + OFF_H8; S.B = ws + OFF_WMIX + W_DIFFQKV * 2; S.nM = TT / 256; S.nN = 12; S.G = gridDim.x; S.c = obid(); S.tA = (size_t)256 * 1024; S.tB = (size_t)256 * 1024;
  auto ep = [&](const f32x16 (&acc)[2][2][2], const fg::Unit& u, int wr, int wc, int r, int h) {
    constexpr float inv = 1.0f / (X8_SCALE * 32.0f);
#pragma unroll
    for (int bj = 0; bj < 2; ++bj) {
      const int colb = u.pn * 256 + bj * 128 + wc * 32;
      if (colb < 2048) {
        const bool isq = colb < 1024;
        const float qs = (isq ? 0.125f : 1.0f) * inv;
#pragma unroll
        for (int ai = 0; ai < 2; ++ai)
#pragma unroll
          for (int m = 0; m < 2; ++m) {
            const int row = u.pm * 256 + ai * 128 + wr * 64 + m * 32 + r;
            const f32x16& a = acc[ai][bj][m];
            float y[16];
            if (row < TL) {
              const int s = row & 4095, idx = (colb & 32) ? (s & 63) : (s >> 6);
              const f32x4 c0 = *(const f32x4*)(rc + idx * 16 + 4 * h), c1 = *(const f32x4*)(rc + idx * 16 + 8 + 4 * h);
              const f32x4 s0 = *(const f32x4*)(rc + 1024 + idx * 16 + 4 * h), s1 = *(const f32x4*)(rc + 1024 + idx * 16 + 8 + 4 * h);
#pragma unroll
              for (int i = 0; i < 8; ++i) {
                const float cc = i < 4 ? c0[i & 3] : c1[i & 3], sn = i < 4 ? s0[i & 3] : s1[i & 3];
                y[i] = (a[i] * cc - a[i + 8] * sn) * qs; y[i + 8] = (a[i + 8] * cc + a[i] * sn) * qs;
              }
            } else {
#pragma unroll
              for (int i = 0; i < 16; ++i) y[i] = a[i] * qs;
            }
            if (isq) {
              u32x4 w0, w1;
              w0.x = pk2(y[0], y[1]); w0.y = pk2(y[2], y[3]); w0.z = pk2(y[4], y[5]); w0.w = pk2(y[6], y[7]);
              w1.x = pk2(y[8], y[9]); w1.y = pk2(y[10], y[11]); w1.z = pk2(y[12], y[13]); w1.w = pk2(y[14], y[15]);
              bf16_t* q = Q + (size_t)row * 1024 + colb + 16 * h;
              *(u32x4*)q = w0; *(u32x4*)(q + 8) = w1;
            } else {
              u32x4 w8;
              w8.x = pk4_fp8(y[0], y[1], y[2], y[3]); w8.y = pk4_fp8(y[4], y[5], y[6], y[7]); w8.z = pk4_fp8(y[8], y[9], y[10], y[11]); w8.w = pk4_fp8(y[12], y[13], y[14], y[15]);
              *(u32x4*)(K8 + (size_t)row * 1024 + (colb - 1024) + 16 * h) = w8;
            }
          }
      } else {
        const int cv = colb - 2048 + 4 * h, tq = r & 3;
#pragma unroll
        for (int ai = 0; ai < 2; ++ai)
#pragma unroll
          for (int m = 0; m < 2; ++m) {
            const int row = u.pm * 256 + ai * 128 + wr * 64 + m * 32 + r, rowq = row & ~3;
            size_t base; int kq;
            if (rowq < TL) { const int b = rowq >> 12, s0 = rowq & 4095; base = (size_t)b * 1024 * 4096 + (size_t)(s0 >> 6) * 64; kq = (s0 & 63) >> 2; }
            else { const int rc2 = rowq - TL, b = rc2 >> 8, c0 = rc2 & 255; base = (size_t)16 * 1024 * 4096 + (size_t)b * 1024 * 256 + (size_t)(c0 >> 6) * 64; kq = (c0 & 63) >> 2; }
            const size_t rstride = rowq < TL ? 4096 : 256;
            const int pos = 32 * (kq & 1) + 16 * (kq >> 3) + 4 * ((kq >> 1) & 3);
            const f32x16& a = acc[ai][bj][m];
#pragma unroll
            for (int g = 0; g < 4; ++g) {
              const int d = (int)pk4_fp8(a[4 * g] * inv, a[4 * g + 1] * inv, a[4 * g + 2] * inv, a[4 * g + 3] * inv);
              const int d0 = __builtin_amdgcn_update_dpp(0, d, 0x00, 0xF, 0xF, true), d1 = __builtin_amdgcn_update_dpp(0, d, 0x55, 0xF, 0xF, true);
              const int d2 = __builtin_amdgcn_update_dpp(0, d, 0xAA, 0xF, 0xF, true), d3 = __builtin_amdgcn_update_dpp(0, d, 0xFF, 0xF, 0xF, true);
              const int sh = 8 * tq;
              const unsigned w = ((unsigned)(d0 >> sh) & 0xffu) | (((unsigned)(d1 >> sh) & 0xffu) << 8) | (((unsigned)(d2 >> sh) & 0xffu) << 16) | (((unsigned)(d3 >> sh) & 0xffu) << 24);
              *(unsigned*)(Vt + base + (size_t)(cv + 8 * g + tq) * rstride + pos) = w;
            }
          }
      }
    }
  };
  fg::gemm_phase_f8<false, false>(lds, 512, 512, 512, S, ep);
}

DI void phase_qkv_win8(KP p, char* smem) {
  char* const ws = ows(p);
  LAS unsigned char* lds = (LAS unsigned char*)smem;
  const float* rc = (const float*)(ws + OFF_ROPE);
  bf16_t* Q = (bf16_t*)(ws + OFF_U + U0_Q);
  bf16_t* Kb = (bf16_t*)(ws + OFF_U + U0_K);
  bf16_t* Vb = (bf16_t*)(ws + OFF_U + U0_V);
  fg::DenseSched S;
  S.A = ws + OFF_H8; S.B = ws + OFF_WMIX + W_WINQKV * 2; S.nM = TT / 256; S.nN = 6; S.G = gridDim.x; S.c = obid(); S.tA = (size_t)256 * 1024; S.tB = (size_t)256 * 1024;
  auto ep = [&](const f32x16 (&acc)[2][2][2], const fg::Unit& u, int wr, int wc, int r, int h) {
    constexpr float inv = 1.0f / (X8_SCALE * 32.0f);
#pragma unroll
    for (int bj = 0; bj < 2; ++bj) {
      const int colb = u.pn * 256 + bj * 128 + wc * 32;
      if (colb < 1280) {
        const bool isq = colb < 1024;
        const float qs = (isq ? 0.125f : 1.0f) * inv;
        bf16_t* dst = isq ? Q + colb + 16 * h : Kb + (colb - 1024) + 16 * h;
        const int ldd = isq ? 1024 : 256;
#pragma unroll
        for (int ai = 0; ai < 2; ++ai)
#pragma unroll
          for (int m = 0; m < 2; ++m) {
            const int row = u.pm * 256 + ai * 128 + wr * 64 + m * 32 + r;
            const f32x16& a = acc[ai][bj][m];
            float y[16];
            if (row < TL) {
              const int s = row & 4095, idx = (colb & 32) ? (s & 63) : (s >> 6);
              const f32x4 c0 = *(const f32x4*)(rc + idx * 16 + 4 * h), c1 = *(const f32x4*)(rc + idx * 16 + 8 + 4 * h);
              const f32x4 s0 = *(const f32x4*)(rc + 1024 + idx * 16 + 4 * h), s1 = *(const f32x4*)(rc + 1024 + idx * 16 + 8 + 4 * h);
#pragma unroll
              for (int i = 0; i < 8; ++i) {
                const float cc = i < 4 ? c0[i & 3] : c1[i & 3], sn = i < 4 ? s0[i & 3] : s1[i & 3];
                y[i] = (a[i] * cc - a[i + 8] * sn) * qs; y[i + 8] = (a[i + 8] * cc + a[i] * sn) * qs;
              }
            } else {
#pragma unroll
              for (int i = 0; i < 16; ++i) y[i] = a[i] * qs;
            }
            u32x4 w0, w1;
            w0.x = pk2(y[0], y[1]); w0.y = pk2(y[2], y[3]); w0.z = pk2(y[4], y[5]); w0.w = pk2(y[6], y[7]);
            w1.x = pk2(y[8], y[9]); w1.y = pk2(y[10], y[11]); w1.z = pk2(y[12], y[13]); w1.w = pk2(y[14], y[15]);
            bf16_t* q = dst + (size_t)row * ldd;
            *(u32x4*)q = w0; *(u32x4*)(q + 8) = w1;
          }
      } else {
        const int cv = colb - 1280 + 4 * h;
#pragma unroll
        for (int ai = 0; ai < 2; ++ai)
#pragma unroll
          for (int m = 0; m < 2; ++m) {
            const int row = u.pm * 256 + ai * 128 + wr * 64 + m * 32 + r;
            const f32x16& a = acc[ai][bj][m];
#pragma unroll
            for (int g = 0; g < 4; ++g) {
              f32x4 v4; v4[0] = a[4 * g] * inv; v4[1] = a[4 * g + 1] * inv; v4[2] = a[4 * g + 2] * inv; v4[3] = a[4 * g + 3] * inv;
              st_bf16x4(Vb + (size_t)row * 256 + cv + 8 * g, v4);
            }
          }
      }
    }
  };
  fg::gemm_phase_f8<false, false>(lds, 512, 512, 512, S, ep);
}

template <bool DRY = false>
DI void phase_oproj(KP p, int layer, const bf16_t* A, const bf16_t* Wt, int nrows, char* smem) {
  char* const ws = ows(p);
  LAS unsigned char* lds = (LAS unsigned char*)smem;
  fg::DenseSched S;
  S.A = (const char*)A; S.B = (const char*)Wt; S.nM = nrows / 256; S.nN = 4; S.G = gridDim.x; S.c = obid(); S.tA = (size_t)256 * 1024 * 2; S.tB = (size_t)256 * 1024 * 2;
  auto ep = [&](const f32x4 (&acc)[2][2][4][2], const fg::Unit& u, int wr, int wc, int fr, int fq) {
    const int row0 = u.pm * 256 + wr * 64 + fr, colb = u.pn * 256 + wc * 32 + 4 * fq;
    const float* g1 = modp(ws, layer, row_bi(row0), 2) + colb;
    f32x4 g[2][2];
#pragma unroll
    for (int bj = 0; bj < 2; ++bj)
#pragma unroll
      for (int n = 0; n < 2; ++n) g[bj][n] = *(const f32x4*)(g1 + bj * 128 + n * 16);
    f32x4 xa[2][2], xb[2][2];
    bf16_t* xr = xrow_ptr(p, ws, row0) + colb;
#pragma unroll
    for (int bj = 0; bj < 2; ++bj)
#pragma unroll
      for (int n = 0; n < 2; ++n) xa[bj][n] = ldbf4(xr + bj * 128 + n * 16);
#pragma unroll
    for (int rr = 0; rr < 8; ++rr) {
      const int ai = rr >> 2, m = rr & 3;
      bf16_t* xn = xr;
      if (rr + 1 < 8) {
        xn = xrow_ptr(p, ws, row0 + ((rr + 1) >> 2) * 128 + ((rr + 1) & 3) * 16) + colb;
#pragma unroll
        for (int bj = 0; bj < 2; ++bj)
#pragma unroll
          for (int n = 0; n < 2; ++n) xb[bj][n] = ldbf4(xn + bj * 128 + n * 16);
      }
#pragma unroll
      for (int bj = 0; bj < 2; ++bj)
#pragma unroll
        for (int n = 0; n < 2; ++n) {
          const f32x4 x = xa[bj][n] + g[bj][n] * acc[ai][bj][m][n];
          if (!DRY) stbf4(xr + bj * 128 + n * 16, x); else asm volatile("" :: "v"(x[0]), "v"(x[1]), "v"(x[2]), "v"(x[3]));
        }
#pragma unroll
      for (int bj = 0; bj < 2; ++bj)
#pragma unroll
        for (int n = 0; n < 2; ++n) xa[bj][n] = xb[bj][n];
      xr = xn;
    }
  };
  fg::gemm_phase<false>(lds, 1024, 1024, 1024, S, ep);
}

template <bool DRY = false>
DI void phase_oproj8(KP p, int layer, const char* A8, const char* W8, int nrows, char* smem) {
  char* const ws = ows(p);
  LAS unsigned char* lds = (LAS unsigned char*)smem;
  fg::DenseSched S;
  S.A = A8; S.B = W8; S.nM = nrows / 256; S.nN = 4; S.G = gridDim.x; S.c = obid(); S.tA = (size_t)256 * 1024; S.tB = (size_t)256 * 1024;
  auto ep = [&](const f32x16 (&acc)[2][2][2], const fg::Unit& u, int wr, int wc, int r, int h) {
    constexpr float inv = 1.0f / (O8_SCALE * 32.0f);
    const int row0 = u.pm * 256 + wr * 64 + r, colb = u.pn * 256 + wc * 32 + 16 * h;
    const float* g1 = modp(ws, layer, row_bi(row0), 2) + colb;
#pragma unroll
    for (int bj = 0; bj < 2; ++bj) {
      f32x4 g[4];
#pragma unroll
      for (int q = 0; q < 4; ++q) g[q] = *(const f32x4*)(g1 + bj * 128 + 4 * q) * inv;
#pragma unroll
      for (int ai = 0; ai < 2; ++ai)
#pragma unroll
        for (int m = 0; m < 2; ++m) {
          bf16_t* xr = xrow_ptr(p, ws, row0 + ai * 128 + m * 32) + colb + bj * 128;
          const u32x4 x0 = ld16(xr), x1 = ld16(xr + 8);
          const f32x16& a = acc[ai][bj][m];
          u32x4 w0, w1;
          w0.x = pk2(bflo(x0.x) + g[0][0] * a[0], bfhi(x0.x) + g[0][1] * a[1]); w0.y = pk2(bflo(x0.y) + g[0][2] * a[2], bfhi(x0.y) + g[0][3] * a[3]);
          w0.z = pk2(bflo(x0.z) + g[1][0] * a[4], bfhi(x0.z) + g[1][1] * a[5]); w0.w = pk2(bflo(x0.w) + g[1][2] * a[6], bfhi(x0.w) + g[1][3] * a[7]);
          w1.x = pk2(bflo(x1.x) + g[2][0] * a[8], bfhi(x1.x) + g[2][1] * a[9]); w1.y = pk2(bflo(x1.y) + g[2][2] * a[10], bfhi(x1.y) + g[2][3] * a[11]);
          w1.z = pk2(bflo(x1.z) + g[3][0] * a[12], bfhi(x1.z) + g[3][1] * a[13]); w1.w = pk2(bflo(x1.w) + g[3][2] * a[14], bfhi(x1.w) + g[3][3] * a[15]);
          if (!DRY) { *(u32x4*)xr = w0; *(u32x4*)(xr + 8) = w1; } else asm volatile("" :: "v"(w0), "v"(w1));
        }
    }
  };
  fg::gemm_phase_f8<false, true>(lds, 512, 512, 512, S, ep);
}

DI void phase_pool_pre(KP p, char* smem) {
  char* const ws = ows(p);
  const int lane = otid() & 63, wid = otid() >> 6;
  const bf16_t* hb = (const bf16_t*)(ws + OFF_H);
  bf16_t* Y = (bf16_t*)(ws + OFF_U + U2_Y);
  const int ch0 = lane * 16, half = 1 << (lane >> 4);
  auto acc16 = [&](float (&a)[16], const bf16_t* q, float sg) __attribute__((always_inline)) {
    const u32x4 v0 = ld16(q), v1 = ld16(q + 8);
    a[0] += sg * bflo(v0.x); a[1] += sg * bfhi(v0.x); a[2] += sg * bflo(v0.y); a[3] += sg * bfhi(v0.y); a[4] += sg * bflo(v0.z); a[5] += sg * bfhi(v0.z); a[6] += sg * bflo(v0.w); a[7] += sg * bfhi(v0.w);
    a[8] += sg * bflo(v1.x); a[9] += sg * bfhi(v1.x); a[10] += sg * bflo(v1.y); a[11] += sg * bfhi(v1.y); a[12] += sg * bflo(v1.z); a[13] += sg * bfhi(v1.z); a[14] += sg * bflo(v1.w); a[15] += sg * bfhi(v1.w);
  };
  for (int seg = obid() * 8 + wid; seg < 2048 + 128; seg += gridDim.x * 8) {
    const int r0 = seg * 32;
    int s0, L;
    if (r0 < TL) { s0 = r0 & 4095; L = 4096; } else { s0 = (r0 - TL) & 255; L = 256; }
    const bf16_t* base = hb + (size_t)(r0 - s0) * DM + ch0;
    float a[16];
#pragma unroll
    for (int j = 0; j < 16; ++j) a[j] = 0.f;
    {
      const int lo = s0 - half < 0 ? 0 : s0 - half, hi = s0 + half > L ? L : s0 + half;
      for (int q = lo; q < hi; ++q) acc16(a, base + (size_t)q * DM, 1.0f);
    }
#pragma unroll 2
    for (int i = 0; i < 32; ++i) {
      const int s = s0 + i;
      const int lo = s - half < 0 ? 0 : s - half, hi = s + half > L ? L : s + half;
      const float inv = 1.0f / (float)(hi - lo);
      const u32x4 c0 = ld16(base + (size_t)s * DM), c1 = ld16(base + (size_t)s * DM + 8);
      u32x4 o0, o1;
      o0.x = pk2(a[0] * inv - bflo(c0.x), a[1] * inv - bfhi(c0.x)); o0.y = pk2(a[2] * inv - bflo(c0.y), a[3] * inv - bfhi(c0.y));
      o0.z = pk2(a[4] * inv - bflo(c0.z), a[5] * inv - bfhi(c0.z)); o0.w = pk2(a[6] * inv - bflo(c0.w), a[7] * inv - bfhi(c0.w));
      o1.x = pk2(a[8] * inv - bflo(c1.x), a[9] * inv - bfhi(c1.x)); o1.y = pk2(a[10] * inv - bflo(c1.y), a[11] * inv - bfhi(c1.y));
      o1.z = pk2(a[12] * inv - bflo(c1.z), a[13] * inv - bfhi(c1.z)); o1.w = pk2(a[14] * inv - bflo(c1.w), a[15] * inv - bfhi(c1.w));
      *(u32x4*)(Y + (size_t)(r0 + i) * DM + ch0) = o0; *(u32x4*)(Y + (size_t)(r0 + i) * DM + ch0 + 8) = o1;
      if (s + half < L) acc16(a, base + (size_t)(s + half) * DM, 1.0f);
      if (s - half >= 0) acc16(a, base + (size_t)(s - half) * DM, -1.0f);
    }
  }
}
struct PoolSched {
  const char* A; const char* B; int G, c;
  DI bool next(int i, fg::Unit& u) const {
    const int L = i * G + c; if (L >= (TT / 256) * 4) return false;
    const int pm = L >> 2, g = L & 3;
    u.pm = pm; u.pn = g; u.aux = 0; u.A = A + ((size_t)pm * 256 * 1024 + g * 256) * 2; u.B = B + (size_t)g * 65536 * 2; return true;
  }
  DI const LAS int* rows(int) const { return nullptr; }
};
template <bool DRY = false>
DI void phase_pool(KP p, char* smem) {
  char* const ws = ows(p);
  LAS unsigned char* lds = (LAS unsigned char*)smem;
  const float* pb = gin(p, 16);
  const float* psc = gin(p, 17);
  PoolSched S; S.A = ws + OFF_U + U2_Y; S.B = ws + OFF_WMIX + W_POOL * 2; S.G = gridDim.x; S.c = obid();
  auto ep = [&](const f32x4 (&acc)[2][2][4][2], const fg::Unit& u, int wr, int wc, int fr, int fq) {
    const int row0 = u.pm * 256 + wr * 64 + fr, colb = u.pn * 256 + wc * 32 + 4 * fq;
    const float* g1 = modp(ws, 2, row_bi(row0), 2) + colb;
    f32x4 g[2][2], bb[2][2];
#pragma unroll
    for (int bj = 0; bj < 2; ++bj)
#pragma unroll
      for (int n = 0; n < 2; ++n) {
        const f32x4 s4 = *(const f32x4*)(psc + colb + bj * 128 + n * 16);
        g[bj][n] = *(const f32x4*)(g1 + bj * 128 + n * 16) * s4;
        bb[bj][n] = *(const f32x4*)(pb + colb + bj * 128 + n * 16) * g[bj][n];
      }
    f32x4 xa[2][2], xb[2][2];
    bf16_t* xr = xrow_ptr(p, ws, row0) + colb;
#pragma unroll
    for (int bj = 0; bj < 2; ++bj)
#pragma unroll
      for (int n = 0; n < 2; ++n) xa[bj][n] = ldbf4(xr + bj * 128 + n * 16);
#pragma unroll
    for (int rr = 0; rr < 8; ++rr) {
      const int ai = rr >> 2, m = rr & 3;
      bf16_t* xn = xr;
      if (rr + 1 < 8) {
        xn = xrow_ptr(p, ws, row0 + ((rr + 1) >> 2) * 128 + ((rr + 1) & 3) * 16) + colb;
#pragma unroll
        for (int bj = 0; bj < 2; ++bj)
#pragma unroll
          for (int n = 0; n < 2; ++n) xb[bj][n] = ldbf4(xn + bj * 128 + n * 16);
      }
#pragma unroll
      for (int bj = 0; bj < 2; ++bj)
#pragma unroll
        for (int n = 0; n < 2; ++n) {
          const f32x4 x = xa[bj][n] + (g[bj][n] * acc[ai][bj][m][n] + bb[bj][n]);
          if (!DRY) stbf4(xr + bj * 128 + n * 16, x); else asm volatile("" :: "v"(x[0]), "v"(x[1]), "v"(x[2]), "v"(x[3]));
        }
#pragma unroll
      for (int bj = 0; bj < 2; ++bj)
#pragma unroll
        for (int n = 0; n < 2; ++n) xa[bj][n] = xb[bj][n];
      xr = xn;
    }
  };
  fg::gemm_phase<false>(lds, 256, 1024, 256, S, ep);
}

typedef short v4i16_t __attribute__((ext_vector_type(4)));
DI s16x4 tr_read(const bf16_t* p) { return __builtin_bit_cast(s16x4, __builtin_amdgcn_ds_read_tr16_b64_v4i16((LAS v4i16_t*)p)); }
DI bf16x8 pack8(const f32x16& x, int s) {
  u32x4 q;
  q.x = pk2(x[8 * s + 0], x[8 * s + 1]); q.y = pk2(x[8 * s + 2], x[8 * s + 3]);
  q.z = pk2(x[8 * s + 4], x[8 * s + 5]); q.w = pk2(x[8 * s + 6], x[8 * s + 7]);
  return __builtin_bit_cast(bf16x8, q);
}
template <int DT, int VLD_, bool MASK>
DI void attn_tile(const bf16_t* sK, int kld, const bf16_t* vbase, const bf16x8 (&qf)[4], f32x16 (&Y)[DT], float& m, float& l, int r, int h, int qpos, int kpos0) {
  f32x16 X[2];
#pragma unroll
  for (int sub = 0; sub < 2; ++sub) {
#pragma unroll
    for (int i = 0; i < 16; ++i) X[sub][i] = 0.f;
#pragma unroll
    for (int s = 0; s < 4; ++s) {
      const bf16x8 a = *(const bf16x8*)(sK + (sub * 32 + r) * kld + 16 * s + 8 * h);
      X[sub] = MFMA32(a, qf[s], X[sub]);
    }
  }
  if (MASK) {
#pragma unroll
    for (int sub = 0; sub < 2; ++sub)
#pragma unroll
      for (int i = 0; i < 16; ++i) {
        const int kp = kpos0 + sub * 32 + (i & 3) + 8 * (i >> 2) + 4 * h;
        const int d = qpos - kp;
        if (d > 128 || d < -128) X[sub][i] = -1e30f;
      }
  }
  float mx = m;
#pragma unroll
  for (int sub = 0; sub < 2; ++sub)
#pragma unroll
    for (int i = 0; i < 16; ++i) mx = fmaxf(mx, X[sub][i]);
  mx = fmaxf(mx, __shfl_xor(mx, 32));
  const float alpha = __expf(m - mx);
  m = mx;
  float ps = 0.f;
#pragma unroll
  for (int sub = 0; sub < 2; ++sub)
#pragma unroll
    for (int i = 0; i < 16; ++i) { const float pv = __expf(X[sub][i] - mx); X[sub][i] = pv; ps += pv; }
  l = l * alpha + ps;
#pragma unroll
  for (int dt = 0; dt < DT; ++dt)
#pragma unroll
    for (int i = 0; i < 16; ++i) Y[dt][i] *= alpha;
#pragma unroll
  for (int sub = 0; sub < 2; ++sub)
#pragma unroll
    for (int s = 0; s < 2; ++s) {
      const bf16x8 pf = pack8(X[sub], s);
#pragma unroll
      for (int dt = 0; dt < DT; ++dt) {
        const bf16_t* vp = vbase + (sub * 32 + 16 * s) * VLD_ + dt * 32;
        const s16x4 lo = tr_read(vp), hi = tr_read(vp + 8 * VLD_);
        const bf16x8 vf = __builtin_shufflevector(lo, hi, 0, 1, 2, 3, 4, 5, 6, 7);
        Y[dt] = MFMA32(vf, pf, Y[dt]);
      }
    }
}

constexpr int A0_KLD = 72, A0_VLD = 96;
constexpr int A0_LDS = 64 * A0_KLD * 2 + 64 * A0_VLD * 2;
DI void phase_attn_win(KP p, char* smem) {
  char* const ws = ows(p);
  bf16_t* sK = (bf16_t*)smem;
  bf16_t* sV = sK + 64 * A0_KLD;
  const bf16_t* Q = (const bf16_t*)(ws + OFF_U + U0_Q);
  const bf16_t* Kb = (const bf16_t*)(ws + OFF_U + U0_K);
  const bf16_t* Vb = (const bf16_t*)(ws + OFF_U + U0_V);
  bf16_t* O = (bf16_t*)(ws + OFF_U + U0_O);
  const float* sink = gin(p, 9);
  const int tid = otid(), lane = tid & 63, wid = tid >> 6, r = lane & 31, h = lane >> 5;
  const bf16_t* vbase = sV + (4 * h + ((lane & 15) >> 2)) * A0_VLD + 16 * ((lane >> 4) & 1) + 4 * (lane & 3);
  const int NLAT = 16 * 4 * 32 * 2, NCTX = 16 * 16;
  for (int it = obid(); it < NLAT + NCTX; it += gridDim.x) {
    const bool lat = it < NLAT;
    int b, kvh, qb = 0, head, qrow, qpos;
    if (lat) {
      b = it >> 8; kvh = (it >> 6) & 3; qb = (it >> 1) & 31; const int hp = it & 1;
      head = kvh * 4 + hp * 2 + (wid >> 2);
      qpos = qb * 128 + (wid & 3) * 32 + r; qrow = b * 4096 + qpos;
    } else {
      const int i2 = it - NLAT; b = i2 >> 4; head = i2 & 15; kvh = head >> 2;
      qpos = wid * 32 + r; qrow = TL + b * 256 + qpos;
    }
    bf16x8 qf[4];
#pragma unroll
    for (int s = 0; s < 4; ++s) qf[s] = *(const bf16x8*)(Q + (size_t)qrow * DM + head * 64 + 16 * s + 8 * h);
    f32x16 Y[2];
#pragma unroll
    for (int dt = 0; dt < 2; ++dt)
#pragma unroll
      for (int i = 0; i < 16; ++i) Y[dt][i] = 0.f;
    float m = sink[head], l = h == 0 ? 1.0f : 0.0f;
    const int kr = tid >> 3, k8 = (tid & 7) * 8;
    auto tile_ok = [&](int t) -> bool { if (t >= 6) return true; if (!lat) return false; const int kt = 2 * qb - 2 + t; return kt >= 0 && kt < 64; };
    auto trow = [&](int t) -> size_t { return t < 6 ? (size_t)b * 4096 + (2 * qb - 2 + t) * 64 + kr : (size_t)TL + b * 256 + (t - 6) * 64 + kr; };
    int t = 0;
    while (t < 10 && !tile_ok(t)) ++t;
    u32x4 rk = ld16(Kb + trow(t) * 256 + kvh * 64 + k8), rv = ld16(Vb + trow(t) * 256 + kvh * 64 + k8);
    while (t < 10) {
      __syncthreads();
      *(u32x4*)(sK + kr * A0_KLD + k8) = rk;
      *(u32x4*)(sV + kr * A0_VLD + k8) = rv;
      __syncthreads();
      int tn = t + 1;
      while (tn < 10 && !tile_ok(tn)) ++tn;
      if (tn < 10) { rk = ld16(Kb + trow(tn) * 256 + kvh * 64 + k8); rv = ld16(Vb + trow(tn) * 256 + kvh * 64 + k8); }
      if (t < 6) attn_tile<2, A0_VLD, true>(sK, A0_KLD, vbase, qf, Y, m, l, r, h, qpos, (2 * qb - 2 + t) * 64);
      else attn_tile<2, A0_VLD, false>(sK, A0_KLD, vbase, qf, Y, m, l, r, h, 0, 0);
      t = tn;
    }
    const float lt = l + __shfl_xor(l, 32);
    const float inv = 1.0f / lt;
#pragma unroll
    for (int dt = 0; dt < 2; ++dt)
#pragma unroll
      for (int g = 0; g < 4; ++g) {
        const float i8 = inv * O8_SCALE;
        *(unsigned*)((unsigned char*)O + (size_t)qrow * DM + head * 64 + dt * 32 + 8 * g + 4 * h) = pk4_fp8(Y[dt][4 * g] * i8, Y[dt][4 * g + 1] * i8, Y[dt][4 * g + 2] * i8, Y[dt][4 * g + 3] * i8);
      }
  }
}

constexpr int A1_KLD = 136, A1_VLD = 160;
constexpr int A1_K8LD = 144;
constexpr int A1_V8LD = 80;
constexpr int A1_KB = 64 * A1_K8LD, A1_VB = 128 * A1_V8LD;
constexpr int A1_LDS = 2 * A1_KB + 2 * A1_VB + 4 * 128 * 32 * 4;
DI void qk_tile(const bf16_t* sK, int kld, const bf16x8 (&qf)[4], f32x16 (&X)[2], int r, int h) {
  bf16x8 kf[2][4];
#pragma unroll
  for (int sub = 0; sub < 2; ++sub)
#pragma unroll
    for (int s = 0; s < 4; ++s) kf[sub][s] = *(const bf16x8*)(sK + (sub * 32 + r) * kld + 16 * s + 8 * h);
#pragma unroll
  for (int sub = 0; sub < 2; ++sub) {
#pragma unroll
    for (int i = 0; i < 16; ++i) X[sub][i] = 0.f;
#pragma unroll
    for (int s = 0; s < 4; ++s) X[sub] = MFMA32(kf[sub][s], qf[s], X[sub]);
  }
}
typedef int v8i_t __attribute__((ext_vector_type(8)));
typedef int v4i_t __attribute__((ext_vector_type(4)));
DI void qk8_tile(const unsigned char* sK8, int kld8, const v8i_t& q8, f32x16 (&X)[2], int r, int h) {
  v8i_t kf[2];
#pragma unroll
  for (int sub = 0; sub < 2; ++sub) { const v4i_t* q_ = (const v4i_t*)(sK8 + (sub * 32 + r) * kld8 + 32 * h); kf[sub] = __builtin_shufflevector(q_[0], q_[1], 0, 1, 2, 3, 4, 5, 6, 7); }
#pragma unroll
  for (int sub = 0; sub < 2; ++sub) {
    f32x16 z;
#pragma unroll
    for (int i = 0; i < 16; ++i) z[i] = 0.f;
    X[sub] = __builtin_amdgcn_mfma_scale_f32_32x32x64_f8f6f4(kf[sub], q8, z, 0, 0, 0, 0x7f7f7f7f, 0, 0x7f7f7f7f);
  }
}
template <int DT, int QSC = 1, int PSH = 0>
DI void softmax_lazy(f32x16 (&X)[2], f32x16 (&Y)[DT], float& m, float& l) {
  constexpr float THR = 4.0f * QSC, L2E = 1.44269504089f / QSC;
  float c0 = X[0][0], c1 = X[0][1], c2 = X[0][2], c3 = X[0][3];
#pragma unroll
  for (int i = 4; i < 16; i += 4) { c0 = fmaxf(c0, X[0][i]); c1 = fmaxf(c1, X[0][i + 1]); c2 = fmaxf(c2, X[0][i + 2]); c3 = fmaxf(c3, X[0][i + 3]); }
#pragma unroll
  for (int i = 0; i < 16; i += 4) { c0 = fmaxf(c0, X[1][i]); c1 = fmaxf(c1, X[1][i + 1]); c2 = fmaxf(c2, X[1][i + 2]); c3 = fmaxf(c3, X[1][i + 3]); }
  float mx = fmaxf(fmaxf(c0, c1), fmaxf(c2, c3));
  { float a, b; swap32(mx, a, b); mx = fmaxf(a, b); }
  if (__builtin_amdgcn_ballot_w64(mx > m + THR) != 0ull) {
    const float mn = fmaxf(m, mx);
    const float alpha = __builtin_amdgcn_exp2f((m - mn) * L2E);
    m = mn; l *= alpha;
#pragma unroll
    for (int dt = 0; dt < DT; ++dt)
#pragma unroll
      for (int i = 0; i < 16; ++i) Y[dt][i] *= alpha;
  }
  const float nm = fmaf(-m, L2E, (float)PSH);
  float ps0 = 0.f, ps1 = 0.f, ps2 = 0.f, ps3 = 0.f;
#pragma unroll
  for (int sub = 0; sub < 2; ++sub)
#pragma unroll
    for (int i = 0; i < 16; i += 4) {
      const float p0 = __builtin_amdgcn_exp2f(fmaf(X[sub][i], L2E, nm)), p1 = __builtin_amdgcn_exp2f(fmaf(X[sub][i + 1], L2E, nm));
      const float p2 = __builtin_amdgcn_exp2f(fmaf(X[sub][i + 2], L2E, nm)), p3 = __builtin_amdgcn_exp2f(fmaf(X[sub][i + 3], L2E, nm));
      X[sub][i] = p0; X[sub][i + 1] = p1; X[sub][i + 2] = p2; X[sub][i + 3] = p3;
      asm("v_add_f32 %0, %1, %0" : "+v"(ps0) : "v"(p0));
      asm("v_add_f32 %0, %1, %0" : "+v"(ps1) : "v"(p1));
      asm("v_add_f32 %0, %1, %0" : "+v"(ps2) : "v"(p2));
      asm("v_add_f32 %0, %1, %0" : "+v"(ps3) : "v"(p3));
    }
  asm("v_add_f32 %0, %1, %0" : "+v"(ps0) : "v"(ps1));
  asm("v_add_f32 %0, %1, %0" : "+v"(ps2) : "v"(ps3));
  l += ps0 + ps2;
}
template <int DT, int VLD_>
DI void pv_tile(const f32x16 (&X)[2], const bf16_t* vbase, f32x16 (&Y)[DT]) {
#pragma unroll
  for (int sub = 0; sub < 2; ++sub)
#pragma unroll
    for (int s = 0; s < 2; ++s) {
      const bf16x8 pf = pack8(X[sub], s);
#pragma unroll
      for (int dt = 0; dt < DT; ++dt) {
        const bf16_t* vp = vbase + (sub * 32 + 16 * s) * VLD_ + dt * 32;
        const s16x4 lo = tr_read(vp), hi = tr_read(vp + 8 * VLD_);
        const bf16x8 vf = __builtin_shufflevector(lo, hi, 0, 1, 2, 3, 4, 5, 6, 7);
        Y[dt] = MFMA32(vf, pf, Y[dt]);
      }
    }
}
DI void phase_attn_diff(KP p, char* smem) {
  char* const ws = ows(p);
  unsigned char* sK = (unsigned char*)smem;
  unsigned char* sV = (unsigned char*)(smem + 2 * A1_KB);
  float* comb = (float*)(smem + 2 * A1_KB + 2 * A1_VB);
  const bf16_t* Q = (const bf16_t*)(ws + OFF_U + U1_Q);
  const unsigned char* K8 = (const unsigned char*)(ws + OFF_U + U1_K);
  const unsigned char* Vt = (const unsigned char*)(ws + OFF_U + U1_V);
  bf16_t* O = (bf16_t*)(ws + OFF_U + U1_O);
  const int tid = otid(), lane = tid & 63, wid = tid >> 6, r = lane & 31, h = lane >> 5, grp = wid >> 2;
  const float lambda_init = 0.8f - 0.6f * 0.74081822068f;
  float lam_full;
  {
    const float* lf = gin(p, 12);
    float s1 = 0.f, s2 = 0.f;
    for (int i = 0; i < 64; ++i) { s1 += lf[i] * lf[64 + i]; s2 += lf[128 + i] * lf[192 + i]; }
    lam_full = expf(s1) - expf(s2) + lambda_init;
  }
  const float* subg = gin(p, 13);
  const int NLAT = 16 * 8 * 32, NCTX = 16 * 8 * 2;
  const int kr = tid >> 3, kc = (tid & 7) * 16;
  for (int it = obid(); it < NLAT + NCTX; it += gridDim.x) {
    const bool lat = it < NLAT;
    int b, head, qrow, t0;
    const int nt = 68;
    if (lat) { b = it >> 8; head = (it >> 5) & 7; const int qb = it & 31; qrow = b * 4096 + qb * 128 + (wid & 3) * 32 + r; t0 = 0; }
    else { const int i2 = it - NLAT; b = i2 >> 4; head = (i2 >> 1) & 7; const int hf = i2 & 1; qrow = TL + b * 256 + hf * 128 + (wid & 3) * 32 + r; t0 = 64; }
    v8i_t q8;
    {
      const bf16_t* qp = Q + (size_t)qrow * DM + head * 128 + grp * 64 + 32 * h;
#pragma unroll
      for (int c4 = 0; c4 < 4; ++c4) {
        const u32x4 w = ld16(qp + 8 * c4);
        q8[2 * c4] = (int)pk4_fp8(bflo(w.x) * 8.f, bfhi(w.x) * 8.f, bflo(w.y) * 8.f, bfhi(w.y) * 8.f);
        q8[2 * c4 + 1] = (int)pk4_fp8(bflo(w.z) * 8.f, bfhi(w.z) * 8.f, bflo(w.w) * 8.f, bfhi(w.w) * 8.f);
      }
    }
    f32x16 Y[4];
#pragma unroll
    for (int dt = 0; dt < 4; ++dt)
#pragma unroll
      for (int i = 0; i < 16; ++i) Y[dt][i] = 0.f;
    float m = -1e30f, l = 0.f;
    auto goff = [&](int t) -> size_t { return (t < 64 ? (size_t)b * 4096 + t * 64 + kr : (size_t)TL + b * 256 + (t - 64) * 64 + kr) * 1024 + head * 128 + kc; };
    auto stK = [&](int t, const u32x4& a) { *(u32x4*)(sK + (t & 1) * A1_KB + kr * A1_K8LD + kc) = a; };
    const int vd = tid >> 2, vcx = (tid & 3) * 16;
    auto voff = [&](int t) -> size_t { return t < 64 ? ((size_t)(b * 1024 + head * 128 + vd) * 4096 + (size_t)t * 64 + vcx) : ((size_t)16 * 1024 * 4096 + (size_t)(b * 1024 + head * 128 + vd) * 256 + (size_t)(t - 64) * 64 + vcx); };
    auto stV = [&](int t, const u32x4& a) { *(u32x4*)(sV + (t & 1) * A1_VB + vd * A1_V8LD + vcx) = a; };
    u32x4 rk0, rv0;
    __syncthreads();
    rk0 = *(const u32x4*)(K8 + goff(t0)); stK(t0, rk0);
    rk0 = *(const u32x4*)(K8 + goff(t0 + 1)); stK(t0 + 1, rk0);
    rk0 = *(const u32x4*)(K8 + goff(t0 + 2));
    rv0 = *(const u32x4*)(Vt + voff(t0));
    __syncthreads();
    f32x16 Xn[2];
    qk8_tile(sK + (t0 & 1) * A1_KB + grp * 64, A1_K8LD, q8, Xn, r, h);
    __syncthreads();
    v8i_t p8;
    auto pv8 = [&](int t) __attribute__((always_inline)) {
      const unsigned char* vb8 = sV + (t & 1) * A1_VB + r * A1_V8LD + 32 * h;
#pragma unroll
      for (int dt = 0; dt < 4; ++dt) {
        const v4i_t* q_ = (const v4i_t*)(vb8 + dt * 32 * A1_V8LD);
        const v8i_t vf = __builtin_shufflevector(q_[0], q_[1], 0, 1, 2, 3, 4, 5, 6, 7);
        Y[dt] = __builtin_amdgcn_mfma_scale_f32_32x32x64_f8f6f4(vf, p8, Y[dt], 0, 0, 0, 0x7f7f7f7f, 0, 0x7f7f7f7f);
      }
    };
    for (int t = t0; t < nt; ++t) {
      if (t + 2 < nt) stK(t + 2, rk0);
      stV(t, rv0);
      if (t + 3 < nt) rk0 = *(const u32x4*)(K8 + goff(t + 3));
      if (t + 1 < nt) rv0 = *(const u32x4*)(Vt + voff(t + 1));
      f32x16 X[2];
      X[0] = Xn[0]; X[1] = Xn[1];
      if (t + 1 < nt) qk8_tile(sK + ((t + 1) & 1) * A1_KB + grp * 64, A1_K8LD, q8, Xn, r, h);
      if (t > t0) pv8(t - 1);
      softmax_lazy<4, 8, 2>(X, Y, m, l);
#pragma unroll
      for (int sub = 0; sub < 2; ++sub)
#pragma unroll
        for (int g4 = 0; g4 < 4; ++g4) p8[4 * sub + g4] = (int)pk4_fp8_nc(X[sub][4 * g4], X[sub][4 * g4 + 1], X[sub][4 * g4 + 2], X[sub][4 * g4 + 3]);
      __syncthreads();
    }
    pv8(nt - 1);
    const float lt = l + __shfl_xor(l, 32);
    const float inv = 1.0f / lt;
    if (grp == 1) {
#pragma unroll
      for (int dt = 0; dt < 4; ++dt)
#pragma unroll
        for (int i = 0; i < 16; ++i) comb[(((wid & 3) * 128) + dt * 32 + (i & 3) + 8 * (i >> 2) + 4 * h) * 32 + r] = Y[dt][i] * inv;
    }
    __syncthreads();
    if (grp == 0) {
      float ss = 0.f;
#pragma unroll
      for (int dt = 0; dt < 4; ++dt)
#pragma unroll
        for (int i = 0; i < 16; ++i) {
          const float o2 = comb[(((wid & 3) * 128) + dt * 32 + (i & 3) + 8 * (i >> 2) + 4 * h) * 32 + r];
          const float vv = Y[dt][i] * inv - lam_full * o2;
          Y[dt][i] = vv; ss += vv * vv;
        }
      ss += __shfl_xor(ss, 32);
      const float rs = rsqrtf(ss * (1.0f / 128.0f) + 1e-6f) * (1.0f - lambda_init);
#pragma unroll
      for (int dt = 0; dt < 4; ++dt)
#pragma unroll
        for (int g = 0; g < 4; ++g) {
          const int d0 = dt * 32 + 8 * g + 4 * h;
          const f32x4 sg = *(const f32x4*)(subg + d0);
          const float r8 = rs * O8_SCALE;
          *(unsigned*)((unsigned char*)O + (size_t)qrow * DM + head * 128 + d0) = pk4_fp8(Y[dt][4 * g] * r8 * sg[0], Y[dt][4 * g + 1] * r8 * sg[1], Y[dt][4 * g + 2] * r8 * sg[2], Y[dt][4 * g + 3] * r8 * sg[3]);
        }
    }
  }
}

DI u32x4 rwkv_mix_load(const bf16_t* hb, const float* mu, int mixi, int row, int k) {
  int s, L;
  if (row < TL) { s = row & 4095; L = 4096; } else { s = (row - TL) & 255; L = 256; }
  const bf16_t* hp = hb + (size_t)row * DM + k;
  const u32x4 c = ld16(hp);
  u32x4 pv = (u32x4){0u, 0u, 0u, 0u}, nx = (u32x4){0u, 0u, 0u, 0u};
  if (s > 0) pv = ld16(hp - DM);
  if (s < L - 1) nx = ld16(hp + DM);
  const float* m0 = mu + (size_t)(0 * 6 + mixi) * DM + k;
  const float* m1 = mu + (size_t)(1 * 6 + mixi) * DM + k;
  const f32x4 a0 = *(const f32x4*)m0, a1 = *(const f32x4*)(m0 + 4), b0 = *(const f32x4*)m1, b1 = *(const f32x4*)(m1 + 4);
  float cv[8] = {bflo(c.x), bfhi(c.x), bflo(c.y), bfhi(c.y), bflo(c.z), bfhi(c.z), bflo(c.w), bfhi(c.w)};
  float pvv[8] = {bflo(pv.x), bfhi(pv.x), bflo(pv.y), bfhi(pv.y), bflo(pv.z), bfhi(pv.z), bflo(pv.w), bfhi(pv.w)};
  float nv[8] = {bflo(nx.x), bfhi(nx.x), bflo(nx.y), bfhi(nx.y), bflo(nx.z), bfhi(nx.z), bflo(nx.w), bfhi(nx.w)};
  float mu0[8] = {a0[0], a0[1], a0[2], a0[3], a1[0], a1[1], a1[2], a1[3]};
  float mu1[8] = {b0[0], b0[1], b0[2], b0[3], b1[0], b1[1], b1[2], b1[3]};
  float o[8];
#pragma unroll
  for (int j = 0; j < 8; ++j) o[j] = cv[j] + (pvv[j] - cv[j]) * mu0[j] + (nv[j] - cv[j]) * mu1[j];
  u32x4 w; w.x = pk2(o[0], o[1]); w.y = pk2(o[2], o[3]); w.z = pk2(o[4], o[5]); w.w = pk2(o[6], o[7]);
  return w;
}
template <int ACT  , class AL>
DI void rwkv_gemm_tile(char* smem, AL la, const bf16_t* Bt, int K, int ldb, bf16_t* dst, int ldd, int row0, int col0, int ncols_valid) {
  auto lb = [&](int tn, int k) -> u32x4 { return (col0 + tn) < ncols_valid ? ld16(Bt + (size_t)(col0 + tn) * ldb + k) : (u32x4){0u, 0u, 0u, 0u}; };
  auto ep = [&](const f32x4 (&acc)[4][2], int r0, int c0, int fr, int fq) {
#pragma unroll
    for (int m = 0; m < 4; ++m)
#pragma unroll
      for (int n = 0; n < 2; ++n)
#pragma unroll
        for (int j = 0; j < 4; ++j) {
          const int row = row0 + r0 + m * 16 + fq * 4 + j, col = col0 + c0 + n * 16 + fr;
          float v = acc[m][n][j];
          if (ACT == 1) v = 1.0f - 2.0f * __builtin_amdgcn_rcpf(1.0f + __expf(2.0f * v));
          if (ACT == 2) v = sigmoidf_(v);
          if (col < ncols_valid) dst[(size_t)row * ldd + col] = f2bf(v);
        }
  };
  sgemm_tile(smem, K, la, lb, ep);
}
DI void phase_rwkv_mix(KP p, char* smem) {
  char* const ws = ows(p);
  const int lane = otid() & 63, wid = otid() >> 6;
  const bf16_t* hb = (const bf16_t*)(ws + OFF_H);
  const float* mu = gin(p, 18);
  bf16_t* XR = (bf16_t*)(ws + OFF_U + U3_XR);
  bf16_t* XK = (bf16_t*)(ws + OFF_U + U3_XK);
  bf16_t* XV = (bf16_t*)(ws + OFF_U + U3_XV);
  const int ch0 = lane * 16;
  for (int r = obid() * 8 + wid; r < TT; r += gridDim.x * 8) {
    int s, L;
    if (r < TL) { s = r & 4095; L = 4096; } else { s = (r - TL) & 255; L = 256; }
    const bf16_t* hp = hb + (size_t)r * DM + ch0;
    float c[16], pv[16], nx[16];
    {
      const u32x4 a = ld16(hp), b = ld16(hp + 8);
      c[0] = bflo(a.x); c[1] = bfhi(a.x); c[2] = bflo(a.y); c[3] = bfhi(a.y); c[4] = bflo(a.z); c[5] = bfhi(a.z); c[6] = bflo(a.w); c[7] = bfhi(a.w);
      c[8] = bflo(b.x); c[9] = bfhi(b.x); c[10] = bflo(b.y); c[11] = bfhi(b.y); c[12] = bflo(b.z); c[13] = bfhi(b.z); c[14] = bflo(b.w); c[15] = bfhi(b.w);
    }
#pragma unroll
    for (int j = 0; j < 16; ++j) { pv[j] = 0.f; nx[j] = 0.f; }
    if (s > 0) {
      const u32x4 a = ld16(hp - DM), b = ld16(hp - DM + 8);
      pv[0] = bflo(a.x); pv[1] = bfhi(a.x); pv[2] = bflo(a.y); pv[3] = bfhi(a.y); pv[4] = bflo(a.z); pv[5] = bfhi(a.z); pv[6] = bflo(a.w); pv[7] = bfhi(a.w);
      pv[8] = bflo(b.x); pv[9] = bfhi(b.x); pv[10] = bflo(b.y); pv[11] = bfhi(b.y); pv[12] = bflo(b.z); pv[13] = bfhi(b.z); pv[14] = bflo(b.w); pv[15] = bfhi(b.w);
    }
    if (s < L - 1) {
      const u32x4 a = ld16(hp + DM), b = ld16(hp + DM + 8);
      nx[0] = bflo(a.x); nx[1] = bfhi(a.x); nx[2] = bflo(a.y); nx[3] = bfhi(a.y); nx[4] = bflo(a.z); nx[5] = bfhi(a.z); nx[6] = bflo(a.w); nx[7] = bfhi(a.w);
      nx[8] = bflo(b.x); nx[9] = bfhi(b.x); nx[10] = bflo(b.y); nx[11] = bfhi(b.y); nx[12] = bflo(b.z); nx[13] = bfhi(b.z); nx[14] = bflo(b.w); nx[15] = bfhi(b.w);
    }
#pragma unroll
    for (int q = 0; q < 3; ++q) {
      const int mixi = q == 0 ? 0 : q + 1;
      if (q == 0 && r >= TL) continue;
      unsigned char* dst = (unsigned char*)(q == 0 ? XR : q == 1 ? XK : XV) + (size_t)r * DM + ch0;
      const float* m0 = mu + (size_t)(0 * 6 + mixi) * DM + ch0;
      const float* m1 = mu + (size_t)(1 * 6 + mixi) * DM + ch0;
      float o[16];
#pragma unroll
      for (int j4 = 0; j4 < 4; ++j4) {
        const f32x4 a = *(const f32x4*)(m0 + 4 * j4), b = *(const f32x4*)(m1 + 4 * j4);
#pragma unroll
        for (int j = 0; j < 4; ++j) { const int k = 4 * j4 + j; o[k] = c[k] + (pv[k] - c[k]) * a[j] + (nx[k] - c[k]) * b[j]; }
      }
      u32x4 w0;
      w0.x = pk4_fp8(o[0] * X8_SCALE, o[1] * X8_SCALE, o[2] * X8_SCALE, o[3] * X8_SCALE); w0.y = pk4_fp8(o[4] * X8_SCALE, o[5] * X8_SCALE, o[6] * X8_SCALE, o[7] * X8_SCALE);
      w0.z = pk4_fp8(o[8] * X8_SCALE, o[9] * X8_SCALE, o[10] * X8_SCALE, o[11] * X8_SCALE); w0.w = pk4_fp8(o[12] * X8_SCALE, o[13] * X8_SCALE, o[14] * X8_SCALE, o[15] * X8_SCALE);
      *(u32x4*)dst = w0;
    }
  }
}
struct RkvSched {
  const char* X0; const char* X1; const char* X2; const char* W; int G, c;
  DI bool next(int i, fg::Unit& u) const {
    int pmg, pn; if (!fg::static_order(i, G, c, 800, 4, pmg, pn)) return false;
    const int job = (pmg >= 256) + (pmg >= 528);
    u.pm = pmg - (job ? 256 + (job - 1) * 272 : 0); u.pn = pn; u.aux = job;
    u.A = X0 + (size_t)job * SZ_TT + (size_t)u.pm * 256 * 1024;
    u.B = W + (size_t)job * 1024 * 1024 * 2 + (size_t)u.pn * 256 * 1024; return true;
  }
  DI const LAS int* rows(int) const { return nullptr; }
};
DI void phase_rwkv_rkv(KP p, char* smem) {
  char* const ws = ows(p);
  LAS unsigned char* lds = (LAS unsigned char*)smem;
  char* U = ws + OFF_U;
  RkvSched S; S.X0 = U + U3_XR; S.X1 = U + U3_XK; S.X2 = U + U3_XV; S.W = ws + OFF_WMIX + W_R * 2; S.G = gridDim.x; S.c = obid();
  auto ep = [&](const f32x16 (&acc)[2][2][2], const fg::Unit& u, int wr, int wc, int r, int h) {
    bf16_t* dst = (bf16_t*)(U + (u.aux ? SZ_TL + (size_t)(u.aux - 1) * SZ_TT : (size_t)0));
    constexpr float inv = 1.0f / (X8_SCALE * 32.0f);
#pragma unroll
    for (int ai = 0; ai < 2; ++ai)
#pragma unroll
      for (int m = 0; m < 2; ++m) {
        const size_t row = (size_t)u.pm * 256 + ai * 128 + wr * 64 + m * 32 + r;
#pragma unroll
        for (int bj = 0; bj < 2; ++bj) {
          const f32x16& a = acc[ai][bj][m];
          u32x4 w0, w1;
          w0.x = pk2(a[0] * inv, a[1] * inv); w0.y = pk2(a[2] * inv, a[3] * inv); w0.z = pk2(a[4] * inv, a[5] * inv); w0.w = pk2(a[6] * inv, a[7] * inv);
          w1.x = pk2(a[8] * inv, a[9] * inv); w1.y = pk2(a[10] * inv, a[11] * inv); w1.z = pk2(a[12] * inv, a[13] * inv); w1.w = pk2(a[14] * inv, a[15] * inv);
          bf16_t* q = dst + row * DM + u.pn * 256 + bj * 128 + wc * 32 + 16 * h;
          *(u32x4*)q = w0; *(u32x4*)(q + 8) = w1;
        }
      }
  };
  fg::gemm_phase_f8<false, true>(lds, 512, 512, 512, S, ep);
}

DI void phase_rwkv_feat1(KP p, char* smem) {
  char* const ws = ows(p);
  const bf16_t* hb = (const bf16_t*)(ws + OFF_H);
  const bf16_t* wm = (const bf16_t*)(ws + OFF_WMIX);
  const float* mu = gin(p, 18);
  char* U = ws + OFF_U;
  const int n3 = 544, n4 = n3 + 544, n5 = n4 + 512;
  for (int t = obid(); t < n5; t += gridDim.x) {
    if (t < n3) {
      const int row0 = t * 128;
      auto la = [&](int trow, int k) -> u32x4 { return rwkv_mix_load(hb, mu, 1, row0 + trow, k); };
      rwkv_gemm_tile<1>(smem, la, wm + W_WA1, 1024, 1024, (bf16_t*)(U + U3_LW), 128, row0, 0, 128);
    } else if (t < n4) {
      const int row0 = (t - n3) * 128;
      auto la = [&](int trow, int k) -> u32x4 { return rwkv_mix_load(hb, mu, 4, row0 + trow, k); };
      rwkv_gemm_tile<0>(smem, la, wm + W_AA1, 1024, 1024, (bf16_t*)(U + U3_LA), 128, row0, 0, 128);
    } else {
      const int row0 = (t - n4) * 128;
      auto la = [&](int trow, int k) -> u32x4 { return rwkv_mix_load(hb, mu, 5, row0 + trow, k); };
      rwkv_gemm_tile<2>(smem, la, wm + W_G1, 1024, 1024, (bf16_t*)(U + U3_LG), 128, row0, 0, 128);
    }
  }
}
struct Feat2Sched {
  const char* U; const char* W; int G, c;
  DI bool next(int i, fg::Unit& u) const {
    const int L = i * G + c; if (L >= 2176 + 2176 + 1024) return false;
    const int job = (L >= 2176) + (L >= 4352), loc = L - job * 2176;
    if (job < 2) { u.pm = loc >> 3; u.pn = loc & 7; } else { u.pm = loc >> 2; u.pn = loc & 3; }
    u.aux = job;
    u.A = U + (job == 0 ? U3_LW : job == 1 ? U3_LA : U3_LG) + (size_t)u.pm * 256 * 128 * 2;
    u.B = W + ((job == 0 ? W_WA2 : job == 1 ? W_AA2 : W_G2) + (size_t)u.pn * 256 * 128) * 2; return true;
  }
  DI const LAS int* rows(int) const { return nullptr; }
};
DI void phase_rwkv_feat2(KP p, char* smem) {
  char* const ws = ows(p);
  LAS unsigned char* lds = (LAS unsigned char*)smem;
  char* U = ws + OFF_U;
  Feat2Sched S; S.U = U; S.W = ws + OFF_WMIX; S.G = gridDim.x; S.c = obid();
  const float* w0 = gin(p, 20);
  const float* a0 = gin(p, 23);
  auto ep = [&](const f32x4 (&acc)[2][2][4][2], const fg::Unit& u, int wr, int wc, int fr, int fq) {
    const int job = u.aux, d = u.pn >> 2;
    const int colu = (job < 2 ? (u.pn & 3) : u.pn) * 256 + wc * 32 + 8 * fq;
    bf16_t* dst = (bf16_t*)(U + (job == 0 ? (d ? U3_LD1 : U3_LD0) : job == 1 ? (d ? U3_A1 : U3_A0) : U3_G));
    const float* bias = (job == 0 ? w0 : a0) + d * 1024;
#pragma unroll
    for (int ai = 0; ai < 2; ++ai)
#pragma unroll
      for (int m = 0; m < 4; ++m) {
        const size_t row = (size_t)u.pm * 256 + ai * 128 + wr * 64 + m * 16 + fr;
#pragma unroll
        for (int bj = 0; bj < 2; ++bj) {
          f32x4 x0 = acc[ai][bj][m][0], x1 = acc[ai][bj][m][1];
          if (job < 2) {
            const f32x4 b0 = *(const f32x4*)(bias + colu + bj * 128), b1 = *(const f32x4*)(bias + colu + bj * 128 + 4);
            const float sc_ = job == 0 ? -0.60653065971f : 1.0f;
#pragma unroll
            for (int j = 0; j < 4; ++j) { x0[j] = sc_ * sigmoidf_(x0[j] + b0[j]); x1[j] = sc_ * sigmoidf_(x1[j] + b1[j]); }
          }
          u32x4 w; w.x = pk2(x0[0], x0[1]); w.y = pk2(x0[2], x0[3]); w.z = pk2(x1[0], x1[1]); w.w = pk2(x1[2], x1[3]);
          *(u32x4*)(dst + row * DM + colu + bj * 128) = w;
        }
      }
  };
  fg::gemm_phase<false, true>(lds, 128, 128, 128, S, ep);
}

constexpr int C3_L = 32, C3_LDK = 72, C3_LDT = 40, C3_LDY = 36;
constexpr int C3_BT = 0, C3_RT = 4608, C3_KT = 9216, C3_CT = 13824, C3_KHT = 18432, C3_CHT = 23552, C3_VT = 28672, C3_GKB = 33792, C3_GKR = 36352,
              C3_GCR = 38912, C3_S0 = 41472, C3_U = 50688, C3_MCB = 55808, C3_Y = 59904, C3_E = 69120, C3_TOT = 69376, C3_SCAN = 70400;
constexpr int SC_LDS = 2 * C3_SCAN;
DI void lds_bar() { asm volatile("s_waitcnt lgkmcnt(0)" ::: "memory"); __builtin_amdgcn_s_barrier(); asm volatile("" ::: "memory"); }
#define DPP_ADD(s, ctrl) ((s) + __builtin_bit_cast(float, __builtin_amdgcn_update_dpp(0, __builtin_bit_cast(int, (s)), (ctrl), 0xF, 0xF, true)))
DI float wave_sum_dpp(float s) {
  s = DPP_ADD(s, 0xB1); s = DPP_ADD(s, 0x4E); s = DPP_ADD(s, 0x141); s = DPP_ADD(s, 0x140);
  const int si = __builtin_bit_cast(int, s);
  const float a0 = __builtin_bit_cast(float, __builtin_amdgcn_readlane(si, 0)), a1 = __builtin_bit_cast(float, __builtin_amdgcn_readlane(si, 16));
  const float a2 = __builtin_bit_cast(float, __builtin_amdgcn_readlane(si, 32)), a3 = __builtin_bit_cast(float, __builtin_amdgcn_readlane(si, 48));
  return (a0 + a1) + (a2 + a3);
}
DI void phase_rwkv_scan(KP p, char* smem) {
  char* const ws = ows(p);
  const int tid = otid(), lane = tid & 63, wid = tid >> 6, sc = wid >> 2, w4 = wid & 3, r = lane & 31, h = lane >> 5;
  char* sb = smem + sc * C3_SCAN;
  bf16_t* Bt = (bf16_t*)(sb + C3_BT); bf16_t* Rt = (bf16_t*)(sb + C3_RT); bf16_t* Kt = (bf16_t*)(sb + C3_KT); bf16_t* Ct = (bf16_t*)(sb + C3_CT);
  bf16_t* KhT = (bf16_t*)(sb + C3_KHT); bf16_t* ChT = (bf16_t*)(sb + C3_CHT); bf16_t* Vt = (bf16_t*)(sb + C3_VT);
  bf16_t* GkbT = (bf16_t*)(sb + C3_GKB); bf16_t* GkrT = (bf16_t*)(sb + C3_GKR); bf16_t* GcrT = (bf16_t*)(sb + C3_GCR);
  bf16_t* S0b = (bf16_t*)(sb + C3_S0); bf16_t* Ub = (bf16_t*)(sb + C3_U);
  float* McbP = (float*)(sb + C3_MCB); float* Yb = (float*)(sb + C3_Y); float* Eb = (float*)(sb + C3_E); float* Tot = (float*)(sb + C3_TOT);
  char* U = ws + OFF_U;
  const bf16_t* Kx = (const bf16_t*)(U + U3_K);
  const bf16_t* Vx = (const bf16_t*)(U + U3_V);
  const bf16_t* Rx = (const bf16_t*)(U + U3_R);
  const int ti = w4 >> 1, tj = w4 & 1;
  const int tio = w4 & 1;
  const int sv = w4 * 16 + (lane >> 2), jq = lane & 3;
  for (int base = obid() * 2; base < 512; base += gridDim.x * 2) {
    const int item = base + sc, dir = item & 1, head = (item >> 1) & 15, b = item >> 5;
    const bf16_t* Ax = (const bf16_t*)(U + (dir ? U3_A1 : U3_A0));
    const bf16_t* Lx = (const bf16_t*)(U + (dir ? U3_LD1 : U3_LD0));
    bf16_t* Ox = (bf16_t*)(U + (dir ? U3_O1 : U3_O0));
    const int ch = head * 64 + lane;
    const float kkw = gin(p, 28)[ch], kaw = gin(p, 29)[ch];
    auto rowof = [&](int n) -> int {
      if (n < 256) { const int c = dir ? 255 - n : n; return TL + b * 256 + c; }
      const int s = dir ? 4095 - (n - 256) : n - 256; return b * 4096 + s;
    };
    f32x16 S;
#pragma unroll
    for (int i = 0; i < 16; ++i) S[i] = 0.f;
    for (int i = lane; i < 64 * C3_LDK / 4; i += 64) if (w4 == 0) ((unsigned long long*)S0b)[i] = 0ull;
    bf16_t pk_[8], pa_[8], pl_[8], pv_[8], pr_[8];
    auto prefetch = [&](int c) {
#pragma unroll
      for (int q = 0; q < 8; ++q) {
        const int n = c * C3_L + w4 * 8 + q;
        const size_t off = (size_t)rowof(n) * DM + ch;
        pk_[q] = Kx[off]; pa_[q] = Ax[off]; pl_[q] = Lx[off]; pv_[q] = Vx[off];
        pr_[q] = n >= 256 ? Rx[off] : (bf16_t)0;
      }
    };
    constexpr int NCH = 4352 / C3_L;
    prefetch(0);
    lds_bar();
    for (int c = 0; c < NCH; ++c) {
      float kkv[8], cv[8], kdv[8], lv[8], cl[8], rv[8], vv[8];
      {
        float run = 0.f;
#pragma unroll
        for (int q = 0; q < 8; ++q) {
          const float kv = bf2f(pk_[q]), av = bf2f(pa_[q]);
          lv[q] = bf2f(pl_[q]); rv[q] = bf2f(pr_[q]); vv[q] = bf2f(pv_[q]);
          const float kkr = kv * kkw;
          kkv[q] = kkr * __builtin_amdgcn_rsqf(fmaxf(wave_sum_dpp(kkr * kkr), 1e-24f));
          cv[q] = kkv[q] * av;
          kdv[q] = kv * (1.0f + (av - 1.0f) * kaw);
          run += lv[q]; cl[q] = run;
        }
        Tot[w4 * 64 + lane] = run;
      }
      if (c + 1 < NCH) prefetch(c + 1);
      lds_bar();
      {
        const float t0 = Tot[lane], t1 = Tot[64 + lane], t2 = Tot[128 + lane], t3 = Tot[192 + lane];
        const float cumL = (t0 + t1) + (t2 + t3);
        const float off = w4 == 0 ? 0.f : (w4 == 1 ? t0 : (w4 == 2 ? t0 + t1 : (t0 + t1) + t2));
        float kh[8], chh[8];
#pragma unroll
        for (int q = 0; q < 8; ++q) {
          const int t = w4 * 8 + q;
          const float cumt = off + cl[q], cump = cumt - lv[q];
          const float e1 = __expf(cump), e2 = __expf(cumt), e3 = __expf(-cumt), e4 = __expf(cumL - cumt);
          Bt[t * C3_LDK + lane] = f2bf(kkv[q] * e1);
          Rt[t * C3_LDK + lane] = f2bf(rv[q] * e2);
          Kt[t * C3_LDK + lane] = f2bf(kdv[q] * e3);
          Ct[t * C3_LDK + lane] = f2bf(cv[q] * e3);
          kh[q] = kdv[q] * e4; chh[q] = cv[q] * e4;
        }
        u32x4 w;
        w.x = pk2(kh[0], kh[1]); w.y = pk2(kh[2], kh[3]); w.z = pk2(kh[4], kh[5]); w.w = pk2(kh[6], kh[7]);
        *(u32x4*)(KhT + lane * C3_LDT + w4 * 8) = w;
        w.x = pk2(chh[0], chh[1]); w.y = pk2(chh[2], chh[3]); w.z = pk2(chh[4], chh[5]); w.w = pk2(chh[6], chh[7]);
        *(u32x4*)(ChT + lane * C3_LDT + w4 * 8) = w;
        w.x = pk2(vv[0], vv[1]); w.y = pk2(vv[2], vv[3]); w.z = pk2(vv[4], vv[5]); w.w = pk2(vv[6], vv[7]);
        *(u32x4*)(Vt + lane * C3_LDT + w4 * 8) = w;
        if (w4 == 0) Eb[lane] = __expf(cumL);
      }
      lds_bar();
      {
        const bf16_t* Ag = (w4 & 1) ? Kt : Ct;
        const bf16_t* Bg = (w4 & 2) ? Rt : Bt;
        f32x16 X;
#pragma unroll
        for (int i = 0; i < 16; ++i) X[i] = 0.f;
#pragma unroll
        for (int s = 0; s < 4; ++s) {
          const bf16x8 a = *(const bf16x8*)(Ag + r * C3_LDK + 16 * s + 8 * h);
          const bf16x8 bq = *(const bf16x8*)(Bg + r * C3_LDK + 16 * s + 8 * h);
          X = MFMA32(a, bq, X);
        }
        const bool incl = (w4 & 2) != 0;
#pragma unroll
        for (int i = 0; i < 16; ++i) { const int jr = (i & 3) + 8 * (i >> 2) + 4 * h; if (!(jr < r || (incl && jr == r))) X[i] = 0.f; }
        if (w4 == 0) {
#pragma unroll
          for (int i = 0; i < 16; ++i) { const int jr = (i & 3) + 8 * (i >> 2) + 4 * h; McbP[r * 32 + (jr & 3) * 8 + (jr >> 2)] = X[i]; }
        } else {
          bf16_t* G = w4 == 1 ? GkbT : (w4 == 2 ? GcrT : GkrT);
#pragma unroll
          for (int g = 0; g < 4; ++g) { u32x2 w; w.x = pk2(X[4 * g], X[4 * g + 1]); w.y = pk2(X[4 * g + 2], X[4 * g + 3]); *(u32x2*)(G + r * C3_LDT + 8 * g + 4 * h) = w; }
        }
      }
      lds_bar();
      f32x16 XO;
      {
        const bf16_t* Bq = (w4 & 2) ? Rt : Bt;
        const bf16_t* Gq = (w4 & 2) ? GkrT : GkbT;
#pragma unroll
        for (int i = 0; i < 16; ++i) XO[i] = 0.f;
#pragma unroll
        for (int s = 0; s < 4; ++s) {
          const bf16x8 a = *(const bf16x8*)(S0b + (32 * tio + r) * C3_LDK + 16 * s + 8 * h);
          const bf16x8 bq = *(const bf16x8*)(Bq + r * C3_LDK + 16 * s + 8 * h);
          XO = MFMA32(a, bq, XO);
        }
#pragma unroll
        for (int s = 0; s < 2; ++s) {
          const bf16x8 a = *(const bf16x8*)(Vt + (32 * tio + r) * C3_LDT + 16 * s + 8 * h);
          const bf16x8 bq = *(const bf16x8*)(Gq + r * C3_LDT + 16 * s + 8 * h);
          XO = MFMA32(a, bq, XO);
        }
        if (w4 < 2) {
#pragma unroll
          for (int i = 0; i < 16; ++i) Yb[(32 * tio + (i & 3) + 8 * (i >> 2) + 4 * h) * C3_LDY + r] = XO[i];
        }
      }
      lds_bar();
      {
        float u[8];
#pragma unroll
        for (int jj = 0; jj < 8; ++jj) u[jj] = 0.f;
        const unsigned ma = (unsigned)(size_t)(McbP + jq * 8);
        f32x4 yv[8];
#pragma unroll
        for (int i = 0; i < 8; ++i) yv[i] = *(const f32x4*)(Yb + sv * C3_LDY + 4 * i);
        f32x4 mA[4], mB[4];
#define C3_MLOAD(t_) asm volatile("ds_read_b128 %0, %2 offset:%c3\n\tds_read_b128 %1, %2 offset:%c4" : "=&v"(mA[(t_) & 3]), "=&v"(mB[(t_) & 3]) : "v"(ma), "i"((t_) * 128), "i"((t_) * 128 + 16) : "memory")
        C3_MLOAD(1); C3_MLOAD(2); C3_MLOAD(3);
        if (jq == 0) u[0] = yv[0][0];
#pragma unroll
        for (int t = 1; t < 32; ++t) {
          if (t + 3 < 32) { C3_MLOAD(t + 3); asm volatile("s_waitcnt lgkmcnt(6)" ::: "memory"); }
          else if (t + 2 < 32) asm volatile("s_waitcnt lgkmcnt(4)" ::: "memory");
          else if (t + 1 < 32) asm volatile("s_waitcnt lgkmcnt(2)" ::: "memory");
          else asm volatile("s_waitcnt lgkmcnt(0)" ::: "memory");
          asm volatile("" :: "v"(mA[t & 3]), "v"(mB[t & 3]));
          __builtin_amdgcn_sched_barrier(0);
          const f32x4 m0 = mA[t & 3], m1 = mB[t & 3];
          const int jl = (t - 1) >> 2;
          float part = 0.f;
#pragma unroll
          for (int jj = 0; jj < 8; ++jj) if (jj != jl && jj * 4 < t) part += u[jj] * (jj < 4 ? m0[jj] : m1[jj - 4]);
          part += u[jl] * (jl < 4 ? m0[jl] : m1[jl - 4]);
          part = DPP_ADD(part, 0xB1); part = DPP_ADD(part, 0x4E);
          const float ut = yv[t >> 2][t & 3] - part;
          u[t >> 2] = (jq == (t & 3)) ? ut : u[t >> 2];
        }
#undef C3_MLOAD
#pragma unroll
        for (int jj = 0; jj < 8; ++jj) Ub[sv * C3_LDT + jq + 4 * jj] = f2bf(u[jj]);
      }
      lds_bar();
      if (w4 >= 2) {
        f32x16 X2;
#pragma unroll
        for (int i = 0; i < 16; ++i) X2[i] = 0.f;
#pragma unroll
        for (int s = 0; s < 2; ++s) {
          const bf16x8 a = *(const bf16x8*)(Ub + (32 * tio + r) * C3_LDT + 16 * s + 8 * h);
          const bf16x8 bq = *(const bf16x8*)(GcrT + r * C3_LDT + 16 * s + 8 * h);
          X2 = MFMA32(a, bq, X2);
        }
        if (c * C3_L >= 256) {
          const size_t orow = (size_t)rowof(c * C3_L + r) * DM + head * 64 + 32 * tio + 4 * h;
#pragma unroll
          for (int g = 0; g < 4; ++g) {
            u32x2 w; w.x = pk2(XO[4 * g] - X2[4 * g], XO[4 * g + 1] - X2[4 * g + 1]); w.y = pk2(XO[4 * g + 2] - X2[4 * g + 2], XO[4 * g + 3] - X2[4 * g + 3]);
            *(u32x2*)(Ox + orow + 8 * g) = w;
          }
        }
      }
      {
        f32x16 P1, P2;
#pragma unroll
        for (int i = 0; i < 16; ++i) { P1[i] = 0.f; P2[i] = 0.f; }
#pragma unroll
        for (int s = 0; s < 2; ++s) {
          const bf16x8 av = *(const bf16x8*)(Vt + (32 * ti + r) * C3_LDT + 16 * s + 8 * h);
          const bf16x8 bk = *(const bf16x8*)(KhT + (32 * tj + r) * C3_LDT + 16 * s + 8 * h);
          P1 = MFMA32(av, bk, P1);
          const bf16x8 au = *(const bf16x8*)(Ub + (32 * ti + r) * C3_LDT + 16 * s + 8 * h);
          const bf16x8 bc = *(const bf16x8*)(ChT + (32 * tj + r) * C3_LDT + 16 * s + 8 * h);
          P2 = MFMA32(au, bc, P2);
        }
        const float ek = Eb[32 * tj + r];
#pragma unroll
        for (int i = 0; i < 16; ++i) {
          S[i] = S[i] * ek + P1[i] - P2[i];
          S0b[(32 * ti + (i & 3) + 8 * (i >> 2) + 4 * h) * C3_LDK + 32 * tj + r] = f2bf(S[i]);
        }
      }
      lds_bar();
    }
  }
}

DI void phase_rwkv_out(KP p, char* smem) {
  char* const ws = ows(p);
  const int lane = otid() & 63, wid = otid() >> 6;
  char* U = ws + OFF_U;
  const bf16_t *Rx = (const bf16_t*)(U + U3_R), *Kx = (const bf16_t*)(U + U3_K), *Vx = (const bf16_t*)(U + U3_V), *A0 = (const bf16_t*)(U + U3_A0),
               *A1 = (const bf16_t*)(U + U3_A1), *Gx = (const bf16_t*)(U + U3_G), *O0 = (const bf16_t*)(U + U3_O0), *O1 = (const bf16_t*)(U + U3_O1);
  bf16_t* Z = (bf16_t*)(ws + OFF_H);
  const int ch0 = lane * 16;
  float ka[16], rk[16], lw[16], lb[16];
#pragma unroll
  for (int j = 0; j < 16; ++j) { ka[j] = gin(p, 29)[ch0 + j]; rk[j] = gin(p, 30)[ch0 + j]; lw[j] = gin(p, 31)[ch0 + j]; lb[j] = gin(p, 32)[ch0 + j]; }
  auto ld16f = [&](const bf16_t* base, size_t off, float (&o)[16]) {
    const u32x4 a = ld16(base + off), b = ld16(base + off + 8);
    o[0] = bflo(a.x); o[1] = bfhi(a.x); o[2] = bflo(a.y); o[3] = bfhi(a.y); o[4] = bflo(a.z); o[5] = bfhi(a.z); o[6] = bflo(a.w); o[7] = bfhi(a.w);
    o[8] = bflo(b.x); o[9] = bfhi(b.x); o[10] = bflo(b.y); o[11] = bfhi(b.y); o[12] = bflo(b.z); o[13] = bfhi(b.z); o[14] = bflo(b.w); o[15] = bfhi(b.w);
  };
  for (int r = obid() * 8 + wid; r < TL; r += gridDim.x * 8) {
    const size_t off = (size_t)r * DM + ch0;
    float o0[16], o1[16], rr[16], kk[16], vv[16], a0[16], a1[16], gg[16];
    ld16f(O0, off, o0); ld16f(O1, off, o1); ld16f(Rx, off, rr); ld16f(Kx, off, kk); ld16f(Vx, off, vv); ld16f(A0, off, a0); ld16f(A1, off, a1); ld16f(Gx, off, gg);
    float s = 0.f, bs = 0.f;
#pragma unroll
    for (int j = 0; j < 16; ++j) {
      o0[j] += o1[j]; s += o0[j];
      const float kd0 = kk[j] * (1.0f + (a0[j] - 1.0f) * ka[j]), kd1 = kk[j] * (1.0f + (a1[j] - 1.0f) * ka[j]);
      bs += rr[j] * (kd0 + kd1) * rk[j];
    }
    s += __shfl_xor(s, 1); s += __shfl_xor(s, 2);
    bs += __shfl_xor(bs, 1); bs += __shfl_xor(bs, 2);
    const float mean = s * (1.0f / 64.0f);
    float q = 0.f;
#pragma unroll
    for (int j = 0; j < 16; ++j) { const float d = o0[j] - mean; q += d * d; }
    q += __shfl_xor(q, 1); q += __shfl_xor(q, 2);
    const float rstd = rsqrtf(q * (1.0f / 64.0f) + 64e-5f);
    float z[16];
#pragma unroll
    for (int j = 0; j < 16; ++j) z[j] = ((o0[j] - mean) * rstd * lw[j] + lb[j] + bs * vv[j]) * gg[j];
    u32x4 w0;
    w0.x = pk4_fp8(z[0] * O8_SCALE, z[1] * O8_SCALE, z[2] * O8_SCALE, z[3] * O8_SCALE); w0.y = pk4_fp8(z[4] * O8_SCALE, z[5] * O8_SCALE, z[6] * O8_SCALE, z[7] * O8_SCALE);
    w0.z = pk4_fp8(z[8] * O8_SCALE, z[9] * O8_SCALE, z[10] * O8_SCALE, z[11] * O8_SCALE); w0.w = pk4_fp8(z[12] * O8_SCALE, z[13] * O8_SCALE, z[14] * O8_SCALE, z[15] * O8_SCALE);
    *(u32x4*)((unsigned char*)Z + off) = w0;
  }
}

#define XB_TMO      128
#define XB_XCNT(j)  (256  + 64 * (j))
#define XB_XSUB(j)  (1280 + 64 * (j))
#define XB_XGEN(j)  (2304 + 64 * (j))
#define XB_TOP      3328
#define XB_TOPGEN   3392
#define XCD_BAR_WORDS 3456
#define XB_SPIN_CAP (1u << 22)
#define LAS __attribute__((address_space(3)))
__device__ __forceinline__ unsigned xb_ld(unsigned* p)              { return __hip_atomic_load(p, __ATOMIC_RELAXED, __HIP_MEMORY_SCOPE_AGENT); }
__device__ __forceinline__ unsigned xb_add(unsigned* p, unsigned v) { return __hip_atomic_fetch_add(p, v, __ATOMIC_RELAXED, __HIP_MEMORY_SCOPE_AGENT); }
__device__ __forceinline__ unsigned xb_xcc_id() { return (unsigned)__builtin_amdgcn_s_getreg((3 << 11) | 20) & 0xFu; }
#define XB_SPIN(cond, bar) do { unsigned _sp = 0; while (cond) { __builtin_amdgcn_s_sleep(1); \
    if ((++_sp & 255u) == 0u) { if (xb_ld(&(bar)[XB_TMO])) break; if (_sp > XB_SPIN_CAP) { atomicAdd(&(bar)[XB_TMO], 1u); break; } } } } while (0)
struct XcdBarrier { unsigned* bar; unsigned x; volatile LAS unsigned* st; };
__device__ __forceinline__ XcdBarrier xcd_barrier_post(unsigned* bar, volatile LAS unsigned* st) {
    XcdBarrier b; b.bar = bar; b.x = xb_xcc_id(); b.st = st;
    if (otid() == 0) (void)xb_add(&bar[XB_XCNT(b.x)], 1u);
    return b;
}
__device__ __forceinline__ void xcd_barrier_complete(unsigned* bar, unsigned x, unsigned& nloc, unsigned& nx) {
    const unsigned G = gridDim.x * gridDim.y * gridDim.z;
    unsigned sum, cnt, mine, sp = 0u;
    for (;;) {
        sum = 0u; cnt = 0u; mine = 0u;
#pragma unroll
        for (unsigned j = 0; j < 16; ++j) { const unsigned c = xb_ld(&bar[XB_XCNT(j)]); sum += c; cnt += (c > 0u) ? 1u : 0u; mine = (j == x) ? c : mine; }
        if (sum == G) break;
        __builtin_amdgcn_s_sleep(1);
        if ((++sp & 255u) == 0u) { if (xb_ld(&bar[XB_TMO])) break; if (sp > XB_SPIN_CAP) { atomicAdd(&bar[XB_TMO], 1u); break; } }
    }
    nloc = mine > 0u ? mine : 1u; nx = cnt > 0u ? cnt : 1u;
}
__device__ __forceinline__ void xcd_barrier(const XcdBarrier& b) {
    asm volatile("s_waitcnt vmcnt(0)" ::: "memory");
    __syncthreads();
    if (otid() == 0) {
        unsigned* bar = b.bar;
        __builtin_amdgcn_s_waitcnt(0);
        unsigned nloc = b.st[0], nx = b.st[1];
        if (nloc == 0u) { xcd_barrier_complete(bar, b.x, nloc, nx); b.st[0] = nloc; b.st[1] = nx; }
        const unsigned old = xb_add(&bar[XB_XSUB(b.x)], 1u);
        const unsigned gen = old / nloc;
        if (old + 1u == (gen + 1u) * nloc) {
            __builtin_amdgcn_fence(__ATOMIC_RELEASE, "agent");
            asm volatile("s_waitcnt vmcnt(0)" ::: "memory");
            const unsigned og = xb_add(&bar[XB_TOP], 1u);
            const unsigned tg = og / nx;
            if (og + 1u == (tg + 1u) * nx) xb_add(&bar[XB_TOPGEN], 1u);
            else XB_SPIN(xb_ld(&bar[XB_TOPGEN]) == tg, bar);
            __builtin_amdgcn_fence(__ATOMIC_ACQUIRE, "agent");
            xb_add(&bar[XB_XGEN(b.x)], 1u);
            asm volatile("s_waitcnt vmcnt(0)" ::: "memory");
        } else {
            XB_SPIN(xb_ld(&bar[XB_XGEN(b.x)]) == gen, bar);
            __builtin_amdgcn_fence(__ATOMIC_ACQUIRE, "agent");
            asm volatile("s_waitcnt vmcnt(0)" ::: "memory");
        }
    }
    __syncthreads();
}

DI void gbar(const XcdBarrier& b0) {
  XcdBarrier b = b0;
  unsigned long long pb = (unsigned long long)b.bar; asm volatile("" : "+s"(pb)); b.bar = (unsigned*)pb;
  unsigned x = b.x; asm volatile("" : "+s"(x)); b.x = x;
  xcd_barrier(b);
}

constexpr int cmaxi(int a, int b) { return a > b ? a : b; }
constexpr int FUSED_LDS = 256 + cmaxi(cmaxi(MOD_LDS, A1_LDS), cmaxi(cmaxi(SC_LDS, R2_LDS), FG_LDS + MOE_UMAX * 1024 + 256));
#ifndef PROBE_GROUP
#define PROBE_GROUP 0
#endif
#define PROBE(g, stmt) do { if constexpr (PROBE_GROUP == (g)) { stmt; gbar(bar); } } while (0)
template <int layer>
DI void run_layer(const XcdBarrier& bar, char* smem) {
  char* U = ows(kparams()) + OFF_U;
  const bf16_t* wm = (const bf16_t*)(ows(kparams()) + OFF_WMIX);
  if constexpr (layer == 0) phase_norm1<0, false, true>(kparams(), layer, smem); else phase_norm1<1, false, layer == 1>(kparams(), layer, smem);
  gbar(bar);
  PROBE(1, (phase_norm1<(layer == 0 ? 0 : 1), true, (layer <= 1)>(kparams(), layer, smem)));
  if constexpr (layer == 0) {
    phase_qkv_win8(kparams(), smem);
    gbar(bar);
    PROBE(3, phase_qkv_win8(kparams(), smem));
    phase_attn_win(kparams(), smem);
    gbar(bar);
    PROBE(4, phase_attn_win(kparams(), smem));
    phase_oproj8(kparams(), 0, U + U0_O, (const char*)(wm + W_WINO), TT, smem);
    gbar(bar);
    PROBE(3, (phase_oproj8<true>(kparams(), 0, U + U0_O, (const char*)(wm + W_WINO), TT, smem)));
  } else if constexpr (layer == 1) {
    phase_qkv_diff8(kparams(), smem);
    gbar(bar);
    PROBE(3, phase_qkv_diff8(kparams(), smem));
    phase_attn_diff(kparams(), smem);
    gbar(bar);
    PROBE(10, phase_attn_diff(kparams(), smem));
    phase_oproj8(kparams(), 1, U + U1_O, (const char*)(wm + W_DIFFO), TT, smem);
    gbar(bar);
    PROBE(3, (phase_oproj8<true>(kparams(), 1, U + U1_O, (const char*)(wm + W_DIFFO), TT, smem)));
  } else if constexpr (layer == 2) {
    phase_pool_pre(kparams(), smem);
    gbar(bar);
    PROBE(6, phase_pool_pre(kparams(), smem));
    phase_pool(kparams(), smem);
    gbar(bar);
    PROBE(6, phase_pool<true>(kparams(), smem));
  } else {
    phase_rwkv_mix(kparams(), smem);
    gbar(bar);
    PROBE(7, phase_rwkv_mix(kparams(), smem));
    phase_rwkv_rkv(kparams(), smem);
    __syncthreads();
    phase_rwkv_feat1(kparams(), smem);
    gbar(bar);
    PROBE(7, phase_rwkv_rkv(kparams(), smem));
    PROBE(8, phase_rwkv_feat1(kparams(), smem));
    phase_rwkv_feat2(kparams(), smem);
    gbar(bar);
    PROBE(8, phase_rwkv_feat2(kparams(), smem));
    phase_rwkv_scan(kparams(), smem);
    gbar(bar);
    PROBE(11, phase_rwkv_scan(kparams(), smem));
    phase_rwkv_out(kparams(), smem);
    gbar(bar);
    PROBE(9, phase_rwkv_out(kparams(), smem));
    phase_oproj8(kparams(), 3, ows(kparams()) + OFF_H, (const char*)(wm + W_RO), TL, smem);
    gbar(bar);
    PROBE(3, (phase_oproj8<true>(kparams(), 3, ows(kparams()) + OFF_H, (const char*)(wm + W_RO), TL, smem)));
  }
  phase_norm2_router(kparams(), layer, smem);
  __syncthreads();
  phase_cvt_moe(kparams(), layer, smem);
  gbar(bar);
  PROBE(2, phase_norm2_router<true>(kparams(), layer, smem));
  PROBE(5, phase_cvt_moe(kparams(), layer, smem));
  phase_moe_up(kparams(), layer, smem);
  gbar(bar);
  phase_moe_down(kparams(), layer, smem);
  gbar(bar);
  PROBE(12, phase_moe_up(kparams(), layer, smem));
  PROBE(12, phase_moe_down(kparams(), layer, smem));
}

__global__ __launch_bounds__(NTH, 2) void k_fused(Params p_unused) {
  extern __shared__ __attribute__((aligned(16))) char smem_all[];
  if (threadIdx.x == 0) *(uint4*)smem_all = make_uint4(0u, 0u, 0u, 0u);
  __syncthreads();
  XcdBarrier bar = xcd_barrier_post((unsigned*)(ows(kparams()) + OFF_BAR), (volatile LAS unsigned*)smem_all);
  char* smem = smem_all + 256;
  phase_cvt_mix(kparams(), smem);
  __syncthreads();
  phase_mod(kparams(), smem);
  gbar(bar);
  PROBE(5, phase_cvt_mix(kparams(), smem));
  PROBE(5, phase_mod(kparams(), smem));
  run_layer<0>(bar, smem);
  run_layer<1>(bar, smem);
  run_layer<2>(bar, smem);
  run_layer<3>(bar, smem);
  phase_norm1<3>(kparams(), 3, smem);
  PROBE(1, (gbar(bar), phase_norm1<3, true>(kparams(), 3, smem)));
}

static void fill_params(Params& p, void* const* d_in, void* d_out, void* d_ws) {
  for (int i = 0; i < 40; ++i) p.in[i] = (const float*)d_in[i];
  p.out = (float*)d_out;
  p.ws = (char*)d_ws;
  bf16_t* wm = (bf16_t*)(p.ws + OFF_WMIX);
  int nj = 0, item = 0;
  auto add = [&](const float* src, size_t dstoff, int K, int N, int ld, int dld = 0, int f8 = 0) {
    p.jobs[nj].src = src; p.jobs[nj].dst = wm + dstoff; p.jobs[nj].K = K; p.jobs[nj].N = N; p.jobs[nj].ld = ld; p.jobs[nj].item0 = item; p.jobs[nj].dld = dld ? dld : K; p.jobs[nj].pad_ = f8;
    item += (K / 64) * (N / 64); ++nj;
  };
  add(p.in[8], W_WINQKV, 1024, 1536, 1536, 0, 1);
  add(p.in[10], W_WINO, 1024, 1024, 1024, 0, 1);
  add(p.in[11], W_DIFFQKV, 1024, 3072, 3072, 0, 1);
  add(p.in[14], W_DIFFO, 1024, 1024, 1024, 0, 1);
  for (int g = 0; g < 4; ++g) add(p.in[15] + (size_t)g * 65536, W_POOL + (size_t)g * 65536, 256, 256, 256);
  add(p.in[19], W_R, 1024, 1024, 1024, 0, 1);
  add(p.in[19] + (size_t)1 * 1024 * 1024, W_K, 1024, 1024, 1024, 0, 1);
  add(p.in[19] + (size_t)2 * 1024 * 1024, W_V, 1024, 1024, 1024, 0, 1);
  for (int d = 0; d < 2; ++d) add(p.in[21] + (size_t)d * 1024 * 64, W_WA1 + (size_t)d * 64 * 1024, 1024, 64, 64);
  for (int d = 0; d < 2; ++d) add(p.in[24] + (size_t)d * 1024 * 64, W_AA1 + (size_t)d * 64 * 1024, 1024, 64, 64);
  add(p.in[26], W_G1, 1024, 128, 128);
  for (int d = 0; d < 2; ++d) add(p.in[22] + (size_t)d * 64 * 1024, W_WA2 + (size_t)d * 1024 * 128 + d * 64, 64, 1024, 1024, 128);
  for (int d = 0; d < 2; ++d) add(p.in[25] + (size_t)d * 64 * 1024, W_AA2 + (size_t)d * 1024 * 128 + d * 64, 64, 1024, 1024, 128);
  add(p.in[27], W_G2, 128, 1024, 1024);
  add(p.in[33], W_RO, 1024, 1024, 1024, 0, 1);
  p.njobs = nj; p.nitems = item;
}

extern "C" void kernel_launch(void* const* d_in, const int* in_sizes, int n_in, void* d_out, int out_size, void* d_ws, size_t ws_size, hipStream_t stream) {
  if (ws_size < WS_NEED || n_in < 40) return;
  Params p{};
  fill_params(p, d_in, d_out, d_ws);
  (void)hipMemsetAsync(p.ws, 0, 32768, stream);
  (void)hipMemsetAsync(p.ws + OFF_H8 + (size_t)TT * DM, 0, 8 * DM, stream);
  static int grid = 0;
  if (!grid) {
    int dev = 0, cus = 0, per_cu = 0;
    (void)hipGetDevice(&dev);
    (void)hipDeviceGetAttribute(&cus, hipDeviceAttributeMultiprocessorCount, dev);
    (void)hipFuncSetAttribute((const void*)k_fused, hipFuncAttributeMaxDynamicSharedMemorySize, FUSED_LDS);
    (void)hipOccupancyMaxActiveBlocksPerMultiprocessor(&per_cu, (const void*)k_fused, NTH, FUSED_LDS);
    grid = cus * (per_cu < 1 ? per_cu : 1);
  }
  if (grid <= 0) return;
  hipLaunchKernelGGL(k_fused, dim3(grid), dim3(NTH), FUSED_LDS, stream, p);
}
```

```cpp
#include <hip/hip_runtime.h>
#include <stdint.h>
#include <stddef.h>

typedef unsigned short bf16_t;
typedef short bf16x8 __attribute__((ext_vector_type(8)));
typedef short s16x4 __attribute__((ext_vector_type(4)));
typedef float f32x4 __attribute__((ext_vector_type(4)));
typedef float f32x16 __attribute__((ext_vector_type(16)));
typedef unsigned u32x4 __attribute__((ext_vector_type(4)));
typedef unsigned u32x2 __attribute__((ext_vector_type(2)));
typedef float f32x2 __attribute__((ext_vector_type(2)));
#define DI __device__ __forceinline__

constexpr int DM = 1024, NBATCH = 16, SEQ = 4096, CTX = 256;
constexpr int TL = NBATCH * SEQ, TC = NBATCH * CTX, TT = TL + TC;
constexpr int NTH = 512;
constexpr int MOE_PAD = 256;
constexpr int MOE_ROWS = 2 * TT + 32 * MOE_PAD;
constexpr int CAP = TT;

constexpr size_t al256(size_t x) { return (x + 255) & ~(size_t)255; }
constexpr size_t OFF_BAR = 0;
constexpr size_t OFF_CNT = 16384;
constexpr size_t OFF_MOD = 32768;
constexpr size_t OFF_ROPE = al256(OFF_MOD + (size_t)4 * 17 * 6144 * 4);
constexpr size_t OFF_XB = al256(OFF_ROPE + 2 * 64 * 16 * 4);
constexpr size_t OFF_H = al256(OFF_XB + (size_t)TT * DM * 2);
constexpr size_t OFF_H8 = al256(OFF_H + (size_t)(TT + 8) * DM * 2);
constexpr size_t OFF_TOK = al256(OFF_H8 + (size_t)(TT + 8) * DM);
constexpr size_t OFF_ROWL = al256(OFF_TOK + (size_t)TT * 32);
constexpr size_t OFF_WMIX = al256(OFF_ROWL + (size_t)32 * CAP * 4);
constexpr size_t W_WINQKV = 0;
constexpr size_t W_WINO = W_WINQKV + (size_t)1536 * 1024;
constexpr size_t W_DIFFQKV = W_WINO + (size_t)1024 * 1024;
constexpr size_t W_DIFFO = W_DIFFQKV + (size_t)3072 * 1024;
constexpr size_t W_POOL = W_DIFFO + (size_t)1024 * 1024;
constexpr size_t W_R = W_POOL + (size_t)4 * 256 * 256;
constexpr size_t W_K = W_R + (size_t)1024 * 1024;
constexpr size_t W_V = W_K + (size_t)1024 * 1024;
constexpr size_t W_WA1 = W_V + (size_t)1024 * 1024;
constexpr size_t W_AA1 = W_WA1 + (size_t)128 * 1024;
constexpr size_t W_G1 = W_AA1 + (size_t)128 * 1024;
constexpr size_t W_WA2 = W_G1 + (size_t)128 * 1024;
constexpr size_t W_AA2 = W_WA2 + (size_t)2048 * 128;
constexpr size_t W_G2 = W_AA2 + (size_t)2048 * 128;
constexpr size_t W_RO = W_G2 + (size_t)1024 * 128;
constexpr size_t W_MIX_END = W_RO + (size_t)1024 * 1024;
constexpr size_t OFF_WR = al256(OFF_WMIX + W_MIX_END * 2);
constexpr size_t OFF_WMOE = al256(OFF_WR + (size_t)4 * 2 * 48 * 1024 * 2);
constexpr size_t WMOE_DOWN = (size_t)32 * 1024 * 1024;
constexpr size_t OFF_U = al256(OFF_WMOE + ((size_t)32 * 1024 * 1024 + (size_t)32 * 1024 * 512) * 2);
constexpr size_t SZ_TT = (size_t)TT * DM * 2, SZ_TL = (size_t)TL * DM * 2;
constexpr size_t U0_Q = 0, U0_K = U0_Q + SZ_TT, U0_V = U0_K + (size_t)TT * 256 * 2, U0_O = U0_V + (size_t)TT * 256 * 2, U0_END = U0_O + SZ_TT;
constexpr size_t U1_Q = 0, U1_K = U1_Q + SZ_TT, U1_V = U1_K + SZ_TT, U1_O = U1_V + SZ_TT, U1_END = U1_O + SZ_TT;
constexpr size_t U2_Y = 0, U2_END = SZ_TT;
constexpr size_t U3_R = 0, U3_K = U3_R + SZ_TL, U3_V = U3_K + SZ_TT, U3_A0 = U3_V + SZ_TT, U3_A1 = U3_A0 + SZ_TT, U3_LD0 = U3_A1 + SZ_TT,
                 U3_LD1 = U3_LD0 + SZ_TT, U3_LW = U3_LD1 + SZ_TT, U3_LA = U3_LW + (size_t)TT * 128 * 2, U3_LG = U3_LA + (size_t)TT * 128 * 2,
                 U3_G = U3_LG + (size_t)TL * 128 * 2, U3_O0 = U3_G + SZ_TL, U3_O1 = U3_O0 + SZ_TL, U3_END = U3_O1 + SZ_TL;
constexpr size_t U3_XR = U3_A0, U3_XK = U3_A1, U3_XV = U3_LD0;
constexpr size_t UM_ACT = 0, UM_YB = UM_ACT + (size_t)MOE_ROWS * 512 * 2, UM_END = UM_YB + (size_t)MOE_ROWS * 1024 * 2;
constexpr size_t cmax(size_t a, size_t b) { return a > b ? a : b; }
constexpr size_t U_SIZE = cmax(cmax(cmax(U0_END, U1_END), U2_END), cmax(U3_END, UM_END));
constexpr size_t WS_NEED = OFF_U + U_SIZE;

struct CvtJob { const float* src; bf16_t* dst; int K, N, ld, item0, dld, pad_; };
constexpr int NJOBS = 24;
struct Params {
  const float* in[40];
  float* out;
  char* ws;
  CvtJob jobs[NJOBS];
  int njobs, nitems;
};

typedef const __attribute__((address_space(4))) Params* KP;
DI KP kparams() { KP q = (KP)__builtin_amdgcn_kernarg_segment_ptr(); asm volatile("" : "+s"(q)); return q; }
DI char* ows(KP p) {
  const unsigned long long w = (unsigned long long)p->ws;
  unsigned lo = (unsigned)w, hi = (unsigned)(w >> 32);
  asm volatile("" : "+v"(lo), "+v"(hi));
  lo = __builtin_amdgcn_readfirstlane(lo); hi = __builtin_amdgcn_readfirstlane(hi);
  return (char*)(__attribute__((address_space(1))) char*)(((unsigned long long)hi << 32) | lo);
}
DI const float* gin(KP p, int i) { return (const float*)(__attribute__((address_space(1))) const float*)p->in[i]; }
DI float* gout(KP p) { return (float*)(__attribute__((address_space(1))) float*)p->out; }
DI int otid() { int t = threadIdx.x; asm volatile("" : "+v"(t)); return t; }
DI int obid() { int b = blockIdx.x; asm volatile("" : "+s"(b)); return b; }
DI unsigned pk2(float lo, float hi) {
  typedef __bf16 bf2 __attribute__((ext_vector_type(2)));
  typedef float f2 __attribute__((ext_vector_type(2)));
  f2 v = {lo, hi};
  return __builtin_bit_cast(unsigned, __builtin_convertvector(v, bf2));
}
DI float clamp8(float x) { return __builtin_amdgcn_fmed3f(x, -440.0f, 440.0f); }
DI void swap32(float x, float& a, float& b) {
  a = x; b = x;
  asm volatile("s_nop 1\n\tv_permlane32_swap_b32 %0, %1\n\ts_nop 1" : "+v"(a), "+v"(b));
}
DI unsigned pk4_fp8_nc(float a, float b, float c, float d) { int w; asm("" : "=v"(w)); w = __builtin_amdgcn_cvt_pk_fp8_f32(a, b, w, false); w = __builtin_amdgcn_cvt_pk_fp8_f32(c, d, w, true); return (unsigned)w; }
DI unsigned pk4_fp8(float a, float b, float c, float d) { int w = __builtin_amdgcn_cvt_pk_fp8_f32(clamp8(a), clamp8(b), 0, false); w = __builtin_amdgcn_cvt_pk_fp8_f32(clamp8(c), clamp8(d), w, true); return (unsigned)w; }
DI bf16_t f2bf(float x) { return (bf16_t)(pk2(x, 0.f) & 0xffffu); }
DI float bf2f(bf16_t b) { return __uint_as_float(((unsigned)b) << 16); }
DI float bflo(unsigned u) { return __uint_as_float(u << 16); }
DI float bfhi(unsigned u) { return __uint_as_float(u & 0xffff0000u); }
DI float wave_sum(float v) {
#pragma unroll
  for (int o = 32; o >= 1; o >>= 1) v += __shfl_xor(v, o);
  return v;
}
DI float sigmoidf_(float x) { return __builtin_amdgcn_rcpf(1.0f + __expf(-x)); }
DI int row_bi(int r) { return r < TL ? (r >> 12) : 16; }
DI bf16_t* xrow_ptr(KP p, char* ws, int r) { return (bf16_t*)(ws + OFF_XB) + (size_t)r * DM; }
DI f32x4 ldbf4(const bf16_t* q) { const u32x2 w = *(const u32x2*)q; return (f32x4){bflo(w.x), bfhi(w.x), bflo(w.y), bfhi(w.y)}; }
DI void stbf4(bf16_t* q, const f32x4& v) { u32x2 w; w.x = pk2(v[0], v[1]); w.y = pk2(v[2], v[3]); *(u32x2*)q = w; }
DI const float* modp(char* ws, int layer, int bi, int which) { return (const float*)(ws + OFF_MOD) + ((size_t)(layer * 17 + bi) * 6 + which) * DM; }
#define MFMA16(a, b, c) __builtin_amdgcn_mfma_f32_16x16x32_bf16((a), (b), (c), 0, 0, 0)
#define MFMA32(a, b, c) __builtin_amdgcn_mfma_f32_32x32x16_bf16((a), (b), (c), 0, 0, 0)

constexpr int SGLD = 72;
constexpr int SG_LDS = 2 * 128 * SGLD * 2;
template <class AL, class BL, class EP>
DI void sgemm_tile(char* smem, int K, AL la, BL lb, EP ep) {
  bf16_t* sA = (bf16_t*)smem;
  bf16_t* sB = sA + 128 * SGLD;
  const int tid = otid(), lane = tid & 63, wid = tid >> 6, wr = wid >> 2, wc = wid & 3, fr = lane & 15, fq = lane >> 4;
  f32x4 acc[4][2];
#pragma unroll
  for (int m = 0; m < 4; ++m)
#pragma unroll
    for (int n = 0; n < 2; ++n) acc[m][n] = (f32x4){0.f, 0.f, 0.f, 0.f};
  const int r_ = tid >> 3, k_ = (tid & 7) * 8;
  u32x4 ra0 = la(r_, k_), ra1 = la(r_ + 64, k_), rb0 = lb(r_, k_), rb1 = lb(r_ + 64, k_);
  const int nk = K >> 6;
  for (int kt = 0; kt < nk; ++kt) {
    __syncthreads();
    *(u32x4*)(sA + r_ * SGLD + k_) = ra0;
    *(u32x4*)(sA + (r_ + 64) * SGLD + k_) = ra1;
    *(u32x4*)(sB + r_ * SGLD + k_) = rb0;
    *(u32x4*)(sB + (r_ + 64) * SGLD + k_) = rb1;
    __syncthreads();
    if (kt + 1 < nk) {
      const int kk = (kt + 1) * 64 + k_;
      ra0 = la(r_, kk); ra1 = la(r_ + 64, kk); rb0 = lb(r_, kk); rb1 = lb(r_ + 64, kk);
    }
#pragma unroll
    for (int ks = 0; ks < 2; ++ks) {
      bf16x8 af[4], bq[2];
#pragma unroll
      for (int m = 0; m < 4; ++m) af[m] = *(const bf16x8*)(sA + (wr * 64 + m * 16 + fr) * SGLD + ks * 32 + fq * 8);
#pragma unroll
      for (int n = 0; n < 2; ++n) bq[n] = *(const bf16x8*)(sB + (wc * 32 + n * 16 + fr) * SGLD + ks * 32 + fq * 8);
#pragma unroll
      for (int m = 0; m < 4; ++m)
#pragma unroll
        for (int n = 0; n < 2; ++n) acc[m][n] = MFMA16(af[m], bq[n], acc[m][n]);
    }
  }
  ep(acc, wr * 64, wc * 32, fr, fq);
}
DI u32x4 ld16(const bf16_t* p) { return *(const u32x4*)p; }

#define LAS __attribute__((address_space(3)))
namespace fg {
typedef int v8i_t __attribute__((ext_vector_type(8)));
typedef int v4i_t __attribute__((ext_vector_type(4)));
constexpr int BM = 256, BK = 64, HALF = 128, HTB = HALF * BK * 2, STAGE_BYTES = 8 * HTB, NXCD = 8, WGM = 8;
DI int lds_byte(int r, int c) { const int st = (r >> 4) * 2 + (c >> 5), rr = r & 15, cc = c & 31, ob = rr * 64 + cc * 2; return st * 1024 + (ob ^ (((ob >> 9) & 1) << 5)); }
DI void stage_rc(int b, int& R, int& C) { const int st = b / 1024, sb = b % 1024, swz = sb ^ (((sb >> 9) & 1) << 5); R = (st >> 1) * 16 + swz / 64; C = (st & 1) * 32 + (swz % 64) / 2; }
struct Unit { const char* A; const char* B; int pm, pn, aux; };
DI bool static_order(int i, int G, int c, int nM, int nN, int& pm, int& pn) {
  const int nwg = nM * nN;
  const long L = (long)i * G + c; if (L >= nwg) return false;
  int wgid = (int)L; { const int q = nwg / NXCD, r = nwg % NXCD, xcd = wgid % NXCD, off = wgid / NXCD; wgid = (xcd < r ? xcd * (q + 1) : r * (q + 1) + (xcd - r) * q) + off; }
  const int nig = WGM * nN, gid = wgid / nig, fm = gid * WGM, gsz = (nM - fm) < WGM ? (nM - fm) : WGM;
  pm = fm + ((wgid % nig) % gsz); pn = (wgid % nig) / gsz; return true;
}
struct DenseSched {
  const char* A; const char* B; int nM, nN, G, c; size_t tA, tB;
  DI bool next(int i, Unit& u) const { int pm, pn; if (!static_order(i, G, c, nM, nN, pm, pn)) return false; u.pm = pm; u.pn = pn; u.aux = 0; u.A = A + (size_t)pm * tA; u.B = B + (size_t)pn * tB; return true; }
  DI const LAS int* rows(int) const { return nullptr; }
};

DI int perm32(int rho) { const int n = rho >> 4, i = rho & 15; return 8 * (i >> 2) + 4 * n + (i & 3); }
template <bool GATHER, bool PERM = false, class Epi, class Sched>
DI void gemm_phase(LAS unsigned char* lds, const int K, const int lda, const int ldb, const Sched& S, const Epi& E) {
  const int tid = otid(), wid = __builtin_amdgcn_readfirstlane(tid >> 6), lane = tid & 63, wr = wid >> 2, wc = wid & 3, fr = lane & 15, fq = lane >> 4;
  const int nt = K / BK;
  unsigned voffA[2], voffB[2]; int sR[2], sC[2];
#pragma unroll
  for (int i = 0; i < 2; ++i) { int R, C; stage_rc(tid * 16 + i * 8192, R, C); sR[i] = R; sC[i] = C; voffA[i] = (unsigned)(R * lda + C) * 2u; const int Rb = PERM ? ((R & ~31) + perm32(R & 31)) : R; voffB[i] = (unsigned)(Rb * ldb + C) * 2u; }
  const size_t kstep = (size_t)(BK * 2), hstepA = (size_t)HALF * lda * 2, hstepB = (size_t)HALF * ldb * 2;
  const unsigned ldsw = (unsigned)wid * 1024u;
  const int aoff = lds_byte(wr * 64 + fr, fq * 8), boff = lds_byte(wc * 32 + fr, fq * 8);
#define FG_SA(b, h) (((b) * 2 + (h)) * HTB)
#define FG_SB(b, h) ((4 + (b) * 2 + (h)) * HTB)
#define FG_GLDS(gp, bufoff, i_) __builtin_amdgcn_global_load_lds((const unsigned*)(gp), (LAS unsigned*)(lds + (bufoff) + ldsw + (i_) * 8192), 16, 0, 0)
#define FG_STAGE_B(bufoff, gbase) do { const char* _gb = (gbase); FG_GLDS(_gb + voffB[0], bufoff, 0); FG_GLDS(_gb + voffB[1], bufoff, 1); } while (0)
#define FG_STAGE_A(bufoff, NX, H, KB) do { \
    if constexpr (GATHER) { const char* _gb = ((NX) ? nA : cA) + (KB); FG_GLDS(_gb + ((NX) ? gn[H][0] : gc[H][0]), bufoff, 0); FG_GLDS(_gb + ((NX) ? gn[H][1] : gc[H][1]), bufoff, 1); } \
    else { const char* _gb = ((NX) ? nA : cA) + (size_t)(H) * hstepA + (KB); FG_GLDS(_gb + voffA[0], bufoff, 0); FG_GLDS(_gb + voffA[1], bufoff, 1); } } while (0)
#define FG_LDA(dst, b, h) do { _Pragma("unroll") for (int m = 0; m < 4; ++m) _Pragma("unroll") for (int k = 0; k < 2; ++k) dst[m][k] = *(const LAS bf16x8*)(lds + FG_SA(b, h) + aoff + m * 2048 + k * 1024); } while (0)
#define FG_LDB(dst, b, h) do { _Pragma("unroll") for (int n = 0; n < 2; ++n) _Pragma("unroll") for (int k = 0; k < 2; ++k) dst[n][k] = *(const LAS bf16x8*)(lds + FG_SB(b, h) + boff + n * 2048 + k * 1024); } while (0)
#define FG_MMA(ai, bj, At, Bt) do { __builtin_amdgcn_s_setprio(1); _Pragma("unroll") for (int m = 0; m < 4; ++m) _Pragma("unroll") for (int n = 0; n < 2; ++n) _Pragma("unroll") for (int k = 0; k < 2; ++k) \
    acc[ai][bj][m][n] = __builtin_amdgcn_mfma_f32_16x16x32_bf16(Bt[n][k], At[m][k], acc[ai][bj][m][n], 0, 0, 0); __builtin_amdgcn_s_setprio(0); } while (0)
#define FG_WAIT_V(n) asm volatile("s_waitcnt vmcnt(" #n ")" ::: "memory")
#define FG_WAIT_L(n) asm volatile("s_waitcnt lgkmcnt(" #n ")" ::: "memory")
#define FG_BAR __builtin_amdgcn_s_barrier()
#define FG_SCHED __builtin_amdgcn_sched_barrier(0)
  Unit cur, nxt; int ui = 0;
  if (!S.next(0, cur)) return;
  f32x4 acc[2][2][4][2];
#pragma unroll
  for (int a = 0; a < 2; ++a)
#pragma unroll
    for (int b = 0; b < 2; ++b)
#pragma unroll
      for (int m = 0; m < 4; ++m)
#pragma unroll
        for (int n = 0; n < 2; ++n) acc[a][b][m][n] = (f32x4){0.f, 0.f, 0.f, 0.f};
  bf16x8 At[4][2], B0[2][2], B1[2][2];
  const char* cA = cur.A; const char* cB = cur.B;
  const char* nA = cA; const char* nB = cB;
  unsigned gc[2][2] = {{0u, 0u}, {0u, 0u}}, gn[2][2] = {{0u, 0u}, {0u, 0u}};
  if constexpr (GATHER) {
    const LAS int* rw = S.rows(0);
#pragma unroll
    for (int h = 0; h < 2; ++h)
#pragma unroll
      for (int i = 0; i < 2; ++i) { gc[h][i] = (unsigned)(rw[h * HALF + sR[i]] * lda + sC[i]) * 2u; gn[h][i] = gc[h][i]; }
  }
  FG_STAGE_B(FG_SB(0, 0), cB); FG_STAGE_B(FG_SB(0, 1), cB + hstepB); FG_STAGE_A(FG_SA(0, 0), false, 0, 0); FG_STAGE_A(FG_SA(0, 1), false, 1, 0);
  if (wr == 1) FG_BAR;
  FG_WAIT_V(2); FG_BAR;
  FG_STAGE_B(FG_SB(1, 0), cB + kstep); FG_STAGE_A(FG_SA(1, 0), false, 0, kstep); FG_STAGE_B(FG_SB(1, 1), cB + hstepB + kstep);
  FG_WAIT_V(6); FG_BAR;
  for (;;) {
    const bool has_next = S.next(ui + 1, nxt);
    nA = has_next ? nxt.A : cA; nB = has_next ? nxt.B : cB;
    if constexpr (GATHER) {
      if (has_next) {
        const LAS int* rw = S.rows(ui + 1);
#pragma unroll
        for (int h = 0; h < 2; ++h)
#pragma unroll
          for (int i = 0; i < 2; ++i) gn[h][i] = (unsigned)(rw[h * HALF + sR[i]] * lda + sC[i]) * 2u;
      } else {
#pragma unroll
        for (int h = 0; h < 2; ++h)
#pragma unroll
          for (int i = 0; i < 2; ++i) gn[h][i] = gc[h][i];
      }
      FG_WAIT_L(0);
    }
    for (int t = 0; t < nt; t += 2) {
      const bool last = (t == nt - 2);
      const size_t k1 = (size_t)(t + 1) * kstep;
      const size_t k2 = last ? 0 : (size_t)(t + 2) * kstep, k3 = k2 + kstep;
      const char* b2 = last ? nB : cB + (size_t)(t + 2) * kstep; const char* b3 = b2 + kstep;
      FG_LDB(B0, 0, 0); FG_LDB(B1, 0, 1); FG_SCHED; FG_LDA(At, 0, 0); FG_STAGE_A(FG_SA(1, 1), false, 1, k1);
      FG_WAIT_V(8); FG_WAIT_L(0); FG_BAR; FG_MMA(0, 0, At, B0); FG_MMA(0, 1, At, B1); FG_BAR; FG_SCHED;
      FG_LDA(At, 0, 1); FG_STAGE_B(FG_SB(0, 0), b2); FG_STAGE_B(FG_SB(0, 1), b2 + hstepB); FG_STAGE_A(FG_SA(0, 0), last, 0, k2);
      FG_WAIT_V(8); FG_WAIT_L(0); FG_BAR; FG_MMA(1, 0, At, B0); FG_MMA(1, 1, At, B1); FG_BAR; FG_SCHED;
      FG_LDB(B0, 1, 0); FG_LDB(B1, 1, 1); FG_SCHED; FG_LDA(At, 1, 0); FG_STAGE_A(FG_SA(0, 1), last, 1, k2);
      FG_WAIT_V(8); FG_WAIT_L(0); FG_BAR; FG_MMA(0, 0, At, B0); FG_MMA(0, 1, At, B1); FG_BAR; FG_SCHED;
      FG_LDA(At, 1, 1); FG_STAGE_B(FG_SB(1, 0), b3); FG_STAGE_B(FG_SB(1, 1), b3 + hstepB); FG_STAGE_A(FG_SA(1, 0), last, 0, k3);
      FG_WAIT_V(8); FG_WAIT_L(0); FG_BAR; FG_MMA(1, 0, At, B0); FG_MMA(1, 1, At, B1); FG_BAR; FG_SCHED;
    }
    if (wr == 0) FG_BAR;
    E(acc, cur, wr, wc, fr, fq);
    if (!has_next) break;
#pragma unroll
    for (int a = 0; a < 2; ++a)
#pragma unroll
      for (int b = 0; b < 2; ++b)
#pragma unroll
        for (int m = 0; m < 4; ++m)
#pragma unroll
          for (int n = 0; n < 2; ++n) acc[a][b][m][n] = (f32x4){0.f, 0.f, 0.f, 0.f};
    cur = nxt; cA = nA; cB = nB; ++ui;
    if constexpr (GATHER) {
#pragma unroll
      for (int h = 0; h < 2; ++h)
#pragma unroll
        for (int i = 0; i < 2; ++i) gc[h][i] = gn[h][i];
    }
    if (wr == 1) FG_BAR;
  }
  FG_WAIT_V(0);
  FG_BAR;
#undef FG_SA
#undef FG_SB
#undef FG_GLDS
#undef FG_STAGE_A
#undef FG_STAGE_B
#undef FG_LDA
#undef FG_LDB
#undef FG_MMA
#undef FG_WAIT_V
#undef FG_WAIT_L
#undef FG_BAR
#undef FG_SCHED
}
DI int perm32f8(int s_) { return 16 * ((s_ >> 2) & 1) + (s_ & 3) + 4 * (s_ >> 3); }
template <bool GATHER, bool PERM = false, class Epi, class Sched>
DI void gemm_phase_f8(LAS unsigned char* lds, const int K, const int lda, const int ldb, const Sched& S, const Epi& E) {
  const int tid = otid(), wid = __builtin_amdgcn_readfirstlane(tid >> 6), lane = tid & 63, wr = wid >> 2, wc = wid & 3, fr = lane & 15, fq = lane >> 4;
  const int nt = K / BK;
  unsigned voffA[2], voffB[2]; int sR[2], sC[2];
#pragma unroll
  for (int i = 0; i < 2; ++i) { int R, C; stage_rc(tid * 16 + i * 8192, R, C); sR[i] = R; sC[i] = C; voffA[i] = (unsigned)(R * lda + C) * 2u; const int Rb = PERM ? ((R & ~31) + perm32f8(R & 31)) : R; voffB[i] = (unsigned)(Rb * ldb + C) * 2u; }
  const size_t kstep = (size_t)(BK * 2), hstepA = (size_t)HALF * lda * 2, hstepB = (size_t)HALF * ldb * 2;
  const unsigned ldsw = (unsigned)wid * 1024u;
  const int r32 = lane & 31, g32 = lane >> 5;
  const int aoff = lds_byte(wr * 64 + r32, 16 * g32), boff = lds_byte(wc * 32 + r32, 16 * g32);
#define FG_SA(b, h) (((b) * 2 + (h)) * HTB)
#define FG_SB(b, h) ((4 + (b) * 2 + (h)) * HTB)
#define FG_GLDS(gp, bufoff, i_) __builtin_amdgcn_global_load_lds((const unsigned*)(gp), (LAS unsigned*)(lds + (bufoff) + ldsw + (i_) * 8192), 16, 0, 0)
#define FG_STAGE_B(bufoff, gbase) do { const char* _gb = (gbase); FG_GLDS(_gb + voffB[0], bufoff, 0); FG_GLDS(_gb + voffB[1], bufoff, 1); } while (0)
#define FG_STAGE_A(bufoff, NX, H, KB) do { \
    if constexpr (GATHER) { const char* _gb = ((NX) ? nA : cA) + (KB); FG_GLDS(_gb + ((NX) ? gn[H][0] : gc[H][0]), bufoff, 0); FG_GLDS(_gb + ((NX) ? gn[H][1] : gc[H][1]), bufoff, 1); } \
    else { const char* _gb = ((NX) ? nA : cA) + (size_t)(H) * hstepA + (KB); FG_GLDS(_gb + voffA[0], bufoff, 0); FG_GLDS(_gb + voffA[1], bufoff, 1); } } while (0)
#define FG_LDA(dst, b, h) do { _Pragma("unroll") for (int m = 0; m < 2; ++m) _Pragma("unroll") for (int k = 0; k < 2; ++k) { const LAS v4i_t* q_ = (const LAS v4i_t*)(lds + FG_SA(b, h) + aoff + m * 4096 + k * 1024); dst[m][k] = __builtin_shufflevector(q_[0], q_[1], 0, 1, 2, 3, 4, 5, 6, 7); } } while (0)
#define FG_LDB(dst, b, h) do { _Pragma("unroll") for (int k = 0; k < 2; ++k) { const LAS v4i_t* q_ = (const LAS v4i_t*)(lds + FG_SB(b, h) + boff + k * 1024); dst[k] = __builtin_shufflevector(q_[0], q_[1], 0, 1, 2, 3, 4, 5, 6, 7); } } while (0)
#define FG_MMA(ai, bj, At, Bt) do { __builtin_amdgcn_s_setprio(1); _Pragma("unroll") for (int m = 0; m < 2; ++m) _Pragma("unroll") for (int k = 0; k < 2; ++k) \
    acc[ai][bj][m] = __builtin_amdgcn_mfma_scale_f32_32x32x64_f8f6f4(Bt[k], At[m][k], acc[ai][bj][m], 0, 0, 0, 0x7f7f7f7f, 0, 0x7f7f7f7f); __builtin_amdgcn_s_setprio(0); } while (0)
#define FG_WAIT_V(n) asm volatile("s_waitcnt vmcnt(" #n ")" ::: "memory")
#define FG_WAIT_L(n) asm volatile("s_waitcnt lgkmcnt(" #n ")" ::: "memory")
#define FG_BAR __builtin_amdgcn_s_barrier()
#define FG_SCHED __builtin_amdgcn_sched_barrier(0)
  Unit cur, nxt; int ui = 0;
  if (!S.next(0, cur)) return;
  f32x16 acc[2][2][2];
#pragma unroll
  for (int a = 0; a < 2; ++a)
#pragma unroll
    for (int b = 0; b < 2; ++b)
#pragma unroll
      for (int m = 0; m < 2; ++m)
#pragma unroll
        for (int n = 0; n < 16; ++n) acc[a][b][m][n] = 0.f;
  v8i_t At[2][2], B0[2], B1[2];
  const char* cA = cur.A; const char* cB = cur.B;
  const char* nA = cA; const char* nB = cB;
  unsigned gc[2][2] = {{0u, 0u}, {0u, 0u}}, gn[2][2] = {{0u, 0u}, {0u, 0u}};
  if constexpr (GATHER) {
    const LAS int* rw = S.rows(0);
#pragma unroll
    for (int h = 0; h < 2; ++h)
#pragma unroll
      for (int i = 0; i < 2; ++i) { gc[h][i] = (unsigned)(rw[h * HALF + sR[i]] * lda + sC[i]) * 2u; gn[h][i] = gc[h][i]; }
  }
  FG_STAGE_B(FG_SB(0, 0), cB); FG_STAGE_B(FG_SB(0, 1), cB + hstepB); FG_STAGE_A(FG_SA(0, 0), false, 0, 0); FG_STAGE_A(FG_SA(0, 1), false, 1, 0);
  if (wr == 1) FG_BAR;
  FG_WAIT_V(2); FG_BAR;
  FG_STAGE_B(FG_SB(1, 0), cB + kstep); FG_STAGE_A(FG_SA(1, 0), false, 0, kstep); FG_STAGE_B(FG_SB(1, 1), cB + hstepB + kstep);
  FG_WAIT_V(6); FG_BAR;
  for (;;) {
    const bool has_next = S.next(ui + 1, nxt);
    nA = has_next ? nxt.A : cA; nB = has_next ? nxt.B : cB;
    if constexpr (GATHER) {
      if (has_next) {
        const LAS int* rw = S.rows(ui + 1);
#pragma unroll
        for (int h = 0; h < 2; ++h)
#pragma unroll
          for (int i = 0; i < 2; ++i) gn[h][i] = (unsigned)(rw[h * HALF + sR[i]] * lda + sC[i]) * 2u;
      } else {
#pragma unroll
        for (int h = 0; h < 2; ++h)
#pragma unroll
          for (int i = 0; i < 2; ++i) gn[h][i] = gc[h][i];
      }
      FG_WAIT_L(0);
    }
#pragma nounroll
    for (int t = 0; t < nt; t += 2) {
      const bool last = (t == nt - 2);
      const size_t k1 = (size_t)(t + 1) * kstep;
      const size_t k2 = last ? 0 : (size_t)(t + 2) * kstep, k3 = k2 + kstep;
      const char* b2 = last ? nB : cB + (size_t)(t + 2) * kstep; const char* b3 = b2 + kstep;
      FG_LDB(B0, 0, 0); FG_LDB(B1, 0, 1); FG_SCHED; FG_LDA(At, 0, 0); FG_STAGE_A(FG_SA(1, 1), false, 1, k1);
      FG_WAIT_V(8); FG_WAIT_L(0); FG_BAR; FG_MMA(0, 0, At, B0); FG_MMA(0, 1, At, B1); FG_BAR; FG_SCHED;
      FG_LDA(At, 0, 1); FG_STAGE_B(FG_SB(0, 0), b2); FG_STAGE_B(FG_SB(0, 1), b2 + hstepB); FG_STAGE_A(FG_SA(0, 0), last, 0, k2);
      FG_WAIT_V(8); FG_WAIT_L(0); FG_BAR; FG_MMA(1, 0, At, B0); FG_MMA(1, 1, At, B1); FG_BAR; FG_SCHED;
      FG_LDB(B0, 1, 0); FG_LDB(B1, 1, 1); FG_SCHED; FG_LDA(At, 1, 0); FG_STAGE_A(FG_SA(0, 1), last, 1, k2);
      FG_WAIT_V(8); FG_WAIT_L(0); FG_BAR; FG_MMA(0, 0, At, B0); FG_MMA(0, 1, At, B1); FG_BAR; FG_SCHED;
      FG_LDA(At, 1, 1); FG_STAGE_B(FG_SB(1, 0), b3); FG_STAGE_B(FG_SB(1, 1), b3 + hstepB); FG_STAGE_A(FG_SA(1, 0), last, 0, k3);
      FG_WAIT_V(8); FG_WAIT_L(0); FG_BAR; FG_MMA(1, 0, At, B0); FG_MMA(1, 1, At, B1); FG_BAR; FG_SCHED;
    }
    if (wr == 0) FG_BAR;
    E(acc, cur, wr, wc, r32, g32);
    if (!has_next) break;
#pragma unroll
    for (int a = 0; a < 2; ++a)
#pragma unroll
      for (int b = 0; b < 2; ++b)
#pragma unroll
        for (int m = 0; m < 2; ++m)
#pragma unroll
          for (int n = 0; n < 16; ++n) acc[a][b][m][n] = 0.f;
    cur = nxt; cA = nA; cB = nB; ++ui;
    if constexpr (GATHER) {
#pragma unroll
      for (int h = 0; h < 2; ++h)
#pragma unroll
        for (int i = 0; i < 2; ++i) gc[h][i] = gn[h][i];
    }
    if (wr == 1) FG_BAR;
  }
  FG_WAIT_V(0);
  FG_BAR;
#undef FG_SA
#undef FG_SB
#undef FG_GLDS
#undef FG_STAGE_A
#undef FG_STAGE_B
#undef FG_LDA
#undef FG_LDB
#undef FG_MMA
#undef FG_WAIT_V
#undef FG_WAIT_L
#undef FG_BAR
#undef FG_SCHED
}
}

DI void cvt_tile(char* smem, const float* src, int ld, bf16_t* dst, int K, int N, int item, int dld, int f8) {
  float* tile = (float*)smem;
  const int ntn = N >> 6, kt = item / ntn, nt = item % ntn, k0 = kt * 64, n0 = nt * 64, tid = otid();
  __syncthreads();
#pragma unroll
  for (int i = 0; i < 8; ++i) { const int idx = tid + i * NTH, r = idx >> 6, c = idx & 63; tile[r * 65 + c] = src[(size_t)(k0 + r) * ld + n0 + c]; }
  __syncthreads();
  const int n = tid >> 3, k8 = (tid & 7) * 8;
  if (f8) {
    u32x2 o8;
    o8.x = pk4_fp8(tile[(k8 + 0) * 65 + n] * 32.f, tile[(k8 + 1) * 65 + n] * 32.f, tile[(k8 + 2) * 65 + n] * 32.f, tile[(k8 + 3) * 65 + n] * 32.f);
    o8.y = pk4_fp8(tile[(k8 + 4) * 65 + n] * 32.f, tile[(k8 + 5) * 65 + n] * 32.f, tile[(k8 + 6) * 65 + n] * 32.f, tile[(k8 + 7) * 65 + n] * 32.f);
    *(u32x2*)((unsigned char*)dst + (size_t)(n0 + n) * dld + k0 + k8) = o8;
    return;
  }
  u32x4 o;
  o.x = pk2(tile[(k8 + 0) * 65 + n], tile[(k8 + 1) * 65 + n]);
  o.y = pk2(tile[(k8 + 2) * 65 + n], tile[(k8 + 3) * 65 + n]);
  o.z = pk2(tile[(k8 + 4) * 65 + n], tile[(k8 + 5) * 65 + n]);
  o.w = pk2(tile[(k8 + 6) * 65 + n], tile[(k8 + 7) * 65 + n]);
  *(u32x4*)(dst + (size_t)(n0 + n) * dld + k0 + k8) = o;
}
DI void phase_cvt_mix(KP p, char* smem) {
  char* const ws = ows(p);
  {
    bf16_t* wz = (bf16_t*)(ws + OFF_WMIX) + W_WA2;
    for (int i = obid() * NTH + otid(); i < 2 * 2048 * 8; i += gridDim.x * NTH) {
      const int row = i >> 3, c8 = i & 7, d = (row & 2047) >> 10;
      *(u32x4*)(wz + (size_t)row * 128 + (1 - d) * 64 + c8 * 8) = (u32x4){0u, 0u, 0u, 0u};
    }
  }
  for (int it = obid(); it < p->nitems; it += gridDim.x) {
    int j = 0;
    while (j + 1 < p->njobs && p->jobs[j + 1].item0 <= it) ++j;
    cvt_tile(smem, (const float*)(__attribute__((address_space(1))) const float*)p->jobs[j].src, p->jobs[j].ld, (bf16_t*)(__attribute__((address_space(1))) bf16_t*)p->jobs[j].dst, p->jobs[j].K, p->jobs[j].N, it - p->jobs[j].item0, p->jobs[j].dld, p->jobs[j].pad_);
  }
}
constexpr float O8_SCALE = 4.0f;
constexpr float X8_SCALE = 4.0f;
constexpr float W8_SCALE = 32.0f, A8_SCALE = 4.0f, WD8_SCALE = 16.0f;
DI int up_src_col(int np) {
  const int slab = np >> 5, pos = np & 31, q = pos & 15, hh = (q >> 2) & 1, i = (q & 3) + 4 * (q >> 3);
  return (pos >> 4) * 512 + slab * 16 + 8 * hh + i;
}
DI void phase_cvt_moe(KP p, int layer, char* smem) {
  char* const ws = ows(p);
  float* tile = (float*)smem;
  bf16_t* wm = (bf16_t*)(ws + OFF_WMOE);
  const int tid = otid();
  const int NUP = 32 * 256, NDN = 32 * 128;
  const int lr = tid >> 4, lc = (tid & 15) * 4;
  auto issue = [&](int it2, f32x4 (&d)[2]) __attribute__((always_inline)) {
    const float* src; int k0, col;
    if (it2 < NUP) {
      const int e = it2 >> 8, t = it2 & 255, kt = t >> 4, nt = t & 15;
      k0 = kt * 64; col = up_src_col(nt * 64 + lc);
      src = gin(p, 38) + ((size_t)(layer * 32 + e) * 1024) * 1024;
    } else {
      const int i2 = it2 - NUP, e = i2 >> 7, t = i2 & 127, kt = t >> 4, nt = t & 15;
      k0 = kt * 64; col = nt * 64 + lc;
      src = gin(p, 39) + ((size_t)(layer * 32 + e) * 512) * 1024;
    }
    d[0] = *(const f32x4*)(src + (size_t)(k0 + lr) * 1024 + col);
    d[1] = *(const f32x4*)(src + (size_t)(k0 + lr + 32) * 1024 + col);
  };
  f32x4 cur[2], nx[2];
  int it = obid();
  if (it < NUP + NDN) issue(it, cur);
  for (; it < NUP + NDN; it += gridDim.x) {
    const int nit = it + gridDim.x;
    if (nit < NUP + NDN) issue(nit, nx);
    __syncthreads();
#pragma unroll
    for (int i = 0; i < 2; ++i)
#pragma unroll
      for (int j = 0; j < 4; ++j) tile[(lr + 32 * i) * 65 + lc + j] = cur[i][j];
    __syncthreads();
    const int n = tid >> 3, k8 = (tid & 7) * 8;
    const float sc8 = it < NUP ? W8_SCALE : WD8_SCALE;
    u32x2 o;
    o.x = pk4_fp8(tile[(k8 + 0) * 65 + n] * sc8, tile[(k8 + 1) * 65 + n] * sc8, tile[(k8 + 2) * 65 + n] * sc8, tile[(k8 + 3) * 65 + n] * sc8);
    o.y = pk4_fp8(tile[(k8 + 4) * 65 + n] * sc8, tile[(k8 + 5) * 65 + n] * sc8, tile[(k8 + 6) * 65 + n] * sc8, tile[(k8 + 7) * 65 + n] * sc8);
    if (it < NUP) {
      const int e = it >> 8, t = it & 255, kt = t >> 4, nt = t & 15, k0 = kt * 64, n0 = nt * 64;
      *(u32x2*)((unsigned char*)wm + (size_t)e * 1024 * 1024 + (size_t)(n0 + n) * 1024 + k0 + k8) = o;
    } else {
      const int i2 = it - NUP, e = i2 >> 7, t = i2 & 127, kt = t >> 4, nt = t & 15, k0 = kt * 64, n0 = nt * 64;
      *(u32x2*)((unsigned char*)(wm + WMOE_DOWN) + (size_t)e * 1024 * 512 + (size_t)(n0 + n) * 512 + k0 + k8) = o;
    }
    cur[0] = nx[0]; cur[1] = nx[1];
  }
}

constexpr int MOD_LDS = 17 * 1024 * 4 + 8 * 17 * 64 * 4;
DI void phase_mod(KP p, char* smem) {
  char* const ws = ows(p);
  float* sc = (float*)smem;
  float* red = sc + 17 * 1024;
  const int tid = otid();
  for (int i = tid; i < 17 * 1024; i += NTH) {
    const int bi = i >> 10, k = i & 1023;
    const float v = bi < 16 ? gin(p, 1)[bi * 1024 + k] : gin(p, 3)[k];
    sc[i] = v / (1.0f + __expf(-v));
  }
  __syncthreads();
  const int col = tid & 63, ks = tid >> 6;
  for (int it = obid(); it < 4 * 96; it += gridDim.x) {
    const int l = it / 96, j = (it % 96) * 64 + col;
    const float* w = gin(p, 4) + (size_t)l * 1024 * 6144 + j;
    float acc[17];
#pragma unroll
    for (int b = 0; b < 17; ++b) acc[b] = 0.f;
    for (int k = ks * 128; k < ks * 128 + 128; ++k) {
      const float wv = w[(size_t)k * 6144];
#pragma unroll
      for (int b = 0; b < 17; ++b) acc[b] += sc[b * 1024 + k] * wv;
    }
    __syncthreads();
#pragma unroll
    for (int b = 0; b < 17; ++b) red[(ks * 17 + b) * 64 + col] = acc[b];
    __syncthreads();
    for (int o = tid; o < 17 * 64; o += NTH) {
      const int b = o >> 6, c = o & 63;
      float s = 0.f;
#pragma unroll
      for (int q = 0; q < 8; ++q) s += red[(q * 17 + b) * 64 + c];
      const int jj = (it % 96) * 64 + c;
      ((float*)(ws + OFF_MOD))[(size_t)(l * 17 + b) * 6144 + jj] = s + gin(p, 5)[l * 6144 + jj];
    }
  }
  {
    bf16_t* wr = (bf16_t*)(ws + OFF_WR);
    for (int i = obid() * NTH + tid; i < 4 * 48 * 1024; i += gridDim.x * NTH) {
      const int l = i / (48 * 1024), n = (i / 1024) % 48, k = i & 1023;
      float w = 0.f;
      if (n < 4) w = gin(p, 34)[((size_t)l * 1024 + k) * 4 + n];
      else if (n < 36) w = gin(p, 36)[((size_t)l * 1024 + k) * 32 + (n - 4)];
      const bf16_t hi = f2bf(w);
      wr[((size_t)(l * 2 + 0) * 48 + n) * 1024 + k] = hi;
      wr[((size_t)(l * 2 + 1) * 48 + n) * 1024 + k] = f2bf(w - bf2f(hi));
    }
  }
  if (obid() == 0) {
    float* rc = (float*)(ws + OFF_ROPE);
    for (int i = tid; i < 1024; i += NTH) {
      const int pos = i >> 4, f = i & 15;
      const float inv = powf(10000.0f, -(float)f / 16.0f);
      const float ang = (float)pos * inv;
      rc[i] = cosf(ang); rc[1024 + i] = sinf(ang);
    }
  }
}

DI void moe_blkstart(char* ws, int layer, int* bs  ) {
  if (otid() == 0) {
    const int* cnt = (const int*)(ws + OFF_CNT) + layer * 32;
    int s = 0;
    for (int e = 0; e < 32; ++e) { bs[e] = s; s += (cnt[e] + MOE_PAD - 1) / MOE_PAD; }
    bs[32] = s;
  }
  __syncthreads();
}
template <int MODE, bool DRY = false, bool OUT8 = false>
DI void phase_norm1(KP p, int layer, char* smem) {
  char* const ws = ows(p);
  int* bs = (int*)smem;
  if (MODE != 0) moe_blkstart(ws, MODE == 3 ? 3 : layer - 1, bs);
  const int lane = otid() & 63, wid = otid() >> 6;
  const int nrows = MODE == 3 ? TL : TT;
  const bf16_t* yb = (const bf16_t*)(ws + OFF_U + UM_YB);
  const int* tok = (const int*)(ws + OFF_TOK);
  bf16_t* hb = (bf16_t*)(ws + OFF_H);
  const int stride = gridDim.x * 8;
  for (int rA = obid() * 8 + wid; rA < nrows; rA += 2 * stride) {
    const int rB = rA + stride;
    const bool hasB = rB < nrows;
    const int rr[2] = {rA, hasB ? rB : rA};
    f32x4 v[2][4];
    int4 t0[2], t1[2];
#pragma unroll
    for (int k = 0; k < 2; ++k) {
      const int r = rr[k];
      if (MODE == 0) {
        const float* src = r < TL ? gin(p, 0) + (size_t)r * DM : gin(p, 2) + (size_t)(r - TL) * DM;
#pragma unroll
        for (int i = 0; i < 4; ++i) v[k][i] = *(const f32x4*)(src + (i * 64 + lane) * 4);
      } else {
        const bf16_t* xr = xrow_ptr(p, ws, r);
#pragma unroll
        for (int i = 0; i < 4; ++i) v[k][i] = ldbf4(xr + (i * 64 + lane) * 4);
        t0[k] = *(const int4*)(tok + (size_t)r * 8);
        t1[k] = *(const int4*)(tok + (size_t)r * 8 + 4);
      }
    }
    if (MODE == 1 || MODE == 3) {
      const int pl = MODE == 3 ? 3 : layer - 1;
      u32x2 ya[2][4], yc[2][4];
#pragma unroll
      for (int k = 0; k < 2; ++k) {
        const size_t d0 = (size_t)(bs[t0[k].x] * MOE_PAD + t0[k].y), d1 = (size_t)(bs[t0[k].z] * MOE_PAD + t0[k].w);
#pragma unroll
        for (int i = 0; i < 4; ++i) { const int ch = (i * 64 + lane) * 4; ya[k][i] = *(const u32x2*)(yb + d0 * DM + ch); yc[k][i] = *(const u32x2*)(yb + d1 * DM + ch); }
      }
#pragma unroll
      for (int k = 0; k < 2; ++k) {
        const float w0 = __int_as_float(t1[k].x), w1 = __int_as_float(t1[k].y);
        const float* g2 = modp(ws, pl, row_bi(rr[k]), 5);
#pragma unroll
        for (int i = 0; i < 4; ++i) {
          const int ch = (i * 64 + lane) * 4;
          const u32x2 a = ya[k][i], b = yc[k][i];
          const f32x4 g = *(const f32x4*)(g2 + ch);
          v[k][i][0] += g[0] * (w0 * bflo(a.x) + w1 * bflo(b.x));
          v[k][i][1] += g[1] * (w0 * bfhi(a.x) + w1 * bfhi(b.x));
          v[k][i][2] += g[2] * (w0 * bflo(a.y) + w1 * bflo(b.y));
          v[k][i][3] += g[3] * (w0 * bfhi(a.y) + w1 * bfhi(b.y));
        }
      }
    }
#pragma unroll
    for (int k = 0; k < 2; ++k) {
      if (k == 1 && !hasB) break;
      const int r = rr[k], bi = row_bi(r);
      bf16_t* xr = xrow_ptr(p, ws, r);
      if ((MODE == 0 || MODE == 1) && !DRY) {
#pragma unroll
        for (int i = 0; i < 4; ++i) stbf4(xr + (i * 64 + lane) * 4, v[k][i]);
      }
      float ss = 0.f;
#pragma unroll
      for (int i = 0; i < 4; ++i) ss += v[k][i][0] * v[k][i][0] + v[k][i][1] * v[k][i][1] + v[k][i][2] * v[k][i][2] + v[k][i][3] * v[k][i][3];
      ss = wave_sum(ss);
      const float rs = rsqrtf(ss * (1.0f / 1024.0f) + 1e-6f);
      if (MODE == 3) {
#pragma unroll
        for (int i = 0; i < 4; ++i) {
          const int ch = (i * 64 + lane) * 4;
          const f32x4 g = *(const f32x4*)(gin(p, 7) + ch);
          f32x4 o; o[0] = v[k][i][0] * rs * g[0]; o[1] = v[k][i][1] * rs * g[1]; o[2] = v[k][i][2] * rs * g[2]; o[3] = v[k][i][3] * rs * g[3];
          if (!DRY) *(f32x4*)(gout(p) + (size_t)r * DM + ch) = o; else asm volatile("" :: "v"(o[0]), "v"(o[1]), "v"(o[2]), "v"(o[3]));
        }
      } else {
        const float* gn = gin(p, 6) + (size_t)(layer * 2 + 0) * DM;
        const float* sh = modp(ws, layer, bi, 0);
        const float* sc = modp(ws, layer, bi, 1);
#pragma unroll
        for (int i = 0; i < 4; ++i) {
          const int ch = (i * 64 + lane) * 4;
          const f32x4 g = *(const f32x4*)(gn + ch), s1 = *(const f32x4*)(sc + ch), s0 = *(const f32x4*)(sh + ch);
          float o[4];
#pragma unroll
          for (int j = 0; j < 4; ++j) o[j] = v[k][i][j] * rs * g[j] * (1.0f + s1[j]) + s0[j];
          if constexpr (OUT8) {
            const unsigned w8 = pk4_fp8(o[0] * X8_SCALE, o[1] * X8_SCALE, o[2] * X8_SCALE, o[3] * X8_SCALE);
            if (!DRY) *(unsigned*)((unsigned char*)(ws + OFF_H8) + (size_t)r * DM + ch) = w8; else asm volatile("" :: "v"(w8));
          } else {
            u32x2 w; w.x = pk2(o[0], o[1]); w.y = pk2(o[2], o[3]);
            if (!DRY) *(u32x2*)(hb + (size_t)r * DM + ch) = w; else asm volatile("" :: "v"(w.x), "v"(w.y));
          }
        }
      }
    }
  }
}

constexpr int R2_TLD = 1032;
constexpr int R2_LLD = 49;
constexpr int R2_LDS = 64 * R2_TLD * 2 + 64 * R2_LLD * 4;
template <bool DRY = false>
DI void phase_norm2_router(KP p, int layer, char* smem) {
  char* const ws = ows(p);
  const int tid = otid(), lane = tid & 63, wid = tid >> 6, fr = lane & 15, fq = lane >> 4;
  bf16_t* tile = (bf16_t*)smem;
  float* lgt = (float*)(smem + 64 * R2_TLD * 2);
  const int nrows = layer == 3 ? TL : TT;
  unsigned char* h8 = (unsigned char*)(ws + OFF_H8);
  int* tok = (int*)(ws + OFF_TOK);
  int* rowl = (int*)(ws + OFF_ROWL);
  int* cnt = (int*)(ws + OFF_CNT) + layer * 32;
  const float* bg = gin(p, 35) + layer * 4;
  const float* be = gin(p, 37) + layer * 32;
  const float* gn = gin(p, 6) + (size_t)(layer * 2 + 1) * DM;
  const bf16_t* wrh = (const bf16_t*)(ws + OFF_WR) + (size_t)layer * 2 * 48 * 1024;
  const bf16_t* wrl = wrh + 48 * 1024;
  bf16x8 bh[4][3], bl[4][3];
#pragma unroll
  for (int ks = 0; ks < 4; ++ks)
#pragma unroll
    for (int nt = 0; nt < 3; ++nt) {
      const size_t o = (size_t)(nt * 16 + fr) * 1024 + wid * 128 + ks * 32 + fq * 8;
      bh[ks][nt] = *(const bf16x8*)(wrh + o); bl[ks][nt] = *(const bf16x8*)(wrl + o);
    }
  for (int rbase = obid() * 64; rbase < nrows; rbase += gridDim.x * 64) {
    const int bi = row_bi(rbase);
    const float* sh = modp(ws, layer, bi, 3);
    const float* sc = modp(ws, layer, bi, 4);
    f32x4 gs[4], s0[4];
#pragma unroll
    for (int i = 0; i < 4; ++i) {
      const int ch = (i * 64 + lane) * 4;
      const f32x4 g = *(const f32x4*)(gn + ch), s1 = *(const f32x4*)(sc + ch);
      gs[i] = g * (1.0f + s1); s0[i] = *(const f32x4*)(sh + ch);
    }
#pragma unroll 2
    for (int q = 0; q < 8; ++q) {
      const int lr = wid * 8 + q, r = rbase + lr;
      const bf16_t* xr = xrow_ptr(p, ws, r);
      f32x4 v[4];
      float ss = 0.f;
#pragma unroll
      for (int i = 0; i < 4; ++i) { v[i] = ldbf4(xr + (i * 64 + lane) * 4); ss += v[i][0] * v[i][0] + v[i][1] * v[i][1] + v[i][2] * v[i][2] + v[i][3] * v[i][3]; }
      ss = wave_sum(ss);
      const float rs = rsqrtf(ss * (1.0f / 1024.0f) + 1e-6f);
#pragma unroll
      for (int i = 0; i < 4; ++i) {
        const int ch = (i * 64 + lane) * 4;
        const f32x4 o = v[i] * rs * gs[i] + s0[i];
        u32x2 w; w.x = pk2(o[0], o[1]); w.y = pk2(o[2], o[3]);
        *(unsigned*)(h8 + (size_t)r * DM + ch) = pk4_fp8(o[0], o[1], o[2], o[3]);
        *(u32x2*)(tile + lr * R2_TLD + ch) = w;
      }
    }
    __syncthreads();
    {
      f32x4 acc[4][3];
#pragma unroll
      for (int rt = 0; rt < 4; ++rt)
#pragma unroll
        for (int nt = 0; nt < 3; ++nt) acc[rt][nt] = (f32x4){0.f, 0.f, 0.f, 0.f};
#pragma unroll
      for (int ks = 0; ks < 4; ++ks)
#pragma unroll
        for (int rt = 0; rt < 4; ++rt) {
          const bf16x8 a = *(const bf16x8*)(tile + (rt * 16 + fr) * R2_TLD + wid * 128 + ks * 32 + fq * 8);
#pragma unroll
          for (int nt = 0; nt < 3; ++nt) { acc[rt][nt] = MFMA16(a, bh[ks][nt], acc[rt][nt]); acc[rt][nt] = MFMA16(a, bl[ks][nt], acc[rt][nt]); }
        }
      __syncthreads();
      float* part = (float*)smem + wid * 64 * R2_LLD;
#pragma unroll
      for (int rt = 0; rt < 4; ++rt)
#pragma unroll
        for (int nt = 0; nt < 3; ++nt)
#pragma unroll
          for (int j = 0; j < 4; ++j) part[(rt * 16 + fq * 4 + j) * R2_LLD + nt * 16 + fr] = acc[rt][nt][j];
    }
    __syncthreads();
    for (int i = tid; i < 64 * 36; i += NTH) {
      const int row = i / 36, col = i - row * 36;
      const float* pp = (const float*)smem + row * R2_LLD + col;
      float sacc = 0.f;
#pragma unroll
      for (int w = 0; w < 8; ++w) sacc += pp[w * 64 * R2_LLD];
      lgt[row * R2_LLD + col] = sacc;
    }
    __syncthreads();
    if (wid == 0) {
      const int r = rbase + lane;
      float* lr_ = lgt + lane * R2_LLD;
      float lg[4];
#pragma unroll
      for (int q = 0; q < 4; ++q) lg[q] = lr_[q] + bg[q];
      int gsel = 0; float gm = lg[0];
#pragma unroll
      for (int q = 1; q < 4; ++q) if (lg[q] > gm) { gm = lg[q]; gsel = q; }
      float gden = 0.f;
#pragma unroll
      for (int q = 0; q < 4; ++q) gden += __expf(lg[q] - gm);
      const float pgrp = 1.0f / gden;
      float le[8];
#pragma unroll
      for (int q = 0; q < 8; ++q) le[q] = lr_[4 + gsel * 8 + q] + be[gsel * 8 + q];
      int i0 = 0; float m0 = le[0];
#pragma unroll
      for (int q = 1; q < 8; ++q) if (le[q] > m0) { m0 = le[q]; i0 = q; }
      int i1 = -1; float m1 = -3.0e38f;
#pragma unroll
      for (int q = 0; q < 8; ++q) if (q != i0 && le[q] > m1) { m1 = le[q]; i1 = q; }
      const float e1 = __expf(m1 - m0);
      const float w0 = pgrp / (1.0f + e1), w1 = pgrp * e1 / (1.0f + e1);
      if (DRY) asm volatile("" :: "v"(w0), "v"(w1), "v"(i0), "v"(i1), "v"(gsel));
      if (!DRY) {
        const int ea = gsel * 8 + i0, eb = gsel * 8 + i1;
        const int pa = atomicAdd(&cnt[ea], 1), pb = atomicAdd(&cnt[eb], 1);
        rowl[(size_t)ea * CAP + pa] = r; rowl[(size_t)eb * CAP + pb] = r;
        int4 t0; t0.x = ea; t0.y = pa; t0.z = eb; t0.w = pb;
        int4 t1; t1.x = __float_as_int(w0); t1.y = __float_as_int(w1); t1.z = 0; t1.w = 0;
        *(int4*)(tok + (size_t)r * 8) = t0; *(int4*)(tok + (size_t)r * 8 + 4) = t1;
      }
    }
  }
}

DI void st_bf16x4(bf16_t* p, const f32x4& v) { u32x2 w; w.x = pk2(v[0], v[1]); w.y = pk2(v[2], v[3]); *(u32x2*)p = w; }
constexpr int FG_LDS = fg::STAGE_BYTES;
constexpr int MOE_UMAX = 12;

struct MoeSched {
  const char* A; const char* B; const LAS int* bs; const LAS int* rowtab; int G, c, ntile; size_t tA, eB, tB;
  DI bool next(int i, fg::Unit& u) const {
    const int rt = (G & 31) ? (i * G + c) >> 2 : i * (G >> 2) + (c & 7) * (G >> 5) + (c >> 5), ct = (G & 31) ? (i * G + c) & 3 : (c >> 3) & 3;
    if (rt >= ntile) return false;
    int e = 0;
#pragma unroll 1
    while (e < 31 && bs[e + 1] <= rt) ++e;
    u.pm = rt; u.pn = ct; u.aux = e; u.A = A + (size_t)rt * tA; u.B = B + (size_t)e * eB + (size_t)ct * tB; return true;
  }
  DI const LAS int* rows(int i) const { return rowtab + i * 256; }
};
DI void phase_moe_up(KP p, int layer, char* smem) {
  char* const ws = ows(p);
  LAS unsigned char* lds = (LAS unsigned char*)smem;
  LAS int* rowtab = (LAS int*)(lds + FG_LDS);
  int* bs = (int*)(smem + FG_LDS + MOE_UMAX * 1024);
  moe_blkstart(ws, layer, bs);
  const int* cnt = (const int*)(ws + OFF_CNT) + layer * 32;
  const int* rowl = (const int*)(ws + OFF_ROWL);
  unsigned char* act8 = (unsigned char*)(ws + OFF_U + UM_ACT);
  MoeSched S;
  S.A = ws + OFF_H8; S.B = ws + OFF_WMOE; S.bs = (const LAS int*)bs; S.rowtab = rowtab; S.G = gridDim.x; S.c = obid(); S.ntile = bs[32];
  S.tA = 0; S.eB = (size_t)1024 * 1024; S.tB = (size_t)256 * 1024;
  {
    const int tid = otid();
    fg::Unit u;
    for (int i = 0; i < MOE_UMAX && S.next(i, u); ++i) {
      if (tid < 256) {
        const int e = u.aux, pos = (u.pm - bs[e]) * 256 + tid;
        rowtab[i * 256 + tid] = pos < cnt[e] ? rowl[(size_t)e * CAP + pos] : TT;
      }
    }
    __syncthreads();
  }
  auto ep = [&](const f32x16 (&acc)[2][2][2], const fg::Unit& u, int wr, int wc, int r, int h) {
    constexpr float inv = 1.0f / W8_SCALE;
#pragma unroll
    for (int ai = 0; ai < 2; ++ai)
#pragma unroll
      for (int m = 0; m < 2; ++m) {
        const size_t row = (size_t)u.pm * 256 + ai * 128 + wr * 64 + m * 32 + r;
#pragma unroll
        for (int bj = 0; bj < 2; ++bj) {
          const int acol = ((u.pn * 256 + bj * 128 + wc * 32) >> 5) * 16 + 8 * h;
          float o[8];
#pragma unroll
          for (int i = 0; i < 8; ++i) { const float g = acc[ai][bj][m][i] * inv, uu = acc[ai][bj][m][i + 8] * inv; o[i] = g * __builtin_amdgcn_rcpf(1.0f + __expf(-g)) * uu; }
          u32x2 w8; w8.x = pk4_fp8(o[0] * A8_SCALE, o[1] * A8_SCALE, o[2] * A8_SCALE, o[3] * A8_SCALE); w8.y = pk4_fp8(o[4] * A8_SCALE, o[5] * A8_SCALE, o[6] * A8_SCALE, o[7] * A8_SCALE);
          *(u32x2*)(act8 + row * 512 + acol) = w8;
        }
      }
  };
  fg::gemm_phase_f8<true>(lds, 512, 512, 512, S, ep);
}
DI void phase_moe_down(KP p, int layer, char* smem) {
  char* const ws = ows(p);
  LAS unsigned char* lds = (LAS unsigned char*)smem;
  int* bs = (int*)(smem + FG_LDS + MOE_UMAX * 1024);
  moe_blkstart(ws, layer, bs);
  bf16_t* yb = (bf16_t*)(ws + OFF_U + UM_YB);
  MoeSched S;
  S.A = ws + OFF_U + UM_ACT; S.B = ws + OFF_WMOE + WMOE_DOWN * 2; S.bs = (const LAS int*)bs; S.rowtab = nullptr; S.G = gridDim.x; S.c = obid(); S.ntile = bs[32];
  S.tA = (size_t)256 * 512; S.eB = (size_t)1024 * 512; S.tB = (size_t)256 * 512;
  auto ep = [&](const f32x16 (&acc)[2][2][2], const fg::Unit& u, int wr, int wc, int r, int h) {
    constexpr float inv = 1.0f / (A8_SCALE * WD8_SCALE);
#pragma unroll
    for (int ai = 0; ai < 2; ++ai)
#pragma unroll
      for (int m = 0; m < 2; ++m) {
        const size_t row = (size_t)u.pm * 256 + ai * 128 + wr * 64 + m * 32 + r;
#pragma unroll
        for (int bj = 0; bj < 2; ++bj) {
          const f32x16& a = acc[ai][bj][m];
          u32x4 w0, w1;
          w0.x = pk2(a[0] * inv, a[1] * inv); w0.y = pk2(a[2] * inv, a[3] * inv); w0.z = pk2(a[4] * inv, a[5] * inv); w0.w = pk2(a[6] * inv, a[7] * inv);
          w1.x = pk2(a[8] * inv, a[9] * inv); w1.y = pk2(a[10] * inv, a[11] * inv); w1.z = pk2(a[12] * inv, a[13] * inv); w1.w = pk2(a[14] * inv, a[15] * inv);
          bf16_t* q = yb + row * DM + u.pn * 256 + bj * 128 + wc * 32 + 16 * h;
          *(u32x4*)q = w0; *(u32x4*)(q + 8) = w1;
        }
      }
  };
  fg::gemm_phase_f8<false, true>(lds, 256, 256, 256, S, ep);
}

template <int NKC>
DI void phase_qkv(KP p, const bf16_t* Wt, bf16_t* Q, bf16_t* Kb, bf16_t* Vb, char* smem) {
  char* const ws = ows(p);
  LAS unsigned char* lds = (LAS unsigned char*)smem;
  constexpr int N = 1024 + 2 * NKC;
  const float* rc = (const float*)(ws + OFF_ROPE);
  fg::DenseSched S;
  S.A = ws + OFF_H; S.B = (const char*)Wt; S.nM = TT / 256; S.nN = N / 256; S.G = gridDim.x; S.c = obid(); S.tA = (size_t)256 * 1024 * 2; S.tB = (size_t)256 * 1024 * 2;
  auto ep = [&](const f32x4 (&acc)[2][2][4][2], const fg::Unit& u, int wr, int wc, int fr, int fq) {
#pragma unroll
    for (int bj = 0; bj < 2; ++bj) {
      const int colb = u.pn * 256 + bj * 128 + wc * 32;
      if (colb < 1024 + NKC) {
        const bool isq = colb < 1024;
        bf16_t* dst = isq ? Q : Kb;
        const int ldd = isq ? 1024 : NKC, cc2 = (isq ? colb : colb - 1024) + 8 * fq;
        const float qs = isq ? 0.125f : 1.0f;
#pragma unroll
        for (int ai = 0; ai < 2; ++ai)
#pragma unroll
          for (int m = 0; m < 4; ++m) {
            const int row = u.pm * 256 + ai * 128 + wr * 64 + m * 16 + fr;
            f32x4 x0 = acc[ai][bj][m][0], x1 = acc[ai][bj][m][1];
            if (row < TL) {
              const int s = row & 4095, idx = (colb & 32) ? (s & 63) : (s >> 6);
              const f32x4 c = *(const f32x4*)(rc + idx * 16 + 4 * fq), sn = *(const f32x4*)(rc + 1024 + idx * 16 + 4 * fq);
              const f32x4 o0 = x0 * c - x1 * sn, o1 = x1 * c + x0 * sn;
              x0 = o0; x1 = o1;
            }
            const f32x4 y0 = x0 * qs, y1 = x1 * qs;
            if (NKC == 1024 && !isq) {
              u32x2 w8; w8.x = pk4_fp8(y0[0], y0[1], y0[2], y0[3]); w8.y = pk4_fp8(y1[0], y1[1], y1[2], y1[3]);
              *(u32x2*)((unsigned char*)Kb + (size_t)row * 1024 + cc2) = w8;
            } else {
              u32x4 w; w.x = pk2(y0[0], y0[1]); w.y = pk2(y0[2], y0[3]); w.z = pk2(y1[0], y1[1]); w.w = pk2(y1[2], y1[3]);
              *(u32x4*)(dst + (size_t)row * ldd + cc2) = w;
            }
          }
      } else {
        const int cv = colb - (1024 + NKC) + 4 * fq;
        if constexpr (NKC == 1024) {
          unsigned char* Vt = (unsigned char*)Vb;
          const int tq = fr & 3;
#pragma unroll
          for (int ai = 0; ai < 2; ++ai)
#pragma unroll
            for (int m = 0; m < 4; ++m) {
              const int row = u.pm * 256 + ai * 128 + wr * 64 + m * 16 + fr, rowq = row & ~3;
              size_t base; int kq;
              if (rowq < TL) { const int b = rowq >> 12, s0 = rowq & 4095; base = (size_t)b * 1024 * 4096 + (size_t)(s0 >> 6) * 64; kq = (s0 & 63) >> 2; }
              else { const int rc2 = rowq - TL, b = rc2 >> 8, c0 = rc2 & 255; base = (size_t)16 * 1024 * 4096 + (size_t)b * 1024 * 256 + (size_t)(c0 >> 6) * 64; kq = (c0 & 63) >> 2; }
              const size_t rstride = rowq < TL ? 4096 : 256;
              const int pos = 32 * (kq & 1) + 16 * (kq >> 3) + 4 * ((kq >> 1) & 3);
#pragma unroll
              for (int n = 0; n < 2; ++n) {
                const f32x4 a = acc[ai][bj][m][n];
                const int d = (int)pk4_fp8(a[0], a[1], a[2], a[3]);
                const int d0 = __builtin_amdgcn_update_dpp(0, d, 0x00, 0xF, 0xF, true), d1 = __builtin_amdgcn_update_dpp(0, d, 0x55, 0xF, 0xF, true);
                const int d2 = __builtin_amdgcn_update_dpp(0, d, 0xAA, 0xF, 0xF, true), d3 = __builtin_amdgcn_update_dpp(0, d, 0xFF, 0xF, 0xF, true);
                const int sh = 8 * tq;
                const unsigned w = ((unsigned)(d0 >> sh) & 0xffu) | (((unsigned)(d1 >> sh) & 0xffu) << 8) | (((unsigned)(d2 >> sh) & 0xffu) << 16) | (((unsigned)(d3 >> sh) & 0xffu) << 24);
                *(unsigned*)(Vt + base + (size_t)(cv + 16 * n + tq) * rstride + pos) = w;
              }
            }
        } else {
#pragma unroll
          for (int ai = 0; ai < 2; ++ai)
#pragma unroll
            for (int m = 0; m < 4; ++m) {
              const int row = u.pm * 256 + ai * 128 + wr * 64 + m * 16 + fr;
              st_bf16x4(Vb + (size_t)row * NKC + cv, acc[ai][bj][m][0]);
              st_bf16x4(Vb + (size_t)row * NKC + cv + 16, acc[ai][bj][m][1]);
            }
        }
      }
    }
  };
  fg::gemm_phase<false>(lds, 1024, 1024, 1024, S, ep);
}

DI void phase_qkv_diff8(KP p, char* smem) {
  char* const ws = ows(p);
  LAS unsigned char* lds = (LAS unsigned char*)smem;
  const float* rc = (const float*)(ws + OFF_ROPE);
  bf16_t* Q = (bf16_t*)(ws + OFF_U + U1_Q);
  unsigned char* K8 = (unsigned char*)(ws + OFF_U + U1_K);
  unsigned char* Vt = (unsigned char*)(ws + OFF_U + U1_V);
  fg::DenseSched S;
  S.A = ws + OFF_H8; S.B = ws + OFF_WMIX + W_DIFFQKV * 2; S.nM = TT / 256; S.nN = 12; S.G = gridDim.x; S.c = obid(); S.tA = (size_t)256 * 1024; S.tB = (size_t)256 * 1024;
  auto ep = [&](const f32x16 (&acc)[2][2][2], const fg::Unit& u, int wr, int wc, int r, int h) {
    constexpr float inv = 1.0f / (X8_SCALE * 32.0f);
#pragma unroll
    for (int bj = 0; bj < 2; ++bj) {
      const int colb = u.pn * 256 + bj * 128 + wc * 32;
      if (colb < 2048) {
        const bool isq = colb < 1024;
        const float qs = (isq ? 0.125f : 1.0f) * inv;
#pragma unroll
        for (int ai = 0; ai < 2; ++ai)
#pragma unroll
          for (int m = 0; m < 2; ++m) {
            const int row = u.pm * 256 + ai * 128 + wr * 64 + m * 32 + r;
            const f32x16& a = acc[ai][bj][m];
            float y[16];
            if (row < TL) {
              const int s = row & 4095, idx = (colb & 32) ? (s & 63) : (s >> 6);
              const f32x4 c0 = *(const f32x4*)(rc + idx * 16 + 4 * h), c1 = *(const f32x4*)(rc + idx * 16 + 8 + 4 * h);
              const f32x4 s0 = *(const f32x4*)(rc + 1024 + idx * 16 + 4 * h), s1 = *(const f32x4*)(rc + 1024 + idx * 16 + 8 + 4 * h);
#pragma unroll
              for (int i = 0; i < 8; ++i) {
                const float cc = i < 4 ? c0[i & 3] : c1[i & 3], sn = i < 4 ? s0[i & 3] : s1[i & 3];
                y[i] = (a[i] * cc - a[i + 8] * sn) * qs; y[i + 8] = (a[i + 8] * cc + a[i] * sn) * qs;
              }
            } else {
#pragma unroll
              for (int i = 0; i < 16; ++i) y[i] = a[i] * qs;
            }
            if (isq) {
              u32x4 w0, w1;
              w0.x = pk2(y[0], y[1]); w0.y = pk2(y[2], y[3]); w0.z = pk2(y[4], y[5]); w0.w = pk2(y[6], y[7]);
              w1.x = pk2(y[8], y[9]); w1.y = pk2(y[10], y[11]); w1.z = pk2(y[12], y[13]); w1.w = pk2(y[14], y[15]);
              bf16_t* q = Q + (size_t)row * 1024 + colb + 16 * h;
              *(u32x4*)q = w0; *(u32x4*)(q + 8) = w1;
            } else {
              u32x4 w8;
              w8.x = pk4_fp8(y[0], y[1], y[2], y[3]); w8.y = pk4_fp8(y[4], y[5], y[6], y[7]); w8.z = pk4_fp8(y[8], y[9], y[10], y[11]); w8.w = pk4_fp8(y[12], y[13], y[14], y[15]);
              *(u32x4*)(K8 + (size_t)row * 1024 + (colb - 1024) + 16 * h) = w8;
            }
          }
      } else {
        const int cv = colb - 2048 + 4 * h, tq = r & 3;
#pragma unroll
        for (int ai = 0; ai < 2; ++ai)
#pragma unroll
          for (int m = 0; m < 2; ++m) {
            const int row = u.pm * 256 + ai * 128 + wr * 64 + m * 32 + r, rowq = row & ~3;
            size_t base; int kq;
            if (rowq < TL) { const int b = rowq >> 12, s0 = rowq & 4095; base = (size_t)b * 1024 * 4096 + (size_t)(s0 >> 6) * 64; kq = (s0 & 63) >> 2; }
            else { const int rc2 = rowq - TL, b = rc2 >> 8, c0 = rc2 & 255; base = (size_t)16 * 1024 * 4096 + (size_t)b * 1024 * 256 + (size_t)(c0 >> 6) * 64; kq = (c0 & 63) >> 2; }
            const size_t rstride = rowq < TL ? 4096 : 256;
            const int pos = 32 * (kq & 1) + 16 * (kq >> 3) + 4 * ((kq >> 1) & 3);
            const f32x16& a = acc[ai][bj][m];
#pragma unroll
            for (int g = 0; g < 4; ++g) {
              const int d = (int)pk4_fp8(a[4 * g] * inv, a[4 * g + 1] * inv, a[4 * g + 2] * inv, a[4 * g + 3] * inv);
              const int d0 = __builtin_amdgcn_update_dpp(0, d, 0x00, 0xF, 0xF, true), d1 = __builtin_amdgcn_update_dpp(0, d, 0x55, 0xF, 0xF, true);
              const int d2 = __builtin_amdgcn_update_dpp(0, d, 0xAA, 0xF, 0xF, true), d3 = __builtin_amdgcn_update_dpp(0, d, 0xFF, 0xF, 0xF, true);
              const int sh = 8 * tq;
              const unsigned w = ((unsigned)(d0 >> sh) & 0xffu) | (((unsigned)(d1 >> sh) & 0xffu) << 8) | (((unsigned)(d2 >> sh) & 0xffu) << 16) | (((unsigned)(d3 >> sh) & 0xffu) << 24);
              *(unsigned*)(Vt + base + (size_t)(cv + 8 * g + tq) * rstride + pos) = w;
            }
          }
      }
    }
  };
  fg::gemm_phase_f8<false, false>(lds, 512, 512, 512, S, ep);
}

DI void phase_qkv_win8(KP p, char* smem) {
  char* const ws = ows(p);
  LAS unsigned char* lds = (LAS unsigned char*)smem;
  const float* rc = (const float*)(ws + OFF_ROPE);
  bf16_t* Q = (bf16_t*)(ws + OFF_U + U0_Q);
  bf16_t* Kb = (bf16_t*)(ws + OFF_U + U0_K);
  bf16_t* Vb = (bf16_t*)(ws + OFF_U + U0_V);
  fg::DenseSched S;
  S.A = ws + OFF_H8; S.B = ws + OFF_WMIX + W_WINQKV * 2; S.nM = TT / 256; S.nN = 6; S.G = gridDim.x; S.c = obid(); S.tA = (size_t)256 * 1024; S.tB = (size_t)256 * 1024;
  auto ep = [&](const f32x16 (&acc)[2][2][2], const fg::Unit& u, int wr, int wc, int r, int h) {
    constexpr float inv = 1.0f / (X8_SCALE * 32.0f);
#pragma unroll
    for (int bj = 0; bj < 2; ++bj) {
      const int colb = u.pn * 256 + bj * 128 + wc * 32;
      if (colb < 1280) {
        const bool isq = colb < 1024;
        const float qs = (isq ? 0.125f : 1.0f) * inv;
        bf16_t* dst = isq ? Q + colb + 16 * h : Kb + (colb - 1024) + 16 * h;
        const int ldd = isq ? 1024 : 256;
#pragma unroll
        for (int ai = 0; ai < 2; ++ai)
#pragma unroll
          for (int m = 0; m < 2; ++m) {
            const int row = u.pm * 256 + ai * 128 + wr * 64 + m * 32 + r;
            const f32x16& a = acc[ai][bj][m];
            float y[16];
            if (row < TL) {
              const int s = row & 4095, idx = (colb & 32) ? (s & 63) : (s >> 6);
              const f32x4 c0 = *(const f32x4*)(rc + idx * 16 + 4 * h), c1 = *(const f32x4*)(rc + idx * 16 + 8 + 4 * h);
              const f32x4 s0 = *(const f32x4*)(rc + 1024 + idx * 16 + 4 * h), s1 = *(const f32x4*)(rc + 1024 + idx * 16 + 8 + 4 * h);
#pragma unroll
              for (int i = 0; i < 8; ++i) {
                const float cc = i < 4 ? c0[i & 3] : c1[i & 3], sn = i < 4 ? s0[i & 3] : s1[i & 3];
                y[i] = (a[i] * cc - a[i + 8] * sn) * qs; y[i + 8] = (a[i + 8] * cc + a[i] * sn) * qs;
              }
            } else {
#pragma unroll
              for (int i = 0; i < 16; ++i) y[i] = a[i] * qs;
            }
            u32x4 w0, w1;
            w0.x = pk2(y[0], y[1]); w0.y = pk2(y[2], y[3]); w0.z = pk2(y[4], y[5]); w0.w = pk2(y[6], y[7]);
            w1.x = pk2(y[8], y[9]); w1.y = pk2(y[10], y[11]); w1.z = pk2(y[12], y[13]); w1.w = pk2(y[14], y[15]);
            bf16_t* q = dst + (size_t)row * ldd;
            *(u32x4*)q = w0; *(u32x4*)(q + 8) = w1;
          }
      } else {
        const int cv = colb - 1280 + 4 * h;
#pragma unroll
        for (int ai = 0; ai < 2; ++ai)
#pragma unroll
          for (int m = 0; m < 2; ++m) {
            const int row = u.pm * 256 + ai * 128 + wr * 64 + m * 32 + r;
            const f32x16& a = acc[ai][bj][m];
#pragma unroll
            for (int g = 0; g < 4; ++g) {
              f32x4 v4; v4[0] = a[4 * g] * inv; v4[1] = a[4 * g + 1] * inv; v4[2] = a[4 * g + 2] * inv; v4[3] = a[4 * g + 3] * inv;
              st_bf16x4(Vb + (size_t)row * 256 + cv + 8 * g, v4);
            }
          }
      }
    }
  };
  fg::gemm_phase_f8<false, false>(lds, 512, 512, 512, S, ep);
}

template <bool DRY = false>
DI void phase_oproj(KP p, int layer, const bf16_t* A, const bf16_t* Wt, int nrows, char* smem) {
  char* const ws = ows(p);
  LAS unsigned char* lds = (LAS unsigned char*)smem;
  fg::DenseSched S;
  S.A = (const char*)A; S.B = (const char*)Wt; S.nM = nrows / 256; S.nN = 4; S.G = gridDim.x; S.c = obid(); S.tA = (size_t)256 * 1024 * 2; S.tB = (size_t)256 * 1024 * 2;
  auto ep = [&](const f32x4 (&acc)[2][2][4][2], const fg::Unit& u, int wr, int wc, int fr, int fq) {
    const int row0 = u.pm * 256 + wr * 64 + fr, colb = u.pn * 256 + wc * 32 + 4 * fq;
    const float* g1 = modp(ws, layer, row_bi(row0), 2) + colb;
    f32x4 g[2][2];
#pragma unroll
    for (int bj = 0; bj < 2; ++bj)
#pragma unroll
      for (int n = 0; n < 2; ++n) g[bj][n] = *(const f32x4*)(g1 + bj * 128 + n * 16);
    f32x4 xa[2][2], xb[2][2];
    bf16_t* xr = xrow_ptr(p, ws, row0) + colb;
#pragma unroll
    for (int bj = 0; bj < 2; ++bj)
#pragma unroll
      for (int n = 0; n < 2; ++n) xa[bj][n] = ldbf4(xr + bj * 128 + n * 16);
#pragma unroll
    for (int rr = 0; rr < 8; ++rr) {
      const int ai = rr >> 2, m = rr & 3;
      bf16_t* xn = xr;
      if (rr + 1 < 8) {
        xn = xrow_ptr(p, ws, row0 + ((rr + 1) >> 2) * 128 + ((rr + 1) & 3) * 16) + colb;
#pragma unroll
        for (int bj = 0; bj < 2; ++bj)
#pragma unroll
          for (int n = 0; n < 2; ++n) xb[bj][n] = ldbf4(xn + bj * 128 + n * 16);
      }
#pragma unroll
      for (int bj = 0; bj < 2; ++bj)
#pragma unroll
        for (int n = 0; n < 2; ++n) {
          const f32x4 x = xa[bj][n] + g[bj][n] * acc[ai][bj][m][n];
          if (!DRY) stbf4(xr + bj * 128 + n * 16, x); else asm volatile("" :: "v"(x[0]), "v"(x[1]), "v"(x[2]), "v"(x[3]));
        }
#pragma unroll
      for (int bj = 0; bj < 2; ++bj)
#pragma unroll
        for (int n = 0; n < 2; ++n) xa[bj][n] = xb[bj][n];
      xr = xn;
    }
  };
  fg::gemm_phase<false>(lds, 1024, 1024, 1024, S, ep);
}

template <bool DRY = false>
DI void phase_oproj8(KP p, int layer, const char* A8, const char* W8, int nrows, char* smem) {
  char* const ws = ows(p);
  LAS unsigned char* lds = (LAS unsigned char*)smem;
  fg::DenseSched S;
  S.A = A8; S.B = W8; S.nM = nrows / 256; S.nN = 4; S.G = gridDim.x; S.c = obid(); S.tA = (size_t)256 * 1024; S.tB = (size_t)256 * 1024;
  auto ep = [&](const f32x16 (&acc)[2][2][2], const fg::Unit& u, int wr, int wc, int r, int h) {
    constexpr float inv = 1.0f / (O8_SCALE * 32.0f);
    const int row0 = u.pm * 256 + wr * 64 + r, colb = u.pn * 256 + wc * 32 + 16 * h;
    const float* g1 = modp(ws, layer, row_bi(row0), 2) + colb;
#pragma unroll
    for (int bj = 0; bj < 2; ++bj) {
      f32x4 g[4];
#pragma unroll
      for (int q = 0; q < 4; ++q) g[q] = *(const f32x4*)(g1 + bj * 128 + 4 * q) * inv;
#pragma unroll
      for (int ai = 0; ai < 2; ++ai)
#pragma unroll
        for (int m = 0; m < 2; ++m) {
          bf16_t* xr = xrow_ptr(p, ws, row0 + ai * 128 + m * 32) + colb + bj * 128;
          const u32x4 x0 = ld16(xr), x1 = ld16(xr + 8);
          const f32x16& a = acc[ai][bj][m];
          u32x4 w0, w1;
          w0.x = pk2(bflo(x0.x) + g[0][0] * a[0], bfhi(x0.x) + g[0][1] * a[1]); w0.y = pk2(bflo(x0.y) + g[0][2] * a[2], bfhi(x0.y) + g[0][3] * a[3]);
          w0.z = pk2(bflo(x0.z) + g[1][0] * a[4], bfhi(x0.z) + g[1][1] * a[5]); w0.w = pk2(bflo(x0.w) + g[1][2] * a[6], bfhi(x0.w) + g[1][3] * a[7]);
          w1.x = pk2(bflo(x1.x) + g[2][0] * a[8], bfhi(x1.x) + g[2][1] * a[9]); w1.y = pk2(bflo(x1.y) + g[2][2] * a[10], bfhi(x1.y) + g[2][3] * a[11]);
          w1.z = pk2(bflo(x1.z) + g[3][0] * a[12], bfhi(x1.z) + g[3][1] * a[13]); w1.w = pk2(bflo(x1.w) + g[3][2] * a[14], bfhi(x1.w) + g[3][3] * a[15]);
          if (!DRY) { *(u32x4*)xr = w0; *(u32x4*)(xr + 8) = w1; } else asm volatile("" :: "v"(w0), "v"(w1));
        }
    }
  };
  fg::gemm_phase_f8<false, true>(lds, 512, 512, 512, S, ep);
}

DI void phase_pool_pre(KP p, char* smem) {
  char* const ws = ows(p);
  const int lane = otid() & 63, wid = otid() >> 6;
  const bf16_t* hb = (const bf16_t*)(ws + OFF_H);
  bf16_t* Y = (bf16_t*)(ws + OFF_U + U2_Y);
  const int ch0 = lane * 16, half = 1 << (lane >> 4);
  auto acc16 = [&](float (&a)[16], const bf16_t* q, float sg) __attribute__((always_inline)) {
    const u32x4 v0 = ld16(q), v1 = ld16(q + 8);
    a[0] += sg * bflo(v0.x); a[1] += sg * bfhi(v0.x); a[2] += sg * bflo(v0.y); a[3] += sg * bfhi(v0.y); a[4] += sg * bflo(v0.z); a[5] += sg * bfhi(v0.z); a[6] += sg * bflo(v0.w); a[7] += sg * bfhi(v0.w);
    a[8] += sg * bflo(v1.x); a[9] += sg * bfhi(v1.x); a[10] += sg * bflo(v1.y); a[11] += sg * bfhi(v1.y); a[12] += sg * bflo(v1.z); a[13] += sg * bfhi(v1.z); a[14] += sg * bflo(v1.w); a[15] += sg * bfhi(v1.w);
  };
  for (int seg = obid() * 8 + wid; seg < 2048 + 128; seg += gridDim.x * 8) {
    const int r0 = seg * 32;
    int s0, L;
    if (r0 < TL) { s0 = r0 & 4095; L = 4096; } else { s0 = (r0 - TL) & 255; L = 256; }
    const bf16_t* base = hb + (size_t)(r0 - s0) * DM + ch0;
    float a[16];
#pragma unroll
    for (int j = 0; j < 16; ++j) a[j] = 0.f;
    {
      const int lo = s0 - half < 0 ? 0 : s0 - half, hi = s0 + half > L ? L : s0 + half;
      for (int q = lo; q < hi; ++q) acc16(a, base + (size_t)q * DM, 1.0f);
    }
#pragma unroll 2
    for (int i = 0; i < 32; ++i) {
      const int s = s0 + i;
      const int lo = s - half < 0 ? 0 : s - half, hi = s + half > L ? L : s + half;
      const float inv = 1.0f / (float)(hi - lo);
      const u32x4 c0 = ld16(base + (size_t)s * DM), c1 = ld16(base + (size_t)s * DM + 8);
      u32x4 o0, o1;
      o0.x = pk2(a[0] * inv - bflo(c0.x), a[1] * inv - bfhi(c0.x)); o0.y = pk2(a[2] * inv - bflo(c0.y), a[3] * inv - bfhi(c0.y));
      o0.z = pk2(a[4] * inv - bflo(c0.z), a[5] * inv - bfhi(c0.z)); o0.w = pk2(a[6] * inv - bflo(c0.w), a[7] * inv - bfhi(c0.w));
      o1.x = pk2(a[8] * inv - bflo(c1.x), a[9] * inv - bfhi(c1.x)); o1.y = pk2(a[10] * inv - bflo(c1.y), a[11] * inv - bfhi(c1.y));
      o1.z = pk2(a[12] * inv - bflo(c1.z), a[13] * inv - bfhi(c1.z)); o1.w = pk2(a[14] * inv - bflo(c1.w), a[15] * inv - bfhi(c1.w));
      *(u32x4*)(Y + (size_t)(r0 + i) * DM + ch0) = o0; *(u32x4*)(Y + (size_t)(r0 + i) * DM + ch0 + 8) = o1;
      if (s + half < L) acc16(a, base + (size_t)(s + half) * DM, 1.0f);
      if (s - half >= 0) acc16(a, base + (size_t)(s - half) * DM, -1.0f);
    }
  }
}
struct PoolSched {
  const char* A; const char* B; int G, c;
  DI bool next(int i, fg::Unit& u) const {
    const int L = i * G + c; if (L >= (TT / 256) * 4) return false;
    const int pm = L >> 2, g = L & 3;
    u.pm = pm; u.pn = g; u.aux = 0; u.A = A + ((size_t)pm * 256 * 1024 + g * 256) * 2; u.B = B + (size_t)g * 65536 * 2; return true;
  }
  DI const LAS int* rows(int) const { return nullptr; }
};
template <bool DRY = false>
DI void phase_pool(KP p, char* smem) {
  char* const ws = ows(p);
  LAS unsigned char* lds = (LAS unsigned char*)smem;
  const float* pb = gin(p, 16);
  const float* psc = gin(p, 17);
  PoolSched S; S.A = ws + OFF_U + U2_Y; S.B = ws + OFF_WMIX + W_POOL * 2; S.G = gridDim.x; S.c = obid();
  auto ep = [&](const f32x4 (&acc)[2][2][4][2], const fg::Unit& u, int wr, int wc, int fr, int fq) {
    const int row0 = u.pm * 256 + wr * 64 + fr, colb = u.pn * 256 + wc * 32 + 4 * fq;
    const float* g1 = modp(ws, 2, row_bi(row0), 2) + colb;
    f32x4 g[2][2], bb[2][2];
#pragma unroll
    for (int bj = 0; bj < 2; ++bj)
#pragma unroll
      for (int n = 0; n < 2; ++n) {
        const f32x4 s4 = *(const f32x4*)(psc + colb + bj * 128 + n * 16);
        g[bj][n] = *(const f32x4*)(g1 + bj * 128 + n * 16) * s4;
        bb[bj][n] = *(const f32x4*)(pb + colb + bj * 128 + n * 16) * g[bj][n];
      }
    f32x4 xa[2][2], xb[2][2];
    bf16_t* xr = xrow_ptr(p, ws, row0) + colb;
#pragma unroll
    for (int bj = 0; bj < 2; ++bj)
#pragma unroll
      for (int n = 0; n < 2; ++n) xa[bj][n] = ldbf4(xr + bj * 128 + n * 16);
#pragma unroll
    for (int rr = 0; rr < 8; ++rr) {
      const int ai = rr >> 2, m = rr & 3;
      bf16_t* xn = xr;
      if (rr + 1 < 8) {
        xn = xrow_ptr(p, ws, row0 + ((rr + 1) >> 2) * 128 + ((rr + 1) & 3) * 16) + colb;
#pragma unroll
        for (int bj = 0; bj < 2; ++bj)
#pragma unroll
          for (int n = 0; n < 2; ++n) xb[bj][n] = ldbf4(xn + bj * 128 + n * 16);
      }
#pragma unroll
      for (int bj = 0; bj < 2; ++bj)
#pragma unroll
        for (int n = 0; n < 2; ++n) {
          const f32x4 x = xa[bj][n] + (g[bj][n] * acc[ai][bj][m][n] + bb[bj][n]);
          if (!DRY) stbf4(xr + bj * 128 + n * 16, x); else asm volatile("" :: "v"(x[0]), "v"(x[1]), "v"(x[2]), "v"(x[3]));
        }
#pragma unroll
      for (int bj = 0; bj < 2; ++bj)
#pragma unroll
        for (int n = 0; n < 2; ++n) xa[bj][n] = xb[bj][n];
      xr = xn;
    }
  };
  fg::gemm_phase<false>(lds, 256, 1024, 256, S, ep);
}

typedef short v4i16_t __attribute__((ext_vector_type(4)));
DI s16x4 tr_read(const bf16_t* p) { return __builtin_bit_cast(s16x4, __builtin_amdgcn_ds_read_tr16_b64_v4i16((LAS v4i16_t*)p)); }
DI bf16x8 pack8(const f32x16& x, int s) {
  u32x4 q;
  q.x = pk2(x[8 * s + 0], x[8 * s + 1]); q.y = pk2(x[8 * s + 2], x[8 * s + 3]);
  q.z = pk2(x[8 * s + 4], x[8 * s + 5]); q.w = pk2(x[8 * s + 6], x[8 * s + 7]);
  return __builtin_bit_cast(bf16x8, q);
}
template <int DT, int VLD_, bool MASK>
DI void attn_tile(const bf16_t* sK, int kld, const bf16_t* vbase, const bf16x8 (&qf)[4], f32x16 (&Y)[DT], float& m, float& l, int r, int h, int qpos, int kpos0) {
  f32x16 X[2];
#pragma unroll
  for (int sub = 0; sub < 2; ++sub) {
#pragma unroll
    for (int i = 0; i < 16; ++i) X[sub][i] = 0.f;
#pragma unroll
    for (int s = 0; s < 4; ++s) {
      const bf16x8 a = *(const bf16x8*)(sK + (sub * 32 + r) * kld + 16 * s + 8 * h);
      X[sub] = MFMA32(a, qf[s], X[sub]);
    }
  }
  if (MASK) {
#pragma unroll
    for (int sub = 0; sub < 2; ++sub)
#pragma unroll
      for (int i = 0; i < 16; ++i) {
        const int kp = kpos0 + sub * 32 + (i & 3) + 8 * (i >> 2) + 4 * h;
        const int d = qpos - kp;
        if (d > 128 || d < -128) X[sub][i] = -1e30f;
      }
  }
  float mx = m;
#pragma unroll
  for (int sub = 0; sub < 2; ++sub)
#pragma unroll
    for (int i = 0; i < 16; ++i) mx = fmaxf(mx, X[sub][i]);
  mx = fmaxf(mx, __shfl_xor(mx, 32));
  const float alpha = __expf(m - mx);
  m = mx;
  float ps = 0.f;
#pragma unroll
  for (int sub = 0; sub < 2; ++sub)
#pragma unroll
    for (int i = 0; i < 16; ++i) { const float pv = __expf(X[sub][i] - mx); X[sub][i] = pv; ps += pv; }
  l = l * alpha + ps;
#pragma unroll
  for (int dt = 0; dt < DT; ++dt)
#pragma unroll
    for (int i = 0; i < 16; ++i) Y[dt][i] *= alpha;
#pragma unroll
  for (int sub = 0; sub < 2; ++sub)
#pragma unroll
    for (int s = 0; s < 2; ++s) {
      const bf16x8 pf = pack8(X[sub], s);
#pragma unroll
      for (int dt = 0; dt < DT; ++dt) {
        const bf16_t* vp = vbase + (sub * 32 + 16 * s) * VLD_ + dt * 32;
        const s16x4 lo = tr_read(vp), hi = tr_read(vp + 8 * VLD_);
        const bf16x8 vf = __builtin_shufflevector(lo, hi, 0, 1, 2, 3, 4, 5, 6, 7);
        Y[dt] = MFMA32(vf, pf, Y[dt]);
      }
    }
}

constexpr int A0_KLD = 72, A0_VLD = 96;
constexpr int A0_LDS = 64 * A0_KLD * 2 + 64 * A0_VLD * 2;
DI void phase_attn_win(KP p, char* smem) {
  char* const ws = ows(p);
  bf16_t* sK = (bf16_t*)smem;
  bf16_t* sV = sK + 64 * A0_KLD;
  const bf16_t* Q = (const bf16_t*)(ws + OFF_U + U0_Q);
  const bf16_t* Kb = (const bf16_t*)(ws + OFF_U + U0_K);
  const bf16_t* Vb = (const bf16_t*)(ws + OFF_U + U0_V);
  bf16_t* O = (bf16_t*)(ws + OFF_U + U0_O);
  const float* sink = gin(p, 9);
  const int tid = otid(), lane = tid & 63, wid = tid >> 6, r = lane & 31, h = lane >> 5;
  const bf16_t* vbase = sV + (4 * h + ((lane & 15) >> 2)) * A0_VLD + 16 * ((lane >> 4) & 1) + 4 * (lane & 3);
  const int NLAT = 16 * 4 * 32 * 2, NCTX = 16 * 16;
  for (int it = obid(); it < NLAT + NCTX; it += gridDim.x) {
    const bool lat = it < NLAT;
    int b, kvh, qb = 0, head, qrow, qpos;
    if (lat) {
      b = it >> 8; kvh = (it >> 6) & 3; qb = (it >> 1) & 31; const int hp = it & 1;
      head = kvh * 4 + hp * 2 + (wid >> 2);
      qpos = qb * 128 + (wid & 3) * 32 + r; qrow = b * 4096 + qpos;
    } else {
      const int i2 = it - NLAT; b = i2 >> 4; head = i2 & 15; kvh = head >> 2;
      qpos = wid * 32 + r; qrow = TL + b * 256 + qpos;
    }
    bf16x8 qf[4];
#pragma unroll
    for (int s = 0; s < 4; ++s) qf[s] = *(const bf16x8*)(Q + (size_t)qrow * DM + head * 64 + 16 * s + 8 * h);
    f32x16 Y[2];
#pragma unroll
    for (int dt = 0; dt < 2; ++dt)
#pragma unroll
      for (int i = 0; i < 16; ++i) Y[dt][i] = 0.f;
    float m = sink[head], l = h == 0 ? 1.0f : 0.0f;
    const int kr = tid >> 3, k8 = (tid & 7) * 8;
    auto tile_ok = [&](int t) -> bool { if (t >= 6) return true; if (!lat) return false; const int kt = 2 * qb - 2 + t; return kt >= 0 && kt < 64; };
    auto trow = [&](int t) -> size_t { return t < 6 ? (size_t)b * 4096 + (2 * qb - 2 + t) * 64 + kr : (size_t)TL + b * 256 + (t - 6) * 64 + kr; };
    int t = 0;
    while (t < 10 && !tile_ok(t)) ++t;
    u32x4 rk = ld16(Kb + trow(t) * 256 + kvh * 64 + k8), rv = ld16(Vb + trow(t) * 256 + kvh * 64 + k8);
    while (t < 10) {
      __syncthreads();
      *(u32x4*)(sK + kr * A0_KLD + k8) = rk;
      *(u32x4*)(sV + kr * A0_VLD + k8) = rv;
      __syncthreads();
      int tn = t + 1;
      while (tn < 10 && !tile_ok(tn)) ++tn;
      if (tn < 10) { rk = ld16(Kb + trow(tn) * 256 + kvh * 64 + k8); rv = ld16(Vb + trow(tn) * 256 + kvh * 64 + k8); }
      if (t < 6) attn_tile<2, A0_VLD, true>(sK, A0_KLD, vbase, qf, Y, m, l, r, h, qpos, (2 * qb - 2 + t) * 64);
      else attn_tile<2, A0_VLD, false>(sK, A0_KLD, vbase, qf, Y, m, l, r, h, 0, 0);
      t = tn;
    }
    const float lt = l + __shfl_xor(l, 32);
    const float inv = 1.0f / lt;
#pragma unroll
    for (int dt = 0; dt < 2; ++dt)
#pragma unroll
      for (int g = 0; g < 4; ++g) {
        const float i8 = inv * O8_SCALE;
        *(unsigned*)((unsigned char*)O + (size_t)qrow * DM + head * 64 + dt * 32 + 8 * g + 4 * h) = pk4_fp8(Y[dt][4 * g] * i8, Y[dt][4 * g + 1] * i8, Y[dt][4 * g + 2] * i8, Y[dt][4 * g + 3] * i8);
      }
  }
}

constexpr int A1_KLD = 136, A1_VLD = 160;
constexpr int A1_K8LD = 144;
constexpr int A1_V8LD = 80;
constexpr int A1_KB = 64 * A1_K8LD, A1_VB = 128 * A1_V8LD;
constexpr int A1_LDS = 2 * A1_KB + 2 * A1_VB + 4 * 128 * 32 * 4;
DI void qk_tile(const bf16_t* sK, int kld, const bf16x8 (&qf)[4], f32x16 (&X)[2], int r, int h) {
  bf16x8 kf[2][4];
#pragma unroll
  for (int sub = 0; sub < 2; ++sub)
#pragma unroll
    for (int s = 0; s < 4; ++s) kf[sub][s] = *(const bf16x8*)(sK + (sub * 32 + r) * kld + 16 * s + 8 * h);
#pragma unroll
  for (int sub = 0; sub < 2; ++sub) {
#pragma unroll
    for (int i = 0; i < 16; ++i) X[sub][i] = 0.f;
#pragma unroll
    for (int s = 0; s < 4; ++s) X[sub] = MFMA32(kf[sub][s], qf[s], X[sub]);
  }
}
typedef int v8i_t __attribute__((ext_vector_type(8)));
typedef int v4i_t __attribute__((ext_vector_type(4)));
DI void qk8_tile(const unsigned char* sK8, int kld8, const v8i_t& q8, f32x16 (&X)[2], int r, int h) {
  v8i_t kf[2];
#pragma unroll
  for (int sub = 0; sub < 2; ++sub) { const v4i_t* q_ = (const v4i_t*)(sK8 + (sub * 32 + r) * kld8 + 32 * h); kf[sub] = __builtin_shufflevector(q_[0], q_[1], 0, 1, 2, 3, 4, 5, 6, 7); }
#pragma unroll
  for (int sub = 0; sub < 2; ++sub) {
    f32x16 z;
#pragma unroll
    for (int i = 0; i < 16; ++i) z[i] = 0.f;
    X[sub] = __builtin_amdgcn_mfma_scale_f32_32x32x64_f8f6f4(kf[sub], q8, z, 0, 0, 0, 0x7f7f7f7f, 0, 0x7f7f7f7f);
  }
}
template <int DT, int QSC = 1, int PSH = 0>
DI void softmax_lazy(f32x16 (&X)[2], f32x16 (&Y)[DT], float& m, float& l) {
  constexpr float THR = 4.0f * QSC, L2E = 1.44269504089f / QSC;
  float c0 = X[0][0], c1 = X[0][1], c2 = X[0][2], c3 = X[0][3];
#pragma unroll
  for (int i = 4; i < 16; i += 4) { c0 = fmaxf(c0, X[0][i]); c1 = fmaxf(c1, X[0][i + 1]); c2 = fmaxf(c2, X[0][i + 2]); c3 = fmaxf(c3, X[0][i + 3]); }
#pragma unroll
  for (int i = 0; i < 16; i += 4) { c0 = fmaxf(c0, X[1][i]); c1 = fmaxf(c1, X[1][i + 1]); c2 = fmaxf(c2, X[1][i + 2]); c3 = fmaxf(c3, X[1][i + 3]); }
  float mx = fmaxf(fmaxf(c0, c1), fmaxf(c2, c3));
  { float a, b; swap32(mx, a, b); mx = fmaxf(a, b); }
  if (__builtin_amdgcn_ballot_w64(mx > m + THR) != 0ull) {
    const float mn = fmaxf(m, mx);
    const float alpha = __builtin_amdgcn_exp2f((m - mn) * L2E);
    m = mn; l *= alpha;
#pragma unroll
    for (int dt = 0; dt < DT; ++dt)
#pragma unroll
      for (int i = 0; i < 16; ++i) Y[dt][i] *= alpha;
  }
  const float nm = fmaf(-m, L2E, (float)PSH);
  float ps0 = 0.f, ps1 = 0.f, ps2 = 0.f, ps3 = 0.f;
#pragma unroll
  for (int sub = 0; sub < 2; ++sub)
#pragma unroll
    for (int i = 0; i < 16; i += 4) {
      const float p0 = __builtin_amdgcn_exp2f(fmaf(X[sub][i], L2E, nm)), p1 = __builtin_amdgcn_exp2f(fmaf(X[sub][i + 1], L2E, nm));
      const float p2 = __builtin_amdgcn_exp2f(fmaf(X[sub][i + 2], L2E, nm)), p3 = __builtin_amdgcn_exp2f(fmaf(X[sub][i + 3], L2E, nm));
      X[sub][i] = p0; X[sub][i + 1] = p1; X[sub][i + 2] = p2; X[sub][i + 3] = p3;
      asm("v_add_f32 %0, %1, %0" : "+v"(ps0) : "v"(p0));
      asm("v_add_f32 %0, %1, %0" : "+v"(ps1) : "v"(p1));
      asm("v_add_f32 %0, %1, %0" : "+v"(ps2) : "v"(p2));
      asm("v_add_f32 %0, %1, %0" : "+v"(ps3) : "v"(p3));
    }
  asm("v_add_f32 %0, %1, %0" : "+v"(ps0) : "v"(ps1));
  asm("v_add_f32 %0, %1, %0" : "+v"(ps2) : "v"(ps3));
  l += ps0 + ps2;
}
template <int DT, int VLD_>
DI void pv_tile(const f32x16 (&X)[2], const bf16_t* vbase, f32x16 (&Y)[DT]) {
#pragma unroll
  for (int sub = 0; sub < 2; ++sub)
#pragma unroll
    for (int s = 0; s < 2; ++s) {
      const bf16x8 pf = pack8(X[sub], s);
#pragma unroll
      for (int dt = 0; dt < DT; ++dt) {
        const bf16_t* vp = vbase + (sub * 32 + 16 * s) * VLD_ + dt * 32;
        const s16x4 lo = tr_read(vp), hi = tr_read(vp + 8 * VLD_);
        const bf16x8 vf = __builtin_shufflevector(lo, hi, 0, 1, 2, 3, 4, 5, 6, 7);
        Y[dt] = MFMA32(vf, pf, Y[dt]);
      }
    }
}
DI void phase_attn_diff(KP p, char* smem) {
  char* const ws = ows(p);
  unsigned char* sK = (unsigned char*)smem;
  unsigned char* sV = (unsigned char*)(smem + 2 * A1_KB);
  float* comb = (float*)(smem + 2 * A1_KB + 2 * A1_VB);
  const bf16_t* Q = (const bf16_t*)(ws + OFF_U + U1_Q);
  const unsigned char* K8 = (const unsigned char*)(ws + OFF_U + U1_K);
  const unsigned char* Vt = (const unsigned char*)(ws + OFF_U + U1_V);
  bf16_t* O = (bf16_t*)(ws + OFF_U + U1_O);
  const int tid = otid(), lane = tid & 63, wid = tid >> 6, r = lane & 31, h = lane >> 5, grp = wid >> 2;
  const float lambda_init = 0.8f - 0.6f * 0.74081822068f;
  float lam_full;
  {
    const float* lf = gin(p, 12);
    float s1 = 0.f, s2 = 0.f;
    for (int i = 0; i < 64; ++i) { s1 += lf[i] * lf[64 + i]; s2 += lf[128 + i] * lf[192 + i]; }
    lam_full = expf(s1) - expf(s2) + lambda_init;
  }
  const float* subg = gin(p, 13);
  const int NLAT = 16 * 8 * 32, NCTX = 16 * 8 * 2;
  const int kr = tid >> 3, kc = (tid & 7) * 16;
  for (int it = obid(); it < NLAT + NCTX; it += gridDim.x) {
    const bool lat = it < NLAT;
    int b, head, qrow, t0;
    const int nt = 68;
    if (lat) { b = it >> 8; head = (it >> 5) & 7; const int qb = it & 31; qrow = b * 4096 + qb * 128 + (wid & 3) * 32 + r; t0 = 0; }
    else { const int i2 = it - NLAT; b = i2 >> 4; head = (i2 >> 1) & 7; const int hf = i2 & 1; qrow = TL + b * 256 + hf * 128 + (wid & 3) * 32 + r; t0 = 64; }
    v8i_t q8;
    {
      const bf16_t* qp = Q + (size_t)qrow * DM + head * 128 + grp * 64 + 32 * h;
#pragma unroll
      for (int c4 = 0; c4 < 4; ++c4) {
        const u32x4 w = ld16(qp + 8 * c4);
        q8[2 * c4] = (int)pk4_fp8(bflo(w.x) * 8.f, bfhi(w.x) * 8.f, bflo(w.y) * 8.f, bfhi(w.y) * 8.f);
        q8[2 * c4 + 1] = (int)pk4_fp8(bflo(w.z) * 8.f, bfhi(w.z) * 8.f, bflo(w.w) * 8.f, bfhi(w.w) * 8.f);
      }
    }
    f32x16 Y[4];
#pragma unroll
    for (int dt = 0; dt < 4; ++dt)
#pragma unroll
      for (int i = 0; i < 16; ++i) Y[dt][i] = 0.f;
    float m = -1e30f, l = 0.f;
    auto goff = [&](int t) -> size_t { return (t < 64 ? (size_t)b * 4096 + t * 64 + kr : (size_t)TL + b * 256 + (t - 64) * 64 + kr) * 1024 + head * 128 + kc; };
    auto stK = [&](int t, const u32x4& a) { *(u32x4*)(sK + (t & 1) * A1_KB + kr * A1_K8LD + kc) = a; };
    const int vd = tid >> 2, vcx = (tid & 3) * 16;
    auto voff = [&](int t) -> size_t { return t < 64 ? ((size_t)(b * 1024 + head * 128 + vd) * 4096 + (size_t)t * 64 + vcx) : ((size_t)16 * 1024 * 4096 + (size_t)(b * 1024 + head * 128 + vd) * 256 + (size_t)(t - 64) * 64 + vcx); };
    auto stV = [&](int t, const u32x4& a) { *(u32x4*)(sV + (t & 1) * A1_VB + vd * A1_V8LD + vcx) = a; };
    u32x4 rk0, rv0;
    __syncthreads();
    rk0 = *(const u32x4*)(K8 + goff(t0)); stK(t0, rk0);
    rk0 = *(const u32x4*)(K8 + goff(t0 + 1)); stK(t0 + 1, rk0);
    rk0 = *(const u32x4*)(K8 + goff(t0 + 2));
    rv0 = *(const u32x4*)(Vt + voff(t0));
    __syncthreads();
    f32x16 Xn[2];
    qk8_tile(sK + (t0 & 1) * A1_KB + grp * 64, A1_K8LD, q8, Xn, r, h);
    __syncthreads();
    v8i_t p8;
    auto pv8 = [&](int t) __attribute__((always_inline)) {
      const unsigned char* vb8 = sV + (t & 1) * A1_VB + r * A1_V8LD + 32 * h;
#pragma unroll
      for (int dt = 0; dt < 4; ++dt) {
        const v4i_t* q_ = (const v4i_t*)(vb8 + dt * 32 * A1_V8LD);
        const v8i_t vf = __builtin_shufflevector(q_[0], q_[1], 0, 1, 2, 3, 4, 5, 6, 7);
        Y[dt] = __builtin_amdgcn_mfma_scale_f32_32x32x64_f8f6f4(vf, p8, Y[dt], 0, 0, 0, 0x7f7f7f7f, 0, 0x7f7f7f7f);
      }
    };
    for (int t = t0; t < nt; ++t) {
      if (t + 2 < nt) stK(t + 2, rk0);
      stV(t, rv0);
      if (t + 3 < nt) rk0 = *(const u32x4*)(K8 + goff(t + 3));
      if (t + 1 < nt) rv0 = *(const u32x4*)(Vt + voff(t + 1));
      f32x16 X[2];
      X[0] = Xn[0]; X[1] = Xn[1];
      if (t + 1 < nt) qk8_tile(sK + ((t + 1) & 1) * A1_KB + grp * 64, A1_K8LD, q8, Xn, r, h);
      if (t > t0) pv8(t - 1);
      softmax_lazy<4, 8, 2>(X, Y, m, l);
#pragma unroll
      for (int sub = 0; sub < 2; ++sub)
#pragma unroll
        for (int g4 = 0; g4 < 4; ++g4) p8[4 * sub + g4] = (int)pk4_fp8_nc(X[sub][4 * g4], X[sub][4 * g4 + 1], X[sub][4 * g4 + 2], X[sub][4 * g4 + 3]);
      __syncthreads();
    }
    pv8(nt - 1);
    const float lt = l + __shfl_xor(l, 32);
    const float inv = 1.0f / lt;
    if (grp == 1) {
#pragma unroll
      for (int dt = 0; dt < 4; ++dt)
#pragma unroll
        for (int i = 0; i < 16; ++i) comb[(((wid & 3) * 128) + dt * 32 + (i & 3) + 8 * (i >> 2) + 4 * h) * 32 + r] = Y[dt][i] * inv;
    }
    __syncthreads();
    if (grp == 0) {
      float ss = 0.f;
#pragma unroll
      for (int dt = 0; dt < 4; ++dt)
#pragma unroll
        for (int i = 0; i < 16; ++i) {
          const float o2 = comb[(((wid & 3) * 128) + dt * 32 + (i & 3) + 8 * (i >> 2) + 4 * h) * 32 + r];
          const float vv = Y[dt][i] * inv - lam_full * o2;
          Y[dt][i] = vv; ss += vv * vv;
        }
      ss += __shfl_xor(ss, 32);
      const float rs = rsqrtf(ss * (1.0f / 128.0f) + 1e-6f) * (1.0f - lambda_init);
#pragma unroll
      for (int dt = 0; dt < 4; ++dt)
#pragma unroll
        for (int g = 0; g < 4; ++g) {
          const int d0 = dt * 32 + 8 * g + 4 * h;
          const f32x4 sg = *(const f32x4*)(subg + d0);
          const float r8 = rs * O8_SCALE;
          *(unsigned*)((unsigned char*)O + (size_t)qrow * DM + head * 128 + d0) = pk4_fp8(Y[dt][4 * g] * r8 * sg[0], Y[dt][4 * g + 1] * r8 * sg[1], Y[dt][4 * g + 2] * r8 * sg[2], Y[dt][4 * g + 3] * r8 * sg[3]);
        }
    }
  }
}

DI u32x4 rwkv_mix_load(const bf16_t* hb, const float* mu, int mixi, int row, int k) {
  int s, L;
  if (row < TL) { s = row & 4095; L = 4096; } else { s = (row - TL) & 255; L = 256; }
  const bf16_t* hp = hb + (size_t)row * DM + k;
  const u32x4 c = ld16(hp);
  u32x4 pv = (u32x4){0u, 0u, 0u, 0u}, nx = (u32x4){0u, 0u, 0u, 0u};
  if (s > 0) pv = ld16(hp - DM);
  if (s < L - 1) nx = ld16(hp + DM);
  const float* m0 = mu + (size_t)(0 * 6 + mixi) * DM + k;
  const float* m1 = mu + (size_t)(1 * 6 + mixi) * DM + k;
  const f32x4 a0 = *(const f32x4*)m0, a1 = *(const f32x4*)(m0 + 4), b0 = *(const f32x4*)m1, b1 = *(const f32x4*)(m1 + 4);
  float cv[8] = {bflo(c.x), bfhi(c.x), bflo(c.y), bfhi(c.y), bflo(c.z), bfhi(c.z), bflo(c.w), bfhi(c.w)};
  float pvv[8] = {bflo(pv.x), bfhi(pv.x), bflo(pv.y), bfhi(pv.y), bflo(pv.z), bfhi(pv.z), bflo(pv.w), bfhi(pv.w)};
  float nv[8] = {bflo(nx.x), bfhi(nx.x), bflo(nx.y), bfhi(nx.y), bflo(nx.z), bfhi(nx.z), bflo(nx.w), bfhi(nx.w)};
  float mu0[8] = {a0[0], a0[1], a0[2], a0[3], a1[0], a1[1], a1[2], a1[3]};
  float mu1[8] = {b0[0], b0[1], b0[2], b0[3], b1[0], b1[1], b1[2], b1[3]};
  float o[8];
#pragma unroll
  for (int j = 0; j < 8; ++j) o[j] = cv[j] + (pvv[j] - cv[j]) * mu0[j] + (nv[j] - cv[j]) * mu1[j];
  u32x4 w; w.x = pk2(o[0], o[1]); w.y = pk2(o[2], o[3]); w.z = pk2(o[4], o[5]); w.w = pk2(o[6], o[7]);
  return w;
}
template <int ACT  , class AL>
DI void rwkv_gemm_tile(char* smem, AL la, const bf16_t* Bt, int K, int ldb, bf16_t* dst, int ldd, int row0, int col0, int ncols_valid) {
  auto lb = [&](int tn, int k) -> u32x4 { return (col0 + tn) < ncols_valid ? ld16(Bt + (size_t)(col0 + tn) * ldb + k) : (u32x4){0u, 0u, 0u, 0u}; };
  auto ep = [&](const f32x4 (&acc)[4][2], int r0, int c0, int fr, int fq) {
#pragma unroll
    for (int m = 0; m < 4; ++m)
#pragma unroll
      for (int n = 0; n < 2; ++n)
#pragma unroll
        for (int j = 0; j < 4; ++j) {
          const int row = row0 + r0 + m * 16 + fq * 4 + j, col = col0 + c0 + n * 16 + fr;
          float v = acc[m][n][j];
          if (ACT == 1) v = 1.0f - 2.0f * __builtin_amdgcn_rcpf(1.0f + __expf(2.0f * v));
          if (ACT == 2) v = sigmoidf_(v);
          if (col < ncols_valid) dst[(size_t)row * ldd + col] = f2bf(v);
        }
  };
  sgemm_tile(smem, K, la, lb, ep);
}
DI void phase_rwkv_mix(KP p, char* smem) {
  char* const ws = ows(p);
  const int lane = otid() & 63, wid = otid() >> 6;
  const bf16_t* hb = (const bf16_t*)(ws + OFF_H);
  const float* mu = gin(p, 18);
  bf16_t* XR = (bf16_t*)(ws + OFF_U + U3_XR);
  bf16_t* XK = (bf16_t*)(ws + OFF_U + U3_XK);
  bf16_t* XV = (bf16_t*)(ws + OFF_U + U3_XV);
  const int ch0 = lane * 16;
  for (int r = obid() * 8 + wid; r < TT; r += gridDim.x * 8) {
    int s, L;
    if (r < TL) { s = r & 4095; L = 4096; } else { s = (r - TL) & 255; L = 256; }
    const bf16_t* hp = hb + (size_t)r * DM + ch0;
    float c[16], pv[16], nx[16];
    {
      const u32x4 a = ld16(hp), b = ld16(hp + 8);
      c[0] = bflo(a.x); c[1] = bfhi(a.x); c[2] = bflo(a.y); c[3] = bfhi(a.y); c[4] = bflo(a.z); c[5] = bfhi(a.z); c[6] = bflo(a.w); c[7] = bfhi(a.w);
      c[8] = bflo(b.x); c[9] = bfhi(b.x); c[10] = bflo(b.y); c[11] = bfhi(b.y); c[12] = bflo(b.z); c[13] = bfhi(b.z); c[14] = bflo(b.w); c[15] = bfhi(b.w);
    }
#pragma unroll
    for (int j = 0; j < 16; ++j) { pv[j] = 0.f; nx[j] = 0.f; }
    if (s > 0) {
      const u32x4 a = ld16(hp - DM), b = ld16(hp - DM + 8);
      pv[0] = bflo(a.x); pv[1] = bfhi(a.x); pv[2] = bflo(a.y); pv[3] = bfhi(a.y); pv[4] = bflo(a.z); pv[5] = bfhi(a.z); pv[6] = bflo(a.w); pv[7] = bfhi(a.w);
      pv[8] = bflo(b.x); pv[9] = bfhi(b.x); pv[10] = bflo(b.y); pv[11] = bfhi(b.y); pv[12] = bflo(b.z); pv[13] = bfhi(b.z); pv[14] = bflo(b.w); pv[15] = bfhi(b.w);
    }
    if (s < L - 1) {
      const u32x4 a = ld16(hp + DM), b = ld16(hp + DM + 8);
      nx[0] = bflo(a.x); nx[1] = bfhi(a.x); nx[2] = bflo(a.y); nx[3] = bfhi(a.y); nx[4] = bflo(a.z); nx[5] = bfhi(a.z); nx[6] = bflo(a.w); nx[7] = bfhi(a.w);
      nx[8] = bflo(b.x); nx[9] = bfhi(b.x); nx[10] = bflo(b.y); nx[11] = bfhi(b.y); nx[12] = bflo(b.z); nx[13] = bfhi(b.z); nx[14] = bflo(b.w); nx[15] = bfhi(b.w);
    }
#pragma unroll
    for (int q = 0; q < 3; ++q) {
      const int mixi = q == 0 ? 0 : q + 1;
      if (q == 0 && r >= TL) continue;
      unsigned char* dst = (unsigned char*)(q == 0 ? XR : q == 1 ? XK : XV) + (size_t)r * DM + ch0;
      const float* m0 = mu + (size_t)(0 * 6 + mixi) * DM + ch0;
      const float* m1 = mu + (size_t)(1 * 6 + mixi) * DM + ch0;
      float o[16];
#pragma unroll
      for (int j4 = 0; j4 < 4; ++j4) {
        const f32x4 a = *(const f32x4*)(m0 + 4 * j4), b = *(const f32x4*)(m1 + 4 * j4);
#pragma unroll
        for (int j = 0; j < 4; ++j) { const int k = 4 * j4 + j; o[k] = c[k] + (pv[k] - c[k]) * a[j] + (nx[k] - c[k]) * b[j]; }
      }
      u32x4 w0;
      w0.x = pk4_fp8(o[0] * X8_SCALE, o[1] * X8_SCALE, o[2] * X8_SCALE, o[3] * X8_SCALE); w0.y = pk4_fp8(o[4] * X8_SCALE, o[5] * X8_SCALE, o[6] * X8_SCALE, o[7] * X8_SCALE);
      w0.z = pk4_fp8(o[8] * X8_SCALE, o[9] * X8_SCALE, o[10] * X8_SCALE, o[11] * X8_SCALE); w0.w = pk4_fp8(o[12] * X8_SCALE, o[13] * X8_SCALE, o[14] * X8_SCALE, o[15] * X8_SCALE);
      *(u32x4*)dst = w0;
    }
  }
}
struct RkvSched {
  const char* X0; const char* X1; const char* X2; const char* W; int G, c;
  DI bool next(int i, fg::Unit& u) const {
    int pmg, pn; if (!fg::static_order(i, G, c, 800, 4, pmg, pn)) return false;
    const int job = (pmg >= 256) + (pmg >= 528);
    u.pm = pmg - (job ? 256 + (job - 1) * 272 : 0); u.pn = pn; u.aux = job;
    u.A = X0 + (size_t)job * SZ_TT + (size_t)u.pm * 256 * 1024;
    u.B = W + (size_t)job * 1024 * 1024 * 2 + (size_t)u.pn * 256 * 1024; return true;
  }
  DI const LAS int* rows(int) const { return nullptr; }
};
DI void phase_rwkv_rkv(KP p, char* smem) {
  char* const ws = ows(p);
  LAS unsigned char* lds = (LAS unsigned char*)smem;
  char* U = ws + OFF_U;
  RkvSched S; S.X0 = U + U3_XR; S.X1 = U + U3_XK; S.X2 = U + U3_XV; S.W = ws + OFF_WMIX + W_R * 2; S.G = gridDim.x; S.c = obid();
  auto ep = [&](const f32x16 (&acc)[2][2][2], const fg::Unit& u, int wr, int wc, int r, int h) {
    bf16_t* dst = (bf16_t*)(U + (u.aux ? SZ_TL + (size_t)(u.aux - 1) * SZ_TT : (size_t)0));
    constexpr float inv = 1.0f / (X8_SCALE * 32.0f);
#pragma unroll
    for (int ai = 0; ai < 2; ++ai)
#pragma unroll
      for (int m = 0; m < 2; ++m) {
        const size_t row = (size_t)u.pm * 256 + ai * 128 + wr * 64 + m * 32 + r;
#pragma unroll
        for (int bj = 0; bj < 2; ++bj) {
          const f32x16& a = acc[ai][bj][m];
          u32x4 w0, w1;
          w0.x = pk2(a[0] * inv, a[1] * inv); w0.y = pk2(a[2] * inv, a[3] * inv); w0.z = pk2(a[4] * inv, a[5] * inv); w0.w = pk2(a[6] * inv, a[7] * inv);
          w1.x = pk2(a[8] * inv, a[9] * inv); w1.y = pk2(a[10] * inv, a[11] * inv); w1.z = pk2(a[12] * inv, a[13] * inv); w1.w = pk2(a[14] * inv, a[15] * inv);
          bf16_t* q = dst + row * DM + u.pn * 256 + bj * 128 + wc * 32 + 16 * h;
          *(u32x4*)q = w0; *(u32x4*)(q + 8) = w1;
        }
      }
  };
  fg::gemm_phase_f8<false, true>(lds, 512, 512, 512, S, ep);
}

DI void phase_rwkv_feat1(KP p, char* smem) {
  char* const ws = ows(p);
  const bf16_t* hb = (const bf16_t*)(ws + OFF_H);
  const bf16_t* wm = (const bf16_t*)(ws + OFF_WMIX);
  const float* mu = gin(p, 18);
  char* U = ws + OFF_U;
  const int n3 = 544, n4 = n3 + 544, n5 = n4 + 512;
  for (int t = obid(); t < n5; t += gridDim.x) {
    if (t < n3) {
      const int row0 = t * 128;
      auto la = [&](int trow, int k) -> u32x4 { return rwkv_mix_load(hb, mu, 1, row0 + trow, k); };
      rwkv_gemm_tile<1>(smem, la, wm + W_WA1, 1024, 1024, (bf16_t*)(U + U3_LW), 128, row0, 0, 128);
    } else if (t < n4) {
      const int row0 = (t - n3) * 128;
      auto la = [&](int trow, int k) -> u32x4 { return rwkv_mix_load(hb, mu, 4, row0 + trow, k); };
      rwkv_gemm_tile<0>(smem, la, wm + W_AA1, 1024, 1024, (bf16_t*)(U + U3_LA), 128, row0, 0, 128);
    } else {
      const int row0 = (t - n4) * 128;
      auto la = [&](int trow, int k) -> u32x4 { return rwkv_mix_load(hb, mu, 5, row0 + trow, k); };
      rwkv_gemm_tile<2>(smem, la, wm + W_G1, 1024, 1024, (bf16_t*)(U + U3_LG), 128, row0, 0, 128);
    }
  }
}
struct Feat2Sched {
  const char* U; const char* W; int G, c;
  DI bool next(int i, fg::Unit& u) const {
    const int L = i * G + c; if (L >= 2176 + 2176 + 1024) return false;
    const int job = (L >= 2176) + (L >= 4352), loc = L - job * 2176;
    if (job < 2) { u.pm = loc >> 3; u.pn = loc & 7; } else { u.pm = loc >> 2; u.pn = loc & 3; }
    u.aux = job;
    u.A = U + (job == 0 ? U3_LW : job == 1 ? U3_LA : U3_LG) + (size_t)u.pm * 256 * 128 * 2;
    u.B = W + ((job == 0 ? W_WA2 : job == 1 ? W_AA2 : W_G2) + (size_t)u.pn * 256 * 128) * 2; return true;
  }
  DI const LAS int* rows(int) const { return nullptr; }
};
DI void phase_rwkv_feat2(KP p, char* smem) {
  char* const ws = ows(p);
  LAS unsigned char* lds = (LAS unsigned char*)smem;
  char* U = ws + OFF_U;
  Feat2Sched S; S.U = U; S.W = ws + OFF_WMIX; S.G = gridDim.x; S.c = obid();
  const float* w0 = gin(p, 20);
  const float* a0 = gin(p, 23);
  auto ep = [&](const f32x4 (&acc)[2][2][4][2], const fg::Unit& u, int wr, int wc, int fr, int fq) {
    const int job = u.aux, d = u.pn >> 2;
    const int colu = (job < 2 ? (u.pn & 3) : u.pn) * 256 + wc * 32 + 8 * fq;
    bf16_t* dst = (bf16_t*)(U + (job == 0 ? (d ? U3_LD1 : U3_LD0) : job == 1 ? (d ? U3_A1 : U3_A0) : U3_G));
    const float* bias = (job == 0 ? w0 : a0) + d * 1024;
#pragma unroll
    for (int ai = 0; ai < 2; ++ai)
#pragma unroll
      for (int m = 0; m < 4; ++m) {
        const size_t row = (size_t)u.pm * 256 + ai * 128 + wr * 64 + m * 16 + fr;
#pragma unroll
        for (int bj = 0; bj < 2; ++bj) {
          f32x4 x0 = acc[ai][bj][m][0], x1 = acc[ai][bj][m][1];
          if (job < 2) {
            const f32x4 b0 = *(const f32x4*)(bias + colu + bj * 128), b1 = *(const f32x4*)(bias + colu + bj * 128 + 4);
            const float sc_ = job == 0 ? -0.60653065971f : 1.0f;
#pragma unroll
            for (int j = 0; j < 4; ++j) { x0[j] = sc_ * sigmoidf_(x0[j] + b0[j]); x1[j] = sc_ * sigmoidf_(x1[j] + b1[j]); }
          }
          u32x4 w; w.x = pk2(x0[0], x0[1]); w.y = pk2(x0[2], x0[3]); w.z = pk2(x1[0], x1[1]); w.w = pk2(x1[2], x1[3]);
          *(u32x4*)(dst + row * DM + colu + bj * 128) = w;
        }
      }
  };
  fg::gemm_phase<false, true>(lds, 128, 128, 128, S, ep);
}

constexpr int C3_L = 32, C3_LDK = 72, C3_LDT = 40, C3_LDY = 36;
constexpr int C3_BT = 0, C3_RT = 4608, C3_KT = 9216, C3_CT = 13824, C3_KHT = 18432, C3_CHT = 23552, C3_VT = 28672, C3_GKB = 33792, C3_GKR = 36352,
              C3_GCR = 38912, C3_S0 = 41472, C3_U = 50688, C3_MCB = 55808, C3_Y = 59904, C3_E = 69120, C3_TOT = 69376, C3_SCAN = 70400;
constexpr int SC_LDS = 2 * C3_SCAN;
DI void lds_bar() { asm volatile("s_waitcnt lgkmcnt(0)" ::: "memory"); __builtin_amdgcn_s_barrier(); asm volatile("" ::: "memory"); }
#define DPP_ADD(s, ctrl) ((s) + __builtin_bit_cast(float, __builtin_amdgcn_update_dpp(0, __builtin_bit_cast(int, (s)), (ctrl), 0xF, 0xF, true)))
DI float wave_sum_dpp(float s) {
  s = DPP_ADD(s, 0xB1); s = DPP_ADD(s, 0x4E); s = DPP_ADD(s, 0x141); s = DPP_ADD(s, 0x140);
  const int si = __builtin_bit_cast(int, s);
  const float a0 = __builtin_bit_cast(float, __builtin_amdgcn_readlane(si, 0)), a1 = __builtin_bit_cast(float, __builtin_amdgcn_readlane(si, 16));
  const float a2 = __builtin_bit_cast(float, __builtin_amdgcn_readlane(si, 32)), a3 = __builtin_bit_cast(float, __builtin_amdgcn_readlane(si, 48));
  return (a0 + a1) + (a2 + a3);
}
DI void phase_rwkv_scan(KP p, char* smem) {
  char* const ws = ows(p);
  const int tid = otid(), lane = tid & 63, wid = tid >> 6, sc = wid >> 2, w4 = wid & 3, r = lane & 31, h = lane >> 5;
  char* sb = smem + sc * C3_SCAN;
  bf16_t* Bt = (bf16_t*)(sb + C3_BT); bf16_t* Rt = (bf16_t*)(sb + C3_RT); bf16_t* Kt = (bf16_t*)(sb + C3_KT); bf16_t* Ct = (bf16_t*)(sb + C3_CT);
  bf16_t* KhT = (bf16_t*)(sb + C3_KHT); bf16_t* ChT = (bf16_t*)(sb + C3_CHT); bf16_t* Vt = (bf16_t*)(sb + C3_VT);
  bf16_t* GkbT = (bf16_t*)(sb + C3_GKB); bf16_t* GkrT = (bf16_t*)(sb + C3_GKR); bf16_t* GcrT = (bf16_t*)(sb + C3_GCR);
  bf16_t* S0b = (bf16_t*)(sb + C3_S0); bf16_t* Ub = (bf16_t*)(sb + C3_U);
  float* McbP = (float*)(sb + C3_MCB); float* Yb = (float*)(sb + C3_Y); float* Eb = (float*)(sb + C3_E); float* Tot = (float*)(sb + C3_TOT);
  char* U = ws + OFF_U;
  const bf16_t* Kx = (const bf16_t*)(U + U3_K);
  const bf16_t* Vx = (const bf16_t*)(U + U3_V);
  const bf16_t* Rx = (const bf16_t*)(U + U3_R);
  const int ti = w4 >> 1, tj = w4 & 1;
  const int tio = w4 & 1;
  const int sv = w4 * 16 + (lane >> 2), jq = lane & 3;
  for (int base = obid() * 2; base < 512; base += gridDim.x * 2) {
    const int item = base + sc, dir = item & 1, head = (item >> 1) & 15, b = item >> 5;
    const bf16_t* Ax = (const bf16_t*)(U + (dir ? U3_A1 : U3_A0));
    const bf16_t* Lx = (const bf16_t*)(U + (dir ? U3_LD1 : U3_LD0));
    bf16_t* Ox = (bf16_t*)(U + (dir ? U3_O1 : U3_O0));
    const int ch = head * 64 + lane;
    const float kkw = gin(p, 28)[ch], kaw = gin(p, 29)[ch];
    auto rowof = [&](int n) -> int {
      if (n < 256) { const int c = dir ? 255 - n : n; return TL + b * 256 + c; }
      const int s = dir ? 4095 - (n - 256) : n - 256; return b * 4096 + s;
    };
    f32x16 S;
#pragma unroll
    for (int i = 0; i < 16; ++i) S[i] = 0.f;
    for (int i = lane; i < 64 * C3_LDK / 4; i += 64) if (w4 == 0) ((unsigned long long*)S0b)[i] = 0ull;
    bf16_t pk_[8], pa_[8], pl_[8], pv_[8], pr_[8];
    auto prefetch = [&](int c) {
#pragma unroll
      for (int q = 0; q < 8; ++q) {
        const int n = c * C3_L + w4 * 8 + q;
        const size_t off = (size_t)rowof(n) * DM + ch;
        pk_[q] = Kx[off]; pa_[q] = Ax[off]; pl_[q] = Lx[off]; pv_[q] = Vx[off];
        pr_[q] = n >= 256 ? Rx[off] : (bf16_t)0;
      }
    };
    constexpr int NCH = 4352 / C3_L;
    prefetch(0);
    lds_bar();
    for (int c = 0; c < NCH; ++c) {
      float kkv[8], cv[8], kdv[8], lv[8], cl[8], rv[8], vv[8];
      {
        float run = 0.f;
#pragma unroll
        for (int q = 0; q < 8; ++q) {
          const float kv = bf2f(pk_[q]), av = bf2f(pa_[q]);
          lv[q] = bf2f(pl_[q]); rv[q] = bf2f(pr_[q]); vv[q] = bf2f(pv_[q]);
          const float kkr = kv * kkw;
          kkv[q] = kkr * __builtin_amdgcn_rsqf(fmaxf(wave_sum_dpp(kkr * kkr), 1e-24f));
          cv[q] = kkv[q] * av;
          kdv[q] = kv * (1.0f + (av - 1.0f) * kaw);
          run += lv[q]; cl[q] = run;
        }
        Tot[w4 * 64 + lane] = run;
      }
      if (c + 1 < NCH) prefetch(c + 1);
      lds_bar();
      {
        const float t0 = Tot[lane], t1 = Tot[64 + lane], t2 = Tot[128 + lane], t3 = Tot[192 + lane];
        const float cumL = (t0 + t1) + (t2 + t3);
        const float off = w4 == 0 ? 0.f : (w4 == 1 ? t0 : (w4 == 2 ? t0 + t1 : (t0 + t1) + t2));
        float kh[8], chh[8];
#pragma unroll
        for (int q = 0; q < 8; ++q) {
          const int t = w4 * 8 + q;
          const float cumt = off + cl[q], cump = cumt - lv[q];
          const float e1 = __expf(cump), e2 = __expf(cumt), e3 = __expf(-cumt), e4 = __expf(cumL - cumt);
          Bt[t * C3_LDK + lane] = f2bf(kkv[q] * e1);
          Rt[t * C3_LDK + lane] = f2bf(rv[q] * e2);
          Kt[t * C3_LDK + lane] = f2bf(kdv[q] * e3);
          Ct[t * C3_LDK + lane] = f2bf(cv[q] * e3);
          kh[q] = kdv[q] * e4; chh[q] = cv[q] * e4;
        }
        u32x4 w;
        w.x = pk2(kh[0], kh[1]); w.y = pk2(kh[2], kh[3]); w.z = pk2(kh[4], kh[5]); w.w = pk2(kh[6], kh[7]);
        *(u32x4*)(KhT + lane * C3_LDT + w4 * 8) = w;
        w.x = pk2(chh[0], chh[1]); w.y = pk2(chh[2], chh[3]); w.z = pk2(chh[4], chh[5]); w.w = pk2(chh[6], chh[7]);
        *(u32x4*)(ChT + lane * C3_LDT + w4 * 8) = w;
        w.x = pk2(vv[0], vv[1]); w.y = pk2(vv[2], vv[3]); w.z = pk2(vv[4], vv[5]); w.w = pk2(vv[6], vv[7]);
        *(u32x4*)(Vt + lane * C3_LDT + w4 * 8) = w;
        if (w4 == 0) Eb[lane] = __expf(cumL);
      }
      lds_bar();
      {
        const bf16_t* Ag = (w4 & 1) ? Kt : Ct;
        const bf16_t* Bg = (w4 & 2) ? Rt : Bt;
        f32x16 X;
#pragma unroll
        for (int i = 0; i < 16; ++i) X[i] = 0.f;
#pragma unroll
        for (int s = 0; s < 4; ++s) {
          const bf16x8 a = *(const bf16x8*)(Ag + r * C3_LDK + 16 * s + 8 * h);
          const bf16x8 bq = *(const bf16x8*)(Bg + r * C3_LDK + 16 * s + 8 * h);
          X = MFMA32(a, bq, X);
        }
        const bool incl = (w4 & 2) != 0;
#pragma unroll
        for (int i = 0; i < 16; ++i) { const int jr = (i & 3) + 8 * (i >> 2) + 4 * h; if (!(jr < r || (incl && jr == r))) X[i] = 0.f; }
        if (w4 == 0) {
#pragma unroll
          for (int i = 0; i < 16; ++i) { const int jr = (i & 3) + 8 * (i >> 2) + 4 * h; McbP[r * 32 + (jr & 3) * 8 + (jr >> 2)] = X[i]; }
        } else {
          bf16_t* G = w4 == 1 ? GkbT : (w4 == 2 ? GcrT : GkrT);
#pragma unroll
          for (int g = 0; g < 4; ++g) { u32x2 w; w.x = pk2(X[4 * g], X[4 * g + 1]); w.y = pk2(X[4 * g + 2], X[4 * g + 3]); *(u32x2*)(G + r * C3_LDT + 8 * g + 4 * h) = w; }
        }
      }
      lds_bar();
      f32x16 XO;
      {
        const bf16_t* Bq = (w4 & 2) ? Rt : Bt;
        const bf16_t* Gq = (w4 & 2) ? GkrT : GkbT;
#pragma unroll
        for (int i = 0; i < 16; ++i) XO[i] = 0.f;
#pragma unroll
        for (int s = 0; s < 4; ++s) {
          const bf16x8 a = *(const bf16x8*)(S0b + (32 * tio + r) * C3_LDK + 16 * s + 8 * h);
          const bf16x8 bq = *(const bf16x8*)(Bq + r * C3_LDK + 16 * s + 8 * h);
          XO = MFMA32(a, bq, XO);
        }
#pragma unroll
        for (int s = 0; s < 2; ++s) {
          const bf16x8 a = *(const bf16x8*)(Vt + (32 * tio + r) * C3_LDT + 16 * s + 8 * h);
          const bf16x8 bq = *(const bf16x8*)(Gq + r * C3_LDT + 16 * s + 8 * h);
          XO = MFMA32(a, bq, XO);
        }
        if (w4 < 2) {
#pragma unroll
          for (int i = 0; i < 16; ++i) Yb[(32 * tio + (i & 3) + 8 * (i >> 2) + 4 * h) * C3_LDY + r] = XO[i];
        }
      }
      lds_bar();
      {
        float u[8];
#pragma unroll
        for (int jj = 0; jj < 8; ++jj) u[jj] = 0.f;
        const unsigned ma = (unsigned)(size_t)(McbP + jq * 8);
        f32x4 yv[8];
#pragma unroll
        for (int i = 0; i < 8; ++i) yv[i] = *(const f32x4*)(Yb + sv * C3_LDY + 4 * i);
        f32x4 mA[4], mB[4];
#define C3_MLOAD(t_) asm volatile("ds_read_b128 %0, %2 offset:%c3\n\tds_read_b128 %1, %2 offset:%c4" : "=&v"(mA[(t_) & 3]), "=&v"(mB[(t_) & 3]) : "v"(ma), "i"((t_) * 128), "i"((t_) * 128 + 16) : "memory")
        C3_MLOAD(1); C3_MLOAD(2); C3_MLOAD(3);
        if (jq == 0) u[0] = yv[0][0];
#pragma unroll
        for (int t = 1; t < 32; ++t) {
          if (t + 3 < 32) { C3_MLOAD(t + 3); asm volatile("s_waitcnt lgkmcnt(6)" ::: "memory"); }
          else if (t + 2 < 32) asm volatile("s_waitcnt lgkmcnt(4)" ::: "memory");
          else if (t + 1 < 32) asm volatile("s_waitcnt lgkmcnt(2)" ::: "memory");
          else asm volatile("s_waitcnt lgkmcnt(0)" ::: "memory");
          asm volatile("" :: "v"(mA[t & 3]), "v"(mB[t & 3]));
          __builtin_amdgcn_sched_barrier(0);
          const f32x4 m0 = mA[t & 3], m1 = mB[t & 3];
          const int jl = (t - 1) >> 2;
          float part = 0.f;
#pragma unroll
          for (int jj = 0; jj < 8; ++jj) if (jj != jl && jj * 4 < t) part += u[jj] * (jj < 4 ? m0[jj] : m1[jj - 4]);
          part += u[jl] * (jl < 4 ? m0[jl] : m1[jl - 4]);
          part = DPP_ADD(part, 0xB1); part = DPP_ADD(part, 0x4E);
          const float ut = yv[t >> 2][t & 3] - part;
          u[t >> 2] = (jq == (t & 3)) ? ut : u[t >> 2];
        }
#undef C3_MLOAD
#pragma unroll
        for (int jj = 0; jj < 8; ++jj) Ub[sv * C3_LDT + jq + 4 * jj] = f2bf(u[jj]);
      }
      lds_bar();
      if (w4 >= 2) {
        f32x16 X2;
#pragma unroll
        for (int i = 0; i < 16; ++i) X2[i] = 0.f;
#pragma unroll
        for (int s = 0; s < 2; ++s) {
          const bf16x8 a = *(const bf16x8*)(Ub + (32 * tio + r) * C3_LDT + 16 * s + 8 * h);
          const bf16x8 bq = *(const bf16x8*)(GcrT + r * C3_LDT + 16 * s + 8 * h);
          X2 = MFMA32(a, bq, X2);
        }
        if (c * C3_L >= 256) {
          const size_t orow = (size_t)rowof(c * C3_L + r) * DM + head * 64 + 32 * tio + 4 * h;
#pragma unroll
          for (int g = 0; g < 4; ++g) {
            u32x2 w; w.x = pk2(XO[4 * g] - X2[4 * g], XO[4 * g + 1] - X2[4 * g + 1]); w.y = pk2(XO[4 * g + 2] - X2[4 * g + 2], XO[4 * g + 3] - X2[4 * g + 3]);
            *(u32x2*)(Ox + orow + 8 * g) = w;
          }
        }
      }
      {
        f32x16 P1, P2;
#pragma unroll
        for (int i = 0; i < 16; ++i) { P1[i] = 0.f; P2[i] = 0.f; }
#pragma unroll
        for (int s = 0; s < 2; ++s) {
          const bf16x8 av = *(const bf16x8*)(Vt + (32 * ti + r) * C3_LDT + 16 * s + 8 * h);
          const bf16x8 bk = *(const bf16x8*)(KhT + (32 * tj + r) * C3_LDT + 16 * s + 8 * h);
          P1 = MFMA32(av, bk, P1);
          const bf16x8 au = *(const bf16x8*)(Ub + (32 * ti + r) * C3_LDT + 16 * s + 8 * h);
          const bf16x8 bc = *(const bf16x8*)(ChT + (32 * tj + r) * C3_LDT + 16 * s + 8 * h);
          P2 = MFMA32(au, bc, P2);
        }
        const float ek = Eb[32 * tj + r];
#pragma unroll
        for (int i = 0; i < 16; ++i) {
          S[i] = S[i] * ek + P1[i] - P2[i];
          S0b[(32 * ti + (i & 3) + 8 * (i >> 2) + 4 * h) * C3_LDK + 32 * tj + r] = f2bf(S[i]);
        }
      }
      lds_bar();
    }
  }
}

DI void phase_rwkv_out(KP p, char* smem) {
  char* const ws = ows(p);
  const int lane = otid() & 63, wid = otid() >> 6;
  char* U = ws + OFF_U;
  const bf16_t *Rx = (const bf16_t*)(U + U3_R), *Kx = (const bf16_t*)(U + U3_K), *Vx = (const bf16_t*)(U + U3_V), *A0 = (const bf16_t*)(U + U3_A0),
               *A1 = (const bf16_t*)(U + U3_A1), *Gx = (const bf16_t*)(U + U3_G), *O0 = (const bf16_t*)(U + U3_O0), *O1 = (const bf16_t*)(U + U3_O1);
  bf16_t* Z = (bf16_t*)(ws + OFF_H);
  const int ch0 = lane * 16;
  float ka[16], rk[16], lw[16], lb[16];
#pragma unroll
  for (int j = 0; j < 16; ++j) { ka[j] = gin(p, 29)[ch0 + j]; rk[j] = gin(p, 30)[ch0 + j]; lw[j] = gin(p, 31)[ch0 + j]; lb[j] = gin(p, 32)[ch0 + j]; }
  auto ld16f = [&](const bf16_t* base, size_t off, float (&o)[16]) {
    const u32x4 a = ld16(base + off), b = ld16(base + off + 8);
    o[0] = bflo(a.x); o[1] = bfhi(a.x); o[2] = bflo(a.y); o[3] = bfhi(a.y); o[4] = bflo(a.z); o[5] = bfhi(a.z); o[6] = bflo(a.w); o[7] = bfhi(a.w);
    o[8] = bflo(b.x); o[9] = bfhi(b.x); o[10] = bflo(b.y); o[11] = bfhi(b.y); o[12] = bflo(b.z); o[13] = bfhi(b.z); o[14] = bflo(b.w); o[15] = bfhi(b.w);
  };
  for (int r = obid() * 8 + wid; r < TL; r += gridDim.x * 8) {
    const size_t off = (size_t)r * DM + ch0;
    float o0[16], o1[16], rr[16], kk[16], vv[16], a0[16], a1[16], gg[16];
    ld16f(O0, off, o0); ld16f(O1, off, o1); ld16f(Rx, off, rr); ld16f(Kx, off, kk); ld16f(Vx, off, vv); ld16f(A0, off, a0); ld16f(A1, off, a1); ld16f(Gx, off, gg);
    float s = 0.f, bs = 0.f;
#pragma unroll
    for (int j = 0; j < 16; ++j) {
      o0[j] += o1[j]; s += o0[j];
      const float kd0 = kk[j] * (1.0f + (a0[j] - 1.0f) * ka[j]), kd1 = kk[j] * (1.0f + (a1[j] - 1.0f) * ka[j]);
      bs += rr[j] * (kd0 + kd1) * rk[j];
    }
    s += __shfl_xor(s, 1); s += __shfl_xor(s, 2);
    bs += __shfl_xor(bs, 1); bs += __shfl_xor(bs, 2);
    const float mean = s * (1.0f / 64.0f);
    float q = 0.f;
#pragma unroll
    for (int j = 0; j < 16; ++j) { const float d = o0[j] - mean; q += d * d; }
    q += __shfl_xor(q, 1); q += __shfl_xor(q, 2);
    const float rstd = rsqrtf(q * (1.0f / 64.0f) + 64e-5f);
    float z[16];
#pragma unroll
    for (int j = 0; j < 16; ++j) z[j] = ((o0[j] - mean) * rstd * lw[j] + lb[j] + bs * vv[j]) * gg[j];
    u32x4 w0;
    w0.x = pk4_fp8(z[0] * O8_SCALE, z[1] * O8_SCALE, z[2] * O8_SCALE, z[3] * O8_SCALE); w0.y = pk4_fp8(z[4] * O8_SCALE, z[5] * O8_SCALE, z[6] * O8_SCALE, z[7] * O8_SCALE);
    w0.z = pk4_fp8(z[8] * O8_SCALE, z[9] * O8_SCALE, z[10] * O8_SCALE, z[11] * O8_SCALE); w0.w = pk4_fp8(z[12] * O8_SCALE, z[13] * O8_SCALE, z[14] * O8_SCALE, z[15] * O8_SCALE);
    *(u32x4*)((unsigned char*)Z + off) = w0;
  }
}

#define XB_TMO      128
#define XB_XCNT(j)  (256  + 64 * (j))
#define XB_XSUB(j)  (1280 + 64 * (j))
#define XB_XGEN(j)  (2304 + 64 * (j))
#define XB_TOP      3328
#define XB_TOPGEN   3392
#define XCD_BAR_WORDS 3456
#define XB_SPIN_CAP (1u << 22)
#define LAS __attribute__((address_space(3)))
__device__ __forceinline__ unsigned xb_ld(unsigned* p)              { return __hip_atomic_load(p, __ATOMIC_RELAXED, __HIP_MEMORY_SCOPE_AGENT); }
__device__ __forceinline__ unsigned xb_add(unsigned* p, unsigned v) { return __hip_atomic_fetch_add(p, v, __ATOMIC_RELAXED, __HIP_MEMORY_SCOPE_AGENT); }
__device__ __forceinline__ unsigned xb_xcc_id() { return (unsigned)__builtin_amdgcn_s_getreg((3 << 11) | 20) & 0xFu; }
#define XB_SPIN(cond, bar) do { unsigned _sp = 0; while (cond) { __builtin_amdgcn_s_sleep(1); \
    if ((++_sp & 255u) == 0u) { if (xb_ld(&(bar)[XB_TMO])) break; if (_sp > XB_SPIN_CAP) { atomicAdd(&(bar)[XB_TMO], 1u); break; } } } } while (0)
struct XcdBarrier { unsigned* bar; unsigned x; volatile LAS unsigned* st; };
__device__ __forceinline__ XcdBarrier xcd_barrier_post(unsigned* bar, volatile LAS unsigned* st) {
    XcdBarrier b; b.bar = bar; b.x = xb_xcc_id(); b.st = st;
    if (otid() == 0) (void)xb_add(&bar[XB_XCNT(b.x)], 1u);
    return b;
}
__device__ __forceinline__ void xcd_barrier_complete(unsigned* bar, unsigned x, unsigned& nloc, unsigned& nx) {
    const unsigned G = gridDim.x * gridDim.y * gridDim.z;
    unsigned sum, cnt, mine, sp = 0u;
    for (;;) {
        sum = 0u; cnt = 0u; mine = 0u;
#pragma unroll
        for (unsigned j = 0; j < 16; ++j) { const unsigned c = xb_ld(&bar[XB_XCNT(j)]); sum += c; cnt += (c > 0u) ? 1u : 0u; mine = (j == x) ? c : mine; }
        if (sum == G) break;
        __builtin_amdgcn_s_sleep(1);
        if ((++sp & 255u) == 0u) { if (xb_ld(&bar[XB_TMO])) break; if (sp > XB_SPIN_CAP) { atomicAdd(&bar[XB_TMO], 1u); break; } }
    }
    nloc = mine > 0u ? mine : 1u; nx = cnt > 0u ? cnt : 1u;
}
__device__ __forceinline__ void xcd_barrier(const XcdBarrier& b) {
    asm volatile("s_waitcnt vmcnt(0)" ::: "memory");
    __syncthreads();
    if (otid() == 0) {
        unsigned* bar = b.bar;
        __builtin_amdgcn_s_waitcnt(0);
        unsigned nloc = b.st[0], nx = b.st[1];
        if (nloc == 0u) { xcd_barrier_complete(bar, b.x, nloc, nx); b.st[0] = nloc; b.st[1] = nx; }
        const unsigned old = xb_add(&bar[XB_XSUB(b.x)], 1u);
        const unsigned gen = old / nloc;
        if (old + 1u == (gen + 1u) * nloc) {
            __builtin_amdgcn_fence(__ATOMIC_RELEASE, "agent");
            asm volatile("s_waitcnt vmcnt(0)" ::: "memory");
            const unsigned og = xb_add(&bar[XB_TOP], 1u);
            const unsigned tg = og / nx;
            if (og + 1u == (tg + 1u) * nx) xb_add(&bar[XB_TOPGEN], 1u);
            else XB_SPIN(xb_ld(&bar[XB_TOPGEN]) == tg, bar);
            __builtin_amdgcn_fence(__ATOMIC_ACQUIRE, "agent");
            xb_add(&bar[XB_XGEN(b.x)], 1u);
            asm volatile("s_waitcnt vmcnt(0)" ::: "memory");
        } else {
            XB_SPIN(xb_ld(&bar[XB_XGEN(b.x)]) == gen, bar);
            __builtin_amdgcn_fence(__ATOMIC_ACQUIRE, "agent");
            asm volatile("s_waitcnt vmcnt(0)" ::: "memory");
        }
    }
    __syncthreads();
}

DI void gbar(const XcdBarrier& b0) {
  XcdBarrier b = b0;
  unsigned long long pb = (unsigned long long)b.bar; asm volatile("" : "+s"(pb)); b.bar = (unsigned*)pb;
  unsigned x = b.x; asm volatile("" : "+s"(x)); b.x = x;
  xcd_barrier(b);
}

constexpr int cmaxi(int a, int b) { return a > b ? a : b; }
constexpr int FUSED_LDS = 256 + cmaxi(cmaxi(MOD_LDS, A1_LDS), cmaxi(cmaxi(SC_LDS, R2_LDS), FG_LDS + MOE_UMAX * 1024 + 256));
#ifndef PROBE_GROUP
#define PROBE_GROUP 0
#endif
#define PROBE(g, stmt) do { if constexpr (PROBE_GROUP == (g)) { stmt; gbar(bar); } } while (0)
template <int layer>
DI void run_layer(const XcdBarrier& bar, char* smem) {
  char* U = ows(kparams()) + OFF_U;
  const bf16_t* wm = (const bf16_t*)(ows(kparams()) + OFF_WMIX);
  if constexpr (layer == 0) phase_norm1<0, false, true>(kparams(), layer, smem); else phase_norm1<1, false, layer == 1>(kparams(), layer, smem);
  gbar(bar);
  PROBE(1, (phase_norm1<(layer == 0 ? 0 : 1), true, (layer <= 1)>(kparams(), layer, smem)));
  if constexpr (layer == 0) {
    phase_qkv_win8(kparams(), smem);
    gbar(bar);
    PROBE(3, phase_qkv_win8(kparams(), smem));
    phase_attn_win(kparams(), smem);
    gbar(bar);
    PROBE(4, phase_attn_win(kparams(), smem));
    phase_oproj8(kparams(), 0, U + U0_O, (const char*)(wm + W_WINO), TT, smem);
    gbar(bar);
    PROBE(3, (phase_oproj8<true>(kparams(), 0, U + U0_O, (const char*)(wm + W_WINO), TT, smem)));
  } else if constexpr (layer == 1) {
    phase_qkv_diff8(kparams(), smem);
    gbar(bar);
    PROBE(3, phase_qkv_diff8(kparams(), smem));
    phase_attn_diff(kparams(), smem);
    gbar(bar);
    PROBE(10, phase_attn_diff(kparams(), smem));
    phase_oproj8(kparams(), 1, U + U1_O, (const char*)(wm + W_DIFFO), TT, smem);
    gbar(bar);
    PROBE(3, (phase_oproj8<true>(kparams(), 1, U + U1_O, (const char*)(wm + W_DIFFO), TT, smem)));
  } else if constexpr (layer == 2) {
    phase_pool_pre(kparams(), smem);
    gbar(bar);
    PROBE(6, phase_pool_pre(kparams(), smem));
    phase_pool(kparams(), smem);
    gbar(bar);
    PROBE(6, phase_pool<true>(kparams(), smem));
  } else {
    phase_rwkv_mix(kparams(), smem);
    gbar(bar);
    PROBE(7, phase_rwkv_mix(kparams(), smem));
    phase_rwkv_rkv(kparams(), smem);
    __syncthreads();
    phase_rwkv_feat1(kparams(), smem);
    gbar(bar);
    PROBE(7, phase_rwkv_rkv(kparams(), smem));
    PROBE(8, phase_rwkv_feat1(kparams(), smem));
    phase_rwkv_feat2(kparams(), smem);
    gbar(bar);
    PROBE(8, phase_rwkv_feat2(kparams(), smem));
    phase_rwkv_scan(kparams(), smem);
    gbar(bar);
    PROBE(11, phase_rwkv_scan(kparams(), smem));
    phase_rwkv_out(kparams(), smem);
    gbar(bar);
    PROBE(9, phase_rwkv_out(kparams(), smem));
    phase_oproj8(kparams(), 3, ows(kparams()) + OFF_H, (const char*)(wm + W_RO), TL, smem);
    gbar(bar);
    PROBE(3, (phase_oproj8<true>(kparams(), 3, ows(kparams()) + OFF_H, (const char*)(wm + W_RO), TL, smem)));
  }
  phase_norm2_router(kparams(), layer, smem);
  __syncthreads();
  phase_cvt_moe(kparams(), layer, smem);
  gbar(bar);
  PROBE(2, phase_norm2_router<true>(kparams(), layer, smem));
  PROBE(5, phase_cvt_moe(kparams(), layer, smem));
  phase_moe_up(kparams(), layer, smem);
  gbar(bar);
  phase_moe_down(kparams(), layer, smem);
  gbar(bar);
  PROBE(12, phase_moe_up(kparams(), layer, smem));
  PROBE(12, phase_moe_down(kparams(), layer, smem));
}

__global__ __launch_bounds__(NTH, 2) void k_fused(Params p_unused) {
  extern __shared__ __attribute__((aligned(16))) char smem_all[];
  if (threadIdx.x == 0) *(uint4*)smem_all = make_uint4(0u, 0u, 0u, 0u);
  __syncthreads();
  XcdBarrier bar = xcd_barrier_post((unsigned*)(ows(kparams()) + OFF_BAR), (volatile LAS unsigned*)smem_all);
  char* smem = smem_all + 256;
  phase_cvt_mix(kparams(), smem);
  __syncthreads();
  phase_mod(kparams(), smem);
  gbar(bar);
  PROBE(5, phase_cvt_mix(kparams(), smem));
  PROBE(5, phase_mod(kparams(), smem));
  run_layer<0>(bar, smem);
  run_layer<1>(bar, smem);
  run_layer<2>(bar, smem);
  run_layer<3>(bar, smem);
  phase_norm1<3>(kparams(), 3, smem);
  PROBE(1, (gbar(bar), phase_norm1<3, true>(kparams(), 3, smem)));
}

static void fill_params(Params& p, void* const* d_in, void* d_out, void* d_ws) {
  for (int i = 0; i < 40; ++i) p.in[i] = (const float*)d_in[i];
  p.out = (float*)d_out;
  p.ws = (char*)d_ws;
  bf16_t* wm = (bf16_t*)(p.ws + OFF_WMIX);
  int nj = 0, item = 0;
  auto add = [&](const float* src, size_t dstoff, int K, int N, int ld, int dld = 0, int f8 = 0) {
    p.jobs[nj].src = src; p.jobs[nj].dst = wm + dstoff; p.jobs[nj].K = K; p.jobs[nj].N = N; p.jobs[nj].ld = ld; p.jobs[nj].item0 = item; p.jobs[nj].dld = dld ? dld : K; p.jobs[nj].pad_ = f8;
    item += (K / 64) * (N / 64); ++nj;
  };
  add(p.in[8], W_WINQKV, 1024, 1536, 1536, 0, 1);
  add(p.in[10], W_WINO, 1024, 1024, 1024, 0, 1);
  add(p.in[11], W_DIFFQKV, 1024, 3072, 3072, 0, 1);
  add(p.in[14], W_DIFFO, 1024, 1024, 1024, 0, 1);
  for (int g = 0; g < 4; ++g) add(p.in[15] + (size_t)g * 65536, W_POOL + (size_t)g * 65536, 256, 256, 256);
  add(p.in[19], W_R, 1024, 1024, 1024, 0, 1);
  add(p.in[19] + (size_t)1 * 1024 * 1024, W_K, 1024, 1024, 1024, 0, 1);
  add(p.in[19] + (size_t)2 * 1024 * 1024, W_V, 1024, 1024, 1024, 0, 1);
  for (int d = 0; d < 2; ++d) add(p.in[21] + (size_t)d * 1024 * 64, W_WA1 + (size_t)d * 64 * 1024, 1024, 64, 64);
  for (int d = 0; d < 2; ++d) add(p.in[24] + (size_t)d * 1024 * 64, W_AA1 + (size_t)d * 64 * 1024, 1024, 64, 64);
  add(p.in[26], W_G1, 1024, 128, 128);
  for (int d = 0; d < 2; ++d) add(p.in[22] + (size_t)d * 64 * 1024, W_WA2 + (size_t)d * 1024 * 128 + d * 64, 64, 1024, 1024, 128);
  for (int d = 0; d < 2; ++d) add(p.in[25] + (size_t)d * 64 * 1024, W_AA2 + (size_t)d * 1024 * 128 + d * 64, 64, 1024, 1024, 128);
  add(p.in[27], W_G2, 128, 1024, 1024);
  add(p.in[33], W_RO, 1024, 1024, 1024, 0, 1);
  p.njobs = nj; p.nitems = item;
}

extern "C" void kernel_launch(void* const* d_in, const int* in_sizes, int n_in, void* d_out, int out_size, void* d_ws, size_t ws_size, hipStream_t stream) {
  if (ws_size < WS_NEED || n_in < 40) return;
  Params p{};
  fill_params(p, d_in, d_out, d_ws);
  (void)hipMemsetAsync(p.ws, 0, 32768, stream);
  (void)hipMemsetAsync(p.ws + OFF_H8 + (size_t)TT * DM, 0, 8 * DM, stream);
  static int grid = 0;
  if (!grid) {
    int dev = 0, cus = 0, per_cu = 0;
    (void)hipGetDevice(&dev);
    (void)hipDeviceGetAttribute(&cus, hipDeviceAttributeMultiprocessorCount, dev);
    (void)hipFuncSetAttribute((const void*)k_fused, hipFuncAttributeMaxDynamicSharedMemorySize, FUSED_LDS);
    (void)hipOccupancyMaxActiveBlocksPerMultiprocessor(&per_cu, (const void*)k_fused, NTH, FUSED_LDS);
    grid = cus * (per_cu < 1 ? per_cu : 1);
  }
  if (grid <= 0) return;
  hipLaunchKernelGGL(k_fused, dim3(grid), dim3(NTH), FUSED_LDS, stream, p);
}
```

```cpp
#include <hip/hip_runtime.h>
#include <stdint.h>
#include <stddef.h>

typedef unsigned short bf16_t;
typedef short bf16x8 __attribute__((ext_vector_type(8)));
typedef short s16x4 __attribute__((ext_vector_type(4)));
typedef float f32x4 __attribute__((ext_vector_type(4)));
typedef float f32x16 __attribute__((ext_vector_type(16)));
typedef unsigned u32x4 __attribute__((ext_vector_type(4)));
typedef unsigned u32x2 __attribute__((ext_vector_type(2)));
typedef float f32x2 __attribute__((ext_vector_type(2)));
#define DI __device__ __forceinline__

constexpr int DM = 1024, NBATCH = 16, SEQ = 4096, CTX = 256;
constexpr int TL = NBATCH * SEQ, TC = NBATCH * CTX, TT = TL + TC;
constexpr int NTH = 512;
constexpr int MOE_PAD = 256;
constexpr int MOE_ROWS = 2 * TT + 32 * MOE_PAD;
constexpr int CAP = TT;

constexpr size_t al256(size_t x) { return (x + 255) & ~(size_t)255; }
constexpr size_t OFF_BAR = 0;
constexpr size_t OFF_CNT = 16384;
constexpr size_t OFF_MOD = 32768;
constexpr size_t OFF_ROPE = al256(OFF_MOD + (size_t)4 * 17 * 6144 * 4);
constexpr size_t OFF_XB = al256(OFF_ROPE + 2 * 64 * 16 * 4);
constexpr size_t OFF_H = al256(OFF_XB + (size_t)TT * DM * 2);
constexpr size_t OFF_H8 = al256(OFF_H + (size_t)(TT + 8) * DM * 2);
constexpr size_t OFF_TOK = al256(OFF_H8 + (size_t)(TT + 8) * DM);
constexpr size_t OFF_ROWL = al256(OFF_TOK + (size_t)TT * 32);
constexpr size_t OFF_WMIX = al256(OFF_ROWL + (size_t)32 * CAP * 4);
constexpr size_t W_WINQKV = 0;
constexpr size_t W_WINO = W_WINQKV + (size_t)1536 * 1024;
constexpr size_t W_DIFFQKV = W_WINO + (size_t)1024 * 1024;
constexpr size_t W_DIFFO = W_DIFFQKV + (size_t)3072 * 1024;
constexpr size_t W_POOL = W_DIFFO + (size_t)1024 * 1024;
constexpr size_t W_R = W_POOL + (size_t)4 * 256 * 256;
constexpr size_t W_K = W_R + (size_t)1024 * 1024;
constexpr size_t W_V = W_K + (size_t)1024 * 1024;
constexpr size_t W_WA1 = W_V + (size_t)1024 * 1024;
constexpr size_t W_AA1 = W_WA1 + (size_t)128 * 1024;
constexpr size_t W_G1 = W_AA1 + (size_t)128 * 1024;
constexpr size_t W_WA2 = W_G1 + (size_t)128 * 1024;
constexpr size_t W_AA2 = W_WA2 + (size_t)2048 * 128;
constexpr size_t W_G2 = W_AA2 + (size_t)2048 * 128;
constexpr size_t W_RO = W_G2 + (size_t)1024 * 128;
constexpr size_t W_MIX_END = W_RO + (size_t)1024 * 1024;
constexpr size_t OFF_WR = al256(OFF_WMIX + W_MIX_END * 2);
constexpr size_t OFF_WMOE = al256(OFF_WR + (size_t)4 * 2 * 48 * 1024 * 2);
constexpr size_t WMOE_DOWN = (size_t)32 * 1024 * 1024;
constexpr size_t OFF_U = al256(OFF_WMOE + ((size_t)32 * 1024 * 1024 + (size_t)32 * 1024 * 512) * 2);
constexpr size_t SZ_TT = (size_t)TT * DM * 2, SZ_TL = (size_t)TL * DM * 2;
constexpr size_t U0_Q = 0, U0_K = U0_Q + SZ_TT, U0_V = U0_K + (size_t)TT * 256 * 2, U0_O = U0_V + (size_t)TT * 256 * 2, U0_END = U0_O + SZ_TT;
constexpr size_t U1_Q = 0, U1_K = U1_Q + SZ_TT, U1_V = U1_K + SZ_TT, U1_O = U1_V + SZ_TT, U1_END = U1_O + SZ_TT;
constexpr size_t U2_Y = 0, U2_END = SZ_TT;
constexpr size_t U3_R = 0, U3_K = U3_R + SZ_TL, U3_V = U3_K + SZ_TT, U3_A0 = U3_V + SZ_TT, U3_A1 = U3_A0 + SZ_TT, U3_LD0 = U3_A1 + SZ_TT,
                 U3_LD1 = U3_LD0 + SZ_TT, U3_LW = U3_LD1 + SZ_TT, U3_LA = U3_LW + (size_t)TT * 128 * 2, U3_LG = U3_LA + (size_t)TT * 128 * 2,
                 U3_G = U3_LG + (size_t)TL * 128 * 2, U3_O0 = U3_G + SZ_TL, U3_O1 = U3_O0 + SZ_TL, U3_END = U3_O1 + SZ_TL;
constexpr size_t U3_XR = U3_A0, U3_XK = U3_A1, U3_XV = U3_LD0;
constexpr size_t UM_ACT = 0, UM_YB = UM_ACT + (size_t)MOE_ROWS * 512 * 2, UM_END = UM_YB + (size_t)MOE_ROWS * 1024 * 2;
constexpr size_t cmax(size_t a, size_t b) { return a > b ? a : b; }
constexpr size_t U_SIZE = cmax(cmax(cmax(U0_END, U1_END), U2_END), cmax(U3_END, UM_END));
constexpr size_t WS_NEED = OFF_U + U_SIZE;

struct CvtJob { const float* src; bf16_t* dst; int K, N, ld, item0, dld, pad_; };
constexpr int NJOBS = 24;
struct Params {
  const float* in[40];
  float* out;
  char* ws;
  CvtJob jobs[NJOBS];
  int njobs, nitems;
};

typedef const __attribute__((address_space(4))) Params* KP;
DI KP kparams() { KP q = (KP)__builtin_amdgcn_kernarg_segment_ptr(); asm volatile("" : "+s"(q)); return q; }
DI char* ows(KP p) {
  const unsigned long long w = (unsigned long long)p->ws;
  unsigned lo = (unsigned)w, hi = (unsigned)(w >> 32);
  asm volatile("" : "+v"(lo), "+v"(hi));
  lo = __builtin_amdgcn_readfirstlane(lo); hi = __builtin_amdgcn_readfirstlane(hi);
  return (char*)(__attribute__((address_space(1))) char*)(((unsigned long long)hi << 32) | lo);
}
DI const float* gin(KP p, int i) { return (const float*)(__attribute__((address_space(1))) const float*)p->in[i]; }
DI float* gout(KP p) { return (float*)(__attribute__((address_space(1))) float*)p->out; }
DI int otid() { int t = threadIdx.x; asm volatile("" : "+v"(t)); return t; }
DI int obid() { int b = blockIdx.x; asm volatile("" : "+s"(b)); return b; }
DI unsigned pk2(float lo, float hi) {
  typedef __bf16 bf2 __attribute__((ext_vector_type(2)));
  typedef float f2 __attribute__((ext_vector_type(2)));
  f2 v = {lo, hi};
  return __builtin_bit_cast(unsigned, __builtin_convertvector(v, bf2));
}
DI float clamp8(float x) { return __builtin_amdgcn_fmed3f(x, -440.0f, 440.0f); }
DI void swap32(float x, float& a, float& b) {
  a = x; b = x;
  asm volatile("s_nop 1\n\tv_permlane32_swap_b32 %0, %1\n\ts_nop 1" : "+v"(a), "+v"(b));
}
DI unsigned pk4_fp8_nc(float a, float b, float c, float d) { int w; asm("" : "=v"(w)); w = __builtin_amdgcn_cvt_pk_fp8_f32(a, b, w, false); w = __builtin_amdgcn_cvt_pk_fp8_f32(c, d, w, true); return (unsigned)w; }
DI unsigned pk4_fp8(float a, float b, float c, float d) { int w = __builtin_amdgcn_cvt_pk_fp8_f32(clamp8(a), clamp8(b), 0, false); w = __builtin_amdgcn_cvt_pk_fp8_f32(clamp8(c), clamp8(d), w, true); return (unsigned)w; }
DI bf16_t f2bf(float x) { return (bf16_t)(pk2(x, 0.f) & 0xffffu); }
DI float bf2f(bf16_t b) { return __uint_as_float(((unsigned)b) << 16); }
DI float bflo(unsigned u) { return __uint_as_float(u << 16); }
DI float bfhi(unsigned u) { return __uint_as_float(u & 0xffff0000u); }
DI float wave_sum(float v) {
#pragma unroll
  for (int o = 32; o >= 1; o >>= 1) v += __shfl_xor(v, o);
  return v;
}
DI float sigmoidf_(float x) { return __builtin_amdgcn_rcpf(1.0f + __expf(-x)); }
DI int row_bi(int r) { return r < TL ? (r >> 12) : 16; }
DI bf16_t* xrow_ptr(KP p, char* ws, int r) { return (bf16_t*)(ws + OFF_XB) + (size_t)r * DM; }
DI f32x4 ldbf4(const bf16_t* q) { const u32x2 w = *(const u32x2*)q; return (f32x4){bflo(w.x), bfhi(w.x), bflo(w.y), bfhi(w.y)}; }
DI void stbf4(bf16_t* q, const f32x4& v) { u32x2 w; w.x = pk2(v[0], v[1]); w.y = pk2(v[2], v[3]); *(u32x2*)q = w; }
DI const float* modp(char* ws, int layer, int bi, int which) { return (const float*)(ws + OFF_MOD) + ((size_t)(layer * 17 + bi) * 6 + which) * DM; }
#define MFMA16(a, b, c) __builtin_amdgcn_mfma_f32_16x16x32_bf16((a), (b), (c), 0, 0, 0)
#define MFMA32(a, b, c) __builtin_amdgcn_mfma_f32_32x32x16_bf16((a), (b), (c), 0, 0, 0)

constexpr int SGLD = 72;
constexpr int SG_LDS = 2 * 128 * SGLD * 2;
template <class AL, class BL, class EP>
DI void sgemm_tile(char* smem, int K, AL la, BL lb, EP ep) {
  bf16_t* sA = (bf16_t*)smem;
  bf16_t* sB = sA + 128 * SGLD;
  const int tid = otid(), lane = tid & 63, wid = tid >> 6, wr = wid >> 2, wc = wid & 3, fr = lane & 15, fq = lane >> 4;
  f32x4 acc[4][2];
#pragma unroll
  for (int m = 0; m < 4; ++m)
#pragma unroll
    for (int n = 0; n < 2; ++n) acc[m][n] = (f32x4){0.f, 0.f, 0.f, 0.f};
  const int r_ = tid >> 3, k_ = (tid & 7) * 8;
  u32x4 ra0 = la(r_, k_), ra1 = la(r_ + 64, k_), rb0 = lb(r_, k_), rb1 = lb(r_ + 64, k_);
  const int nk = K >> 6;
  for (int kt = 0; kt < nk; ++kt) {
    __syncthreads();
    *(u32x4*)(sA + r_ * SGLD + k_) = ra0;
    *(u32x4*)(sA + (r_ + 64) * SGLD + k_) = ra1;
    *(u32x4*)(sB + r_ * SGLD + k_) = rb0;
    *(u32x4*)(sB + (r_ + 64) * SGLD + k_) = rb1;
    __syncthreads();
    if (kt + 1 < nk) {
      const int kk = (kt + 1) * 64 + k_;
      ra0 = la(r_, kk); ra1 = la(r_ + 64, kk); rb0 = lb(r_, kk); rb1 = lb(r_ + 64, kk);
    }
#pragma unroll
    for (int ks = 0; ks < 2; ++ks) {
      bf16x8 af[4], bq[2];
#pragma unroll
      for (int m = 0; m < 4; ++m) af[m] = *(const bf16x8*)(sA + (wr * 64 + m * 16 + fr) * SGLD + ks * 32 + fq * 8);
#pragma unroll
      for (int n = 0; n < 2; ++n) bq[n] = *(const bf16x8*)(sB + (wc * 32 + n * 16 + fr) * SGLD + ks * 32 + fq * 8);
#pragma unroll
      for (int m = 0; m < 4; ++m)
#pragma unroll
        for (int n = 0; n < 2; ++n) acc[m][n] = MFMA16(af[m], bq[n], acc[m][n]);
    }
  }
  ep(acc, wr * 64, wc * 32, fr, fq);
}
DI u32x4 ld16(const bf16_t* p) { return *(const u32x4*)p; }

#define LAS __attribute__((address_space(3)))
namespace fg {
typedef int v8i_t __attribute__((ext_vector_type(8)));
typedef int v4i_t __attribute__((ext_vector_type(4)));
constexpr int BM = 256, BK = 64, HALF = 128, HTB = HALF * BK * 2, STAGE_BYTES = 8 * HTB, NXCD = 8, WGM = 8;
DI int lds_byte(int r, int c) { const int st = (r >> 4) * 2 + (c >> 5), rr = r & 15, cc = c & 31, ob = rr * 64 + cc * 2; return st * 1024 + (ob ^ (((ob >> 9) & 1) << 5)); }
DI void stage_rc(int b, int& R, int& C) { const int st = b / 1024, sb = b % 1024, swz = sb ^ (((sb >> 9) & 1) << 5); R = (st >> 1) * 16 + swz / 64; C = (st & 1) * 32 + (swz % 64) / 2; }
struct Unit { const char* A; const char* B; int pm, pn, aux; };
DI bool static_order(int i, int G, int c, int nM, int nN, int& pm, int& pn) {
  const int nwg = nM * nN;
  const long L = (long)i * G + c; if (L >= nwg) return false;
  int wgid = (int)L; { const int q = nwg / NXCD, r = nwg % NXCD, xcd = wgid % NXCD, off = wgid / NXCD; wgid = (xcd < r ? xcd * (q + 1) : r * (q + 1) + (xcd - r) * q) + off; }
  const int nig = WGM * nN, gid = wgid / nig, fm = gid * WGM, gsz = (nM - fm) < WGM ? (nM - fm) : WGM;
  pm = fm + ((wgid % nig) % gsz); pn = (wgid % nig) / gsz; return true;
}
struct DenseSched {
  const char* A; const char* B; int nM, nN, G, c; size_t tA, tB;
  DI bool next(int i, Unit& u) const { int pm, pn; if (!static_order(i, G, c, nM, nN, pm, pn)) return false; u.pm = pm; u.pn = pn; u.aux = 0; u.A = A + (size_t)pm * tA; u.B = B + (size_t)pn * tB; return true; }
  DI const LAS int* rows(int) const { return nullptr; }
};

DI int perm32(int rho) { const int n = rho >> 4, i = rho & 15; return 8 * (i >> 2) + 4 * n + (i & 3); }
template <bool GATHER, bool PERM = false, class Epi, class Sched>
DI void gemm_phase(LAS unsigned char* lds, const int K, const int lda, const int ldb, const Sched& S, const Epi& E) {
  const int tid = otid(), wid = __builtin_amdgcn_readfirstlane(tid >> 6), lane = tid & 63, wr = wid >> 2, wc = wid & 3, fr = lane & 15, fq = lane >> 4;
  const int nt = K / BK;
  unsigned voffA[2], voffB[2]; int sR[2], sC[2];
#pragma unroll
  for (int i = 0; i < 2; ++i) { int R, C; stage_rc(tid * 16 + i * 8192, R, C); sR[i] = R; sC[i] = C; voffA[i] = (unsigned)(R * lda + C) * 2u; const int Rb = PERM ? ((R & ~31) + perm32(R & 31)) : R; voffB[i] = (unsigned)(Rb * ldb + C) * 2u; }
  const size_t kstep = (size_t)(BK * 2), hstepA = (size_t)HALF * lda * 2, hstepB = (size_t)HALF * ldb * 2;
  const unsigned ldsw = (unsigned)wid * 1024u;
  const int aoff = lds_byte(wr * 64 + fr, fq * 8), boff = lds_byte(wc * 32 + fr, fq * 8);
#define FG_SA(b, h) (((b) * 2 + (h)) * HTB)
#define FG_SB(b, h) ((4 + (b) * 2 + (h)) * HTB)
#define FG_GLDS(gp, bufoff, i_) __builtin_amdgcn_global_load_lds((const unsigned*)(gp), (LAS unsigned*)(lds + (bufoff) + ldsw + (i_) * 8192), 16, 0, 0)
#define FG_STAGE_B(bufoff, gbase) do { const char* _gb = (gbase); FG_GLDS(_gb + voffB[0], bufoff, 0); FG_GLDS(_gb + voffB[1], bufoff, 1); } while (0)
#define FG_STAGE_A(bufoff, NX, H, KB) do { \
    if constexpr (GATHER) { const char* _gb = ((NX) ? nA : cA) + (KB); FG_GLDS(_gb + ((NX) ? gn[H][0] : gc[H][0]), bufoff, 0); FG_GLDS(_gb + ((NX) ? gn[H][1] : gc[H][1]), bufoff, 1); } \
    else { const char* _gb = ((NX) ? nA : cA) + (size_t)(H) * hstepA + (KB); FG_GLDS(_gb + voffA[0], bufoff, 0); FG_GLDS(_gb + voffA[1], bufoff, 1); } } while (0)
#define FG_LDA(dst, b, h) do { _Pragma("unroll") for (int m = 0; m < 4; ++m) _Pragma("unroll") for (int k = 0; k < 2; ++k) dst[m][k] = *(const LAS bf16x8*)(lds + FG_SA(b, h) + aoff + m * 2048 + k * 1024); } while (0)
#define FG_LDB(dst, b, h) do { _Pragma("unroll") for (int n = 0; n < 2; ++n) _Pragma("unroll") for (int k = 0; k < 2; ++k) dst[n][k] = *(const LAS bf16x8*)(lds + FG_SB(b, h) + boff + n * 2048 + k * 1024); } while (0)
#define FG_MMA(ai, bj, At, Bt) do { __builtin_amdgcn_s_setprio(1); _Pragma("unroll") for (int m = 0; m < 4; ++m) _Pragma("unroll") for (int n = 0; n < 2; ++n) _Pragma("unroll") for (int k = 0; k < 2; ++k) \
    acc[ai][bj][m][n] = __builtin_amdgcn_mfma_f32_16x16x32_bf16(Bt[n][k], At[m][k], acc[ai][bj][m][n], 0, 0, 0); __builtin_amdgcn_s_setprio(0); } while (0)
#define FG_WAIT_V(n) asm volatile("s_waitcnt vmcnt(" #n ")" ::: "memory")
#define FG_WAIT_L(n) asm volatile("s_waitcnt lgkmcnt(" #n ")" ::: "memory")
#define FG_BAR __builtin_amdgcn_s_barrier()
#define FG_SCHED __builtin_amdgcn_sched_barrier(0)
  Unit cur, nxt; int ui = 0;
  if (!S.next(0, cur)) return;
  f32x4 acc[2][2][4][2];
#pragma unroll
  for (int a = 0; a < 2; ++a)
#pragma unroll
    for (int b = 0; b < 2; ++b)
#pragma unroll
      for (int m = 0; m < 4; ++m)
#pragma unroll
        for (int n = 0; n < 2; ++n) acc[a][b][m][n] = (f32x4){0.f, 0.f, 0.f, 0.f};
  bf16x8 At[4][2], B0[2][2], B1[2][2];
  const char* cA = cur.A; const char* cB = cur.B;
  const char* nA = cA; const char* nB = cB;
  unsigned gc[2][2] = {{0u, 0u}, {0u, 0u}}, gn[2][2] = {{0u, 0u}, {0u, 0u}};
  if constexpr (GATHER) {
    const LAS int* rw = S.rows(0);
#pragma unroll
    for (int h = 0; h < 2; ++h)
#pragma unroll
      for (int i = 0; i < 2; ++i) { gc[h][i] = (unsigned)(rw[h * HALF + sR[i]] * lda + sC[i]) * 2u; gn[h][i] = gc[h][i]; }
  }
  FG_STAGE_B(FG_SB(0, 0), cB); FG_STAGE_B(FG_SB(0, 1), cB + hstepB); FG_STAGE_A(FG_SA(0, 0), false, 0, 0); FG_STAGE_A(FG_SA(0, 1), false, 1, 0);
  if (wr == 1) FG_BAR;
  FG_WAIT_V(2); FG_BAR;
  FG_STAGE_B(FG_SB(1, 0), cB + kstep); FG_STAGE_A(FG_SA(1, 0), false, 0, kstep); FG_STAGE_B(FG_SB(1, 1), cB + hstepB + kstep);
  FG_WAIT_V(6); FG_BAR;
  for (;;) {
    const bool has_next = S.next(ui + 1, nxt);
    nA = has_next ? nxt.A : cA; nB = has_next ? nxt.B : cB;
    if constexpr (GATHER) {
      if (has_next) {
        const LAS int* rw = S.rows(ui + 1);
#pragma unroll
        for (int h = 0; h < 2; ++h)
#pragma unroll
          for (int i = 0; i < 2; ++i) gn[h][i] = (unsigned)(rw[h * HALF + sR[i]] * lda + sC[i]) * 2u;
      } else {
#pragma unroll
        for (int h = 0; h < 2; ++h)
#pragma unroll
          for (int i = 0; i < 2; ++i) gn[h][i] = gc[h][i];
      }
      FG_WAIT_L(0);
    }
    for (int t = 0; t < nt; t += 2) {
      const bool last = (t == nt - 2);
      const size_t k1 = (size_t)(t + 1) * kstep;
      const size_t k2 = last ? 0 : (size_t)(t + 2) * kstep, k3 = k2 + kstep;
      const char* b2 = last ? nB : cB + (size_t)(t + 2) * kstep; const char* b3 = b2 + kstep;
      FG_LDB(B0, 0, 0); FG_LDB(B1, 0, 1); FG_SCHED; FG_LDA(At, 0, 0); FG_STAGE_A(FG_SA(1, 1), false, 1, k1);
      FG_WAIT_V(8); FG_WAIT_L(0); FG_BAR; FG_MMA(0, 0, At, B0); FG_MMA(0, 1, At, B1); FG_BAR; FG_SCHED;
      FG_LDA(At, 0, 1); FG_STAGE_B(FG_SB(0, 0), b2); FG_STAGE_B(FG_SB(0, 1), b2 + hstepB); FG_STAGE_A(FG_SA(0, 0), last, 0, k2);
      FG_WAIT_V(8); FG_WAIT_L(0); FG_BAR; FG_MMA(1, 0, At, B0); FG_MMA(1, 1, At, B1); FG_BAR; FG_SCHED;
      FG_LDB(B0, 1, 0); FG_LDB(B1, 1, 1); FG_SCHED; FG_LDA(At, 1, 0); FG_STAGE_A(FG_SA(0, 1), last, 1, k2);
      FG_WAIT_V(8); FG_WAIT_L(0); FG_BAR; FG_MMA(0, 0, At, B0); FG_MMA(0, 1, At, B1); FG_BAR; FG_SCHED;
      FG_LDA(At, 1, 1); FG_STAGE_B(FG_SB(1, 0), b3); FG_STAGE_B(FG_SB(1, 1), b3 + hstepB); FG_STAGE_A(FG_SA(1, 0), last, 0, k3);
      FG_WAIT_V(8); FG_WAIT_L(0); FG_BAR; FG_MMA(1, 0, At, B0); FG_MMA(1, 1, At, B1); FG_BAR; FG_SCHED;
    }
    if (wr == 0) FG_BAR;
    E(acc, cur, wr, wc, fr, fq);
    if (!has_next) break;
#pragma unroll
    for (int a = 0; a < 2; ++a)
#pragma unroll
      for (int b = 0; b < 2; ++b)
#pragma unroll
        for (int m = 0; m < 4; ++m)
#pragma unroll
          for (int n = 0; n < 2; ++n) acc[a][b][m][n] = (f32x4){0.f, 0.f, 0.f, 0.f};
    cur = nxt; cA = nA; cB = nB; ++ui;
    if constexpr (GATHER) {
#pragma unroll
      for (int h = 0; h < 2; ++h)
#pragma unroll
        for (int i = 0; i < 2; ++i) gc[h][i] = gn[h][i];
    }
    if (wr == 1) FG_BAR;
  }
  FG_WAIT_V(0);
  FG_BAR;
#undef FG_SA
#undef FG_SB
#undef FG_GLDS
#undef FG_STAGE_A
#undef FG_STAGE_B
#undef FG_LDA
#undef FG_LDB
#undef FG_MMA
#undef FG_WAIT_V
#undef FG_WAIT_L
#undef FG_BAR
#undef FG_SCHED
}
DI int perm32f8(int s_) { return 16 * ((s_ >> 2) & 1) + (s_ & 3) + 4 * (s_ >> 3); }
template <bool GATHER, bool PERM = false, class Epi, class Sched>
DI void gemm_phase_f8(LAS unsigned char* lds, const int K, const int lda, const int ldb, const Sched& S, const Epi& E) {
  const int tid = otid(), wid = __builtin_amdgcn_readfirstlane(tid >> 6), lane = tid & 63, wr = wid >> 2, wc = wid & 3, fr = lane & 15, fq = lane >> 4;
  const int nt = K / BK;
  unsigned voffA[2], voffB[2]; int sR[2], sC[2];
#pragma unroll
  for (int i = 0; i < 2; ++i) { int R, C; stage_rc(tid * 16 + i * 8192, R, C); sR[i] = R; sC[i] = C; voffA[i] = (unsigned)(R * lda + C) * 2u; const int Rb = PERM ? ((R & ~31) + perm32f8(R & 31)) : R; voffB[i] = (unsigned)(Rb * ldb + C) * 2u; }
  const size_t kstep = (size_t)(BK * 2), hstepA = (size_t)HALF * lda * 2, hstepB = (size_t)HALF * ldb * 2;
  const unsigned ldsw = (unsigned)wid * 1024u;
  const int r32 = lane & 31, g32 = lane >> 5;
  const int aoff = lds_byte(wr * 64 + r32, 16 * g32), boff = lds_byte(wc * 32 + r32, 16 * g32);
#define FG_SA(b, h) (((b) * 2 + (h)) * HTB)
#define FG_SB(b, h) ((4 + (b) * 2 + (h)) * HTB)
#define FG_GLDS(gp, bufoff, i_) __builtin_amdgcn_global_load_lds((const unsigned*)(gp), (LAS unsigned*)(lds + (bufoff) + ldsw + (i_) * 8192), 16, 0, 0)
#define FG_STAGE_B(bufoff, gbase) do { const char* _gb = (gbase); FG_GLDS(_gb + voffB[0], bufoff, 0); FG_GLDS(_gb + voffB[1], bufoff, 1); } while (0)
#define FG_STAGE_A(bufoff, NX, H, KB) do { \
    if constexpr (GATHER) { const char* _gb = ((NX) ? nA : cA) + (KB); FG_GLDS(_gb + ((NX) ? gn[H][0] : gc[H][0]), bufoff, 0); FG_GLDS(_gb + ((NX) ? gn[H][1] : gc[H][1]), bufoff, 1); } \
    else { const char* _gb = ((NX) ? nA : cA) + (size_t)(H) * hstepA + (KB); FG_GLDS(_gb + voffA[0], bufoff, 0); FG_GLDS(_gb + voffA[1], bufoff, 1); } } while (0)
#define FG_LDA(dst, b, h) do { _Pragma("unroll") for (int m = 0; m < 2; ++m) _Pragma("unroll") for (int k = 0; k < 2; ++k) { const LAS v4i_t* q_ = (const LAS v4i_t*)(lds + FG_SA(b, h) + aoff + m * 4096 + k * 1024); dst[m][k] = __builtin_shufflevector(q_[0], q_[1], 0, 1, 2, 3, 4, 5, 6, 7); } } while (0)
#define FG_LDB(dst, b, h) do { _Pragma("unroll") for (int k = 0; k < 2; ++k) { const LAS v4i_t* q_ = (const LAS v4i_t*)(lds + FG_SB(b, h) + boff + k * 1024); dst[k] = __builtin_shufflevector(q_[0], q_[1], 0, 1, 2, 3, 4, 5, 6, 7); } } while (0)
#define FG_MMA(ai, bj, At, Bt) do { __builtin_amdgcn_s_setprio(1); _Pragma("unroll") for (int m = 0; m < 2; ++m) _Pragma("unroll") for (int k = 0; k < 2; ++k) \
    acc[ai][bj][m] = __builtin_amdgcn_mfma_scale_f32_32x32x64_f8f6f4(Bt[k], At[m][k], acc[ai][bj][m], 0, 0, 0, 0x7f7f7f7f, 0, 0x7f7f7f7f); __builtin_amdgcn_s_setprio(0); } while (0)
#define FG_WAIT_V(n) asm volatile("s_waitcnt vmcnt(" #n ")" ::: "memory")
#define FG_WAIT_L(n) asm volatile("s_waitcnt lgkmcnt(" #n ")" ::: "memory")
#define FG_BAR __builtin_amdgcn_s_barrier()
#define FG_SCHED __builtin_amdgcn_sched_barrier(0)
  Unit cur, nxt; int ui = 0;
  if (!S.next(0, cur)) return;
  f32x16 acc[2][2][2];
#pragma unroll
  for (int a = 0; a < 2; ++a)
#pragma unroll
    for (int b = 0; b < 2; ++b)
#pragma unroll
      for (int m = 0; m < 2; ++m)
#pragma unroll
        for (int n = 0; n < 16; ++n) acc[a][b][m][n] = 0.f;
  v8i_t At[2][2], B0[2], B1[2];
  const char* cA = cur.A; const char* cB = cur.B;
  const char* nA = cA; const char* nB = cB;
  unsigned gc[2][2] = {{0u, 0u}, {0u, 0u}}, gn[2][2] = {{0u, 0u}, {0u, 0u}};
  if constexpr (GATHER) {
    const LAS int* rw = S.rows(0);
#pragma unroll
    for (int h = 0; h < 2; ++h)
#pragma unroll
      for (int i = 0; i < 2; ++i) { gc[h][i] = (unsigned)(rw[h * HALF + sR[i]] * lda + sC[i]) * 2u; gn[h][i] = gc[h][i]; }
  }
  FG_STAGE_B(FG_SB(0, 0), cB); FG_STAGE_B(FG_SB(0, 1), cB + hstepB); FG_STAGE_A(FG_SA(0, 0), false, 0, 0); FG_STAGE_A(FG_SA(0, 1), false, 1, 0);
  if (wr == 1) FG_BAR;
  FG_WAIT_V(2); FG_BAR;
  FG_STAGE_B(FG_SB(1, 0), cB + kstep); FG_STAGE_A(FG_SA(1, 0), false, 0, kstep); FG_STAGE_B(FG_SB(1, 1), cB + hstepB + kstep);
  FG_WAIT_V(6); FG_BAR;
  for (;;) {
    const bool has_next = S.next(ui + 1, nxt);
    nA = has_next ? nxt.A : cA; nB = has_next ? nxt.B : cB;
    if constexpr (GATHER) {
      if (has_next) {
        const LAS int* rw = S.rows(ui + 1);
#pragma unroll
        for (int h = 0; h < 2; ++h)
#pragma unroll
          for (int i = 0; i < 2; ++i) gn[h][i] = (unsigned)(rw[h * HALF + sR[i]] * lda + sC[i]) * 2u;
      } else {
#pragma unroll
        for (int h = 0; h < 2; ++h)
#pragma unroll
          for (int i = 0; i < 2; ++i) gn[h][i] = gc[h][i];
      }
      FG_WAIT_L(0);
    }
#pragma nounroll
    for (int t = 0; t < nt; t += 2) {
      const bool last = (t == nt - 2);
      const size_t k1 = (size_t)(t + 1) * kstep;
      const size_t k2 = last ? 0 : (size_t)(t + 2) * kstep, k3 = k2 + kstep;
      const char* b2 = last ? nB : cB + (size_t)(t + 2) * kstep; const char* b3 = b2 + kstep;
      FG_LDB(B0, 0, 0); FG_LDB(B1, 0, 1); FG_SCHED; FG_LDA(At, 0, 0); FG_STAGE_A(FG_SA(1, 1), false, 1, k1);
      FG_WAIT_V(8); FG_WAIT_L(0); FG_BAR; FG_MMA(0, 0, At, B0); FG_MMA(0, 1, At, B1); FG_BAR; FG_SCHED;
      FG_LDA(At, 0, 1); FG_STAGE_B(FG_SB(0, 0), b2); FG_STAGE_B(FG_SB(0, 1), b2 + hstepB); FG_STAGE_A(FG_SA(0, 0), last, 0, k2);
      FG_WAIT_V(8); FG_WAIT_L(0); FG_BAR; FG_MMA(1, 0, At, B0); FG_MMA(1, 1, At, B1); FG_BAR; FG_SCHED;
      FG_LDB(B0, 1, 0); FG_LDB(B1, 1, 1); FG_SCHED; FG_LDA(At, 1, 0); FG_STAGE_A(FG_SA(0, 1), last, 1, k2);
      FG_WAIT_V(8); FG_WAIT_L(0); FG_BAR; FG_MMA(0, 0, At, B0); FG_MMA(0, 1, At, B1); FG_BAR; FG_SCHED;
      FG_LDA(At, 1, 1); FG_STAGE_B(FG_SB(1, 0), b3); FG_STAGE_B(FG_SB(1, 1), b3 + hstepB); FG_STAGE_A(FG_SA(1, 0), last, 0, k3);
      FG_WAIT_V(8); FG_WAIT_L(0); FG_BAR; FG_MMA(1, 0, At, B0); FG_MMA(1, 1, At, B1); FG_BAR; FG_SCHED;
    }
    if (wr == 0) FG_BAR;
    E(acc, cur, wr, wc, r32, g32);
    if (!has_next) break;
#pragma unroll
    for (int a = 0; a < 2; ++a)
#pragma unroll
      for (int b = 0; b < 2; ++b)
#pragma unroll
        for (int m = 0; m < 2; ++m)
#pragma unroll
          for (int n = 0; n < 16; ++n) acc[a][b][m][n] = 0.f;
    cur = nxt; cA = nA; cB = nB; ++ui;
    if constexpr (GATHER) {
#pragma unroll
      for (int h = 0; h < 2; ++h)
#pragma unroll
        for (int i = 0; i < 2; ++i) gc[h][i] = gn[h][i];
    }
    if (wr == 1) FG_BAR;
  }
  FG_WAIT_V(0);
  FG_BAR;
#undef FG_SA
#undef FG_SB
#undef FG_GLDS
#undef FG_STAGE_A
#undef FG_STAGE_B
#undef FG_LDA
#undef FG_LDB
#undef FG_MMA
#undef FG_WAIT_V
#undef FG_WAIT_L
#undef FG_BAR
#undef FG_SCHED
}
}

DI void cvt_tile(char* smem, const float* src, int ld, bf16_t* dst, int K, int N, int item, int dld, int f8) {
  float* tile = (float*)smem;
  const int ntn = N >> 6, kt = item / ntn, nt = item % ntn, k0 = kt * 64, n0 = nt * 64, tid = otid();
  __syncthreads();
#pragma unroll
  for (int i = 0; i < 8; ++i) { const int idx = tid + i * NTH, r = idx >> 6, c = idx & 63; tile[r * 65 + c] = src[(size_t)(k0 + r) * ld + n0 + c]; }
  __syncthreads();
  const int n = tid >> 3, k8 = (tid & 7) * 8;
  if (f8) {
    u32x2 o8;
    o8.x = pk4_fp8(tile[(k8 + 0) * 65 + n] * 32.f, tile[(k8 + 1) * 65 + n] * 32.f, tile[(k8 + 2) * 65 + n] * 32.f, tile[(k8 + 3) * 65 + n] * 32.f);
    o8.y = pk4_fp8(tile[(k8 + 4) * 65 + n] * 32.f, tile[(k8 + 5) * 65 + n] * 32.f, tile[(k8 + 6) * 65 + n] * 32.f, tile[(k8 + 7) * 65 + n] * 32.f);
    *(u32x2*)((unsigned char*)dst + (size_t)(n0 + n) * dld + k0 + k8) = o8;
    return;
  }
  u32x4 o;
  o.x = pk2(tile[(k8 + 0) * 65 + n], tile[(k8 + 1) * 65 + n]);
  o.y = pk2(tile[(k8 + 2) * 65 + n], tile[(k8 + 3) * 65 + n]);
  o.z = pk2(tile[(k8 + 4) * 65 + n], tile[(k8 + 5) * 65 + n]);
  o.w = pk2(tile[(k8 + 6) * 65 + n], tile[(k8 + 7) * 65 + n]);
  *(u32x4*)(dst + (size_t)(n0 + n) * dld + k0 + k8) = o;
}
DI void phase_cvt_mix(KP p, char* smem) {
  char* const ws = ows(p);
  {
    bf16_t* wz = (bf16_t*)(ws + OFF_WMIX) + W_WA2;
    for (int i = obid() * NTH + otid(); i < 2 * 2048 * 8; i += gridDim.x * NTH) {
      const int row = i >> 3, c8 = i & 7, d = (row & 2047) >> 10;
      *(u32x4*)(wz + (size_t)row * 128 + (1 - d) * 64 + c8 * 8) = (u32x4){0u, 0u, 0u, 0u};
    }
  }
  for (int it = obid(); it < p->nitems; it += gridDim.x) {
    int j = 0;
    while (j + 1 < p->njobs && p->jobs[j + 1].item0 <= it) ++j;
    cvt_tile(smem, (const float*)(__attribute__((address_space(1))) const float*)p->jobs[j].src, p->jobs[j].ld, (bf16_t*)(__attribute__((address_space(1))) bf16_t*)p->jobs[j].dst, p->jobs[j].K, p->jobs[j].N, it - p->jobs[j].item0, p->jobs[j].dld, p->jobs[j].pad_);
  }
}
constexpr float O8_SCALE = 4.0f;
constexpr float X8_SCALE = 4.0f;
constexpr float W8_SCALE = 32.0f, A8_SCALE = 4.0f, WD8_SCALE = 16.0f;
DI int up_src_col(int np) {
  const int slab = np >> 5, pos = np & 31, q = pos & 15, hh = (q >> 2) & 1, i = (q & 3) + 4 * (q >> 3);
  return (pos >> 4) * 512 + slab * 16 + 8 * hh + i;
}
DI void phase_cvt_moe(KP p, int layer, char* smem) {
  char* const ws = ows(p);
  float* tile = (float*)smem;
  bf16_t* wm = (bf16_t*)(ws + OFF_WMOE);
  const int tid = otid();
  const int NUP = 32 * 256, NDN = 32 * 128;
  const int lr = tid >> 4, lc = (tid & 15) * 4;
  auto issue = [&](int it2, f32x4 (&d)[2]) __attribute__((always_inline)) {
    const float* src; int k0, col;
    if (it2 < NUP) {
      const int e = it2 >> 8, t = it2 & 255, kt = t >> 4, nt = t & 15;
      k0 = kt * 64; col = up_src_col(nt * 64 + lc);
      src = gin(p, 38) + ((size_t)(layer * 32 + e) * 1024) * 1024;
    } else {
      const int i2 = it2 - NUP, e = i2 >> 7, t = i2 & 127, kt = t >> 4, nt = t & 15;
      k0 = kt * 64; col = nt * 64 + lc;
      src = gin(p, 39) + ((size_t)(layer * 32 + e) * 512) * 1024;
    }
    d[0] = *(const f32x4*)(src + (size_t)(k0 + lr) * 1024 + col);
    d[1] = *(const f32x4*)(src + (size_t)(k0 + lr + 32) * 1024 + col);
  };
  f32x4 cur[2], nx[2];
  int it = obid();
  if (it < NUP + NDN) issue(it, cur);
  for (; it < NUP + NDN; it += gridDim.x) {
    const int nit = it + gridDim.x;
    if (nit < NUP + NDN) issue(nit, nx);
    __syncthreads();
#pragma unroll
    for (int i = 0; i < 2; ++i)
#pragma unroll
      for (int j = 0; j < 4; ++j) tile[(lr + 32 * i) * 65 + lc + j] = cur[i][j];
    __syncthreads();
    const int n = tid >> 3, k8 = (tid & 7) * 8;
    const float sc8 = it < NUP ? W8_SCALE : WD8_SCALE;
    u32x2 o;
    o.x = pk4_fp8(tile[(k8 + 0) * 65 + n] * sc8, tile[(k8 + 1) * 65 + n] * sc8, tile[(k8 + 2) * 65 + n] * sc8, tile[(k8 + 3) * 65 + n] * sc8);
    o.y = pk4_fp8(tile[(k8 + 4) * 65 + n] * sc8, tile[(k8 + 5) * 65 + n] * sc8, tile[(k8 + 6) * 65 + n] * sc8, tile[(k8 + 7) * 65 + n] * sc8);
    if (it < NUP) {
      const int e = it >> 8, t = it & 255, kt = t >> 4, nt = t & 15, k0 = kt * 64, n0 = nt * 64;
      *(u32x2*)((unsigned char*)wm + (size_t)e * 1024 * 1024 + (size_t)(n0 + n) * 1024 + k0 + k8) = o;
    } else {
      const int i2 = it - NUP, e = i2 >> 7, t = i2 & 127, kt = t >> 4, nt = t & 15, k0 = kt * 64, n0 = nt * 64;
      *(u32x2*)((unsigned char*)(wm + WMOE_DOWN) + (size_t)e * 1024 * 512 + (size_t)(n0 + n) * 512 + k0 + k8) = o;
    }
    cur[0] = nx[0]; cur[1] = nx[1];
  }
}

constexpr int MOD_LDS = 17 * 1024 * 4 + 8 * 17 * 64 * 4;
DI void phase_mod(KP p, char* smem) {
  char* const ws = ows(p);
  float* sc = (float*)smem;
  float* red = sc + 17 * 1024;
  const int tid = otid();
  for (int i = tid; i < 17 * 1024; i += NTH) {
    const int bi = i >> 10, k = i & 1023;
    const float v = bi < 16 ? gin(p, 1)[bi * 1024 + k] : gin(p, 3)[k];
    sc[i] = v / (1.0f + __expf(-v));
  }
  __syncthreads();
  const int col = tid & 63, ks = tid >> 6;
  for (int it = obid(); it < 4 * 96; it += gridDim.x) {
    const int l = it / 96, j = (it % 96) * 64 + col;
    const float* w = gin(p, 4) + (size_t)l * 1024 * 6144 + j;
    float acc[17];
#pragma unroll
    for (int b = 0; b < 17; ++b) acc[b] = 0.f;
    for (int k0 = ks * 128; k0 < ks * 128 + 128; k0 += 8) {
      float wv[8];
#pragma unroll
      for (int u = 0; u < 8; ++u) wv[u] = w[(size_t)(k0 + u) * 6144];
#pragma unroll
      for (int u4 = 0; u4 < 2; ++u4)
#pragma unroll
        for (int b = 0; b < 17; ++b) {
          const f32x4 s4 = *(const f32x4*)(sc + b * 1024 + k0 + 4 * u4);
          acc[b] += s4[0] * wv[4 * u4] + s4[1] * wv[4 * u4 + 1] + s4[2] * wv[4 * u4 + 2] + s4[3] * wv[4 * u4 + 3];
        }
    }
    __syncthreads();
#pragma unroll
    for (int b = 0; b < 17; ++b) red[(ks * 17 + b) * 64 + col] = acc[b];
    __syncthreads();
    for (int o = tid; o < 17 * 64; o += NTH) {
      const int b = o >> 6, c = o & 63;
      float s = 0.f;
#pragma unroll
      for (int q = 0; q < 8; ++q) s += red[(q * 17 + b) * 64 + c];
      const int jj = (it % 96) * 64 + c;
      ((float*)(ws + OFF_MOD))[(size_t)(l * 17 + b) * 6144 + jj] = s + gin(p, 5)[l * 6144 + jj];
    }
  }
  {
    bf16_t* wr = (bf16_t*)(ws + OFF_WR);
    for (int i = obid() * NTH + tid; i < 4 * 48 * 1024; i += gridDim.x * NTH) {
      const int l = i / (48 * 1024), n = (i / 1024) % 48, k = i & 1023;
      float w = 0.f;
      if (n < 4) w = gin(p, 34)[((size_t)l * 1024 + k) * 4 + n];
      else if (n < 36) w = gin(p, 36)[((size_t)l * 1024 + k) * 32 + (n - 4)];
      const bf16_t hi = f2bf(w);
      wr[((size_t)(l * 2 + 0) * 48 + n) * 1024 + k] = hi;
      wr[((size_t)(l * 2 + 1) * 48 + n) * 1024 + k] = f2bf(w - bf2f(hi));
    }
  }
  if (obid() == 0) {
    float* rc = (float*)(ws + OFF_ROPE);
    for (int i = tid; i < 1024; i += NTH) {
      const int pos = i >> 4, f = i & 15;
      const float inv = powf(10000.0f, -(float)f / 16.0f);
      const float ang = (float)pos * inv;
      rc[i] = cosf(ang); rc[1024 + i] = sinf(ang);
    }
  }
}

DI void moe_blkstart(char* ws, int layer, int* bs  ) {
  if (otid() == 0) {
    const int* cnt = (const int*)(ws + OFF_CNT) + layer * 32;
    int s = 0;
    for (int e = 0; e < 32; ++e) { bs[e] = s; s += (cnt[e] + MOE_PAD - 1) / MOE_PAD; }
    bs[32] = s;
  }
  __syncthreads();
}
template <int MODE, bool DRY = false, bool OUT8 = false>
DI void phase_norm1(KP p, int layer, char* smem) {
  char* const ws = ows(p);
  int* bs = (int*)smem;
  if (MODE != 0) moe_blkstart(ws, MODE == 3 ? 3 : layer - 1, bs);
  const int lane = otid() & 63, wid = otid() >> 6;
  const int nrows = MODE == 3 ? TL : TT;
  const bf16_t* yb = (const bf16_t*)(ws + OFF_U + UM_YB);
  const int* tok = (const int*)(ws + OFF_TOK);
  bf16_t* hb = (bf16_t*)(ws + OFF_H);
  const int stride = gridDim.x * 8;
  for (int rA = obid() * 8 + wid; rA < nrows; rA += 2 * stride) {
    const int rB = rA + stride;
    const bool hasB = rB < nrows;
    const int rr[2] = {rA, hasB ? rB : rA};
    f32x4 v[2][4];
    int4 t0[2], t1[2];
#pragma unroll
    for (int k = 0; k < 2; ++k) {
      const int r = rr[k];
      if (MODE == 0) {
        const float* src = r < TL ? gin(p, 0) + (size_t)r * DM : gin(p, 2) + (size_t)(r - TL) * DM;
#pragma unroll
        for (int i = 0; i < 4; ++i) v[k][i] = *(const f32x4*)(src + (i * 64 + lane) * 4);
      } else {
        const bf16_t* xr = xrow_ptr(p, ws, r);
#pragma unroll
        for (int i = 0; i < 4; ++i) v[k][i] = ldbf4(xr + (i * 64 + lane) * 4);
        t0[k] = *(const int4*)(tok + (size_t)r * 8);
        t1[k] = *(const int4*)(tok + (size_t)r * 8 + 4);
      }
    }
    if (MODE == 1 || MODE == 3) {
      const int pl = MODE == 3 ? 3 : layer - 1;
      u32x2 ya[2][4], yc[2][4];
#pragma unroll
      for (int k = 0; k < 2; ++k) {
        const size_t d0 = (size_t)(bs[t0[k].x] * MOE_PAD + t0[k].y), d1 = (size_t)(bs[t0[k].z] * MOE_PAD + t0[k].w);
#pragma unroll
        for (int i = 0; i < 4; ++i) { const int ch = (i * 64 + lane) * 4; ya[k][i] = *(const u32x2*)(yb + d0 * DM + ch); yc[k][i] = *(const u32x2*)(yb + d1 * DM + ch); }
      }
#pragma unroll
      for (int k = 0; k < 2; ++k) {
        const float w0 = __int_as_float(t1[k].x), w1 = __int_as_float(t1[k].y);
        const float* g2 = modp(ws, pl, row_bi(rr[k]), 5);
#pragma unroll
        for (int i = 0; i < 4; ++i) {
          const int ch = (i * 64 + lane) * 4;
          const u32x2 a = ya[k][i], b = yc[k][i];
          const f32x4 g = *(const f32x4*)(g2 + ch);
          v[k][i][0] += g[0] * (w0 * bflo(a.x) + w1 * bflo(b.x));
          v[k][i][1] += g[1] * (w0 * bfhi(a.x) + w1 * bfhi(b.x));
          v[k][i][2] += g[2] * (w0 * bflo(a.y) + w1 * bflo(b.y));
          v[k][i][3] += g[3] * (w0 * bfhi(a.y) + w1 * bfhi(b.y));
        }
      }
    }
#pragma unroll
    for (int k = 0; k < 2; ++k) {
      if (k == 1 && !hasB) break;
      const int r = rr[k], bi = row_bi(r);
      bf16_t* xr = xrow_ptr(p, ws, r);
      if ((MODE == 0 || MODE == 1) && !DRY) {
#pragma unroll
        for (int i = 0; i < 4; ++i) stbf4(xr + (i * 64 + lane) * 4, v[k][i]);
      }
      float ss = 0.f;
#pragma unroll
      for (int i = 0; i < 4; ++i) ss += v[k][i][0] * v[k][i][0] + v[k][i][1] * v[k][i][1] + v[k][i][2] * v[k][i][2] + v[k][i][3] * v[k][i][3];
      ss = wave_sum(ss);
      const float rs = rsqrtf(ss * (1.0f / 1024.0f) + 1e-6f);
      if (MODE == 3) {
#pragma unroll
        for (int i = 0; i < 4; ++i) {
          const int ch = (i * 64 + lane) * 4;
          const f32x4 g = *(const f32x4*)(gin(p, 7) + ch);
          f32x4 o; o[0] = v[k][i][0] * rs * g[0]; o[1] = v[k][i][1] * rs * g[1]; o[2] = v[k][i][2] * rs * g[2]; o[3] = v[k][i][3] * rs * g[3];
          if (!DRY) *(f32x4*)(gout(p) + (size_t)r * DM + ch) = o; else asm volatile("" :: "v"(o[0]), "v"(o[1]), "v"(o[2]), "v"(o[3]));
        }
      } else {
        const float* gn = gin(p, 6) + (size_t)(layer * 2 + 0) * DM;
        const float* sh = modp(ws, layer, bi, 0);
        const float* sc = modp(ws, layer, bi, 1);
#pragma unroll
        for (int i = 0; i < 4; ++i) {
          const int ch = (i * 64 + lane) * 4;
          const f32x4 g = *(const f32x4*)(gn + ch), s1 = *(const f32x4*)(sc + ch), s0 = *(const f32x4*)(sh + ch);
          float o[4];
#pragma unroll
          for (int j = 0; j < 4; ++j) o[j] = v[k][i][j] * rs * g[j] * (1.0f + s1[j]) + s0[j];
          if constexpr (OUT8) {
            const unsigned w8 = pk4_fp8(o[0] * X8_SCALE, o[1] * X8_SCALE, o[2] * X8_SCALE, o[3] * X8_SCALE);
            if (!DRY) *(unsigned*)((unsigned char*)(ws + OFF_H8) + (size_t)r * DM + ch) = w8; else asm volatile("" :: "v"(w8));
          } else {
            u32x2 w; w.x = pk2(o[0], o[1]); w.y = pk2(o[2], o[3]);
            if (!DRY) *(u32x2*)(hb + (size_t)r * DM + ch) = w; else asm volatile("" :: "v"(w.x), "v"(w.y));
          }
        }
      }
    }
  }
}

constexpr int R2_TLD = 1032;
constexpr int R2_LLD = 49;
constexpr int R2_LDS = 64 * R2_TLD * 2 + 64 * R2_LLD * 4;
template <bool DRY = false>
DI void phase_norm2_router(KP p, int layer, char* smem) {
  char* const ws = ows(p);
  const int tid = otid(), lane = tid & 63, wid = tid >> 6, fr = lane & 15, fq = lane >> 4;
  bf16_t* tile = (bf16_t*)smem;
  float* lgt = (float*)(smem + 64 * R2_TLD * 2);
  const int nrows = layer == 3 ? TL : TT;
  unsigned char* h8 = (unsigned char*)(ws + OFF_H8);
  int* tok = (int*)(ws + OFF_TOK);
  int* rowl = (int*)(ws + OFF_ROWL);
  int* cnt = (int*)(ws + OFF_CNT) + layer * 32;
  const float* bg = gin(p, 35) + layer * 4;
  const float* be = gin(p, 37) + layer * 32;
  const float* gn = gin(p, 6) + (size_t)(layer * 2 + 1) * DM;
  const bf16_t* wrh = (const bf16_t*)(ws + OFF_WR) + (size_t)layer * 2 * 48 * 1024;
  const bf16_t* wrl = wrh + 48 * 1024;
  bf16x8 bh[4][3], bl[4][3];
#pragma unroll
  for (int ks = 0; ks < 4; ++ks)
#pragma unroll
    for (int nt = 0; nt < 3; ++nt) {
      const size_t o = (size_t)(nt * 16 + fr) * 1024 + wid * 128 + ks * 32 + fq * 8;
      bh[ks][nt] = *(const bf16x8*)(wrh + o); bl[ks][nt] = *(const bf16x8*)(wrl + o);
    }
  for (int rbase = obid() * 64; rbase < nrows; rbase += gridDim.x * 64) {
    const int bi = row_bi(rbase);
    const float* sh = modp(ws, layer, bi, 3);
    const float* sc = modp(ws, layer, bi, 4);
    f32x4 gs[4], s0[4];
#pragma unroll
    for (int i = 0; i < 4; ++i) {
      const int ch = (i * 64 + lane) * 4;
      const f32x4 g = *(const f32x4*)(gn + ch), s1 = *(const f32x4*)(sc + ch);
      gs[i] = g * (1.0f + s1); s0[i] = *(const f32x4*)(sh + ch);
    }
#pragma unroll 2
    for (int q = 0; q < 8; ++q) {
      const int lr = wid * 8 + q, r = rbase + lr;
      const bf16_t* xr = xrow_ptr(p, ws, r);
      f32x4 v[4];
      float ss = 0.f;
#pragma unroll
      for (int i = 0; i < 4; ++i) { v[i] = ldbf4(xr + (i * 64 + lane) * 4); ss += v[i][0] * v[i][0] + v[i][1] * v[i][1] + v[i][2] * v[i][2] + v[i][3] * v[i][3]; }
      ss = wave_sum(ss);
      const float rs = rsqrtf(ss * (1.0f / 1024.0f) + 1e-6f);
#pragma unroll
      for (int i = 0; i < 4; ++i) {
        const int ch = (i * 64 + lane) * 4;
        const f32x4 o = v[i] * rs * gs[i] + s0[i];
        u32x2 w; w.x = pk2(o[0], o[1]); w.y = pk2(o[2], o[3]);
        *(unsigned*)(h8 + (size_t)r * DM + ch) = pk4_fp8(o[0], o[1], o[2], o[3]);
        *(u32x2*)(tile + lr * R2_TLD + ch) = w;
      }
    }
    __syncthreads();
    {
      f32x4 acc[4][3];
#pragma unroll
      for (int rt = 0; rt < 4; ++rt)
#pragma unroll
        for (int nt = 0; nt < 3; ++nt) acc[rt][nt] = (f32x4){0.f, 0.f, 0.f, 0.f};
#pragma unroll
      for (int ks = 0; ks < 4; ++ks)
#pragma unroll
        for (int rt = 0; rt < 4; ++rt) {
          const bf16x8 a = *(const bf16x8*)(tile + (rt * 16 + fr) * R2_TLD + wid * 128 + ks * 32 + fq * 8);
#pragma unroll
          for (int nt = 0; nt < 3; ++nt) { acc[rt][nt] = MFMA16(a, bh[ks][nt], acc[rt][nt]); acc[rt][nt] = MFMA16(a, bl[ks][nt], acc[rt][nt]); }
        }
      __syncthreads();
      float* part = (float*)smem + wid * 64 * R2_LLD;
#pragma unroll
      for (int rt = 0; rt < 4; ++rt)
#pragma unroll
        for (int nt = 0; nt < 3; ++nt)
#pragma unroll
          for (int j = 0; j < 4; ++j) part[(rt * 16 + fq * 4 + j) * R2_LLD + nt * 16 + fr] = acc[rt][nt][j];
    }
    __syncthreads();
    for (int i = tid; i < 64 * 36; i += NTH) {
      const int row = i / 36, col = i - row * 36;
      const float* pp = (const float*)smem + row * R2_LLD + col;
      float sacc = 0.f;
#pragma unroll
      for (int w = 0; w < 8; ++w) sacc += pp[w * 64 * R2_LLD];
      lgt[row * R2_LLD + col] = sacc;
    }
    __syncthreads();
    if (wid == 0) {
      const int r = rbase + lane;
      float* lr_ = lgt + lane * R2_LLD;
      float lg[4];
#pragma unroll
      for (int q = 0; q < 4; ++q) lg[q] = lr_[q] + bg[q];
      int gsel = 0; float gm = lg[0];
#pragma unroll
      for (int q = 1; q < 4; ++q) if (lg[q] > gm) { gm = lg[q]; gsel = q; }
      float gden = 0.f;
#pragma unroll
      for (int q = 0; q < 4; ++q) gden += __expf(lg[q] - gm);
      const float pgrp = 1.0f / gden;
      float le[8];
#pragma unroll
      for (int q = 0; q < 8; ++q) le[q] = lr_[4 + gsel * 8 + q] + be[gsel * 8 + q];
      int i0 = 0; float m0 = le[0];
#pragma unroll
      for (int q = 1; q < 8; ++q) if (le[q] > m0) { m0 = le[q]; i0 = q; }
      int i1 = -1; float m1 = -3.0e38f;
#pragma unroll
      for (int q = 0; q < 8; ++q) if (q != i0 && le[q] > m1) { m1 = le[q]; i1 = q; }
      const float e1 = __expf(m1 - m0);
      const float w0 = pgrp / (1.0f + e1), w1 = pgrp * e1 / (1.0f + e1);
      if (DRY) asm volatile("" :: "v"(w0), "v"(w1), "v"(i0), "v"(i1), "v"(gsel));
      if (!DRY) {
        const int ea = gsel * 8 + i0, eb = gsel * 8 + i1;
        const int pa = atomicAdd(&cnt[ea], 1), pb = atomicAdd(&cnt[eb], 1);
        rowl[(size_t)ea * CAP + pa] = r; rowl[(size_t)eb * CAP + pb] = r;
        int4 t0; t0.x = ea; t0.y = pa; t0.z = eb; t0.w = pb;
        int4 t1; t1.x = __float_as_int(w0); t1.y = __float_as_int(w1); t1.z = 0; t1.w = 0;
        *(int4*)(tok + (size_t)r * 8) = t0; *(int4*)(tok + (size_t)r * 8 + 4) = t1;
      }
    }
  }
}

DI void st_bf16x4(bf16_t* p, const f32x4& v) { u32x2 w; w.x = pk2(v[0], v[1]); w.y = pk2(v[2], v[3]); *(u32x2*)p = w; }
constexpr int FG_LDS = fg::STAGE_BYTES;
constexpr int MOE_UMAX = 12;

struct MoeSched {
  const char* A; const char* B; const LAS int* bs; const LAS int* rowtab; int G, c, ntile; size_t tA, eB, tB;
  DI bool next(int i, fg::Unit& u) const {
    const int rt = (G & 31) ? (i * G + c) >> 2 : i * (G >> 2) + (c & 7) * (G >> 5) + (c >> 5), ct = (G & 31) ? (i * G + c) & 3 : (c >> 3) & 3;
    if (rt >= ntile) return false;
    int e = 0;
#pragma unroll 1
    while (e < 31 && bs[e + 1] <= rt) ++e;
    u.pm = rt; u.pn = ct; u.aux = e; u.A = A + (size_t)rt * tA; u.B = B + (size_t)e * eB + (size_t)ct * tB; return true;
  }
  DI const LAS int* rows(int i) const { return rowtab + i * 256; }
};
DI void phase_moe_up(KP p, int layer, char* smem) {
  char* const ws = ows(p);
  LAS unsigned char* lds = (LAS unsigned char*)smem;
  LAS int* rowtab = (LAS int*)(lds + FG_LDS);
  int* bs = (int*)(smem + FG_LDS + MOE_UMAX * 1024);
  moe_blkstart(ws, layer, bs);
  const int* cnt = (const int*)(ws + OFF_CNT) + layer * 32;
  const int* rowl = (const int*)(ws + OFF_ROWL);
  unsigned char* act8 = (unsigned char*)(ws + OFF_U + UM_ACT);
  MoeSched S;
  S.A = ws + OFF_H8; S.B = ws + OFF_WMOE; S.bs = (const LAS int*)bs; S.rowtab = rowtab; S.G = gridDim.x; S.c = obid(); S.ntile = bs[32];
  S.tA = 0; S.eB = (size_t)1024 * 1024; S.tB = (size_t)256 * 1024;
  {
    const int tid = otid();
    fg::Unit u;
    for (int i = 0; i < MOE_UMAX && S.next(i, u); ++i) {
      if (tid < 256) {
        const int e = u.aux, pos = (u.pm - bs[e]) * 256 + tid;
        rowtab[i * 256 + tid] = pos < cnt[e] ? rowl[(size_t)e * CAP + pos] : TT;
      }
    }
    __syncthreads();
  }
  auto ep = [&](const f32x16 (&acc)[2][2][2], const fg::Unit& u, int wr, int wc, int r, int h) {
    constexpr float inv = 1.0f / W8_SCALE;
#pragma unroll
    for (int ai = 0; ai < 2; ++ai)
#pragma unroll
      for (int m = 0; m < 2; ++m) {
        const size_t row = (size_t)u.pm * 256 + ai * 128 + wr * 64 + m * 32 + r;
#pragma unroll
        for (int bj = 0; bj < 2; ++bj) {
          const int acol = ((u.pn * 256 + bj * 128 + wc * 32) >> 5) * 16 + 8 * h;
          float o[8];
#pragma unroll
          for (int i = 0; i < 8; ++i) { const float g = acc[ai][bj][m][i] * inv, uu = acc[ai][bj][m][i + 8] * inv; o[i] = g * __builtin_amdgcn_rcpf(1.0f + __expf(-g)) * uu; }
          u32x2 w8; w8.x = pk4_fp8(o[0] * A8_SCALE, o[1] * A8_SCALE, o[2] * A8_SCALE, o[3] * A8_SCALE); w8.y = pk4_fp8(o[4] * A8_SCALE, o[5] * A8_SCALE, o[6] * A8_SCALE, o[7] * A8_SCALE);
          *(u32x2*)(act8 + row * 512 + acol) = w8;
        }
      }
  };
  fg::gemm_phase_f8<true>(lds, 512, 512, 512, S, ep);
}
DI void phase_moe_down(KP p, int layer, char* smem) {
  char* const ws = ows(p);
  LAS unsigned char* lds = (LAS unsigned char*)smem;
  int* bs = (int*)(smem + FG_LDS + MOE_UMAX * 1024);
  moe_blkstart(ws, layer, bs);
  bf16_t* yb = (bf16_t*)(ws + OFF_U + UM_YB);
  MoeSched S;
  S.A = ws + OFF_U + UM_ACT; S.B = ws + OFF_WMOE + WMOE_DOWN * 2; S.bs = (const LAS int*)bs; S.rowtab = nullptr; S.G = gridDim.x; S.c = obid(); S.ntile = bs[32];
  S.tA = (size_t)256 * 512; S.eB = (size_t)1024 * 512; S.tB = (size_t)256 * 512;
  auto ep = [&](const f32x16 (&acc)[2][2][2], const fg::Unit& u, int wr, int wc, int r, int h) {
    constexpr float inv = 1.0f / (A8_SCALE * WD8_SCALE);
#pragma unroll
    for (int ai = 0; ai < 2; ++ai)
#pragma unroll
      for (int m = 0; m < 2; ++m) {
        const size_t row = (size_t)u.pm * 256 + ai * 128 + wr * 64 + m * 32 + r;
#pragma unroll
        for (int bj = 0; bj < 2; ++bj) {
          const f32x16& a = acc[ai][bj][m];
          u32x4 w0, w1;
          w0.x = pk2(a[0] * inv, a[1] * inv); w0.y = pk2(a[2] * inv, a[3] * inv); w0.z = pk2(a[4] * inv, a[5] * inv); w0.w = pk2(a[6] * inv, a[7] * inv);
          w1.x = pk2(a[8] * inv, a[9] * inv); w1.y = pk2(a[10] * inv, a[11] * inv); w1.z = pk2(a[12] * inv, a[13] * inv); w1.w = pk2(a[14] * inv, a[15] * inv);
          bf16_t* q = yb + row * DM + u.pn * 256 + bj * 128 + wc * 32 + 16 * h;
          *(u32x4*)q = w0; *(u32x4*)(q + 8) = w1;
        }
      }
  };
  fg::gemm_phase_f8<false, true>(lds, 256, 256, 256, S, ep);
}

template <int NKC>
DI void phase_qkv(KP p, const bf16_t* Wt, bf16_t* Q, bf16_t* Kb, bf16_t* Vb, char* smem) {
  char* const ws = ows(p);
  LAS unsigned char* lds = (LAS unsigned char*)smem;
  constexpr int N = 1024 + 2 * NKC;
  const float* rc = (const float*)(ws + OFF_ROPE);
  fg::DenseSched S;
  S.A = ws + OFF_H; S.B = (const char*)Wt; S.nM = TT / 256; S.nN = N / 256; S.G = gridDim.x; S.c = obid(); S.tA = (size_t)256 * 1024 * 2; S.tB = (size_t)256 * 1024 * 2;
  auto ep = [&](const f32x4 (&acc)[2][2][4][2], const fg::Unit& u, int wr, int wc, int fr, int fq) {
#pragma unroll
    for (int bj = 0; bj < 2; ++bj) {
      const int colb = u.pn * 256 + bj * 128 + wc * 32;
      if (colb < 1024 + NKC) {
        const bool isq = colb < 1024;
        bf16_t* dst = isq ? Q : Kb;
        const int ldd = isq ? 1024 : NKC, cc2 = (isq ? colb : colb - 1024) + 8 * fq;
        const float qs = isq ? 0.125f : 1.0f;
#pragma unroll
        for (int ai = 0; ai < 2; ++ai)
#pragma unroll
          for (int m = 0; m < 4; ++m) {
            const int row = u.pm * 256 + ai * 128 + wr * 64 + m * 16 + fr;
            f32x4 x0 = acc[ai][bj][m][0], x1 = acc[ai][bj][m][1];
            if (row < TL) {
              const int s = row & 4095, idx = (colb & 32) ? (s & 63) : (s >> 6);
              const f32x4 c = *(const f32x4*)(rc + idx * 16 + 4 * fq), sn = *(const f32x4*)(rc + 1024 + idx * 16 + 4 * fq);
              const f32x4 o0 = x0 * c - x1 * sn, o1 = x1 * c + x0 * sn;
              x0 = o0; x1 = o1;
            }
            const f32x4 y0 = x0 * qs, y1 = x1 * qs;
            if (NKC == 1024 && !isq) {
              u32x2 w8; w8.x = pk4_fp8(y0[0], y0[1], y0[2], y0[3]); w8.y = pk4_fp8(y1[0], y1[1], y1[2], y1[3]);
              *(u32x2*)((unsigned char*)Kb + (size_t)row * 1024 + cc2) = w8;
            } else {
              u32x4 w; w.x = pk2(y0[0], y0[1]); w.y = pk2(y0[2], y0[3]); w.z = pk2(y1[0], y1[1]); w.w = pk2(y1[2], y1[3]);
              *(u32x4*)(dst + (size_t)row * ldd + cc2) = w;
            }
          }
      } else {
        const int cv = colb - (1024 + NKC) + 4 * fq;
        if constexpr (NKC == 1024) {
          unsigned char* Vt = (unsigned char*)Vb;
          const int tq = fr & 3;
#pragma unroll
          for (int ai = 0; ai < 2; ++ai)
#pragma unroll
            for (int m = 0; m < 4; ++m) {
              const int row = u.pm * 256 + ai * 128 + wr * 64 + m * 16 + fr, rowq = row & ~3;
              size_t base; int kq;
              if (rowq < TL) { const int b = rowq >> 12, s0 = rowq & 4095; base = (size_t)b * 1024 * 4096 + (size_t)(s0 >> 6) * 64; kq = (s0 & 63) >> 2; }
              else { const int rc2 = rowq - TL, b = rc2 >> 8, c0 = rc2 & 255; base = (size_t)16 * 1024 * 4096 + (size_t)b * 1024 * 256 + (size_t)(c0 >> 6) * 64; kq = (c0 & 63) >> 2; }
              const size_t rstride = rowq < TL ? 4096 : 256;
              const int pos = 32 * (kq & 1) + 16 * (kq >> 3) + 4 * ((kq >> 1) & 3);
#pragma unroll
              for (int n = 0; n < 2; ++n) {
                const f32x4 a = acc[ai][bj][m][n];
                const int d = (int)pk4_fp8(a[0], a[1], a[2], a[3]);
                const int d0 = __builtin_amdgcn_update_dpp(0, d, 0x00, 0xF, 0xF, true), d1 = __builtin_amdgcn_update_dpp(0, d, 0x55, 0xF, 0xF, true);
                const int d2 = __builtin_amdgcn_update_dpp(0, d, 0xAA, 0xF, 0xF, true), d3 = __builtin_amdgcn_update_dpp(0, d, 0xFF, 0xF, 0xF, true);
                const int sh = 8 * tq;
                const unsigned w = ((unsigned)(d0 >> sh) & 0xffu) | (((unsigned)(d1 >> sh) & 0xffu) << 8) | (((unsigned)(d2 >> sh) & 0xffu) << 16) | (((unsigned)(d3 >> sh) & 0xffu) << 24);
                *(unsigned*)(Vt + base + (size_t)(cv + 16 * n + tq) * rstride + pos) = w;
              }
            }
        } else {
#pragma unroll
          for (int ai = 0; ai < 2; ++ai)
#pragma unroll
            for (int m = 0; m < 4; ++m) {
              const int row = u.pm * 256 + ai * 128 + wr * 64 + m * 16 + fr;
              st_bf16x4(Vb + (size_t)row * NKC + cv, acc[ai][bj][m][0]);
              st_bf16x4(Vb + (size_t)row * NKC + cv + 16, acc[ai][bj][m][1]);
            }
        }
      }
    }
  };
  fg::gemm_phase<false>(lds, 1024, 1024, 1024, S, ep);
}

DI void phase_qkv_diff8(KP p, char* smem) {
  char* const ws = ows(p);
  LAS unsigned char* lds = (LAS unsigned char*)smem;
  const float* rc = (const float*)(ws + OFF_ROPE);
  bf16_t* Q = (bf16_t*)(ws + OFF_U + U1_Q);
  unsigned char* K8 = (unsigned char*)(ws + OFF_U + U1_K);
  unsigned char* Vt = (unsigned char*)(ws + OFF_U + U1_V);
  fg::DenseSched S;
  S.A = ws + OFF_H8; S.B = ws + OFF_WMIX + W_DIFFQKV * 2; S.nM = TT / 256; S.nN = 12; S.G = gridDim.x; S.c = obid(); S.tA = (size_t)256 * 1024; S.tB = (size_t)256 * 1024;
  auto ep = [&](const f32x16 (&acc)[2][2][2], const fg::Unit& u, int wr, int wc, int r, int h) {
    constexpr float inv = 1.0f / (X8_SCALE * 32.0f);
#pragma unroll
    for (int bj = 0; bj < 2; ++bj) {
      const int colb = u.pn * 256 + bj * 128 + wc * 32;
      if (colb < 2048) {
        const bool isq = colb < 1024;
        const float qs = (isq ? 0.125f : 1.0f) * inv;
#pragma unroll
        for (int ai = 0; ai < 2; ++ai)
#pragma unroll
          for (int m = 0; m < 2; ++m) {
            const int row = u.pm * 256 + ai * 128 + wr * 64 + m * 32 + r;
            const f32x16& a = acc[ai][bj][m];
            float y[16];
            if (row < TL) {
              const int s = row & 4095, idx = (colb & 32) ? (s & 63) : (s >> 6);
              const f32x4 c0 = *(const f32x4*)(rc + idx * 16 + 4 * h), c1 = *(const f32x4*)(rc + idx * 16 + 8 + 4 * h);
              const f32x4 s0 = *(const f32x4*)(rc + 1024 + idx * 16 + 4 * h), s1 = *(const f32x4*)(rc + 1024 + idx * 16 + 8 + 4 * h);
#pragma unroll
              for (int i = 0; i < 8; ++i) {
                const float cc = i < 4 ? c0[i & 3] : c1[i & 3], sn = i < 4 ? s0[i & 3] : s1[i & 3];
                y[i] = (a[i] * cc - a[i + 8] * sn) * qs; y[i + 8] = (a[i + 8] * cc + a[i] * sn) * qs;
              }
            } else {
#pragma unroll
              for (int i = 0; i < 16; ++i) y[i] = a[i] * qs;
            }
            if (isq) {
              u32x4 w0, w1;
              w0.x = pk2(y[0], y[1]); w0.y = pk2(y[2], y[3]); w0.z = pk2(y[4], y[5]); w0.w = pk2(y[6], y[7]);
              w1.x = pk2(y[8], y[9]); w1.y = pk2(y[10], y[11]); w1.z = pk2(y[12], y[13]); w1.w = pk2(y[14], y[15]);
              bf16_t* q = Q + (size_t)row * 1024 + colb + 16 * h;
              *(u32x4*)q = w0; *(u32x4*)(q + 8) = w1;
            } else {
              u32x4 w8;
              w8.x = pk4_fp8(y[0], y[1], y[2], y[3]); w8.y = pk4_fp8(y[4], y[5], y[6], y[7]); w8.z = pk4_fp8(y[8], y[9], y[10], y[11]); w8.w = pk4_fp8(y[12], y[13], y[14], y[15]);
              *(u32x4*)(K8 + (size_t)row * 1024 + (colb - 1024) + 16 * h) = w8;
            }
          }
      } else {
        const int cv = colb - 2048 + 4 * h, tq = r & 3;
#pragma unroll
        for (int ai = 0; ai < 2; ++ai)
#pragma unroll
          for (int m = 0; m < 2; ++m) {
            const int row = u.pm * 256 + ai * 128 + wr * 64 + m * 32 + r, rowq = row & ~3;
            size_t base; int kq;
            if (rowq < TL) { const int b = rowq >> 12, s0 = rowq & 4095; base = (size_t)b * 1024 * 4096 + (size_t)(s0 >> 6) * 64; kq = (s0 & 63) >> 2; }
            else { const int rc2 = rowq - TL, b = rc2 >> 8, c0 = rc2 & 255; base = (size_t)16 * 1024 * 4096 + (size_t)b * 1024 * 256 + (size_t)(c0 >> 6) * 64; kq = (c0 & 63) >> 2; }
            const size_t rstride = rowq < TL ? 4096 : 256;
            const int pos = 32 * (kq & 1) + 16 * (kq >> 3) + 4 * ((kq >> 1) & 3);
            const f32x16& a = acc[ai][bj][m];
#pragma unroll
            for (int g = 0; g < 4; ++g) {
              const int d = (int)pk4_fp8(a[4 * g] * inv, a[4 * g + 1] * inv, a[4 * g + 2] * inv, a[4 * g + 3] * inv);
              const int d0 = __builtin_amdgcn_update_dpp(0, d, 0x00, 0xF, 0xF, true), d1 = __builtin_amdgcn_update_dpp(0, d, 0x55, 0xF, 0xF, true);
              const int d2 = __builtin_amdgcn_update_dpp(0, d, 0xAA, 0xF, 0xF, true), d3 = __builtin_amdgcn_update_dpp(0, d, 0xFF, 0xF, 0xF, true);
              const int sh = 8 * tq;
              const unsigned w = ((unsigned)(d0 >> sh) & 0xffu) | (((unsigned)(d1 >> sh) & 0xffu) << 8) | (((unsigned)(d2 >> sh) & 0xffu) << 16) | (((unsigned)(d3 >> sh) & 0xffu) << 24);
              *(unsigned*)(Vt + base + (size_t)(cv + 8 * g + tq) * rstride + pos) = w;
            }
          }
      }
    }
  };
  fg::gemm_phase_f8<false, false>(lds, 512, 512, 512, S, ep);
}

DI void phase_qkv_win8(KP p, char* smem) {
  char* const ws = ows(p);
  LAS unsigned char* lds = (LAS unsigned char*)smem;
  const float* rc = (const float*)(ws + OFF_ROPE);
  bf16_t* Q = (bf16_t*)(ws + OFF_U + U0_Q);
  bf16_t* Kb = (bf16_t*)(ws + OFF_U + U0_K);
  bf16_t* Vb = (bf16_t*)(ws + OFF_U + U0_V);
  fg::DenseSched S;
  S.A = ws + OFF_H8; S.B = ws + OFF_WMIX + W_WINQKV * 2; S.nM = TT / 256; S.nN = 6; S.G = gridDim.x; S.c = obid(); S.tA = (size_t)256 * 1024; S.tB = (size_t)256 * 1024;
  auto ep = [&](const f32x16 (&acc)[2][2][2], const fg::Unit& u, int wr, int wc, int r, int h) {
    constexpr float inv = 1.0f / (X8_SCALE * 32.0f);
#pragma unroll
    for (int bj = 0; bj < 2; ++bj) {
      const int colb = u.pn * 256 + bj * 128 + wc * 32;
      if (colb < 1280) {
        const bool isq = colb < 1024;
        const float qs = (isq ? 0.125f : 1.0f) * inv;
        bf16_t* dst = isq ? Q + colb + 16 * h : Kb + (colb - 1024) + 16 * h;
        const int ldd = isq ? 1024 : 256;
#pragma unroll
        for (int ai = 0; ai < 2; ++ai)
#pragma unroll
          for (int m = 0; m < 2; ++m) {
            const int row = u.pm * 256 + ai * 128 + wr * 64 + m * 32 + r;
            const f32x16& a = acc[ai][bj][m];
            float y[16];
            if (row < TL) {
              const int s = row & 4095, idx = (colb & 32) ? (s & 63) : (s >> 6);
              const f32x4 c0 = *(const f32x4*)(rc + idx * 16 + 4 * h), c1 = *(const f32x4*)(rc + idx * 16 + 8 + 4 * h);
              const f32x4 s0 = *(const f32x4*)(rc + 1024 + idx * 16 + 4 * h), s1 = *(const f32x4*)(rc + 1024 + idx * 16 + 8 + 4 * h);
#pragma unroll
              for (int i = 0; i < 8; ++i) {
                const float cc = i < 4 ? c0[i & 3] : c1[i & 3], sn = i < 4 ? s0[i & 3] : s1[i & 3];
                y[i] = (a[i] * cc - a[i + 8] * sn) * qs; y[i + 8] = (a[i + 8] * cc + a[i] * sn) * qs;
              }
            } else {
#pragma unroll
              for (int i = 0; i < 16; ++i) y[i] = a[i] * qs;
            }
            u32x4 w0, w1;
            w0.x = pk2(y[0], y[1]); w0.y = pk2(y[2], y[3]); w0.z = pk2(y[4], y[5]); w0.w = pk2(y[6], y[7]);
            w1.x = pk2(y[8], y[9]); w1.y = pk2(y[10], y[11]); w1.z = pk2(y[12], y[13]); w1.w = pk2(y[14], y[15]);
            bf16_t* q = dst + (size_t)row * ldd;
            *(u32x4*)q = w0; *(u32x4*)(q + 8) = w1;
          }
      } else {
        const int cv = colb - 1280 + 4 * h;
#pragma unroll
        for (int ai = 0; ai < 2; ++ai)
#pragma unroll
          for (int m = 0; m < 2; ++m) {
            const int row = u.pm * 256 + ai * 128 + wr * 64 + m * 32 + r;
            const f32x16& a = acc[ai][bj][m];
#pragma unroll
            for (int g = 0; g < 4; ++g) {
              f32x4 v4; v4[0] = a[4 * g] * inv; v4[1] = a[4 * g + 1] * inv; v4[2] = a[4 * g + 2] * inv; v4[3] = a[4 * g + 3] * inv;
              st_bf16x4(Vb + (size_t)row * 256 + cv + 8 * g, v4);
            }
          }
      }
    }
  };
  fg::gemm_phase_f8<false, false>(lds, 512, 512, 512, S, ep);
}

template <bool DRY = false>
DI void phase_oproj(KP p, int layer, const bf16_t* A, const bf16_t* Wt, int nrows, char* smem) {
  char* const ws = ows(p);
  LAS unsigned char* lds = (LAS unsigned char*)smem;
  fg::DenseSched S;
  S.A = (const char*)A; S.B = (const char*)Wt; S.nM = nrows / 256; S.nN = 4; S.G = gridDim.x; S.c = obid(); S.tA = (size_t)256 * 1024 * 2; S.tB = (size_t)256 * 1024 * 2;
  auto ep = [&](const f32x4 (&acc)[2][2][4][2], const fg::Unit& u, int wr, int wc, int fr, int fq) {
    const int row0 = u.pm * 256 + wr * 64 + fr, colb = u.pn * 256 + wc * 32 + 4 * fq;
    const float* g1 = modp(ws, layer, row_bi(row0), 2) + colb;
    f32x4 g[2][2];
#pragma unroll
    for (int bj = 0; bj < 2; ++bj)
#pragma unroll
      for (int n = 0; n < 2; ++n) g[bj][n] = *(const f32x4*)(g1 + bj * 128 + n * 16);
    f32x4 xa[2][2], xb[2][2];
    bf16_t* xr = xrow_ptr(p, ws, row0) + colb;
#pragma unroll
    for (int bj = 0; bj < 2; ++bj)
#pragma unroll
      for (int n = 0; n < 2; ++n) xa[bj][n] = ldbf4(xr + bj * 128 + n * 16);
#pragma unroll
    for (int rr = 0; rr < 8; ++rr) {
      const int ai = rr >> 2, m = rr & 3;
      bf16_t* xn = xr;
      if (rr + 1 < 8) {
        xn = xrow_ptr(p, ws, row0 + ((rr + 1) >> 2) * 128 + ((rr + 1) & 3) * 16) + colb;
#pragma unroll
        for (int bj = 0; bj < 2; ++bj)
#pragma unroll
          for (int n = 0; n < 2; ++n) xb[bj][n] = ldbf4(xn + bj * 128 + n * 16);
      }
#pragma unroll
      for (int bj = 0; bj < 2; ++bj)
#pragma unroll
        for (int n = 0; n < 2; ++n) {
          const f32x4 x = xa[bj][n] + g[bj][n] * acc[ai][bj][m][n];
          if (!DRY) stbf4(xr + bj * 128 + n * 16, x); else asm volatile("" :: "v"(x[0]), "v"(x[1]), "v"(x[2]), "v"(x[3]));
        }
#pragma unroll
      for (int bj = 0; bj < 2; ++bj)
#pragma unroll
        for (int n = 0; n < 2; ++n) xa[bj][n] = xb[bj][n];
      xr = xn;
    }
  };
  fg::gemm_phase<false>(lds, 1024, 1024, 1024, S, ep);
}

template <bool DRY = false>
DI void phase_oproj8(KP p, int layer, const char* A8, const char* W8, int nrows, char* smem) {
  char* const ws = ows(p);
  LAS unsigned char* lds = (LAS unsigned char*)smem;
  fg::DenseSched S;
  S.A = A8; S.B = W8; S.nM = nrows / 256; S.nN = 4; S.G = gridDim.x; S.c = obid(); S.tA = (size_t)256 * 1024; S.tB = (size_t)256 * 1024;
  auto ep = [&](const f32x16 (&acc)[2][2][2], const fg::Unit& u, int wr, int wc, int r, int h) {
    constexpr float inv = 1.0f / (O8_SCALE * 32.0f);
    const int row0 = u.pm * 256 + wr * 64 + r, colb = u.pn * 256 + wc * 32 + 16 * h;
    const float* g1 = modp(ws, layer, row_bi(row0), 2) + colb;
#pragma unroll
    for (int bj = 0; bj < 2; ++bj) {
      f32x4 g[4];
#pragma unroll
      for (int q = 0; q < 4; ++q) g[q] = *(const f32x4*)(g1 + bj * 128 + 4 * q) * inv;
#pragma unroll
      for (int ai = 0; ai < 2; ++ai)
#pragma unroll
        for (int m = 0; m < 2; ++m) {
          bf16_t* xr = xrow_ptr(p, ws, row0 + ai * 128 + m * 32) + colb + bj * 128;
          const u32x4 x0 = ld16(xr), x1 = ld16(xr + 8);
          const f32x16& a = acc[ai][bj][m];
          u32x4 w0, w1;
          w0.x = pk2(bflo(x0.x) + g[0][0] * a[0], bfhi(x0.x) + g[0][1] * a[1]); w0.y = pk2(bflo(x0.y) + g[0][2] * a[2], bfhi(x0.y) + g[0][3] * a[3]);
          w0.z = pk2(bflo(x0.z) + g[1][0] * a[4], bfhi(x0.z) + g[1][1] * a[5]); w0.w = pk2(bflo(x0.w) + g[1][2] * a[6], bfhi(x0.w) + g[1][3] * a[7]);
          w1.x = pk2(bflo(x1.x) + g[2][0] * a[8], bfhi(x1.x) + g[2][1] * a[9]); w1.y = pk2(bflo(x1.y) + g[2][2] * a[10], bfhi(x1.y) + g[2][3] * a[11]);
          w1.z = pk2(bflo(x1.z) + g[3][0] * a[12], bfhi(x1.z) + g[3][1] * a[13]); w1.w = pk2(bflo(x1.w) + g[3][2] * a[14], bfhi(x1.w) + g[3][3] * a[15]);
          if (!DRY) { *(u32x4*)xr = w0; *(u32x4*)(xr + 8) = w1; } else asm volatile("" :: "v"(w0), "v"(w1));
        }
    }
  };
  fg::gemm_phase_f8<false, true>(lds, 512, 512, 512, S, ep);
}

DI void phase_pool_pre(KP p, char* smem) {
  char* const ws = ows(p);
  const int lane = otid() & 63, wid = otid() >> 6;
  const bf16_t* hb = (const bf16_t*)(ws + OFF_H);
  bf16_t* Y = (bf16_t*)(ws + OFF_U + U2_Y);
  const int ch0 = lane * 16, half = 1 << (lane >> 4);
  auto acc16 = [&](float (&a)[16], const bf16_t* q, float sg) __attribute__((always_inline)) {
    const u32x4 v0 = ld16(q), v1 = ld16(q + 8);
    a[0] += sg * bflo(v0.x); a[1] += sg * bfhi(v0.x); a[2] += sg * bflo(v0.y); a[3] += sg * bfhi(v0.y); a[4] += sg * bflo(v0.z); a[5] += sg * bfhi(v0.z); a[6] += sg * bflo(v0.w); a[7] += sg * bfhi(v0.w);
    a[8] += sg * bflo(v1.x); a[9] += sg * bfhi(v1.x); a[10] += sg * bflo(v1.y); a[11] += sg * bfhi(v1.y); a[12] += sg * bflo(v1.z); a[13] += sg * bfhi(v1.z); a[14] += sg * bflo(v1.w); a[15] += sg * bfhi(v1.w);
  };
  for (int seg = obid() * 8 + wid; seg < 2048 + 128; seg += gridDim.x * 8) {
    const int r0 = seg * 32;
    int s0, L;
    if (r0 < TL) { s0 = r0 & 4095; L = 4096; } else { s0 = (r0 - TL) & 255; L = 256; }
    const bf16_t* base = hb + (size_t)(r0 - s0) * DM + ch0;
    float a[16];
#pragma unroll
    for (int j = 0; j < 16; ++j) a[j] = 0.f;
    {
      const int lo = s0 - half < 0 ? 0 : s0 - half, hi = s0 + half > L ? L : s0 + half;
      for (int q = lo; q < hi; ++q) acc16(a, base + (size_t)q * DM, 1.0f);
    }
#pragma unroll 2
    for (int i = 0; i < 32; ++i) {
      const int s = s0 + i;
      const int lo = s - half < 0 ? 0 : s - half, hi = s + half > L ? L : s + half;
      const float inv = 1.0f / (float)(hi - lo);
      const u32x4 c0 = ld16(base + (size_t)s * DM), c1 = ld16(base + (size_t)s * DM + 8);
      u32x4 o0, o1;
      o0.x = pk2(a[0] * inv - bflo(c0.x), a[1] * inv - bfhi(c0.x)); o0.y = pk2(a[2] * inv - bflo(c0.y), a[3] * inv - bfhi(c0.y));
      o0.z = pk2(a[4] * inv - bflo(c0.z), a[5] * inv - bfhi(c0.z)); o0.w = pk2(a[6] * inv - bflo(c0.w), a[7] * inv - bfhi(c0.w));
      o1.x = pk2(a[8] * inv - bflo(c1.x), a[9] * inv - bfhi(c1.x)); o1.y = pk2(a[10] * inv - bflo(c1.y), a[11] * inv - bfhi(c1.y));
      o1.z = pk2(a[12] * inv - bflo(c1.z), a[13] * inv - bfhi(c1.z)); o1.w = pk2(a[14] * inv - bflo(c1.w), a[15] * inv - bfhi(c1.w));
      *(u32x4*)(Y + (size_t)(r0 + i) * DM + ch0) = o0; *(u32x4*)(Y + (size_t)(r0 + i) * DM + ch0 + 8) = o1;
      if (s + half < L) acc16(a, base + (size_t)(s + half) * DM, 1.0f);
      if (s - half >= 0) acc16(a, base + (size_t)(s - half) * DM, -1.0f);
    }
  }
}
struct PoolSched {
  const char* A; const char* B; int G, c;
  DI bool next(int i, fg::Unit& u) const {
    const int L = i * G + c; if (L >= (TT / 256) * 4) return false;
    const int pm = L >> 2, g = L & 3;
    u.pm = pm; u.pn = g; u.aux = 0; u.A = A + ((size_t)pm * 256 * 1024 + g * 256) * 2; u.B = B + (size_t)g * 65536 * 2; return true;
  }
  DI const LAS int* rows(int) const { return nullptr; }
};
template <bool DRY = false>
DI void phase_pool(KP p, char* smem) {
  char* const ws = ows(p);
  LAS unsigned char* lds = (LAS unsigned char*)smem;
  const float* pb = gin(p, 16);
  const float* psc = gin(p, 17);
  PoolSched S; S.A = ws + OFF_U + U2_Y; S.B = ws + OFF_WMIX + W_POOL * 2; S.G = gridDim.x; S.c = obid();
  auto ep = [&](const f32x4 (&acc)[2][2][4][2], const fg::Unit& u, int wr, int wc, int fr, int fq) {
    const int row0 = u.pm * 256 + wr * 64 + fr, colb = u.pn * 256 + wc * 32 + 4 * fq;
    const float* g1 = modp(ws, 2, row_bi(row0), 2) + colb;
    f32x4 g[2][2], bb[2][2];
#pragma unroll
    for (int bj = 0; bj < 2; ++bj)
#pragma unroll
      for (int n = 0; n < 2; ++n) {
        const f32x4 s4 = *(const f32x4*)(psc + colb + bj * 128 + n * 16);
        g[bj][n] = *(const f32x4*)(g1 + bj * 128 + n * 16) * s4;
        bb[bj][n] = *(const f32x4*)(pb + colb + bj * 128 + n * 16) * g[bj][n];
      }
    f32x4 xa[2][2], xb[2][2];
    bf16_t* xr = xrow_ptr(p, ws, row0) + colb;
#pragma unroll
    for (int bj = 0; bj < 2; ++bj)
#pragma unroll
      for (int n = 0; n < 2; ++n) xa[bj][n] = ldbf4(xr + bj * 128 + n * 16);
#pragma unroll
    for (int rr = 0; rr < 8; ++rr) {
      const int ai = rr >> 2, m = rr & 3;
      bf16_t* xn = xr;
      if (rr + 1 < 8) {
        xn = xrow_ptr(p, ws, row0 + ((rr + 1) >> 2) * 128 + ((rr + 1) & 3) * 16) + colb;
#pragma unroll
        for (int bj = 0; bj < 2; ++bj)
#pragma unroll
          for (int n = 0; n < 2; ++n) xb[bj][n] = ldbf4(xn + bj * 128 + n * 16);
      }
#pragma unroll
      for (int bj = 0; bj < 2; ++bj)
#pragma unroll
        for (int n = 0; n < 2; ++n) {
          const f32x4 x = xa[bj][n] + (g[bj][n] * acc[ai][bj][m][n] + bb[bj][n]);
          if (!DRY) stbf4(xr + bj * 128 + n * 16, x); else asm volatile("" :: "v"(x[0]), "v"(x[1]), "v"(x[2]), "v"(x[3]));
        }
#pragma unroll
      for (int bj = 0; bj < 2; ++bj)
#pragma unroll
        for (int n = 0; n < 2; ++n) xa[bj][n] = xb[bj][n];
      xr = xn;
    }
  };
  fg::gemm_phase<false>(lds, 256, 1024, 256, S, ep);
}

typedef short v4i16_t __attribute__((ext_vector_type(4)));
DI s16x4 tr_read(const bf16_t* p) { return __builtin_bit_cast(s16x4, __builtin_amdgcn_ds_read_tr16_b64_v4i16((LAS v4i16_t*)p)); }
DI bf16x8 pack8(const f32x16& x, int s) {
  u32x4 q;
  q.x = pk2(x[8 * s + 0], x[8 * s + 1]); q.y = pk2(x[8 * s + 2], x[8 * s + 3]);
  q.z = pk2(x[8 * s + 4], x[8 * s + 5]); q.w = pk2(x[8 * s + 6], x[8 * s + 7]);
  return __builtin_bit_cast(bf16x8, q);
}
template <int DT, int VLD_, bool MASK>
DI void attn_tile(const bf16_t* sK, int kld, const bf16_t* vbase, const bf16x8 (&qf)[4], f32x16 (&Y)[DT], float& m, float& l, int r, int h, int qpos, int kpos0) {
  f32x16 X[2];
#pragma unroll
  for (int sub = 0; sub < 2; ++sub) {
#pragma unroll
    for (int i = 0; i < 16; ++i) X[sub][i] = 0.f;
#pragma unroll
    for (int s = 0; s < 4; ++s) {
      const bf16x8 a = *(const bf16x8*)(sK + (sub * 32 + r) * kld + 16 * s + 8 * h);
      X[sub] = MFMA32(a, qf[s], X[sub]);
    }
  }
  if (MASK) {
#pragma unroll
    for (int sub = 0; sub < 2; ++sub)
#pragma unroll
      for (int i = 0; i < 16; ++i) {
        const int kp = kpos0 + sub * 32 + (i & 3) + 8 * (i >> 2) + 4 * h;
        const int d = qpos - kp;
        if (d > 128 || d < -128) X[sub][i] = -1e30f;
      }
  }
  float mx = m;
#pragma unroll
  for (int sub = 0; sub < 2; ++sub)
#pragma unroll
    for (int i = 0; i < 16; ++i) mx = fmaxf(mx, X[sub][i]);
  mx = fmaxf(mx, __shfl_xor(mx, 32));
  const float alpha = __expf(m - mx);
  m = mx;
  float ps = 0.f;
#pragma unroll
  for (int sub = 0; sub < 2; ++sub)
#pragma unroll
    for (int i = 0; i < 16; ++i) { const float pv = __expf(X[sub][i] - mx); X[sub][i] = pv; ps += pv; }
  l = l * alpha + ps;
#pragma unroll
  for (int dt = 0; dt < DT; ++dt)
#pragma unroll
    for (int i = 0; i < 16; ++i) Y[dt][i] *= alpha;
#pragma unroll
  for (int sub = 0; sub < 2; ++sub)
#pragma unroll
    for (int s = 0; s < 2; ++s) {
      const bf16x8 pf = pack8(X[sub], s);
#pragma unroll
      for (int dt = 0; dt < DT; ++dt) {
        const bf16_t* vp = vbase + (sub * 32 + 16 * s) * VLD_ + dt * 32;
        const s16x4 lo = tr_read(vp), hi = tr_read(vp + 8 * VLD_);
        const bf16x8 vf = __builtin_shufflevector(lo, hi, 0, 1, 2, 3, 4, 5, 6, 7);
        Y[dt] = MFMA32(vf, pf, Y[dt]);
      }
    }
}

constexpr int A0_KLD = 72, A0_VLD = 96;
constexpr int A0_LDS = 64 * A0_KLD * 2 + 64 * A0_VLD * 2;
DI void phase_attn_win(KP p, char* smem) {
  char* const ws = ows(p);
  bf16_t* sK = (bf16_t*)smem;
  bf16_t* sV = sK + 64 * A0_KLD;
  const bf16_t* Q = (const bf16_t*)(ws + OFF_U + U0_Q);
  const bf16_t* Kb = (const bf16_t*)(ws + OFF_U + U0_K);
  const bf16_t* Vb = (const bf16_t*)(ws + OFF_U + U0_V);
  bf16_t* O = (bf16_t*)(ws + OFF_U + U0_O);
  const float* sink = gin(p, 9);
  const int tid = otid(), lane = tid & 63, wid = tid >> 6, r = lane & 31, h = lane >> 5;
  const bf16_t* vbase = sV + (4 * h + ((lane & 15) >> 2)) * A0_VLD + 16 * ((lane >> 4) & 1) + 4 * (lane & 3);
  const int NLAT = 16 * 4 * 32 * 2, NCTX = 16 * 16;
  for (int it = obid(); it < NLAT + NCTX; it += gridDim.x) {
    const bool lat = it < NLAT;
    int b, kvh, qb = 0, head, qrow, qpos;
    if (lat) {
      b = it >> 8; kvh = (it >> 6) & 3; qb = (it >> 1) & 31; const int hp = it & 1;
      head = kvh * 4 + hp * 2 + (wid >> 2);
      qpos = qb * 128 + (wid & 3) * 32 + r; qrow = b * 4096 + qpos;
    } else {
      const int i2 = it - NLAT; b = i2 >> 4; head = i2 & 15; kvh = head >> 2;
      qpos = wid * 32 + r; qrow = TL + b * 256 + qpos;
    }
    bf16x8 qf[4];
#pragma unroll
    for (int s = 0; s < 4; ++s) qf[s] = *(const bf16x8*)(Q + (size_t)qrow * DM + head * 64 + 16 * s + 8 * h);
    f32x16 Y[2];
#pragma unroll
    for (int dt = 0; dt < 2; ++dt)
#pragma unroll
      for (int i = 0; i < 16; ++i) Y[dt][i] = 0.f;
    float m = sink[head], l = h == 0 ? 1.0f : 0.0f;
    const int kr = tid >> 3, k8 = (tid & 7) * 8;
    auto tile_ok = [&](int t) -> bool { if (t >= 6) return true; if (!lat) return false; const int kt = 2 * qb - 2 + t; return kt >= 0 && kt < 64; };
    auto trow = [&](int t) -> size_t { return t < 6 ? (size_t)b * 4096 + (2 * qb - 2 + t) * 64 + kr : (size_t)TL + b * 256 + (t - 6) * 64 + kr; };
    int t = 0;
    while (t < 10 && !tile_ok(t)) ++t;
    u32x4 rk = ld16(Kb + trow(t) * 256 + kvh * 64 + k8), rv = ld16(Vb + trow(t) * 256 + kvh * 64 + k8);
    while (t < 10) {
      __syncthreads();
      *(u32x4*)(sK + kr * A0_KLD + k8) = rk;
      *(u32x4*)(sV + kr * A0_VLD + k8) = rv;
      __syncthreads();
      int tn = t + 1;
      while (tn < 10 && !tile_ok(tn)) ++tn;
      if (tn < 10) { rk = ld16(Kb + trow(tn) * 256 + kvh * 64 + k8); rv = ld16(Vb + trow(tn) * 256 + kvh * 64 + k8); }
      if (t < 6) attn_tile<2, A0_VLD, true>(sK, A0_KLD, vbase, qf, Y, m, l, r, h, qpos, (2 * qb - 2 + t) * 64);
      else attn_tile<2, A0_VLD, false>(sK, A0_KLD, vbase, qf, Y, m, l, r, h, 0, 0);
      t = tn;
    }
    const float lt = l + __shfl_xor(l, 32);
    const float inv = 1.0f / lt;
#pragma unroll
    for (int dt = 0; dt < 2; ++dt)
#pragma unroll
      for (int g = 0; g < 4; ++g) {
        const float i8 = inv * O8_SCALE;
        *(unsigned*)((unsigned char*)O + (size_t)qrow * DM + head * 64 + dt * 32 + 8 * g + 4 * h) = pk4_fp8(Y[dt][4 * g] * i8, Y[dt][4 * g + 1] * i8, Y[dt][4 * g + 2] * i8, Y[dt][4 * g + 3] * i8);
      }
  }
}

constexpr int A1_KLD = 136, A1_VLD = 160;
constexpr int A1_K8LD = 144;
constexpr int A1_V8LD = 80;
constexpr int A1_KB = 64 * A1_K8LD, A1_VB = 128 * A1_V8LD;
constexpr int A1_LDS = 2 * A1_KB + 2 * A1_VB + 4 * 128 * 32 * 4;
DI void qk_tile(const bf16_t* sK, int kld, const bf16x8 (&qf)[4], f32x16 (&X)[2], int r, int h) {
  bf16x8 kf[2][4];
#pragma unroll
  for (int sub = 0; sub < 2; ++sub)
#pragma unroll
    for (int s = 0; s < 4; ++s) kf[sub][s] = *(const bf16x8*)(sK + (sub * 32 + r) * kld + 16 * s + 8 * h);
#pragma unroll
  for (int sub = 0; sub < 2; ++sub) {
#pragma unroll
    for (int i = 0; i < 16; ++i) X[sub][i] = 0.f;
#pragma unroll
    for (int s = 0; s < 4; ++s) X[sub] = MFMA32(kf[sub][s], qf[s], X[sub]);
  }
}
typedef int v8i_t __attribute__((ext_vector_type(8)));
typedef int v4i_t __attribute__((ext_vector_type(4)));
DI void qk8_tile(const unsigned char* sK8, int kld8, const v8i_t& q8, f32x16 (&X)[2], int r, int h) {
  v8i_t kf[2];
#pragma unroll
  for (int sub = 0; sub < 2; ++sub) { const v4i_t* q_ = (const v4i_t*)(sK8 + (sub * 32 + r) * kld8 + 32 * h); kf[sub] = __builtin_shufflevector(q_[0], q_[1], 0, 1, 2, 3, 4, 5, 6, 7); }
#pragma unroll
  for (int sub = 0; sub < 2; ++sub) {
    f32x16 z;
#pragma unroll
    for (int i = 0; i < 16; ++i) z[i] = 0.f;
    X[sub] = __builtin_amdgcn_mfma_scale_f32_32x32x64_f8f6f4(kf[sub], q8, z, 0, 0, 0, 0x7f7f7f7f, 0, 0x7f7f7f7f);
  }
}
template <int DT, int QSC = 1, int PSH = 0>
DI void softmax_lazy(f32x16 (&X)[2], f32x16 (&Y)[DT], float& m, float& l) {
  constexpr float THR = 4.0f * QSC, L2E = 1.44269504089f / QSC;
  float c0 = X[0][0], c1 = X[0][1], c2 = X[0][2], c3 = X[0][3];
#pragma unroll
  for (int i = 4; i < 16; i += 4) { c0 = fmaxf(c0, X[0][i]); c1 = fmaxf(c1, X[0][i + 1]); c2 = fmaxf(c2, X[0][i + 2]); c3 = fmaxf(c3, X[0][i + 3]); }
#pragma unroll
  for (int i = 0; i < 16; i += 4) { c0 = fmaxf(c0, X[1][i]); c1 = fmaxf(c1, X[1][i + 1]); c2 = fmaxf(c2, X[1][i + 2]); c3 = fmaxf(c3, X[1][i + 3]); }
  float mx = fmaxf(fmaxf(c0, c1), fmaxf(c2, c3));
  { float a, b; swap32(mx, a, b); mx = fmaxf(a, b); }
  if (__builtin_amdgcn_ballot_w64(mx > m + THR) != 0ull) {
    const float mn = fmaxf(m, mx);
    const float alpha = __builtin_amdgcn_exp2f((m - mn) * L2E);
    m = mn; l *= alpha;
#pragma unroll
    for (int dt = 0; dt < DT; ++dt)
#pragma unroll
      for (int i = 0; i < 16; ++i) Y[dt][i] *= alpha;
  }
  const float nm = fmaf(-m, L2E, (float)PSH);
  float ps0 = 0.f, ps1 = 0.f, ps2 = 0.f, ps3 = 0.f;
#pragma unroll
  for (int sub = 0; sub < 2; ++sub)
#pragma unroll
    for (int i = 0; i < 16; i += 4) {
      const float p0 = __builtin_amdgcn_exp2f(fmaf(X[sub][i], L2E, nm)), p1 = __builtin_amdgcn_exp2f(fmaf(X[sub][i + 1], L2E, nm));
      const float p2 = __builtin_amdgcn_exp2f(fmaf(X[sub][i + 2], L2E, nm)), p3 = __builtin_amdgcn_exp2f(fmaf(X[sub][i + 3], L2E, nm));
      X[sub][i] = p0; X[sub][i + 1] = p1; X[sub][i + 2] = p2; X[sub][i + 3] = p3;
      asm("v_add_f32 %0, %1, %0" : "+v"(ps0) : "v"(p0));
      asm("v_add_f32 %0, %1, %0" : "+v"(ps1) : "v"(p1));
      asm("v_add_f32 %0, %1, %0" : "+v"(ps2) : "v"(p2));
      asm("v_add_f32 %0, %1, %0" : "+v"(ps3) : "v"(p3));
    }
  asm("v_add_f32 %0, %1, %0" : "+v"(ps0) : "v"(ps1));
  asm("v_add_f32 %0, %1, %0" : "+v"(ps2) : "v"(ps3));
  l += ps0 + ps2;
}
template <int DT, int VLD_>
DI void pv_tile(const f32x16 (&X)[2], const bf16_t* vbase, f32x16 (&Y)[DT]) {
#pragma unroll
  for (int sub = 0; sub < 2; ++sub)
#pragma unroll
    for (int s = 0; s < 2; ++s) {
      const bf16x8 pf = pack8(X[sub], s);
#pragma unroll
      for (int dt = 0; dt < DT; ++dt) {
        const bf16_t* vp = vbase + (sub * 32 + 16 * s) * VLD_ + dt * 32;
        const s16x4 lo = tr_read(vp), hi = tr_read(vp + 8 * VLD_);
        const bf16x8 vf = __builtin_shufflevector(lo, hi, 0, 1, 2, 3, 4, 5, 6, 7);
        Y[dt] = MFMA32(vf, pf, Y[dt]);
      }
    }
}
DI void phase_attn_diff(KP p, char* smem) {
  char* const ws = ows(p);
  unsigned char* sK = (unsigned char*)smem;
  unsigned char* sV = (unsigned char*)(smem + 2 * A1_KB);
  float* comb = (float*)(smem + 2 * A1_KB + 2 * A1_VB);
  const bf16_t* Q = (const bf16_t*)(ws + OFF_U + U1_Q);
  const unsigned char* K8 = (const unsigned char*)(ws + OFF_U + U1_K);
  const unsigned char* Vt = (const unsigned char*)(ws + OFF_U + U1_V);
  bf16_t* O = (bf16_t*)(ws + OFF_U + U1_O);
  const int tid = otid(), lane = tid & 63, wid = tid >> 6, r = lane & 31, h = lane >> 5, grp = wid >> 2;
  const float lambda_init = 0.8f - 0.6f * 0.74081822068f;
  float lam_full;
  {
    const float* lf = gin(p, 12);
    float s1 = 0.f, s2 = 0.f;
    for (int i = 0; i < 64; ++i) { s1 += lf[i] * lf[64 + i]; s2 += lf[128 + i] * lf[192 + i]; }
    lam_full = expf(s1) - expf(s2) + lambda_init;
  }
  const float* subg = gin(p, 13);
  const int NLAT = 16 * 8 * 32, NCTX = 16 * 8 * 2;
  const int kr = tid >> 3, kc = (tid & 7) * 16;
  for (int it = obid(); it < NLAT + NCTX; it += gridDim.x) {
    const bool lat = it < NLAT;
    int b, head, qrow, t0;
    const int nt = 68;
    if (lat) { b = it >> 8; head = (it >> 5) & 7; const int qb = it & 31; qrow = b * 4096 + qb * 128 + (wid & 3) * 32 + r; t0 = 0; }
    else { const int i2 = it - NLAT; b = i2 >> 4; head = (i2 >> 1) & 7; const int hf = i2 & 1; qrow = TL + b * 256 + hf * 128 + (wid & 3) * 32 + r; t0 = 64; }
    v8i_t q8;
    {
      const bf16_t* qp = Q + (size_t)qrow * DM + head * 128 + grp * 64 + 32 * h;
#pragma unroll
      for (int c4 = 0; c4 < 4; ++c4) {
        const u32x4 w = ld16(qp + 8 * c4);
        q8[2 * c4] = (int)pk4_fp8(bflo(w.x) * 8.f, bfhi(w.x) * 8.f, bflo(w.y) * 8.f, bfhi(w.y) * 8.f);
        q8[2 * c4 + 1] = (int)pk4_fp8(bflo(w.z) * 8.f, bfhi(w.z) * 8.f, bflo(w.w) * 8.f, bfhi(w.w) * 8.f);
      }
    }
    f32x16 Y[4];
#pragma unroll
    for (int dt = 0; dt < 4; ++dt)
#pragma unroll
      for (int i = 0; i < 16; ++i) Y[dt][i] = 0.f;
    float m = -1e30f, l = 0.f;
    auto goff = [&](int t) -> size_t { return (t < 64 ? (size_t)b * 4096 + t * 64 + kr : (size_t)TL + b * 256 + (t - 64) * 64 + kr) * 1024 + head * 128 + kc; };
    auto stK = [&](int t, const u32x4& a) { *(u32x4*)(sK + (t & 1) * A1_KB + kr * A1_K8LD + kc) = a; };
    const int vd = tid >> 2, vcx = (tid & 3) * 16;
    auto voff = [&](int t) -> size_t { return t < 64 ? ((size_t)(b * 1024 + head * 128 + vd) * 4096 + (size_t)t * 64 + vcx) : ((size_t)16 * 1024 * 4096 + (size_t)(b * 1024 + head * 128 + vd) * 256 + (size_t)(t - 64) * 64 + vcx); };
    auto stV = [&](int t, const u32x4& a) { *(u32x4*)(sV + (t & 1) * A1_VB + vd * A1_V8LD + vcx) = a; };
    u32x4 rk0, rv0;
    __syncthreads();
    rk0 = *(const u32x4*)(K8 + goff(t0)); stK(t0, rk0);
    rk0 = *(const u32x4*)(K8 + goff(t0 + 1)); stK(t0 + 1, rk0);
    rk0 = *(const u32x4*)(K8 + goff(t0 + 2));
    rv0 = *(const u32x4*)(Vt + voff(t0));
    __syncthreads();
    f32x16 Xn[2];
    qk8_tile(sK + (t0 & 1) * A1_KB + grp * 64, A1_K8LD, q8, Xn, r, h);
    __syncthreads();
    v8i_t p8;
    auto pv8 = [&](int t) __attribute__((always_inline)) {
      const unsigned char* vb8 = sV + (t & 1) * A1_VB + r * A1_V8LD + 32 * h;
#pragma unroll
      for (int dt = 0; dt < 4; ++dt) {
        const v4i_t* q_ = (const v4i_t*)(vb8 + dt * 32 * A1_V8LD);
        const v8i_t vf = __builtin_shufflevector(q_[0], q_[1], 0, 1, 2, 3, 4, 5, 6, 7);
        Y[dt] = __builtin_amdgcn_mfma_scale_f32_32x32x64_f8f6f4(vf, p8, Y[dt], 0, 0, 0, 0x7f7f7f7f, 0, 0x7f7f7f7f);
      }
    };
    for (int t = t0; t < nt; ++t) {
      if (t + 2 < nt) stK(t + 2, rk0);
      stV(t, rv0);
      if (t + 3 < nt) rk0 = *(const u32x4*)(K8 + goff(t + 3));
      if (t + 1 < nt) rv0 = *(const u32x4*)(Vt + voff(t + 1));
      f32x16 X[2];
      X[0] = Xn[0]; X[1] = Xn[1];
      if (t + 1 < nt) qk8_tile(sK + ((t + 1) & 1) * A1_KB + grp * 64, A1_K8LD, q8, Xn, r, h);
      if (t > t0) pv8(t - 1);
      softmax_lazy<4, 8, 2>(X, Y, m, l);
#pragma unroll
      for (int sub = 0; sub < 2; ++sub)
#pragma unroll
        for (int g4 = 0; g4 < 4; ++g4) p8[4 * sub + g4] = (int)pk4_fp8_nc(X[sub][4 * g4], X[sub][4 * g4 + 1], X[sub][4 * g4 + 2], X[sub][4 * g4 + 3]);
      __syncthreads();
    }
    pv8(nt - 1);
    const float lt = l + __shfl_xor(l, 32);
    const float inv = 1.0f / lt;
    if (grp == 1) {
#pragma unroll
      for (int dt = 0; dt < 4; ++dt)
#pragma unroll
        for (int i = 0; i < 16; ++i) comb[(((wid & 3) * 128) + dt * 32 + (i & 3) + 8 * (i >> 2) + 4 * h) * 32 + r] = Y[dt][i] * inv;
    }
    __syncthreads();
    if (grp == 0) {
      float ss = 0.f;
#pragma unroll
      for (int dt = 0; dt < 4; ++dt)
#pragma unroll
        for (int i = 0; i < 16; ++i) {
          const float o2 = comb[(((wid & 3) * 128) + dt * 32 + (i & 3) + 8 * (i >> 2) + 4 * h) * 32 + r];
          const float vv = Y[dt][i] * inv - lam_full * o2;
          Y[dt][i] = vv; ss += vv * vv;
        }
      ss += __shfl_xor(ss, 32);
      const float rs = rsqrtf(ss * (1.0f / 128.0f) + 1e-6f) * (1.0f - lambda_init);
#pragma unroll
      for (int dt = 0; dt < 4; ++dt)
#pragma unroll
        for (int g = 0; g < 4; ++g) {
          const int d0 = dt * 32 + 8 * g + 4 * h;
          const f32x4 sg = *(const f32x4*)(subg + d0);
          const float r8 = rs * O8_SCALE;
          *(unsigned*)((unsigned char*)O + (size_t)qrow * DM + head * 128 + d0) = pk4_fp8(Y[dt][4 * g] * r8 * sg[0], Y[dt][4 * g + 1] * r8 * sg[1], Y[dt][4 * g + 2] * r8 * sg[2], Y[dt][4 * g + 3] * r8 * sg[3]);
        }
    }
  }
}

DI u32x4 rwkv_mix_load(const bf16_t* hb, const float* mu, int mixi, int row, int k) {
  int s, L;
  if (row < TL) { s = row & 4095; L = 4096; } else { s = (row - TL) & 255; L = 256; }
  const bf16_t* hp = hb + (size_t)row * DM + k;
  const u32x4 c = ld16(hp);
  u32x4 pv = (u32x4){0u, 0u, 0u, 0u}, nx = (u32x4){0u, 0u, 0u, 0u};
  if (s > 0) pv = ld16(hp - DM);
  if (s < L - 1) nx = ld16(hp + DM);
  const float* m0 = mu + (size_t)(0 * 6 + mixi) * DM + k;
  const float* m1 = mu + (size_t)(1 * 6 + mixi) * DM + k;
  const f32x4 a0 = *(const f32x4*)m0, a1 = *(const f32x4*)(m0 + 4), b0 = *(const f32x4*)m1, b1 = *(const f32x4*)(m1 + 4);
  float cv[8] = {bflo(c.x), bfhi(c.x), bflo(c.y), bfhi(c.y), bflo(c.z), bfhi(c.z), bflo(c.w), bfhi(c.w)};
  float pvv[8] = {bflo(pv.x), bfhi(pv.x), bflo(pv.y), bfhi(pv.y), bflo(pv.z), bfhi(pv.z), bflo(pv.w), bfhi(pv.w)};
  float nv[8] = {bflo(nx.x), bfhi(nx.x), bflo(nx.y), bfhi(nx.y), bflo(nx.z), bfhi(nx.z), bflo(nx.w), bfhi(nx.w)};
  float mu0[8] = {a0[0], a0[1], a0[2], a0[3], a1[0], a1[1], a1[2], a1[3]};
  float mu1[8] = {b0[0], b0[1], b0[2], b0[3], b1[0], b1[1], b1[2], b1[3]};
  float o[8];
#pragma unroll
  for (int j = 0; j < 8; ++j) o[j] = cv[j] + (pvv[j] - cv[j]) * mu0[j] + (nv[j] - cv[j]) * mu1[j];
  u32x4 w; w.x = pk2(o[0], o[1]); w.y = pk2(o[2], o[3]); w.z = pk2(o[4], o[5]); w.w = pk2(o[6], o[7]);
  return w;
}
template <int ACT  , class AL>
DI void rwkv_gemm_tile(char* smem, AL la, const bf16_t* Bt, int K, int ldb, bf16_t* dst, int ldd, int row0, int col0, int ncols_valid) {
  auto lb = [&](int tn, int k) -> u32x4 { return (col0 + tn) < ncols_valid ? ld16(Bt + (size_t)(col0 + tn) * ldb + k) : (u32x4){0u, 0u, 0u, 0u}; };
  auto ep = [&](const f32x4 (&acc)[4][2], int r0, int c0, int fr, int fq) {
#pragma unroll
    for (int m = 0; m < 4; ++m)
#pragma unroll
      for (int n = 0; n < 2; ++n)
#pragma unroll
        for (int j = 0; j < 4; ++j) {
          const int row = row0 + r0 + m * 16 + fq * 4 + j, col = col0 + c0 + n * 16 + fr;
          float v = acc[m][n][j];
          if (ACT == 1) v = 1.0f - 2.0f * __builtin_amdgcn_rcpf(1.0f + __expf(2.0f * v));
          if (ACT == 2) v = sigmoidf_(v);
          if (col < ncols_valid) dst[(size_t)row * ldd + col] = f2bf(v);
        }
  };
  sgemm_tile(smem, K, la, lb, ep);
}
DI void phase_rwkv_mix(KP p, char* smem) {
  char* const ws = ows(p);
  const int lane = otid() & 63, wid = otid() >> 6;
  const bf16_t* hb = (const bf16_t*)(ws + OFF_H);
  const float* mu = gin(p, 18);
  bf16_t* XR = (bf16_t*)(ws + OFF_U + U3_XR);
  bf16_t* XK = (bf16_t*)(ws + OFF_U + U3_XK);
  bf16_t* XV = (bf16_t*)(ws + OFF_U + U3_XV);
  const int ch0 = lane * 16;
  for (int r = obid() * 8 + wid; r < TT; r += gridDim.x * 8) {
    int s, L;
    if (r < TL) { s = r & 4095; L = 4096; } else { s = (r - TL) & 255; L = 256; }
    const bf16_t* hp = hb + (size_t)r * DM + ch0;
    float c[16], pv[16], nx[16];
    {
      const u32x4 a = ld16(hp), b = ld16(hp + 8);
      c[0] = bflo(a.x); c[1] = bfhi(a.x); c[2] = bflo(a.y); c[3] = bfhi(a.y); c[4] = bflo(a.z); c[5] = bfhi(a.z); c[6] = bflo(a.w); c[7] = bfhi(a.w);
      c[8] = bflo(b.x); c[9] = bfhi(b.x); c[10] = bflo(b.y); c[11] = bfhi(b.y); c[12] = bflo(b.z); c[13] = bfhi(b.z); c[14] = bflo(b.w); c[15] = bfhi(b.w);
    }
#pragma unroll
    for (int j = 0; j < 16; ++j) { pv[j] = 0.f; nx[j] = 0.f; }
    if (s > 0) {
      const u32x4 a = ld16(hp - DM), b = ld16(hp - DM + 8);
      pv[0] = bflo(a.x); pv[1] = bfhi(a.x); pv[2] = bflo(a.y); pv[3] = bfhi(a.y); pv[4] = bflo(a.z); pv[5] = bfhi(a.z); pv[6] = bflo(a.w); pv[7] = bfhi(a.w);
      pv[8] = bflo(b.x); pv[9] = bfhi(b.x); pv[10] = bflo(b.y); pv[11] = bfhi(b.y); pv[12] = bflo(b.z); pv[13] = bfhi(b.z); pv[14] = bflo(b.w); pv[15] = bfhi(b.w);
    }
    if (s < L - 1) {
      const u32x4 a = ld16(hp + DM), b = ld16(hp + DM + 8);
      nx[0] = bflo(a.x); nx[1] = bfhi(a.x); nx[2] = bflo(a.y); nx[3] = bfhi(a.y); nx[4] = bflo(a.z); nx[5] = bfhi(a.z); nx[6] = bflo(a.w); nx[7] = bfhi(a.w);
      nx[8] = bflo(b.x); nx[9] = bfhi(b.x); nx[10] = bflo(b.y); nx[11] = bfhi(b.y); nx[12] = bflo(b.z); nx[13] = bfhi(b.z); nx[14] = bflo(b.w); nx[15] = bfhi(b.w);
    }
#pragma unroll
    for (int q = 0; q < 3; ++q) {
      const int mixi = q == 0 ? 0 : q + 1;
      if (q == 0 && r >= TL) continue;
      unsigned char* dst = (unsigned char*)(q == 0 ? XR : q == 1 ? XK : XV) + (size_t)r * DM + ch0;
      const float* m0 = mu + (size_t)(0 * 6 + mixi) * DM + ch0;
      const float* m1 = mu + (size_t)(1 * 6 + mixi) * DM + ch0;
      float o[16];
#pragma unroll
      for (int j4 = 0; j4 < 4; ++j4) {
        const f32x4 a = *(const f32x4*)(m0 + 4 * j4), b = *(const f32x4*)(m1 + 4 * j4);
#pragma unroll
        for (int j = 0; j < 4; ++j) { const int k = 4 * j4 + j; o[k] = c[k] + (pv[k] - c[k]) * a[j] + (nx[k] - c[k]) * b[j]; }
      }
      u32x4 w0;
      w0.x = pk4_fp8(o[0] * X8_SCALE, o[1] * X8_SCALE, o[2] * X8_SCALE, o[3] * X8_SCALE); w0.y = pk4_fp8(o[4] * X8_SCALE, o[5] * X8_SCALE, o[6] * X8_SCALE, o[7] * X8_SCALE);
      w0.z = pk4_fp8(o[8] * X8_SCALE, o[9] * X8_SCALE, o[10] * X8_SCALE, o[11] * X8_SCALE); w0.w = pk4_fp8(o[12] * X8_SCALE, o[13] * X8_SCALE, o[14] * X8_SCALE, o[15] * X8_SCALE);
      *(u32x4*)dst = w0;
    }
  }
}
struct RkvSched {
  const char* X0; const char* X1; const char* X2; const char* W; int G, c;
  DI bool next(int i, fg::Unit& u) const {
    int pmg, pn; if (!fg::static_order(i, G, c, 800, 4, pmg, pn)) return false;
    const int job = (pmg >= 256) + (pmg >= 528);
    u.pm = pmg - (job ? 256 + (job - 1) * 272 : 0); u.pn = pn; u.aux = job;
    u.A = X0 + (size_t)job * SZ_TT + (size_t)u.pm * 256 * 1024;
    u.B = W + (size_t)job * 1024 * 1024 * 2 + (size_t)u.pn * 256 * 1024; return true;
  }
  DI const LAS int* rows(int) const { return nullptr; }
};
DI void phase_rwkv_rkv(KP p, char* smem) {
  char* const ws = ows(p);
  LAS unsigned char* lds = (LAS unsigned char*)smem;
  char* U = ws + OFF_U;
  RkvSched S; S.X0 = U + U3_XR; S.X1 = U + U3_XK; S.X2 = U + U3_XV; S.W = ws + OFF_WMIX + W_R * 2; S.G = gridDim.x; S.c = obid();
  auto ep = [&](const f32x16 (&acc)[2][2][2], const fg::Unit& u, int wr, int wc, int r, int h) {
    bf16_t* dst = (bf16_t*)(U + (u.aux ? SZ_TL + (size_t)(u.aux - 1) * SZ_TT : (size_t)0));
    constexpr float inv = 1.0f / (X8_SCALE * 32.0f);
#pragma unroll
    for (int ai = 0; ai < 2; ++ai)
#pragma unroll
      for (int m = 0; m < 2; ++m) {
        const size_t row = (size_t)u.pm * 256 + ai * 128 + wr * 64 + m * 32 + r;
#pragma unroll
        for (int bj = 0; bj < 2; ++bj) {
          const f32x16& a = acc[ai][bj][m];
          u32x4 w0, w1;
          w0.x = pk2(a[0] * inv, a[1] * inv); w0.y = pk2(a[2] * inv, a[3] * inv); w0.z = pk2(a[4] * inv, a[5] * inv); w0.w = pk2(a[6] * inv, a[7] * inv);
          w1.x = pk2(a[8] * inv, a[9] * inv); w1.y = pk2(a[10] * inv, a[11] * inv); w1.z = pk2(a[12] * inv, a[13] * inv); w1.w = pk2(a[14] * inv, a[15] * inv);
          bf16_t* q = dst + row * DM + u.pn * 256 + bj * 128 + wc * 32 + 16 * h;
          *(u32x4*)q = w0; *(u32x4*)(q + 8) = w1;
        }
      }
  };
  fg::gemm_phase_f8<false, true>(lds, 512, 512, 512, S, ep);
}

DI void phase_rwkv_feat1(KP p, char* smem) {
  char* const ws = ows(p);
  const bf16_t* hb = (const bf16_t*)(ws + OFF_H);
  const bf16_t* wm = (const bf16_t*)(ws + OFF_WMIX);
  const float* mu = gin(p, 18);
  char* U = ws + OFF_U;
  const int n3 = 544, n4 = n3 + 544, n5 = n4 + 512;
  for (int t = obid(); t < n5; t += gridDim.x) {
    if (t < n3) {
      const int row0 = t * 128;
      auto la = [&](int trow, int k) -> u32x4 { return rwkv_mix_load(hb, mu, 1, row0 + trow, k); };
      rwkv_gemm_tile<1>(smem, la, wm + W_WA1, 1024, 1024, (bf16_t*)(U + U3_LW), 128, row0, 0, 128);
    } else if (t < n4) {
      const int row0 = (t - n3) * 128;
      auto la = [&](int trow, int k) -> u32x4 { return rwkv_mix_load(hb, mu, 4, row0 + trow, k); };
      rwkv_gemm_tile<0>(smem, la, wm + W_AA1, 1024, 1024, (bf16_t*)(U + U3_LA), 128, row0, 0, 128);
    } else {
      const int row0 = (t - n4) * 128;
      auto la = [&](int trow, int k) -> u32x4 { return rwkv_mix_load(hb, mu, 5, row0 + trow, k); };
      rwkv_gemm_tile<2>(smem, la, wm + W_G1, 1024, 1024, (bf16_t*)(U + U3_LG), 128, row0, 0, 128);
    }
  }
}
struct Feat2Sched {
  const char* U; const char* W; int G, c;
  DI bool next(int i, fg::Unit& u) const {
    const int L = i * G + c; if (L >= 2176 + 2176 + 1024) return false;
    const int job = (L >= 2176) + (L >= 4352), loc = L - job * 2176;
    if (job < 2) { u.pm = loc >> 3; u.pn = loc & 7; } else { u.pm = loc >> 2; u.pn = loc & 3; }
    u.aux = job;
    u.A = U + (job == 0 ? U3_LW : job == 1 ? U3_LA : U3_LG) + (size_t)u.pm * 256 * 128 * 2;
    u.B = W + ((job == 0 ? W_WA2 : job == 1 ? W_AA2 : W_G2) + (size_t)u.pn * 256 * 128) * 2; return true;
  }
  DI const LAS int* rows(int) const { return nullptr; }
};
DI void phase_rwkv_feat2(KP p, char* smem) {
  char* const ws = ows(p);
  LAS unsigned char* lds = (LAS unsigned char*)smem;
  char* U = ws + OFF_U;
  Feat2Sched S; S.U = U; S.W = ws + OFF_WMIX; S.G = gridDim.x; S.c = obid();
  const float* w0 = gin(p, 20);
  const float* a0 = gin(p, 23);
  auto ep = [&](const f32x4 (&acc)[2][2][4][2], const fg::Unit& u, int wr, int wc, int fr, int fq) {
    const int job = u.aux, d = u.pn >> 2;
    const int colu = (job < 2 ? (u.pn & 3) : u.pn) * 256 + wc * 32 + 8 * fq;
    bf16_t* dst = (bf16_t*)(U + (job == 0 ? (d ? U3_LD1 : U3_LD0) : job == 1 ? (d ? U3_A1 : U3_A0) : U3_G));
    const float* bias = (job == 0 ? w0 : a0) + d * 1024;
#pragma unroll
    for (int ai = 0; ai < 2; ++ai)
#pragma unroll
      for (int m = 0; m < 4; ++m) {
        const size_t row = (size_t)u.pm * 256 + ai * 128 + wr * 64 + m * 16 + fr;
#pragma unroll
        for (int bj = 0; bj < 2; ++bj) {
          f32x4 x0 = acc[ai][bj][m][0], x1 = acc[ai][bj][m][1];
          if (job < 2) {
            const f32x4 b0 = *(const f32x4*)(bias + colu + bj * 128), b1 = *(const f32x4*)(bias + colu + bj * 128 + 4);
            const float sc_ = job == 0 ? -0.60653065971f : 1.0f;
#pragma unroll
            for (int j = 0; j < 4; ++j) { x0[j] = sc_ * sigmoidf_(x0[j] + b0[j]); x1[j] = sc_ * sigmoidf_(x1[j] + b1[j]); }
          }
          u32x4 w; w.x = pk2(x0[0], x0[1]); w.y = pk2(x0[2], x0[3]); w.z = pk2(x1[0], x1[1]); w.w = pk2(x1[2], x1[3]);
          *(u32x4*)(dst + row * DM + colu + bj * 128) = w;
        }
      }
  };
  fg::gemm_phase<false, true>(lds, 128, 128, 128, S, ep);
}

constexpr int C3_L = 32, C3_LDK = 72, C3_LDT = 40, C3_LDY = 36;
constexpr int C3_BT = 0, C3_RT = 4608, C3_KT = 9216, C3_CT = 13824, C3_KHT = 18432, C3_CHT = 23552, C3_VT = 28672, C3_GKB = 33792, C3_GKR = 36352,
              C3_GCR = 38912, C3_S0 = 41472, C3_U = 50688, C3_MCB = 55808, C3_Y = 59904, C3_E = 69120, C3_TOT = 69376, C3_SCAN = 70400;
constexpr int SC_LDS = 2 * C3_SCAN;
DI void lds_bar() { asm volatile("s_waitcnt lgkmcnt(0)" ::: "memory"); __builtin_amdgcn_s_barrier(); asm volatile("" ::: "memory"); }
#define DPP_ADD(s, ctrl) ((s) + __builtin_bit_cast(float, __builtin_amdgcn_update_dpp(0, __builtin_bit_cast(int, (s)), (ctrl), 0xF, 0xF, true)))
DI float wave_sum_dpp(float s) {
  s = DPP_ADD(s, 0xB1); s = DPP_ADD(s, 0x4E); s = DPP_ADD(s, 0x141); s = DPP_ADD(s, 0x140);
  const int si = __builtin_bit_cast(int, s);
  const float a0 = __builtin_bit_cast(float, __builtin_amdgcn_readlane(si, 0)), a1 = __builtin_bit_cast(float, __builtin_amdgcn_readlane(si, 16));
  const float a2 = __builtin_bit_cast(float, __builtin_amdgcn_readlane(si, 32)), a3 = __builtin_bit_cast(float, __builtin_amdgcn_readlane(si, 48));
  return (a0 + a1) + (a2 + a3);
}
DI void phase_rwkv_scan(KP p, char* smem) {
  char* const ws = ows(p);
  const int tid = otid(), lane = tid & 63, wid = tid >> 6, sc = wid >> 2, w4 = wid & 3, r = lane & 31, h = lane >> 5;
  char* sb = smem + sc * C3_SCAN;
  bf16_t* Bt = (bf16_t*)(sb + C3_BT); bf16_t* Rt = (bf16_t*)(sb + C3_RT); bf16_t* Kt = (bf16_t*)(sb + C3_KT); bf16_t* Ct = (bf16_t*)(sb + C3_CT);
  bf16_t* KhT = (bf16_t*)(sb + C3_KHT); bf16_t* ChT = (bf16_t*)(sb + C3_CHT); bf16_t* Vt = (bf16_t*)(sb + C3_VT);
  bf16_t* GkbT = (bf16_t*)(sb + C3_GKB); bf16_t* GkrT = (bf16_t*)(sb + C3_GKR); bf16_t* GcrT = (bf16_t*)(sb + C3_GCR);
  bf16_t* S0b = (bf16_t*)(sb + C3_S0); bf16_t* Ub = (bf16_t*)(sb + C3_U);
  float* McbP = (float*)(sb + C3_MCB); float* Yb = (float*)(sb + C3_Y); float* Eb = (float*)(sb + C3_E); float* Tot = (float*)(sb + C3_TOT);
  char* U = ws + OFF_U;
  const bf16_t* Kx = (const bf16_t*)(U + U3_K);
  const bf16_t* Vx = (const bf16_t*)(U + U3_V);
  const bf16_t* Rx = (const bf16_t*)(U + U3_R);
  const int ti = w4 >> 1, tj = w4 & 1;
  const int tio = w4 & 1;
  const int sv = w4 * 16 + (lane >> 2), jq = lane & 3;
  for (int base = obid() * 2; base < 512; base += gridDim.x * 2) {
    const int item = base + sc, dir = item & 1, head = (item >> 1) & 15, b = item >> 5;
    const bf16_t* Ax = (const bf16_t*)(U + (dir ? U3_A1 : U3_A0));
    const bf16_t* Lx = (const bf16_t*)(U + (dir ? U3_LD1 : U3_LD0));
    bf16_t* Ox = (bf16_t*)(U + (dir ? U3_O1 : U3_O0));
    const int ch = head * 64 + lane;
    const float kkw = gin(p, 28)[ch], kaw = gin(p, 29)[ch];
    auto rowof = [&](int n) -> int {
      if (n < 256) { const int c = dir ? 255 - n : n; return TL + b * 256 + c; }
      const int s = dir ? 4095 - (n - 256) : n - 256; return b * 4096 + s;
    };
    f32x16 S;
#pragma unroll
    for (int i = 0; i < 16; ++i) S[i] = 0.f;
    for (int i = lane; i < 64 * C3_LDK / 4; i += 64) if (w4 == 0) ((unsigned long long*)S0b)[i] = 0ull;
    bf16_t pk_[8], pa_[8], pl_[8], pv_[8], pr_[8];
    auto prefetch = [&](int c) {
#pragma unroll
      for (int q = 0; q < 8; ++q) {
        const int n = c * C3_L + w4 * 8 + q;
        const size_t off = (size_t)rowof(n) * DM + ch;
        pk_[q] = Kx[off]; pa_[q] = Ax[off]; pl_[q] = Lx[off]; pv_[q] = Vx[off];
        pr_[q] = n >= 256 ? Rx[off] : (bf16_t)0;
      }
    };
    constexpr int NCH = 4352 / C3_L;
    prefetch(0);
    lds_bar();
    for (int c = 0; c < NCH; ++c) {
      float kkv[8], cv[8], kdv[8], lv[8], cl[8], rv[8], vv[8];
      {
        float run = 0.f;
#pragma unroll
        for (int q = 0; q < 8; ++q) {
          const float kv = bf2f(pk_[q]), av = bf2f(pa_[q]);
          lv[q] = bf2f(pl_[q]); rv[q] = bf2f(pr_[q]); vv[q] = bf2f(pv_[q]);
          const float kkr = kv * kkw;
          kkv[q] = kkr * __builtin_amdgcn_rsqf(fmaxf(wave_sum_dpp(kkr * kkr), 1e-24f));
          cv[q] = kkv[q] * av;
          kdv[q] = kv * (1.0f + (av - 1.0f) * kaw);
          run += lv[q]; cl[q] = run;
        }
        Tot[w4 * 64 + lane] = run;
      }
      if (c + 1 < NCH) prefetch(c + 1);
      lds_bar();
      {
        const float t0 = Tot[lane], t1 = Tot[64 + lane], t2 = Tot[128 + lane], t3 = Tot[192 + lane];
        const float cumL = (t0 + t1) + (t2 + t3);
        const float off = w4 == 0 ? 0.f : (w4 == 1 ? t0 : (w4 == 2 ? t0 + t1 : (t0 + t1) + t2));
        float kh[8], chh[8];
#pragma unroll
        for (int q = 0; q < 8; ++q) {
          const int t = w4 * 8 + q;
          const float cumt = off + cl[q], cump = cumt - lv[q];
          const float e1 = __expf(cump), e2 = __expf(cumt), e3 = __expf(-cumt), e4 = __expf(cumL - cumt);
          Bt[t * C3_LDK + lane] = f2bf(kkv[q] * e1);
          Rt[t * C3_LDK + lane] = f2bf(rv[q] * e2);
          Kt[t * C3_LDK + lane] = f2bf(kdv[q] * e3);
          Ct[t * C3_LDK + lane] = f2bf(cv[q] * e3);
          kh[q] = kdv[q] * e4; chh[q] = cv[q] * e4;
        }
        u32x4 w;
        w.x = pk2(kh[0], kh[1]); w.y = pk2(kh[2], kh[3]); w.z = pk2(kh[4], kh[5]); w.w = pk2(kh[6], kh[7]);
        *(u32x4*)(KhT + lane * C3_LDT + w4 * 8) = w;
        w.x = pk2(chh[0], chh[1]); w.y = pk2(chh[2], chh[3]); w.z = pk2(chh[4], chh[5]); w.w = pk2(chh[6], chh[7]);
        *(u32x4*)(ChT + lane * C3_LDT + w4 * 8) = w;
        w.x = pk2(vv[0], vv[1]); w.y = pk2(vv[2], vv[3]); w.z = pk2(vv[4], vv[5]); w.w = pk2(vv[6], vv[7]);
        *(u32x4*)(Vt + lane * C3_LDT + w4 * 8) = w;
        if (w4 == 0) Eb[lane] = __expf(cumL);
      }
      lds_bar();
      {
        const bf16_t* Ag = (w4 & 1) ? Kt : Ct;
        const bf16_t* Bg = (w4 & 2) ? Rt : Bt;
        f32x16 X;
#pragma unroll
        for (int i = 0; i < 16; ++i) X[i] = 0.f;
#pragma unroll
        for (int s = 0; s < 4; ++s) {
          const bf16x8 a = *(const bf16x8*)(Ag + r * C3_LDK + 16 * s + 8 * h);
          const bf16x8 bq = *(const bf16x8*)(Bg + r * C3_LDK + 16 * s + 8 * h);
          X = MFMA32(a, bq, X);
        }
        const bool incl = (w4 & 2) != 0;
#pragma unroll
        for (int i = 0; i < 16; ++i) { const int jr = (i & 3) + 8 * (i >> 2) + 4 * h; if (!(jr < r || (incl && jr == r))) X[i] = 0.f; }
        if (w4 == 0) {
#pragma unroll
          for (int i = 0; i < 16; ++i) { const int jr = (i & 3) + 8 * (i >> 2) + 4 * h; McbP[r * 32 + (jr & 3) * 8 + (jr >> 2)] = X[i]; }
        } else {
          bf16_t* G = w4 == 1 ? GkbT : (w4 == 2 ? GcrT : GkrT);
#pragma unroll
          for (int g = 0; g < 4; ++g) { u32x2 w; w.x = pk2(X[4 * g], X[4 * g + 1]); w.y = pk2(X[4 * g + 2], X[4 * g + 3]); *(u32x2*)(G + r * C3_LDT + 8 * g + 4 * h) = w; }
        }
      }
      lds_bar();
      f32x16 XO;
      {
        const bf16_t* Bq = (w4 & 2) ? Rt : Bt;
        const bf16_t* Gq = (w4 & 2) ? GkrT : GkbT;
#pragma unroll
        for (int i = 0; i < 16; ++i) XO[i] = 0.f;
#pragma unroll
        for (int s = 0; s < 4; ++s) {
          const bf16x8 a = *(const bf16x8*)(S0b + (32 * tio + r) * C3_LDK + 16 * s + 8 * h);
          const bf16x8 bq = *(const bf16x8*)(Bq + r * C3_LDK + 16 * s + 8 * h);
          XO = MFMA32(a, bq, XO);
        }
#pragma unroll
        for (int s = 0; s < 2; ++s) {
          const bf16x8 a = *(const bf16x8*)(Vt + (32 * tio + r) * C3_LDT + 16 * s + 8 * h);
          const bf16x8 bq = *(const bf16x8*)(Gq + r * C3_LDT + 16 * s + 8 * h);
          XO = MFMA32(a, bq, XO);
        }
        if (w4 < 2) {
#pragma unroll
          for (int i = 0; i < 16; ++i) Yb[(32 * tio + (i & 3) + 8 * (i >> 2) + 4 * h) * C3_LDY + r] = XO[i];
        }
      }
      lds_bar();
      {
        float u[8];
#pragma unroll
        for (int jj = 0; jj < 8; ++jj) u[jj] = 0.f;
        const unsigned ma = (unsigned)(size_t)(McbP + jq * 8);
        f32x4 yv[8];
#pragma unroll
        for (int i = 0; i < 8; ++i) yv[i] = *(const f32x4*)(Yb + sv * C3_LDY + 4 * i);
        f32x4 mA[4], mB[4];
#define C3_MLOAD(t_) asm volatile("ds_read_b128 %0, %2 offset:%c3\n\tds_read_b128 %1, %2 offset:%c4" : "=&v"(mA[(t_) & 3]), "=&v"(mB[(t_) & 3]) : "v"(ma), "i"((t_) * 128), "i"((t_) * 128 + 16) : "memory")
        C3_MLOAD(1); C3_MLOAD(2); C3_MLOAD(3);
        if (jq == 0) u[0] = yv[0][0];
#pragma unroll
        for (int t = 1; t < 32; ++t) {
          if (t + 3 < 32) { C3_MLOAD(t + 3); asm volatile("s_waitcnt lgkmcnt(6)" ::: "memory"); }
          else if (t + 2 < 32) asm volatile("s_waitcnt lgkmcnt(4)" ::: "memory");
          else if (t + 1 < 32) asm volatile("s_waitcnt lgkmcnt(2)" ::: "memory");
          else asm volatile("s_waitcnt lgkmcnt(0)" ::: "memory");
          asm volatile("" :: "v"(mA[t & 3]), "v"(mB[t & 3]));
          __builtin_amdgcn_sched_barrier(0);
          const f32x4 m0 = mA[t & 3], m1 = mB[t & 3];
          const int jl = (t - 1) >> 2;
          float part = 0.f;
#pragma unroll
          for (int jj = 0; jj < 8; ++jj) if (jj != jl && jj * 4 < t) part += u[jj] * (jj < 4 ? m0[jj] : m1[jj - 4]);
          part += u[jl] * (jl < 4 ? m0[jl] : m1[jl - 4]);
          part = DPP_ADD(part, 0xB1); part = DPP_ADD(part, 0x4E);
          const float ut = yv[t >> 2][t & 3] - part;
          u[t >> 2] = (jq == (t & 3)) ? ut : u[t >> 2];
        }
#undef C3_MLOAD
#pragma unroll
        for (int jj = 0; jj < 8; ++jj) Ub[sv * C3_LDT + jq + 4 * jj] = f2bf(u[jj]);
      }
      lds_bar();
      if (w4 >= 2) {
        f32x16 X2;
#pragma unroll
        for (int i = 0; i < 16; ++i) X2[i] = 0.f;
#pragma unroll
        for (int s = 0; s < 2; ++s) {
          const bf16x8 a = *(const bf16x8*)(Ub + (32 * tio + r) * C3_LDT + 16 * s + 8 * h);
          const bf16x8 bq = *(const bf16x8*)(GcrT + r * C3_LDT + 16 * s + 8 * h);
          X2 = MFMA32(a, bq, X2);
        }
        if (c * C3_L >= 256) {
          const size_t orow = (size_t)rowof(c * C3_L + r) * DM + head * 64 + 32 * tio + 4 * h;
#pragma unroll
          for (int g = 0; g < 4; ++g) {
            u32x2 w; w.x = pk2(XO[4 * g] - X2[4 * g], XO[4 * g + 1] - X2[4 * g + 1]); w.y = pk2(XO[4 * g + 2] - X2[4 * g + 2], XO[4 * g + 3] - X2[4 * g + 3]);
            *(u32x2*)(Ox + orow + 8 * g) = w;
          }
        }
      }
      {
        f32x16 P1, P2;
#pragma unroll
        for (int i = 0; i < 16; ++i) { P1[i] = 0.f; P2[i] = 0.f; }
#pragma unroll
        for (int s = 0; s < 2; ++s) {
          const bf16x8 av = *(const bf16x8*)(Vt + (32 * ti + r) * C3_LDT + 16 * s + 8 * h);
          const bf16x8 bk = *(const bf16x8*)(KhT + (32 * tj + r) * C3_LDT + 16 * s + 8 * h);
          P1 = MFMA32(av, bk, P1);
          const bf16x8 au = *(const bf16x8*)(Ub + (32 * ti + r) * C3_LDT + 16 * s + 8 * h);
          const bf16x8 bc = *(const bf16x8*)(ChT + (32 * tj + r) * C3_LDT + 16 * s + 8 * h);
          P2 = MFMA32(au, bc, P2);
        }
        const float ek = Eb[32 * tj + r];
#pragma unroll
        for (int i = 0; i < 16; ++i) {
          S[i] = S[i] * ek + P1[i] - P2[i];
          S0b[(32 * ti + (i & 3) + 8 * (i >> 2) + 4 * h) * C3_LDK + 32 * tj + r] = f2bf(S[i]);
        }
      }
      lds_bar();
    }
  }
}

DI void phase_rwkv_out(KP p, char* smem) {
  char* const ws = ows(p);
  const int lane = otid() & 63, wid = otid() >> 6;
  char* U = ws + OFF_U;
  const bf16_t *Rx = (const bf16_t*)(U + U3_R), *Kx = (const bf16_t*)(U + U3_K), *Vx = (const bf16_t*)(U + U3_V), *A0 = (const bf16_t*)(U + U3_A0),
               *A1 = (const bf16_t*)(U + U3_A1), *Gx = (const bf16_t*)(U + U3_G), *O0 = (const bf16_t*)(U + U3_O0), *O1 = (const bf16_t*)(U + U3_O1);
  bf16_t* Z = (bf16_t*)(ws + OFF_H);
  const int ch0 = lane * 16;
  float ka[16], rk[16], lw[16], lb[16];
#pragma unroll
  for (int j = 0; j < 16; ++j) { ka[j] = gin(p, 29)[ch0 + j]; rk[j] = gin(p, 30)[ch0 + j]; lw[j] = gin(p, 31)[ch0 + j]; lb[j] = gin(p, 32)[ch0 + j]; }
  auto ld16f = [&](const bf16_t* base, size_t off, float (&o)[16]) {
    const u32x4 a = ld16(base + off), b = ld16(base + off + 8);
    o[0] = bflo(a.x); o[1] = bfhi(a.x); o[2] = bflo(a.y); o[3] = bfhi(a.y); o[4] = bflo(a.z); o[5] = bfhi(a.z); o[6] = bflo(a.w); o[7] = bfhi(a.w);
    o[8] = bflo(b.x); o[9] = bfhi(b.x); o[10] = bflo(b.y); o[11] = bfhi(b.y); o[12] = bflo(b.z); o[13] = bfhi(b.z); o[14] = bflo(b.w); o[15] = bfhi(b.w);
  };
  for (int r = obid() * 8 + wid; r < TL; r += gridDim.x * 8) {
    const size_t off = (size_t)r * DM + ch0;
    float o0[16], o1[16], rr[16], kk[16], vv[16], a0[16], a1[16], gg[16];
    ld16f(O0, off, o0); ld16f(O1, off, o1); ld16f(Rx, off, rr); ld16f(Kx, off, kk); ld16f(Vx, off, vv); ld16f(A0, off, a0); ld16f(A1, off, a1); ld16f(Gx, off, gg);
    float s = 0.f, bs = 0.f;
#pragma unroll
    for (int j = 0; j < 16; ++j) {
      o0[j] += o1[j]; s += o0[j];
      const float kd0 = kk[j] * (1.0f + (a0[j] - 1.0f) * ka[j]), kd1 = kk[j] * (1.0f + (a1[j] - 1.0f) * ka[j]);
      bs += rr[j] * (kd0 + kd1) * rk[j];
    }
    s += __shfl_xor(s, 1); s += __shfl_xor(s, 2);
    bs += __shfl_xor(bs, 1); bs += __shfl_xor(bs, 2);
    const float mean = s * (1.0f / 64.0f);
    float q = 0.f;
#pragma unroll
    for (int j = 0; j < 16; ++j) { const float d = o0[j] - mean; q += d * d; }
    q += __shfl_xor(q, 1); q += __shfl_xor(q, 2);
    const float rstd = rsqrtf(q * (1.0f / 64.0f) + 64e-5f);
    float z[16];
#pragma unroll
    for (int j = 0; j < 16; ++j) z[j] = ((o0[j] - mean) * rstd * lw[j] + lb[j] + bs * vv[j]) * gg[j];
    u32x4 w0;
    w0.x = pk4_fp8(z[0] * O8_SCALE, z[1] * O8_SCALE, z[2] * O8_SCALE, z[3] * O8_SCALE); w0.y = pk4_fp8(z[4] * O8_SCALE, z[5] * O8_SCALE, z[6] * O8_SCALE, z[7] * O8_SCALE);
    w0.z = pk4_fp8(z[8] * O8_SCALE, z[9] * O8_SCALE, z[10] * O8_SCALE, z[11] * O8_SCALE); w0.w = pk4_fp8(z[12] * O8_SCALE, z[13] * O8_SCALE, z[14] * O8_SCALE, z[15] * O8_SCALE);
    *(u32x4*)((unsigned char*)Z + off) = w0;
  }
}

#define XB_TMO      128
#define XB_XCNT(j)  (256  + 64 * (j))
#define XB_XSUB(j)  (1280 + 64 * (j))
#define XB_XGEN(j)  (2304 + 64 * (j))
#define XB_TOP      3328
#define XB_TOPGEN   3392
#define XCD_BAR_WORDS 3456
#define XB_SPIN_CAP (1u << 22)
#define LAS __attribute__((address_space(3)))
__device__ __forceinline__ unsigned xb_ld(unsigned* p)              { return __hip_atomic_load(p, __ATOMIC_RELAXED, __HIP_MEMORY_SCOPE_AGENT); }
__device__ __forceinline__ unsigned xb_add(unsigned* p, unsigned v) { return __hip_atomic_fetch_add(p, v, __ATOMIC_RELAXED, __HIP_MEMORY_SCOPE_AGENT); }
__device__ __forceinline__ unsigned xb_xcc_id() { return (unsigned)__builtin_amdgcn_s_getreg((3 << 11) | 20) & 0xFu; }
#define XB_SPIN(cond, bar) do { unsigned _sp = 0; while (cond) { __builtin_amdgcn_s_sleep(1); \
    if ((++_sp & 255u) == 0u) { if (xb_ld(&(bar)[XB_TMO])) break; if (_sp > XB_SPIN_CAP) { atomicAdd(&(bar)[XB_TMO], 1u); break; } } } } while (0)
struct XcdBarrier { unsigned* bar; unsigned x; volatile LAS unsigned* st; };
__device__ __forceinline__ XcdBarrier xcd_barrier_post(unsigned* bar, volatile LAS unsigned* st) {
    XcdBarrier b; b.bar = bar; b.x = xb_xcc_id(); b.st = st;
    if (otid() == 0) (void)xb_add(&bar[XB_XCNT(b.x)], 1u);
    return b;
}
__device__ __forceinline__ void xcd_barrier_complete(unsigned* bar, unsigned x, unsigned& nloc, unsigned& nx) {
    const unsigned G = gridDim.x * gridDim.y * gridDim.z;
    unsigned sum, cnt, mine, sp = 0u;
    for (;;) {
        sum = 0u; cnt = 0u; mine = 0u;
#pragma unroll
        for (unsigned j = 0; j < 16; ++j) { const unsigned c = xb_ld(&bar[XB_XCNT(j)]); sum += c; cnt += (c > 0u) ? 1u : 0u; mine = (j == x) ? c : mine; }
        if (sum == G) break;
        __builtin_amdgcn_s_sleep(1);
        if ((++sp & 255u) == 0u) { if (xb_ld(&bar[XB_TMO])) break; if (sp > XB_SPIN_CAP) { atomicAdd(&bar[XB_TMO], 1u); break; } }
    }
    nloc = mine > 0u ? mine : 1u; nx = cnt > 0u ? cnt : 1u;
}
__device__ __forceinline__ void xcd_barrier(const XcdBarrier& b) {
    asm volatile("s_waitcnt vmcnt(0)" ::: "memory");
    __syncthreads();
    if (otid() == 0) {
        unsigned* bar = b.bar;
        __builtin_amdgcn_s_waitcnt(0);
        unsigned nloc = b.st[0], nx = b.st[1];
        if (nloc == 0u) { xcd_barrier_complete(bar, b.x, nloc, nx); b.st[0] = nloc; b.st[1] = nx; }
        const unsigned old = xb_add(&bar[XB_XSUB(b.x)], 1u);
        const unsigned gen = old / nloc;
        if (old + 1u == (gen + 1u) * nloc) {
            __builtin_amdgcn_fence(__ATOMIC_RELEASE, "agent");
            asm volatile("s_waitcnt vmcnt(0)" ::: "memory");
            const unsigned og = xb_add(&bar[XB_TOP], 1u);
            const unsigned tg = og / nx;
            if (og + 1u == (tg + 1u) * nx) xb_add(&bar[XB_TOPGEN], 1u);
            else XB_SPIN(xb_ld(&bar[XB_TOPGEN]) == tg, bar);
            __builtin_amdgcn_fence(__ATOMIC_ACQUIRE, "agent");
            xb_add(&bar[XB_XGEN(b.x)], 1u);
            asm volatile("s_waitcnt vmcnt(0)" ::: "memory");
        } else {
            XB_SPIN(xb_ld(&bar[XB_XGEN(b.x)]) == gen, bar);
            __builtin_amdgcn_fence(__ATOMIC_ACQUIRE, "agent");
            asm volatile("s_waitcnt vmcnt(0)" ::: "memory");
        }
    }
    __syncthreads();
}

DI void gbar(const XcdBarrier& b0) {
  XcdBarrier b = b0;
  unsigned long long pb = (unsigned long long)b.bar; asm volatile("" : "+s"(pb)); b.bar = (unsigned*)pb;
  unsigned x = b.x; asm volatile("" : "+s"(x)); b.x = x;
  xcd_barrier(b);
}

constexpr int cmaxi(int a, int b) { return a > b ? a : b; }
constexpr int FUSED_LDS = 256 + cmaxi(cmaxi(MOD_LDS, A1_LDS), cmaxi(cmaxi(SC_LDS, R2_LDS), FG_LDS + MOE_UMAX * 1024 + 256));
#ifndef PROBE_GROUP
#define PROBE_GROUP 0
#endif
#define PROBE(g, stmt) do { if constexpr (PROBE_GROUP == (g)) { stmt; gbar(bar); } } while (0)
template <int layer>
DI void run_layer(const XcdBarrier& bar, char* smem) {
  char* U = ows(kparams()) + OFF_U;
  const bf16_t* wm = (const bf16_t*)(ows(kparams()) + OFF_WMIX);
  if constexpr (layer == 0) phase_norm1<0, false, true>(kparams(), layer, smem); else phase_norm1<1, false, layer == 1>(kparams(), layer, smem);
  gbar(bar);
  PROBE(1, (phase_norm1<(layer == 0 ? 0 : 1), true, (layer <= 1)>(kparams(), layer, smem)));
  if constexpr (layer == 0) {
    phase_qkv_win8(kparams(), smem);
    gbar(bar);
    PROBE(3, phase_qkv_win8(kparams(), smem));
    phase_attn_win(kparams(), smem);
    gbar(bar);
    PROBE(4, phase_attn_win(kparams(), smem));
    phase_oproj8(kparams(), 0, U + U0_O, (const char*)(wm + W_WINO), TT, smem);
    gbar(bar);
    PROBE(3, (phase_oproj8<true>(kparams(), 0, U + U0_O, (const char*)(wm + W_WINO), TT, smem)));
  } else if constexpr (layer == 1) {
    phase_qkv_diff8(kparams(), smem);
    gbar(bar);
    PROBE(3, phase_qkv_diff8(kparams(), smem));
    phase_attn_diff(kparams(), smem);
    gbar(bar);
    PROBE(10, phase_attn_diff(kparams(), smem));
    phase_oproj8(kparams(), 1, U + U1_O, (const char*)(wm + W_DIFFO), TT, smem);
    gbar(bar);
    PROBE(3, (phase_oproj8<true>(kparams(), 1, U + U1_O, (const char*)(wm + W_DIFFO), TT, smem)));
  } else if constexpr (layer == 2) {
    phase_pool_pre(kparams(), smem);
    gbar(bar);
    PROBE(6, phase_pool_pre(kparams(), smem));
    phase_pool(kparams(), smem);
    gbar(bar);
    PROBE(6, phase_pool<true>(kparams(), smem));
  } else {
    phase_rwkv_mix(kparams(), smem);
    gbar(bar);
    PROBE(7, phase_rwkv_mix(kparams(), smem));
    phase_rwkv_rkv(kparams(), smem);
    __syncthreads();
    phase_rwkv_feat1(kparams(), smem);
    gbar(bar);
    PROBE(7, phase_rwkv_rkv(kparams(), smem));
    PROBE(8, phase_rwkv_feat1(kparams(), smem));
    phase_rwkv_feat2(kparams(), smem);
    gbar(bar);
    PROBE(8, phase_rwkv_feat2(kparams(), smem));
    phase_rwkv_scan(kparams(), smem);
    gbar(bar);
    PROBE(11, phase_rwkv_scan(kparams(), smem));
    phase_rwkv_out(kparams(), smem);
    gbar(bar);
    PROBE(9, phase_rwkv_out(kparams(), smem));
    phase_oproj8(kparams(), 3, ows(kparams()) + OFF_H, (const char*)(wm + W_RO), TL, smem);
    gbar(bar);
    PROBE(3, (phase_oproj8<true>(kparams(), 3, ows(kparams()) + OFF_H, (const char*)(wm + W_RO), TL, smem)));
  }
  phase_norm2_router(kparams(), layer, smem);
  __syncthreads();
  phase_cvt_moe(kparams(), layer, smem);
  gbar(bar);
  PROBE(2, phase_norm2_router<true>(kparams(), layer, smem));
  PROBE(5, phase_cvt_moe(kparams(), layer, smem));
  phase_moe_up(kparams(), layer, smem);
  gbar(bar);
  phase_moe_down(kparams(), layer, smem);
  gbar(bar);
  PROBE(12, phase_moe_up(kparams(), layer, smem));
  PROBE(12, phase_moe_down(kparams(), layer, smem));
}

__global__ __launch_bounds__(NTH, 2) void k_fused(Params p_unused) {
  extern __shared__ __attribute__((aligned(16))) char smem_all[];
  if (threadIdx.x == 0) *(uint4*)smem_all = make_uint4(0u, 0u, 0u, 0u);
  __syncthreads();
  XcdBarrier bar = xcd_barrier_post((unsigned*)(ows(kparams()) + OFF_BAR), (volatile LAS unsigned*)smem_all);
  char* smem = smem_all + 256;
  phase_cvt_mix(kparams(), smem);
  __syncthreads();
  phase_mod(kparams(), smem);
  gbar(bar);
  PROBE(5, phase_cvt_mix(kparams(), smem));
  PROBE(5, phase_mod(kparams(), smem));
  run_layer<0>(bar, smem);
  run_layer<1>(bar, smem);
  run_layer<2>(bar, smem);
  run_layer<3>(bar, smem);
  phase_norm1<3>(kparams(), 3, smem);
  PROBE(1, (gbar(bar), phase_norm1<3, true>(kparams(), 3, smem)));
}

static void fill_params(Params& p, void* const* d_in, void* d_out, void* d_ws) {
  for (int i = 0; i < 40; ++i) p.in[i] = (const float*)d_in[i];
  p.out = (float*)d_out;
  p.ws = (char*)d_ws;
  bf16_t* wm = (bf16_t*)(p.ws + OFF_WMIX);
  int nj = 0, item = 0;
  auto add = [&](const float* src, size_t dstoff, int K, int N, int ld, int dld = 0, int f8 = 0) {
    p.jobs[nj].src = src; p.jobs[nj].dst = wm + dstoff; p.jobs[nj].K = K; p.jobs[nj].N = N; p.jobs[nj].ld = ld; p.jobs[nj].item0 = item; p.jobs[nj].dld = dld ? dld : K; p.jobs[nj].pad_ = f8;
    item += (K / 64) * (N / 64); ++nj;
  };
  add(p.in[8], W_WINQKV, 1024, 1536, 1536, 0, 1);
  add(p.in[10], W_WINO, 1024, 1024, 1024, 0, 1);
  add(p.in[11], W_DIFFQKV, 1024, 3072, 3072, 0, 1);
  add(p.in[14], W_DIFFO, 1024, 1024, 1024, 0, 1);
  for (int g = 0; g < 4; ++g) add(p.in[15] + (size_t)g * 65536, W_POOL + (size_t)g * 65536, 256, 256, 256);
  add(p.in[19], W_R, 1024, 1024, 1024, 0, 1);
  add(p.in[19] + (size_t)1 * 1024 * 1024, W_K, 1024, 1024, 1024, 0, 1);
  add(p.in[19] + (size_t)2 * 1024 * 1024, W_V, 1024, 1024, 1024, 0, 1);
  for (int d = 0; d < 2; ++d) add(p.in[21] + (size_t)d * 1024 * 64, W_WA1 + (size_t)d * 64 * 1024, 1024, 64, 64);
  for (int d = 0; d < 2; ++d) add(p.in[24] + (size_t)d * 1024 * 64, W_AA1 + (size_t)d * 64 * 1024, 1024, 64, 64);
  add(p.in[26], W_G1, 1024, 128, 128);
  for (int d = 0; d < 2; ++d) add(p.in[22] + (size_t)d * 64 * 1024, W_WA2 + (size_t)d * 1024 * 128 + d * 64, 64, 1024, 1024, 128);
  for (int d = 0; d < 2; ++d) add(p.in[25] + (size_t)d * 64 * 1024, W_AA2 + (size_t)d * 1024 * 128 + d * 64, 64, 1024, 1024, 128);
  add(p.in[27], W_G2, 128, 1024, 1024);
  add(p.in[33], W_RO, 1024, 1024, 1024, 0, 1);
  p.njobs = nj; p.nitems = item;
}

extern "C" void kernel_launch(void* const* d_in, const int* in_sizes, int n_in, void* d_out, int out_size, void* d_ws, size_t ws_size, hipStream_t stream) {
  if (ws_size < WS_NEED || n_in < 40) return;
  Params p{};
  fill_params(p, d_in, d_out, d_ws);
  (void)hipMemsetAsync(p.ws, 0, 32768, stream);
  (void)hipMemsetAsync(p.ws + OFF_H8 + (size_t)TT * DM, 0, 8 * DM, stream);
  static int grid = 0;
  if (!grid) {
    int dev = 0, cus = 0, per_cu = 0;
    (void)hipGetDevice(&dev);
    (void)hipDeviceGetAttribute(&cus, hipDeviceAttributeMultiprocessorCount, dev);
    (void)hipFuncSetAttribute((const void*)k_fused, hipFuncAttributeMaxDynamicSharedMemorySize, FUSED_LDS);
    (void)hipOccupancyMaxActiveBlocksPerMultiprocessor(&per_cu, (const void*)k_fused, NTH, FUSED_LDS);
    grid = cus * (per_cu < 1 ? per_cu : 1);
  }
  if (grid <= 0) return;
  hipLaunchKernelGGL(k_fused, dim3(grid), dim3(NTH), FUSED_LDS, stream, p);
}
```

```cpp
#include <hip/hip_runtime.h>
#include <stdint.h>
#include <stddef.h>

typedef unsigned short bf16_t;
typedef short bf16x8 __attribute__((ext_vector_type(8)));
typedef short s16x4 __attribute__((ext_vector_type(4)));
typedef float f32x4 __attribute__((ext_vector_type(4)));
typedef float f32x16 __attribute__((ext_vector_type(16)));
typedef unsigned u32x4 __attribute__((ext_vector_type(4)));
typedef unsigned u32x2 __attribute__((ext_vector_type(2)));
typedef float f32x2 __attribute__((ext_vector_type(2)));
#define DI __device__ __forceinline__

constexpr int DM = 1024, NBATCH = 16, SEQ = 4096, CTX = 256;
constexpr int TL = NBATCH * SEQ, TC = NBATCH * CTX, TT = TL + TC;
constexpr int NTH = 512;
constexpr int MOE_PAD = 256;
constexpr int MOE_ROWS = 2 * TT + 32 * MOE_PAD;
constexpr int CAP = TT;

constexpr size_t al256(size_t x) { return (x + 255) & ~(size_t)255; }
constexpr size_t OFF_BAR = 0;
constexpr size_t OFF_CNT = 16384;
constexpr int CNT_STRIDE = 32;
constexpr size_t OFF_MOD = 32768;
constexpr size_t OFF_ROPE = al256(OFF_MOD + (size_t)4 * 17 * 6144 * 4);
constexpr size_t OFF_XB = al256(OFF_ROPE + 2 * 64 * 16 * 4);
constexpr size_t OFF_H = al256(OFF_XB + (size_t)TT * DM * 2);
constexpr size_t OFF_H8 = al256(OFF_H + (size_t)(TT + 8) * DM * 2);
constexpr size_t OFF_TOK = al256(OFF_H8 + (size_t)(TT + 8) * DM);
constexpr size_t OFF_ROWL = al256(OFF_TOK + (size_t)TT * 32);
constexpr size_t OFF_WMIX = al256(OFF_ROWL + (size_t)32 * CAP * 4);
constexpr size_t W_WINQKV = 0;
constexpr size_t W_WINO = W_WINQKV + (size_t)1536 * 1024;
constexpr size_t W_DIFFQKV = W_WINO + (size_t)1024 * 1024;
constexpr size_t W_DIFFO = W_DIFFQKV + (size_t)3072 * 1024;
constexpr size_t W_POOL = W_DIFFO + (size_t)1024 * 1024;
constexpr size_t W_R = W_POOL + (size_t)4 * 256 * 256;
constexpr size_t W_K = W_R + (size_t)1024 * 1024;
constexpr size_t W_V = W_K + (size_t)1024 * 1024;
constexpr size_t W_WA1 = W_V + (size_t)1024 * 1024;
constexpr size_t W_AA1 = W_WA1 + (size_t)128 * 1024;
constexpr size_t W_G1 = W_AA1 + (size_t)128 * 1024;
constexpr size_t W_WA2 = W_G1 + (size_t)128 * 1024;
constexpr size_t W_AA2 = W_WA2 + (size_t)2048 * 128;
constexpr size_t W_G2 = W_AA2 + (size_t)2048 * 128;
constexpr size_t W_RO = W_G2 + (size_t)1024 * 128;
constexpr size_t W_MIX_END = W_RO + (size_t)1024 * 1024;
constexpr size_t OFF_WR = al256(OFF_WMIX + W_MIX_END * 2);
constexpr size_t OFF_WMOE = al256(OFF_WR + (size_t)4 * 2 * 48 * 1024 * 2);
constexpr size_t WMOE_DOWN = (size_t)32 * 1024 * 1024;
constexpr size_t OFF_U = al256(OFF_WMOE + ((size_t)32 * 1024 * 1024 + (size_t)32 * 1024 * 512) * 2);
constexpr size_t SZ_TT = (size_t)TT * DM * 2, SZ_TL = (size_t)TL * DM * 2;
constexpr size_t U0_Q = 0, U0_K = U0_Q + SZ_TT, U0_V = U0_K + (size_t)TT * 256 * 2, U0_O = U0_V + (size_t)TT * 256 * 2, U0_END = U0_O + SZ_TT;
constexpr size_t U1_Q = 0, U1_K = U1_Q + SZ_TT, U1_V = U1_K + SZ_TT, U1_O = U1_V + SZ_TT, U1_END = U1_O + SZ_TT;
constexpr size_t U2_Y = 0, U2_END = SZ_TT;
constexpr size_t U3_R = 0, U3_K = U3_R + SZ_TL, U3_V = U3_K + SZ_TT, U3_A0 = U3_V + SZ_TT, U3_A1 = U3_A0 + SZ_TT, U3_LD0 = U3_A1 + SZ_TT,
                 U3_LD1 = U3_LD0 + SZ_TT, U3_LW = U3_LD1 + SZ_TT, U3_LA = U3_LW + (size_t)TT * 128 * 2, U3_LG = U3_LA + (size_t)TT * 128 * 2,
                 U3_G = U3_LG + (size_t)TL * 128 * 2, U3_O0 = U3_G + SZ_TL, U3_O1 = U3_O0 + SZ_TL, U3_END = U3_O1 + SZ_TL;
constexpr size_t U3_XR = U3_A0, U3_XK = U3_A1, U3_XV = U3_LD0;
constexpr size_t UM_ACT = 0, UM_YB = UM_ACT + (size_t)MOE_ROWS * 512 * 2, UM_END = UM_YB + (size_t)MOE_ROWS * 1024 * 2;
constexpr size_t cmax(size_t a, size_t b) { return a > b ? a : b; }
constexpr size_t U_SIZE = cmax(cmax(cmax(U0_END, U1_END), U2_END), cmax(U3_END, UM_END));
constexpr size_t WS_NEED = OFF_U + U_SIZE;

struct CvtJob { const float* src; bf16_t* dst; int K, N, ld, item0, dld, pad_; };
constexpr int NJOBS = 24;
struct Params {
  const float* in[40];
  float* out;
  char* ws;
  CvtJob jobs[NJOBS];
  int njobs, nitems;
};

typedef const __attribute__((address_space(4))) Params* KP;
DI KP kparams() { KP q = (KP)__builtin_amdgcn_kernarg_segment_ptr(); asm volatile("" : "+s"(q)); return q; }
DI char* ows(KP p) {
  const unsigned long long w = (unsigned long long)p->ws;
  unsigned lo = (unsigned)w, hi = (unsigned)(w >> 32);
  asm volatile("" : "+v"(lo), "+v"(hi));
  lo = __builtin_amdgcn_readfirstlane(lo); hi = __builtin_amdgcn_readfirstlane(hi);
  return (char*)(__attribute__((address_space(1))) char*)(((unsigned long long)hi << 32) | lo);
}
DI const float* gin(KP p, int i) { return (const float*)(__attribute__((address_space(1))) const float*)p->in[i]; }
DI float* gout(KP p) { return (float*)(__attribute__((address_space(1))) float*)p->out; }
DI int otid() { int t = threadIdx.x; asm volatile("" : "+v"(t)); return t; }
DI int obid() { int b = blockIdx.x; asm volatile("" : "+s"(b)); return b; }
DI unsigned pk2(float lo, float hi) {
  typedef __bf16 bf2 __attribute__((ext_vector_type(2)));
  typedef float f2 __attribute__((ext_vector_type(2)));
  f2 v = {lo, hi};
  return __builtin_bit_cast(unsigned, __builtin_convertvector(v, bf2));
}
DI float clamp8(float x) { return __builtin_amdgcn_fmed3f(x, -440.0f, 440.0f); }
DI void swap32(float x, float& a, float& b) {
  a = x; b = x;
  asm volatile("s_nop 1\n\tv_permlane32_swap_b32 %0, %1\n\ts_nop 1" : "+v"(a), "+v"(b));
}
DI unsigned pk4_fp8_nc(float a, float b, float c, float d) { int w; asm("" : "=v"(w)); w = __builtin_amdgcn_cvt_pk_fp8_f32(a, b, w, false); w = __builtin_amdgcn_cvt_pk_fp8_f32(c, d, w, true); return (unsigned)w; }
DI unsigned pk4_fp8(float a, float b, float c, float d) { int w = __builtin_amdgcn_cvt_pk_fp8_f32(clamp8(a), clamp8(b), 0, false); w = __builtin_amdgcn_cvt_pk_fp8_f32(clamp8(c), clamp8(d), w, true); return (unsigned)w; }
DI bf16_t f2bf(float x) { return (bf16_t)(pk2(x, 0.f) & 0xffffu); }
DI float bf2f(bf16_t b) { return __uint_as_float(((unsigned)b) << 16); }
DI float bflo(unsigned u) { return __uint_as_float(u << 16); }
DI float bfhi(unsigned u) { return __uint_as_float(u & 0xffff0000u); }
DI float wave_sum(float v) {
#pragma unroll
  for (int o = 32; o >= 1; o >>= 1) v += __shfl_xor(v, o);
  return v;
}
DI float sigmoidf_(float x) { return __builtin_amdgcn_rcpf(1.0f + __expf(-x)); }
DI int row_bi(int r) { return r < TL ? (r >> 12) : 16; }
DI bf16_t* xrow_ptr(KP p, char* ws, int r) { return (bf16_t*)(ws + OFF_XB) + (size_t)r * DM; }
DI f32x4 ldbf4(const bf16_t* q) { const u32x2 w = *(const u32x2*)q; return (f32x4){bflo(w.x), bfhi(w.x), bflo(w.y), bfhi(w.y)}; }
DI void stbf4(bf16_t* q, const f32x4& v) { u32x2 w; w.x = pk2(v[0], v[1]); w.y = pk2(v[2], v[3]); *(u32x2*)q = w; }
DI const float* modp(char* ws, int layer, int bi, int which) { return (const float*)(ws + OFF_MOD) + ((size_t)(layer * 17 + bi) * 6 + which) * DM; }
#define MFMA16(a, b, c) __builtin_amdgcn_mfma_f32_16x16x32_bf16((a), (b), (c), 0, 0, 0)
#define MFMA32(a, b, c) __builtin_amdgcn_mfma_f32_32x32x16_bf16((a), (b), (c), 0, 0, 0)

constexpr int SGLD = 72;
constexpr int SG_LDS = 2 * 128 * SGLD * 2;
template <class AL, class BL, class EP>
DI void sgemm_tile(char* smem, int K, AL la, BL lb, EP ep) {
  bf16_t* sA = (bf16_t*)smem;
  bf16_t* sB = sA + 128 * SGLD;
  const int tid = otid(), lane = tid & 63, wid = tid >> 6, wr = wid >> 2, wc = wid & 3, fr = lane & 15, fq = lane >> 4;
  f32x4 acc[4][2];
#pragma unroll
  for (int m = 0; m < 4; ++m)
#pragma unroll
    for (int n = 0; n < 2; ++n) acc[m][n] = (f32x4){0.f, 0.f, 0.f, 0.f};
  const int r_ = tid >> 3, k_ = (tid & 7) * 8;
  u32x4 ra0 = la(r_, k_), ra1 = la(r_ + 64, k_), rb0 = lb(r_, k_), rb1 = lb(r_ + 64, k_);
  const int nk = K >> 6;
  for (int kt = 0; kt < nk; ++kt) {
    __syncthreads();
    *(u32x4*)(sA + r_ * SGLD + k_) = ra0;
    *(u32x4*)(sA + (r_ + 64) * SGLD + k_) = ra1;
    *(u32x4*)(sB + r_ * SGLD + k_) = rb0;
    *(u32x4*)(sB + (r_ + 64) * SGLD + k_) = rb1;
    __syncthreads();
    if (kt + 1 < nk) {
      const int kk = (kt + 1) * 64 + k_;
      ra0 = la(r_, kk); ra1 = la(r_ + 64, kk); rb0 = lb(r_, kk); rb1 = lb(r_ + 64, kk);
    }
#pragma unroll
    for (int ks = 0; ks < 2; ++ks) {
      bf16x8 af[4], bq[2];
#pragma unroll
      for (int m = 0; m < 4; ++m) af[m] = *(const bf16x8*)(sA + (wr * 64 + m * 16 + fr) * SGLD + ks * 32 + fq * 8);
#pragma unroll
      for (int n = 0; n < 2; ++n) bq[n] = *(const bf16x8*)(sB + (wc * 32 + n * 16 + fr) * SGLD + ks * 32 + fq * 8);
#pragma unroll
      for (int m = 0; m < 4; ++m)
#pragma unroll
        for (int n = 0; n < 2; ++n) acc[m][n] = MFMA16(af[m], bq[n], acc[m][n]);
    }
  }
  ep(acc, wr * 64, wc * 32, fr, fq);
}
DI u32x4 ld16(const bf16_t* p) { return *(const u32x4*)p; }

#define LAS __attribute__((address_space(3)))
namespace fg {
typedef int v8i_t __attribute__((ext_vector_type(8)));
typedef int v4i_t __attribute__((ext_vector_type(4)));
constexpr int BM = 256, BK = 64, HALF = 128, HTB = HALF * BK * 2, STAGE_BYTES = 8 * HTB, NXCD = 8, WGM = 8;
DI int lds_byte(int r, int c) { const int st = (r >> 4) * 2 + (c >> 5), rr = r & 15, cc = c & 31, ob = rr * 64 + cc * 2; return st * 1024 + (ob ^ (((ob >> 9) & 1) << 5)); }
DI void stage_rc(int b, int& R, int& C) { const int st = b / 1024, sb = b % 1024, swz = sb ^ (((sb >> 9) & 1) << 5); R = (st >> 1) * 16 + swz / 64; C = (st & 1) * 32 + (swz % 64) / 2; }
struct Unit { const char* A; const char* B; int pm, pn, aux; };
DI bool static_order(int i, int G, int c, int nM, int nN, int& pm, int& pn) {
  const int nwg = nM * nN;
  const long L = (long)i * G + c; if (L >= nwg) return false;
  int wgid = (int)L; { const int q = nwg / NXCD, r = nwg % NXCD, xcd = wgid % NXCD, off = wgid / NXCD; wgid = (xcd < r ? xcd * (q + 1) : r * (q + 1) + (xcd - r) * q) + off; }
  const int nig = WGM * nN, gid = wgid / nig, fm = gid * WGM, gsz = (nM - fm) < WGM ? (nM - fm) : WGM;
  pm = fm + ((wgid % nig) % gsz); pn = (wgid % nig) / gsz; return true;
}
struct DenseSched {
  const char* A; const char* B; int nM, nN, G, c; size_t tA, tB;
  DI bool next(int i, Unit& u) const { int pm, pn; if (!static_order(i, G, c, nM, nN, pm, pn)) return false; u.pm = pm; u.pn = pn; u.aux = 0; u.A = A + (size_t)pm * tA; u.B = B + (size_t)pn * tB; return true; }
  DI const LAS int* rows(int) const { return nullptr; }
};

DI int perm32(int rho) { const int n = rho >> 4, i = rho & 15; return 8 * (i >> 2) + 4 * n + (i & 3); }
template <bool GATHER, bool PERM = false, class Epi, class Sched>
DI void gemm_phase(LAS unsigned char* lds, const int K, const int lda, const int ldb, const Sched& S, const Epi& E) {
  const int tid = otid(), wid = __builtin_amdgcn_readfirstlane(tid >> 6), lane = tid & 63, wr = wid >> 2, wc = wid & 3, fr = lane & 15, fq = lane >> 4;
  const int nt = K / BK;
  unsigned voffA[2], voffB[2]; int sR[2], sC[2];
#pragma unroll
  for (int i = 0; i < 2; ++i) { int R, C; stage_rc(tid * 16 + i * 8192, R, C); sR[i] = R; sC[i] = C; voffA[i] = (unsigned)(R * lda + C) * 2u; const int Rb = PERM ? ((R & ~31) + perm32(R & 31)) : R; voffB[i] = (unsigned)(Rb * ldb + C) * 2u; }
  const size_t kstep = (size_t)(BK * 2), hstepA = (size_t)HALF * lda * 2, hstepB = (size_t)HALF * ldb * 2;
  const unsigned ldsw = (unsigned)wid * 1024u;
  const int aoff = lds_byte(wr * 64 + fr, fq * 8), boff = lds_byte(wc * 32 + fr, fq * 8);
#define FG_SA(b, h) (((b) * 2 + (h)) * HTB)
#define FG_SB(b, h) ((4 + (b) * 2 + (h)) * HTB)
#define FG_GLDS(gp, bufoff, i_) __builtin_amdgcn_global_load_lds((const unsigned*)(gp), (LAS unsigned*)(lds + (bufoff) + ldsw + (i_) * 8192), 16, 0, 0)
#define FG_STAGE_B(bufoff, gbase) do { const char* _gb = (gbase); FG_GLDS(_gb + voffB[0], bufoff, 0); FG_GLDS(_gb + voffB[1], bufoff, 1); } while (0)
#define FG_STAGE_A(bufoff, NX, H, KB) do { \
    if constexpr (GATHER) { const char* _gb = ((NX) ? nA : cA) + (KB); FG_GLDS(_gb + ((NX) ? gn[H][0] : gc[H][0]), bufoff, 0); FG_GLDS(_gb + ((NX) ? gn[H][1] : gc[H][1]), bufoff, 1); } \
    else { const char* _gb = ((NX) ? nA : cA) + (size_t)(H) * hstepA + (KB); FG_GLDS(_gb + voffA[0], bufoff, 0); FG_GLDS(_gb + voffA[1], bufoff, 1); } } while (0)
#define FG_LDA(dst, b, h) do { _Pragma("unroll") for (int m = 0; m < 4; ++m) _Pragma("unroll") for (int k = 0; k < 2; ++k) dst[m][k] = *(const LAS bf16x8*)(lds + FG_SA(b, h) + aoff + m * 2048 + k * 1024); } while (0)
#define FG_LDB(dst, b, h) do { _Pragma("unroll") for (int n = 0; n < 2; ++n) _Pragma("unroll") for (int k = 0; k < 2; ++k) dst[n][k] = *(const LAS bf16x8*)(lds + FG_SB(b, h) + boff + n * 2048 + k * 1024); } while (0)
#define FG_MMA(ai, bj, At, Bt) do { __builtin_amdgcn_s_setprio(1); _Pragma("unroll") for (int m = 0; m < 4; ++m) _Pragma("unroll") for (int n = 0; n < 2; ++n) _Pragma("unroll") for (int k = 0; k < 2; ++k) \
    acc[ai][bj][m][n] = __builtin_amdgcn_mfma_f32_16x16x32_bf16(Bt[n][k], At[m][k], acc[ai][bj][m][n], 0, 0, 0); __builtin_amdgcn_s_setprio(0); } while (0)
#define FG_WAIT_V(n) asm volatile("s_waitcnt vmcnt(" #n ")" ::: "memory")
#define FG_WAIT_L(n) asm volatile("s_waitcnt lgkmcnt(" #n ")" ::: "memory")
#define FG_BAR __builtin_amdgcn_s_barrier()
#define FG_SCHED __builtin_amdgcn_sched_barrier(0)
  Unit cur, nxt; int ui = 0;
  if (!S.next(0, cur)) return;
  f32x4 acc[2][2][4][2];
#pragma unroll
  for (int a = 0; a < 2; ++a)
#pragma unroll
    for (int b = 0; b < 2; ++b)
#pragma unroll
      for (int m = 0; m < 4; ++m)
#pragma unroll
        for (int n = 0; n < 2; ++n) acc[a][b][m][n] = (f32x4){0.f, 0.f, 0.f, 0.f};
  bf16x8 At[4][2], B0[2][2], B1[2][2];
  const char* cA = cur.A; const char* cB = cur.B;
  const char* nA = cA; const char* nB = cB;
  unsigned gc[2][2] = {{0u, 0u}, {0u, 0u}}, gn[2][2] = {{0u, 0u}, {0u, 0u}};
  if constexpr (GATHER) {
    const LAS int* rw = S.rows(0);
#pragma unroll
    for (int h = 0; h < 2; ++h)
#pragma unroll
      for (int i = 0; i < 2; ++i) { gc[h][i] = (unsigned)(rw[h * HALF + sR[i]] * lda + sC[i]) * 2u; gn[h][i] = gc[h][i]; }
  }
  FG_STAGE_B(FG_SB(0, 0), cB); FG_STAGE_B(FG_SB(0, 1), cB + hstepB); FG_STAGE_A(FG_SA(0, 0), false, 0, 0); FG_STAGE_A(FG_SA(0, 1), false, 1, 0);
  if (wr == 1) FG_BAR;
  FG_WAIT_V(2); FG_BAR;
  FG_STAGE_B(FG_SB(1, 0), cB + kstep); FG_STAGE_A(FG_SA(1, 0), false, 0, kstep); FG_STAGE_B(FG_SB(1, 1), cB + hstepB + kstep);
  FG_WAIT_V(6); FG_BAR;
  for (;;) {
    const bool has_next = S.next(ui + 1, nxt);
    nA = has_next ? nxt.A : cA; nB = has_next ? nxt.B : cB;
    if constexpr (GATHER) {
      if (has_next) {
        const LAS int* rw = S.rows(ui + 1);
#pragma unroll
        for (int h = 0; h < 2; ++h)
#pragma unroll
          for (int i = 0; i < 2; ++i) gn[h][i] = (unsigned)(rw[h * HALF + sR[i]] * lda + sC[i]) * 2u;
      } else {
#pragma unroll
        for (int h = 0; h < 2; ++h)
#pragma unroll
          for (int i = 0; i < 2; ++i) gn[h][i] = gc[h][i];
      }
      FG_WAIT_L(0);
    }
    for (int t = 0; t < nt; t += 2) {
      const bool last = (t == nt - 2);
      const size_t k1 = (size_t)(t + 1) * kstep;
      const size_t k2 = last ? 0 : (size_t)(t + 2) * kstep, k3 = k2 + kstep;
      const char* b2 = last ? nB : cB + (size_t)(t + 2) * kstep; const char* b3 = b2 + kstep;
      FG_LDB(B0, 0, 0); FG_LDB(B1, 0, 1); FG_SCHED; FG_LDA(At, 0, 0); FG_STAGE_A(FG_SA(1, 1), false, 1, k1);
      FG_WAIT_V(8); FG_WAIT_L(0); FG_BAR; FG_MMA(0, 0, At, B0); FG_MMA(0, 1, At, B1); FG_BAR; FG_SCHED;
      FG_LDA(At, 0, 1); FG_STAGE_B(FG_SB(0, 0), b2); FG_STAGE_B(FG_SB(0, 1), b2 + hstepB); FG_STAGE_A(FG_SA(0, 0), last, 0, k2);
      FG_WAIT_V(8); FG_WAIT_L(0); FG_BAR; FG_MMA(1, 0, At, B0); FG_MMA(1, 1, At, B1); FG_BAR; FG_SCHED;
      FG_LDB(B0, 1, 0); FG_LDB(B1, 1, 1); FG_SCHED; FG_LDA(At, 1, 0); FG_STAGE_A(FG_SA(0, 1), last, 1, k2);
      FG_WAIT_V(8); FG_WAIT_L(0); FG_BAR; FG_MMA(0, 0, At, B0); FG_MMA(0, 1, At, B1); FG_BAR; FG_SCHED;
      FG_LDA(At, 1, 1); FG_STAGE_B(FG_SB(1, 0), b3); FG_STAGE_B(FG_SB(1, 1), b3 + hstepB); FG_STAGE_A(FG_SA(1, 0), last, 0, k3);
      FG_WAIT_V(8); FG_WAIT_L(0); FG_BAR; FG_MMA(1, 0, At, B0); FG_MMA(1, 1, At, B1); FG_BAR; FG_SCHED;
    }
    if (wr == 0) FG_BAR;
    E(acc, cur, wr, wc, fr, fq);
    if (!has_next) break;
#pragma unroll
    for (int a = 0; a < 2; ++a)
#pragma unroll
      for (int b = 0; b < 2; ++b)
#pragma unroll
        for (int m = 0; m < 4; ++m)
#pragma unroll
          for (int n = 0; n < 2; ++n) acc[a][b][m][n] = (f32x4){0.f, 0.f, 0.f, 0.f};
    cur = nxt; cA = nA; cB = nB; ++ui;
    if constexpr (GATHER) {
#pragma unroll
      for (int h = 0; h < 2; ++h)
#pragma unroll
        for (int i = 0; i < 2; ++i) gc[h][i] = gn[h][i];
    }
    if (wr == 1) FG_BAR;
  }
  FG_WAIT_V(0);
  FG_BAR;
#undef FG_SA
#undef FG_SB
#undef FG_GLDS
#undef FG_STAGE_A
#undef FG_STAGE_B
#undef FG_LDA
#undef FG_LDB
#undef FG_MMA
#undef FG_WAIT_V
#undef FG_WAIT_L
#undef FG_BAR
#undef FG_SCHED
}
DI int perm32f8(int s_) { return 16 * ((s_ >> 2) & 1) + (s_ & 3) + 4 * (s_ >> 3); }
template <bool GATHER, bool PERM = false, class Epi, class Sched>
DI void gemm_phase_f8(LAS unsigned char* lds, const int K, const int lda, const int ldb, const Sched& S, const Epi& E) {
  const int tid = otid(), wid = __builtin_amdgcn_readfirstlane(tid >> 6), lane = tid & 63, wr = wid >> 2, wc = wid & 3, fr = lane & 15, fq = lane >> 4;
  const int nt = K / BK;
  unsigned voffA[2], voffB[2]; int sR[2], sC[2];
#pragma unroll
  for (int i = 0; i < 2; ++i) { int R, C; stage_rc(tid * 16 + i * 8192, R, C); sR[i] = R; sC[i] = C; voffA[i] = (unsigned)(R * lda + C) * 2u; const int Rb = PERM ? ((R & ~31) + perm32f8(R & 31)) : R; voffB[i] = (unsigned)(Rb * ldb + C) * 2u; }
  const size_t kstep = (size_t)(BK * 2), hstepA = (size_t)HALF * lda * 2, hstepB = (size_t)HALF * ldb * 2;
  const unsigned ldsw = (unsigned)wid * 1024u;
  const int r32 = lane & 31, g32 = lane >> 5;
  const int aoff = lds_byte(wr * 64 + r32, 16 * g32), boff = lds_byte(wc * 32 + r32, 16 * g32);
#define FG_SA(b, h) (((b) * 2 + (h)) * HTB)
#define FG_SB(b, h) ((4 + (b) * 2 + (h)) * HTB)
#define FG_GLDS(gp, bufoff, i_) __builtin_amdgcn_global_load_lds((const unsigned*)(gp), (LAS unsigned*)(lds + (bufoff) + ldsw + (i_) * 8192), 16, 0, 0)
#define FG_STAGE_B(bufoff, gbase) do { const char* _gb = (gbase); FG_GLDS(_gb + voffB[0], bufoff, 0); FG_GLDS(_gb + voffB[1], bufoff, 1); } while (0)
#define FG_STAGE_A(bufoff, NX, H, KB) do { \
    if constexpr (GATHER) { const char* _gb = ((NX) ? nA : cA) + (KB); FG_GLDS(_gb + ((NX) ? gn[H][0] : gc[H][0]), bufoff, 0); FG_GLDS(_gb + ((NX) ? gn[H][1] : gc[H][1]), bufoff, 1); } \
    else { const char* _gb = ((NX) ? nA : cA) + (size_t)(H) * hstepA + (KB); FG_GLDS(_gb + voffA[0], bufoff, 0); FG_GLDS(_gb + voffA[1], bufoff, 1); } } while (0)
#define FG_LDA(dst, b, h) do { _Pragma("unroll") for (int m = 0; m < 2; ++m) _Pragma("unroll") for (int k = 0; k < 2; ++k) { const LAS v4i_t* q_ = (const LAS v4i_t*)(lds + FG_SA(b, h) + aoff + m * 4096 + k * 1024); dst[m][k] = __builtin_shufflevector(q_[0], q_[1], 0, 1, 2, 3, 4, 5, 6, 7); } } while (0)
#define FG_LDB(dst, b, h) do { _Pragma("unroll") for (int k = 0; k < 2; ++k) { const LAS v4i_t* q_ = (const LAS v4i_t*)(lds + FG_SB(b, h) + boff + k * 1024); dst[k] = __builtin_shufflevector(q_[0], q_[1], 0, 1, 2, 3, 4, 5, 6, 7); } } while (0)
#define FG_MMA(ai, bj, At, Bt) do { __builtin_amdgcn_s_setprio(1); _Pragma("unroll") for (int m = 0; m < 2; ++m) _Pragma("unroll") for (int k = 0; k < 2; ++k) \
    acc[ai][bj][m] = __builtin_amdgcn_mfma_scale_f32_32x32x64_f8f6f4(Bt[k], At[m][k], acc[ai][bj][m], 0, 0, 0, 0x7f7f7f7f, 0, 0x7f7f7f7f); __builtin_amdgcn_s_setprio(0); } while (0)
#define FG_WAIT_V(n) asm volatile("s_waitcnt vmcnt(" #n ")" ::: "memory")
#define FG_WAIT_L(n) asm volatile("s_waitcnt lgkmcnt(" #n ")" ::: "memory")
#define FG_BAR __builtin_amdgcn_s_barrier()
#define FG_SCHED __builtin_amdgcn_sched_barrier(0)
  Unit cur, nxt; int ui = 0;
  if (!S.next(0, cur)) return;
  f32x16 acc[2][2][2];
#pragma unroll
  for (int a = 0; a < 2; ++a)
#pragma unroll
    for (int b = 0; b < 2; ++b)
#pragma unroll
      for (int m = 0; m < 2; ++m)
#pragma unroll
        for (int n = 0; n < 16; ++n) acc[a][b][m][n] = 0.f;
  v8i_t At[2][2], B0[2], B1[2];
  const char* cA = cur.A; const char* cB = cur.B;
  const char* nA = cA; const char* nB = cB;
  unsigned gc[2][2] = {{0u, 0u}, {0u, 0u}}, gn[2][2] = {{0u, 0u}, {0u, 0u}};
  if constexpr (GATHER) {
    const LAS int* rw = S.rows(0);
#pragma unroll
    for (int h = 0; h < 2; ++h)
#pragma unroll
      for (int i = 0; i < 2; ++i) { gc[h][i] = (unsigned)(rw[h * HALF + sR[i]] * lda + sC[i]) * 2u; gn[h][i] = gc[h][i]; }
  }
  FG_STAGE_B(FG_SB(0, 0), cB); FG_STAGE_B(FG_SB(0, 1), cB + hstepB); FG_STAGE_A(FG_SA(0, 0), false, 0, 0); FG_STAGE_A(FG_SA(0, 1), false, 1, 0);
  if (wr == 1) FG_BAR;
  FG_WAIT_V(2); FG_BAR;
  FG_STAGE_B(FG_SB(1, 0), cB + kstep); FG_STAGE_A(FG_SA(1, 0), false, 0, kstep); FG_STAGE_B(FG_SB(1, 1), cB + hstepB + kstep);
  FG_WAIT_V(6); FG_BAR;
  for (;;) {
    const bool has_next = S.next(ui + 1, nxt);
    nA = has_next ? nxt.A : cA; nB = has_next ? nxt.B : cB;
    if constexpr (GATHER) {
      if (has_next) {
        const LAS int* rw = S.rows(ui + 1);
#pragma unroll
        for (int h = 0; h < 2; ++h)
#pragma unroll
          for (int i = 0; i < 2; ++i) gn[h][i] = (unsigned)(rw[h * HALF + sR[i]] * lda + sC[i]) * 2u;
      } else {
#pragma unroll
        for (int h = 0; h < 2; ++h)
#pragma unroll
          for (int i = 0; i < 2; ++i) gn[h][i] = gc[h][i];
      }
      FG_WAIT_L(0);
    }
#pragma nounroll
    for (int t = 0; t < nt; t += 2) {
      const bool last = (t == nt - 2);
      const size_t k1 = (size_t)(t + 1) * kstep;
      const size_t k2 = last ? 0 : (size_t)(t + 2) * kstep, k3 = k2 + kstep;
      const char* b2 = last ? nB : cB + (size_t)(t + 2) * kstep; const char* b3 = b2 + kstep;
      FG_LDB(B0, 0, 0); FG_LDB(B1, 0, 1); FG_SCHED; FG_LDA(At, 0, 0); FG_STAGE_A(FG_SA(1, 1), false, 1, k1);
      FG_WAIT_V(8); FG_WAIT_L(0); FG_BAR; FG_MMA(0, 0, At, B0); FG_MMA(0, 1, At, B1); FG_BAR; FG_SCHED;
      FG_LDA(At, 0, 1); FG_STAGE_B(FG_SB(0, 0), b2); FG_STAGE_B(FG_SB(0, 1), b2 + hstepB); FG_STAGE_A(FG_SA(0, 0), last, 0, k2);
      FG_WAIT_V(8); FG_WAIT_L(0); FG_BAR; FG_MMA(1, 0, At, B0); FG_MMA(1, 1, At, B1); FG_BAR; FG_SCHED;
      FG_LDB(B0, 1, 0); FG_LDB(B1, 1, 1); FG_SCHED; FG_LDA(At, 1, 0); FG_STAGE_A(FG_SA(0, 1), last, 1, k2);
      FG_WAIT_V(8); FG_WAIT_L(0); FG_BAR; FG_MMA(0, 0, At, B0); FG_MMA(0, 1, At, B1); FG_BAR; FG_SCHED;
      FG_LDA(At, 1, 1); FG_STAGE_B(FG_SB(1, 0), b3); FG_STAGE_B(FG_SB(1, 1), b3 + hstepB); FG_STAGE_A(FG_SA(1, 0), last, 0, k3);
      FG_WAIT_V(8); FG_WAIT_L(0); FG_BAR; FG_MMA(1, 0, At, B0); FG_MMA(1, 1, At, B1); FG_BAR; FG_SCHED;
    }
    if (wr == 0) FG_BAR;
    E(acc, cur, wr, wc, r32, g32);
    if (!has_next) break;
#pragma unroll
    for (int a = 0; a < 2; ++a)
#pragma unroll
      for (int b = 0; b < 2; ++b)
#pragma unroll
        for (int m = 0; m < 2; ++m)
#pragma unroll
          for (int n = 0; n < 16; ++n) acc[a][b][m][n] = 0.f;
    cur = nxt; cA = nA; cB = nB; ++ui;
    if constexpr (GATHER) {
#pragma unroll
      for (int h = 0; h < 2; ++h)
#pragma unroll
        for (int i = 0; i < 2; ++i) gc[h][i] = gn[h][i];
    }
    if (wr == 1) FG_BAR;
  }
  FG_WAIT_V(0);
  FG_BAR;
#undef FG_SA
#undef FG_SB
#undef FG_GLDS
#undef FG_STAGE_A
#undef FG_STAGE_B
#undef FG_LDA
#undef FG_LDB
#undef FG_MMA
#undef FG_WAIT_V
#undef FG_WAIT_L
#undef FG_BAR
#undef FG_SCHED
}
}

DI void cvt_tile(char* smem, const float* src, int ld, bf16_t* dst, int K, int N, int item, int dld, int f8) {
  float* tile = (float*)smem;
  const int ntn = N >> 6, kt = item / ntn, nt = item % ntn, k0 = kt * 64, n0 = nt * 64, tid = otid();
  __syncthreads();
#pragma unroll
  for (int i = 0; i < 8; ++i) { const int idx = tid + i * NTH, r = idx >> 6, c = idx & 63; tile[r * 65 + c] = src[(size_t)(k0 + r) * ld + n0 + c]; }
  __syncthreads();
  const int n = tid >> 3, k8 = (tid & 7) * 8;
  if (f8) {
    u32x2 o8;
    o8.x = pk4_fp8(tile[(k8 + 0) * 65 + n] * 32.f, tile[(k8 + 1) * 65 + n] * 32.f, tile[(k8 + 2) * 65 + n] * 32.f, tile[(k8 + 3) * 65 + n] * 32.f);
    o8.y = pk4_fp8(tile[(k8 + 4) * 65 + n] * 32.f, tile[(k8 + 5) * 65 + n] * 32.f, tile[(k8 + 6) * 65 + n] * 32.f, tile[(k8 + 7) * 65 + n] * 32.f);
    *(u32x2*)((unsigned char*)dst + (size_t)(n0 + n) * dld + k0 + k8) = o8;
    return;
  }
  u32x4 o;
  o.x = pk2(tile[(k8 + 0) * 65 + n], tile[(k8 + 1) * 65 + n]);
  o.y = pk2(tile[(k8 + 2) * 65 + n], tile[(k8 + 3) * 65 + n]);
  o.z = pk2(tile[(k8 + 4) * 65 + n], tile[(k8 + 5) * 65 + n]);
  o.w = pk2(tile[(k8 + 6) * 65 + n], tile[(k8 + 7) * 65 + n]);
  *(u32x4*)(dst + (size_t)(n0 + n) * dld + k0 + k8) = o;
}
DI void phase_cvt_mix(KP p, char* smem) {
  char* const ws = ows(p);
  {
    bf16_t* wz = (bf16_t*)(ws + OFF_WMIX) + W_WA2;
    for (int i = obid() * NTH + otid(); i < 2 * 2048 * 8; i += gridDim.x * NTH) {
      const int row = i >> 3, c8 = i & 7, d = (row & 2047) >> 10;
      *(u32x4*)(wz + (size_t)row * 128 + (1 - d) * 64 + c8 * 8) = (u32x4){0u, 0u, 0u, 0u};
    }
  }
  for (int it = obid(); it < p->nitems; it += gridDim.x) {
    int j = 0;
    while (j + 1 < p->njobs && p->jobs[j + 1].item0 <= it) ++j;
    cvt_tile(smem, (const float*)(__attribute__((address_space(1))) const float*)p->jobs[j].src, p->jobs[j].ld, (bf16_t*)(__attribute__((address_space(1))) bf16_t*)p->jobs[j].dst, p->jobs[j].K, p->jobs[j].N, it - p->jobs[j].item0, p->jobs[j].dld, p->jobs[j].pad_);
  }
}
constexpr float Y8_SCALE = 16.0f;
constexpr float O8_SCALE = 4.0f;
constexpr float X8_SCALE = 4.0f;
constexpr float W8_SCALE = 32.0f, A8_SCALE = 4.0f, WD8_SCALE = 16.0f;
DI int up_src_col(int np) {
  const int slab = np >> 5, pos = np & 31, q = pos & 15, hh = (q >> 2) & 1, i = (q & 3) + 4 * (q >> 3);
  return (pos >> 4) * 512 + slab * 16 + 8 * hh + i;
}
DI void phase_cvt_moe(KP p, int layer, char* smem) {
  char* const ws = ows(p);
  float* tile = (float*)smem;
  bf16_t* wm = (bf16_t*)(ws + OFF_WMOE);
  const int tid = otid();
  const int NUP = 32 * 256, NDN = 32 * 128;
  const int lr = tid >> 4, lc = (tid & 15) * 4;
  auto issue = [&](int it2, f32x4 (&d)[2]) __attribute__((always_inline)) {
    const float* src; int k0, col;
    if (it2 < NUP) {
      const int e = it2 >> 8, t = it2 & 255, kt = t >> 4, nt = t & 15;
      k0 = kt * 64; col = up_src_col(nt * 64 + lc);
      src = gin(p, 38) + ((size_t)(layer * 32 + e) * 1024) * 1024;
    } else {
      const int i2 = it2 - NUP, e = i2 >> 7, t = i2 & 127, kt = t >> 4, nt = t & 15;
      k0 = kt * 64; col = nt * 64 + lc;
      src = gin(p, 39) + ((size_t)(layer * 32 + e) * 512) * 1024;
    }
    d[0] = *(const f32x4*)(src + (size_t)(k0 + lr) * 1024 + col);
    d[1] = *(const f32x4*)(src + (size_t)(k0 + lr + 32) * 1024 + col);
  };
  f32x4 cur[2], nx[2];
  int it = obid();
  if (it < NUP + NDN) issue(it, cur);
  for (; it < NUP + NDN; it += gridDim.x) {
    const int nit = it + gridDim.x;
    if (nit < NUP + NDN) issue(nit, nx);
    __syncthreads();
#pragma unroll
    for (int i = 0; i < 2; ++i)
#pragma unroll
      for (int j = 0; j < 4; ++j) tile[(lr + 32 * i) * 65 + lc + j] = cur[i][j];
    __syncthreads();
    const int n = tid >> 3, k8 = (tid & 7) * 8;
    const float sc8 = it < NUP ? W8_SCALE : WD8_SCALE;
    u32x2 o;
    o.x = pk4_fp8(tile[(k8 + 0) * 65 + n] * sc8, tile[(k8 + 1) * 65 + n] * sc8, tile[(k8 + 2) * 65 + n] * sc8, tile[(k8 + 3) * 65 + n] * sc8);
    o.y = pk4_fp8(tile[(k8 + 4) * 65 + n] * sc8, tile[(k8 + 5) * 65 + n] * sc8, tile[(k8 + 6) * 65 + n] * sc8, tile[(k8 + 7) * 65 + n] * sc8);
    if (it < NUP) {
      const int e = it >> 8, t = it & 255, kt = t >> 4, nt = t & 15, k0 = kt * 64, n0 = nt * 64;
      *(u32x2*)((unsigned char*)wm + (size_t)e * 1024 * 1024 + (size_t)(n0 + n) * 1024 + k0 + k8) = o;
    } else {
      const int i2 = it - NUP, e = i2 >> 7, t = i2 & 127, kt = t >> 4, nt = t & 15, k0 = kt * 64, n0 = nt * 64;
      *(u32x2*)((unsigned char*)(wm + WMOE_DOWN) + (size_t)e * 1024 * 512 + (size_t)(n0 + n) * 512 + k0 + k8) = o;
    }
    cur[0] = nx[0]; cur[1] = nx[1];
  }
}

constexpr int MOD_LDS = 17 * 1024 * 4 + 8 * 17 * 64 * 4;
DI void phase_mod(KP p, char* smem) {
  char* const ws = ows(p);
  float* sc = (float*)smem;
  float* red = sc + 17 * 1024;
  const int tid = otid();
  {
    float v[34];
#pragma unroll
    for (int q = 0; q < 32; ++q) v[q] = gin(p, 1)[tid + q * NTH];
    v[32] = gin(p, 3)[tid]; v[33] = gin(p, 3)[tid + NTH];
#pragma unroll
    for (int q = 0; q < 34; ++q) sc[tid + q * NTH] = v[q] * __builtin_amdgcn_rcpf(1.0f + __expf(-v[q]));
  }
  __syncthreads();
  const int col = tid & 63, ks = tid >> 6;
  for (int it = obid(); it < 4 * 96; it += gridDim.x) {
    const int l = it / 96, j = (it % 96) * 64 + col;
    const float* w = gin(p, 4) + (size_t)l * 1024 * 6144 + j;
    float acc[17];
#pragma unroll
    for (int b = 0; b < 17; ++b) acc[b] = 0.f;
    for (int k0 = ks * 128; k0 < ks * 128 + 128; k0 += 8) {
      float wv[8];
#pragma unroll
      for (int u = 0; u < 8; ++u) wv[u] = w[(size_t)(k0 + u) * 6144];
#pragma unroll
      for (int u4 = 0; u4 < 2; ++u4)
#pragma unroll
        for (int b = 0; b < 17; ++b) {
          const f32x4 s4 = *(const f32x4*)(sc + b * 1024 + k0 + 4 * u4);
          acc[b] += s4[0] * wv[4 * u4] + s4[1] * wv[4 * u4 + 1] + s4[2] * wv[4 * u4 + 2] + s4[3] * wv[4 * u4 + 3];
        }
    }
    __syncthreads();
#pragma unroll
    for (int b = 0; b < 17; ++b) red[(ks * 17 + b) * 64 + col] = acc[b];
    __syncthreads();
    for (int o = tid; o < 17 * 64; o += NTH) {
      const int b = o >> 6, c = o & 63;
      float s = 0.f;
#pragma unroll
      for (int q = 0; q < 8; ++q) s += red[(q * 17 + b) * 64 + c];
      const int jj = (it % 96) * 64 + c;
      ((float*)(ws + OFF_MOD))[(size_t)(l * 17 + b) * 6144 + jj] = s + gin(p, 5)[l * 6144 + jj];
    }
  }
  {
    bf16_t* wr = (bf16_t*)(ws + OFF_WR);
    for (int i = obid() * NTH + tid; i < 4 * 48 * 1024; i += gridDim.x * NTH) {
      const int l = i / (48 * 1024), n = (i / 1024) % 48, k = i & 1023;
      float w = 0.f;
      if (n < 4) w = gin(p, 34)[((size_t)l * 1024 + k) * 4 + n];
      else if (n < 36) w = gin(p, 36)[((size_t)l * 1024 + k) * 32 + (n - 4)];
      const bf16_t hi = f2bf(w);
      wr[((size_t)(l * 2 + 0) * 48 + n) * 1024 + k] = hi;
      wr[((size_t)(l * 2 + 1) * 48 + n) * 1024 + k] = f2bf(w - bf2f(hi));
    }
  }
  if (obid() == 0) {
    float* rc = (float*)(ws + OFF_ROPE);
    for (int i = tid; i < 1024; i += NTH) {
      const int pos = i >> 4, f = i & 15;
      const float inv = powf(10000.0f, -(float)f / 16.0f);
      const float ang = (float)pos * inv;
      rc[i] = cosf(ang); rc[1024 + i] = sinf(ang);
    }
  }
}

DI void moe_blkstart(char* ws, int layer, int* bs  ) {
  if (otid() == 0) {
    const int* cnt = (const int*)(ws + OFF_CNT) + layer * 32 * CNT_STRIDE;
    int s = 0;
    for (int e = 0; e < 32; ++e) { bs[e] = s; s += (cnt[e * CNT_STRIDE] + MOE_PAD - 1) / MOE_PAD; }
    bs[32] = s;
  }
  __syncthreads();
}
template <int MODE, bool DRY = false, bool OUT8 = false>
DI void phase_norm1(KP p, int layer, char* smem) {
  char* const ws = ows(p);
  int* bs = (int*)smem;
  if (MODE != 0) moe_blkstart(ws, MODE == 3 ? 3 : layer - 1, bs);
  const int lane = otid() & 63, wid = otid() >> 6;
  const int nrows = MODE == 3 ? TL : TT;
  const unsigned char* yb = (const unsigned char*)(ws + OFF_U + UM_YB);
  const int* tok = (const int*)(ws + OFF_TOK);
  bf16_t* hb = (bf16_t*)(ws + OFF_H);
  constexpr int NR = 4;
  const int stride = gridDim.x * 8;
  for (int rA = obid() * 8 + wid; rA < nrows; rA += NR * stride) {
    int rr[NR]; bool has[NR];
#pragma unroll
    for (int k = 0; k < NR; ++k) { has[k] = rA + k * stride < nrows; rr[k] = has[k] ? rA + k * stride : rA; }
    f32x4 v[NR][4];
    int4 t0[NR], t1[NR];
#pragma unroll
    for (int k = 0; k < NR; ++k) {
      const int r = rr[k];
      if (MODE == 0) {
        const float* src = r < TL ? gin(p, 0) + (size_t)r * DM : gin(p, 2) + (size_t)(r - TL) * DM;
#pragma unroll
        for (int i = 0; i < 4; ++i) v[k][i] = *(const f32x4*)(src + (i * 64 + lane) * 4);
      } else {
        const bf16_t* xr = xrow_ptr(p, ws, r);
#pragma unroll
        for (int i = 0; i < 4; ++i) v[k][i] = ldbf4(xr + (i * 64 + lane) * 4);
        t0[k] = *(const int4*)(tok + (size_t)r * 8);
        t1[k] = *(const int4*)(tok + (size_t)r * 8 + 4);
      }
    }
    if (MODE == 1 || MODE == 3) {
      const int pl = MODE == 3 ? 3 : layer - 1;
      unsigned ya[NR][4], yc[NR][4];
#pragma unroll
      for (int k = 0; k < NR; ++k) {
        const size_t d0 = (size_t)(bs[t0[k].x] * MOE_PAD + t0[k].y), d1 = (size_t)(bs[t0[k].z] * MOE_PAD + t0[k].w);
#pragma unroll
        for (int i = 0; i < 4; ++i) { const int ch = (i * 64 + lane) * 4; ya[k][i] = *(const unsigned*)(yb + d0 * DM + ch); yc[k][i] = *(const unsigned*)(yb + d1 * DM + ch); }
      }
#pragma unroll
      for (int k = 0; k < NR; ++k) {
        const float w0 = __int_as_float(t1[k].x) * (1.0f / Y8_SCALE), w1 = __int_as_float(t1[k].y) * (1.0f / Y8_SCALE);
        const float* g2 = modp(ws, pl, row_bi(rr[k]), 5);
#pragma unroll
        for (int i = 0; i < 4; ++i) {
          const int ch = (i * 64 + lane) * 4;
          const f32x2 a01 = __builtin_amdgcn_cvt_pk_f32_fp8((int)ya[k][i], false), a23 = __builtin_amdgcn_cvt_pk_f32_fp8((int)ya[k][i], true);
          const f32x2 b01 = __builtin_amdgcn_cvt_pk_f32_fp8((int)yc[k][i], false), b23 = __builtin_amdgcn_cvt_pk_f32_fp8((int)yc[k][i], true);
          const f32x4 g = *(const f32x4*)(g2 + ch);
          v[k][i][0] += g[0] * (w0 * a01[0] + w1 * b01[0]);
          v[k][i][1] += g[1] * (w0 * a01[1] + w1 * b01[1]);
          v[k][i][2] += g[2] * (w0 * a23[0] + w1 * b23[0]);
          v[k][i][3] += g[3] * (w0 * a23[1] + w1 * b23[1]);
        }
      }
    }
#pragma unroll
    for (int k = 0; k < NR; ++k) {
      if (!has[k]) continue;
      const int r = rr[k], bi = row_bi(r);
      bf16_t* xr = xrow_ptr(p, ws, r);
      if ((MODE == 0 || MODE == 1) && !DRY) {
#pragma unroll
        for (int i = 0; i < 4; ++i) stbf4(xr + (i * 64 + lane) * 4, v[k][i]);
      }
      float ss = 0.f;
#pragma unroll
      for (int i = 0; i < 4; ++i) ss += v[k][i][0] * v[k][i][0] + v[k][i][1] * v[k][i][1] + v[k][i][2] * v[k][i][2] + v[k][i][3] * v[k][i][3];
      ss = wave_sum(ss);
      const float rs = rsqrtf(ss * (1.0f / 1024.0f) + 1e-6f);
      if (MODE == 3) {
#pragma unroll
        for (int i = 0; i < 4; ++i) {
          const int ch = (i * 64 + lane) * 4;
          const f32x4 g = *(const f32x4*)(gin(p, 7) + ch);
          f32x4 o; o[0] = v[k][i][0] * rs * g[0]; o[1] = v[k][i][1] * rs * g[1]; o[2] = v[k][i][2] * rs * g[2]; o[3] = v[k][i][3] * rs * g[3];
          if (!DRY) *(f32x4*)(gout(p) + (size_t)r * DM + ch) = o; else asm volatile("" :: "v"(o[0]), "v"(o[1]), "v"(o[2]), "v"(o[3]));
        }
      } else {
        const float* gn = gin(p, 6) + (size_t)(layer * 2 + 0) * DM;
        const float* sh = modp(ws, layer, bi, 0);
        const float* sc = modp(ws, layer, bi, 1);
#pragma unroll
        for (int i = 0; i < 4; ++i) {
          const int ch = (i * 64 + lane) * 4;
          const f32x4 g = *(const f32x4*)(gn + ch), s1 = *(const f32x4*)(sc + ch), s0 = *(const f32x4*)(sh + ch);
          float o[4];
#pragma unroll
          for (int j = 0; j < 4; ++j) o[j] = v[k][i][j] * rs * g[j] * (1.0f + s1[j]) + s0[j];
          if constexpr (OUT8) {
            const unsigned w8 = pk4_fp8(o[0] * X8_SCALE, o[1] * X8_SCALE, o[2] * X8_SCALE, o[3] * X8_SCALE);
            if (!DRY) *(unsigned*)((unsigned char*)(ws + OFF_H8) + (size_t)r * DM + ch) = w8; else asm volatile("" :: "v"(w8));
          } else {
            u32x2 w; w.x = pk2(o[0], o[1]); w.y = pk2(o[2], o[3]);
            if (!DRY) *(u32x2*)(hb + (size_t)r * DM + ch) = w; else asm volatile("" :: "v"(w.x), "v"(w.y));
          }
        }
      }
    }
  }
}

constexpr int R2_TLD = 1032;
constexpr int R2_LLD = 49;
constexpr int R2_LDS = 64 * R2_TLD * 2 + 64 * R2_LLD * 4;
template <bool DRY = false>
DI void phase_norm2_router(KP p, int layer, char* smem) {
  char* const ws = ows(p);
  const int tid = otid(), lane = tid & 63, wid = tid >> 6, fr = lane & 15, fq = lane >> 4;
  bf16_t* tile = (bf16_t*)smem;
  float* lgt = (float*)(smem + 64 * R2_TLD * 2);
  const int nrows = layer == 3 ? TL : TT;
  unsigned char* h8 = (unsigned char*)(ws + OFF_H8);
  int* tok = (int*)(ws + OFF_TOK);
  int* rowl = (int*)(ws + OFF_ROWL);
  int* cnt = (int*)(ws + OFF_CNT) + layer * 32 * CNT_STRIDE;
  const float* bg = gin(p, 35) + layer * 4;
  const float* be = gin(p, 37) + layer * 32;
  const float* gn = gin(p, 6) + (size_t)(layer * 2 + 1) * DM;
  const bf16_t* wrh = (const bf16_t*)(ws + OFF_WR) + (size_t)layer * 2 * 48 * 1024;
  const bf16_t* wrl = wrh + 48 * 1024;
  bf16x8 bh[4][3], bl[4][3];
#pragma unroll
  for (int ks = 0; ks < 4; ++ks)
#pragma unroll
    for (int nt = 0; nt < 3; ++nt) {
      const size_t o = (size_t)(nt * 16 + fr) * 1024 + wid * 128 + ks * 32 + fq * 8;
      bh[ks][nt] = *(const bf16x8*)(wrh + o); bl[ks][nt] = *(const bf16x8*)(wrl + o);
    }
  int pea = 0, peb = 0, prka = 0, prkb = 0, pbase = 0, pr = 0; float pw0 = 0.f, pw1 = 0.f; bool pend = false;
  for (int rbase = obid() * 64; rbase < nrows; rbase += gridDim.x * 64) {
    const int bi = row_bi(rbase);
    const float* sh = modp(ws, layer, bi, 3);
    const float* sc = modp(ws, layer, bi, 4);
    f32x4 gs[4], s0[4];
#pragma unroll
    for (int i = 0; i < 4; ++i) {
      const int ch = (i * 64 + lane) * 4;
      const f32x4 g = *(const f32x4*)(gn + ch), s1 = *(const f32x4*)(sc + ch);
      gs[i] = g * (1.0f + s1); s0[i] = *(const f32x4*)(sh + ch);
    }
#pragma unroll 2
    for (int q = 0; q < 8; ++q) {
      const int lr = wid * 8 + q, r = rbase + lr;
      const bf16_t* xr = xrow_ptr(p, ws, r);
      f32x4 v[4];
      float ss = 0.f;
#pragma unroll
      for (int i = 0; i < 4; ++i) { v[i] = ldbf4(xr + (i * 64 + lane) * 4); ss += v[i][0] * v[i][0] + v[i][1] * v[i][1] + v[i][2] * v[i][2] + v[i][3] * v[i][3]; }
      ss = wave_sum(ss);
      const float rs = rsqrtf(ss * (1.0f / 1024.0f) + 1e-6f);
#pragma unroll
      for (int i = 0; i < 4; ++i) {
        const int ch = (i * 64 + lane) * 4;
        const f32x4 o = v[i] * rs * gs[i] + s0[i];
        u32x2 w; w.x = pk2(o[0], o[1]); w.y = pk2(o[2], o[3]);
        *(unsigned*)(h8 + (size_t)r * DM + ch) = pk4_fp8(o[0], o[1], o[2], o[3]);
        *(u32x2*)(tile + lr * R2_TLD + ch) = w;
      }
    }
    __syncthreads();
    {
      f32x4 acc[4][3];
#pragma unroll
      for (int rt = 0; rt < 4; ++rt)
#pragma unroll
        for (int nt = 0; nt < 3; ++nt) acc[rt][nt] = (f32x4){0.f, 0.f, 0.f, 0.f};
#pragma unroll
      for (int ks = 0; ks < 4; ++ks)
#pragma unroll
        for (int rt = 0; rt < 4; ++rt) {
          const bf16x8 a = *(const bf16x8*)(tile + (rt * 16 + fr) * R2_TLD + wid * 128 + ks * 32 + fq * 8);
#pragma unroll
          for (int nt = 0; nt < 3; ++nt) { acc[rt][nt] = MFMA16(a, bh[ks][nt], acc[rt][nt]); acc[rt][nt] = MFMA16(a, bl[ks][nt], acc[rt][nt]); }
        }
      __syncthreads();
      float* part = (float*)smem + wid * 64 * R2_LLD;
#pragma unroll
      for (int rt = 0; rt < 4; ++rt)
#pragma unroll
        for (int nt = 0; nt < 3; ++nt)
#pragma unroll
          for (int j = 0; j < 4; ++j) part[(rt * 16 + fq * 4 + j) * R2_LLD + nt * 16 + fr] = acc[rt][nt][j];
    }
    __syncthreads();
    for (int i = tid; i < 64 * 36; i += NTH) {
      const int row = i / 36, col = i - row * 36;
      const float* pp = (const float*)smem + row * R2_LLD + col;
      float sacc = 0.f;
#pragma unroll
      for (int w = 0; w < 8; ++w) sacc += pp[w * 64 * R2_LLD];
      lgt[row * R2_LLD + col] = sacc;
    }
    __syncthreads();
    if (wid == 0) {
      const int r = rbase + lane;
      float* lr_ = lgt + lane * R2_LLD;
      float lg[4];
#pragma unroll
      for (int q = 0; q < 4; ++q) lg[q] = lr_[q] + bg[q];
      int gsel = 0; float gm = lg[0];
#pragma unroll
      for (int q = 1; q < 4; ++q) if (lg[q] > gm) { gm = lg[q]; gsel = q; }
      float gden = 0.f;
#pragma unroll
      for (int q = 0; q < 4; ++q) gden += __expf(lg[q] - gm);
      const float pgrp = 1.0f / gden;
      float le[8];
#pragma unroll
      for (int q = 0; q < 8; ++q) le[q] = lr_[4 + gsel * 8 + q] + be[gsel * 8 + q];
      int i0 = 0; float m0 = le[0];
#pragma unroll
      for (int q = 1; q < 8; ++q) if (le[q] > m0) { m0 = le[q]; i0 = q; }
      int i1 = -1; float m1 = -3.0e38f;
#pragma unroll
      for (int q = 0; q < 8; ++q) if (q != i0 && le[q] > m1) { m1 = le[q]; i1 = q; }
      const float e1 = __expf(m1 - m0);
      const float w0 = pgrp / (1.0f + e1), w1 = pgrp * e1 / (1.0f + e1);
      if (DRY) asm volatile("" :: "v"(w0), "v"(w1), "v"(i0), "v"(i1), "v"(gsel));
      if (!DRY) {
        if (pend) {
          const int ppa = __shfl(pbase, pea) + prka, ppb = __shfl(pbase, peb) + prkb;
          rowl[(size_t)pea * CAP + ppa] = pr; rowl[(size_t)peb * CAP + ppb] = pr;
          int4 t0; t0.x = pea; t0.y = ppa; t0.z = peb; t0.w = ppb;
          int4 t1; t1.x = __float_as_int(pw0); t1.y = __float_as_int(pw1); t1.z = 0; t1.w = 0;
          *(int4*)(tok + (size_t)pr * 8) = t0; *(int4*)(tok + (size_t)pr * 8 + 4) = t1;
        }
        pea = gsel * 8 + i0; peb = gsel * 8 + i1; pw0 = w0; pw1 = w1; pr = r; pend = true;
        LAS int* hist = (LAS int*)(smem + R2_LDS);
        if (lane < 32) hist[lane] = 0;
        prka = __hip_atomic_fetch_add(hist + pea, 1, __ATOMIC_RELAXED, __HIP_MEMORY_SCOPE_WORKGROUP);
        prkb = __hip_atomic_fetch_add(hist + peb, 1, __ATOMIC_RELAXED, __HIP_MEMORY_SCOPE_WORKGROUP);
        const int cntv = lane < 32 ? __hip_atomic_load(hist + (lane & 31), __ATOMIC_RELAXED, __HIP_MEMORY_SCOPE_WORKGROUP) : 0;
        pbase = 0;
        if (lane < 32 && cntv > 0) pbase = atomicAdd(&cnt[lane * CNT_STRIDE], cntv);
      }
    }
  }
  if (!DRY && wid == 0 && pend) {
    const int ppa = __shfl(pbase, pea) + prka, ppb = __shfl(pbase, peb) + prkb;
    rowl[(size_t)pea * CAP + ppa] = pr; rowl[(size_t)peb * CAP + ppb] = pr;
    int4 t0; t0.x = pea; t0.y = ppa; t0.z = peb; t0.w = ppb;
    int4 t1; t1.x = __float_as_int(pw0); t1.y = __float_as_int(pw1); t1.z = 0; t1.w = 0;
    *(int4*)(tok + (size_t)pr * 8) = t0; *(int4*)(tok + (size_t)pr * 8 + 4) = t1;
  }
}

DI void st_bf16x4(bf16_t* p, const f32x4& v) { u32x2 w; w.x = pk2(v[0], v[1]); w.y = pk2(v[2], v[3]); *(u32x2*)p = w; }
constexpr int FG_LDS = fg::STAGE_BYTES;
constexpr int MOE_UMAX = 12;

struct MoeSched {
  const char* A; const char* B; const LAS int* bs; const LAS int* rowtab; int G, c, ntile; size_t tA, eB, tB;
  DI bool next(int i, fg::Unit& u) const {
    const int rt = (G & 31) ? (i * G + c) >> 2 : i * (G >> 2) + (c & 7) * (G >> 5) + (c >> 5), ct = (G & 31) ? (i * G + c) & 3 : (c >> 3) & 3;
    if (rt >= ntile) return false;
    const int ln_ = (int)__builtin_amdgcn_mbcnt_hi(~0u, __builtin_amdgcn_mbcnt_lo(~0u, 0u));
    const int e = __builtin_popcountll(__builtin_amdgcn_ballot_w64(ln_ < 31 && bs[ln_ < 31 ? ln_ + 1 : 0] <= rt));
    u.pm = rt; u.pn = ct; u.aux = e; u.A = A + (size_t)rt * tA; u.B = B + (size_t)e * eB + (size_t)ct * tB; return true;
  }
  DI const LAS int* rows(int i) const { return rowtab + i * 256; }
};
DI void phase_moe_up(KP p, int layer, char* smem) {
  char* const ws = ows(p);
  LAS unsigned char* lds = (LAS unsigned char*)smem;
  LAS int* rowtab = (LAS int*)(lds + FG_LDS);
  int* bs = (int*)(smem + FG_LDS + MOE_UMAX * 1024);
  moe_blkstart(ws, layer, bs);
  const int* cnt = (const int*)(ws + OFF_CNT) + layer * 32 * CNT_STRIDE;
  const int* rowl = (const int*)(ws + OFF_ROWL);
  unsigned char* act8 = (unsigned char*)(ws + OFF_U + UM_ACT);
  MoeSched S;
  S.A = ws + OFF_H8; S.B = ws + OFF_WMOE; S.bs = (const LAS int*)bs; S.rowtab = rowtab; S.G = gridDim.x; S.c = obid(); S.ntile = bs[32];
  S.tA = 0; S.eB = (size_t)1024 * 1024; S.tB = (size_t)256 * 1024;
  {
    const int tid = otid();
    fg::Unit u;
    for (int i = 0; i < MOE_UMAX && S.next(i, u); ++i) {
      if (tid < 256) {
        const int e = u.aux, pos = (u.pm - bs[e]) * 256 + tid;
        rowtab[i * 256 + tid] = pos < cnt[e * CNT_STRIDE] ? rowl[(size_t)e * CAP + pos] : TT;
      }
    }
    __syncthreads();
  }
  auto ep = [&](const f32x16 (&acc)[2][2][2], const fg::Unit& u, int wr, int wc, int r, int h) {
    constexpr float inv = 1.0f / W8_SCALE;
#pragma unroll
    for (int ai = 0; ai < 2; ++ai)
#pragma unroll
      for (int m = 0; m < 2; ++m) {
        const size_t row = (size_t)u.pm * 256 + ai * 128 + wr * 64 + m * 32 + r;
#pragma unroll
        for (int bj = 0; bj < 2; ++bj) {
          const int acol = ((u.pn * 256 + bj * 128 + wc * 32) >> 5) * 16 + 8 * h;
          float o[8];
#pragma unroll
          for (int i = 0; i < 8; ++i) { const float g = acc[ai][bj][m][i] * inv, uu = acc[ai][bj][m][i + 8] * inv; o[i] = g * __builtin_amdgcn_rcpf(1.0f + __expf(-g)) * uu; }
          u32x2 w8; w8.x = pk4_fp8(o[0] * A8_SCALE, o[1] * A8_SCALE, o[2] * A8_SCALE, o[3] * A8_SCALE); w8.y = pk4_fp8(o[4] * A8_SCALE, o[5] * A8_SCALE, o[6] * A8_SCALE, o[7] * A8_SCALE);
          *(u32x2*)(act8 + row * 512 + acol) = w8;
        }
      }
  };
  fg::gemm_phase_f8<true>(lds, 512, 512, 512, S, ep);
}
DI void phase_moe_down(KP p, int layer, char* smem) {
  char* const ws = ows(p);
  LAS unsigned char* lds = (LAS unsigned char*)smem;
  int* bs = (int*)(smem + FG_LDS + MOE_UMAX * 1024);
  moe_blkstart(ws, layer, bs);
  unsigned char* yb = (unsigned char*)(ws + OFF_U + UM_YB);
  MoeSched S;
  S.A = ws + OFF_U + UM_ACT; S.B = ws + OFF_WMOE + WMOE_DOWN * 2; S.bs = (const LAS int*)bs; S.rowtab = nullptr; S.G = gridDim.x; S.c = obid(); S.ntile = bs[32];
  S.tA = (size_t)256 * 512; S.eB = (size_t)1024 * 512; S.tB = (size_t)256 * 512;
  auto ep = [&](const f32x16 (&acc)[2][2][2], const fg::Unit& u, int wr, int wc, int r, int h) {
    constexpr float inv = Y8_SCALE / (A8_SCALE * WD8_SCALE);
#pragma unroll
    for (int ai = 0; ai < 2; ++ai)
#pragma unroll
      for (int m = 0; m < 2; ++m) {
        const size_t row = (size_t)u.pm * 256 + ai * 128 + wr * 64 + m * 32 + r;
#pragma unroll
        for (int bj = 0; bj < 2; ++bj) {
          const f32x16& a = acc[ai][bj][m];
          u32x4 w8;
          w8.x = pk4_fp8(a[0] * inv, a[1] * inv, a[2] * inv, a[3] * inv); w8.y = pk4_fp8(a[4] * inv, a[5] * inv, a[6] * inv, a[7] * inv);
          w8.z = pk4_fp8(a[8] * inv, a[9] * inv, a[10] * inv, a[11] * inv); w8.w = pk4_fp8(a[12] * inv, a[13] * inv, a[14] * inv, a[15] * inv);
          *(u32x4*)(yb + row * DM + u.pn * 256 + bj * 128 + wc * 32 + 16 * h) = w8;
        }
      }
  };
  fg::gemm_phase_f8<false, true>(lds, 256, 256, 256, S, ep);
}

template <int NKC>
DI void phase_qkv(KP p, const bf16_t* Wt, bf16_t* Q, bf16_t* Kb, bf16_t* Vb, char* smem) {
  char* const ws = ows(p);
  LAS unsigned char* lds = (LAS unsigned char*)smem;
  constexpr int N = 1024 + 2 * NKC;
  const float* rc = (const float*)(ws + OFF_ROPE);
  fg::DenseSched S;
  S.A = ws + OFF_H; S.B = (const char*)Wt; S.nM = TT / 256; S.nN = N / 256; S.G = gridDim.x; S.c = obid(); S.tA = (size_t)256 * 1024 * 2; S.tB = (size_t)256 * 1024 * 2;
  auto ep = [&](const f32x4 (&acc)[2][2][4][2], const fg::Unit& u, int wr, int wc, int fr, int fq) {
#pragma unroll
    for (int bj = 0; bj < 2; ++bj) {
      const int colb = u.pn * 256 + bj * 128 + wc * 32;
      if (colb < 1024 + NKC) {
        const bool isq = colb < 1024;
        bf16_t* dst = isq ? Q : Kb;
        const int ldd = isq ? 1024 : NKC, cc2 = (isq ? colb : colb - 1024) + 8 * fq;
        const float qs = isq ? 0.125f : 1.0f;
#pragma unroll
        for (int ai = 0; ai < 2; ++ai)
#pragma unroll
          for (int m = 0; m < 4; ++m) {
            const int row = u.pm * 256 + ai * 128 + wr * 64 + m * 16 + fr;
            f32x4 x0 = acc[ai][bj][m][0], x1 = acc[ai][bj][m][1];
            if (row < TL) {
              const int s = row & 4095, idx = (colb & 32) ? (s & 63) : (s >> 6);
              const f32x4 c = *(const f32x4*)(rc + idx * 16 + 4 * fq), sn = *(const f32x4*)(rc + 1024 + idx * 16 + 4 * fq);
              const f32x4 o0 = x0 * c - x1 * sn, o1 = x1 * c + x0 * sn;
              x0 = o0; x1 = o1;
            }
            const f32x4 y0 = x0 * qs, y1 = x1 * qs;
            if (NKC == 1024 && !isq) {
              u32x2 w8; w8.x = pk4_fp8(y0[0], y0[1], y0[2], y0[3]); w8.y = pk4_fp8(y1[0], y1[1], y1[2], y1[3]);
              *(u32x2*)((unsigned char*)Kb + (size_t)row * 1024 + cc2) = w8;
            } else {
              u32x4 w; w.x = pk2(y0[0], y0[1]); w.y = pk2(y0[2], y0[3]); w.z = pk2(y1[0], y1[1]); w.w = pk2(y1[2], y1[3]);
              *(u32x4*)(dst + (size_t)row * ldd + cc2) = w;
            }
          }
      } else {
        const int cv = colb - (1024 + NKC) + 4 * fq;
        if constexpr (NKC == 1024) {
          unsigned char* Vt = (unsigned char*)Vb;
          const int tq = fr & 3;
#pragma unroll
          for (int ai = 0; ai < 2; ++ai)
#pragma unroll
            for (int m = 0; m < 4; ++m) {
              const int row = u.pm * 256 + ai * 128 + wr * 64 + m * 16 + fr, rowq = row & ~3;
              size_t base; int kq;
              if (rowq < TL) { const int b = rowq >> 12, s0 = rowq & 4095; base = (size_t)b * 1024 * 4096 + (size_t)(s0 >> 6) * 64; kq = (s0 & 63) >> 2; }
              else { const int rc2 = rowq - TL, b = rc2 >> 8, c0 = rc2 & 255; base = (size_t)16 * 1024 * 4096 + (size_t)b * 1024 * 256 + (size_t)(c0 >> 6) * 64; kq = (c0 & 63) >> 2; }
              const size_t rstride = rowq < TL ? 4096 : 256;
              const int pos = 32 * (kq & 1) + 16 * (kq >> 3) + 4 * ((kq >> 1) & 3);
#pragma unroll
              for (int n = 0; n < 2; ++n) {
                const f32x4 a = acc[ai][bj][m][n];
                const int d = (int)pk4_fp8(a[0], a[1], a[2], a[3]);
                const int d0 = __builtin_amdgcn_update_dpp(0, d, 0x00, 0xF, 0xF, true), d1 = __builtin_amdgcn_update_dpp(0, d, 0x55, 0xF, 0xF, true);
                const int d2 = __builtin_amdgcn_update_dpp(0, d, 0xAA, 0xF, 0xF, true), d3 = __builtin_amdgcn_update_dpp(0, d, 0xFF, 0xF, 0xF, true);
                const int sh = 8 * tq;
                const unsigned w = ((unsigned)(d0 >> sh) & 0xffu) | (((unsigned)(d1 >> sh) & 0xffu) << 8) | (((unsigned)(d2 >> sh) & 0xffu) << 16) | (((unsigned)(d3 >> sh) & 0xffu) << 24);
                *(unsigned*)(Vt + base + (size_t)(cv + 16 * n + tq) * rstride + pos) = w;
              }
            }
        } else {
#pragma unroll
          for (int ai = 0; ai < 2; ++ai)
#pragma unroll
            for (int m = 0; m < 4; ++m) {
              const int row = u.pm * 256 + ai * 128 + wr * 64 + m * 16 + fr;
              st_bf16x4(Vb + (size_t)row * NKC + cv, acc[ai][bj][m][0]);
              st_bf16x4(Vb + (size_t)row * NKC + cv + 16, acc[ai][bj][m][1]);
            }
        }
      }
    }
  };
  fg::gemm_phase<false>(lds, 1024, 1024, 1024, S, ep);
}

DI void phase_qkv_diff8(KP p, char* smem) {
  char* const ws = ows(p);
  LAS unsigned char* lds = (LAS unsigned char*)smem;
  const float* rc = (const float*)(ws + OFF_ROPE);
  bf16_t* Q = (bf16_t*)(ws + OFF_U + U1_Q);
  unsigned char* K8 = (unsigned char*)(ws + OFF_U + U1_K);
  unsigned char* Vt = (unsigned char*)(ws + OFF_U + U1_V);
  fg::DenseSched S;
  S.A = ws + OFF_H8; S.B = ws + OFF_WMIX + W_DIFFQKV * 2; S.nM = TT / 256; S.nN = 12; S.G = gridDim.x; S.c = obid(); S.tA = (size_t)256 * 1024; S.tB = (size_t)256 * 1024;
  auto ep = [&](const f32x16 (&acc)[2][2][2], const fg::Unit& u, int wr, int wc, int r, int h) {
    constexpr float inv = 1.0f / (X8_SCALE * 32.0f);
#pragma unroll
    for (int bj = 0; bj < 2; ++bj) {
      const int colb = u.pn * 256 + bj * 128 + wc * 32;
      if (colb < 2048) {
        const bool isq = colb < 1024;
        const float qs = (isq ? 0.125f : 1.0f) * inv;
#pragma unroll
        for (int ai = 0; ai < 2; ++ai)
#pragma unroll
          for (int m = 0; m < 2; ++m) {
            const int row = u.pm * 256 + ai * 128 + wr * 64 + m * 32 + r;
            const f32x16& a = acc[ai][bj][m];
            float y[16];
            if (row < TL) {
              const int s = row & 4095, idx = (colb & 32) ? (s & 63) : (s >> 6);
              const f32x4 c0 = *(const f32x4*)(rc + idx * 16 + 4 * h), c1 = *(const f32x4*)(rc + idx * 16 + 8 + 4 * h);
              const f32x4 s0 = *(const f32x4*)(rc + 1024 + idx * 16 + 4 * h), s1 = *(const f32x4*)(rc + 1024 + idx * 16 + 8 + 4 * h);
#pragma unroll
              for (int i = 0; i < 8; ++i) {
                const float cc = i < 4 ? c0[i & 3] : c1[i & 3], sn = i < 4 ? s0[i & 3] : s1[i & 3];
                y[i] = (a[i] * cc - a[i + 8] * sn) * qs; y[i + 8] = (a[i + 8] * cc + a[i] * sn) * qs;
              }
            } else {
#pragma unroll
              for (int i = 0; i < 16; ++i) y[i] = a[i] * qs;
            }
            if (isq) {
              u32x4 w8;
              w8.x = pk4_fp8(y[0] * 8.f, y[1] * 8.f, y[2] * 8.f, y[3] * 8.f); w8.y = pk4_fp8(y[4] * 8.f, y[5] * 8.f, y[6] * 8.f, y[7] * 8.f);
              w8.z = pk4_fp8(y[8] * 8.f, y[9] * 8.f, y[10] * 8.f, y[11] * 8.f); w8.w = pk4_fp8(y[12] * 8.f, y[13] * 8.f, y[14] * 8.f, y[15] * 8.f);
              *(u32x4*)((unsigned char*)Q + (size_t)row * 1024 + colb + 16 * h) = w8;
            } else {
              u32x4 w8;
              w8.x = pk4_fp8(y[0], y[1], y[2], y[3]); w8.y = pk4_fp8(y[4], y[5], y[6], y[7]); w8.z = pk4_fp8(y[8], y[9], y[10], y[11]); w8.w = pk4_fp8(y[12], y[13], y[14], y[15]);
              *(u32x4*)(K8 + (size_t)row * 1024 + (colb - 1024) + 16 * h) = w8;
            }
          }
      } else {
        const int cv = colb - 2048 + 4 * h, tq = r & 3;
#pragma unroll
        for (int ai = 0; ai < 2; ++ai)
#pragma unroll
          for (int m = 0; m < 2; ++m) {
            const int row = u.pm * 256 + ai * 128 + wr * 64 + m * 32 + r, rowq = row & ~3;
            size_t base; int kq;
            if (rowq < TL) { const int b = rowq >> 12, s0 = rowq & 4095; base = (size_t)b * 1024 * 4096 + (size_t)(s0 >> 6) * 64; kq = (s0 & 63) >> 2; }
            else { const int rc2 = rowq - TL, b = rc2 >> 8, c0 = rc2 & 255; base = (size_t)16 * 1024 * 4096 + (size_t)b * 1024 * 256 + (size_t)(c0 >> 6) * 64; kq = (c0 & 63) >> 2; }
            const size_t rstride = rowq < TL ? 4096 : 256;
            const int pos = 32 * (kq & 1) + 16 * (kq >> 3) + 4 * ((kq >> 1) & 3);
            const f32x16& a = acc[ai][bj][m];
#pragma unroll
            for (int g = 0; g < 4; ++g) {
              const int d = (int)pk4_fp8(a[4 * g] * inv, a[4 * g + 1] * inv, a[4 * g + 2] * inv, a[4 * g + 3] * inv);
              const int d0 = __builtin_amdgcn_update_dpp(0, d, 0x00, 0xF, 0xF, true), d1 = __builtin_amdgcn_update_dpp(0, d, 0x55, 0xF, 0xF, true);
              const int d2 = __builtin_amdgcn_update_dpp(0, d, 0xAA, 0xF, 0xF, true), d3 = __builtin_amdgcn_update_dpp(0, d, 0xFF, 0xF, 0xF, true);
              const int sh = 8 * tq;
              const unsigned w = ((unsigned)(d0 >> sh) & 0xffu) | (((unsigned)(d1 >> sh) & 0xffu) << 8) | (((unsigned)(d2 >> sh) & 0xffu) << 16) | (((unsigned)(d3 >> sh) & 0xffu) << 24);
              *(unsigned*)(Vt + base + (size_t)(cv + 8 * g + tq) * rstride + pos) = w;
            }
          }
      }
    }
  };
  fg::gemm_phase_f8<false, false>(lds, 512, 512, 512, S, ep);
}

DI void phase_qkv_win8(KP p, char* smem) {
  char* const ws = ows(p);
  LAS unsigned char* lds = (LAS unsigned char*)smem;
  const float* rc = (const float*)(ws + OFF_ROPE);
  bf16_t* Q = (bf16_t*)(ws + OFF_U + U0_Q);
  bf16_t* Kb = (bf16_t*)(ws + OFF_U + U0_K);
  bf16_t* Vb = (bf16_t*)(ws + OFF_U + U0_V);
  fg::DenseSched S;
  S.A = ws + OFF_H8; S.B = ws + OFF_WMIX + W_WINQKV * 2; S.nM = TT / 256; S.nN = 6; S.G = gridDim.x; S.c = obid(); S.tA = (size_t)256 * 1024; S.tB = (size_t)256 * 1024;
  auto ep = [&](const f32x16 (&acc)[2][2][2], const fg::Unit& u, int wr, int wc, int r, int h) {
    constexpr float inv = 1.0f / (X8_SCALE * 32.0f);
#pragma unroll
    for (int bj = 0; bj < 2; ++bj) {
      const int colb = u.pn * 256 + bj * 128 + wc * 32;
      if (colb < 1280) {
        const bool isq = colb < 1024;
        const float qs = (isq ? 0.125f : 1.0f) * inv;
        bf16_t* dst = isq ? Q + colb + 16 * h : Kb + (colb - 1024) + 16 * h;
        const int ldd = isq ? 1024 : 256;
#pragma unroll
        for (int ai = 0; ai < 2; ++ai)
#pragma unroll
          for (int m = 0; m < 2; ++m) {
            const int row = u.pm * 256 + ai * 128 + wr * 64 + m * 32 + r;
            const f32x16& a = acc[ai][bj][m];
            float y[16];
            if (row < TL) {
              const int s = row & 4095, idx = (colb & 32) ? (s & 63) : (s >> 6);
              const f32x4 c0 = *(const f32x4*)(rc + idx * 16 + 4 * h), c1 = *(const f32x4*)(rc + idx * 16 + 8 + 4 * h);
              const f32x4 s0 = *(const f32x4*)(rc + 1024 + idx * 16 + 4 * h), s1 = *(const f32x4*)(rc + 1024 + idx * 16 + 8 + 4 * h);
#pragma unroll
              for (int i = 0; i < 8; ++i) {
                const float cc = i < 4 ? c0[i & 3] : c1[i & 3], sn = i < 4 ? s0[i & 3] : s1[i & 3];
                y[i] = (a[i] * cc - a[i + 8] * sn) * qs; y[i + 8] = (a[i + 8] * cc + a[i] * sn) * qs;
              }
            } else {
#pragma unroll
              for (int i = 0; i < 16; ++i) y[i] = a[i] * qs;
            }
            u32x4 w0, w1;
            w0.x = pk2(y[0], y[1]); w0.y = pk2(y[2], y[3]); w0.z = pk2(y[4], y[5]); w0.w = pk2(y[6], y[7]);
            w1.x = pk2(y[8], y[9]); w1.y = pk2(y[10], y[11]); w1.z = pk2(y[12], y[13]); w1.w = pk2(y[14], y[15]);
            bf16_t* q = dst + (size_t)row * ldd;
            *(u32x4*)q = w0; *(u32x4*)(q + 8) = w1;
          }
      } else {
        const int cv = colb - 1280 + 4 * h;
#pragma unroll
        for (int ai = 0; ai < 2; ++ai)
#pragma unroll
          for (int m = 0; m < 2; ++m) {
            const int row = u.pm * 256 + ai * 128 + wr * 64 + m * 32 + r;
            const f32x16& a = acc[ai][bj][m];
#pragma unroll
            for (int g = 0; g < 4; ++g) {
              f32x4 v4; v4[0] = a[4 * g] * inv; v4[1] = a[4 * g + 1] * inv; v4[2] = a[4 * g + 2] * inv; v4[3] = a[4 * g + 3] * inv;
              st_bf16x4(Vb + (size_t)row * 256 + cv + 8 * g, v4);
            }
          }
      }
    }
  };
  fg::gemm_phase_f8<false, false>(lds, 512, 512, 512, S, ep);
}

template <bool DRY = false>
DI void phase_oproj(KP p, int layer, const bf16_t* A, const bf16_t* Wt, int nrows, char* smem) {
  char* const ws = ows(p);
  LAS unsigned char* lds = (LAS unsigned char*)smem;
  fg::DenseSched S;
  S.A = (const char*)A; S.B = (const char*)Wt; S.nM = nrows / 256; S.nN = 4; S.G = gridDim.x; S.c = obid(); S.tA = (size_t)256 * 1024 * 2; S.tB = (size_t)256 * 1024 * 2;
  auto ep = [&](const f32x4 (&acc)[2][2][4][2], const fg::Unit& u, int wr, int wc, int fr, int fq) {
    const int row0 = u.pm * 256 + wr * 64 + fr, colb = u.pn * 256 + wc * 32 + 4 * fq;
    const float* g1 = modp(ws, layer, row_bi(row0), 2) + colb;
    f32x4 g[2][2];
#pragma unroll
    for (int bj = 0; bj < 2; ++bj)
#pragma unroll
      for (int n = 0; n < 2; ++n) g[bj][n] = *(const f32x4*)(g1 + bj * 128 + n * 16);
    f32x4 xa[2][2], xb[2][2];
    bf16_t* xr = xrow_ptr(p, ws, row0) + colb;
#pragma unroll
    for (int bj = 0; bj < 2; ++bj)
#pragma unroll
      for (int n = 0; n < 2; ++n) xa[bj][n] = ldbf4(xr + bj * 128 + n * 16);
#pragma unroll
    for (int rr = 0; rr < 8; ++rr) {
      const int ai = rr >> 2, m = rr & 3;
      bf16_t* xn = xr;
      if (rr + 1 < 8) {
        xn = xrow_ptr(p, ws, row0 + ((rr + 1) >> 2) * 128 + ((rr + 1) & 3) * 16) + colb;
#pragma unroll
        for (int bj = 0; bj < 2; ++bj)
#pragma unroll
          for (int n = 0; n < 2; ++n) xb[bj][n] = ldbf4(xn + bj * 128 + n * 16);
      }
#pragma unroll
      for (int bj = 0; bj < 2; ++bj)
#pragma unroll
        for (int n = 0; n < 2; ++n) {
          const f32x4 x = xa[bj][n] + g[bj][n] * acc[ai][bj][m][n];
          if (!DRY) stbf4(xr + bj * 128 + n * 16, x); else asm volatile("" :: "v"(x[0]), "v"(x[1]), "v"(x[2]), "v"(x[3]));
        }
#pragma unroll
      for (int bj = 0; bj < 2; ++bj)
#pragma unroll
        for (int n = 0; n < 2; ++n) xa[bj][n] = xb[bj][n];
      xr = xn;
    }
  };
  fg::gemm_phase<false>(lds, 1024, 1024, 1024, S, ep);
}

template <bool DRY = false>
DI void phase_oproj8(KP p, int layer, const char* A8, const char* W8, int nrows, char* smem) {
  char* const ws = ows(p);
  LAS unsigned char* lds = (LAS unsigned char*)smem;
  fg::DenseSched S;
  S.A = A8; S.B = W8; S.nM = nrows / 256; S.nN = 4; S.G = gridDim.x; S.c = obid(); S.tA = (size_t)256 * 1024; S.tB = (size_t)256 * 1024;
  auto ep = [&](const f32x16 (&acc)[2][2][2], const fg::Unit& u, int wr, int wc, int r, int h) {
    constexpr float inv = 1.0f / (O8_SCALE * 32.0f);
    const int row0 = u.pm * 256 + wr * 64 + r, colb = u.pn * 256 + wc * 32 + 16 * h;
    const float* g1 = modp(ws, layer, row_bi(row0), 2) + colb;
#pragma unroll
    for (int bj = 0; bj < 2; ++bj) {
      f32x4 g[4];
#pragma unroll
      for (int q = 0; q < 4; ++q) g[q] = *(const f32x4*)(g1 + bj * 128 + 4 * q) * inv;
#pragma unroll
      for (int ai = 0; ai < 2; ++ai)
#pragma unroll
        for (int m = 0; m < 2; ++m) {
          bf16_t* xr = xrow_ptr(p, ws, row0 + ai * 128 + m * 32) + colb + bj * 128;
          const u32x4 x0 = ld16(xr), x1 = ld16(xr + 8);
          const f32x16& a = acc[ai][bj][m];
          u32x4 w0, w1;
          w0.x = pk2(bflo(x0.x) + g[0][0] * a[0], bfhi(x0.x) + g[0][1] * a[1]); w0.y = pk2(bflo(x0.y) + g[0][2] * a[2], bfhi(x0.y) + g[0][3] * a[3]);
          w0.z = pk2(bflo(x0.z) + g[1][0] * a[4], bfhi(x0.z) + g[1][1] * a[5]); w0.w = pk2(bflo(x0.w) + g[1][2] * a[6], bfhi(x0.w) + g[1][3] * a[7]);
          w1.x = pk2(bflo(x1.x) + g[2][0] * a[8], bfhi(x1.x) + g[2][1] * a[9]); w1.y = pk2(bflo(x1.y) + g[2][2] * a[10], bfhi(x1.y) + g[2][3] * a[11]);
          w1.z = pk2(bflo(x1.z) + g[3][0] * a[12], bfhi(x1.z) + g[3][1] * a[13]); w1.w = pk2(bflo(x1.w) + g[3][2] * a[14], bfhi(x1.w) + g[3][3] * a[15]);
          if (!DRY) { *(u32x4*)xr = w0; *(u32x4*)(xr + 8) = w1; } else asm volatile("" :: "v"(w0), "v"(w1));
        }
    }
  };
  fg::gemm_phase_f8<false, true>(lds, 512, 512, 512, S, ep);
}

DI void phase_pool_pre(KP p, char* smem) {
  char* const ws = ows(p);
  const int lane = otid() & 63, wid = otid() >> 6;
  const bf16_t* hb = (const bf16_t*)(ws + OFF_H);
  bf16_t* Y = (bf16_t*)(ws + OFF_U + U2_Y);
  const int ch0 = lane * 16, half = 1 << (lane >> 4);
  auto acc16 = [&](float (&a)[16], const bf16_t* q, float sg) __attribute__((always_inline)) {
    const u32x4 v0 = ld16(q), v1 = ld16(q + 8);
    a[0] += sg * bflo(v0.x); a[1] += sg * bfhi(v0.x); a[2] += sg * bflo(v0.y); a[3] += sg * bfhi(v0.y); a[4] += sg * bflo(v0.z); a[5] += sg * bfhi(v0.z); a[6] += sg * bflo(v0.w); a[7] += sg * bfhi(v0.w);
    a[8] += sg * bflo(v1.x); a[9] += sg * bfhi(v1.x); a[10] += sg * bflo(v1.y); a[11] += sg * bfhi(v1.y); a[12] += sg * bflo(v1.z); a[13] += sg * bfhi(v1.z); a[14] += sg * bflo(v1.w); a[15] += sg * bfhi(v1.w);
  };
  for (int seg = obid() * 8 + wid; seg < 2048 + 128; seg += gridDim.x * 8) {
    const int r0 = seg * 32;
    int s0, L;
    if (r0 < TL) { s0 = r0 & 4095; L = 4096; } else { s0 = (r0 - TL) & 255; L = 256; }
    const bf16_t* base = hb + (size_t)(r0 - s0) * DM + ch0;
    float a[16];
#pragma unroll
    for (int j = 0; j < 16; ++j) a[j] = 0.f;
    {
      const int lo = s0 - half < 0 ? 0 : s0 - half, hi = s0 + half > L ? L : s0 + half;
      for (int q = lo; q < hi; ++q) acc16(a, base + (size_t)q * DM, 1.0f);
    }
#pragma unroll 1
    for (int ib = 0; ib < 32; ib += 4) {
      u32x4 cc[4][2], ee[4][2], ll[4][2];
#pragma unroll
      for (int j = 0; j < 4; ++j) {
        const int s = s0 + ib + j;
        const bf16_t* cp = base + (size_t)s * DM;
        const bf16_t* ep = base + (size_t)(s + half < L ? s + half : s) * DM;
        const bf16_t* lp = base + (size_t)(s - half >= 0 ? s - half : s) * DM;
        cc[j][0] = ld16(cp); cc[j][1] = ld16(cp + 8); ee[j][0] = ld16(ep); ee[j][1] = ld16(ep + 8); ll[j][0] = ld16(lp); ll[j][1] = ld16(lp + 8);
      }
#pragma unroll
      for (int j = 0; j < 4; ++j) {
        const int s = s0 + ib + j;
        const int lo = s - half < 0 ? 0 : s - half, hi = s + half > L ? L : s + half;
        const float inv = 1.0f / (float)(hi - lo);
        const u32x4 c0 = cc[j][0], c1 = cc[j][1];
        u32x4 o0, o1;
        o0.x = pk2(a[0] * inv - bflo(c0.x), a[1] * inv - bfhi(c0.x)); o0.y = pk2(a[2] * inv - bflo(c0.y), a[3] * inv - bfhi(c0.y));
        o0.z = pk2(a[4] * inv - bflo(c0.z), a[5] * inv - bfhi(c0.z)); o0.w = pk2(a[6] * inv - bflo(c0.w), a[7] * inv - bfhi(c0.w));
        o1.x = pk2(a[8] * inv - bflo(c1.x), a[9] * inv - bfhi(c1.x)); o1.y = pk2(a[10] * inv - bflo(c1.y), a[11] * inv - bfhi(c1.y));
        o1.z = pk2(a[12] * inv - bflo(c1.z), a[13] * inv - bfhi(c1.z)); o1.w = pk2(a[14] * inv - bflo(c1.w), a[15] * inv - bfhi(c1.w));
        *(u32x4*)(Y + (size_t)(r0 + ib + j) * DM + ch0) = o0; *(u32x4*)(Y + (size_t)(r0 + ib + j) * DM + ch0 + 8) = o1;
        const float fe = s + half < L ? 1.0f : 0.0f, fl = s - half >= 0 ? -1.0f : 0.0f;
        const u32x4 e0 = ee[j][0], e1 = ee[j][1], l0 = ll[j][0], l1 = ll[j][1];
        a[0] += fe * bflo(e0.x) + fl * bflo(l0.x); a[1] += fe * bfhi(e0.x) + fl * bfhi(l0.x); a[2] += fe * bflo(e0.y) + fl * bflo(l0.y); a[3] += fe * bfhi(e0.y) + fl * bfhi(l0.y);
        a[4] += fe * bflo(e0.z) + fl * bflo(l0.z); a[5] += fe * bfhi(e0.z) + fl * bfhi(l0.z); a[6] += fe * bflo(e0.w) + fl * bflo(l0.w); a[7] += fe * bfhi(e0.w) + fl * bfhi(l0.w);
        a[8] += fe * bflo(e1.x) + fl * bflo(l1.x); a[9] += fe * bfhi(e1.x) + fl * bfhi(l1.x); a[10] += fe * bflo(e1.y) + fl * bflo(l1.y); a[11] += fe * bfhi(e1.y) + fl * bfhi(l1.y);
        a[12] += fe * bflo(e1.z) + fl * bflo(l1.z); a[13] += fe * bfhi(e1.z) + fl * bfhi(l1.z); a[14] += fe * bflo(e1.w) + fl * bflo(l1.w); a[15] += fe * bfhi(e1.w) + fl * bfhi(l1.w);
      }
    }
  }
}
struct PoolSched {
  const char* A; const char* B; int G, c;
  DI bool next(int i, fg::Unit& u) const {
    const int L = i * G + c; if (L >= (TT / 256) * 4) return false;
    const int pm = L >> 2, g = L & 3;
    u.pm = pm; u.pn = g; u.aux = 0; u.A = A + ((size_t)pm * 256 * 1024 + g * 256) * 2; u.B = B + (size_t)g * 65536 * 2; return true;
  }
  DI const LAS int* rows(int) const { return nullptr; }
};
template <bool DRY = false>
DI void phase_pool(KP p, char* smem) {
  char* const ws = ows(p);
  LAS unsigned char* lds = (LAS unsigned char*)smem;
  const float* pb = gin(p, 16);
  const float* psc = gin(p, 17);
  PoolSched S; S.A = ws + OFF_U + U2_Y; S.B = ws + OFF_WMIX + W_POOL * 2; S.G = gridDim.x; S.c = obid();
  auto ep = [&](const f32x4 (&acc)[2][2][4][2], const fg::Unit& u, int wr, int wc, int fr, int fq) {
    const int row0 = u.pm * 256 + wr * 64 + fr, colb = u.pn * 256 + wc * 32 + 4 * fq;
    const float* g1 = modp(ws, 2, row_bi(row0), 2) + colb;
    f32x4 g[2][2], bb[2][2];
#pragma unroll
    for (int bj = 0; bj < 2; ++bj)
#pragma unroll
      for (int n = 0; n < 2; ++n) {
        const f32x4 s4 = *(const f32x4*)(psc + colb + bj * 128 + n * 16);
        g[bj][n] = *(const f32x4*)(g1 + bj * 128 + n * 16) * s4;
        bb[bj][n] = *(const f32x4*)(pb + colb + bj * 128 + n * 16) * g[bj][n];
      }
    f32x4 xa[2][2], xb[2][2];
    bf16_t* xr = xrow_ptr(p, ws, row0) + colb;
#pragma unroll
    for (int bj = 0; bj < 2; ++bj)
#pragma unroll
      for (int n = 0; n < 2; ++n) xa[bj][n] = ldbf4(xr + bj * 128 + n * 16);
#pragma unroll
    for (int rr = 0; rr < 8; ++rr) {
      const int ai = rr >> 2, m = rr & 3;
      bf16_t* xn = xr;
      if (rr + 1 < 8) {
        xn = xrow_ptr(p, ws, row0 + ((rr + 1) >> 2) * 128 + ((rr + 1) & 3) * 16) + colb;
#pragma unroll
        for (int bj = 0; bj < 2; ++bj)
#pragma unroll
          for (int n = 0; n < 2; ++n) xb[bj][n] = ldbf4(xn + bj * 128 + n * 16);
      }
#pragma unroll
      for (int bj = 0; bj < 2; ++bj)
#pragma unroll
        for (int n = 0; n < 2; ++n) {
          const f32x4 x = xa[bj][n] + (g[bj][n] * acc[ai][bj][m][n] + bb[bj][n]);
          if (!DRY) stbf4(xr + bj * 128 + n * 16, x); else asm volatile("" :: "v"(x[0]), "v"(x[1]), "v"(x[2]), "v"(x[3]));
        }
#pragma unroll
      for (int bj = 0; bj < 2; ++bj)
#pragma unroll
        for (int n = 0; n < 2; ++n) xa[bj][n] = xb[bj][n];
      xr = xn;
    }
  };
  fg::gemm_phase<false>(lds, 256, 1024, 256, S, ep);
}

typedef short v4i16_t __attribute__((ext_vector_type(4)));
DI s16x4 tr_read(const bf16_t* p) { return __builtin_bit_cast(s16x4, __builtin_amdgcn_ds_read_tr16_b64_v4i16((LAS v4i16_t*)p)); }
DI bf16x8 pack8(const f32x16& x, int s) {
  u32x4 q;
  q.x = pk2(x[8 * s + 0], x[8 * s + 1]); q.y = pk2(x[8 * s + 2], x[8 * s + 3]);
  q.z = pk2(x[8 * s + 4], x[8 * s + 5]); q.w = pk2(x[8 * s + 6], x[8 * s + 7]);
  return __builtin_bit_cast(bf16x8, q);
}
template <int DT, int VLD_, bool MASK>
DI void attn_tile(const bf16_t* sK, int kld, const bf16_t* vbase, const bf16x8 (&qf)[4], f32x16 (&Y)[DT], float& m, float& l, int r, int h, int qpos, int kpos0) {
  f32x16 X[2];
#pragma unroll
  for (int sub = 0; sub < 2; ++sub) {
#pragma unroll
    for (int i = 0; i < 16; ++i) X[sub][i] = 0.f;
#pragma unroll
    for (int s = 0; s < 4; ++s) {
      const bf16x8 a = *(const bf16x8*)(sK + (sub * 32 + r) * kld + 16 * s + 8 * h);
      X[sub] = MFMA32(a, qf[s], X[sub]);
    }
  }
  if (MASK) {
#pragma unroll
    for (int sub = 0; sub < 2; ++sub)
#pragma unroll
      for (int i = 0; i < 16; ++i) {
        const int kp = kpos0 + sub * 32 + (i & 3) + 8 * (i >> 2) + 4 * h;
        const int d = qpos - kp;
        if (d > 128 || d < -128) X[sub][i] = -1e30f;
      }
  }
  float mx = m;
#pragma unroll
  for (int sub = 0; sub < 2; ++sub)
#pragma unroll
    for (int i = 0; i < 16; ++i) mx = fmaxf(mx, X[sub][i]);
  mx = fmaxf(mx, __shfl_xor(mx, 32));
  const float alpha = __expf(m - mx);
  m = mx;
  float ps = 0.f;
#pragma unroll
  for (int sub = 0; sub < 2; ++sub)
#pragma unroll
    for (int i = 0; i < 16; ++i) { const float pv = __expf(X[sub][i] - mx); X[sub][i] = pv; ps += pv; }
  l = l * alpha + ps;
#pragma unroll
  for (int dt = 0; dt < DT; ++dt)
#pragma unroll
    for (int i = 0; i < 16; ++i) Y[dt][i] *= alpha;
#pragma unroll
  for (int sub = 0; sub < 2; ++sub)
#pragma unroll
    for (int s = 0; s < 2; ++s) {
      const bf16x8 pf = pack8(X[sub], s);
#pragma unroll
      for (int dt = 0; dt < DT; ++dt) {
        const bf16_t* vp = vbase + (sub * 32 + 16 * s) * VLD_ + dt * 32;
        const s16x4 lo = tr_read(vp), hi = tr_read(vp + 8 * VLD_);
        const bf16x8 vf = __builtin_shufflevector(lo, hi, 0, 1, 2, 3, 4, 5, 6, 7);
        Y[dt] = MFMA32(vf, pf, Y[dt]);
      }
    }
}

constexpr int A0_KLD = 72, A0_VLD = 96;
constexpr int A0_LDS = 64 * A0_KLD * 2 + 64 * A0_VLD * 2;
DI void phase_attn_win(KP p, char* smem) {
  char* const ws = ows(p);
  bf16_t* sK = (bf16_t*)smem;
  bf16_t* sV = sK + 64 * A0_KLD;
  const bf16_t* Q = (const bf16_t*)(ws + OFF_U + U0_Q);
  const bf16_t* Kb = (const bf16_t*)(ws + OFF_U + U0_K);
  const bf16_t* Vb = (const bf16_t*)(ws + OFF_U + U0_V);
  bf16_t* O = (bf16_t*)(ws + OFF_U + U0_O);
  const float* sink = gin(p, 9);
  const int tid = otid(), lane = tid & 63, wid = tid >> 6, r = lane & 31, h = lane >> 5;
  const bf16_t* vbase = sV + (4 * h + ((lane & 15) >> 2)) * A0_VLD + 16 * ((lane >> 4) & 1) + 4 * (lane & 3);
  const int NLAT = 16 * 4 * 32 * 2, NCTX = 16 * 16;
  for (int it = obid(); it < NLAT + NCTX; it += gridDim.x) {
    const bool lat = it < NLAT;
    int b, kvh, qb = 0, head, qrow, qpos;
    if (lat) {
      b = it >> 8; kvh = (it >> 6) & 3; qb = (it >> 1) & 31; const int hp = it & 1;
      head = kvh * 4 + hp * 2 + (wid >> 2);
      qpos = qb * 128 + (wid & 3) * 32 + r; qrow = b * 4096 + qpos;
    } else {
      const int i2 = it - NLAT; b = i2 >> 4; head = i2 & 15; kvh = head >> 2;
      qpos = wid * 32 + r; qrow = TL + b * 256 + qpos;
    }
    bf16x8 qf[4];
#pragma unroll
    for (int s = 0; s < 4; ++s) qf[s] = *(const bf16x8*)(Q + (size_t)qrow * DM + head * 64 + 16 * s + 8 * h);
    f32x16 Y[2];
#pragma unroll
    for (int dt = 0; dt < 2; ++dt)
#pragma unroll
      for (int i = 0; i < 16; ++i) Y[dt][i] = 0.f;
    float m = sink[head], l = h == 0 ? 1.0f : 0.0f;
    const int kr = tid >> 3, k8 = (tid & 7) * 8;
    auto tile_ok = [&](int t) -> bool { if (t >= 6) return true; if (!lat) return false; const int kt = 2 * qb - 2 + t; return kt >= 0 && kt < 64; };
    auto trow = [&](int t) -> size_t { return t < 6 ? (size_t)b * 4096 + (2 * qb - 2 + t) * 64 + kr : (size_t)TL + b * 256 + (t - 6) * 64 + kr; };
    int t = 0;
    while (t < 10 && !tile_ok(t)) ++t;
    u32x4 rk = ld16(Kb + trow(t) * 256 + kvh * 64 + k8), rv = ld16(Vb + trow(t) * 256 + kvh * 64 + k8);
    while (t < 10) {
      __syncthreads();
      *(u32x4*)(sK + kr * A0_KLD + k8) = rk;
      *(u32x4*)(sV + kr * A0_VLD + k8) = rv;
      __syncthreads();
      int tn = t + 1;
      while (tn < 10 && !tile_ok(tn)) ++tn;
      if (tn < 10) { rk = ld16(Kb + trow(tn) * 256 + kvh * 64 + k8); rv = ld16(Vb + trow(tn) * 256 + kvh * 64 + k8); }
      if (t < 6) attn_tile<2, A0_VLD, true>(sK, A0_KLD, vbase, qf, Y, m, l, r, h, qpos, (2 * qb - 2 + t) * 64);
      else attn_tile<2, A0_VLD, false>(sK, A0_KLD, vbase, qf, Y, m, l, r, h, 0, 0);
      t = tn;
    }
    const float lt = l + __shfl_xor(l, 32);
    const float inv = 1.0f / lt;
#pragma unroll
    for (int dt = 0; dt < 2; ++dt)
#pragma unroll
      for (int g = 0; g < 4; ++g) {
        const float i8 = inv * O8_SCALE;
        *(unsigned*)((unsigned char*)O + (size_t)qrow * DM + head * 64 + dt * 32 + 8 * g + 4 * h) = pk4_fp8(Y[dt][4 * g] * i8, Y[dt][4 * g + 1] * i8, Y[dt][4 * g + 2] * i8, Y[dt][4 * g + 3] * i8);
      }
  }
}

constexpr int A1_KLD = 136, A1_VLD = 160;
constexpr int A1_K8LD = 144;
constexpr int A1_V8LD = 80;
constexpr int A1_KB = 64 * A1_K8LD, A1_VB = 128 * A1_V8LD;
constexpr int A1_LDS = 2 * A1_KB + 2 * A1_VB + 4 * 128 * 32 * 4;
DI void qk_tile(const bf16_t* sK, int kld, const bf16x8 (&qf)[4], f32x16 (&X)[2], int r, int h) {
  bf16x8 kf[2][4];
#pragma unroll
  for (int sub = 0; sub < 2; ++sub)
#pragma unroll
    for (int s = 0; s < 4; ++s) kf[sub][s] = *(const bf16x8*)(sK + (sub * 32 + r) * kld + 16 * s + 8 * h);
#pragma unroll
  for (int sub = 0; sub < 2; ++sub) {
#pragma unroll
    for (int i = 0; i < 16; ++i) X[sub][i] = 0.f;
#pragma unroll
    for (int s = 0; s < 4; ++s) X[sub] = MFMA32(kf[sub][s], qf[s], X[sub]);
  }
}
typedef int v8i_t __attribute__((ext_vector_type(8)));
typedef int v4i_t __attribute__((ext_vector_type(4)));
DI void qk8_tile(const unsigned char* sK8, int kld8, const v8i_t& q8, f32x16 (&X)[2], int r, int h) {
  v8i_t kf[2];
#pragma unroll
  for (int sub = 0; sub < 2; ++sub) { const v4i_t* q_ = (const v4i_t*)(sK8 + (sub * 32 + r) * kld8 + 32 * h); kf[sub] = __builtin_shufflevector(q_[0], q_[1], 0, 1, 2, 3, 4, 5, 6, 7); }
#pragma unroll
  for (int sub = 0; sub < 2; ++sub) {
    f32x16 z;
#pragma unroll
    for (int i = 0; i < 16; ++i) z[i] = 0.f;
    X[sub] = __builtin_amdgcn_mfma_scale_f32_32x32x64_f8f6f4(kf[sub], q8, z, 0, 0, 0, 0x7f7f7f7f, 0, 0x7f7f7f7f);
  }
}
template <int DT, int QSC = 1, int PSH = 0>
DI void softmax_lazy(f32x16 (&X)[2], f32x16 (&Y)[DT], float& m, float& l) {
  constexpr float THR = 4.0f * QSC, L2E = 1.44269504089f / QSC;
  float c0 = X[0][0], c1 = X[0][1], c2 = X[0][2], c3 = X[0][3];
#pragma unroll
  for (int i = 4; i < 16; i += 4) { c0 = fmaxf(c0, X[0][i]); c1 = fmaxf(c1, X[0][i + 1]); c2 = fmaxf(c2, X[0][i + 2]); c3 = fmaxf(c3, X[0][i + 3]); }
#pragma unroll
  for (int i = 0; i < 16; i += 4) { c0 = fmaxf(c0, X[1][i]); c1 = fmaxf(c1, X[1][i + 1]); c2 = fmaxf(c2, X[1][i + 2]); c3 = fmaxf(c3, X[1][i + 3]); }
  float mx = fmaxf(fmaxf(c0, c1), fmaxf(c2, c3));
  { float a, b; swap32(mx, a, b); mx = fmaxf(a, b); }
  if (__builtin_amdgcn_ballot_w64(mx > m + THR) != 0ull) {
    const float mn = fmaxf(m, mx);
    const float alpha = __builtin_amdgcn_exp2f((m - mn) * L2E);
    m = mn; l *= alpha;
#pragma unroll
    for (int dt = 0; dt < DT; ++dt)
#pragma unroll
      for (int i = 0; i < 16; ++i) Y[dt][i] *= alpha;
  }
  const float nm = fmaf(-m, L2E, (float)PSH);
  float ps0 = 0.f, ps1 = 0.f, ps2 = 0.f, ps3 = 0.f;
#pragma unroll
  for (int sub = 0; sub < 2; ++sub)
#pragma unroll
    for (int i = 0; i < 16; i += 4) {
      const float p0 = __builtin_amdgcn_exp2f(fmaf(X[sub][i], L2E, nm)), p1 = __builtin_amdgcn_exp2f(fmaf(X[sub][i + 1], L2E, nm));
      const float p2 = __builtin_amdgcn_exp2f(fmaf(X[sub][i + 2], L2E, nm)), p3 = __builtin_amdgcn_exp2f(fmaf(X[sub][i + 3], L2E, nm));
      X[sub][i] = p0; X[sub][i + 1] = p1; X[sub][i + 2] = p2; X[sub][i + 3] = p3;
      ps0 += p0; ps1 += p1; ps2 += p2; ps3 += p3;
    }
  l += (ps0 + ps1) + (ps2 + ps3);
}
template <int DT, int VLD_>
DI void pv_tile(const f32x16 (&X)[2], const bf16_t* vbase, f32x16 (&Y)[DT]) {
#pragma unroll
  for (int sub = 0; sub < 2; ++sub)
#pragma unroll
    for (int s = 0; s < 2; ++s) {
      const bf16x8 pf = pack8(X[sub], s);
#pragma unroll
      for (int dt = 0; dt < DT; ++dt) {
        const bf16_t* vp = vbase + (sub * 32 + 16 * s) * VLD_ + dt * 32;
        const s16x4 lo = tr_read(vp), hi = tr_read(vp + 8 * VLD_);
        const bf16x8 vf = __builtin_shufflevector(lo, hi, 0, 1, 2, 3, 4, 5, 6, 7);
        Y[dt] = MFMA32(vf, pf, Y[dt]);
      }
    }
}
DI void phase_attn_diff(KP p, char* smem) {
  char* const ws = ows(p);
  unsigned char* sK = (unsigned char*)smem;
  unsigned char* sV = (unsigned char*)(smem + 2 * A1_KB);
  float* comb = (float*)(smem + 2 * A1_KB + 2 * A1_VB);
  const bf16_t* Q = (const bf16_t*)(ws + OFF_U + U1_Q);
  const unsigned char* K8 = (const unsigned char*)(ws + OFF_U + U1_K);
  const unsigned char* Vt = (const unsigned char*)(ws + OFF_U + U1_V);
  bf16_t* O = (bf16_t*)(ws + OFF_U + U1_O);
  const int tid = otid(), lane = tid & 63, wid = tid >> 6, r = lane & 31, h = lane >> 5, grp = wid >> 2;
  const float lambda_init = 0.8f - 0.6f * 0.74081822068f;
  float lam_full;
  {
    const float* lf = gin(p, 12);
    float s1 = 0.f, s2 = 0.f;
    for (int i = 0; i < 64; ++i) { s1 += lf[i] * lf[64 + i]; s2 += lf[128 + i] * lf[192 + i]; }
    lam_full = expf(s1) - expf(s2) + lambda_init;
  }
  const float* subg = gin(p, 13);
  const int NLAT = 16 * 8 * 32, NCTX = 16 * 8 * 2;
  const int kr = tid >> 3, kc = (tid & 7) * 16;
  for (int it = obid(); it < NLAT + NCTX; it += gridDim.x) {
    const bool lat = it < NLAT;
    int b, head, qrow, t0;
    const int nt = 68;
    if (lat) { b = it >> 8; head = (it >> 5) & 7; const int qb = it & 31; qrow = b * 4096 + qb * 128 + (wid & 3) * 32 + r; t0 = 0; }
    else { const int i2 = it - NLAT; b = i2 >> 4; head = (i2 >> 1) & 7; const int hf = i2 & 1; qrow = TL + b * 256 + hf * 128 + (wid & 3) * 32 + r; t0 = 64; }
    v8i_t q8;
    {
      const v4i_t* qp = (const v4i_t*)((const unsigned char*)Q + (size_t)qrow * DM + head * 128 + grp * 64 + 32 * h);
      q8 = __builtin_shufflevector(qp[0], qp[1], 0, 1, 2, 3, 4, 5, 6, 7);
    }
    f32x16 Y[4];
#pragma unroll
    for (int dt = 0; dt < 4; ++dt)
#pragma unroll
      for (int i = 0; i < 16; ++i) Y[dt][i] = 0.f;
    float m = -1e30f, l = 0.f;
    auto goff = [&](int t) -> size_t { return (t < 64 ? (size_t)b * 4096 + t * 64 + kr : (size_t)TL + b * 256 + (t - 64) * 64 + kr) * 1024 + head * 128 + kc; };
    auto stK = [&](int t, const u32x4& a) { *(u32x4*)(sK + (t & 1) * A1_KB + kr * A1_K8LD + kc) = a; };
    const int vd = tid >> 2, vcx = (tid & 3) * 16;
    auto voff = [&](int t) -> size_t { return t < 64 ? ((size_t)(b * 1024 + head * 128 + vd) * 4096 + (size_t)t * 64 + vcx) : ((size_t)16 * 1024 * 4096 + (size_t)(b * 1024 + head * 128 + vd) * 256 + (size_t)(t - 64) * 64 + vcx); };
    auto stV = [&](int t, const u32x4& a) { *(u32x4*)(sV + (t & 1) * A1_VB + vd * A1_V8LD + vcx) = a; };
    u32x4 rk0, rv0;
    __syncthreads();
    rk0 = *(const u32x4*)(K8 + goff(t0)); stK(t0, rk0);
    rk0 = *(const u32x4*)(K8 + goff(t0 + 1)); stK(t0 + 1, rk0);
    rk0 = *(const u32x4*)(K8 + goff(t0 + 2));
    rv0 = *(const u32x4*)(Vt + voff(t0));
    __syncthreads();
    f32x16 Xn[2];
    qk8_tile(sK + (t0 & 1) * A1_KB + grp * 64, A1_K8LD, q8, Xn, r, h);
    __syncthreads();
    v8i_t p8;
    auto pv8 = [&](int t) __attribute__((always_inline)) {
      const unsigned char* vb8 = sV + (t & 1) * A1_VB + r * A1_V8LD + 32 * h;
#pragma unroll
      for (int dt = 0; dt < 4; ++dt) {
        const v4i_t* q_ = (const v4i_t*)(vb8 + dt * 32 * A1_V8LD);
        const v8i_t vf = __builtin_shufflevector(q_[0], q_[1], 0, 1, 2, 3, 4, 5, 6, 7);
        Y[dt] = __builtin_amdgcn_mfma_scale_f32_32x32x64_f8f6f4(vf, p8, Y[dt], 0, 0, 0, 0x7f7f7f7f, 0, 0x7f7f7f7f);
      }
    };
    auto step = [&](int t, f32x16 (&X)[2], f32x16 (&Xo)[2]) __attribute__((always_inline)) {
      if (t + 2 < nt) stK(t + 2, rk0);
      stV(t, rv0);
      if (t + 3 < nt) rk0 = *(const u32x4*)(K8 + goff(t + 3));
      if (t + 1 < nt) rv0 = *(const u32x4*)(Vt + voff(t + 1));
      if (t + 1 < nt) qk8_tile(sK + ((t + 1) & 1) * A1_KB + grp * 64, A1_K8LD, q8, Xo, r, h);
      if (t > t0) pv8(t - 1);
      softmax_lazy<4, 8, 2>(X, Y, m, l);
#pragma unroll
      for (int sub = 0; sub < 2; ++sub)
#pragma unroll
        for (int g4 = 0; g4 < 4; ++g4) p8[4 * sub + g4] = (int)pk4_fp8_nc(X[sub][4 * g4], X[sub][4 * g4 + 1], X[sub][4 * g4 + 2], X[sub][4 * g4 + 3]);
      __syncthreads();
    };
    f32x16 Xm[2];
#pragma unroll 1
    for (int t = t0; t < nt; t += 2) { step(t, Xn, Xm); step(t + 1, Xm, Xn); }
    pv8(nt - 1);
    const float lt = l + __shfl_xor(l, 32);
    const float inv = 1.0f / lt;
    if (grp == 1) {
#pragma unroll
      for (int dt = 0; dt < 4; ++dt)
#pragma unroll
        for (int i = 0; i < 16; ++i) comb[(((wid & 3) * 128) + dt * 32 + (i & 3) + 8 * (i >> 2) + 4 * h) * 32 + r] = Y[dt][i] * inv;
    }
    __syncthreads();
    if (grp == 0) {
      float ss = 0.f;
#pragma unroll
      for (int dt = 0; dt < 4; ++dt)
#pragma unroll
        for (int i = 0; i < 16; ++i) {
          const float o2 = comb[(((wid & 3) * 128) + dt * 32 + (i & 3) + 8 * (i >> 2) + 4 * h) * 32 + r];
          const float vv = Y[dt][i] * inv - lam_full * o2;
          Y[dt][i] = vv; ss += vv * vv;
        }
      ss += __shfl_xor(ss, 32);
      const float rs = rsqrtf(ss * (1.0f / 128.0f) + 1e-6f) * (1.0f - lambda_init);
#pragma unroll
      for (int dt = 0; dt < 4; ++dt)
#pragma unroll
        for (int g = 0; g < 4; ++g) {
          const int d0 = dt * 32 + 8 * g + 4 * h;
          const f32x4 sg = *(const f32x4*)(subg + d0);
          const float r8 = rs * O8_SCALE;
          *(unsigned*)((unsigned char*)O + (size_t)qrow * DM + head * 128 + d0) = pk4_fp8(Y[dt][4 * g] * r8 * sg[0], Y[dt][4 * g + 1] * r8 * sg[1], Y[dt][4 * g + 2] * r8 * sg[2], Y[dt][4 * g + 3] * r8 * sg[3]);
        }
    }
  }
}

DI u32x4 rwkv_mix_load(const bf16_t* hb, const float* mu, int mixi, int row, int k) {
  int s, L;
  if (row < TL) { s = row & 4095; L = 4096; } else { s = (row - TL) & 255; L = 256; }
  const bf16_t* hp = hb + (size_t)row * DM + k;
  const u32x4 c = ld16(hp);
  u32x4 pv = (u32x4){0u, 0u, 0u, 0u}, nx = (u32x4){0u, 0u, 0u, 0u};
  if (s > 0) pv = ld16(hp - DM);
  if (s < L - 1) nx = ld16(hp + DM);
  const float* m0 = mu + (size_t)(0 * 6 + mixi) * DM + k;
  const float* m1 = mu + (size_t)(1 * 6 + mixi) * DM + k;
  const f32x4 a0 = *(const f32x4*)m0, a1 = *(const f32x4*)(m0 + 4), b0 = *(const f32x4*)m1, b1 = *(const f32x4*)(m1 + 4);
  float cv[8] = {bflo(c.x), bfhi(c.x), bflo(c.y), bfhi(c.y), bflo(c.z), bfhi(c.z), bflo(c.w), bfhi(c.w)};
  float pvv[8] = {bflo(pv.x), bfhi(pv.x), bflo(pv.y), bfhi(pv.y), bflo(pv.z), bfhi(pv.z), bflo(pv.w), bfhi(pv.w)};
  float nv[8] = {bflo(nx.x), bfhi(nx.x), bflo(nx.y), bfhi(nx.y), bflo(nx.z), bfhi(nx.z), bflo(nx.w), bfhi(nx.w)};
  float mu0[8] = {a0[0], a0[1], a0[2], a0[3], a1[0], a1[1], a1[2], a1[3]};
  float mu1[8] = {b0[0], b0[1], b0[2], b0[3], b1[0], b1[1], b1[2], b1[3]};
  float o[8];
#pragma unroll
  for (int j = 0; j < 8; ++j) o[j] = cv[j] + (pvv[j] - cv[j]) * mu0[j] + (nv[j] - cv[j]) * mu1[j];
  u32x4 w; w.x = pk2(o[0], o[1]); w.y = pk2(o[2], o[3]); w.z = pk2(o[4], o[5]); w.w = pk2(o[6], o[7]);
  return w;
}
template <int ACT  , class AL>
DI void rwkv_gemm_tile(char* smem, AL la, const bf16_t* Bt, int K, int ldb, bf16_t* dst, int ldd, int row0, int col0, int ncols_valid) {
  auto lb = [&](int tn, int k) -> u32x4 { return (col0 + tn) < ncols_valid ? ld16(Bt + (size_t)(col0 + tn) * ldb + k) : (u32x4){0u, 0u, 0u, 0u}; };
  auto ep = [&](const f32x4 (&acc)[4][2], int r0, int c0, int fr, int fq) {
#pragma unroll
    for (int m = 0; m < 4; ++m)
#pragma unroll
      for (int n = 0; n < 2; ++n)
#pragma unroll
        for (int j = 0; j < 4; ++j) {
          const int row = row0 + r0 + m * 16 + fq * 4 + j, col = col0 + c0 + n * 16 + fr;
          float v = acc[m][n][j];
          if (ACT == 1) v = 1.0f - 2.0f * __builtin_amdgcn_rcpf(1.0f + __expf(2.0f * v));
          if (ACT == 2) v = sigmoidf_(v);
          if (col < ncols_valid) dst[(size_t)row * ldd + col] = f2bf(v);
        }
  };
  sgemm_tile(smem, K, la, lb, ep);
}
DI void phase_rwkv_mix(KP p, char* smem) {
  char* const ws = ows(p);
  const int lane = otid() & 63, wid = otid() >> 6;
  const bf16_t* hb = (const bf16_t*)(ws + OFF_H);
  const float* mu = gin(p, 18);
  bf16_t* XR = (bf16_t*)(ws + OFF_U + U3_XR);
  bf16_t* XK = (bf16_t*)(ws + OFF_U + U3_XK);
  bf16_t* XV = (bf16_t*)(ws + OFF_U + U3_XV);
  const int ch0 = lane * 16;
  for (int r = obid() * 8 + wid; r < TT; r += gridDim.x * 8) {
    int s, L;
    if (r < TL) { s = r & 4095; L = 4096; } else { s = (r - TL) & 255; L = 256; }
    const bf16_t* hp = hb + (size_t)r * DM + ch0;
    float c[16], pv[16], nx[16];
    {
      const u32x4 a = ld16(hp), b = ld16(hp + 8);
      c[0] = bflo(a.x); c[1] = bfhi(a.x); c[2] = bflo(a.y); c[3] = bfhi(a.y); c[4] = bflo(a.z); c[5] = bfhi(a.z); c[6] = bflo(a.w); c[7] = bfhi(a.w);
      c[8] = bflo(b.x); c[9] = bfhi(b.x); c[10] = bflo(b.y); c[11] = bfhi(b.y); c[12] = bflo(b.z); c[13] = bfhi(b.z); c[14] = bflo(b.w); c[15] = bfhi(b.w);
    }
#pragma unroll
    for (int j = 0; j < 16; ++j) { pv[j] = 0.f; nx[j] = 0.f; }
    if (s > 0) {
      const u32x4 a = ld16(hp - DM), b = ld16(hp - DM + 8);
      pv[0] = bflo(a.x); pv[1] = bfhi(a.x); pv[2] = bflo(a.y); pv[3] = bfhi(a.y); pv[4] = bflo(a.z); pv[5] = bfhi(a.z); pv[6] = bflo(a.w); pv[7] = bfhi(a.w);
      pv[8] = bflo(b.x); pv[9] = bfhi(b.x); pv[10] = bflo(b.y); pv[11] = bfhi(b.y); pv[12] = bflo(b.z); pv[13] = bfhi(b.z); pv[14] = bflo(b.w); pv[15] = bfhi(b.w);
    }
    if (s < L - 1) {
      const u32x4 a = ld16(hp + DM), b = ld16(hp + DM + 8);
      nx[0] = bflo(a.x); nx[1] = bfhi(a.x); nx[2] = bflo(a.y); nx[3] = bfhi(a.y); nx[4] = bflo(a.z); nx[5] = bfhi(a.z); nx[6] = bflo(a.w); nx[7] = bfhi(a.w);
      nx[8] = bflo(b.x); nx[9] = bfhi(b.x); nx[10] = bflo(b.y); nx[11] = bfhi(b.y); nx[12] = bflo(b.z); nx[13] = bfhi(b.z); nx[14] = bflo(b.w); nx[15] = bfhi(b.w);
    }
#pragma unroll
    for (int q = 0; q < 3; ++q) {
      const int mixi = q == 0 ? 0 : q + 1;
      if (q == 0 && r >= TL) continue;
      unsigned char* dst = (unsigned char*)(q == 0 ? XR : q == 1 ? XK : XV) + (size_t)r * DM + ch0;
      const float* m0 = mu + (size_t)(0 * 6 + mixi) * DM + ch0;
      const float* m1 = mu + (size_t)(1 * 6 + mixi) * DM + ch0;
      float o[16];
#pragma unroll
      for (int j4 = 0; j4 < 4; ++j4) {
        const f32x4 a = *(const f32x4*)(m0 + 4 * j4), b = *(const f32x4*)(m1 + 4 * j4);
#pragma unroll
        for (int j = 0; j < 4; ++j) { const int k = 4 * j4 + j; o[k] = c[k] + (pv[k] - c[k]) * a[j] + (nx[k] - c[k]) * b[j]; }
      }
      u32x4 w0;
      w0.x = pk4_fp8(o[0] * X8_SCALE, o[1] * X8_SCALE, o[2] * X8_SCALE, o[3] * X8_SCALE); w0.y = pk4_fp8(o[4] * X8_SCALE, o[5] * X8_SCALE, o[6] * X8_SCALE, o[7] * X8_SCALE);
      w0.z = pk4_fp8(o[8] * X8_SCALE, o[9] * X8_SCALE, o[10] * X8_SCALE, o[11] * X8_SCALE); w0.w = pk4_fp8(o[12] * X8_SCALE, o[13] * X8_SCALE, o[14] * X8_SCALE, o[15] * X8_SCALE);
      *(u32x4*)dst = w0;
    }
  }
}
struct RkvSched {
  const char* X0; const char* X1; const char* X2; const char* W; int G, c;
  DI bool next(int i, fg::Unit& u) const {
    int pmg, pn; if (!fg::static_order(i, G, c, 800, 4, pmg, pn)) return false;
    const int job = (pmg >= 256) + (pmg >= 528);
    u.pm = pmg - (job ? 256 + (job - 1) * 272 : 0); u.pn = pn; u.aux = job;
    u.A = X0 + (size_t)job * SZ_TT + (size_t)u.pm * 256 * 1024;
    u.B = W + (size_t)job * 1024 * 1024 * 2 + (size_t)u.pn * 256 * 1024; return true;
  }
  DI const LAS int* rows(int) const { return nullptr; }
};
DI void phase_rwkv_rkv(KP p, char* smem) {
  char* const ws = ows(p);
  LAS unsigned char* lds = (LAS unsigned char*)smem;
  char* U = ws + OFF_U;
  RkvSched S; S.X0 = U + U3_XR; S.X1 = U + U3_XK; S.X2 = U + U3_XV; S.W = ws + OFF_WMIX + W_R * 2; S.G = gridDim.x; S.c = obid();
  auto ep = [&](const f32x16 (&acc)[2][2][2], const fg::Unit& u, int wr, int wc, int r, int h) {
    bf16_t* dst = (bf16_t*)(U + (u.aux ? SZ_TL + (size_t)(u.aux - 1) * SZ_TT : (size_t)0));
    constexpr float inv = 1.0f / (X8_SCALE * 32.0f);
#pragma unroll
    for (int ai = 0; ai < 2; ++ai)
#pragma unroll
      for (int m = 0; m < 2; ++m) {
        const size_t row = (size_t)u.pm * 256 + ai * 128 + wr * 64 + m * 32 + r;
#pragma unroll
        for (int bj = 0; bj < 2; ++bj) {
          const f32x16& a = acc[ai][bj][m];
          u32x4 w0, w1;
          w0.x = pk2(a[0] * inv, a[1] * inv); w0.y = pk2(a[2] * inv, a[3] * inv); w0.z = pk2(a[4] * inv, a[5] * inv); w0.w = pk2(a[6] * inv, a[7] * inv);
          w1.x = pk2(a[8] * inv, a[9] * inv); w1.y = pk2(a[10] * inv, a[11] * inv); w1.z = pk2(a[12] * inv, a[13] * inv); w1.w = pk2(a[14] * inv, a[15] * inv);
          bf16_t* q = dst + row * DM + u.pn * 256 + bj * 128 + wc * 32 + 16 * h;
          *(u32x4*)q = w0; *(u32x4*)(q + 8) = w1;
        }
      }
  };
  fg::gemm_phase_f8<false, true>(lds, 512, 512, 512, S, ep);
}

struct MixRaw { u32x4 c[2], pv[2], nx[2], b[2]; f32x4 a0, a1, b0, b1; };
template <int ACT>
DI void rwkv_mix_gemm_tile(char* smem, const bf16_t* hb, const float* mu, int mixi, const bf16_t* Bt, bf16_t* dst, int row0) {
  bf16_t* sA = (bf16_t*)smem;
  bf16_t* sB = sA + 128 * SGLD;
  const int tid = otid(), lane = tid & 63, wid = tid >> 6, wr = wid >> 2, wc = wid & 3, fr = lane & 15, fq = lane >> 4;
  f32x4 acc[4][2];
#pragma unroll
  for (int m = 0; m < 4; ++m)
#pragma unroll
    for (int n = 0; n < 2; ++n) acc[m][n] = (f32x4){0.f, 0.f, 0.f, 0.f};
  const int r_ = tid >> 3, k_ = (tid & 7) * 8;
  bool hasp[2], hasn[2];
  const bf16_t* hp[2];
#pragma unroll
  for (int i = 0; i < 2; ++i) {
    const int row = row0 + r_ + 64 * i;
    int s_, L;
    if (row < TL) { s_ = row & 4095; L = 4096; } else { s_ = (row - TL) & 255; L = 256; }
    hasp[i] = s_ > 0; hasn[i] = s_ < L - 1;
    hp[i] = hb + (size_t)row * DM + k_;
  }
  const float* m0 = mu + (size_t)(0 * 6 + mixi) * DM + k_;
  const float* m1 = mu + (size_t)(1 * 6 + mixi) * DM + k_;
  const bf16_t* bp = Bt + (size_t)r_ * 1024 + k_;
  auto issue = [&](int kt, MixRaw& q) __attribute__((always_inline)) {
    const int ko = kt * 64;
#pragma unroll
    for (int i = 0; i < 2; ++i) {
      q.c[i] = ld16(hp[i] + ko);
      q.pv[i] = ld16(hp[i] + ko - (hasp[i] ? DM : 0));
      q.nx[i] = ld16(hp[i] + ko + (hasn[i] ? DM : 0));
      q.b[i] = ld16(bp + (size_t)i * 64 * 1024 + ko);
    }
    q.a0 = *(const f32x4*)(m0 + ko); q.a1 = *(const f32x4*)(m0 + ko + 4); q.b0 = *(const f32x4*)(m1 + ko); q.b1 = *(const f32x4*)(m1 + ko + 4);
  };
  auto finish = [&](const MixRaw& q, int i) __attribute__((always_inline)) -> u32x4 {
    const u32x4 c = q.c[i], pv = q.pv[i], nx = q.nx[i];
    const float fp_ = hasp[i] ? 1.0f : 0.0f, fn_ = hasn[i] ? 1.0f : 0.0f;
    const float cv[8] = {bflo(c.x), bfhi(c.x), bflo(c.y), bfhi(c.y), bflo(c.z), bfhi(c.z), bflo(c.w), bfhi(c.w)};
    const float pvv[8] = {bflo(pv.x), bfhi(pv.x), bflo(pv.y), bfhi(pv.y), bflo(pv.z), bfhi(pv.z), bflo(pv.w), bfhi(pv.w)};
    const float nv[8] = {bflo(nx.x), bfhi(nx.x), bflo(nx.y), bfhi(nx.y), bflo(nx.z), bfhi(nx.z), bflo(nx.w), bfhi(nx.w)};
    const float mu0[8] = {q.a0[0], q.a0[1], q.a0[2], q.a0[3], q.a1[0], q.a1[1], q.a1[2], q.a1[3]};
    const float mu1[8] = {q.b0[0], q.b0[1], q.b0[2], q.b0[3], q.b1[0], q.b1[1], q.b1[2], q.b1[3]};
    float o[8];
#pragma unroll
    for (int j = 0; j < 8; ++j) o[j] = cv[j] + (fp_ * pvv[j] - cv[j]) * mu0[j] + (fn_ * nv[j] - cv[j]) * mu1[j];
    u32x4 w; w.x = pk2(o[0], o[1]); w.y = pk2(o[2], o[3]); w.z = pk2(o[4], o[5]); w.w = pk2(o[6], o[7]);
    return w;
  };
  auto step = [&](MixRaw& q, int kt) __attribute__((always_inline)) {
    const u32x4 ra0 = finish(q, 0), ra1 = finish(q, 1), rb0 = q.b[0], rb1 = q.b[1];
    __syncthreads();
    *(u32x4*)(sA + r_ * SGLD + k_) = ra0;
    *(u32x4*)(sA + (r_ + 64) * SGLD + k_) = ra1;
    *(u32x4*)(sB + r_ * SGLD + k_) = rb0;
    *(u32x4*)(sB + (r_ + 64) * SGLD + k_) = rb1;
    __syncthreads();
    if (kt + 2 < 16) issue(kt + 2, q);
#pragma unroll
    for (int ks = 0; ks < 2; ++ks) {
      bf16x8 af[4], bq[2];
#pragma unroll
      for (int m = 0; m < 4; ++m) af[m] = *(const bf16x8*)(sA + (wr * 64 + m * 16 + fr) * SGLD + ks * 32 + fq * 8);
#pragma unroll
      for (int n = 0; n < 2; ++n) bq[n] = *(const bf16x8*)(sB + (wc * 32 + n * 16 + fr) * SGLD + ks * 32 + fq * 8);
#pragma unroll
      for (int m = 0; m < 4; ++m)
#pragma unroll
        for (int n = 0; n < 2; ++n) acc[m][n] = MFMA16(af[m], bq[n], acc[m][n]);
    }
  };
  MixRaw Q, P;
  issue(0, Q); issue(1, P);
#pragma unroll 1
  for (int kt = 0; kt < 16; kt += 2) { step(Q, kt); step(P, kt + 1); }
  const int r0 = wr * 64, c0 = wc * 32;
#pragma unroll
  for (int m = 0; m < 4; ++m)
#pragma unroll
    for (int n = 0; n < 2; ++n)
#pragma unroll
      for (int j = 0; j < 4; ++j) {
        const int row = row0 + r0 + m * 16 + fq * 4 + j, col = c0 + n * 16 + fr;
        float v = acc[m][n][j];
        if (ACT == 1) v = 1.0f - 2.0f * __builtin_amdgcn_rcpf(1.0f + __expf(2.0f * v));
        if (ACT == 2) v = sigmoidf_(v);
        dst[(size_t)row * 128 + col] = f2bf(v);
      }
}
DI void phase_rwkv_feat1(KP p, char* smem) {
  char* const ws = ows(p);
  const bf16_t* hb = (const bf16_t*)(ws + OFF_H);
  const bf16_t* wm = (const bf16_t*)(ws + OFF_WMIX);
  const float* mu = gin(p, 18);
  char* U = ws + OFF_U;
  const int n3 = 544, n4 = n3 + 544, n5 = n4 + 512;
  for (int t = obid(); t < n5; t += gridDim.x) {
    if (t < n3) rwkv_mix_gemm_tile<1>(smem, hb, mu, 1, wm + W_WA1, (bf16_t*)(U + U3_LW), t * 128);
    else if (t < n4) rwkv_mix_gemm_tile<0>(smem, hb, mu, 4, wm + W_AA1, (bf16_t*)(U + U3_LA), (t - n3) * 128);
    else rwkv_mix_gemm_tile<2>(smem, hb, mu, 5, wm + W_G1, (bf16_t*)(U + U3_LG), (t - n4) * 128);
  }
}
constexpr int F2_W = 1024 * 144;
constexpr int F2_LDS = F2_W + 4096;
DI void phase_rwkv_feat2(KP p, char* smem) {
  char* const ws = ows(p);
  char* U = ws + OFF_U;
  const bf16_t* wmix = (const bf16_t*)(ws + OFF_WMIX);
  const int tid = otid(), lane = tid & 63, wid = tid >> 6, r = lane & 31, h = lane >> 5;
  const int nblk = gridDim.x, nbA = (nblk * 13) >> 6, nbG = (nblk - 4 * nbA) >> 1;
  int set, bl, nb;
  { const int bidx = obid(); if (bidx < 4 * nbA) { set = bidx / nbA; bl = bidx % nbA; nb = nbA; } else { const int b2 = bidx - 4 * nbA; set = 4 + (b2 >= nbG); bl = set == 4 ? b2 : b2 - nbG; nb = set == 4 ? nbG : nblk - 4 * nbA - nbG; } }
  const bool isg = set >= 4;
  const int job = isg ? 2 : (set >> 1), d = isg ? 0 : (set & 1), hf = isg ? set - 4 : 0;
  const int KS = isg ? 8 : 4;
  const int ldw = KS * 32 + 16;
  const int ncols = isg ? 512 : 1024, nrows = isg ? TL : TT;
  const bf16_t* hid = (const bf16_t*)(U + (job == 0 ? U3_LW : job == 1 ? U3_LA : U3_LG)) + (isg ? 0 : d * 64);
  const bf16_t* w2 = wmix + (job == 0 ? W_WA2 : job == 1 ? W_AA2 : W_G2) + (isg ? (size_t)hf * 512 * 128 : (size_t)d * 1024 * 128 + d * 64);
  const float* bias = (job == 0 ? gin(p, 20) : gin(p, 23)) + d * 1024;
  bf16_t* dst = (bf16_t*)(U + (job == 0 ? (d ? U3_LD1 : U3_LD0) : job == 1 ? (d ? U3_A1 : U3_A0) : U3_G)) + hf * 512;
  const float sc_ = job == 0 ? -0.60653065971f : 1.0f;
  __syncthreads();
  float* sbias = (float*)(smem + F2_W);
  for (int c = tid; c < 1024; c += NTH) sbias[c] = isg ? 0.f : bias[c];
  {
    const int cpr = KS * 2;
    for (int c = tid; c < ncols * cpr; c += NTH) {
      const int n = c / cpr, ck = c % cpr, within = n & 31, hh = within >> 4, i = within & 15;
      const int slot = (n & ~31) + (i & 3) + 8 * (i >> 2) + 4 * hh;
      *(u32x4*)(smem + slot * ldw + ck * 16) = ld16(w2 + (size_t)n * 128 + ck * 8);
    }
  }
  __syncthreads();
  for (int t = bl * 8 + wid; t < nrows / 32; t += nb * 8) {
    const size_t row = (size_t)t * 32 + r;
    bf16x8 hb[8];
#pragma unroll
    for (int s2 = 0; s2 < 8; ++s2) if (s2 < KS) hb[s2] = __builtin_bit_cast(bf16x8, ld16(hid + row * 128 + 16 * s2 + 8 * h));
#pragma unroll 2
    for (int ct = 0; ct < ncols / 32; ++ct) {
      f32x16 acc;
#pragma unroll
      for (int i = 0; i < 16; ++i) acc[i] = 0.f;
      const char* wrow = smem + (ct * 32 + r) * ldw + 16 * h;
#pragma unroll
      for (int s2 = 0; s2 < 8; ++s2) if (s2 < KS) acc = MFMA32(*(const bf16x8*)(wrow + 32 * s2), hb[s2], acc);
      const int n0 = ct * 32 + 16 * h;
      float y[16];
      if (!isg) {
#pragma unroll
        for (int q = 0; q < 4; ++q) {
          const f32x4 b4 = *(const f32x4*)(sbias + n0 + 4 * q);
#pragma unroll
          for (int j = 0; j < 4; ++j) y[4 * q + j] = sc_ * sigmoidf_(acc[4 * q + j] + b4[j]);
        }
      } else {
#pragma unroll
        for (int i = 0; i < 16; ++i) y[i] = acc[i];
      }
      u32x4 w0, w1;
      w0.x = pk2(y[0], y[1]); w0.y = pk2(y[2], y[3]); w0.z = pk2(y[4], y[5]); w0.w = pk2(y[6], y[7]);
      w1.x = pk2(y[8], y[9]); w1.y = pk2(y[10], y[11]); w1.z = pk2(y[12], y[13]); w1.w = pk2(y[14], y[15]);
      bf16_t* q_ = dst + row * DM + n0;
      *(u32x4*)q_ = w0; *(u32x4*)(q_ + 8) = w1;
    }
  }
}

constexpr int C3_L = 32, C3_LDK = 72, C3_LDT = 40, C3_LDY = 36;
constexpr int C3_BT = 0, C3_RT = 4608, C3_KT = 9216, C3_CT = 13824, C3_KHT = 18432, C3_CHT = 23552, C3_VT = 28672, C3_GKB = 33792, C3_GKR = 36352,
              C3_GCR = 38912, C3_S0 = 41472, C3_U = 50688, C3_MCB = 55808, C3_Y = 59904, C3_E = 69120, C3_TOT = 69376, C3_SCAN = 70400;
constexpr int SC_LDS = 2 * C3_SCAN;
DI void lds_bar() { asm volatile("s_waitcnt lgkmcnt(0)" ::: "memory"); __builtin_amdgcn_s_barrier(); asm volatile("" ::: "memory"); }
#define DPP_ADD(s, ctrl) ((s) + __builtin_bit_cast(float, __builtin_amdgcn_update_dpp(0, __builtin_bit_cast(int, (s)), (ctrl), 0xF, 0xF, true)))
DI float wave_sum_dpp(float s) {
  s = DPP_ADD(s, 0xB1); s = DPP_ADD(s, 0x4E); s = DPP_ADD(s, 0x141); s = DPP_ADD(s, 0x140);
  const int si = __builtin_bit_cast(int, s);
  const float a0 = __builtin_bit_cast(float, __builtin_amdgcn_readlane(si, 0)), a1 = __builtin_bit_cast(float, __builtin_amdgcn_readlane(si, 16));
  const float a2 = __builtin_bit_cast(float, __builtin_amdgcn_readlane(si, 32)), a3 = __builtin_bit_cast(float, __builtin_amdgcn_readlane(si, 48));
  return (a0 + a1) + (a2 + a3);
}
DI void phase_rwkv_scan(KP p, char* smem) {
  char* const ws = ows(p);
  const int tid = otid(), lane = tid & 63, wid = tid >> 6, sc = wid >> 2, w4 = wid & 3, r = lane & 31, h = lane >> 5;
  char* sb = smem + sc * C3_SCAN;
  bf16_t* Bt = (bf16_t*)(sb + C3_BT); bf16_t* Rt = (bf16_t*)(sb + C3_RT); bf16_t* Kt = (bf16_t*)(sb + C3_KT); bf16_t* Ct = (bf16_t*)(sb + C3_CT);
  bf16_t* KhT = (bf16_t*)(sb + C3_KHT); bf16_t* ChT = (bf16_t*)(sb + C3_CHT); bf16_t* Vt = (bf16_t*)(sb + C3_VT);
  bf16_t* GkbT = (bf16_t*)(sb + C3_GKB); bf16_t* GkrT = (bf16_t*)(sb + C3_GKR); bf16_t* GcrT = (bf16_t*)(sb + C3_GCR);
  bf16_t* S0b = (bf16_t*)(sb + C3_S0); bf16_t* Ub = (bf16_t*)(sb + C3_U);
  float* McbP = (float*)(sb + C3_MCB); float* Yb = (float*)(sb + C3_Y); float* Eb = (float*)(sb + C3_E); float* Tot = (float*)(sb + C3_TOT);
  char* U = ws + OFF_U;
  const bf16_t* Kx = (const bf16_t*)(U + U3_K);
  const bf16_t* Vx = (const bf16_t*)(U + U3_V);
  const bf16_t* Rx = (const bf16_t*)(U + U3_R);
  const int ti = w4 >> 1, tj = w4 & 1;
  const int tio = w4 & 1;
  const int sv = w4 * 16 + (lane >> 2), jq = lane & 3;
  for (int base = obid() * 2; base < 512; base += gridDim.x * 2) {
    const int item = base + sc, dir = item & 1, head = (item >> 1) & 15, b = item >> 5;
    const bf16_t* Ax = (const bf16_t*)(U + (dir ? U3_A1 : U3_A0));
    const bf16_t* Lx = (const bf16_t*)(U + (dir ? U3_LD1 : U3_LD0));
    bf16_t* Ox = (bf16_t*)(U + (dir ? U3_O1 : U3_O0));
    const int ch = head * 64 + lane;
    const float kkw = gin(p, 28)[ch], kaw = gin(p, 29)[ch];
    auto rowof = [&](int n) -> int {
      if (n < 256) { const int c = dir ? 255 - n : n; return TL + b * 256 + c; }
      const int s = dir ? 4095 - (n - 256) : n - 256; return b * 4096 + s;
    };
    f32x16 S;
#pragma unroll
    for (int i = 0; i < 16; ++i) S[i] = 0.f;
    for (int i = lane; i < 64 * C3_LDK / 4; i += 64) if (w4 == 0) ((unsigned long long*)S0b)[i] = 0ull;
    bf16_t pk_[8], pa_[8], pl_[8], pv_[8], pr_[8];
    auto prefetch = [&](int c) {
#pragma unroll
      for (int q = 0; q < 8; ++q) {
        const int n = c * C3_L + w4 * 8 + q;
        const size_t off = (size_t)rowof(n) * DM + ch;
        pk_[q] = Kx[off]; pa_[q] = Ax[off]; pl_[q] = Lx[off]; pv_[q] = Vx[off];
        pr_[q] = n >= 256 ? Rx[off] : (bf16_t)0;
      }
    };
    constexpr int NCH = 4352 / C3_L;
    prefetch(0);
    lds_bar();
    for (int c = 0; c < NCH; ++c) {
      float kkv[8], cv[8], kdv[8], lv[8], cl[8], rv[8], vv[8];
      {
        float run = 0.f;
#pragma unroll
        for (int q = 0; q < 8; ++q) {
          const float kv = bf2f(pk_[q]), av = bf2f(pa_[q]);
          lv[q] = bf2f(pl_[q]); rv[q] = bf2f(pr_[q]); vv[q] = bf2f(pv_[q]);
          const float kkr = kv * kkw;
          kkv[q] = kkr * __builtin_amdgcn_rsqf(fmaxf(wave_sum_dpp(kkr * kkr), 1e-24f));
          cv[q] = kkv[q] * av;
          kdv[q] = kv * (1.0f + (av - 1.0f) * kaw);
          run += lv[q]; cl[q] = run;
        }
        Tot[w4 * 64 + lane] = run;
      }
      if (c + 1 < NCH) prefetch(c + 1);
      lds_bar();
      {
        const float t0 = Tot[lane], t1 = Tot[64 + lane], t2 = Tot[128 + lane], t3 = Tot[192 + lane];
        const float cumL = (t0 + t1) + (t2 + t3);
        const float off = w4 == 0 ? 0.f : (w4 == 1 ? t0 : (w4 == 2 ? t0 + t1 : (t0 + t1) + t2));
        float kh[8], chh[8];
#pragma unroll
        for (int q = 0; q < 8; ++q) {
          const int t = w4 * 8 + q;
          const float cumt = off + cl[q], cump = cumt - lv[q];
          const float e1 = __expf(cump), e2 = __expf(cumt), e3 = __expf(-cumt), e4 = __expf(cumL - cumt);
          Bt[t * C3_LDK + lane] = f2bf(kkv[q] * e1);
          Rt[t * C3_LDK + lane] = f2bf(rv[q] * e2);
          Kt[t * C3_LDK + lane] = f2bf(kdv[q] * e3);
          Ct[t * C3_LDK + lane] = f2bf(cv[q] * e3);
          kh[q] = kdv[q] * e4; chh[q] = cv[q] * e4;
        }
        u32x4 w;
        w.x = pk2(kh[0], kh[1]); w.y = pk2(kh[2], kh[3]); w.z = pk2(kh[4], kh[5]); w.w = pk2(kh[6], kh[7]);
        *(u32x4*)(KhT + lane * C3_LDT + w4 * 8) = w;
        w.x = pk2(chh[0], chh[1]); w.y = pk2(chh[2], chh[3]); w.z = pk2(chh[4], chh[5]); w.w = pk2(chh[6], chh[7]);
        *(u32x4*)(ChT + lane * C3_LDT + w4 * 8) = w;
        w.x = pk2(vv[0], vv[1]); w.y = pk2(vv[2], vv[3]); w.z = pk2(vv[4], vv[5]); w.w = pk2(vv[6], vv[7]);
        *(u32x4*)(Vt + lane * C3_LDT + w4 * 8) = w;
        if (w4 == 0) Eb[lane] = __expf(cumL);
      }
      lds_bar();
      {
        const bf16_t* Ag = (w4 & 1) ? Kt : Ct;
        const bf16_t* Bg = (w4 & 2) ? Rt : Bt;
        f32x16 X;
#pragma unroll
        for (int i = 0; i < 16; ++i) X[i] = 0.f;
#pragma unroll
        for (int s = 0; s < 4; ++s) {
          const bf16x8 a = *(const bf16x8*)(Ag + r * C3_LDK + 16 * s + 8 * h);
          const bf16x8 bq = *(const bf16x8*)(Bg + r * C3_LDK + 16 * s + 8 * h);
          X = MFMA32(a, bq, X);
        }
        const bool incl = (w4 & 2) != 0;
#pragma unroll
        for (int i = 0; i < 16; ++i) { const int jr = (i & 3) + 8 * (i >> 2) + 4 * h; if (!(jr < r || (incl && jr == r))) X[i] = 0.f; }
        if (w4 == 0) {
#pragma unroll
          for (int i = 0; i < 16; ++i) { const int jr = (i & 3) + 8 * (i >> 2) + 4 * h; McbP[r * 32 + (jr & 3) * 8 + (jr >> 2)] = X[i]; }
        } else {
          bf16_t* G = w4 == 1 ? GkbT : (w4 == 2 ? GcrT : GkrT);
#pragma unroll
          for (int g = 0; g < 4; ++g) { u32x2 w; w.x = pk2(X[4 * g], X[4 * g + 1]); w.y = pk2(X[4 * g + 2], X[4 * g + 3]); *(u32x2*)(G + r * C3_LDT + 8 * g + 4 * h) = w; }
        }
      }
      lds_bar();
      f32x16 XO;
      {
        const bf16_t* Bq = (w4 & 2) ? Rt : Bt;
        const bf16_t* Gq = (w4 & 2) ? GkrT : GkbT;
#pragma unroll
        for (int i = 0; i < 16; ++i) XO[i] = 0.f;
#pragma unroll
        for (int s = 0; s < 4; ++s) {
          const bf16x8 a = *(const bf16x8*)(S0b + (32 * tio + r) * C3_LDK + 16 * s + 8 * h);
          const bf16x8 bq = *(const bf16x8*)(Bq + r * C3_LDK + 16 * s + 8 * h);
          XO = MFMA32(a, bq, XO);
        }
#pragma unroll
        for (int s = 0; s < 2; ++s) {
          const bf16x8 a = *(const bf16x8*)(Vt + (32 * tio + r) * C3_LDT + 16 * s + 8 * h);
          const bf16x8 bq = *(const bf16x8*)(Gq + r * C3_LDT + 16 * s + 8 * h);
          XO = MFMA32(a, bq, XO);
        }
        if (w4 < 2) {
#pragma unroll
          for (int i = 0; i < 16; ++i) Yb[(32 * tio + (i & 3) + 8 * (i >> 2) + 4 * h) * C3_LDY + r] = XO[i];
        }
      }
      lds_bar();
      {
        float u[8];
#pragma unroll
        for (int jj = 0; jj < 8; ++jj) u[jj] = 0.f;
        const unsigned ma = (unsigned)(size_t)(McbP + jq * 8);
        f32x4 yv[8];
#pragma unroll
        for (int i = 0; i < 8; ++i) yv[i] = *(const f32x4*)(Yb + sv * C3_LDY + 4 * i);
        f32x4 mA[4], mB[4];
#define C3_MLOAD(t_) asm volatile("ds_read_b128 %0, %2 offset:%c3\n\tds_read_b128 %1, %2 offset:%c4" : "=&v"(mA[(t_) & 3]), "=&v"(mB[(t_) & 3]) : "v"(ma), "i"((t_) * 128), "i"((t_) * 128 + 16) : "memory")
        C3_MLOAD(1); C3_MLOAD(2); C3_MLOAD(3);
        if (jq == 0) u[0] = yv[0][0];
#pragma unroll
        for (int t = 1; t < 32; ++t) {
          if (t + 3 < 32) { C3_MLOAD(t + 3); asm volatile("s_waitcnt lgkmcnt(6)" ::: "memory"); }
          else if (t + 2 < 32) asm volatile("s_waitcnt lgkmcnt(4)" ::: "memory");
          else if (t + 1 < 32) asm volatile("s_waitcnt lgkmcnt(2)" ::: "memory");
          else asm volatile("s_waitcnt lgkmcnt(0)" ::: "memory");
          asm volatile("" :: "v"(mA[t & 3]), "v"(mB[t & 3]));
          __builtin_amdgcn_sched_barrier(0);
          const f32x4 m0 = mA[t & 3], m1 = mB[t & 3];
          const int jl = (t - 1) >> 2;
          float part = 0.f;
#pragma unroll
          for (int jj = 0; jj < 8; ++jj) if (jj != jl && jj * 4 < t) part += u[jj] * (jj < 4 ? m0[jj] : m1[jj - 4]);
          part += u[jl] * (jl < 4 ? m0[jl] : m1[jl - 4]);
          part = DPP_ADD(part, 0xB1); part = DPP_ADD(part, 0x4E);
          const float ut = yv[t >> 2][t & 3] - part;
          u[t >> 2] = (jq == (t & 3)) ? ut : u[t >> 2];
        }
#undef C3_MLOAD
#pragma unroll
        for (int jj = 0; jj < 8; ++jj) Ub[sv * C3_LDT + jq + 4 * jj] = f2bf(u[jj]);
      }
      lds_bar();
      if (w4 >= 2) {
        f32x16 X2;
#pragma unroll
        for (int i = 0; i < 16; ++i) X2[i] = 0.f;
#pragma unroll
        for (int s = 0; s < 2; ++s) {
          const bf16x8 a = *(const bf16x8*)(Ub + (32 * tio + r) * C3_LDT + 16 * s + 8 * h);
          const bf16x8 bq = *(const bf16x8*)(GcrT + r * C3_LDT + 16 * s + 8 * h);
          X2 = MFMA32(a, bq, X2);
        }
        if (c * C3_L >= 256) {
          const size_t orow = (size_t)rowof(c * C3_L + r) * DM + head * 64 + 32 * tio + 4 * h;
#pragma unroll
          for (int g = 0; g < 4; ++g) {
            u32x2 w; w.x = pk2(XO[4 * g] - X2[4 * g], XO[4 * g + 1] - X2[4 * g + 1]); w.y = pk2(XO[4 * g + 2] - X2[4 * g + 2], XO[4 * g + 3] - X2[4 * g + 3]);
            *(u32x2*)(Ox + orow + 8 * g) = w;
          }
        }
      }
      {
        f32x16 P1, P2;
#pragma unroll
        for (int i = 0; i < 16; ++i) { P1[i] = 0.f; P2[i] = 0.f; }
#pragma unroll
        for (int s = 0; s < 2; ++s) {
          const bf16x8 av = *(const bf16x8*)(Vt + (32 * ti + r) * C3_LDT + 16 * s + 8 * h);
          const bf16x8 bk = *(const bf16x8*)(KhT + (32 * tj + r) * C3_LDT + 16 * s + 8 * h);
          P1 = MFMA32(av, bk, P1);
          const bf16x8 au = *(const bf16x8*)(Ub + (32 * ti + r) * C3_LDT + 16 * s + 8 * h);
          const bf16x8 bc = *(const bf16x8*)(ChT + (32 * tj + r) * C3_LDT + 16 * s + 8 * h);
          P2 = MFMA32(au, bc, P2);
        }
        const float ek = Eb[32 * tj + r];
#pragma unroll
        for (int i = 0; i < 16; ++i) {
          S[i] = S[i] * ek + P1[i] - P2[i];
          S0b[(32 * ti + (i & 3) + 8 * (i >> 2) + 4 * h) * C3_LDK + 32 * tj + r] = f2bf(S[i]);
        }
      }
      lds_bar();
    }
  }
}

DI void phase_rwkv_out(KP p, char* smem) {
  char* const ws = ows(p);
  const int lane = otid() & 63, wid = otid() >> 6;
  char* U = ws + OFF_U;
  const bf16_t *Rx = (const bf16_t*)(U + U3_R), *Kx = (const bf16_t*)(U + U3_K), *Vx = (const bf16_t*)(U + U3_V), *A0 = (const bf16_t*)(U + U3_A0),
               *A1 = (const bf16_t*)(U + U3_A1), *Gx = (const bf16_t*)(U + U3_G), *O0 = (const bf16_t*)(U + U3_O0), *O1 = (const bf16_t*)(U + U3_O1);
  bf16_t* Z = (bf16_t*)(ws + OFF_H);
  const int ch0 = lane * 16;
  float ka[16], rk[16], lw[16], lb[16];
#pragma unroll
  for (int j = 0; j < 16; ++j) { ka[j] = gin(p, 29)[ch0 + j]; rk[j] = gin(p, 30)[ch0 + j]; lw[j] = gin(p, 31)[ch0 + j]; lb[j] = gin(p, 32)[ch0 + j]; }
  auto ld16f = [&](const bf16_t* base, size_t off, float (&o)[16]) {
    const u32x4 a = ld16(base + off), b = ld16(base + off + 8);
    o[0] = bflo(a.x); o[1] = bfhi(a.x); o[2] = bflo(a.y); o[3] = bfhi(a.y); o[4] = bflo(a.z); o[5] = bfhi(a.z); o[6] = bflo(a.w); o[7] = bfhi(a.w);
    o[8] = bflo(b.x); o[9] = bfhi(b.x); o[10] = bflo(b.y); o[11] = bfhi(b.y); o[12] = bflo(b.z); o[13] = bfhi(b.z); o[14] = bflo(b.w); o[15] = bfhi(b.w);
  };
  for (int r = obid() * 8 + wid; r < TL; r += gridDim.x * 8) {
    const size_t off = (size_t)r * DM + ch0;
    float o0[16], o1[16], rr[16], kk[16], vv[16], a0[16], a1[16], gg[16];
    ld16f(O0, off, o0); ld16f(O1, off, o1); ld16f(Rx, off, rr); ld16f(Kx, off, kk); ld16f(Vx, off, vv); ld16f(A0, off, a0); ld16f(A1, off, a1); ld16f(Gx, off, gg);
    float s = 0.f, bs = 0.f;
#pragma unroll
    for (int j = 0; j < 16; ++j) {
      o0[j] += o1[j]; s += o0[j];
      const float kd0 = kk[j] * (1.0f + (a0[j] - 1.0f) * ka[j]), kd1 = kk[j] * (1.0f + (a1[j] - 1.0f) * ka[j]);
      bs += rr[j] * (kd0 + kd1) * rk[j];
    }
    s += __shfl_xor(s, 1); s += __shfl_xor(s, 2);
    bs += __shfl_xor(bs, 1); bs += __shfl_xor(bs, 2);
    const float mean = s * (1.0f / 64.0f);
    float q = 0.f;
#pragma unroll
    for (int j = 0; j < 16; ++j) { const float d = o0[j] - mean; q += d * d; }
    q += __shfl_xor(q, 1); q += __shfl_xor(q, 2);
    const float rstd = rsqrtf(q * (1.0f / 64.0f) + 64e-5f);
    float z[16];
#pragma unroll
    for (int j = 0; j < 16; ++j) z[j] = ((o0[j] - mean) * rstd * lw[j] + lb[j] + bs * vv[j]) * gg[j];
    u32x4 w0;
    w0.x = pk4_fp8(z[0] * O8_SCALE, z[1] * O8_SCALE, z[2] * O8_SCALE, z[3] * O8_SCALE); w0.y = pk4_fp8(z[4] * O8_SCALE, z[5] * O8_SCALE, z[6] * O8_SCALE, z[7] * O8_SCALE);
    w0.z = pk4_fp8(z[8] * O8_SCALE, z[9] * O8_SCALE, z[10] * O8_SCALE, z[11] * O8_SCALE); w0.w = pk4_fp8(z[12] * O8_SCALE, z[13] * O8_SCALE, z[14] * O8_SCALE, z[15] * O8_SCALE);
    *(u32x4*)((unsigned char*)Z + off) = w0;
  }
}

#define XB_TMO      128
#define XB_XCNT(j)  (256  + 64 * (j))
#define XB_XSUB(j)  (1280 + 64 * (j))
#define XB_XGEN(j)  (2304 + 64 * (j))
#define XB_TOP      3328
#define XB_TOPGEN   3392
#define XCD_BAR_WORDS 3456
#define XB_SPIN_CAP (1u << 22)
#define LAS __attribute__((address_space(3)))
__device__ __forceinline__ unsigned xb_ld(unsigned* p)              { return __hip_atomic_load(p, __ATOMIC_RELAXED, __HIP_MEMORY_SCOPE_AGENT); }
__device__ __forceinline__ unsigned xb_add(unsigned* p, unsigned v) { return __hip_atomic_fetch_add(p, v, __ATOMIC_RELAXED, __HIP_MEMORY_SCOPE_AGENT); }
__device__ __forceinline__ unsigned xb_xcc_id() { return (unsigned)__builtin_amdgcn_s_getreg((3 << 11) | 20) & 0xFu; }
#define XB_SPIN(cond, bar) do { unsigned _sp = 0; while (cond) { __builtin_amdgcn_s_sleep(1); \
    if ((++_sp & 255u) == 0u) { if (xb_ld(&(bar)[XB_TMO])) break; if (_sp > XB_SPIN_CAP) { atomicAdd(&(bar)[XB_TMO], 1u); break; } } } } while (0)
struct XcdBarrier { unsigned* bar; unsigned x; volatile LAS unsigned* st; };
__device__ __forceinline__ XcdBarrier xcd_barrier_post(unsigned* bar, volatile LAS unsigned* st) {
    XcdBarrier b; b.bar = bar; b.x = xb_xcc_id(); b.st = st;
    if (otid() == 0) (void)xb_add(&bar[XB_XCNT(b.x)], 1u);
    return b;
}
__device__ __forceinline__ void xcd_barrier_complete(unsigned* bar, unsigned x, unsigned& nloc, unsigned& nx) {
    const unsigned G = gridDim.x * gridDim.y * gridDim.z;
    unsigned sum, cnt, mine, sp = 0u;
    for (;;) {
        sum = 0u; cnt = 0u; mine = 0u;
#pragma unroll
        for (unsigned j = 0; j < 16; ++j) { const unsigned c = xb_ld(&bar[XB_XCNT(j)]); sum += c; cnt += (c > 0u) ? 1u : 0u; mine = (j == x) ? c : mine; }
        if (sum == G) break;
        __builtin_amdgcn_s_sleep(1);
        if ((++sp & 255u) == 0u) { if (xb_ld(&bar[XB_TMO])) break; if (sp > XB_SPIN_CAP) { atomicAdd(&bar[XB_TMO], 1u); break; } }
    }
    nloc = mine > 0u ? mine : 1u; nx = cnt > 0u ? cnt : 1u;
}
__device__ __forceinline__ void xcd_barrier(const XcdBarrier& b) {
    asm volatile("s_waitcnt vmcnt(0)" ::: "memory");
    __syncthreads();
    if (otid() == 0) {
        unsigned* bar = b.bar;
        __builtin_amdgcn_s_waitcnt(0);
        unsigned nloc = b.st[0], nx = b.st[1];
        if (nloc == 0u) { xcd_barrier_complete(bar, b.x, nloc, nx); b.st[0] = nloc; b.st[1] = nx; }
        const unsigned old = xb_add(&bar[XB_XSUB(b.x)], 1u);
        const unsigned gen = old / nloc;
        if (old + 1u == (gen + 1u) * nloc) {
            __builtin_amdgcn_fence(__ATOMIC_RELEASE, "agent");
            asm volatile("s_waitcnt vmcnt(0)" ::: "memory");
            const unsigned og = xb_add(&bar[XB_TOP], 1u);
            const unsigned tg = og / nx;
            if (og + 1u == (tg + 1u) * nx) xb_add(&bar[XB_TOPGEN], 1u);
            else XB_SPIN(xb_ld(&bar[XB_TOPGEN]) == tg, bar);
            __builtin_amdgcn_fence(__ATOMIC_ACQUIRE, "agent");
            xb_add(&bar[XB_XGEN(b.x)], 1u);
            asm volatile("s_waitcnt vmcnt(0)" ::: "memory");
        } else {
            XB_SPIN(xb_ld(&bar[XB_XGEN(b.x)]) == gen, bar);
            __builtin_amdgcn_fence(__ATOMIC_ACQUIRE, "agent");
            asm volatile("s_waitcnt vmcnt(0)" ::: "memory");
        }
    }
    __syncthreads();
}

DI void gbar(const XcdBarrier& b0) {
  XcdBarrier b = b0;
  unsigned long long pb = (unsigned long long)b.bar; asm volatile("" : "+s"(pb)); b.bar = (unsigned*)pb;
  unsigned x = b.x; asm volatile("" : "+s"(x)); b.x = x;
  xcd_barrier(b);
}

constexpr int cmaxi(int a, int b) { return a > b ? a : b; }
constexpr int FUSED_LDS = 256 + cmaxi(cmaxi(cmaxi(MOD_LDS, A1_LDS), F2_LDS), cmaxi(cmaxi(SC_LDS, R2_LDS), FG_LDS + MOE_UMAX * 1024 + 256));
#ifndef PROBE_GROUP
#define PROBE_GROUP 0
#endif
#define PROBE(g, stmt) do { if constexpr (PROBE_GROUP == (g)) { stmt; gbar(bar); } } while (0)
template <int layer>
DI void run_layer(const XcdBarrier& bar, char* smem) {
  char* U = ows(kparams()) + OFF_U;
  const bf16_t* wm = (const bf16_t*)(ows(kparams()) + OFF_WMIX);
  if constexpr (layer == 0) phase_norm1<0, false, true>(kparams(), layer, smem); else phase_norm1<1, false, layer == 1>(kparams(), layer, smem);
  gbar(bar);
  PROBE(1, (phase_norm1<(layer == 0 ? 0 : 1), true, (layer <= 1)>(kparams(), layer, smem)));
  if constexpr (layer == 0) {
    phase_qkv_win8(kparams(), smem);
    gbar(bar);
    PROBE(3, phase_qkv_win8(kparams(), smem));
    phase_attn_win(kparams(), smem);
    gbar(bar);
    PROBE(4, phase_attn_win(kparams(), smem));
    phase_oproj8(kparams(), 0, U + U0_O, (const char*)(wm + W_WINO), TT, smem);
    gbar(bar);
    PROBE(3, (phase_oproj8<true>(kparams(), 0, U + U0_O, (const char*)(wm + W_WINO), TT, smem)));
  } else if constexpr (layer == 1) {
    phase_qkv_diff8(kparams(), smem);
    gbar(bar);
    PROBE(3, phase_qkv_diff8(kparams(), smem));
    phase_attn_diff(kparams(), smem);
    gbar(bar);
    PROBE(10, phase_attn_diff(kparams(), smem));
    phase_oproj8(kparams(), 1, U + U1_O, (const char*)(wm + W_DIFFO), TT, smem);
    gbar(bar);
    PROBE(3, (phase_oproj8<true>(kparams(), 1, U + U1_O, (const char*)(wm + W_DIFFO), TT, smem)));
  } else if constexpr (layer == 2) {
    phase_pool_pre(kparams(), smem);
    gbar(bar);
    PROBE(6, phase_pool_pre(kparams(), smem));
    phase_pool(kparams(), smem);
    gbar(bar);
    PROBE(6, phase_pool<true>(kparams(), smem));
  } else {
    phase_rwkv_mix(kparams(), smem);
    gbar(bar);
    PROBE(7, phase_rwkv_mix(kparams(), smem));
    phase_rwkv_rkv(kparams(), smem);
    __syncthreads();
    phase_rwkv_feat1(kparams(), smem);
    gbar(bar);
    PROBE(7, phase_rwkv_rkv(kparams(), smem));
    PROBE(8, phase_rwkv_feat1(kparams(), smem));
    phase_rwkv_feat2(kparams(), smem);
    gbar(bar);
    PROBE(8, phase_rwkv_feat2(kparams(), smem));
    phase_rwkv_scan(kparams(), smem);
    gbar(bar);
    PROBE(11, phase_rwkv_scan(kparams(), smem));
    phase_rwkv_out(kparams(), smem);
    gbar(bar);
    PROBE(9, phase_rwkv_out(kparams(), smem));
    phase_oproj8(kparams(), 3, ows(kparams()) + OFF_H, (const char*)(wm + W_RO), TL, smem);
    gbar(bar);
    PROBE(3, (phase_oproj8<true>(kparams(), 3, ows(kparams()) + OFF_H, (const char*)(wm + W_RO), TL, smem)));
  }
  phase_norm2_router(kparams(), layer, smem);
  __syncthreads();
  phase_cvt_moe(kparams(), layer, smem);
  gbar(bar);
  PROBE(2, phase_norm2_router<true>(kparams(), layer, smem));
  PROBE(5, phase_cvt_moe(kparams(), layer, smem));
  phase_moe_up(kparams(), layer, smem);
  gbar(bar);
  phase_moe_down(kparams(), layer, smem);
  gbar(bar);
  PROBE(12, phase_moe_up(kparams(), layer, smem));
  PROBE(12, phase_moe_down(kparams(), layer, smem));
}

__global__ __launch_bounds__(NTH, 2) void k_fused(Params p_unused) {
  extern __shared__ __attribute__((aligned(16))) char smem_all[];
  if (threadIdx.x == 0) *(uint4*)smem_all = make_uint4(0u, 0u, 0u, 0u);
  __syncthreads();
  XcdBarrier bar = xcd_barrier_post((unsigned*)(ows(kparams()) + OFF_BAR), (volatile LAS unsigned*)smem_all);
  char* smem = smem_all + 256;
  phase_cvt_mix(kparams(), smem);
  __syncthreads();
  phase_mod(kparams(), smem);
  gbar(bar);
  PROBE(5, phase_cvt_mix(kparams(), smem));
  PROBE(5, phase_mod(kparams(), smem));
  run_layer<0>(bar, smem);
  run_layer<1>(bar, smem);
  run_layer<2>(bar, smem);
  run_layer<3>(bar, smem);
  phase_norm1<3>(kparams(), 3, smem);
  PROBE(1, (gbar(bar), phase_norm1<3, true>(kparams(), 3, smem)));
}

static void fill_params(Params& p, void* const* d_in, void* d_out, void* d_ws) {
  for (int i = 0; i < 40; ++i) p.in[i] = (const float*)d_in[i];
  p.out = (float*)d_out;
  p.ws = (char*)d_ws;
  bf16_t* wm = (bf16_t*)(p.ws + OFF_WMIX);
  int nj = 0, item = 0;
  auto add = [&](const float* src, size_t dstoff, int K, int N, int ld, int dld = 0, int f8 = 0) {
    p.jobs[nj].src = src; p.jobs[nj].dst = wm + dstoff; p.jobs[nj].K = K; p.jobs[nj].N = N; p.jobs[nj].ld = ld; p.jobs[nj].item0 = item; p.jobs[nj].dld = dld ? dld : K; p.jobs[nj].pad_ = f8;
    item += (K / 64) * (N / 64); ++nj;
  };
  add(p.in[8], W_WINQKV, 1024, 1536, 1536, 0, 1);
  add(p.in[10], W_WINO, 1024, 1024, 1024, 0, 1);
  add(p.in[11], W_DIFFQKV, 1024, 3072, 3072, 0, 1);
  add(p.in[14], W_DIFFO, 1024, 1024, 1024, 0, 1);
  for (int g = 0; g < 4; ++g) add(p.in[15] + (size_t)g * 65536, W_POOL + (size_t)g * 65536, 256, 256, 256);
  add(p.in[19], W_R, 1024, 1024, 1024, 0, 1);
  add(p.in[19] + (size_t)1 * 1024 * 1024, W_K, 1024, 1024, 1024, 0, 1);
  add(p.in[19] + (size_t)2 * 1024 * 1024, W_V, 1024, 1024, 1024, 0, 1);
  for (int d = 0; d < 2; ++d) add(p.in[21] + (size_t)d * 1024 * 64, W_WA1 + (size_t)d * 64 * 1024, 1024, 64, 64);
  for (int d = 0; d < 2; ++d) add(p.in[24] + (size_t)d * 1024 * 64, W_AA1 + (size_t)d * 64 * 1024, 1024, 64, 64);
  add(p.in[26], W_G1, 1024, 128, 128);
  for (int d = 0; d < 2; ++d) add(p.in[22] + (size_t)d * 64 * 1024, W_WA2 + (size_t)d * 1024 * 128 + d * 64, 64, 1024, 1024, 128);
  for (int d = 0; d < 2; ++d) add(p.in[25] + (size_t)d * 64 * 1024, W_AA2 + (size_t)d * 1024 * 128 + d * 64, 64, 1024, 1024, 128);
  add(p.in[27], W_G2, 128, 1024, 1024);
  add(p.in[33], W_RO, 1024, 1024, 1024, 0, 1);
  p.njobs = nj; p.nitems = item;
}

extern "C" void kernel_launch(void* const* d_in, const int* in_sizes, int n_in, void* d_out, int out_size, void* d_ws, size_t ws_size, hipStream_t stream) {
  if (ws_size < WS_NEED || n_in < 40) return;
  Params p{};
  fill_params(p, d_in, d_out, d_ws);
  (void)hipMemsetAsync(p.ws, 0, 32768, stream);
  (void)hipMemsetAsync(p.ws + OFF_H8 + (size_t)TT * DM, 0, 8 * DM, stream);
  static int grid = 0;
  if (!grid) {
    int dev = 0, cus = 0, per_cu = 0;
    (void)hipGetDevice(&dev);
    (void)hipDeviceGetAttribute(&cus, hipDeviceAttributeMultiprocessorCount, dev);
    (void)hipFuncSetAttribute((const void*)k_fused, hipFuncAttributeMaxDynamicSharedMemorySize, FUSED_LDS);
    (void)hipOccupancyMaxActiveBlocksPerMultiprocessor(&per_cu, (const void*)k_fused, NTH, FUSED_LDS);
    grid = cus * (per_cu < 1 ? per_cu : 1);
  }
  if (grid <= 0) return;
  hipLaunchKernelGGL(k_fused, dim3(grid), dim3(NTH), FUSED_LDS, stream, p);
}
```
